# Optimizing an MI355X kernel written in HIP

```python
import jax, jax.numpy as jnp
from jax import lax
import numpy as np

D_MODEL = 1024
BATCH = 4
SEQ = 4096
DEPTH = 1

HEAD_DIM = 64
D_MIX = D_MODEL
GDN_HEADS = (D_MIX // 2) // HEAD_DIM
GDN_WIDTH = GDN_HEADS * HEAD_DIM
SWA_Q_HEADS = (D_MIX - GDN_WIDTH) // HEAD_DIM
SWA_KV_HEADS = 2
SWA_GROUP = SWA_Q_HEADS // SWA_KV_HEADS
SWA_WIDTH = SWA_Q_HEADS * HEAD_DIM
SWA_KV_WIDTH = SWA_KV_HEADS * HEAD_DIM
WINDOW = 128
CONV_WIDTH = 4
CHUNK = 64
D_FF = ((8 * D_MODEL // 3 + 255) // 256) * 256
PROJ_WIDTH = 4 * GDN_WIDTH + 2 * GDN_HEADS + SWA_WIDTH + 2 * SWA_KV_WIDTH
EPS = 1e-6

kernel_name = 'hymba_gdn_swa_adaln'


def rms_norm(x, w):
    xf = x.astype(jnp.float32)
    y = xf * lax.rsqrt(jnp.mean(xf * xf, axis=-1, keepdims=True) + EPS)
    return (y * w.astype(jnp.float32)).astype(x.dtype)


def l2_norm(x):
    xf = x.astype(jnp.float32)
    return xf * lax.rsqrt(jnp.sum(xf * xf, axis=-1, keepdims=True) + EPS)


def causal_depthwise_conv(x, w):
    return lax.conv_general_dilated(
        x, w.astype(x.dtype), window_strides=(1,), padding=[(CONV_WIDTH - 1, 0)],
        dimension_numbers=('NWC', 'WIO', 'NWC'), feature_group_count=x.shape[-1])


def gated_delta_rule_chunked(q, k, v, g, beta):
    B, T, H, Dk = q.shape
    Dv = v.shape[-1]
    N = T // CHUNK

    def chunks(t):
        t = t.reshape((B, N, CHUNK, H) + t.shape[3:])
        return jnp.moveaxis(t, 3, 1)

    q = chunks(q) * (Dk ** -0.5)
    k, v, g, beta = chunks(k), chunks(v), chunks(g), chunks(beta)
    G = jnp.cumsum(g, axis=-1)
    idx = jnp.arange(CHUNK)
    causal = idx[:, None] >= idx[None, :]
    strict = idx[:, None] > idx[None, :]
    decay = jnp.exp(jnp.where(causal, G[..., :, None] - G[..., None, :], -jnp.inf))
    kb = k * beta[..., None]
    A = jnp.where(strict, jnp.einsum('bhncd,bhnsd->bhncs', kb, k) * decay, 0.0)
    L = A + jnp.eye(CHUNK, dtype=A.dtype)
    rhs = jnp.concatenate([v * beta[..., None], kb * jnp.exp(G)[..., None]], axis=-1)
    sol = lax.linalg.triangular_solve(L, rhs, left_side=True, lower=True, unit_diagonal=True)
    u, w = sol[..., :Dv], sol[..., Dv:]
    qk = jnp.where(causal, jnp.einsum('bhncd,bhnsd->bhncs', q, k) * decay, 0.0)
    q_dec = q * jnp.exp(G)[..., None]
    k_dec = k * jnp.exp(G[..., -1:] - G)[..., None]
    chunk_decay = jnp.exp(G[..., -1])

    xs = tuple(jnp.moveaxis(t, 2, 0) for t in (u, w, qk, q_dec, k_dec, chunk_decay))

    def step(S, inp):
        u_c, w_c, qk_c, qd_c, kd_c, dec_c = inp
        v_new = u_c - jnp.einsum('bhcd,bhde->bhce', w_c, S)
        o = jnp.einsum('bhcd,bhde->bhce', qd_c, S) + jnp.einsum('bhcs,bhse->bhce', qk_c, v_new)
        S = S * dec_c[..., None, None] + jnp.einsum('bhcd,bhce->bhde', kd_c, v_new)
        return S, o

    S0 = jnp.zeros((B, H, Dk, Dv), jnp.float32)
    _, o = lax.scan(step, S0, xs)
    return jnp.transpose(o, (1, 0, 3, 2, 4)).reshape(B, T, H, Dv)


def sliding_window_attention(q, k, v, sinks):
    B, T, Hq, D = q.shape
    NB = T // WINDOW
    qb = q.reshape(B, NB, WINDOW, SWA_KV_HEADS, SWA_GROUP, D)

    def banded(t):
        t = t.reshape(B, NB, WINDOW, SWA_KV_HEADS, D)
        prev = jnp.pad(t, ((0, 0), (1, 0), (0, 0), (0, 0), (0, 0)))[:, :-1]
        return jnp.concatenate([prev, t], axis=2)

    kw, vw = banded(k), banded(v)
    s = jnp.einsum('bnqhgd,bnkhd->bhgnqk', qb, kw).astype(jnp.float32) * (D ** -0.5)
    qi = jnp.arange(WINDOW)[:, None] + WINDOW
    ki = jnp.arange(2 * WINDOW)[None, :]
    dist = (qi - ki).astype(jnp.float32)
    in_window = (qi - ki >= 0) & (qi - ki < WINDOW)
    key_exists = (jnp.arange(NB)[:, None] * WINDOW + ki - WINDOW) >= 0
    mask = in_window[None] & key_exists[:, None, :]
    slopes = 2.0 ** (-8.0 * (jnp.arange(Hq, dtype=jnp.float32) + 1.0) / Hq)
    slopes = slopes.reshape(SWA_KV_HEADS, SWA_GROUP)
    s = s - slopes[:, :, None, None, None] * dist
    s = jnp.where(mask, s, -jnp.inf)
    sink = sinks.astype(jnp.float32).reshape(SWA_KV_HEADS, SWA_GROUP)[None, :, :, None, None, None]
    m = jnp.maximum(jnp.max(s, axis=-1, keepdims=True), sink)
    p = jnp.exp(s - m)
    p = p / (jnp.sum(p, axis=-1, keepdims=True) + jnp.exp(sink - m))
    o = jnp.einsum('bhgnqk,bnkhd->bnqhgd', p.astype(v.dtype), vw)
    return o.reshape(B, T, Hq * D)


def setup_inputs(seed: int = 0) -> dict:
    key = jax.random.key(seed)
    ks = jax.random.split(key, 20)
    f32 = jnp.float32
    nrm = lambda k, shape, scale: jax.random.normal(k, shape, f32) * scale
    gain = lambda k, shape: 1.0 + 0.1 * jax.random.normal(k, shape, f32)
    a_init = jax.random.uniform(ks[6], (DEPTH, GDN_HEADS), f32, 1.0, 16.0)
    dt = jnp.exp(jax.random.uniform(ks[7], (DEPTH, GDN_HEADS), f32, np.log(1e-3), np.log(1e-1)))
    return {
        'x': nrm(ks[0], (BATCH, SEQ, D_MODEL), 1.0),
        'c': nrm(ks[1], (BATCH, D_MODEL), 1.0),
        'w_ada': nrm(ks[2], (DEPTH, D_MODEL, 6 * D_MODEL), D_MODEL ** -0.5),
        'b_ada': nrm(ks[3], (DEPTH, 6 * D_MODEL), 0.1),
        'norm1_w': gain(ks[4], (DEPTH, D_MODEL)),
        'w_in': nrm(ks[5], (DEPTH, D_MODEL, PROJ_WIDTH), D_MODEL ** -0.5),
        'conv_w': nrm(ks[8], (DEPTH, CONV_WIDTH, 1, 3 * GDN_WIDTH), CONV_WIDTH ** -0.5),
        'a_log': jnp.log(a_init),
        'dt_bias': dt + jnp.log(-jnp.expm1(-dt)),
        'gdn_norm_w': gain(ks[9], (DEPTH, HEAD_DIM)),
        'q_norm_w': gain(ks[10], (DEPTH, HEAD_DIM)),
        'k_norm_w': gain(ks[11], (DEPTH, HEAD_DIM)),
        'sinks': nrm(ks[12], (DEPTH, SWA_Q_HEADS), 1.0),
        'w_out': nrm(ks[13], (DEPTH, D_MIX, D_MODEL), D_MIX ** -0.5),
        'norm2_w': gain(ks[14], (DEPTH, D_MODEL)),
        'w_gate': nrm(ks[15], (DEPTH, D_MODEL, D_FF), D_MODEL ** -0.5),
        'w_up': nrm(ks[16], (DEPTH, D_MODEL, D_FF), D_MODEL ** -0.5),
        'w_down': nrm(ks[17], (DEPTH, D_FF, D_MODEL), D_FF ** -0.5),
    }


def reference(x, c, w_ada, b_ada, norm1_w, w_in, conv_w, a_log, dt_bias, gdn_norm_w,
              q_norm_w, k_norm_w, sinks, w_out, norm2_w, w_gate, w_up, w_down):
    B, T, _ = x.shape
    split_sizes = (GDN_WIDTH,) * 4 + (GDN_HEADS,) * 2 + (SWA_WIDTH, SWA_KV_WIDTH, SWA_KV_WIDTH)
    split_points = []
    acc = 0
    for sz in split_sizes[:-1]:
        acc += sz
        split_points.append(acc)
    c_act = jax.nn.silu(c)
    for l in range(DEPTH):
        mod = (c_act @ w_ada[l] + b_ada[l])[:, None, :]
        shift1, scale1, gate1, shift2, scale2, gate2 = jnp.split(mod, 6, axis=-1)

        h = rms_norm(x, norm1_w[l]) * (1.0 + scale1) + shift1
        proj = h @ w_in[l]
        gq, gk, gv, gz, ga, gb, sq, sk, sv = jnp.split(proj, split_points, axis=-1)

        qkv = jax.nn.silu(causal_depthwise_conv(jnp.concatenate([gq, gk, gv], axis=-1), conv_w[l]))
        gq, gk, gv = jnp.split(qkv, 3, axis=-1)
        heads = lambda t: t.reshape(B, T, -1, HEAD_DIM)
        q_g = l2_norm(heads(gq))
        k_g = l2_norm(heads(gk))
        v_g = heads(gv).astype(jnp.float32)
        beta = jax.nn.sigmoid(gb.astype(jnp.float32))
        g = -jnp.exp(a_log[l].astype(jnp.float32)) * jax.nn.softplus(
            ga.astype(jnp.float32) + dt_bias[l].astype(jnp.float32))
        o_g = gated_delta_rule_chunked(q_g, k_g, v_g, g, beta).astype(x.dtype)
        o_g = rms_norm(o_g, gdn_norm_w[l]) * jax.nn.silu(heads(gz))
        o_g = o_g.reshape(B, T, GDN_WIDTH)

        q_s = rms_norm(heads(sq), q_norm_w[l])
        k_s = rms_norm(heads(sk), k_norm_w[l])
        v_s = heads(sv)
        o_s = sliding_window_attention(q_s, k_s, v_s, sinks[l])

        mixed = jnp.concatenate([o_g, o_s], axis=-1) @ w_out[l]
        x = x + gate1 * mixed

        h2 = rms_norm(x, norm2_w[l]) * (1.0 + scale2) + shift2
        ffn = (jax.nn.silu(h2 @ w_gate[l]) * (h2 @ w_up[l])) @ w_down[l]
        x = x + gate2 * ffn
    return x
```

```cpp
#include <hip/hip_runtime.h>
#include <cstdio>
#include <cstdint>
#include <cmath>
namespace pg8 {
#define PG8_LAS __attribute__((address_space(3)))
typedef unsigned short bf16_t;
typedef short bf16x8 __attribute__((ext_vector_type(8)));
typedef float f32x4 __attribute__((ext_vector_type(4)));
typedef unsigned u32x4 __attribute__((ext_vector_type(4)));
constexpr int BM = 256, BK = 64, HALF = 128, HTB = HALF * BK * 2  , STAGE_BYTES = 8 * HTB, NXCD = 8, WGM = 8;

__host__ __device__ __forceinline__ int lds_byte(int r, int c) { const int st = (r >> 4) * 2 + (c >> 5), rr = r & 15, cc = c & 31, ob = rr * 64 + cc * 2; return st * 1024 + (ob ^ (((ob >> 9) & 1) << 5)); }
__host__ __device__ __forceinline__ void stage_rc(int b, int& R, int& C) { const int st = b / 1024, sb = b % 1024, swz = sb ^ (((sb >> 9) & 1) << 5); R = (st >> 1) * 16 + swz / 64; C = (st & 1) * 32 + (swz % 64) / 2; }
__host__ __device__ __forceinline__ int perm32(int rho) { const int n = rho >> 4, i = rho & 15; return 8 * (i >> 2) + 4 * n + (i & 3); }

struct Unit { int pm, pn; };
struct Gemm { const bf16_t* A; const bf16_t* Bt; int M, N, K; };

struct StaticOrder {
    int nM, nN, nwg, G, c;
    __host__ __device__ void init(int M, int N, int G_, int c_) { nM = M / BM; nN = N / BM; nwg = nM * nN; G = G_; c = c_; }
    __host__ __device__ bool next(int i, Unit& u) const {
        const long L = (long)i * G + c; if (L >= nwg) return false;
        int wgid = (int)L; { const int q = nwg / NXCD, r = nwg % NXCD, xcd = wgid % NXCD, off = wgid / NXCD; wgid = (xcd < r ? xcd * (q + 1) : r * (q + 1) + (xcd - r) * q) + off; }
        const int nig = WGM * nN, gid = wgid / nig, fm = gid * WGM, gsz = (nM - fm) < WGM ? (nM - fm) : WGM;
        u.pm = fm + ((wgid % nig) % gsz); u.pn = (wgid % nig) / gsz; return true;
    }
    __device__ __forceinline__ void a_ready(const Unit&) const {}
    __device__ __forceinline__ void done(const Unit&) const {}
};

__device__ __forceinline__ unsigned cvt_pk_bf16(float lo, float hi) { unsigned r; asm volatile("v_cvt_pk_bf16_f32 %0, %1, %2" : "=v"(r) : "v"(lo), "v"(hi)); return r; }
__device__ __forceinline__ float silu_f(float x) { return x * __builtin_amdgcn_rcpf(1.0f + __expf(-x)); }

struct EpiBf16Plain {
    static constexpr bool PERM = true, AFTER_DRAIN = false;
    bf16_t* O; int ldc;
    __device__ __forceinline__ void operator()(const f32x4 (&acc)[2][2][4][2], const Unit& u, int wr, int wc, int fr, int fq) const {
        const int row0 = u.pm * BM + wr * 64 + fr, col0 = u.pn * BM + wc * 32 + 8 * fq;
#pragma unroll
        for (int ai = 0; ai < 2; ++ai)
#pragma unroll
            for (int m = 0; m < 4; ++m) { bf16_t* rowp = O + (size_t)(row0 + ai * HALF + m * 16) * ldc + col0;
#pragma unroll
                for (int bj = 0; bj < 2; ++bj) { const f32x4 v0 = acc[ai][bj][m][0], v1 = acc[ai][bj][m][1];
                    u32x4 w; w.x = cvt_pk_bf16(v0[0], v0[1]); w.y = cvt_pk_bf16(v0[2], v0[3]); w.z = cvt_pk_bf16(v1[0], v1[1]); w.w = cvt_pk_bf16(v1[2], v1[3]);
                    *(u32x4*)(rowp + bj * HALF) = w; } }
    }
};
struct EpiSwiGLU {
    static constexpr bool PERM = true, AFTER_DRAIN = false;
    bf16_t* O; int ldc;
    __device__ __forceinline__ void operator()(const f32x4 (&acc)[2][2][4][2], const Unit& u, int wr, int wc, int fr, int fq) const {
        const int row0 = u.pm * BM + wr * 64 + fr, col0 = u.pn * HALF + wc * 32 + 8 * fq;
#pragma unroll
        for (int ai = 0; ai < 2; ++ai)
#pragma unroll
            for (int m = 0; m < 4; ++m) { bf16_t* rowp = O + (size_t)(row0 + ai * HALF + m * 16) * ldc + col0;
                const f32x4 g0 = acc[ai][0][m][0], g1 = acc[ai][0][m][1], u0 = acc[ai][1][m][0], u1 = acc[ai][1][m][1];
                float a[8];
#pragma unroll
                for (int i = 0; i < 4; ++i) { a[i] = silu_f(g0[i]) * u0[i]; a[4 + i] = silu_f(g1[i]) * u1[i]; }
                u32x4 w; w.x = cvt_pk_bf16(a[0], a[1]); w.y = cvt_pk_bf16(a[2], a[3]); w.z = cvt_pk_bf16(a[4], a[5]); w.w = cvt_pk_bf16(a[6], a[7]);
                *(u32x4*)rowp = w; }
    }
};
struct EpiGateRes {
    static constexpr bool PERM = false, AFTER_DRAIN = false;
    const float* base; float* out; int ldc; const float* gate; int gstride; int rows_per_batch;
    __device__ __forceinline__ void operator()(const f32x4 (&acc)[2][2][4][2], const Unit& u, int wr, int wc, int fr, int fq) const {
        const int row0 = u.pm * BM + wr * 64 + fr, col0 = u.pn * BM + wc * 32 + 4 * fq;
        const float* gp = gate + (size_t)((u.pm * BM) / rows_per_batch) * gstride + col0;
        f32x4 gv[2][2];
#pragma unroll
        for (int bj = 0; bj < 2; ++bj)
#pragma unroll
            for (int n = 0; n < 2; ++n) gv[bj][n] = *(const f32x4*)(gp + bj * HALF + n * 16);
#pragma unroll
        for (int ai = 0; ai < 2; ++ai)
#pragma unroll
            for (int m = 0; m < 4; ++m) { const size_t off = (size_t)(row0 + ai * HALF + m * 16) * ldc + col0;
#pragma unroll
                for (int bj = 0; bj < 2; ++bj)
#pragma unroll
                    for (int n = 0; n < 2; ++n) { const f32x4 bs = *(const f32x4*)(base + off + bj * HALF + n * 16);
                        *(f32x4*)(out + off + bj * HALF + n * 16) = bs + gv[bj][n] * acc[ai][bj][m][n]; } }
    }
};

template <class Epi, class Sched, bool ALIGN_EPI = false, bool SP2 = false>
__device__ __forceinline__ void gemm_phase(PG8_LAS unsigned char* lds, const Gemm g, const Sched& S, const Epi& E) {
    const int tid = threadIdx.x, wid = __builtin_amdgcn_readfirstlane(tid >> 6), lane = tid & 63, wr = wid >> 2, wc = wid & 3, fr = lane & 15, fq = lane >> 4;
    const int K = g.K, nt = K / BK;
    unsigned voffA[2], voffB[2];
#pragma unroll
    for (int i = 0; i < 2; ++i) { int R, C; stage_rc(tid * 16 + i * 8192, R, C); const int Rb = Epi::PERM ? ((R & ~31) + perm32(R & 31)) : R;
        voffA[i] = (unsigned)(R * K + C) * 2u; voffB[i] = (unsigned)(Rb * K + C) * 2u; }
    const size_t kstep = (size_t)(BK * 2);
    const size_t hstep = (size_t)HALF * K * 2;
    const size_t tstep = 2 * hstep;
    const unsigned ldsw = (unsigned)wid * 1024u;
    const int aoff = lds_byte(wr * 64 + fr, fq * 8), boff = lds_byte(wc * 32 + fr, fq * 8);
#define PG8_SA(b, h) (((b) * 2 + (h)) * HTB)
#define PG8_SB(b, h) ((4 + (b) * 2 + (h)) * HTB)
#define PG8_STAGE(bufoff, gbase, voff) do { _Pragma("unroll") for (int _i = 0; _i < 2; ++_i) \
        __builtin_amdgcn_global_load_lds((const unsigned*)((const char*)(gbase) + (voff)[_i]), (PG8_LAS unsigned*)(lds + (bufoff) + ldsw + _i * 8192), 16, 0, 0); } while (0)
#define PG8_LDA(dst, b, h) do { _Pragma("unroll") for (int m = 0; m < 4; ++m) _Pragma("unroll") for (int k = 0; k < 2; ++k) dst[m][k] = *(const PG8_LAS bf16x8*)(lds + PG8_SA(b, h) + aoff + m * 2048 + k * 1024); } while (0)
#define PG8_LDB(dst, b, h) do { _Pragma("unroll") for (int n = 0; n < 2; ++n) _Pragma("unroll") for (int k = 0; k < 2; ++k) dst[n][k] = *(const PG8_LAS bf16x8*)(lds + PG8_SB(b, h) + boff + n * 2048 + k * 1024); } while (0)
#define PG8_MMA(ai, bj, At, Bt) do { __builtin_amdgcn_s_setprio(1); _Pragma("unroll") for (int m = 0; m < 4; ++m) _Pragma("unroll") for (int n = 0; n < 2; ++n) _Pragma("unroll") for (int k = 0; k < 2; ++k) \
        acc[ai][bj][m][n] = __builtin_amdgcn_mfma_f32_16x16x32_bf16(Bt[n][k], At[m][k], acc[ai][bj][m][n], 0, 0, 0); __builtin_amdgcn_s_setprio(0); } while (0)
#define PG8_WAIT_V(n) asm volatile("s_waitcnt vmcnt(" #n ")" ::: "memory")
#define PG8_WAIT_L(n) asm volatile("s_waitcnt lgkmcnt(" #n ")" ::: "memory")
#define PG8_BAR __builtin_amdgcn_s_barrier()
#define PG8_SCHED __builtin_amdgcn_sched_barrier(0)
    Unit cur, nxt; int ui = 0;
    if (!S.next(0, cur)) return;
    f32x4 acc[2][2][4][2];
#pragma unroll
    for (int a = 0; a < 2; ++a)
#pragma unroll
        for (int b = 0; b < 2; ++b)
#pragma unroll
            for (int m = 0; m < 4; ++m)
#pragma unroll
                for (int n = 0; n < 2; ++n) acc[a][b][m][n] = (f32x4){0.f, 0.f, 0.f, 0.f};
    bf16x8 At[4][2], B0[2][2], B1[2][2];
    const char* cA = (const char*)g.A + (size_t)cur.pm * tstep; const char* cB = (const char*)g.Bt + (size_t)cur.pn * tstep;
    S.a_ready(cur);
    if constexpr (SP2) {
        PG8_STAGE(PG8_SB(0, 0), cB, voffB); PG8_STAGE(PG8_SB(0, 1), cB + hstep, voffB); PG8_STAGE(PG8_SA(0, 0), cA, voffA); PG8_STAGE(PG8_SA(0, 1), cA + hstep, voffA);
        if (wr == 1) PG8_BAR;
        PG8_WAIT_V(2); PG8_BAR;
        PG8_STAGE(PG8_SB(1, 0), cB + kstep, voffB); PG8_STAGE(PG8_SA(1, 0), cA + kstep, voffA); PG8_STAGE(PG8_SB(1, 1), cB + hstep + kstep, voffB);
        PG8_WAIT_V(6); PG8_BAR;
    } else {
        PG8_STAGE(PG8_SB(0, 0), cB, voffB); PG8_STAGE(PG8_SA(0, 0), cA, voffA); PG8_STAGE(PG8_SB(0, 1), cB + hstep, voffB); PG8_STAGE(PG8_SA(0, 1), cA + hstep, voffA);
        if (wr == 1) PG8_BAR;
        PG8_WAIT_V(4); PG8_BAR;
        PG8_STAGE(PG8_SB(1, 0), cB + kstep, voffB); PG8_STAGE(PG8_SA(1, 0), cA + kstep, voffA); PG8_STAGE(PG8_SB(1, 1), cB + hstep + kstep, voffB);
        PG8_WAIT_V(6); PG8_BAR;
    }
    for (;;) {
        const bool has_next = S.next(ui + 1, nxt);
        const char* nA = has_next ? (const char*)g.A + (size_t)nxt.pm * tstep : cA; const char* nB = has_next ? (const char*)g.Bt + (size_t)nxt.pn * tstep : cB;
        for (int t = 0; t < nt; t += 2) {
            const bool last = (t == nt - 2);
            const char* a1 = cA + (size_t)(t + 1) * kstep;
            const char* a2 = last ? nA : cA + (size_t)(t + 2) * kstep; const char* b2 = last ? nB : cB + (size_t)(t + 2) * kstep;
            const char* a3 = a2 + kstep; const char* b3 = b2 + kstep;
            if (last && has_next) S.a_ready(nxt);
            if constexpr (SP2) {
            PG8_LDB(B0, 0, 0); PG8_LDB(B1, 0, 1); PG8_SCHED; PG8_LDA(At, 0, 0); PG8_STAGE(PG8_SA(1, 1), a1 + hstep, voffA);
            PG8_WAIT_V(8); PG8_WAIT_L(0); PG8_BAR; PG8_MMA(0, 0, At, B0); PG8_MMA(0, 1, At, B1); PG8_BAR; PG8_SCHED;
            PG8_LDA(At, 0, 1); PG8_STAGE(PG8_SB(0, 0), b2, voffB); PG8_STAGE(PG8_SB(0, 1), b2 + hstep, voffB); PG8_STAGE(PG8_SA(0, 0), a2, voffA);
            PG8_WAIT_V(8); PG8_WAIT_L(0); PG8_BAR; PG8_MMA(1, 0, At, B0); PG8_MMA(1, 1, At, B1); PG8_BAR; PG8_SCHED;
            PG8_LDB(B0, 1, 0); PG8_LDB(B1, 1, 1); PG8_SCHED; PG8_LDA(At, 1, 0); PG8_STAGE(PG8_SA(0, 1), a2 + hstep, voffA);
            PG8_WAIT_V(8); PG8_WAIT_L(0); PG8_BAR; PG8_MMA(0, 0, At, B0); PG8_MMA(0, 1, At, B1); PG8_BAR; PG8_SCHED;
            PG8_LDA(At, 1, 1); PG8_STAGE(PG8_SB(1, 0), b3, voffB); PG8_STAGE(PG8_SB(1, 1), b3 + hstep, voffB); PG8_STAGE(PG8_SA(1, 0), a3, voffA);
            PG8_WAIT_V(8); PG8_WAIT_L(0); PG8_BAR; PG8_MMA(1, 0, At, B0); PG8_MMA(1, 1, At, B1); PG8_BAR; PG8_SCHED;
            } else {
            PG8_LDB(B0, 0, 0); PG8_SCHED; PG8_LDA(At, 0, 0); PG8_STAGE(PG8_SA(1, 1), a1 + hstep, voffA);
            PG8_WAIT_L(8); PG8_BAR; PG8_WAIT_L(0); PG8_MMA(0, 0, At, B0); PG8_BAR; PG8_SCHED;
            PG8_LDB(B1, 0, 1); PG8_STAGE(PG8_SB(0, 0), b2, voffB);
            PG8_BAR; PG8_WAIT_L(0); PG8_MMA(0, 1, At, B1); PG8_BAR;
            PG8_LDA(At, 0, 1); PG8_STAGE(PG8_SA(0, 0), a2, voffA);
            PG8_BAR; PG8_WAIT_L(0); PG8_MMA(1, 0, At, B0); PG8_BAR; PG8_SCHED;
            PG8_STAGE(PG8_SB(0, 1), b2 + hstep, voffB);
            PG8_WAIT_V(6); PG8_BAR; PG8_MMA(1, 1, At, B1); PG8_BAR;
            PG8_LDB(B0, 1, 0); PG8_SCHED; PG8_LDA(At, 1, 0); PG8_STAGE(PG8_SA(0, 1), a2 + hstep, voffA);
            PG8_WAIT_L(8); PG8_BAR; PG8_WAIT_L(0); PG8_MMA(0, 0, At, B0); PG8_BAR; PG8_SCHED;
            PG8_LDB(B1, 1, 1); PG8_STAGE(PG8_SB(1, 0), b3, voffB);
            PG8_BAR; PG8_WAIT_L(0); PG8_MMA(0, 1, At, B1); PG8_BAR;
            PG8_LDA(At, 1, 1); PG8_STAGE(PG8_SA(1, 0), a3, voffA);
            PG8_BAR; PG8_WAIT_L(0); PG8_MMA(1, 0, At, B0); PG8_BAR; PG8_SCHED;
            PG8_STAGE(PG8_SB(1, 1), b3 + hstep, voffB);
            PG8_WAIT_V(6); PG8_BAR; PG8_MMA(1, 1, At, B1); PG8_BAR;
            }
        }
        if constexpr (ALIGN_EPI) { if (wr == 0) PG8_BAR; }
        if constexpr (!Epi::AFTER_DRAIN) { E(acc, cur, wr, wc, fr, fq); S.done(cur); }
        if (!has_next) break;
#pragma unroll
        for (int a = 0; a < 2; ++a)
#pragma unroll
            for (int b = 0; b < 2; ++b)
#pragma unroll
                for (int m = 0; m < 4; ++m)
#pragma unroll
                    for (int n = 0; n < 2; ++n) acc[a][b][m][n] = (f32x4){0.f, 0.f, 0.f, 0.f};
        cur = nxt; cA = nA; cB = nB; ++ui;
        if constexpr (ALIGN_EPI) { if (wr == 1) PG8_BAR; }
    }
    PG8_WAIT_V(0);
    if constexpr (!ALIGN_EPI) { if (wr == 0) PG8_BAR; }
    PG8_BAR;
    if constexpr (Epi::AFTER_DRAIN) { E.fused(acc, cur, wr, wc, fr, fq, lds, wid, lane); S.done(cur); }
#undef PG8_SA
#undef PG8_SB
#undef PG8_STAGE
#undef PG8_LDA
#undef PG8_LDB
#undef PG8_MMA
#undef PG8_WAIT_V
#undef PG8_WAIT_L
#undef PG8_BAR
#undef PG8_SCHED
}
}
constexpr int NWAVES = 8;
constexpr int BATCH = 4, T = 4096, D = 1024, M = BATCH * T;
constexpr int PROJ_W = 2832, NP = 2816, FF = 2816, NGU = 2 * FF, HD = 64;
constexpr int C_GQ = 0, C_GK = 512, C_GV = 1024, C_GZ = 1536, C_SQ = 2048, C_SK = 2560, C_SV = 2688;
constexpr float EPS = 1e-6f;
constexpr size_t MiB = 1u << 20;
constexpr size_t WS_CTL = 0, CTL_ZERO_BYTES = 1 * MiB;
constexpr size_t WS_MODF = 1 * MiB;
constexpr size_t WS_WAB = 1 * MiB + 256 * 1024;
constexpr size_t WS_GB = 2 * MiB;
constexpr size_t WS_WIN = 4 * MiB, WS_WOUT = 10 * MiB, WS_WGU = 12 * MiB, WS_WDN = 24 * MiB;
constexpr size_t WS_H = 32 * MiB;
constexpr size_t WS_PQ = 64 * MiB;
constexpr size_t WS_MIX = 160 * MiB;
constexpr size_t WS_END = 192 * MiB;
constexpr int CW_BAR = 4096;
constexpr int CW_MODACC = 16384;
constexpr int RING_OFF = 0, RING_BYTES = 131072;
constexpr int LDSCTL_OFF = RING_BYTES, MISC_OFF = LDSCTL_OFF + 320;
constexpr int LDS_BYTES = 147456;
#define GAS __attribute__((address_space(1)))
#define LAS __attribute__((address_space(3)))
typedef unsigned short bf16;
typedef unsigned v4u __attribute__((ext_vector_type(4)));
typedef float f32x4 __attribute__((ext_vector_type(4)));
typedef short bf16x8 __attribute__((ext_vector_type(8)));
typedef GAS unsigned gu32;
typedef GAS unsigned long long gu64;
#define RLX_AGENT __ATOMIC_RELAXED, __HIP_MEMORY_SCOPE_AGENT
#define LDS_WAIT() asm volatile("s_waitcnt lgkmcnt(0)" ::: "memory")
#define VM_WAIT() asm volatile("s_waitcnt vmcnt(0)" ::: "memory")
__device__ __forceinline__ unsigned long long rt() { return __builtin_amdgcn_s_memrealtime(); }
__device__ __forceinline__ unsigned f2bf(float f) { unsigned u = __builtin_bit_cast(unsigned, f); return (u + 0x7fffu + ((u >> 16) & 1u)) >> 16; }
__device__ __forceinline__ unsigned pk2(float lo, float hi) { return f2bf(lo) | (f2bf(hi) << 16); }

#define XB_TMO      128
#define XB_XCNT(j)  (256  + 64 * (j))
#define XB_XSUB(j)  (1280 + 64 * (j))
#define XB_XGEN(j)  (2304 + 64 * (j))
#define XB_TOP      3328
#define XB_TOPGEN   3392
#define XCD_BAR_WORDS 3456
#define XB_SPIN_CAP (1u << 22)

__device__ __forceinline__ unsigned xb_ld(unsigned* p)              { return __hip_atomic_load(p, __ATOMIC_RELAXED, __HIP_MEMORY_SCOPE_AGENT); }
__device__ __forceinline__ unsigned xb_add(unsigned* p, unsigned v) { return __hip_atomic_fetch_add(p, v, __ATOMIC_RELAXED, __HIP_MEMORY_SCOPE_AGENT); }
__device__ __forceinline__ unsigned xb_xcc_id() { return (unsigned)__builtin_amdgcn_s_getreg((3 << 11) | 20) & 0xFu; }
#define XB_SPIN(cond, bar) do { unsigned _sp = 0; while (cond) { __builtin_amdgcn_s_sleep(1); \
    if ((++_sp & 255u) == 0u) { if (xb_ld(&(bar)[XB_TMO])) break; if (_sp > XB_SPIN_CAP) { atomicAdd(&(bar)[XB_TMO], 1u); break; } } } } while (0)

struct XcdBarrier {
    unsigned* bar; unsigned x;
    volatile LAS unsigned* st;
};

__device__ __forceinline__ XcdBarrier xcd_barrier_post(unsigned* bar, volatile LAS unsigned* st) {
    XcdBarrier b; b.bar = bar; b.x = xb_xcc_id(); b.st = st;
    if (threadIdx.x == 0) (void)xb_add(&bar[XB_XCNT(b.x)], 1u);
    return b;
}
__device__ __forceinline__ void xcd_barrier_complete(unsigned* bar, unsigned x, unsigned& nloc, unsigned& nx) {
    const unsigned G = gridDim.x * gridDim.y * gridDim.z;
    unsigned sum, cnt, mine, sp = 0u;
    for (;;) {
        sum = 0u; cnt = 0u; mine = 0u;
#pragma unroll
        for (unsigned j = 0; j < 16; ++j) { const unsigned c = xb_ld(&bar[XB_XCNT(j)]); sum += c; cnt += (c > 0u) ? 1u : 0u; mine = (j == x) ? c : mine; }
        if (sum == G) break;
        __builtin_amdgcn_s_sleep(1);
        if ((++sp & 255u) == 0u) { if (xb_ld(&bar[XB_TMO])) break; if (sp > XB_SPIN_CAP) { atomicAdd(&bar[XB_TMO], 1u); break; } }
    }
    nloc = mine > 0u ? mine : 1u; nx = cnt > 0u ? cnt : 1u;
}

__device__ __forceinline__ void xcd_barrier(const XcdBarrier& b) {
    asm volatile("s_waitcnt vmcnt(0)" ::: "memory");
    __syncthreads();
    if (threadIdx.x == 0) {
        unsigned* bar = b.bar;
        __builtin_amdgcn_s_waitcnt(0);
        unsigned nloc = b.st[0], nx = b.st[1];
        if (nloc == 0u) { xcd_barrier_complete(bar, b.x, nloc, nx); b.st[0] = nloc; b.st[1] = nx; }
        const unsigned old = xb_add(&bar[XB_XSUB(b.x)], 1u);
        const unsigned gen = old / nloc;
        if (old + 1u == (gen + 1u) * nloc) {
            __builtin_amdgcn_fence(__ATOMIC_RELEASE, "agent");
            asm volatile("s_waitcnt vmcnt(0)" ::: "memory");
            const unsigned og = xb_add(&bar[XB_TOP], 1u);
            const unsigned tg = og / nx;
            if (og + 1u == (tg + 1u) * nx) xb_add(&bar[XB_TOPGEN], 1u);
            else XB_SPIN(xb_ld(&bar[XB_TOPGEN]) == tg, bar);
            __builtin_amdgcn_fence(__ATOMIC_ACQUIRE, "agent");
            xb_add(&bar[XB_XGEN(b.x)], 1u);
            asm volatile("s_waitcnt vmcnt(0)" ::: "memory");
        } else {
            XB_SPIN(xb_ld(&bar[XB_XGEN(b.x)]) == gen, bar);
            __builtin_amdgcn_fence(__ATOMIC_ACQUIRE, "agent");
            asm volatile("s_waitcnt vmcnt(0)" ::: "memory");
        }
    }
    __syncthreads();
}
struct Frame {
    LAS unsigned char* lds;
    volatile LAS unsigned* MISC;
    gu32* ctl;
    int tid, lane, wave;
    int vcu, G;
    const float *x, *c, *w_ada, *b_ada, *norm1_w, *w_in, *conv_w, *a_log, *dt_bias, *gdn_norm_w, *q_norm_w, *k_norm_w, *sinks, *w_out, *norm2_w, *w_gate, *w_up, *w_down;
    float* out;
    float *modacc, *modf, *wab, *gb;
    bf16 *Win_t, *Wout_t, *Wgu_t, *Wdn_t, *H, *PQ, *MIX;
};
__device__ __forceinline__ float wave_sum(float v) {
#pragma unroll
    for (int o = 1; o < 64; o <<= 1) v += __shfl_xor(v, o);
    return v;
}
__device__ __forceinline__ float wave_max(float v) {
#pragma unroll
    for (int o = 1; o < 64; o <<= 1) v = fmaxf(v, __shfl_xor(v, o));
    return v;
}
__device__ __forceinline__ float bf2f(bf16 h) { return __uint_as_float((unsigned)h << 16); }
__device__ __forceinline__ float ld_f32_coh(const float* p) { return __uint_as_float(__hip_atomic_load((const unsigned*)p, RLX_AGENT)); }
__device__ __forceinline__ float silu(float x) { return x / (1.0f + __expf(-x)); }

__device__ __forceinline__ void tr_item(const float* W, int ldw, int src_col, bf16* WT, int K, int dst_row, int k0, LAS float* scr, int lane) {
#pragma unroll 8
    for (int i = 0; i < 32; ++i) { const int kk = 2 * i + (lane >> 5); scr[kk * 33 + (lane & 31)] = W[(size_t)(k0 + kk) * ldw + src_col + (lane & 31)]; }
    LDS_WAIT(); asm volatile("" ::: "memory");
    const int c = lane & 7;
#pragma unroll
    for (int j = 0; j < 4; ++j) { const int n = (lane >> 3) + 8 * j; const LAS float* s = scr + (8 * c) * 33 + n;
        v4u o; o.x = pk2(s[0 * 33], s[1 * 33]); o.y = pk2(s[2 * 33], s[3 * 33]); o.z = pk2(s[4 * 33], s[5 * 33]); o.w = pk2(s[6 * 33], s[7 * 33]);
        *(GAS v4u*)(WT + (size_t)(dst_row + n) * K + k0 + 8 * c) = o; }
    LDS_WAIT(); asm volatile("" ::: "memory");
}

__device__ __forceinline__ void p0_prologue(Frame& F) {
    LAS float* scr = (LAS float*)(F.lds + RING_OFF + F.wave * 16384);
    const int gw = F.vcu * NWAVES + F.wave, NGW = F.G * NWAVES, lane = F.lane;
    constexpr int I_ADA = 24 * 16, I_AB = 16, I_IN = 16 * (NP / 32), I_OUT = 16 * 32, I_GU = 16 * (NGU / 32), I_DN = (FF / 64) * 32;
    constexpr int NITEMS = I_ADA + I_AB + I_IN + I_OUT + I_GU + I_DN;
    for (int it = gw; it < NITEMS; it += NGW) {
        int r = it;
        if (r < I_ADA) {
            const int ct = r % 24, ks = r / 24, col = ct * 256 + lane, k0 = ks * 64;
            float acc[4][4];
#pragma unroll
            for (int j = 0; j < 4; ++j)
#pragma unroll
                for (int b = 0; b < 4; ++b) acc[j][b] = 0.f;
#pragma unroll 4
            for (int kk = 0; kk < 64; ++kk) { const int k = k0 + kk; float cb[4];
#pragma unroll
                for (int b = 0; b < 4; ++b) cb[b] = silu(F.c[b * D + k]);
#pragma unroll
                for (int j = 0; j < 4; ++j) { const float w = F.w_ada[(size_t)k * (6 * D) + col + 64 * j];
#pragma unroll
                    for (int b = 0; b < 4; ++b) acc[j][b] += cb[b] * w; } }
#pragma unroll
            for (int j = 0; j < 4; ++j)
#pragma unroll
                for (int b = 0; b < 4; ++b) atomicAdd(F.modacc + b * (6 * D) + col + 64 * j, acc[j][b]);
            continue;
        }
        r -= I_ADA;
        if (r < I_AB) {
            for (int i = 0; i < 16; ++i) { const int k = i * 64 + lane; F.wab[r * D + k] = F.w_in[(size_t)k * PROJ_W + 2048 + r]; }
            continue;
        }
        r -= I_AB;
        if (r < I_IN) { const int nb = r % (NP / 32), kb = r / (NP / 32), n0 = 32 * nb; tr_item(F.w_in, PROJ_W, n0 < 2048 ? n0 : n0 + 16, F.Win_t, D, n0, 64 * kb, scr, lane); continue; }
        r -= I_IN;
        if (r < I_OUT) { const int nb = r % 32, kb = r / 32; tr_item(F.w_out, D, 32 * nb, F.Wout_t, D, 32 * nb, 64 * kb, scr, lane); continue; }
        r -= I_OUT;
        if (r < I_GU) { const int nb = r % (NGU / 32), kb = r / (NGU / 32), n0 = 32 * nb, p = n0 >> 8, j = n0 & 255;
            if (j < 128) tr_item(F.w_gate, FF, 128 * p + j, F.Wgu_t, D, n0, 64 * kb, scr, lane);
            else         tr_item(F.w_up,   FF, 128 * p + j - 128, F.Wgu_t, D, n0, 64 * kb, scr, lane);
            continue; }
        r -= I_GU;
        { const int nb = r % 32, kb = r / 32; tr_item(F.w_down, D, 32 * nb, F.Wdn_t, FF, 32 * nb, 64 * kb, scr, lane); }
    }
}

template <int WHICH> __device__ __forceinline__ void norm_phase(Frame& F) {
    const int gw = F.vcu * NWAVES + F.wave, NGW = F.G * NWAVES, lane = F.lane;
    if (WHICH == 1) {
        for (int idx = gw * 64 + lane; idx < 4 * 6 * D; idx += NGW * 64) F.modf[idx] = ld_f32_coh(F.modacc + idx) + F.b_ada[idx % (6 * D)];
    }
    const float* src = (WHICH == 1) ? F.x : F.out;
    const float* nw = (WHICH == 1) ? F.norm1_w : F.norm2_w;
    for (int m0 = gw * 4; m0 < M; m0 += NGW * 4) {
        const int b = m0 / T;
        float gm[16], sh[16];
#pragma unroll
        for (int i = 0; i < 4; ++i)
#pragma unroll
            for (int e = 0; e < 4; ++e) { const int c = 256 * i + 4 * lane + e; float sc, sf;
                if (WHICH == 1) { sf = ld_f32_coh(F.modacc + b * 6 * D + c) + F.b_ada[c]; sc = ld_f32_coh(F.modacc + b * 6 * D + D + c) + F.b_ada[D + c]; }
                else { sf = F.modf[b * 6 * D + 3 * D + c]; sc = F.modf[b * 6 * D + 4 * D + c]; }
                gm[4 * i + e] = nw[c] * (1.0f + sc); sh[4 * i + e] = sf; }
        float h[4][16];
#pragma unroll
        for (int r = 0; r < 4; ++r) {
            const GAS f32x4* xr = (const GAS f32x4*)(src + (size_t)(m0 + r) * D) + lane;
            f32x4 v[4]; float ss = 0.f;
#pragma unroll
            for (int i = 0; i < 4; ++i) { v[i] = xr[64 * i]; ss += (v[i].x * v[i].x + v[i].y * v[i].y) + (v[i].z * v[i].z + v[i].w * v[i].w); }
            const float rstd = 1.0f / sqrtf(wave_sum(ss) * (1.0f / D) + EPS);
            GAS unsigned long long* o8 = (GAS unsigned long long*)(F.H + (size_t)(m0 + r) * D) + lane;
#pragma unroll
            for (int i = 0; i < 4; ++i) {
                const float a0 = v[i].x * rstd * gm[4 * i + 0] + sh[4 * i + 0], a1 = v[i].y * rstd * gm[4 * i + 1] + sh[4 * i + 1];
                const float a2 = v[i].z * rstd * gm[4 * i + 2] + sh[4 * i + 2], a3 = v[i].w * rstd * gm[4 * i + 3] + sh[4 * i + 3];
                h[r][4 * i + 0] = a0; h[r][4 * i + 1] = a1; h[r][4 * i + 2] = a2; h[r][4 * i + 3] = a3;
                o8[64 * i] = (unsigned long long)pk2(a0, a1) | ((unsigned long long)pk2(a2, a3) << 32); }
        }
        if (WHICH == 1) {
            float myv = 0.f;
            for (int j = 0; j < 16; ++j) {
                const GAS f32x4* wp = (const GAS f32x4*)(F.wab + j * D) + lane;
                f32x4 wv[4];
#pragma unroll
                for (int i = 0; i < 4; ++i) wv[i] = wp[64 * i];
#pragma unroll
                for (int r = 0; r < 4; ++r) { float p = 0.f;
#pragma unroll
                    for (int i = 0; i < 4; ++i) p += (h[r][4 * i] * wv[i].x + h[r][4 * i + 1] * wv[i].y) + (h[r][4 * i + 2] * wv[i].z + h[r][4 * i + 3] * wv[i].w);
                    p = wave_sum(p);
                    if (lane == r * 16 + j) myv = p; }
            }
            const int j = lane & 15, hh = j & 7;
            float val;
            if (j < 8) { const float xx = myv + F.dt_bias[hh]; const float sp = fmaxf(xx, 0.f) + log1pf(__expf(-fabsf(xx))); val = -__expf(F.a_log[hh]) * sp; }
            else val = 1.0f / (1.0f + __expf(-myv));
            F.gb[(size_t)m0 * 16 + lane] = val;
        }
    }
}

__device__ __forceinline__ void gdn_wave(Frame& F, int bh, LAS float* scr) {
    const int lane = F.lane, b = bh >> 3, hh = bh & 7;
    float S[64];
#pragma unroll
    for (int d = 0; d < 64; ++d) S[d] = 0.f;
    float wq[4], wk[4], wv[4];
#pragma unroll
    for (int j = 0; j < 4; ++j) { wq[j] = F.conv_w[j * 1536 + hh * 64 + lane]; wk[j] = F.conv_w[j * 1536 + 512 + hh * 64 + lane]; wv[j] = F.conv_w[j * 1536 + 1024 + hh * 64 + lane]; }
    const float nwg = F.gdn_norm_w[lane];
    float xq0 = 0.f, xq1 = 0.f, xq2 = 0.f, xk0 = 0.f, xk1 = 0.f, xk2 = 0.f, xv0 = 0.f, xv1 = 0.f, xv2 = 0.f;
    const size_t row0 = (size_t)b * T;
    const bf16* pq = F.PQ + row0 * NP + hh * 64 + lane;
    bf16 nq = pq[C_GQ], nk = pq[C_GK], nv = pq[C_GV], nz = pq[C_GZ];
    float ng = ld_f32_coh(F.gb + row0 * 16 + hh), nb = ld_f32_coh(F.gb + row0 * 16 + 8 + hh);
    for (int t = 0; t < T; ++t) {
        const float rq = bf2f(nq), rk = bf2f(nk), rv = bf2f(nv), rz = bf2f(nz), g = ng, beta = nb;
        if (t + 1 < T) { const bf16* p2 = pq + (size_t)(t + 1) * NP; nq = p2[C_GQ]; nk = p2[C_GK]; nv = p2[C_GV]; nz = p2[C_GZ];
            ng = ld_f32_coh(F.gb + (row0 + t + 1) * 16 + hh); nb = ld_f32_coh(F.gb + (row0 + t + 1) * 16 + 8 + hh); }
        float cq = wq[0] * xq0 + wq[1] * xq1 + wq[2] * xq2 + wq[3] * rq;
        float ck = wk[0] * xk0 + wk[1] * xk1 + wk[2] * xk2 + wk[3] * rk;
        float cv = wv[0] * xv0 + wv[1] * xv1 + wv[2] * xv2 + wv[3] * rv;
        xq0 = xq1; xq1 = xq2; xq2 = rq; xk0 = xk1; xk1 = xk2; xk2 = rk; xv0 = xv1; xv1 = xv2; xv2 = rv;
        cq = silu(cq); ck = silu(ck); cv = silu(cv);
        const float qn = cq / sqrtf(wave_sum(cq * cq) + EPS), kn = ck / sqrtf(wave_sum(ck * ck) + EPS);
        scr[lane] = kn; scr[64 + lane] = qn;
        LDS_WAIT(); asm volatile("" ::: "memory");
        const float a = __expf(g);
        float kd = 0.f;
#pragma unroll
        for (int d4 = 0; d4 < 16; ++d4) { const f32x4 kv = *(const LAS f32x4*)(scr + 4 * d4);
            kd += kv.x * S[4 * d4]; kd += kv.y * S[4 * d4 + 1]; kd += kv.z * S[4 * d4 + 2]; kd += kv.w * S[4 * d4 + 3]; }
        const float cc = beta * (cv - a * kd);
        float o = 0.f;
#pragma unroll
        for (int d4 = 0; d4 < 16; ++d4) { const f32x4 kv = *(const LAS f32x4*)(scr + 4 * d4); const f32x4 qv = *(const LAS f32x4*)(scr + 64 + 4 * d4);
            S[4 * d4] = a * S[4 * d4] + cc * kv.x; o += qv.x * S[4 * d4];
            S[4 * d4 + 1] = a * S[4 * d4 + 1] + cc * kv.y; o += qv.y * S[4 * d4 + 1];
            S[4 * d4 + 2] = a * S[4 * d4 + 2] + cc * kv.z; o += qv.z * S[4 * d4 + 2];
            S[4 * d4 + 3] = a * S[4 * d4 + 3] + cc * kv.w; o += qv.w * S[4 * d4 + 3]; }
        LDS_WAIT(); asm volatile("" ::: "memory");
        o *= 0.125f;
        const float on = o / sqrtf(wave_sum(o * o) * (1.0f / 64.0f) + EPS) * nwg * silu(rz);
        F.MIX[(row0 + t) * D + hh * 64 + lane] = (bf16)f2bf(on);
    }
}
__device__ __forceinline__ void swa_query(Frame& F, int item, LAS float* scr) {
    const int lane = F.lane, t = item & (T - 1), hq = (item >> 12) & 7, b = item >> 15, kvh = hq >> 2;
    const size_t row0 = (size_t)b * T;
    const float qraw = bf2f(F.PQ[(row0 + t) * NP + C_SQ + hq * 64 + lane]);
    const float qn = qraw / sqrtf(wave_sum(qraw * qraw) * (1.0f / 64.0f) + EPS) * F.q_norm_w[lane];
    scr[lane] = qn * F.k_norm_w[lane];
    LDS_WAIT(); asm volatile("" ::: "memory");
    const float slope = exp2f(-(float)(hq + 1)), sink = F.sinks[hq];
    float sc[2];
#pragma unroll
    for (int jj = 0; jj < 2; ++jj) {
        const int s = t - 127 + lane + 64 * jj;
        float v = -INFINITY;
        if (s >= 0) {
            const GAS v4u* kp = (const GAS v4u*)(F.PQ + (row0 + s) * NP + C_SK + kvh * 64);
            float dot = 0.f, ssk = 0.f;
#pragma unroll
            for (int c8 = 0; c8 < 8; ++c8) { const v4u kk = kp[c8]; const unsigned wds[4] = {kk.x, kk.y, kk.z, kk.w};
#pragma unroll
                for (int w = 0; w < 4; ++w) { const float k0 = __uint_as_float(wds[w] << 16), k1 = __uint_as_float(wds[w] & 0xffff0000u);
                    const float q0 = scr[c8 * 8 + 2 * w], q1 = scr[c8 * 8 + 2 * w + 1];
                    dot += q0 * k0 + q1 * k1; ssk += k0 * k0 + k1 * k1; } }
            v = dot / sqrtf(ssk * (1.0f / 64.0f) + EPS) * 0.125f - slope * (float)(t - s);
        }
        sc[jj] = v;
    }
    const float mx = fmaxf(wave_max(fmaxf(sc[0], sc[1])), sink);
    const float p0 = __expf(sc[0] - mx), p1 = __expf(sc[1] - mx);
    const float den = wave_sum(p0 + p1) + __expf(sink - mx);
    LDS_WAIT(); asm volatile("" ::: "memory");
    scr[64 + lane] = p0; scr[128 + lane] = p1;
    LDS_WAIT(); asm volatile("" ::: "memory");
    float o = 0.f;
    const int s0 = t - 127;
    const bf16* vp = F.PQ + row0 * NP + C_SV + kvh * 64 + lane;
    for (int j = (s0 < 0 ? -s0 : 0); j < 128; ++j) o += scr[64 + j] * bf2f(vp[(size_t)(s0 + j) * NP]);
    LDS_WAIT(); asm volatile("" ::: "memory");
    F.MIX[(row0 + t) * D + 512 + hq * 64 + lane] = (bf16)f2bf(o / den);
}
__device__ __forceinline__ void p3_mixers(Frame& F) {
    LAS float* scr = (LAS float*)(F.lds + RING_OFF + F.wave * 1024);
    const int bx = blockIdx.x;
    if (bx < 32 && F.wave == 0) { gdn_wave(F, bx, scr); return; }
    const int id = (bx < 32) ? bx * 7 + (F.wave - 1) : 224 + (bx - 32) * 8 + F.wave;
    const int nworkers = 224 + (F.G - 32) * 8;
    for (int it = id; it < BATCH * 8 * T; it += nworkers) swa_query(F, it, scr);
}

struct Args { const float* in[18]; float* out; unsigned char* ws; };
__global__ void __launch_bounds__(NWAVES * 64, 2) hymba_fwd(Args args) {
    extern __shared__ __attribute__((aligned(16))) unsigned char lds[];
    Frame F;
    F.lds = (LAS unsigned char*)lds;
    F.MISC = (volatile LAS unsigned*)(F.lds + MISC_OFF);
    F.tid = threadIdx.x; F.lane = F.tid & 63; F.wave = __builtin_amdgcn_readfirstlane(F.tid >> 6);
    F.G = gridDim.x; { const int bx = blockIdx.x; F.vcu = (F.G % 8 == 0) ? (bx % 8) * (F.G / 8) + bx / 8 : bx; }
    unsigned char* ws = args.ws;
    F.ctl = (gu32*)(ws + WS_CTL);
    F.x = args.in[0]; F.c = args.in[1]; F.w_ada = args.in[2]; F.b_ada = args.in[3]; F.norm1_w = args.in[4]; F.w_in = args.in[5]; F.conv_w = args.in[6];
    F.a_log = args.in[7]; F.dt_bias = args.in[8]; F.gdn_norm_w = args.in[9]; F.q_norm_w = args.in[10]; F.k_norm_w = args.in[11]; F.sinks = args.in[12];
    F.w_out = args.in[13]; F.norm2_w = args.in[14]; F.w_gate = args.in[15]; F.w_up = args.in[16]; F.w_down = args.in[17]; F.out = args.out;
    F.modacc = (float*)(ws + WS_CTL) + CW_MODACC; F.modf = (float*)(ws + WS_MODF); F.wab = (float*)(ws + WS_WAB); F.gb = (float*)(ws + WS_GB);
    F.Win_t = (bf16*)(ws + WS_WIN); F.Wout_t = (bf16*)(ws + WS_WOUT); F.Wgu_t = (bf16*)(ws + WS_WGU); F.Wdn_t = (bf16*)(ws + WS_WDN);
    F.H = (bf16*)(ws + WS_H); F.PQ = (bf16*)(ws + WS_PQ); F.MIX = (bf16*)(ws + WS_MIX);
    for (int u = F.tid; u < (LDS_BYTES - LDSCTL_OFF) / 4; u += NWAVES * 64) ((LAS unsigned*)(F.lds + LDSCTL_OFF))[u] = 0u;
    __syncthreads();
    XcdBarrier bar = xcd_barrier_post((unsigned*)(F.ctl + CW_BAR), F.MISC + 8);
#define GRID_BAR() xcd_barrier(bar)

    p0_prologue(F); GRID_BAR();
    norm_phase<1>(F); GRID_BAR();
    { pg8::Gemm g{F.H, F.Win_t, M, NP, D}; pg8::StaticOrder S; S.init(M, NP, F.G, (int)blockIdx.x);
      pg8::EpiBf16Plain E{F.PQ, NP};
      pg8::gemm_phase<pg8::EpiBf16Plain, pg8::StaticOrder, true, true>(F.lds + RING_OFF, g, S, E); }
    GRID_BAR();
    p3_mixers(F); GRID_BAR();
    { pg8::Gemm g{F.MIX, F.Wout_t, M, D, D}; pg8::StaticOrder S; S.init(M, D, F.G, (int)blockIdx.x);
      pg8::EpiGateRes E{F.x, F.out, D, F.modf + 2 * D, 6 * D, T};
      pg8::gemm_phase<pg8::EpiGateRes, pg8::StaticOrder, true, true>(F.lds + RING_OFF, g, S, E); }
    GRID_BAR();
    norm_phase<2>(F); GRID_BAR();
    { pg8::Gemm g{F.H, F.Wgu_t, M, NGU, D}; pg8::StaticOrder S; S.init(M, NGU, F.G, (int)blockIdx.x);
      pg8::EpiSwiGLU E{F.PQ, FF};
      pg8::gemm_phase<pg8::EpiSwiGLU, pg8::StaticOrder, true, true>(F.lds + RING_OFF, g, S, E); }
    GRID_BAR();
    { pg8::Gemm g{F.PQ, F.Wdn_t, M, D, FF}; pg8::StaticOrder S; S.init(M, D, F.G, (int)blockIdx.x);
      pg8::EpiGateRes E{F.out, F.out, D, F.modf + 5 * D, 6 * D, T};
      pg8::gemm_phase<pg8::EpiGateRes, pg8::StaticOrder, true, true>(F.lds + RING_OFF, g, S, E); }
#undef GRID_BAR
}

extern "C" void kernel_launch(void* const* d_in, const int* in_sizes, int n_in, void* d_out, int out_size, void* d_ws, size_t ws_size, hipStream_t stream) {
    static int grid = 0;
    if (grid == 0) {
        if (n_in != 18 || in_sizes[0] != M * D || out_size != M * D || ws_size < WS_END) { fprintf(stderr, "kernel_launch: unexpected shapes (n_in %d, in0 %d, out %d, ws %zu); nothing launched\n", n_in, n_in > 0 ? in_sizes[0] : -1, out_size, ws_size); grid = -1; return; }
        int dev = 0, cus = 0;
        if (hipGetDevice(&dev) != hipSuccess || hipDeviceGetAttribute(&cus, hipDeviceAttributeMultiprocessorCount, dev) != hipSuccess) { grid = -1; return; }
        if (hipFuncSetAttribute((const void*)hymba_fwd, hipFuncAttributeMaxDynamicSharedMemorySize, LDS_BYTES) != hipSuccess) { fprintf(stderr, "kernel_launch: hipFuncSetAttribute failed\n"); grid = -1; return; }
        (void)hipGetLastError();
        grid = cus;
    }
    if (grid < 0) return;
    if (hipMemsetAsync((char*)d_ws + WS_CTL, 0, CTL_ZERO_BYTES, stream) != hipSuccess) { fprintf(stderr, "kernel_launch: hipMemsetAsync failed\n"); return; }
    Args a{};
    for (int i = 0; i < 18; ++i) a.in[i] = (const float*)d_in[i];
    a.out = (float*)d_out; a.ws = (unsigned char*)d_ws;
    hipLaunchKernelGGL(hymba_fwd, dim3(grid), dim3(NWAVES * 64), LDS_BYTES, stream, a);
    const hipError_t le = hipPeekAtLastError();
    if (le != hipSuccess) fprintf(stderr, "kernel_launch: launch failed: %s\n", hipGetErrorName(le));
}
```

```cpp
#include <hip/hip_runtime.h>
#include <cstdio>
#include <cstdint>
#include <cmath>
namespace pg8 {
#define PG8_LAS __attribute__((address_space(3)))
typedef unsigned short bf16_t;
typedef short bf16x8 __attribute__((ext_vector_type(8)));
typedef float f32x4 __attribute__((ext_vector_type(4)));
typedef unsigned u32x4 __attribute__((ext_vector_type(4)));
constexpr int BM = 256, BK = 64, HALF = 128, HTB = HALF * BK * 2  , STAGE_BYTES = 8 * HTB, NXCD = 8, WGM = 8;

__host__ __device__ __forceinline__ int lds_byte(int r, int c) { const int st = (r >> 4) * 2 + (c >> 5), rr = r & 15, cc = c & 31, ob = rr * 64 + cc * 2; return st * 1024 + (ob ^ (((ob >> 9) & 1) << 5)); }
__host__ __device__ __forceinline__ void stage_rc(int b, int& R, int& C) { const int st = b / 1024, sb = b % 1024, swz = sb ^ (((sb >> 9) & 1) << 5); R = (st >> 1) * 16 + swz / 64; C = (st & 1) * 32 + (swz % 64) / 2; }
__host__ __device__ __forceinline__ int perm32(int rho) { const int n = rho >> 4, i = rho & 15; return 8 * (i >> 2) + 4 * n + (i & 3); }

struct Unit { int pm, pn; };
struct Gemm { const bf16_t* A; const bf16_t* Bt; int M, N, K; };

struct StaticOrder {
    int nM, nN, nwg, G, c;
    __host__ __device__ void init(int M, int N, int G_, int c_) { nM = M / BM; nN = N / BM; nwg = nM * nN; G = G_; c = c_; }
    __host__ __device__ bool next(int i, Unit& u) const {
        const long L = (long)i * G + c; if (L >= nwg) return false;
        int wgid = (int)L; { const int q = nwg / NXCD, r = nwg % NXCD, xcd = wgid % NXCD, off = wgid / NXCD; wgid = (xcd < r ? xcd * (q + 1) : r * (q + 1) + (xcd - r) * q) + off; }
        const int nig = WGM * nN, gid = wgid / nig, fm = gid * WGM, gsz = (nM - fm) < WGM ? (nM - fm) : WGM;
        u.pm = fm + ((wgid % nig) % gsz); u.pn = (wgid % nig) / gsz; return true;
    }
    __device__ __forceinline__ void a_ready(const Unit&) const {}
    __device__ __forceinline__ void done(const Unit&) const {}
};

__device__ __forceinline__ unsigned cvt_pk_bf16(float lo, float hi) { unsigned r; asm volatile("v_cvt_pk_bf16_f32 %0, %1, %2" : "=v"(r) : "v"(lo), "v"(hi)); return r; }
__device__ __forceinline__ float silu_f(float x) { return x * __builtin_amdgcn_rcpf(1.0f + __expf(-x)); }

struct EpiBf16Plain {
    static constexpr bool PERM = true, AFTER_DRAIN = false;
    bf16_t* O; int ldc;
    __device__ __forceinline__ void operator()(const f32x4 (&acc)[2][2][4][2], const Unit& u, int wr, int wc, int fr, int fq) const {
        const int row0 = u.pm * BM + wr * 64 + fr, col0 = u.pn * BM + wc * 32 + 8 * fq;
#pragma unroll
        for (int ai = 0; ai < 2; ++ai)
#pragma unroll
            for (int m = 0; m < 4; ++m) { bf16_t* rowp = O + (size_t)(row0 + ai * HALF + m * 16) * ldc + col0;
#pragma unroll
                for (int bj = 0; bj < 2; ++bj) { const f32x4 v0 = acc[ai][bj][m][0], v1 = acc[ai][bj][m][1];
                    u32x4 w; w.x = cvt_pk_bf16(v0[0], v0[1]); w.y = cvt_pk_bf16(v0[2], v0[3]); w.z = cvt_pk_bf16(v1[0], v1[1]); w.w = cvt_pk_bf16(v1[2], v1[3]);
                    *(u32x4*)(rowp + bj * HALF) = w; } }
    }
};
struct EpiSwiGLU {
    static constexpr bool PERM = true, AFTER_DRAIN = false;
    bf16_t* O; int ldc;
    __device__ __forceinline__ void operator()(const f32x4 (&acc)[2][2][4][2], const Unit& u, int wr, int wc, int fr, int fq) const {
        const int row0 = u.pm * BM + wr * 64 + fr, col0 = u.pn * HALF + wc * 32 + 8 * fq;
#pragma unroll
        for (int ai = 0; ai < 2; ++ai)
#pragma unroll
            for (int m = 0; m < 4; ++m) { bf16_t* rowp = O + (size_t)(row0 + ai * HALF + m * 16) * ldc + col0;
                const f32x4 g0 = acc[ai][0][m][0], g1 = acc[ai][0][m][1], u0 = acc[ai][1][m][0], u1 = acc[ai][1][m][1];
                float a[8];
#pragma unroll
                for (int i = 0; i < 4; ++i) { a[i] = silu_f(g0[i]) * u0[i]; a[4 + i] = silu_f(g1[i]) * u1[i]; }
                u32x4 w; w.x = cvt_pk_bf16(a[0], a[1]); w.y = cvt_pk_bf16(a[2], a[3]); w.z = cvt_pk_bf16(a[4], a[5]); w.w = cvt_pk_bf16(a[6], a[7]);
                *(u32x4*)rowp = w; }
    }
};
struct EpiGateRes {
    static constexpr bool PERM = false, AFTER_DRAIN = false;
    const float* base; float* out; int ldc; const float* gate; int gstride; int rows_per_batch;
    __device__ __forceinline__ void operator()(const f32x4 (&acc)[2][2][4][2], const Unit& u, int wr, int wc, int fr, int fq) const {
        const int row0 = u.pm * BM + wr * 64 + fr, col0 = u.pn * BM + wc * 32 + 4 * fq;
        const float* gp = gate + (size_t)((u.pm * BM) / rows_per_batch) * gstride + col0;
        f32x4 gv[2][2];
#pragma unroll
        for (int bj = 0; bj < 2; ++bj)
#pragma unroll
            for (int n = 0; n < 2; ++n) gv[bj][n] = *(const f32x4*)(gp + bj * HALF + n * 16);
#pragma unroll
        for (int ai = 0; ai < 2; ++ai)
#pragma unroll
            for (int m = 0; m < 4; ++m) { const size_t off = (size_t)(row0 + ai * HALF + m * 16) * ldc + col0;
#pragma unroll
                for (int bj = 0; bj < 2; ++bj)
#pragma unroll
                    for (int n = 0; n < 2; ++n) { const f32x4 bs = *(const f32x4*)(base + off + bj * HALF + n * 16);
                        *(f32x4*)(out + off + bj * HALF + n * 16) = bs + gv[bj][n] * acc[ai][bj][m][n]; } }
    }
};

template <class Epi, class Sched, bool ALIGN_EPI = false, bool SP2 = false>
__device__ __forceinline__ void gemm_phase(PG8_LAS unsigned char* lds, const Gemm g, const Sched& S, const Epi& E) {
    const int tid = threadIdx.x, wid = __builtin_amdgcn_readfirstlane(tid >> 6), lane = tid & 63, wr = wid >> 2, wc = wid & 3, fr = lane & 15, fq = lane >> 4;
    const int K = g.K, nt = K / BK;
    unsigned voffA[2], voffB[2];
#pragma unroll
    for (int i = 0; i < 2; ++i) { int R, C; stage_rc(tid * 16 + i * 8192, R, C); const int Rb = Epi::PERM ? ((R & ~31) + perm32(R & 31)) : R;
        voffA[i] = (unsigned)(R * K + C) * 2u; voffB[i] = (unsigned)(Rb * K + C) * 2u; }
    const size_t kstep = (size_t)(BK * 2);
    const size_t hstep = (size_t)HALF * K * 2;
    const size_t tstep = 2 * hstep;
    const unsigned ldsw = (unsigned)wid * 1024u;
    const int aoff = lds_byte(wr * 64 + fr, fq * 8), boff = lds_byte(wc * 32 + fr, fq * 8);
#define PG8_SA(b, h) (((b) * 2 + (h)) * HTB)
#define PG8_SB(b, h) ((4 + (b) * 2 + (h)) * HTB)
#define PG8_STAGE(bufoff, gbase, voff) do { _Pragma("unroll") for (int _i = 0; _i < 2; ++_i) \
        __builtin_amdgcn_global_load_lds((const unsigned*)((const char*)(gbase) + (voff)[_i]), (PG8_LAS unsigned*)(lds + (bufoff) + ldsw + _i * 8192), 16, 0, 0); } while (0)
#define PG8_LDA(dst, b, h) do { _Pragma("unroll") for (int m = 0; m < 4; ++m) _Pragma("unroll") for (int k = 0; k < 2; ++k) dst[m][k] = *(const PG8_LAS bf16x8*)(lds + PG8_SA(b, h) + aoff + m * 2048 + k * 1024); } while (0)
#define PG8_LDB(dst, b, h) do { _Pragma("unroll") for (int n = 0; n < 2; ++n) _Pragma("unroll") for (int k = 0; k < 2; ++k) dst[n][k] = *(const PG8_LAS bf16x8*)(lds + PG8_SB(b, h) + boff + n * 2048 + k * 1024); } while (0)
#define PG8_MMA(ai, bj, At, Bt) do { __builtin_amdgcn_s_setprio(1); _Pragma("unroll") for (int m = 0; m < 4; ++m) _Pragma("unroll") for (int n = 0; n < 2; ++n) _Pragma("unroll") for (int k = 0; k < 2; ++k) \
        acc[ai][bj][m][n] = __builtin_amdgcn_mfma_f32_16x16x32_bf16(Bt[n][k], At[m][k], acc[ai][bj][m][n], 0, 0, 0); __builtin_amdgcn_s_setprio(0); } while (0)
#define PG8_WAIT_V(n) asm volatile("s_waitcnt vmcnt(" #n ")" ::: "memory")
#define PG8_WAIT_L(n) asm volatile("s_waitcnt lgkmcnt(" #n ")" ::: "memory")
#define PG8_BAR __builtin_amdgcn_s_barrier()
#define PG8_SCHED __builtin_amdgcn_sched_barrier(0)
    Unit cur, nxt; int ui = 0;
    if (!S.next(0, cur)) return;
    f32x4 acc[2][2][4][2];
#pragma unroll
    for (int a = 0; a < 2; ++a)
#pragma unroll
        for (int b = 0; b < 2; ++b)
#pragma unroll
            for (int m = 0; m < 4; ++m)
#pragma unroll
                for (int n = 0; n < 2; ++n) acc[a][b][m][n] = (f32x4){0.f, 0.f, 0.f, 0.f};
    bf16x8 At[4][2], B0[2][2], B1[2][2];
    const char* cA = (const char*)g.A + (size_t)cur.pm * tstep; const char* cB = (const char*)g.Bt + (size_t)cur.pn * tstep;
    S.a_ready(cur);
    if constexpr (SP2) {
        PG8_STAGE(PG8_SB(0, 0), cB, voffB); PG8_STAGE(PG8_SB(0, 1), cB + hstep, voffB); PG8_STAGE(PG8_SA(0, 0), cA, voffA); PG8_STAGE(PG8_SA(0, 1), cA + hstep, voffA);
        if (wr == 1) PG8_BAR;
        PG8_WAIT_V(2); PG8_BAR;
        PG8_STAGE(PG8_SB(1, 0), cB + kstep, voffB); PG8_STAGE(PG8_SA(1, 0), cA + kstep, voffA); PG8_STAGE(PG8_SB(1, 1), cB + hstep + kstep, voffB);
        PG8_WAIT_V(6); PG8_BAR;
    } else {
        PG8_STAGE(PG8_SB(0, 0), cB, voffB); PG8_STAGE(PG8_SA(0, 0), cA, voffA); PG8_STAGE(PG8_SB(0, 1), cB + hstep, voffB); PG8_STAGE(PG8_SA(0, 1), cA + hstep, voffA);
        if (wr == 1) PG8_BAR;
        PG8_WAIT_V(4); PG8_BAR;
        PG8_STAGE(PG8_SB(1, 0), cB + kstep, voffB); PG8_STAGE(PG8_SA(1, 0), cA + kstep, voffA); PG8_STAGE(PG8_SB(1, 1), cB + hstep + kstep, voffB);
        PG8_WAIT_V(6); PG8_BAR;
    }
    for (;;) {
        const bool has_next = S.next(ui + 1, nxt);
        const char* nA = has_next ? (const char*)g.A + (size_t)nxt.pm * tstep : cA; const char* nB = has_next ? (const char*)g.Bt + (size_t)nxt.pn * tstep : cB;
        for (int t = 0; t < nt; t += 2) {
            const bool last = (t == nt - 2);
            const char* a1 = cA + (size_t)(t + 1) * kstep;
            const char* a2 = last ? nA : cA + (size_t)(t + 2) * kstep; const char* b2 = last ? nB : cB + (size_t)(t + 2) * kstep;
            const char* a3 = a2 + kstep; const char* b3 = b2 + kstep;
            if (last && has_next) S.a_ready(nxt);
            if constexpr (SP2) {
            PG8_LDB(B0, 0, 0); PG8_LDB(B1, 0, 1); PG8_SCHED; PG8_LDA(At, 0, 0); PG8_STAGE(PG8_SA(1, 1), a1 + hstep, voffA);
            PG8_WAIT_V(8); PG8_WAIT_L(0); PG8_BAR; PG8_MMA(0, 0, At, B0); PG8_MMA(0, 1, At, B1); PG8_BAR; PG8_SCHED;
            PG8_LDA(At, 0, 1); PG8_STAGE(PG8_SB(0, 0), b2, voffB); PG8_STAGE(PG8_SB(0, 1), b2 + hstep, voffB); PG8_STAGE(PG8_SA(0, 0), a2, voffA);
            PG8_WAIT_V(8); PG8_WAIT_L(0); PG8_BAR; PG8_MMA(1, 0, At, B0); PG8_MMA(1, 1, At, B1); PG8_BAR; PG8_SCHED;
            PG8_LDB(B0, 1, 0); PG8_LDB(B1, 1, 1); PG8_SCHED; PG8_LDA(At, 1, 0); PG8_STAGE(PG8_SA(0, 1), a2 + hstep, voffA);
            PG8_WAIT_V(8); PG8_WAIT_L(0); PG8_BAR; PG8_MMA(0, 0, At, B0); PG8_MMA(0, 1, At, B1); PG8_BAR; PG8_SCHED;
            PG8_LDA(At, 1, 1); PG8_STAGE(PG8_SB(1, 0), b3, voffB); PG8_STAGE(PG8_SB(1, 1), b3 + hstep, voffB); PG8_STAGE(PG8_SA(1, 0), a3, voffA);
            PG8_WAIT_V(8); PG8_WAIT_L(0); PG8_BAR; PG8_MMA(1, 0, At, B0); PG8_MMA(1, 1, At, B1); PG8_BAR; PG8_SCHED;
            } else {
            PG8_LDB(B0, 0, 0); PG8_SCHED; PG8_LDA(At, 0, 0); PG8_STAGE(PG8_SA(1, 1), a1 + hstep, voffA);
            PG8_WAIT_L(8); PG8_BAR; PG8_WAIT_L(0); PG8_MMA(0, 0, At, B0); PG8_BAR; PG8_SCHED;
            PG8_LDB(B1, 0, 1); PG8_STAGE(PG8_SB(0, 0), b2, voffB);
            PG8_BAR; PG8_WAIT_L(0); PG8_MMA(0, 1, At, B1); PG8_BAR;
            PG8_LDA(At, 0, 1); PG8_STAGE(PG8_SA(0, 0), a2, voffA);
            PG8_BAR; PG8_WAIT_L(0); PG8_MMA(1, 0, At, B0); PG8_BAR; PG8_SCHED;
            PG8_STAGE(PG8_SB(0, 1), b2 + hstep, voffB);
            PG8_WAIT_V(6); PG8_BAR; PG8_MMA(1, 1, At, B1); PG8_BAR;
            PG8_LDB(B0, 1, 0); PG8_SCHED; PG8_LDA(At, 1, 0); PG8_STAGE(PG8_SA(0, 1), a2 + hstep, voffA);
            PG8_WAIT_L(8); PG8_BAR; PG8_WAIT_L(0); PG8_MMA(0, 0, At, B0); PG8_BAR; PG8_SCHED;
            PG8_LDB(B1, 1, 1); PG8_STAGE(PG8_SB(1, 0), b3, voffB);
            PG8_BAR; PG8_WAIT_L(0); PG8_MMA(0, 1, At, B1); PG8_BAR;
            PG8_LDA(At, 1, 1); PG8_STAGE(PG8_SA(1, 0), a3, voffA);
            PG8_BAR; PG8_WAIT_L(0); PG8_MMA(1, 0, At, B0); PG8_BAR; PG8_SCHED;
            PG8_STAGE(PG8_SB(1, 1), b3 + hstep, voffB);
            PG8_WAIT_V(6); PG8_BAR; PG8_MMA(1, 1, At, B1); PG8_BAR;
            }
        }
        if constexpr (ALIGN_EPI) { if (wr == 0) PG8_BAR; }
        if constexpr (!Epi::AFTER_DRAIN) { E(acc, cur, wr, wc, fr, fq); S.done(cur); }
        if (!has_next) break;
#pragma unroll
        for (int a = 0; a < 2; ++a)
#pragma unroll
            for (int b = 0; b < 2; ++b)
#pragma unroll
                for (int m = 0; m < 4; ++m)
#pragma unroll
                    for (int n = 0; n < 2; ++n) acc[a][b][m][n] = (f32x4){0.f, 0.f, 0.f, 0.f};
        cur = nxt; cA = nA; cB = nB; ++ui;
        if constexpr (ALIGN_EPI) { if (wr == 1) PG8_BAR; }
    }
    PG8_WAIT_V(0);
    if constexpr (!ALIGN_EPI) { if (wr == 0) PG8_BAR; }
    PG8_BAR;
    if constexpr (Epi::AFTER_DRAIN) { E.fused(acc, cur, wr, wc, fr, fq, lds, wid, lane); S.done(cur); }
#undef PG8_SA
#undef PG8_SB
#undef PG8_STAGE
#undef PG8_LDA
#undef PG8_LDB
#undef PG8_MMA
#undef PG8_WAIT_V
#undef PG8_WAIT_L
#undef PG8_BAR
#undef PG8_SCHED
}
}
constexpr int NWAVES = 8;
constexpr int BATCH = 4, T = 4096, D = 1024, M = BATCH * T;
constexpr int PROJ_W = 2832, NP = 2816, FF = 2816, NGU = 2 * FF, HD = 64;
constexpr int C_GQ = 0, C_GK = 512, C_GV = 1024, C_GZ = 1536, C_SQ = 2048, C_SK = 2560, C_SV = 2688;
constexpr float EPS = 1e-6f;
constexpr size_t MiB = 1u << 20;
constexpr size_t WS_CTL = 0, CTL_ZERO_BYTES = 1 * MiB;
constexpr size_t WS_MODF = 1 * MiB;
constexpr size_t WS_WAB = 1 * MiB + 256 * 1024;
constexpr size_t WS_GB = 2 * MiB;
constexpr size_t WS_WIN = 4 * MiB, WS_WOUT = 10 * MiB, WS_WGU = 12 * MiB, WS_WDN = 24 * MiB;
constexpr size_t WS_H = 32 * MiB;
constexpr size_t WS_PQ = 64 * MiB;
constexpr size_t WS_MIX = 160 * MiB;
constexpr size_t WS_CHKA = 192 * MiB;
constexpr size_t WS_DEC = 1 * MiB + 384 * 1024;
constexpr size_t WS_END = 256 * MiB;
constexpr int CW_BAR = 4096;
constexpr int CW_MODACC = 16384;
constexpr int RING_OFF = 0, RING_BYTES = 131072;
constexpr int LDSCTL_OFF = RING_BYTES, MISC_OFF = LDSCTL_OFF + 320;
constexpr int LDS_BYTES = 147456;
#define GAS __attribute__((address_space(1)))
#define LAS __attribute__((address_space(3)))
typedef unsigned short bf16;
typedef unsigned v4u __attribute__((ext_vector_type(4)));
typedef float f32x4 __attribute__((ext_vector_type(4)));
typedef short bf16x8 __attribute__((ext_vector_type(8)));
typedef GAS unsigned gu32;
typedef GAS unsigned long long gu64;
#define RLX_AGENT __ATOMIC_RELAXED, __HIP_MEMORY_SCOPE_AGENT
#define LDS_WAIT() asm volatile("s_waitcnt lgkmcnt(0)" ::: "memory")
#define VM_WAIT() asm volatile("s_waitcnt vmcnt(0)" ::: "memory")
__device__ __forceinline__ unsigned long long rt() { return __builtin_amdgcn_s_memrealtime(); }
__device__ __forceinline__ unsigned f2bf(float f) { unsigned u = __builtin_bit_cast(unsigned, f); return (u + 0x7fffu + ((u >> 16) & 1u)) >> 16; }
__device__ __forceinline__ unsigned pk2(float lo, float hi) { return f2bf(lo) | (f2bf(hi) << 16); }

#define XB_TMO      128
#define XB_XCNT(j)  (256  + 64 * (j))
#define XB_XSUB(j)  (1280 + 64 * (j))
#define XB_XGEN(j)  (2304 + 64 * (j))
#define XB_TOP      3328
#define XB_TOPGEN   3392
#define XCD_BAR_WORDS 3456
#define XB_SPIN_CAP (1u << 22)

__device__ __forceinline__ unsigned xb_ld(unsigned* p)              { return __hip_atomic_load(p, __ATOMIC_RELAXED, __HIP_MEMORY_SCOPE_AGENT); }
__device__ __forceinline__ unsigned xb_add(unsigned* p, unsigned v) { return __hip_atomic_fetch_add(p, v, __ATOMIC_RELAXED, __HIP_MEMORY_SCOPE_AGENT); }
__device__ __forceinline__ unsigned xb_xcc_id() { return (unsigned)__builtin_amdgcn_s_getreg((3 << 11) | 20) & 0xFu; }
#define XB_SPIN(cond, bar) do { unsigned _sp = 0; while (cond) { __builtin_amdgcn_s_sleep(1); \
    if ((++_sp & 255u) == 0u) { if (xb_ld(&(bar)[XB_TMO])) break; if (_sp > XB_SPIN_CAP) { atomicAdd(&(bar)[XB_TMO], 1u); break; } } } } while (0)

struct XcdBarrier {
    unsigned* bar; unsigned x;
    volatile LAS unsigned* st;
};

__device__ __forceinline__ XcdBarrier xcd_barrier_post(unsigned* bar, volatile LAS unsigned* st) {
    XcdBarrier b; b.bar = bar; b.x = xb_xcc_id(); b.st = st;
    if (threadIdx.x == 0) (void)xb_add(&bar[XB_XCNT(b.x)], 1u);
    return b;
}
__device__ __forceinline__ void xcd_barrier_complete(unsigned* bar, unsigned x, unsigned& nloc, unsigned& nx) {
    const unsigned G = gridDim.x * gridDim.y * gridDim.z;
    unsigned sum, cnt, mine, sp = 0u;
    for (;;) {
        sum = 0u; cnt = 0u; mine = 0u;
#pragma unroll
        for (unsigned j = 0; j < 16; ++j) { const unsigned c = xb_ld(&bar[XB_XCNT(j)]); sum += c; cnt += (c > 0u) ? 1u : 0u; mine = (j == x) ? c : mine; }
        if (sum == G) break;
        __builtin_amdgcn_s_sleep(1);
        if ((++sp & 255u) == 0u) { if (xb_ld(&bar[XB_TMO])) break; if (sp > XB_SPIN_CAP) { atomicAdd(&bar[XB_TMO], 1u); break; } }
    }
    nloc = mine > 0u ? mine : 1u; nx = cnt > 0u ? cnt : 1u;
}

__device__ __forceinline__ void xcd_barrier(const XcdBarrier& b) {
    asm volatile("s_waitcnt vmcnt(0)" ::: "memory");
    __syncthreads();
    if (threadIdx.x == 0) {
        unsigned* bar = b.bar;
        __builtin_amdgcn_s_waitcnt(0);
        unsigned nloc = b.st[0], nx = b.st[1];
        if (nloc == 0u) { xcd_barrier_complete(bar, b.x, nloc, nx); b.st[0] = nloc; b.st[1] = nx; }
        const unsigned old = xb_add(&bar[XB_XSUB(b.x)], 1u);
        const unsigned gen = old / nloc;
        if (old + 1u == (gen + 1u) * nloc) {
            __builtin_amdgcn_fence(__ATOMIC_RELEASE, "agent");
            asm volatile("s_waitcnt vmcnt(0)" ::: "memory");
            const unsigned og = xb_add(&bar[XB_TOP], 1u);
            const unsigned tg = og / nx;
            if (og + 1u == (tg + 1u) * nx) xb_add(&bar[XB_TOPGEN], 1u);
            else XB_SPIN(xb_ld(&bar[XB_TOPGEN]) == tg, bar);
            __builtin_amdgcn_fence(__ATOMIC_ACQUIRE, "agent");
            xb_add(&bar[XB_XGEN(b.x)], 1u);
            asm volatile("s_waitcnt vmcnt(0)" ::: "memory");
        } else {
            XB_SPIN(xb_ld(&bar[XB_XGEN(b.x)]) == gen, bar);
            __builtin_amdgcn_fence(__ATOMIC_ACQUIRE, "agent");
            asm volatile("s_waitcnt vmcnt(0)" ::: "memory");
        }
    }
    __syncthreads();
}
struct Frame {
    LAS unsigned char* lds;
    volatile LAS unsigned* MISC;
    gu32* ctl;
    int tid, lane, wave;
    int vcu, G;
    const float *x, *c, *w_ada, *b_ada, *norm1_w, *w_in, *conv_w, *a_log, *dt_bias, *gdn_norm_w, *q_norm_w, *k_norm_w, *sinks, *w_out, *norm2_w, *w_gate, *w_up, *w_down;
    float* out;
    float *modacc, *modf, *wab, *gb, *dec;
    bf16 *Win_t, *Wout_t, *Wgu_t, *Wdn_t, *H, *PQ, *MIX, *CHKA, *CHKU;
};
__device__ __forceinline__ float wave_sum(float v) {
#pragma unroll
    for (int o = 1; o < 64; o <<= 1) v += __shfl_xor(v, o);
    return v;
}
__device__ __forceinline__ float wave_max(float v) {
#pragma unroll
    for (int o = 1; o < 64; o <<= 1) v = fmaxf(v, __shfl_xor(v, o));
    return v;
}
__device__ __forceinline__ float bf2f(bf16 h) { return __uint_as_float((unsigned)h << 16); }
__device__ __forceinline__ float ld_f32_coh(const float* p) { return __uint_as_float(__hip_atomic_load((const unsigned*)p, RLX_AGENT)); }
__device__ __forceinline__ float silu(float x) { return x / (1.0f + __expf(-x)); }

__device__ __forceinline__ void tr_item(const float* W, int ldw, int src_col, bf16* WT, int K, int dst_row, int k0, LAS float* scr, int lane) {
#pragma unroll 8
    for (int i = 0; i < 32; ++i) { const int kk = 2 * i + (lane >> 5); scr[kk * 33 + (lane & 31)] = W[(size_t)(k0 + kk) * ldw + src_col + (lane & 31)]; }
    LDS_WAIT(); asm volatile("" ::: "memory");
    const int c = lane & 7;
#pragma unroll
    for (int j = 0; j < 4; ++j) { const int n = (lane >> 3) + 8 * j; const LAS float* s = scr + (8 * c) * 33 + n;
        v4u o; o.x = pk2(s[0 * 33], s[1 * 33]); o.y = pk2(s[2 * 33], s[3 * 33]); o.z = pk2(s[4 * 33], s[5 * 33]); o.w = pk2(s[6 * 33], s[7 * 33]);
        *(GAS v4u*)(WT + (size_t)(dst_row + n) * K + k0 + 8 * c) = o; }
    LDS_WAIT(); asm volatile("" ::: "memory");
}

__device__ __forceinline__ void p0_prologue(Frame& F) {
    LAS float* scr = (LAS float*)(F.lds + RING_OFF + F.wave * 16384);
    const int gw = F.vcu * NWAVES + F.wave, NGW = F.G * NWAVES, lane = F.lane;
    constexpr int I_ADA = 24 * 16, I_AB = 16, I_IN = 16 * (NP / 32), I_OUT = 16 * 32, I_GU = 16 * (NGU / 32), I_DN = (FF / 64) * 32;
    constexpr int NITEMS = I_ADA + I_AB + I_IN + I_OUT + I_GU + I_DN;
    for (int it = gw; it < NITEMS; it += NGW) {
        int r = it;
        if (r < I_ADA) {
            const int ct = r % 24, ks = r / 24, col = ct * 256 + lane, k0 = ks * 64;
            float acc[4][4];
#pragma unroll
            for (int j = 0; j < 4; ++j)
#pragma unroll
                for (int b = 0; b < 4; ++b) acc[j][b] = 0.f;
#pragma unroll 4
            for (int kk = 0; kk < 64; ++kk) { const int k = k0 + kk; float cb[4];
#pragma unroll
                for (int b = 0; b < 4; ++b) cb[b] = silu(F.c[b * D + k]);
#pragma unroll
                for (int j = 0; j < 4; ++j) { const float w = F.w_ada[(size_t)k * (6 * D) + col + 64 * j];
#pragma unroll
                    for (int b = 0; b < 4; ++b) acc[j][b] += cb[b] * w; } }
#pragma unroll
            for (int j = 0; j < 4; ++j)
#pragma unroll
                for (int b = 0; b < 4; ++b) atomicAdd(F.modacc + b * (6 * D) + col + 64 * j, acc[j][b]);
            continue;
        }
        r -= I_ADA;
        if (r < I_AB) {
            for (int i = 0; i < 16; ++i) { const int k = i * 64 + lane; F.wab[r * D + k] = F.w_in[(size_t)k * PROJ_W + 2048 + r]; }
            continue;
        }
        r -= I_AB;
        if (r < I_IN) { const int nb = r % (NP / 32), kb = r / (NP / 32), n0 = 32 * nb; tr_item(F.w_in, PROJ_W, n0 < 2048 ? n0 : n0 + 16, F.Win_t, D, n0, 64 * kb, scr, lane); continue; }
        r -= I_IN;
        if (r < I_OUT) { const int nb = r % 32, kb = r / 32; tr_item(F.w_out, D, 32 * nb, F.Wout_t, D, 32 * nb, 64 * kb, scr, lane); continue; }
        r -= I_OUT;
        if (r < I_GU) { const int nb = r % (NGU / 32), kb = r / (NGU / 32), n0 = 32 * nb, p = n0 >> 8, j = n0 & 255;
            if (j < 128) tr_item(F.w_gate, FF, 128 * p + j, F.Wgu_t, D, n0, 64 * kb, scr, lane);
            else         tr_item(F.w_up,   FF, 128 * p + j - 128, F.Wgu_t, D, n0, 64 * kb, scr, lane);
            continue; }
        r -= I_GU;
        { const int nb = r % 32, kb = r / 32; tr_item(F.w_down, D, 32 * nb, F.Wdn_t, FF, 32 * nb, 64 * kb, scr, lane); }
    }
}

template <int WHICH> __device__ __forceinline__ void norm_phase(Frame& F) {
    const int gw = F.vcu * NWAVES + F.wave, NGW = F.G * NWAVES, lane = F.lane;
    if (WHICH == 1) {
        for (int idx = gw * 64 + lane; idx < 4 * 6 * D; idx += NGW * 64) F.modf[idx] = ld_f32_coh(F.modacc + idx) + F.b_ada[idx % (6 * D)];
    }
    const float* src = (WHICH == 1) ? F.x : F.out;
    const float* nw = (WHICH == 1) ? F.norm1_w : F.norm2_w;
    for (int m0 = gw * 4; m0 < M; m0 += NGW * 4) {
        const int b = m0 / T;
        float gm[16], sh[16];
#pragma unroll
        for (int i = 0; i < 4; ++i)
#pragma unroll
            for (int e = 0; e < 4; ++e) { const int c = 256 * i + 4 * lane + e; float sc, sf;
                if (WHICH == 1) { sf = ld_f32_coh(F.modacc + b * 6 * D + c) + F.b_ada[c]; sc = ld_f32_coh(F.modacc + b * 6 * D + D + c) + F.b_ada[D + c]; }
                else { sf = F.modf[b * 6 * D + 3 * D + c]; sc = F.modf[b * 6 * D + 4 * D + c]; }
                gm[4 * i + e] = nw[c] * (1.0f + sc); sh[4 * i + e] = sf; }
        float h[4][16];
#pragma unroll
        for (int r = 0; r < 4; ++r) {
            const GAS f32x4* xr = (const GAS f32x4*)(src + (size_t)(m0 + r) * D) + lane;
            f32x4 v[4]; float ss = 0.f;
#pragma unroll
            for (int i = 0; i < 4; ++i) { v[i] = xr[64 * i]; ss += (v[i].x * v[i].x + v[i].y * v[i].y) + (v[i].z * v[i].z + v[i].w * v[i].w); }
            const float rstd = 1.0f / sqrtf(wave_sum(ss) * (1.0f / D) + EPS);
            GAS unsigned long long* o8 = (GAS unsigned long long*)(F.H + (size_t)(m0 + r) * D) + lane;
#pragma unroll
            for (int i = 0; i < 4; ++i) {
                const float a0 = v[i].x * rstd * gm[4 * i + 0] + sh[4 * i + 0], a1 = v[i].y * rstd * gm[4 * i + 1] + sh[4 * i + 1];
                const float a2 = v[i].z * rstd * gm[4 * i + 2] + sh[4 * i + 2], a3 = v[i].w * rstd * gm[4 * i + 3] + sh[4 * i + 3];
                h[r][4 * i + 0] = a0; h[r][4 * i + 1] = a1; h[r][4 * i + 2] = a2; h[r][4 * i + 3] = a3;
                o8[64 * i] = (unsigned long long)pk2(a0, a1) | ((unsigned long long)pk2(a2, a3) << 32); }
        }
        if (WHICH == 1) {
            float myv = 0.f;
            for (int j = 0; j < 16; ++j) {
                const GAS f32x4* wp = (const GAS f32x4*)(F.wab + j * D) + lane;
                f32x4 wv[4];
#pragma unroll
                for (int i = 0; i < 4; ++i) wv[i] = wp[64 * i];
#pragma unroll
                for (int r = 0; r < 4; ++r) { float p = 0.f;
#pragma unroll
                    for (int i = 0; i < 4; ++i) p += (h[r][4 * i] * wv[i].x + h[r][4 * i + 1] * wv[i].y) + (h[r][4 * i + 2] * wv[i].z + h[r][4 * i + 3] * wv[i].w);
                    p = wave_sum(p);
                    if (lane == r * 16 + j) myv = p; }
            }
            const int j = lane & 15, hh = j & 7;
            float val;
            if (j < 8) { const float xx = myv + F.dt_bias[hh]; const float sp = fmaxf(xx, 0.f) + log1pf(__expf(-fabsf(xx))); val = -__expf(F.a_log[hh]) * sp; }
            else val = 1.0f / (1.0f + __expf(-myv));
            F.gb[(size_t)m0 * 16 + lane] = val;
        }
    }
}

__device__ __forceinline__ void gdn_wave(Frame& F, int bh, LAS float* scr) {
    const int lane = F.lane, b = bh >> 3, hh = bh & 7;
    float S[64];
#pragma unroll
    for (int d = 0; d < 64; ++d) S[d] = 0.f;
    float wq[4], wk[4], wv[4];
#pragma unroll
    for (int j = 0; j < 4; ++j) { wq[j] = F.conv_w[j * 1536 + hh * 64 + lane]; wk[j] = F.conv_w[j * 1536 + 512 + hh * 64 + lane]; wv[j] = F.conv_w[j * 1536 + 1024 + hh * 64 + lane]; }
    const float nwg = F.gdn_norm_w[lane];
    float xq0 = 0.f, xq1 = 0.f, xq2 = 0.f, xk0 = 0.f, xk1 = 0.f, xk2 = 0.f, xv0 = 0.f, xv1 = 0.f, xv2 = 0.f;
    const size_t row0 = (size_t)b * T;
    const bf16* pq = F.PQ + row0 * NP + hh * 64 + lane;
    bf16 nq = pq[C_GQ], nk = pq[C_GK], nv = pq[C_GV], nz = pq[C_GZ];
    float ng = ld_f32_coh(F.gb + row0 * 16 + hh), nb = ld_f32_coh(F.gb + row0 * 16 + 8 + hh);
    for (int t = 0; t < T; ++t) {
        const float rq = bf2f(nq), rk = bf2f(nk), rv = bf2f(nv), rz = bf2f(nz), g = ng, beta = nb;
        if (t + 1 < T) { const bf16* p2 = pq + (size_t)(t + 1) * NP; nq = p2[C_GQ]; nk = p2[C_GK]; nv = p2[C_GV]; nz = p2[C_GZ];
            ng = ld_f32_coh(F.gb + (row0 + t + 1) * 16 + hh); nb = ld_f32_coh(F.gb + (row0 + t + 1) * 16 + 8 + hh); }
        float cq = wq[0] * xq0 + wq[1] * xq1 + wq[2] * xq2 + wq[3] * rq;
        float ck = wk[0] * xk0 + wk[1] * xk1 + wk[2] * xk2 + wk[3] * rk;
        float cv = wv[0] * xv0 + wv[1] * xv1 + wv[2] * xv2 + wv[3] * rv;
        xq0 = xq1; xq1 = xq2; xq2 = rq; xk0 = xk1; xk1 = xk2; xk2 = rk; xv0 = xv1; xv1 = xv2; xv2 = rv;
        cq = silu(cq); ck = silu(ck); cv = silu(cv);
        const float qn = cq / sqrtf(wave_sum(cq * cq) + EPS), kn = ck / sqrtf(wave_sum(ck * ck) + EPS);
        scr[lane] = kn; scr[64 + lane] = qn;
        LDS_WAIT(); asm volatile("" ::: "memory");
        const float a = __expf(g);
        float kd = 0.f;
#pragma unroll
        for (int d4 = 0; d4 < 16; ++d4) { const f32x4 kv = *(const LAS f32x4*)(scr + 4 * d4);
            kd += kv.x * S[4 * d4]; kd += kv.y * S[4 * d4 + 1]; kd += kv.z * S[4 * d4 + 2]; kd += kv.w * S[4 * d4 + 3]; }
        const float cc = beta * (cv - a * kd);
        float o = 0.f;
#pragma unroll
        for (int d4 = 0; d4 < 16; ++d4) { const f32x4 kv = *(const LAS f32x4*)(scr + 4 * d4); const f32x4 qv = *(const LAS f32x4*)(scr + 64 + 4 * d4);
            S[4 * d4] = a * S[4 * d4] + cc * kv.x; o += qv.x * S[4 * d4];
            S[4 * d4 + 1] = a * S[4 * d4 + 1] + cc * kv.y; o += qv.y * S[4 * d4 + 1];
            S[4 * d4 + 2] = a * S[4 * d4 + 2] + cc * kv.z; o += qv.z * S[4 * d4 + 2];
            S[4 * d4 + 3] = a * S[4 * d4 + 3] + cc * kv.w; o += qv.w * S[4 * d4 + 3]; }
        LDS_WAIT(); asm volatile("" ::: "memory");
        o *= 0.125f;
        const float on = o / sqrtf(wave_sum(o * o) * (1.0f / 64.0f) + EPS) * nwg * silu(rz);
        F.MIX[(row0 + t) * D + hh * 64 + lane] = (bf16)f2bf(on);
    }
}
__device__ __forceinline__ void swa_query(Frame& F, int item, LAS float* scr) {
    const int lane = F.lane, t = item & (T - 1), hq = (item >> 12) & 7, b = item >> 15, kvh = hq >> 2;
    const size_t row0 = (size_t)b * T;
    const float qraw = bf2f(F.PQ[(row0 + t) * NP + C_SQ + hq * 64 + lane]);
    const float qn = qraw / sqrtf(wave_sum(qraw * qraw) * (1.0f / 64.0f) + EPS) * F.q_norm_w[lane];
    scr[lane] = qn * F.k_norm_w[lane];
    LDS_WAIT(); asm volatile("" ::: "memory");
    const float slope = exp2f(-(float)(hq + 1)), sink = F.sinks[hq];
    float sc[2];
#pragma unroll
    for (int jj = 0; jj < 2; ++jj) {
        const int s = t - 127 + lane + 64 * jj;
        float v = -INFINITY;
        if (s >= 0) {
            const GAS v4u* kp = (const GAS v4u*)(F.PQ + (row0 + s) * NP + C_SK + kvh * 64);
            float dot = 0.f, ssk = 0.f;
#pragma unroll
            for (int c8 = 0; c8 < 8; ++c8) { const v4u kk = kp[c8]; const unsigned wds[4] = {kk.x, kk.y, kk.z, kk.w};
#pragma unroll
                for (int w = 0; w < 4; ++w) { const float k0 = __uint_as_float(wds[w] << 16), k1 = __uint_as_float(wds[w] & 0xffff0000u);
                    const float q0 = scr[c8 * 8 + 2 * w], q1 = scr[c8 * 8 + 2 * w + 1];
                    dot += q0 * k0 + q1 * k1; ssk += k0 * k0 + k1 * k1; } }
            v = dot / sqrtf(ssk * (1.0f / 64.0f) + EPS) * 0.125f - slope * (float)(t - s);
        }
        sc[jj] = v;
    }
    const float mx = fmaxf(wave_max(fmaxf(sc[0], sc[1])), sink);
    const float p0 = __expf(sc[0] - mx), p1 = __expf(sc[1] - mx);
    const float den = wave_sum(p0 + p1) + __expf(sink - mx);
    LDS_WAIT(); asm volatile("" ::: "memory");
    scr[64 + lane] = p0; scr[128 + lane] = p1;
    LDS_WAIT(); asm volatile("" ::: "memory");
    float o = 0.f;
    const int s0 = t - 127;
    const bf16* vp = F.PQ + row0 * NP + C_SV + kvh * 64 + lane;
    for (int j = (s0 < 0 ? -s0 : 0); j < 128; ++j) o += scr[64 + j] * bf2f(vp[(size_t)(s0 + j) * NP]);
    LDS_WAIT(); asm volatile("" ::: "memory");
    F.MIX[(row0 + t) * D + 512 + hq * 64 + lane] = (bf16)f2bf(o / den);
}
typedef short s16x4v __attribute__((ext_vector_type(4)));
typedef float f32x2_t __attribute__((ext_vector_type(2))); typedef __bf16 bf16x2_t __attribute__((ext_vector_type(2)));
__device__ __forceinline__ unsigned cvtpk(float lo, float hi) { f32x2_t v = {lo, hi}; bf16x2_t b = __builtin_convertvector(v, bf16x2_t); return __builtin_bit_cast(unsigned, b); }
__device__ __forceinline__ float rdlane(float v, int l) { return __int_as_float(__builtin_amdgcn_readlane(__float_as_int(v), l)); }
__device__ __forceinline__ bf16x8 pack8(const f32x4 a, const f32x4 b) {
    v4u w; w.x = cvtpk(a[0], a[1]); w.y = cvtpk(a[2], a[3]); w.z = cvtpk(b[0], b[1]); w.w = cvtpk(b[2], b[3]); return __builtin_bit_cast(bf16x8, w); }

__device__ __forceinline__ void gdn_prep_chunk(Frame& F, int ci, LAS unsigned char* wl  ) {
    const int lane = F.lane, bh = ci >> 6, n = ci & 63, b = bh >> 3, hh = bh & 7, fr = lane & 15, fq = lane >> 4;
    const size_t m0 = (size_t)b * T + 64 * n;
    bf16* const cA = F.CHKA + (size_t)ci * 16384;
    bf16* const cU = F.CHKU + (size_t)ci * 4096;
    const float g = ld_f32_coh(F.gb + (m0 + lane) * 16 + hh), beta = ld_f32_coh(F.gb + (m0 + lane) * 16 + 8 + hh);
    float G = g;
#pragma unroll
    for (int o = 1; o < 64; o <<= 1) { const float t = __shfl_up(G, o); if (lane >= o) G += t; }
    const float eG = __expf(G), Glast = __shfl(G, 63), kdsc = __expf(Glast - G), beG = beta * eG;
    if (lane == 0) F.dec[ci] = __expf(Glast);
    const int offcol = ((lane >> 5) * 64 + 16 * ((lane & 15) >> 2)) * 8 + 4 * ((lane >> 4) & 1) + (lane & 3);
    LAS bf16* const Qn = (LAS bf16*)wl; LAS bf16* const Kn = (LAS bf16*)(wl + 8192);
    float xk[64];
    {
        const bf16* src = F.PQ + m0 * NP + C_GQ + hh * 64 + lane;
        const float w0 = F.conv_w[hh * 64 + lane], w1 = F.conv_w[1536 + hh * 64 + lane], w2 = F.conv_w[2 * 1536 + hh * 64 + lane], w3 = F.conv_w[3 * 1536 + hh * 64 + lane];
        float x0 = 0.f, x1 = 0.f, x2 = 0.f;
        if (n > 0) { x0 = bf2f(*(src - 3 * NP)); x1 = bf2f(*(src - 2 * NP)); x2 = bf2f(*(src - NP)); }
        bf16* qd = cA + 4096 + offcol;
#pragma unroll
        for (int c = 0; c < 64; ++c) {
            const float r = bf2f(src[(size_t)c * NP]);
            const float cq = silu(w0 * x0 + w1 * x1 + w2 * x2 + w3 * r); x0 = x1; x1 = x2; x2 = r;
            const float qn = cq / sqrtf(wave_sum(cq * cq) + EPS);
            Qn[c * 64 + lane] = (bf16)f2bf(qn);
            qd[((c >> 4) * 128 + (c & 15)) * 8] = (bf16)f2bf(qn * rdlane(eG, c) * 0.125f);
        }
    }
    {
        const bf16* src = F.PQ + m0 * NP + C_GK + hh * 64 + lane;
        const float w0 = F.conv_w[512 + hh * 64 + lane], w1 = F.conv_w[1536 + 512 + hh * 64 + lane], w2 = F.conv_w[2 * 1536 + 512 + hh * 64 + lane], w3 = F.conv_w[3 * 1536 + 512 + hh * 64 + lane];
        float x0 = 0.f, x1 = 0.f, x2 = 0.f;
        if (n > 0) { x0 = bf2f(*(src - 3 * NP)); x1 = bf2f(*(src - 2 * NP)); x2 = bf2f(*(src - NP)); }
        bf16* kdt = cA + 3 * 4096 + (lane >> 4) * 2 * 64 * 8 + (lane & 15) * 8;
        float kq[4];
#pragma unroll
        for (int c = 0; c < 64; ++c) {
            const float r = bf2f(src[(size_t)c * NP]);
            const float ck = silu(w0 * x0 + w1 * x1 + w2 * x2 + w3 * r); x0 = x1; x1 = x2; x2 = r;
            const float kn = ck / sqrtf(wave_sum(ck * ck) + EPS);
            Kn[c * 64 + lane] = (bf16)f2bf(kn);
            xk[c] = kn * rdlane(beG, c);
            kq[c & 3] = kn * rdlane(kdsc, c);
            if ((c & 3) == 3) { const int c0 = c - 3;
                unsigned long long pk = (unsigned long long)cvtpk(kq[0], kq[1]) | ((unsigned long long)cvtpk(kq[2], kq[3]) << 32);
                *(unsigned long long*)(kdt + ((c0 >> 5) * 64 + 16 * ((c0 & 15) >> 2)) * 8 + 4 * ((c0 >> 4) & 1)) = pk; }
        }
    }
    LDS_WAIT(); asm volatile("" ::: "memory");
    bf16x8 kf[4][2], qf[4][2];
#pragma unroll
    for (int blk = 0; blk < 4; ++blk)
#pragma unroll
        for (int kk = 0; kk < 2; ++kk) { kf[blk][kk] = *(const LAS bf16x8*)(Kn + (16 * blk + fr) * 64 + 32 * kk + 8 * fq); qf[blk][kk] = *(const LAS bf16x8*)(Qn + (16 * blk + fr) * 64 + 32 * kk + 8 * fq); }
    float Gcol[4], Bcol[4], Grow[4][4];
#pragma unroll
    for (int t = 0; t < 4; ++t) { Gcol[t] = __shfl(G, 16 * t + fr); Bcol[t] = __shfl(beta, 16 * t + fr);
#pragma unroll
        for (int i = 0; i < 4; ++i) Grow[t][i] = __shfl(G, 16 * t + 4 * fq + i); }
    LDS_WAIT(); asm volatile("" ::: "memory");
#pragma unroll
    for (int tc = 0; tc < 4; ++tc)
#pragma unroll
        for (int ks = 0; ks < 2; ++ks) {
            f32x4 v[2];
#pragma unroll
            for (int h2 = 0; h2 < 2; ++h2) { const int ts = 2 * ks + h2;
                if (ts <= tc) { f32x4 acc = (f32x4){0.f, 0.f, 0.f, 0.f};
                    acc = __builtin_amdgcn_mfma_f32_16x16x32_bf16(kf[ts][0], qf[tc][0], acc, 0, 0, 0); acc = __builtin_amdgcn_mfma_f32_16x16x32_bf16(kf[ts][1], qf[tc][1], acc, 0, 0, 0);
#pragma unroll
                    for (int i = 0; i < 4; ++i) { const int cidx = 16 * tc + fr, sidx = 16 * ts + 4 * fq + i; v[h2][i] = (cidx >= sidx) ? acc[i] * __expf(Gcol[tc] - Grow[ts][i]) * 0.125f : 0.f; }
                } else v[h2] = (f32x4){0.f, 0.f, 0.f, 0.f}; }
            *(bf16x8*)(cA + 2 * 4096 + ((tc * 2 + ks) * 64 + lane) * 8) = pack8(v[0], v[1]);
        }
    LAS float* const Am = (LAS float*)wl;
#pragma unroll
    for (int tc = 0; tc < 4; ++tc)
#pragma unroll
        for (int ts = 0; ts <= tc; ++ts) { f32x4 acc = (f32x4){0.f, 0.f, 0.f, 0.f};
            acc = __builtin_amdgcn_mfma_f32_16x16x32_bf16(kf[ts][0], kf[tc][0], acc, 0, 0, 0); acc = __builtin_amdgcn_mfma_f32_16x16x32_bf16(kf[ts][1], kf[tc][1], acc, 0, 0, 0);
            f32x4 a;
#pragma unroll
            for (int i = 0; i < 4; ++i) { const int cidx = 16 * tc + fr, sidx = 16 * ts + 4 * fq + i; a[i] = (cidx > sidx) ? Bcol[tc] * acc[i] * __expf(Gcol[tc] - Grow[ts][i]) : 0.f; }
            *(LAS f32x4*)(Am + (16 * tc + fr) * 64 + 16 * ts + 4 * fq) = a; }
    LDS_WAIT(); asm volatile("" ::: "memory");
    float Ar[64];
#pragma unroll
    for (int c = 1; c < 64; ++c) Ar[c] = Am[c * 64 + lane];
    LDS_WAIT(); asm volatile("" ::: "memory");
#pragma unroll
    for (int c = 1; c < 64; ++c) {
#pragma unroll
        for (int s = 0; s < c; ++s) xk[c] -= rdlane(Ar[c], s) * xk[s];
    }
    {
        bf16* wm = cA + offcol;
#pragma unroll
        for (int c = 0; c < 64; ++c) wm[((c >> 4) * 128 + (c & 15)) * 8] = (bf16)f2bf(-xk[c]);
    }
    float xv[64];
    {
        const bf16* src = F.PQ + m0 * NP + C_GV + hh * 64 + lane;
        const float w0 = F.conv_w[1024 + hh * 64 + lane], w1 = F.conv_w[1536 + 1024 + hh * 64 + lane], w2 = F.conv_w[2 * 1536 + 1024 + hh * 64 + lane], w3 = F.conv_w[3 * 1536 + 1024 + hh * 64 + lane];
        float x0 = 0.f, x1 = 0.f, x2 = 0.f;
        if (n > 0) { x0 = bf2f(*(src - 3 * NP)); x1 = bf2f(*(src - 2 * NP)); x2 = bf2f(*(src - NP)); }
#pragma unroll
        for (int c = 0; c < 64; ++c) {
            const float r = bf2f(src[(size_t)c * NP]);
            const float cv = silu(w0 * x0 + w1 * x1 + w2 * x2 + w3 * r); x0 = x1; x1 = x2; x2 = r;
            xv[c] = cv * rdlane(beta, c);
        }
    }
#pragma unroll
    for (int c = 1; c < 64; ++c) {
#pragma unroll
        for (int s = 0; s < c; ++s) xv[c] -= rdlane(Ar[c], s) * xv[s];
    }
    {
        bf16* up = cU + ((lane >> 4) * 4 * 64 + (lane & 15)) * 4;
#pragma unroll
        for (int c4 = 0; c4 < 16; ++c4) { const unsigned long long pk = (unsigned long long)cvtpk(xv[4 * c4], xv[4 * c4 + 1]) | ((unsigned long long)cvtpk(xv[4 * c4 + 2], xv[4 * c4 + 3]) << 32);
            *(unsigned long long*)(up + ((c4 >> 2) * 64 + 16 * (c4 & 3)) * 4) = pk; }
    }
    LDS_WAIT(); asm volatile("" ::: "memory");
}

#define GDN_BAR() do { asm volatile("" ::: "memory"); __builtin_amdgcn_s_barrier(); asm volatile("" ::: "memory"); } while (0)
__device__ __forceinline__ void gdn_scan(Frame& F, int bh) {
    const int lane = F.lane, wave = F.wave, b = bh >> 3, hh = bh & 7, fr = lane & 15, fq = lane >> 4;
    LAS unsigned char* const ring = F.lds + RING_OFF;
    constexpr int SLOT = 40960;
    const unsigned char* gA = (const unsigned char*)(F.CHKA + (size_t)bh * 64 * 16384);
    const unsigned char* gU = (const unsigned char*)(F.CHKU + (size_t)bh * 64 * 4096);
    if (wave >= 4) {
        const int lw = wave - 4;
#define GDN_ISSUE(nn) do { const int n_ = (nn); const int sl_ = n_ % 3; _Pragma("unroll") for (int i_ = 0; i_ < 10; ++i_) { const int p_ = lw * 10 + i_; \
            const unsigned char* s_ = (p_ < 32) ? gA + (size_t)n_ * 32768 + p_ * 1024 : gU + (size_t)n_ * 8192 + (p_ - 32) * 1024; \
            __builtin_amdgcn_global_load_lds((const unsigned*)(s_ + lane * 16), (LAS unsigned*)(ring + sl_ * SLOT + p_ * 1024), 16, 0, 0); } } while (0)
        GDN_ISSUE(0); GDN_ISSUE(1);
        asm volatile("s_waitcnt vmcnt(10)" ::: "memory"); GDN_BAR();
        for (int n = 0; n < 64; ++n) {
            if (n + 2 < 64) { GDN_ISSUE(n + 2); asm volatile("s_waitcnt vmcnt(10)" ::: "memory"); } else asm volatile("s_waitcnt vmcnt(0)" ::: "memory");
            GDN_BAR();
        }
#undef GDN_ISSUE
    } else {
        const int ew = wave;
        f32x4 Sacc[4];
#pragma unroll
        for (int t = 0; t < 4; ++t) Sacc[t] = (f32x4){0.f, 0.f, 0.f, 0.f};
        const float* decp = F.dec + bh * 64;
        float dnext = ld_f32_coh(decp);
        bf16* op = F.MIX + ((size_t)b * T + 4 * fq) * D + hh * 64 + 16 * ew + fr;
        GDN_BAR();
        for (int n = 0; n < 64; ++n) {
            const LAS unsigned char* sl = ring + (n % 3) * SLOT;
            const float dec = dnext; if (n + 1 < 64) dnext = ld_f32_coh(decp + n + 1);
            f32x4 V[4], O[4];
#pragma unroll
            for (int mt = 0; mt < 4; ++mt) { const unsigned long long uu = *(const LAS unsigned long long*)(sl + 32768 + ((ew * 4 + mt) * 64 + lane) * 8); const unsigned lo = (unsigned)uu, hi = (unsigned)(uu >> 32);
                V[mt] = (f32x4){__uint_as_float(lo << 16), __uint_as_float(lo & 0xffff0000u), __uint_as_float(hi << 16), __uint_as_float(hi & 0xffff0000u)}; O[mt] = (f32x4){0.f, 0.f, 0.f, 0.f}; }
            bf16x8 Sb[2]; Sb[0] = pack8(Sacc[0], Sacc[1]); Sb[1] = pack8(Sacc[2], Sacc[3]);
#pragma unroll
            for (int mt = 0; mt < 4; ++mt)
#pragma unroll
                for (int ks = 0; ks < 2; ++ks) { const bf16x8 wf = *(const LAS bf16x8*)(sl + ((mt * 2 + ks) * 64 + lane) * 16), qf = *(const LAS bf16x8*)(sl + 8192 + ((mt * 2 + ks) * 64 + lane) * 16);
                    V[mt] = __builtin_amdgcn_mfma_f32_16x16x32_bf16(wf, Sb[ks], V[mt], 0, 0, 0); O[mt] = __builtin_amdgcn_mfma_f32_16x16x32_bf16(qf, Sb[ks], O[mt], 0, 0, 0); }
            bf16x8 Vb[2]; Vb[0] = pack8(V[0], V[1]); Vb[1] = pack8(V[2], V[3]);
#pragma unroll
            for (int t = 0; t < 4; ++t) Sacc[t] = Sacc[t] * dec;
#pragma unroll
            for (int mt = 0; mt < 4; ++mt)
#pragma unroll
                for (int ks = 0; ks < 2; ++ks) { const bf16x8 af = *(const LAS bf16x8*)(sl + 16384 + ((mt * 2 + ks) * 64 + lane) * 16), kf = *(const LAS bf16x8*)(sl + 24576 + ((mt * 2 + ks) * 64 + lane) * 16);
                    O[mt] = __builtin_amdgcn_mfma_f32_16x16x32_bf16(af, Vb[ks], O[mt], 0, 0, 0); Sacc[mt] = __builtin_amdgcn_mfma_f32_16x16x32_bf16(kf, Vb[ks], Sacc[mt], 0, 0, 0); }
            bf16* o2 = op + (size_t)(64 * n) * D;
#pragma unroll
            for (int mt = 0; mt < 4; ++mt)
#pragma unroll
                for (int i = 0; i < 4; ++i) o2[(size_t)(16 * mt + i) * D] = (bf16)f2bf(O[mt][i]);
            LDS_WAIT(); GDN_BAR();
        }
    }
    asm volatile("s_waitcnt vmcnt(0)" ::: "memory"); GDN_BAR(); asm volatile("" ::: "memory");
    for (int idx = F.tid; idx < T * 8; idx += NWAVES * 64) {
        const int row = idx >> 3, oc = idx & 7;
        bf16* p = F.MIX + ((size_t)b * T + row) * D + hh * 64 + oc * 8;
        const v4u ov = *(const GAS v4u*)p, zv = *(const GAS v4u*)(F.PQ + ((size_t)b * T + row) * NP + C_GZ + hh * 64 + oc * 8);
        const unsigned ow[4] = {ov.x, ov.y, ov.z, ov.w}, zw[4] = {zv.x, zv.y, zv.z, zv.w};
        float o[8], z[8]; float ss = 0.f;
#pragma unroll
        for (int w = 0; w < 4; ++w) { o[2 * w] = __uint_as_float(ow[w] << 16); o[2 * w + 1] = __uint_as_float(ow[w] & 0xffff0000u); z[2 * w] = __uint_as_float(zw[w] << 16); z[2 * w + 1] = __uint_as_float(zw[w] & 0xffff0000u);
            ss += o[2 * w] * o[2 * w] + o[2 * w + 1] * o[2 * w + 1]; }
        ss += __shfl_xor(ss, 1); ss += __shfl_xor(ss, 2); ss += __shfl_xor(ss, 4);
        const float rstd = 1.0f / sqrtf(ss * (1.0f / 64.0f) + EPS);
        float r[8];
#pragma unroll
        for (int j = 0; j < 8; ++j) r[j] = o[j] * rstd * F.gdn_norm_w[oc * 8 + j] * silu(z[j]);
        v4u w4; w4.x = cvtpk(r[0], r[1]); w4.y = cvtpk(r[2], r[3]); w4.z = cvtpk(r[4], r[5]); w4.w = cvtpk(r[6], r[7]);
        *(GAS v4u*)p = w4;
    }
}
__device__ __forceinline__ void p3a_prep(Frame& F) {
    LAS unsigned char* wl = F.lds + RING_OFF + F.wave * 16384;
    const int gw = F.vcu * NWAVES + F.wave, NGW = F.G * NWAVES;
    for (int ci = gw; ci < BATCH * 8 * (T / 64); ci += NGW) gdn_prep_chunk(F, ci, wl);
}
__device__ __forceinline__ void p3b_mixers(Frame& F) {
    const int bx = blockIdx.x;
    if (bx < 32) { gdn_scan(F, bx); return; }
    LAS float* scr = (LAS float*)(F.lds + RING_OFF + F.wave * 1024);
    const int id = (bx - 32) * 8 + F.wave, nworkers = (F.G - 32) * 8;
    for (int it = id; it < BATCH * 8 * T; it += nworkers) swa_query(F, it, scr);
}

struct Args { const float* in[18]; float* out; unsigned char* ws; };
__global__ void __launch_bounds__(NWAVES * 64, 2) hymba_fwd(Args args) {
    extern __shared__ __attribute__((aligned(16))) unsigned char lds[];
    Frame F;
    F.lds = (LAS unsigned char*)lds;
    F.MISC = (volatile LAS unsigned*)(F.lds + MISC_OFF);
    F.tid = threadIdx.x; F.lane = F.tid & 63; F.wave = __builtin_amdgcn_readfirstlane(F.tid >> 6);
    F.G = gridDim.x; { const int bx = blockIdx.x; F.vcu = (F.G % 8 == 0) ? (bx % 8) * (F.G / 8) + bx / 8 : bx; }
    unsigned char* ws = args.ws;
    F.ctl = (gu32*)(ws + WS_CTL);
    F.x = args.in[0]; F.c = args.in[1]; F.w_ada = args.in[2]; F.b_ada = args.in[3]; F.norm1_w = args.in[4]; F.w_in = args.in[5]; F.conv_w = args.in[6];
    F.a_log = args.in[7]; F.dt_bias = args.in[8]; F.gdn_norm_w = args.in[9]; F.q_norm_w = args.in[10]; F.k_norm_w = args.in[11]; F.sinks = args.in[12];
    F.w_out = args.in[13]; F.norm2_w = args.in[14]; F.w_gate = args.in[15]; F.w_up = args.in[16]; F.w_down = args.in[17]; F.out = args.out;
    F.modacc = (float*)(ws + WS_CTL) + CW_MODACC; F.modf = (float*)(ws + WS_MODF); F.wab = (float*)(ws + WS_WAB); F.gb = (float*)(ws + WS_GB);
    F.Win_t = (bf16*)(ws + WS_WIN); F.Wout_t = (bf16*)(ws + WS_WOUT); F.Wgu_t = (bf16*)(ws + WS_WGU); F.Wdn_t = (bf16*)(ws + WS_WDN);
    F.H = (bf16*)(ws + WS_H); F.PQ = (bf16*)(ws + WS_PQ); F.MIX = (bf16*)(ws + WS_MIX); F.CHKA = (bf16*)(ws + WS_CHKA); F.CHKU = (bf16*)(ws + WS_H); F.dec = (float*)(ws + WS_DEC);
    for (int u = F.tid; u < (LDS_BYTES - LDSCTL_OFF) / 4; u += NWAVES * 64) ((LAS unsigned*)(F.lds + LDSCTL_OFF))[u] = 0u;
    __syncthreads();
    XcdBarrier bar = xcd_barrier_post((unsigned*)(F.ctl + CW_BAR), F.MISC + 8);
#define GRID_BAR() xcd_barrier(bar)

    p0_prologue(F); GRID_BAR();
    norm_phase<1>(F); GRID_BAR();
    { pg8::Gemm g{F.H, F.Win_t, M, NP, D}; pg8::StaticOrder S; S.init(M, NP, F.G, (int)blockIdx.x);
      pg8::EpiBf16Plain E{F.PQ, NP};
      pg8::gemm_phase<pg8::EpiBf16Plain, pg8::StaticOrder, true, true>(F.lds + RING_OFF, g, S, E); }
    GRID_BAR();
    p3a_prep(F); GRID_BAR();
    p3b_mixers(F); GRID_BAR();
    { pg8::Gemm g{F.MIX, F.Wout_t, M, D, D}; pg8::StaticOrder S; S.init(M, D, F.G, (int)blockIdx.x);
      pg8::EpiGateRes E{F.x, F.out, D, F.modf + 2 * D, 6 * D, T};
      pg8::gemm_phase<pg8::EpiGateRes, pg8::StaticOrder, true, true>(F.lds + RING_OFF, g, S, E); }
    GRID_BAR();
    norm_phase<2>(F); GRID_BAR();
    { pg8::Gemm g{F.H, F.Wgu_t, M, NGU, D}; pg8::StaticOrder S; S.init(M, NGU, F.G, (int)blockIdx.x);
      pg8::EpiSwiGLU E{F.PQ, FF};
      pg8::gemm_phase<pg8::EpiSwiGLU, pg8::StaticOrder, true, true>(F.lds + RING_OFF, g, S, E); }
    GRID_BAR();
    { pg8::Gemm g{F.PQ, F.Wdn_t, M, D, FF}; pg8::StaticOrder S; S.init(M, D, F.G, (int)blockIdx.x);
      pg8::EpiGateRes E{F.out, F.out, D, F.modf + 5 * D, 6 * D, T};
      pg8::gemm_phase<pg8::EpiGateRes, pg8::StaticOrder, true, true>(F.lds + RING_OFF, g, S, E); }
#undef GRID_BAR
}

extern "C" void kernel_launch(void* const* d_in, const int* in_sizes, int n_in, void* d_out, int out_size, void* d_ws, size_t ws_size, hipStream_t stream) {
    static int grid = 0;
    if (grid == 0) {
        if (n_in != 18 || in_sizes[0] != M * D || out_size != M * D || ws_size < WS_END) { fprintf(stderr, "kernel_launch: unexpected shapes (n_in %d, in0 %d, out %d, ws %zu); nothing launched\n", n_in, n_in > 0 ? in_sizes[0] : -1, out_size, ws_size); grid = -1; return; }
        int dev = 0, cus = 0;
        if (hipGetDevice(&dev) != hipSuccess || hipDeviceGetAttribute(&cus, hipDeviceAttributeMultiprocessorCount, dev) != hipSuccess) { grid = -1; return; }
        if (hipFuncSetAttribute((const void*)hymba_fwd, hipFuncAttributeMaxDynamicSharedMemorySize, LDS_BYTES) != hipSuccess) { fprintf(stderr, "kernel_launch: hipFuncSetAttribute failed\n"); grid = -1; return; }
        (void)hipGetLastError();
        grid = cus;
    }
    if (grid < 0) return;
    if (hipMemsetAsync((char*)d_ws + WS_CTL, 0, CTL_ZERO_BYTES, stream) != hipSuccess) { fprintf(stderr, "kernel_launch: hipMemsetAsync failed\n"); return; }
    Args a{};
    for (int i = 0; i < 18; ++i) a.in[i] = (const float*)d_in[i];
    a.out = (float*)d_out; a.ws = (unsigned char*)d_ws;
    hipLaunchKernelGGL(hymba_fwd, dim3(grid), dim3(NWAVES * 64), LDS_BYTES, stream, a);
    const hipError_t le = hipPeekAtLastError();
    if (le != hipSuccess) fprintf(stderr, "kernel_launch: launch failed: %s\n", hipGetErrorName(le));
}
```

```cpp
#include <hip/hip_runtime.h>
#include <cstdio>
#include <cstdint>
#include <cmath>
namespace pg8 {
#define PG8_LAS __attribute__((address_space(3)))
typedef unsigned short bf16_t;
typedef short bf16x8 __attribute__((ext_vector_type(8)));
typedef float f32x4 __attribute__((ext_vector_type(4)));
typedef unsigned u32x4 __attribute__((ext_vector_type(4)));
constexpr int BM = 256, BK = 64, HALF = 128, HTB = HALF * BK * 2  , STAGE_BYTES = 8 * HTB, NXCD = 8, WGM = 8;

__host__ __device__ __forceinline__ int lds_byte(int r, int c) { const int st = (r >> 4) * 2 + (c >> 5), rr = r & 15, cc = c & 31, ob = rr * 64 + cc * 2; return st * 1024 + (ob ^ (((ob >> 9) & 1) << 5)); }
__host__ __device__ __forceinline__ void stage_rc(int b, int& R, int& C) { const int st = b / 1024, sb = b % 1024, swz = sb ^ (((sb >> 9) & 1) << 5); R = (st >> 1) * 16 + swz / 64; C = (st & 1) * 32 + (swz % 64) / 2; }
__host__ __device__ __forceinline__ int perm32(int rho) { const int n = rho >> 4, i = rho & 15; return 8 * (i >> 2) + 4 * n + (i & 3); }

struct Unit { int pm, pn; };
struct Gemm { const bf16_t* A; const bf16_t* Bt; int M, N, K; };

struct StaticOrder {
    int nM, nN, nwg, G, c;
    __host__ __device__ void init(int M, int N, int G_, int c_) { nM = M / BM; nN = N / BM; nwg = nM * nN; G = G_; c = c_; }
    __host__ __device__ bool next(int i, Unit& u) const {
        const long L = (long)i * G + c; if (L >= nwg) return false;
        int wgid = (int)L; { const int q = nwg / NXCD, r = nwg % NXCD, xcd = wgid % NXCD, off = wgid / NXCD; wgid = (xcd < r ? xcd * (q + 1) : r * (q + 1) + (xcd - r) * q) + off; }
        const int nig = WGM * nN, gid = wgid / nig, fm = gid * WGM, gsz = (nM - fm) < WGM ? (nM - fm) : WGM;
        u.pm = fm + ((wgid % nig) % gsz); u.pn = (wgid % nig) / gsz; return true;
    }
    __device__ __forceinline__ void a_ready(const Unit&) const {}
    __device__ __forceinline__ void done(const Unit&) const {}
};

__device__ __forceinline__ unsigned cvt_pk_bf16(float lo, float hi) { unsigned r; asm volatile("v_cvt_pk_bf16_f32 %0, %1, %2" : "=v"(r) : "v"(lo), "v"(hi)); return r; }
__device__ __forceinline__ float silu_f(float x) { return x * __builtin_amdgcn_rcpf(1.0f + __expf(-x)); }

struct EpiBf16Plain {
    static constexpr bool PERM = true, AFTER_DRAIN = false;
    bf16_t* O; int ldc;
    __device__ __forceinline__ void operator()(const f32x4 (&acc)[2][2][4][2], const Unit& u, int wr, int wc, int fr, int fq) const {
        const int row0 = u.pm * BM + wr * 64 + fr, col0 = u.pn * BM + wc * 32 + 8 * fq;
#pragma unroll
        for (int ai = 0; ai < 2; ++ai)
#pragma unroll
            for (int m = 0; m < 4; ++m) { bf16_t* rowp = O + (size_t)(row0 + ai * HALF + m * 16) * ldc + col0;
#pragma unroll
                for (int bj = 0; bj < 2; ++bj) { const f32x4 v0 = acc[ai][bj][m][0], v1 = acc[ai][bj][m][1];
                    u32x4 w; w.x = cvt_pk_bf16(v0[0], v0[1]); w.y = cvt_pk_bf16(v0[2], v0[3]); w.z = cvt_pk_bf16(v1[0], v1[1]); w.w = cvt_pk_bf16(v1[2], v1[3]);
                    *(u32x4*)(rowp + bj * HALF) = w; } }
    }
};
struct EpiSwiGLU {
    static constexpr bool PERM = true, AFTER_DRAIN = false;
    bf16_t* O; int ldc;
    __device__ __forceinline__ void operator()(const f32x4 (&acc)[2][2][4][2], const Unit& u, int wr, int wc, int fr, int fq) const {
        const int row0 = u.pm * BM + wr * 64 + fr, col0 = u.pn * HALF + wc * 32 + 8 * fq;
#pragma unroll
        for (int ai = 0; ai < 2; ++ai)
#pragma unroll
            for (int m = 0; m < 4; ++m) { bf16_t* rowp = O + (size_t)(row0 + ai * HALF + m * 16) * ldc + col0;
                const f32x4 g0 = acc[ai][0][m][0], g1 = acc[ai][0][m][1], u0 = acc[ai][1][m][0], u1 = acc[ai][1][m][1];
                float a[8];
#pragma unroll
                for (int i = 0; i < 4; ++i) { a[i] = silu_f(g0[i]) * u0[i]; a[4 + i] = silu_f(g1[i]) * u1[i]; }
                u32x4 w; w.x = cvt_pk_bf16(a[0], a[1]); w.y = cvt_pk_bf16(a[2], a[3]); w.z = cvt_pk_bf16(a[4], a[5]); w.w = cvt_pk_bf16(a[6], a[7]);
                *(u32x4*)rowp = w; }
    }
};
struct EpiGateRes {
    static constexpr bool PERM = false, AFTER_DRAIN = false;
    const float* base; float* out; int ldc; const float* gate; int gstride; int rows_per_batch;
    __device__ __forceinline__ void operator()(const f32x4 (&acc)[2][2][4][2], const Unit& u, int wr, int wc, int fr, int fq) const {
        const int row0 = u.pm * BM + wr * 64 + fr, col0 = u.pn * BM + wc * 32 + 4 * fq;
        const float* gp = gate + (size_t)((u.pm * BM) / rows_per_batch) * gstride + col0;
        f32x4 gv[2][2];
#pragma unroll
        for (int bj = 0; bj < 2; ++bj)
#pragma unroll
            for (int n = 0; n < 2; ++n) gv[bj][n] = *(const f32x4*)(gp + bj * HALF + n * 16);
#pragma unroll
        for (int ai = 0; ai < 2; ++ai)
#pragma unroll
            for (int m = 0; m < 4; ++m) { const size_t off = (size_t)(row0 + ai * HALF + m * 16) * ldc + col0;
#pragma unroll
                for (int bj = 0; bj < 2; ++bj)
#pragma unroll
                    for (int n = 0; n < 2; ++n) { const f32x4 bs = *(const f32x4*)(base + off + bj * HALF + n * 16);
                        *(f32x4*)(out + off + bj * HALF + n * 16) = bs + gv[bj][n] * acc[ai][bj][m][n]; } }
    }
};

template <class Epi, class Sched, bool ALIGN_EPI = false, bool SP2 = false>
__device__ __forceinline__ void gemm_phase(PG8_LAS unsigned char* lds, const Gemm g, const Sched& S, const Epi& E) {
    const int tid = threadIdx.x, wid = __builtin_amdgcn_readfirstlane(tid >> 6), lane = tid & 63, wr = wid >> 2, wc = wid & 3, fr = lane & 15, fq = lane >> 4;
    const int K = g.K, nt = K / BK;
    unsigned voffA[2], voffB[2];
#pragma unroll
    for (int i = 0; i < 2; ++i) { int R, C; stage_rc(tid * 16 + i * 8192, R, C); const int Rb = Epi::PERM ? ((R & ~31) + perm32(R & 31)) : R;
        voffA[i] = (unsigned)(R * K + C) * 2u; voffB[i] = (unsigned)(Rb * K + C) * 2u; }
    const size_t kstep = (size_t)(BK * 2);
    const size_t hstep = (size_t)HALF * K * 2;
    const size_t tstep = 2 * hstep;
    const unsigned ldsw = (unsigned)wid * 1024u;
    const int aoff = lds_byte(wr * 64 + fr, fq * 8), boff = lds_byte(wc * 32 + fr, fq * 8);
#define PG8_SA(b, h) (((b) * 2 + (h)) * HTB)
#define PG8_SB(b, h) ((4 + (b) * 2 + (h)) * HTB)
#define PG8_STAGE(bufoff, gbase, voff) do { _Pragma("unroll") for (int _i = 0; _i < 2; ++_i) \
        __builtin_amdgcn_global_load_lds((const unsigned*)((const char*)(gbase) + (voff)[_i]), (PG8_LAS unsigned*)(lds + (bufoff) + ldsw + _i * 8192), 16, 0, 0); } while (0)
#define PG8_LDA(dst, b, h) do { _Pragma("unroll") for (int m = 0; m < 4; ++m) _Pragma("unroll") for (int k = 0; k < 2; ++k) dst[m][k] = *(const PG8_LAS bf16x8*)(lds + PG8_SA(b, h) + aoff + m * 2048 + k * 1024); } while (0)
#define PG8_LDB(dst, b, h) do { _Pragma("unroll") for (int n = 0; n < 2; ++n) _Pragma("unroll") for (int k = 0; k < 2; ++k) dst[n][k] = *(const PG8_LAS bf16x8*)(lds + PG8_SB(b, h) + boff + n * 2048 + k * 1024); } while (0)
#define PG8_MMA(ai, bj, At, Bt) do { __builtin_amdgcn_s_setprio(1); _Pragma("unroll") for (int m = 0; m < 4; ++m) _Pragma("unroll") for (int n = 0; n < 2; ++n) _Pragma("unroll") for (int k = 0; k < 2; ++k) \
        acc[ai][bj][m][n] = __builtin_amdgcn_mfma_f32_16x16x32_bf16(Bt[n][k], At[m][k], acc[ai][bj][m][n], 0, 0, 0); __builtin_amdgcn_s_setprio(0); } while (0)
#define PG8_WAIT_V(n) asm volatile("s_waitcnt vmcnt(" #n ")" ::: "memory")
#define PG8_WAIT_L(n) asm volatile("s_waitcnt lgkmcnt(" #n ")" ::: "memory")
#define PG8_BAR __builtin_amdgcn_s_barrier()
#define PG8_SCHED __builtin_amdgcn_sched_barrier(0)
    Unit cur, nxt; int ui = 0;
    if (!S.next(0, cur)) return;
    f32x4 acc[2][2][4][2];
#pragma unroll
    for (int a = 0; a < 2; ++a)
#pragma unroll
        for (int b = 0; b < 2; ++b)
#pragma unroll
            for (int m = 0; m < 4; ++m)
#pragma unroll
                for (int n = 0; n < 2; ++n) acc[a][b][m][n] = (f32x4){0.f, 0.f, 0.f, 0.f};
    bf16x8 At[4][2], B0[2][2], B1[2][2];
    const char* cA = (const char*)g.A + (size_t)cur.pm * tstep; const char* cB = (const char*)g.Bt + (size_t)cur.pn * tstep;
    S.a_ready(cur);
    if constexpr (SP2) {
        PG8_STAGE(PG8_SB(0, 0), cB, voffB); PG8_STAGE(PG8_SB(0, 1), cB + hstep, voffB); PG8_STAGE(PG8_SA(0, 0), cA, voffA); PG8_STAGE(PG8_SA(0, 1), cA + hstep, voffA);
        if (wr == 1) PG8_BAR;
        PG8_WAIT_V(2); PG8_BAR;
        PG8_STAGE(PG8_SB(1, 0), cB + kstep, voffB); PG8_STAGE(PG8_SA(1, 0), cA + kstep, voffA); PG8_STAGE(PG8_SB(1, 1), cB + hstep + kstep, voffB);
        PG8_WAIT_V(6); PG8_BAR;
    } else {
        PG8_STAGE(PG8_SB(0, 0), cB, voffB); PG8_STAGE(PG8_SA(0, 0), cA, voffA); PG8_STAGE(PG8_SB(0, 1), cB + hstep, voffB); PG8_STAGE(PG8_SA(0, 1), cA + hstep, voffA);
        if (wr == 1) PG8_BAR;
        PG8_WAIT_V(4); PG8_BAR;
        PG8_STAGE(PG8_SB(1, 0), cB + kstep, voffB); PG8_STAGE(PG8_SA(1, 0), cA + kstep, voffA); PG8_STAGE(PG8_SB(1, 1), cB + hstep + kstep, voffB);
        PG8_WAIT_V(6); PG8_BAR;
    }
    for (;;) {
        const bool has_next = S.next(ui + 1, nxt);
        const char* nA = has_next ? (const char*)g.A + (size_t)nxt.pm * tstep : cA; const char* nB = has_next ? (const char*)g.Bt + (size_t)nxt.pn * tstep : cB;
        for (int t = 0; t < nt; t += 2) {
            const bool last = (t == nt - 2);
            const char* a1 = cA + (size_t)(t + 1) * kstep;
            const char* a2 = last ? nA : cA + (size_t)(t + 2) * kstep; const char* b2 = last ? nB : cB + (size_t)(t + 2) * kstep;
            const char* a3 = a2 + kstep; const char* b3 = b2 + kstep;
            if (last && has_next) S.a_ready(nxt);
            if constexpr (SP2) {
            PG8_LDB(B0, 0, 0); PG8_LDB(B1, 0, 1); PG8_SCHED; PG8_LDA(At, 0, 0); PG8_STAGE(PG8_SA(1, 1), a1 + hstep, voffA);
            PG8_WAIT_V(8); PG8_WAIT_L(0); PG8_BAR; PG8_MMA(0, 0, At, B0); PG8_MMA(0, 1, At, B1); PG8_BAR; PG8_SCHED;
            PG8_LDA(At, 0, 1); PG8_STAGE(PG8_SB(0, 0), b2, voffB); PG8_STAGE(PG8_SB(0, 1), b2 + hstep, voffB); PG8_STAGE(PG8_SA(0, 0), a2, voffA);
            PG8_WAIT_V(8); PG8_WAIT_L(0); PG8_BAR; PG8_MMA(1, 0, At, B0); PG8_MMA(1, 1, At, B1); PG8_BAR; PG8_SCHED;
            PG8_LDB(B0, 1, 0); PG8_LDB(B1, 1, 1); PG8_SCHED; PG8_LDA(At, 1, 0); PG8_STAGE(PG8_SA(0, 1), a2 + hstep, voffA);
            PG8_WAIT_V(8); PG8_WAIT_L(0); PG8_BAR; PG8_MMA(0, 0, At, B0); PG8_MMA(0, 1, At, B1); PG8_BAR; PG8_SCHED;
            PG8_LDA(At, 1, 1); PG8_STAGE(PG8_SB(1, 0), b3, voffB); PG8_STAGE(PG8_SB(1, 1), b3 + hstep, voffB); PG8_STAGE(PG8_SA(1, 0), a3, voffA);
            PG8_WAIT_V(8); PG8_WAIT_L(0); PG8_BAR; PG8_MMA(1, 0, At, B0); PG8_MMA(1, 1, At, B1); PG8_BAR; PG8_SCHED;
            } else {
            PG8_LDB(B0, 0, 0); PG8_SCHED; PG8_LDA(At, 0, 0); PG8_STAGE(PG8_SA(1, 1), a1 + hstep, voffA);
            PG8_WAIT_L(8); PG8_BAR; PG8_WAIT_L(0); PG8_MMA(0, 0, At, B0); PG8_BAR; PG8_SCHED;
            PG8_LDB(B1, 0, 1); PG8_STAGE(PG8_SB(0, 0), b2, voffB);
            PG8_BAR; PG8_WAIT_L(0); PG8_MMA(0, 1, At, B1); PG8_BAR;
            PG8_LDA(At, 0, 1); PG8_STAGE(PG8_SA(0, 0), a2, voffA);
            PG8_BAR; PG8_WAIT_L(0); PG8_MMA(1, 0, At, B0); PG8_BAR; PG8_SCHED;
            PG8_STAGE(PG8_SB(0, 1), b2 + hstep, voffB);
            PG8_WAIT_V(6); PG8_BAR; PG8_MMA(1, 1, At, B1); PG8_BAR;
            PG8_LDB(B0, 1, 0); PG8_SCHED; PG8_LDA(At, 1, 0); PG8_STAGE(PG8_SA(0, 1), a2 + hstep, voffA);
            PG8_WAIT_L(8); PG8_BAR; PG8_WAIT_L(0); PG8_MMA(0, 0, At, B0); PG8_BAR; PG8_SCHED;
            PG8_LDB(B1, 1, 1); PG8_STAGE(PG8_SB(1, 0), b3, voffB);
            PG8_BAR; PG8_WAIT_L(0); PG8_MMA(0, 1, At, B1); PG8_BAR;
            PG8_LDA(At, 1, 1); PG8_STAGE(PG8_SA(1, 0), a3, voffA);
            PG8_BAR; PG8_WAIT_L(0); PG8_MMA(1, 0, At, B0); PG8_BAR; PG8_SCHED;
            PG8_STAGE(PG8_SB(1, 1), b3 + hstep, voffB);
            PG8_WAIT_V(6); PG8_BAR; PG8_MMA(1, 1, At, B1); PG8_BAR;
            }
        }
        if constexpr (ALIGN_EPI) { if (wr == 0) PG8_BAR; }
        if constexpr (!Epi::AFTER_DRAIN) { E(acc, cur, wr, wc, fr, fq); S.done(cur); }
        if (!has_next) break;
#pragma unroll
        for (int a = 0; a < 2; ++a)
#pragma unroll
            for (int b = 0; b < 2; ++b)
#pragma unroll
                for (int m = 0; m < 4; ++m)
#pragma unroll
                    for (int n = 0; n < 2; ++n) acc[a][b][m][n] = (f32x4){0.f, 0.f, 0.f, 0.f};
        cur = nxt; cA = nA; cB = nB; ++ui;
        if constexpr (ALIGN_EPI) { if (wr == 1) PG8_BAR; }
    }
    PG8_WAIT_V(0);
    if constexpr (!ALIGN_EPI) { if (wr == 0) PG8_BAR; }
    PG8_BAR;
    if constexpr (Epi::AFTER_DRAIN) { E.fused(acc, cur, wr, wc, fr, fq, lds, wid, lane); S.done(cur); }
#undef PG8_SA
#undef PG8_SB
#undef PG8_STAGE
#undef PG8_LDA
#undef PG8_LDB
#undef PG8_MMA
#undef PG8_WAIT_V
#undef PG8_WAIT_L
#undef PG8_BAR
#undef PG8_SCHED
}
}
constexpr int NWAVES = 8;
constexpr int BATCH = 4, T = 4096, D = 1024, M = BATCH * T;
constexpr int PROJ_W = 2832, NP = 2816, FF = 2816, NGU = 2 * FF, HD = 64;
constexpr int C_GQ = 0, C_GK = 512, C_GV = 1024, C_GZ = 1536, C_SQ = 2048, C_SK = 2560, C_SV = 2688;
constexpr float EPS = 1e-6f;
constexpr size_t MiB = 1u << 20;
constexpr size_t WS_CTL = 0, CTL_ZERO_BYTES = 1 * MiB;
constexpr size_t WS_MODF = 1 * MiB;
constexpr size_t WS_WAB = 1 * MiB + 256 * 1024;
constexpr size_t WS_GB = 2 * MiB;
constexpr size_t WS_WIN = 4 * MiB, WS_WOUT = 10 * MiB, WS_WGU = 12 * MiB, WS_WDN = 24 * MiB;
constexpr size_t WS_H = 32 * MiB;
constexpr size_t WS_PQ = 64 * MiB;
constexpr size_t WS_MIX = 160 * MiB;
constexpr size_t WS_CHKA = 192 * MiB;
constexpr size_t WS_DEC = 1 * MiB + 384 * 1024;
constexpr size_t WS_END = 256 * MiB;
constexpr int CW_BAR = 4096;
constexpr int CW_MODACC = 16384;
constexpr int RING_OFF = 0, RING_BYTES = 131072;
constexpr int LDSCTL_OFF = RING_BYTES, MISC_OFF = LDSCTL_OFF + 320;
constexpr int LDS_BYTES = 147456;
#define GAS __attribute__((address_space(1)))
#define LAS __attribute__((address_space(3)))
typedef unsigned short bf16;
typedef unsigned v4u __attribute__((ext_vector_type(4)));
typedef float f32x4 __attribute__((ext_vector_type(4)));
typedef short bf16x8 __attribute__((ext_vector_type(8)));
typedef GAS unsigned gu32;
typedef GAS unsigned long long gu64;
#define RLX_AGENT __ATOMIC_RELAXED, __HIP_MEMORY_SCOPE_AGENT
#define LDS_WAIT() asm volatile("s_waitcnt lgkmcnt(0)" ::: "memory")
#define VM_WAIT() asm volatile("s_waitcnt vmcnt(0)" ::: "memory")
__device__ __forceinline__ unsigned long long rt() { return __builtin_amdgcn_s_memrealtime(); }
__device__ __forceinline__ unsigned f2bf(float f) { unsigned u = __builtin_bit_cast(unsigned, f); return (u + 0x7fffu + ((u >> 16) & 1u)) >> 16; }
__device__ __forceinline__ unsigned pk2(float lo, float hi) { return f2bf(lo) | (f2bf(hi) << 16); }

#define XB_TMO      128
#define XB_XCNT(j)  (256  + 64 * (j))
#define XB_XSUB(j)  (1280 + 64 * (j))
#define XB_XGEN(j)  (2304 + 64 * (j))
#define XB_TOP      3328
#define XB_TOPGEN   3392
#define XCD_BAR_WORDS 3456
#define XB_SPIN_CAP (1u << 22)

__device__ __forceinline__ unsigned xb_ld(unsigned* p)              { return __hip_atomic_load(p, __ATOMIC_RELAXED, __HIP_MEMORY_SCOPE_AGENT); }
__device__ __forceinline__ unsigned xb_add(unsigned* p, unsigned v) { return __hip_atomic_fetch_add(p, v, __ATOMIC_RELAXED, __HIP_MEMORY_SCOPE_AGENT); }
__device__ __forceinline__ unsigned xb_xcc_id() { return (unsigned)__builtin_amdgcn_s_getreg((3 << 11) | 20) & 0xFu; }
#define XB_SPIN(cond, bar) do { unsigned _sp = 0; while (cond) { __builtin_amdgcn_s_sleep(1); \
    if ((++_sp & 255u) == 0u) { if (xb_ld(&(bar)[XB_TMO])) break; if (_sp > XB_SPIN_CAP) { atomicAdd(&(bar)[XB_TMO], 1u); break; } } } } while (0)

struct XcdBarrier {
    unsigned* bar; unsigned x;
    volatile LAS unsigned* st;
};

__device__ __forceinline__ XcdBarrier xcd_barrier_post(unsigned* bar, volatile LAS unsigned* st) {
    XcdBarrier b; b.bar = bar; b.x = xb_xcc_id(); b.st = st;
    if (threadIdx.x == 0) (void)xb_add(&bar[XB_XCNT(b.x)], 1u);
    return b;
}
__device__ __forceinline__ void xcd_barrier_complete(unsigned* bar, unsigned x, unsigned& nloc, unsigned& nx) {
    const unsigned G = gridDim.x * gridDim.y * gridDim.z;
    unsigned sum, cnt, mine, sp = 0u;
    for (;;) {
        sum = 0u; cnt = 0u; mine = 0u;
#pragma unroll
        for (unsigned j = 0; j < 16; ++j) { const unsigned c = xb_ld(&bar[XB_XCNT(j)]); sum += c; cnt += (c > 0u) ? 1u : 0u; mine = (j == x) ? c : mine; }
        if (sum == G) break;
        __builtin_amdgcn_s_sleep(1);
        if ((++sp & 255u) == 0u) { if (xb_ld(&bar[XB_TMO])) break; if (sp > XB_SPIN_CAP) { atomicAdd(&bar[XB_TMO], 1u); break; } }
    }
    nloc = mine > 0u ? mine : 1u; nx = cnt > 0u ? cnt : 1u;
}

__device__ __forceinline__ void xcd_barrier(const XcdBarrier& b) {
    asm volatile("s_waitcnt vmcnt(0)" ::: "memory");
    __syncthreads();
    if (threadIdx.x == 0) {
        unsigned* bar = b.bar;
        __builtin_amdgcn_s_waitcnt(0);
        unsigned nloc = b.st[0], nx = b.st[1];
        if (nloc == 0u) { xcd_barrier_complete(bar, b.x, nloc, nx); b.st[0] = nloc; b.st[1] = nx; }
        const unsigned old = xb_add(&bar[XB_XSUB(b.x)], 1u);
        const unsigned gen = old / nloc;
        if (old + 1u == (gen + 1u) * nloc) {
            __builtin_amdgcn_fence(__ATOMIC_RELEASE, "agent");
            asm volatile("s_waitcnt vmcnt(0)" ::: "memory");
            const unsigned og = xb_add(&bar[XB_TOP], 1u);
            const unsigned tg = og / nx;
            if (og + 1u == (tg + 1u) * nx) xb_add(&bar[XB_TOPGEN], 1u);
            else XB_SPIN(xb_ld(&bar[XB_TOPGEN]) == tg, bar);
            __builtin_amdgcn_fence(__ATOMIC_ACQUIRE, "agent");
            xb_add(&bar[XB_XGEN(b.x)], 1u);
            asm volatile("s_waitcnt vmcnt(0)" ::: "memory");
        } else {
            XB_SPIN(xb_ld(&bar[XB_XGEN(b.x)]) == gen, bar);
            __builtin_amdgcn_fence(__ATOMIC_ACQUIRE, "agent");
            asm volatile("s_waitcnt vmcnt(0)" ::: "memory");
        }
    }
    __syncthreads();
}
struct Frame {
    LAS unsigned char* lds;
    volatile LAS unsigned* MISC;
    gu32* ctl;
    int tid, lane, wave;
    int vcu, G;
    const float *x, *c, *w_ada, *b_ada, *norm1_w, *w_in, *conv_w, *a_log, *dt_bias, *gdn_norm_w, *q_norm_w, *k_norm_w, *sinks, *w_out, *norm2_w, *w_gate, *w_up, *w_down;
    float* out;
    float *modacc, *modf, *wab, *gb, *dec;
    bf16 *Win_t, *Wout_t, *Wgu_t, *Wdn_t, *H, *PQ, *MIX, *CHKA, *CHKU;
};
__device__ __forceinline__ float wave_sum(float v) {
#pragma unroll
    for (int o = 1; o < 64; o <<= 1) v += __shfl_xor(v, o);
    return v;
}
__device__ __forceinline__ float wave_max(float v) {
#pragma unroll
    for (int o = 1; o < 64; o <<= 1) v = fmaxf(v, __shfl_xor(v, o));
    return v;
}
__device__ __forceinline__ float bf2f(bf16 h) { return __uint_as_float((unsigned)h << 16); }
__device__ __forceinline__ float ld_f32_coh(const float* p) { return __uint_as_float(__hip_atomic_load((const unsigned*)p, RLX_AGENT)); }
__device__ __forceinline__ float silu(float x) { return x / (1.0f + __expf(-x)); }

__device__ __forceinline__ void tr_item(const float* W, int ldw, int src_col, bf16* WT, int K, int dst_row, int k0, LAS float* scr, int lane) {
#pragma unroll 8
    for (int i = 0; i < 32; ++i) { const int kk = 2 * i + (lane >> 5); scr[kk * 33 + (lane & 31)] = W[(size_t)(k0 + kk) * ldw + src_col + (lane & 31)]; }
    LDS_WAIT(); asm volatile("" ::: "memory");
    const int c = lane & 7;
#pragma unroll
    for (int j = 0; j < 4; ++j) { const int n = (lane >> 3) + 8 * j; const LAS float* s = scr + (8 * c) * 33 + n;
        v4u o; o.x = pk2(s[0 * 33], s[1 * 33]); o.y = pk2(s[2 * 33], s[3 * 33]); o.z = pk2(s[4 * 33], s[5 * 33]); o.w = pk2(s[6 * 33], s[7 * 33]);
        *(GAS v4u*)(WT + (size_t)(dst_row + n) * K + k0 + 8 * c) = o; }
    LDS_WAIT(); asm volatile("" ::: "memory");
}

__device__ __forceinline__ void p0_prologue(Frame& F) {
    LAS float* scr = (LAS float*)(F.lds + RING_OFF + F.wave * 16384);
    const int gw = F.vcu * NWAVES + F.wave, NGW = F.G * NWAVES, lane = F.lane;
    constexpr int I_ADA = 24 * 16, I_AB = 16, I_IN = 16 * (NP / 32), I_OUT = 16 * 32, I_GU = 16 * (NGU / 32), I_DN = (FF / 64) * 32;
    constexpr int NITEMS = I_ADA + I_AB + I_IN + I_OUT + I_GU + I_DN;
    for (int it = gw; it < NITEMS; it += NGW) {
        int r = it;
        if (r < I_ADA) {
            const int ct = r % 24, ks = r / 24, col = ct * 256 + lane, k0 = ks * 64;
            float acc[4][4];
#pragma unroll
            for (int j = 0; j < 4; ++j)
#pragma unroll
                for (int b = 0; b < 4; ++b) acc[j][b] = 0.f;
#pragma unroll 4
            for (int kk = 0; kk < 64; ++kk) { const int k = k0 + kk; float cb[4];
#pragma unroll
                for (int b = 0; b < 4; ++b) cb[b] = silu(F.c[b * D + k]);
#pragma unroll
                for (int j = 0; j < 4; ++j) { const float w = F.w_ada[(size_t)k * (6 * D) + col + 64 * j];
#pragma unroll
                    for (int b = 0; b < 4; ++b) acc[j][b] += cb[b] * w; } }
#pragma unroll
            for (int j = 0; j < 4; ++j)
#pragma unroll
                for (int b = 0; b < 4; ++b) atomicAdd(F.modacc + b * (6 * D) + col + 64 * j, acc[j][b]);
            continue;
        }
        r -= I_ADA;
        if (r < I_AB) {
            for (int i = 0; i < 16; ++i) { const int k = i * 64 + lane; F.wab[r * D + k] = F.w_in[(size_t)k * PROJ_W + 2048 + r]; }
            continue;
        }
        r -= I_AB;
        if (r < I_IN) { const int nb = r % (NP / 32), kb = r / (NP / 32), n0 = 32 * nb; tr_item(F.w_in, PROJ_W, n0 < 2048 ? n0 : n0 + 16, F.Win_t, D, n0, 64 * kb, scr, lane); continue; }
        r -= I_IN;
        if (r < I_OUT) { const int nb = r % 32, kb = r / 32; tr_item(F.w_out, D, 32 * nb, F.Wout_t, D, 32 * nb, 64 * kb, scr, lane); continue; }
        r -= I_OUT;
        if (r < I_GU) { const int nb = r % (NGU / 32), kb = r / (NGU / 32), n0 = 32 * nb, p = n0 >> 8, j = n0 & 255;
            if (j < 128) tr_item(F.w_gate, FF, 128 * p + j, F.Wgu_t, D, n0, 64 * kb, scr, lane);
            else         tr_item(F.w_up,   FF, 128 * p + j - 128, F.Wgu_t, D, n0, 64 * kb, scr, lane);
            continue; }
        r -= I_GU;
        { const int nb = r % 32, kb = r / 32; tr_item(F.w_down, D, 32 * nb, F.Wdn_t, FF, 32 * nb, 64 * kb, scr, lane); }
    }
}

template <int WHICH> __device__ __forceinline__ void norm_phase(Frame& F) {
    const int gw = F.vcu * NWAVES + F.wave, NGW = F.G * NWAVES, lane = F.lane;
    if (WHICH == 1) {
        for (int idx = gw * 64 + lane; idx < 4 * 6 * D; idx += NGW * 64) F.modf[idx] = ld_f32_coh(F.modacc + idx) + F.b_ada[idx % (6 * D)];
    }
    const float* src = (WHICH == 1) ? F.x : F.out;
    const float* nw = (WHICH == 1) ? F.norm1_w : F.norm2_w;
    for (int m0 = gw * 4; m0 < M; m0 += NGW * 4) {
        const int b = m0 / T;
        float gm[16], sh[16];
#pragma unroll
        for (int i = 0; i < 4; ++i)
#pragma unroll
            for (int e = 0; e < 4; ++e) { const int c = 256 * i + 4 * lane + e; float sc, sf;
                if (WHICH == 1) { sf = ld_f32_coh(F.modacc + b * 6 * D + c) + F.b_ada[c]; sc = ld_f32_coh(F.modacc + b * 6 * D + D + c) + F.b_ada[D + c]; }
                else { sf = F.modf[b * 6 * D + 3 * D + c]; sc = F.modf[b * 6 * D + 4 * D + c]; }
                gm[4 * i + e] = nw[c] * (1.0f + sc); sh[4 * i + e] = sf; }
        float h[4][16];
#pragma unroll
        for (int r = 0; r < 4; ++r) {
            const GAS f32x4* xr = (const GAS f32x4*)(src + (size_t)(m0 + r) * D) + lane;
            f32x4 v[4]; float ss = 0.f;
#pragma unroll
            for (int i = 0; i < 4; ++i) { v[i] = xr[64 * i]; ss += (v[i].x * v[i].x + v[i].y * v[i].y) + (v[i].z * v[i].z + v[i].w * v[i].w); }
            const float rstd = 1.0f / sqrtf(wave_sum(ss) * (1.0f / D) + EPS);
            GAS unsigned long long* o8 = (GAS unsigned long long*)(F.H + (size_t)(m0 + r) * D) + lane;
#pragma unroll
            for (int i = 0; i < 4; ++i) {
                const float a0 = v[i].x * rstd * gm[4 * i + 0] + sh[4 * i + 0], a1 = v[i].y * rstd * gm[4 * i + 1] + sh[4 * i + 1];
                const float a2 = v[i].z * rstd * gm[4 * i + 2] + sh[4 * i + 2], a3 = v[i].w * rstd * gm[4 * i + 3] + sh[4 * i + 3];
                h[r][4 * i + 0] = a0; h[r][4 * i + 1] = a1; h[r][4 * i + 2] = a2; h[r][4 * i + 3] = a3;
                o8[64 * i] = (unsigned long long)pk2(a0, a1) | ((unsigned long long)pk2(a2, a3) << 32); }
        }
        if (WHICH == 1) {
            float myv = 0.f;
            for (int j = 0; j < 16; ++j) {
                const GAS f32x4* wp = (const GAS f32x4*)(F.wab + j * D) + lane;
                f32x4 wv[4];
#pragma unroll
                for (int i = 0; i < 4; ++i) wv[i] = wp[64 * i];
#pragma unroll
                for (int r = 0; r < 4; ++r) { float p = 0.f;
#pragma unroll
                    for (int i = 0; i < 4; ++i) p += (h[r][4 * i] * wv[i].x + h[r][4 * i + 1] * wv[i].y) + (h[r][4 * i + 2] * wv[i].z + h[r][4 * i + 3] * wv[i].w);
                    p = wave_sum(p);
                    if (lane == r * 16 + j) myv = p; }
            }
            const int j = lane & 15, hh = j & 7;
            float val;
            if (j < 8) { const float xx = myv + F.dt_bias[hh]; const float sp = fmaxf(xx, 0.f) + log1pf(__expf(-fabsf(xx))); val = -__expf(F.a_log[hh]) * sp; }
            else val = 1.0f / (1.0f + __expf(-myv));
            F.gb[(size_t)m0 * 16 + lane] = val;
        }
    }
}

__device__ __forceinline__ void gdn_wave(Frame& F, int bh, LAS float* scr) {
    const int lane = F.lane, b = bh >> 3, hh = bh & 7;
    float S[64];
#pragma unroll
    for (int d = 0; d < 64; ++d) S[d] = 0.f;
    float wq[4], wk[4], wv[4];
#pragma unroll
    for (int j = 0; j < 4; ++j) { wq[j] = F.conv_w[j * 1536 + hh * 64 + lane]; wk[j] = F.conv_w[j * 1536 + 512 + hh * 64 + lane]; wv[j] = F.conv_w[j * 1536 + 1024 + hh * 64 + lane]; }
    const float nwg = F.gdn_norm_w[lane];
    float xq0 = 0.f, xq1 = 0.f, xq2 = 0.f, xk0 = 0.f, xk1 = 0.f, xk2 = 0.f, xv0 = 0.f, xv1 = 0.f, xv2 = 0.f;
    const size_t row0 = (size_t)b * T;
    const bf16* pq = F.PQ + row0 * NP + hh * 64 + lane;
    bf16 nq = pq[C_GQ], nk = pq[C_GK], nv = pq[C_GV], nz = pq[C_GZ];
    float ng = ld_f32_coh(F.gb + row0 * 16 + hh), nb = ld_f32_coh(F.gb + row0 * 16 + 8 + hh);
    for (int t = 0; t < T; ++t) {
        const float rq = bf2f(nq), rk = bf2f(nk), rv = bf2f(nv), rz = bf2f(nz), g = ng, beta = nb;
        if (t + 1 < T) { const bf16* p2 = pq + (size_t)(t + 1) * NP; nq = p2[C_GQ]; nk = p2[C_GK]; nv = p2[C_GV]; nz = p2[C_GZ];
            ng = ld_f32_coh(F.gb + (row0 + t + 1) * 16 + hh); nb = ld_f32_coh(F.gb + (row0 + t + 1) * 16 + 8 + hh); }
        float cq = wq[0] * xq0 + wq[1] * xq1 + wq[2] * xq2 + wq[3] * rq;
        float ck = wk[0] * xk0 + wk[1] * xk1 + wk[2] * xk2 + wk[3] * rk;
        float cv = wv[0] * xv0 + wv[1] * xv1 + wv[2] * xv2 + wv[3] * rv;
        xq0 = xq1; xq1 = xq2; xq2 = rq; xk0 = xk1; xk1 = xk2; xk2 = rk; xv0 = xv1; xv1 = xv2; xv2 = rv;
        cq = silu(cq); ck = silu(ck); cv = silu(cv);
        const float qn = cq / sqrtf(wave_sum(cq * cq) + EPS), kn = ck / sqrtf(wave_sum(ck * ck) + EPS);
        scr[lane] = kn; scr[64 + lane] = qn;
        LDS_WAIT(); asm volatile("" ::: "memory");
        const float a = __expf(g);
        float kd = 0.f;
#pragma unroll
        for (int d4 = 0; d4 < 16; ++d4) { const f32x4 kv = *(const LAS f32x4*)(scr + 4 * d4);
            kd += kv.x * S[4 * d4]; kd += kv.y * S[4 * d4 + 1]; kd += kv.z * S[4 * d4 + 2]; kd += kv.w * S[4 * d4 + 3]; }
        const float cc = beta * (cv - a * kd);
        float o = 0.f;
#pragma unroll
        for (int d4 = 0; d4 < 16; ++d4) { const f32x4 kv = *(const LAS f32x4*)(scr + 4 * d4); const f32x4 qv = *(const LAS f32x4*)(scr + 64 + 4 * d4);
            S[4 * d4] = a * S[4 * d4] + cc * kv.x; o += qv.x * S[4 * d4];
            S[4 * d4 + 1] = a * S[4 * d4 + 1] + cc * kv.y; o += qv.y * S[4 * d4 + 1];
            S[4 * d4 + 2] = a * S[4 * d4 + 2] + cc * kv.z; o += qv.z * S[4 * d4 + 2];
            S[4 * d4 + 3] = a * S[4 * d4 + 3] + cc * kv.w; o += qv.w * S[4 * d4 + 3]; }
        LDS_WAIT(); asm volatile("" ::: "memory");
        o *= 0.125f;
        const float on = o / sqrtf(wave_sum(o * o) * (1.0f / 64.0f) + EPS) * nwg * silu(rz);
        F.MIX[(row0 + t) * D + hh * 64 + lane] = (bf16)f2bf(on);
    }
}
__device__ __forceinline__ void swa_query(Frame& F, int item, LAS float* scr) {
    const int lane = F.lane, t = item & (T - 1), hq = (item >> 12) & 7, b = item >> 15, kvh = hq >> 2;
    const size_t row0 = (size_t)b * T;
    const float qraw = bf2f(F.PQ[(row0 + t) * NP + C_SQ + hq * 64 + lane]);
    const float qn = qraw / sqrtf(wave_sum(qraw * qraw) * (1.0f / 64.0f) + EPS) * F.q_norm_w[lane];
    scr[lane] = qn * F.k_norm_w[lane];
    LDS_WAIT(); asm volatile("" ::: "memory");
    const float slope = exp2f(-(float)(hq + 1)), sink = F.sinks[hq];
    float sc[2];
#pragma unroll
    for (int jj = 0; jj < 2; ++jj) {
        const int s = t - 127 + lane + 64 * jj;
        float v = -INFINITY;
        if (s >= 0) {
            const GAS v4u* kp = (const GAS v4u*)(F.PQ + (row0 + s) * NP + C_SK + kvh * 64);
            float dot = 0.f, ssk = 0.f;
#pragma unroll
            for (int c8 = 0; c8 < 8; ++c8) { const v4u kk = kp[c8]; const unsigned wds[4] = {kk.x, kk.y, kk.z, kk.w};
#pragma unroll
                for (int w = 0; w < 4; ++w) { const float k0 = __uint_as_float(wds[w] << 16), k1 = __uint_as_float(wds[w] & 0xffff0000u);
                    const float q0 = scr[c8 * 8 + 2 * w], q1 = scr[c8 * 8 + 2 * w + 1];
                    dot += q0 * k0 + q1 * k1; ssk += k0 * k0 + k1 * k1; } }
            v = dot / sqrtf(ssk * (1.0f / 64.0f) + EPS) * 0.125f - slope * (float)(t - s);
        }
        sc[jj] = v;
    }
    const float mx = fmaxf(wave_max(fmaxf(sc[0], sc[1])), sink);
    const float p0 = __expf(sc[0] - mx), p1 = __expf(sc[1] - mx);
    const float den = wave_sum(p0 + p1) + __expf(sink - mx);
    LDS_WAIT(); asm volatile("" ::: "memory");
    scr[64 + lane] = p0; scr[128 + lane] = p1;
    LDS_WAIT(); asm volatile("" ::: "memory");
    float o = 0.f;
    const int s0 = t - 127;
    const bf16* vp = F.PQ + row0 * NP + C_SV + kvh * 64 + lane;
    for (int j = (s0 < 0 ? -s0 : 0); j < 128; ++j) o += scr[64 + j] * bf2f(vp[(size_t)(s0 + j) * NP]);
    LDS_WAIT(); asm volatile("" ::: "memory");
    F.MIX[(row0 + t) * D + 512 + hq * 64 + lane] = (bf16)f2bf(o / den);
}
typedef short s16x4v __attribute__((ext_vector_type(4)));
typedef float f32x2_t __attribute__((ext_vector_type(2))); typedef __bf16 bf16x2_t __attribute__((ext_vector_type(2)));
__device__ __forceinline__ unsigned cvtpk(float lo, float hi) { f32x2_t v = {lo, hi}; bf16x2_t b = __builtin_convertvector(v, bf16x2_t); return __builtin_bit_cast(unsigned, b); }
__device__ __forceinline__ float rdlane(float v, int l) { return __int_as_float(__builtin_amdgcn_readlane(__float_as_int(v), l)); }
__device__ __forceinline__ bf16x8 pack8(const f32x4 a, const f32x4 b) {
    v4u w; w.x = cvtpk(a[0], a[1]); w.y = cvtpk(a[2], a[3]); w.z = cvtpk(b[0], b[1]); w.w = cvtpk(b[2], b[3]); return __builtin_bit_cast(bf16x8, w); }

__device__ __forceinline__ void gdn_prep_chunk(Frame& F, int ci, LAS unsigned char* wl  ) {
    const int lane = F.lane, bh = ci >> 6, n = ci & 63, b = bh >> 3, hh = bh & 7, fr = lane & 15, fq = lane >> 4;
    const size_t m0 = (size_t)b * T + 64 * n;
    bf16* const cA = F.CHKA + (size_t)ci * 16384;
    bf16* const cU = F.CHKU + (size_t)ci * 4096;
    const float g = ld_f32_coh(F.gb + (m0 + lane) * 16 + hh), beta = ld_f32_coh(F.gb + (m0 + lane) * 16 + 8 + hh);
    float G = g;
#pragma unroll
    for (int o = 1; o < 64; o <<= 1) { const float t = __shfl_up(G, o); if (lane >= o) G += t; }
    const float eG = __expf(G), Glast = __shfl(G, 63), kdsc = __expf(Glast - G), beG = beta * eG;
    if (lane == 0) F.dec[ci] = __expf(Glast);
    const int offcol = ((lane >> 5) * 64 + 16 * ((lane & 15) >> 2)) * 8 + 4 * ((lane >> 4) & 1) + (lane & 3);
    LAS bf16* const Qn = (LAS bf16*)wl; LAS bf16* const Kn = (LAS bf16*)(wl + 8192);
    float xk[64];
    {
        const bf16* src = F.PQ + m0 * NP + C_GQ + hh * 64 + lane;
        const float w0 = F.conv_w[hh * 64 + lane], w1 = F.conv_w[1536 + hh * 64 + lane], w2 = F.conv_w[2 * 1536 + hh * 64 + lane], w3 = F.conv_w[3 * 1536 + hh * 64 + lane];
        float x0 = 0.f, x1 = 0.f, x2 = 0.f;
        if (n > 0) { x0 = bf2f(*(src - 3 * NP)); x1 = bf2f(*(src - 2 * NP)); x2 = bf2f(*(src - NP)); }
        bf16* qd = cA + 4096 + offcol;
#pragma unroll
        for (int c = 0; c < 64; ++c) {
            const float r = bf2f(src[(size_t)c * NP]);
            const float cq = silu(w0 * x0 + w1 * x1 + w2 * x2 + w3 * r); x0 = x1; x1 = x2; x2 = r;
            const float qn = cq / sqrtf(wave_sum(cq * cq) + EPS);
            Qn[c * 64 + lane] = (bf16)f2bf(qn);
            qd[((c >> 4) * 128 + (c & 15)) * 8] = (bf16)f2bf(qn * rdlane(eG, c) * 0.125f);
        }
    }
    {
        const bf16* src = F.PQ + m0 * NP + C_GK + hh * 64 + lane;
        const float w0 = F.conv_w[512 + hh * 64 + lane], w1 = F.conv_w[1536 + 512 + hh * 64 + lane], w2 = F.conv_w[2 * 1536 + 512 + hh * 64 + lane], w3 = F.conv_w[3 * 1536 + 512 + hh * 64 + lane];
        float x0 = 0.f, x1 = 0.f, x2 = 0.f;
        if (n > 0) { x0 = bf2f(*(src - 3 * NP)); x1 = bf2f(*(src - 2 * NP)); x2 = bf2f(*(src - NP)); }
        bf16* kdt = cA + 3 * 4096 + (lane >> 4) * 2 * 64 * 8 + (lane & 15) * 8;
        float kq[4];
#pragma unroll
        for (int c = 0; c < 64; ++c) {
            const float r = bf2f(src[(size_t)c * NP]);
            const float ck = silu(w0 * x0 + w1 * x1 + w2 * x2 + w3 * r); x0 = x1; x1 = x2; x2 = r;
            const float kn = ck / sqrtf(wave_sum(ck * ck) + EPS);
            Kn[c * 64 + lane] = (bf16)f2bf(kn);
            xk[c] = kn * rdlane(beG, c);
            kq[c & 3] = kn * rdlane(kdsc, c);
            if ((c & 3) == 3) { const int c0 = c - 3;
                unsigned long long pk = (unsigned long long)cvtpk(kq[0], kq[1]) | ((unsigned long long)cvtpk(kq[2], kq[3]) << 32);
                *(unsigned long long*)(kdt + ((c0 >> 5) * 64 + 16 * ((c0 & 15) >> 2)) * 8 + 4 * ((c0 >> 4) & 1)) = pk; }
        }
    }
    LDS_WAIT(); asm volatile("" ::: "memory");
    bf16x8 kf[4][2], qf[4][2];
#pragma unroll
    for (int blk = 0; blk < 4; ++blk)
#pragma unroll
        for (int kk = 0; kk < 2; ++kk) { kf[blk][kk] = *(const LAS bf16x8*)(Kn + (16 * blk + fr) * 64 + 32 * kk + 8 * fq); qf[blk][kk] = *(const LAS bf16x8*)(Qn + (16 * blk + fr) * 64 + 32 * kk + 8 * fq); }
    float Gcol[4], Bcol[4], Grow[4][4];
#pragma unroll
    for (int t = 0; t < 4; ++t) { Gcol[t] = __shfl(G, 16 * t + fr); Bcol[t] = __shfl(beta, 16 * t + fr);
#pragma unroll
        for (int i = 0; i < 4; ++i) Grow[t][i] = __shfl(G, 16 * t + 4 * fq + i); }
    LDS_WAIT(); asm volatile("" ::: "memory");
#pragma unroll
    for (int tc = 0; tc < 4; ++tc)
#pragma unroll
        for (int ks = 0; ks < 2; ++ks) {
            f32x4 v[2];
#pragma unroll
            for (int h2 = 0; h2 < 2; ++h2) { const int ts = 2 * ks + h2;
                if (ts <= tc) { f32x4 acc = (f32x4){0.f, 0.f, 0.f, 0.f};
                    acc = __builtin_amdgcn_mfma_f32_16x16x32_bf16(kf[ts][0], qf[tc][0], acc, 0, 0, 0); acc = __builtin_amdgcn_mfma_f32_16x16x32_bf16(kf[ts][1], qf[tc][1], acc, 0, 0, 0);
#pragma unroll
                    for (int i = 0; i < 4; ++i) { const int cidx = 16 * tc + fr, sidx = 16 * ts + 4 * fq + i; v[h2][i] = (cidx >= sidx) ? acc[i] * __expf(Gcol[tc] - Grow[ts][i]) * 0.125f : 0.f; }
                } else v[h2] = (f32x4){0.f, 0.f, 0.f, 0.f}; }
            *(bf16x8*)(cA + 2 * 4096 + ((tc * 2 + ks) * 64 + lane) * 8) = pack8(v[0], v[1]);
        }
    LAS float* const Am = (LAS float*)wl;
#pragma unroll
    for (int tc = 0; tc < 4; ++tc)
#pragma unroll
        for (int ts = 0; ts <= tc; ++ts) { f32x4 acc = (f32x4){0.f, 0.f, 0.f, 0.f};
            acc = __builtin_amdgcn_mfma_f32_16x16x32_bf16(kf[ts][0], kf[tc][0], acc, 0, 0, 0); acc = __builtin_amdgcn_mfma_f32_16x16x32_bf16(kf[ts][1], kf[tc][1], acc, 0, 0, 0);
            f32x4 a;
#pragma unroll
            for (int i = 0; i < 4; ++i) { const int cidx = 16 * tc + fr, sidx = 16 * ts + 4 * fq + i; a[i] = (cidx > sidx) ? Bcol[tc] * acc[i] * __expf(Gcol[tc] - Grow[ts][i]) : 0.f; }
            *(LAS f32x4*)(Am + (16 * tc + fr) * 64 + 16 * ts + 4 * fq) = a; }
    LDS_WAIT(); asm volatile("" ::: "memory");
    float Ar[64];
#pragma unroll
    for (int c = 1; c < 64; ++c) Ar[c] = Am[c * 64 + lane];
    LDS_WAIT(); asm volatile("" ::: "memory");
#pragma unroll
    for (int c = 1; c < 64; ++c) {
#pragma unroll
        for (int s = 0; s < c; ++s) xk[c] -= rdlane(Ar[c], s) * xk[s];
    }
    {
        bf16* wm = cA + offcol;
#pragma unroll
        for (int c = 0; c < 64; ++c) wm[((c >> 4) * 128 + (c & 15)) * 8] = (bf16)f2bf(-xk[c]);
    }
    float xv[64];
    {
        const bf16* src = F.PQ + m0 * NP + C_GV + hh * 64 + lane;
        const float w0 = F.conv_w[1024 + hh * 64 + lane], w1 = F.conv_w[1536 + 1024 + hh * 64 + lane], w2 = F.conv_w[2 * 1536 + 1024 + hh * 64 + lane], w3 = F.conv_w[3 * 1536 + 1024 + hh * 64 + lane];
        float x0 = 0.f, x1 = 0.f, x2 = 0.f;
        if (n > 0) { x0 = bf2f(*(src - 3 * NP)); x1 = bf2f(*(src - 2 * NP)); x2 = bf2f(*(src - NP)); }
#pragma unroll
        for (int c = 0; c < 64; ++c) {
            const float r = bf2f(src[(size_t)c * NP]);
            const float cv = silu(w0 * x0 + w1 * x1 + w2 * x2 + w3 * r); x0 = x1; x1 = x2; x2 = r;
            xv[c] = cv * rdlane(beta, c);
        }
    }
#pragma unroll
    for (int c = 1; c < 64; ++c) {
#pragma unroll
        for (int s = 0; s < c; ++s) xv[c] -= rdlane(Ar[c], s) * xv[s];
    }
    {
        bf16* up = cU + ((lane >> 4) * 4 * 64 + (lane & 15)) * 4;
#pragma unroll
        for (int c4 = 0; c4 < 16; ++c4) { const unsigned long long pk = (unsigned long long)cvtpk(xv[4 * c4], xv[4 * c4 + 1]) | ((unsigned long long)cvtpk(xv[4 * c4 + 2], xv[4 * c4 + 3]) << 32);
            *(unsigned long long*)(up + ((c4 >> 2) * 64 + 16 * (c4 & 3)) * 4) = pk; }
    }
    LDS_WAIT(); asm volatile("" ::: "memory");
}

#define GDN_BAR() do { asm volatile("" ::: "memory"); __builtin_amdgcn_s_barrier(); asm volatile("" ::: "memory"); } while (0)
__device__ __forceinline__ void gdn_scan(Frame& F, int bh) {
    const int lane = F.lane, wave = F.wave, b = bh >> 3, hh = bh & 7, fr = lane & 15, fq = lane >> 4;
    LAS unsigned char* const ring = F.lds + RING_OFF;
    constexpr int SLOT = 40960;
    const unsigned char* gA = (const unsigned char*)(F.CHKA + (size_t)bh * 64 * 16384);
    const unsigned char* gU = (const unsigned char*)(F.CHKU + (size_t)bh * 64 * 4096);
    if (wave >= 4) {
        const int lw = wave - 4;
#define GDN_ISSUE(nn) do { const int n_ = (nn); const int sl_ = n_ % 3; _Pragma("unroll") for (int i_ = 0; i_ < 10; ++i_) { const int p_ = lw * 10 + i_; \
            const unsigned char* s_ = (p_ < 32) ? gA + (size_t)n_ * 32768 + p_ * 1024 : gU + (size_t)n_ * 8192 + (p_ - 32) * 1024; \
            __builtin_amdgcn_global_load_lds((const unsigned*)(s_ + lane * 16), (LAS unsigned*)(ring + sl_ * SLOT + p_ * 1024), 16, 0, 0); } } while (0)
        GDN_ISSUE(0); GDN_ISSUE(1);
        asm volatile("s_waitcnt vmcnt(10)" ::: "memory"); GDN_BAR();
        for (int n = 0; n < 64; ++n) {
            if (n + 2 < 64) { GDN_ISSUE(n + 2); asm volatile("s_waitcnt vmcnt(10)" ::: "memory"); } else asm volatile("s_waitcnt vmcnt(0)" ::: "memory");
            GDN_BAR();
        }
#undef GDN_ISSUE
    } else {
        const int ew = wave;
        f32x4 Sacc[4];
#pragma unroll
        for (int t = 0; t < 4; ++t) Sacc[t] = (f32x4){0.f, 0.f, 0.f, 0.f};
        const float* decp = F.dec + bh * 64;
        float dnext = ld_f32_coh(decp);
        bf16* op = F.MIX + ((size_t)b * T + 4 * fq) * D + hh * 64 + 16 * ew + fr;
        GDN_BAR();
        for (int n = 0; n < 64; ++n) {
            const LAS unsigned char* sl = ring + (n % 3) * SLOT;
            const float dec = dnext; if (n + 1 < 64) dnext = ld_f32_coh(decp + n + 1);
            f32x4 V[4], O[4];
#pragma unroll
            for (int mt = 0; mt < 4; ++mt) { const unsigned long long uu = *(const LAS unsigned long long*)(sl + 32768 + ((ew * 4 + mt) * 64 + lane) * 8); const unsigned lo = (unsigned)uu, hi = (unsigned)(uu >> 32);
                V[mt] = (f32x4){__uint_as_float(lo << 16), __uint_as_float(lo & 0xffff0000u), __uint_as_float(hi << 16), __uint_as_float(hi & 0xffff0000u)}; O[mt] = (f32x4){0.f, 0.f, 0.f, 0.f}; }
            bf16x8 Sb[2]; Sb[0] = pack8(Sacc[0], Sacc[1]); Sb[1] = pack8(Sacc[2], Sacc[3]);
#pragma unroll
            for (int mt = 0; mt < 4; ++mt)
#pragma unroll
                for (int ks = 0; ks < 2; ++ks) { const bf16x8 wf = *(const LAS bf16x8*)(sl + ((mt * 2 + ks) * 64 + lane) * 16), qf = *(const LAS bf16x8*)(sl + 8192 + ((mt * 2 + ks) * 64 + lane) * 16);
                    V[mt] = __builtin_amdgcn_mfma_f32_16x16x32_bf16(wf, Sb[ks], V[mt], 0, 0, 0); O[mt] = __builtin_amdgcn_mfma_f32_16x16x32_bf16(qf, Sb[ks], O[mt], 0, 0, 0); }
            bf16x8 Vb[2]; Vb[0] = pack8(V[0], V[1]); Vb[1] = pack8(V[2], V[3]);
#pragma unroll
            for (int t = 0; t < 4; ++t) Sacc[t] = Sacc[t] * dec;
#pragma unroll
            for (int mt = 0; mt < 4; ++mt)
#pragma unroll
                for (int ks = 0; ks < 2; ++ks) { const bf16x8 af = *(const LAS bf16x8*)(sl + 16384 + ((mt * 2 + ks) * 64 + lane) * 16), kf = *(const LAS bf16x8*)(sl + 24576 + ((mt * 2 + ks) * 64 + lane) * 16);
                    O[mt] = __builtin_amdgcn_mfma_f32_16x16x32_bf16(af, Vb[ks], O[mt], 0, 0, 0); Sacc[mt] = __builtin_amdgcn_mfma_f32_16x16x32_bf16(kf, Vb[ks], Sacc[mt], 0, 0, 0); }
            bf16* o2 = op + (size_t)(64 * n) * D;
#pragma unroll
            for (int mt = 0; mt < 4; ++mt)
#pragma unroll
                for (int i = 0; i < 4; ++i) o2[(size_t)(16 * mt + i) * D] = (bf16)f2bf(O[mt][i]);
            LDS_WAIT(); GDN_BAR();
        }
    }
    asm volatile("s_waitcnt vmcnt(0)" ::: "memory"); GDN_BAR(); asm volatile("" ::: "memory");
    for (int idx = F.tid; idx < T * 8; idx += NWAVES * 64) {
        const int row = idx >> 3, oc = idx & 7;
        bf16* p = F.MIX + ((size_t)b * T + row) * D + hh * 64 + oc * 8;
        const v4u ov = *(const GAS v4u*)p, zv = *(const GAS v4u*)(F.PQ + ((size_t)b * T + row) * NP + C_GZ + hh * 64 + oc * 8);
        const unsigned ow[4] = {ov.x, ov.y, ov.z, ov.w}, zw[4] = {zv.x, zv.y, zv.z, zv.w};
        float o[8], z[8]; float ss = 0.f;
#pragma unroll
        for (int w = 0; w < 4; ++w) { o[2 * w] = __uint_as_float(ow[w] << 16); o[2 * w + 1] = __uint_as_float(ow[w] & 0xffff0000u); z[2 * w] = __uint_as_float(zw[w] << 16); z[2 * w + 1] = __uint_as_float(zw[w] & 0xffff0000u);
            ss += o[2 * w] * o[2 * w] + o[2 * w + 1] * o[2 * w + 1]; }
        ss += __shfl_xor(ss, 1); ss += __shfl_xor(ss, 2); ss += __shfl_xor(ss, 4);
        const float rstd = 1.0f / sqrtf(ss * (1.0f / 64.0f) + EPS);
        float r[8];
#pragma unroll
        for (int j = 0; j < 8; ++j) r[j] = o[j] * rstd * F.gdn_norm_w[oc * 8 + j] * silu(z[j]);
        v4u w4; w4.x = cvtpk(r[0], r[1]); w4.y = cvtpk(r[2], r[3]); w4.z = cvtpk(r[4], r[5]); w4.w = cvtpk(r[6], r[7]);
        *(GAS v4u*)p = w4;
    }
}
__device__ __forceinline__ void swa_unit(Frame& F, int unit, LAS unsigned char* L) {
    const int tid = F.tid, lane = F.lane, wave = F.wave, fr = lane & 15, fq = lane >> 4;
    const int blk = unit & 63, kvh = (unit >> 6) & 1, b = unit >> 7, t0 = blk * 64;
    const size_t row0 = (size_t)b * T;
    LAS bf16* const Ks = (LAS bf16*)L; LAS bf16* const Vt = (LAS bf16*)(L + 27648);
    for (int p = tid; p < 1536; p += NWAVES * 64) {
        const int key = p >> 3, oc = p & 7, s = t0 - 128 + key;
        v4u kv = (v4u){0u, 0u, 0u, 0u}, vv = (v4u){0u, 0u, 0u, 0u};
        if (s >= 0) { kv = *(const GAS v4u*)(F.PQ + (row0 + s) * NP + C_SK + kvh * 64 + oc * 8); vv = *(const GAS v4u*)(F.PQ + (row0 + s) * NP + C_SV + kvh * 64 + oc * 8); }
        const unsigned kw[4] = {kv.x, kv.y, kv.z, kv.w}, vw[4] = {vv.x, vv.y, vv.z, vv.w};
        float k[8]; float ss = 0.f;
#pragma unroll
        for (int w = 0; w < 4; ++w) { k[2 * w] = __uint_as_float(kw[w] << 16); k[2 * w + 1] = __uint_as_float(kw[w] & 0xffff0000u); ss += k[2 * w] * k[2 * w] + k[2 * w + 1] * k[2 * w + 1]; }
        ss += __shfl_xor(ss, 1); ss += __shfl_xor(ss, 2); ss += __shfl_xor(ss, 4);
        const float rstd = 1.0f / sqrtf(ss * (1.0f / 64.0f) + EPS);
#pragma unroll
        for (int j = 0; j < 8; ++j) k[j] = k[j] * rstd * F.k_norm_w[oc * 8 + j];
        v4u o; o.x = cvtpk(k[0], k[1]); o.y = cvtpk(k[2], k[3]); o.z = cvtpk(k[4], k[5]); o.w = cvtpk(k[6], k[7]);
        *(LAS v4u*)(Ks + key * 72 + oc * 8) = o;
#pragma unroll
        for (int w = 0; w < 4; ++w) { Vt[(oc * 8 + 2 * w) * 196 + key] = (bf16)(vw[w] & 0xffffu); Vt[(oc * 8 + 2 * w + 1) * 196 + key] = (bf16)(vw[w] >> 16); }
    }
    __syncthreads();
    const int hq = kvh * 4 + (wave >> 1);
    const float slope = exp2f(-(float)(hq + 1)), sink = F.sinks[hq];
#pragma unroll 1
    for (int qt = 0; qt < 2; ++qt) {
        const int tq0 = t0 + 32 * (wave & 1) + 16 * qt;
        bf16x8 qf[2];
        {
            const bf16* qp = F.PQ + (row0 + tq0 + fr) * NP + C_SQ + hq * 64 + 8 * fq;
            const v4u r0 = *(const GAS v4u*)qp, r1 = *(const GAS v4u*)(qp + 32);
            const unsigned qw[8] = {r0.x, r0.y, r0.z, r0.w, r1.x, r1.y, r1.z, r1.w};
            float q[16]; float ss = 0.f;
#pragma unroll
            for (int w = 0; w < 8; ++w) { q[2 * w] = __uint_as_float(qw[w] << 16); q[2 * w + 1] = __uint_as_float(qw[w] & 0xffff0000u); ss += q[2 * w] * q[2 * w] + q[2 * w + 1] * q[2 * w + 1]; }
            ss += __shfl_xor(ss, 16); ss += __shfl_xor(ss, 32);
            const float rstd = 0.125f / sqrtf(ss * (1.0f / 64.0f) + EPS);
#pragma unroll
            for (int kk = 0; kk < 2; ++kk) { float z[8];
#pragma unroll
                for (int j = 0; j < 8; ++j) z[j] = q[8 * kk + j] * rstd * F.q_norm_w[32 * kk + 8 * fq + j];
                v4u o; o.x = cvtpk(z[0], z[1]); o.y = cvtpk(z[2], z[3]); o.z = cvtpk(z[4], z[5]); o.w = cvtpk(z[6], z[7]); qf[kk] = __builtin_bit_cast(bf16x8, o); }
        }
        f32x4 sc[12]; float mx = -INFINITY;
#pragma unroll
        for (int nt = 0; nt < 12; ++nt) { f32x4 acc = (f32x4){0.f, 0.f, 0.f, 0.f};
#pragma unroll
            for (int kk = 0; kk < 2; ++kk) { const bf16x8 kf = *(const LAS bf16x8*)(Ks + (16 * nt + fr) * 72 + 32 * kk + 8 * fq); acc = __builtin_amdgcn_mfma_f32_16x16x32_bf16(kf, qf[kk], acc, 0, 0, 0); }
#pragma unroll
            for (int i = 0; i < 4; ++i) { const int s = t0 - 128 + 16 * nt + 4 * fq + i, dist = tq0 + fr - s; const bool ok = (s >= 0) && (dist >= 0) && (dist < 128);
                const float v = ok ? acc[i] - slope * (float)dist : -INFINITY; acc[i] = v; mx = fmaxf(mx, v); }
            sc[nt] = acc; }
        mx = fmaxf(mx, __shfl_xor(mx, 16)); mx = fmaxf(mx, __shfl_xor(mx, 32)); mx = fmaxf(mx, sink);
        float sum = 0.f;
#pragma unroll
        for (int nt = 0; nt < 12; ++nt)
#pragma unroll
            for (int i = 0; i < 4; ++i) { const float p = __expf(sc[nt][i] - mx); sc[nt][i] = p; sum += p; }
        sum += __shfl_xor(sum, 16); sum += __shfl_xor(sum, 32);
        const float den = sum + __expf(sink - mx);
        bf16x8 pf[6];
#pragma unroll
        for (int ks = 0; ks < 6; ++ks) pf[ks] = pack8(sc[2 * ks], sc[2 * ks + 1]);
        float rden[4];
#pragma unroll
        for (int i = 0; i < 4; ++i) rden[i] = 1.0f / __shfl(den, 4 * fq + i);
        bf16* op = F.MIX + (row0 + tq0 + 4 * fq) * D + 512 + hq * 64 + fr;
#pragma unroll 1
        for (int dt = 0; dt < 4; ++dt) { f32x4 oacc = (f32x4){0.f, 0.f, 0.f, 0.f};
#pragma unroll
            for (int ks = 0; ks < 6; ++ks) { const LAS bf16* vp = Vt + (16 * dt + fr) * 196 + 32 * ks + 4 * fq;
                const unsigned long long lo = *(const LAS unsigned long long*)vp, hi = *(const LAS unsigned long long*)(vp + 16);
                v4u vv; vv.x = (unsigned)lo; vv.y = (unsigned)(lo >> 32); vv.z = (unsigned)hi; vv.w = (unsigned)(hi >> 32);
                oacc = __builtin_amdgcn_mfma_f32_16x16x32_bf16(pf[ks], __builtin_bit_cast(bf16x8, vv), oacc, 0, 0, 0); }
#pragma unroll
            for (int i = 0; i < 4; ++i) op[(size_t)i * D + 16 * dt] = (bf16)f2bf(oacc[i] * rden[i]); }
    }
    __syncthreads();
}
__device__ __forceinline__ void p3a_prep(Frame& F) {
    LAS unsigned char* wl = F.lds + RING_OFF + F.wave * 16384;
    const int gw = F.vcu * NWAVES + F.wave, NGW = F.G * NWAVES;
    for (int ci = gw; ci < BATCH * 8 * (T / 64); ci += NGW) gdn_prep_chunk(F, ci, wl);
}
__device__ __forceinline__ void p3b_mixers(Frame& F) {
    const int bx = blockIdx.x;
    if (bx < 32) { gdn_scan(F, bx); return; }
    for (int u = bx - 32; u < BATCH * 2 * (T / 64); u += F.G - 32) swa_unit(F, u, F.lds + RING_OFF);
}

struct Args { const float* in[18]; float* out; unsigned char* ws; };
__global__ void __launch_bounds__(NWAVES * 64, 2) hymba_fwd(Args args) {
    extern __shared__ __attribute__((aligned(16))) unsigned char lds[];
    Frame F;
    F.lds = (LAS unsigned char*)lds;
    F.MISC = (volatile LAS unsigned*)(F.lds + MISC_OFF);
    F.tid = threadIdx.x; F.lane = F.tid & 63; F.wave = __builtin_amdgcn_readfirstlane(F.tid >> 6);
    F.G = gridDim.x; { const int bx = blockIdx.x; F.vcu = (F.G % 8 == 0) ? (bx % 8) * (F.G / 8) + bx / 8 : bx; }
    unsigned char* ws = args.ws;
    F.ctl = (gu32*)(ws + WS_CTL);
    F.x = args.in[0]; F.c = args.in[1]; F.w_ada = args.in[2]; F.b_ada = args.in[3]; F.norm1_w = args.in[4]; F.w_in = args.in[5]; F.conv_w = args.in[6];
    F.a_log = args.in[7]; F.dt_bias = args.in[8]; F.gdn_norm_w = args.in[9]; F.q_norm_w = args.in[10]; F.k_norm_w = args.in[11]; F.sinks = args.in[12];
    F.w_out = args.in[13]; F.norm2_w = args.in[14]; F.w_gate = args.in[15]; F.w_up = args.in[16]; F.w_down = args.in[17]; F.out = args.out;
    F.modacc = (float*)(ws + WS_CTL) + CW_MODACC; F.modf = (float*)(ws + WS_MODF); F.wab = (float*)(ws + WS_WAB); F.gb = (float*)(ws + WS_GB);
    F.Win_t = (bf16*)(ws + WS_WIN); F.Wout_t = (bf16*)(ws + WS_WOUT); F.Wgu_t = (bf16*)(ws + WS_WGU); F.Wdn_t = (bf16*)(ws + WS_WDN);
    F.H = (bf16*)(ws + WS_H); F.PQ = (bf16*)(ws + WS_PQ); F.MIX = (bf16*)(ws + WS_MIX); F.CHKA = (bf16*)(ws + WS_CHKA); F.CHKU = (bf16*)(ws + WS_H); F.dec = (float*)(ws + WS_DEC);
    for (int u = F.tid; u < (LDS_BYTES - LDSCTL_OFF) / 4; u += NWAVES * 64) ((LAS unsigned*)(F.lds + LDSCTL_OFF))[u] = 0u;
    __syncthreads();
    XcdBarrier bar = xcd_barrier_post((unsigned*)(F.ctl + CW_BAR), F.MISC + 8);
#define GRID_BAR() xcd_barrier(bar)

    p0_prologue(F); GRID_BAR();
    norm_phase<1>(F); GRID_BAR();
    { pg8::Gemm g{F.H, F.Win_t, M, NP, D}; pg8::StaticOrder S; S.init(M, NP, F.G, (int)blockIdx.x);
      pg8::EpiBf16Plain E{F.PQ, NP};
      pg8::gemm_phase<pg8::EpiBf16Plain, pg8::StaticOrder, true, true>(F.lds + RING_OFF, g, S, E); }
    GRID_BAR();
    p3a_prep(F); GRID_BAR();
    p3b_mixers(F); GRID_BAR();
    { pg8::Gemm g{F.MIX, F.Wout_t, M, D, D}; pg8::StaticOrder S; S.init(M, D, F.G, (int)blockIdx.x);
      pg8::EpiGateRes E{F.x, F.out, D, F.modf + 2 * D, 6 * D, T};
      pg8::gemm_phase<pg8::EpiGateRes, pg8::StaticOrder, true, true>(F.lds + RING_OFF, g, S, E); }
    GRID_BAR();
    norm_phase<2>(F); GRID_BAR();
    { pg8::Gemm g{F.H, F.Wgu_t, M, NGU, D}; pg8::StaticOrder S; S.init(M, NGU, F.G, (int)blockIdx.x);
      pg8::EpiSwiGLU E{F.PQ, FF};
      pg8::gemm_phase<pg8::EpiSwiGLU, pg8::StaticOrder, true, true>(F.lds + RING_OFF, g, S, E); }
    GRID_BAR();
    { pg8::Gemm g{F.PQ, F.Wdn_t, M, D, FF}; pg8::StaticOrder S; S.init(M, D, F.G, (int)blockIdx.x);
      pg8::EpiGateRes E{F.out, F.out, D, F.modf + 5 * D, 6 * D, T};
      pg8::gemm_phase<pg8::EpiGateRes, pg8::StaticOrder, true, true>(F.lds + RING_OFF, g, S, E); }
#undef GRID_BAR
}

extern "C" void kernel_launch(void* const* d_in, const int* in_sizes, int n_in, void* d_out, int out_size, void* d_ws, size_t ws_size, hipStream_t stream) {
    static int grid = 0;
    if (grid == 0) {
        if (n_in != 18 || in_sizes[0] != M * D || out_size != M * D || ws_size < WS_END) { fprintf(stderr, "kernel_launch: unexpected shapes (n_in %d, in0 %d, out %d, ws %zu); nothing launched\n", n_in, n_in > 0 ? in_sizes[0] : -1, out_size, ws_size); grid = -1; return; }
        int dev = 0, cus = 0;
        if (hipGetDevice(&dev) != hipSuccess || hipDeviceGetAttribute(&cus, hipDeviceAttributeMultiprocessorCount, dev) != hipSuccess) { grid = -1; return; }
        if (hipFuncSetAttribute((const void*)hymba_fwd, hipFuncAttributeMaxDynamicSharedMemorySize, LDS_BYTES) != hipSuccess) { fprintf(stderr, "kernel_launch: hipFuncSetAttribute failed\n"); grid = -1; return; }
        (void)hipGetLastError();
        grid = cus;
    }
    if (grid < 0) return;
    if (hipMemsetAsync((char*)d_ws + WS_CTL, 0, CTL_ZERO_BYTES, stream) != hipSuccess) { fprintf(stderr, "kernel_launch: hipMemsetAsync failed\n"); return; }
    Args a{};
    for (int i = 0; i < 18; ++i) a.in[i] = (const float*)d_in[i];
    a.out = (float*)d_out; a.ws = (unsigned char*)d_ws;
    hipLaunchKernelGGL(hymba_fwd, dim3(grid), dim3(NWAVES * 64), LDS_BYTES, stream, a);
    const hipError_t le = hipPeekAtLastError();
    if (le != hipSuccess) fprintf(stderr, "kernel_launch: launch failed: %s\n", hipGetErrorName(le));
}
```

```cpp
#include <hip/hip_runtime.h>
#include <cstdio>
#include <cstdint>
#include <cmath>
namespace pg8 {
#define PG8_LAS __attribute__((address_space(3)))
typedef unsigned short bf16_t;
typedef short bf16x8 __attribute__((ext_vector_type(8)));
typedef float f32x4 __attribute__((ext_vector_type(4)));
typedef unsigned u32x4 __attribute__((ext_vector_type(4)));
constexpr int BM = 256, BK = 64, HALF = 128, HTB = HALF * BK * 2  , STAGE_BYTES = 8 * HTB, NXCD = 8, WGM = 8;

__host__ __device__ __forceinline__ int lds_byte(int r, int c) { const int st = (r >> 4) * 2 + (c >> 5), rr = r & 15, cc = c & 31, ob = rr * 64 + cc * 2; return st * 1024 + (ob ^ (((ob >> 9) & 1) << 5)); }
__host__ __device__ __forceinline__ void stage_rc(int b, int& R, int& C) { const int st = b / 1024, sb = b % 1024, swz = sb ^ (((sb >> 9) & 1) << 5); R = (st >> 1) * 16 + swz / 64; C = (st & 1) * 32 + (swz % 64) / 2; }
__host__ __device__ __forceinline__ int perm32(int rho) { const int n = rho >> 4, i = rho & 15; return 8 * (i >> 2) + 4 * n + (i & 3); }

struct Unit { int pm, pn; };
struct Gemm { const bf16_t* A; const bf16_t* Bt; int M, N, K; };

struct StaticOrder {
    int nM, nN, nwg, G, c;
    __host__ __device__ void init(int M, int N, int G_, int c_) { nM = M / BM; nN = N / BM; nwg = nM * nN; G = G_; c = c_; }
    __host__ __device__ bool next(int i, Unit& u) const {
        const long L = (long)i * G + c; if (L >= nwg) return false;
        int wgid = (int)L; { const int q = nwg / NXCD, r = nwg % NXCD, xcd = wgid % NXCD, off = wgid / NXCD; wgid = (xcd < r ? xcd * (q + 1) : r * (q + 1) + (xcd - r) * q) + off; }
        const int nig = WGM * nN, gid = wgid / nig, fm = gid * WGM, gsz = (nM - fm) < WGM ? (nM - fm) : WGM;
        u.pm = fm + ((wgid % nig) % gsz); u.pn = (wgid % nig) / gsz; return true;
    }
    __device__ __forceinline__ void a_ready(const Unit&) const {}
    __device__ __forceinline__ void done(const Unit&) const {}
};

__device__ __forceinline__ unsigned cvt_pk_bf16(float lo, float hi) { unsigned r; asm volatile("v_cvt_pk_bf16_f32 %0, %1, %2" : "=v"(r) : "v"(lo), "v"(hi)); return r; }
__device__ __forceinline__ float silu_f(float x) { return x * __builtin_amdgcn_rcpf(1.0f + __expf(-x)); }

struct EpiBf16Plain {
    static constexpr bool PERM = true, AFTER_DRAIN = false;
    bf16_t* O; int ldc; int silu_lo, silu_hi;
    __device__ __forceinline__ void operator()(const f32x4 (&acc)[2][2][4][2], const Unit& u, int wr, int wc, int fr, int fq) const {
        const int row0 = u.pm * BM + wr * 64 + fr, col0 = u.pn * BM + wc * 32 + 8 * fq;
        const bool act = (u.pn >= silu_lo) && (u.pn < silu_hi);
#pragma unroll
        for (int ai = 0; ai < 2; ++ai)
#pragma unroll
            for (int m = 0; m < 4; ++m) { bf16_t* rowp = O + (size_t)(row0 + ai * HALF + m * 16) * ldc + col0;
#pragma unroll
                for (int bj = 0; bj < 2; ++bj) { f32x4 v0 = acc[ai][bj][m][0], v1 = acc[ai][bj][m][1];
                    if (act) {
#pragma unroll
                        for (int i = 0; i < 4; ++i) { v0[i] = silu_f(v0[i]); v1[i] = silu_f(v1[i]); } }
                    u32x4 w; w.x = cvt_pk_bf16(v0[0], v0[1]); w.y = cvt_pk_bf16(v0[2], v0[3]); w.z = cvt_pk_bf16(v1[0], v1[1]); w.w = cvt_pk_bf16(v1[2], v1[3]);
                    *(u32x4*)(rowp + bj * HALF) = w; } }
    }
};
struct EpiSwiGLU {
    static constexpr bool PERM = true, AFTER_DRAIN = false;
    bf16_t* O; int ldc;
    __device__ __forceinline__ void operator()(const f32x4 (&acc)[2][2][4][2], const Unit& u, int wr, int wc, int fr, int fq) const {
        const int row0 = u.pm * BM + wr * 64 + fr, col0 = u.pn * HALF + wc * 32 + 8 * fq;
#pragma unroll
        for (int ai = 0; ai < 2; ++ai)
#pragma unroll
            for (int m = 0; m < 4; ++m) { bf16_t* rowp = O + (size_t)(row0 + ai * HALF + m * 16) * ldc + col0;
                const f32x4 g0 = acc[ai][0][m][0], g1 = acc[ai][0][m][1], u0 = acc[ai][1][m][0], u1 = acc[ai][1][m][1];
                float a[8];
#pragma unroll
                for (int i = 0; i < 4; ++i) { a[i] = silu_f(g0[i]) * u0[i]; a[4 + i] = silu_f(g1[i]) * u1[i]; }
                u32x4 w; w.x = cvt_pk_bf16(a[0], a[1]); w.y = cvt_pk_bf16(a[2], a[3]); w.z = cvt_pk_bf16(a[4], a[5]); w.w = cvt_pk_bf16(a[6], a[7]);
                *(u32x4*)rowp = w; }
    }
};
struct EpiGateRes {
    static constexpr bool PERM = false, AFTER_DRAIN = false;
    const float* base; float* out; int ldc; const float* gate; int gstride; int rows_per_batch;
    __device__ __forceinline__ void operator()(const f32x4 (&acc)[2][2][4][2], const Unit& u, int wr, int wc, int fr, int fq) const {
        const int row0 = u.pm * BM + wr * 64 + fr, col0 = u.pn * BM + wc * 32 + 4 * fq;
        const float* gp = gate + (size_t)((u.pm * BM) / rows_per_batch) * gstride + col0;
        f32x4 gv[2][2];
#pragma unroll
        for (int bj = 0; bj < 2; ++bj)
#pragma unroll
            for (int n = 0; n < 2; ++n) gv[bj][n] = *(const f32x4*)(gp + bj * HALF + n * 16);
#pragma unroll
        for (int ai = 0; ai < 2; ++ai)
#pragma unroll
            for (int m = 0; m < 4; ++m) { const size_t off = (size_t)(row0 + ai * HALF + m * 16) * ldc + col0;
#pragma unroll
                for (int bj = 0; bj < 2; ++bj)
#pragma unroll
                    for (int n = 0; n < 2; ++n) { const f32x4 bs = *(const f32x4*)(base + off + bj * HALF + n * 16);
                        *(f32x4*)(out + off + bj * HALF + n * 16) = bs + gv[bj][n] * acc[ai][bj][m][n]; } }
    }
};

template <class Epi, class Sched, bool ALIGN_EPI = false, bool SP2 = false>
__device__ __forceinline__ void gemm_phase(PG8_LAS unsigned char* lds, const Gemm g, const Sched& S, const Epi& E) {
    const int tid = threadIdx.x, wid = __builtin_amdgcn_readfirstlane(tid >> 6), lane = tid & 63, wr = wid >> 2, wc = wid & 3, fr = lane & 15, fq = lane >> 4;
    const int K = g.K, nt = K / BK;
    unsigned voffA[2], voffB[2];
#pragma unroll
    for (int i = 0; i < 2; ++i) { int R, C; stage_rc(tid * 16 + i * 8192, R, C); const int Rb = Epi::PERM ? ((R & ~31) + perm32(R & 31)) : R;
        voffA[i] = (unsigned)(R * K + C) * 2u; voffB[i] = (unsigned)(Rb * K + C) * 2u; }
    const size_t kstep = (size_t)(BK * 2);
    const size_t hstep = (size_t)HALF * K * 2;
    const size_t tstep = 2 * hstep;
    const unsigned ldsw = (unsigned)wid * 1024u;
    const int aoff = lds_byte(wr * 64 + fr, fq * 8), boff = lds_byte(wc * 32 + fr, fq * 8);
#define PG8_SA(b, h) (((b) * 2 + (h)) * HTB)
#define PG8_SB(b, h) ((4 + (b) * 2 + (h)) * HTB)
#define PG8_STAGE(bufoff, gbase, voff) do { _Pragma("unroll") for (int _i = 0; _i < 2; ++_i) \
        __builtin_amdgcn_global_load_lds((const unsigned*)((const char*)(gbase) + (voff)[_i]), (PG8_LAS unsigned*)(lds + (bufoff) + ldsw + _i * 8192), 16, 0, 0); } while (0)
#define PG8_LDA(dst, b, h) do { _Pragma("unroll") for (int m = 0; m < 4; ++m) _Pragma("unroll") for (int k = 0; k < 2; ++k) dst[m][k] = *(const PG8_LAS bf16x8*)(lds + PG8_SA(b, h) + aoff + m * 2048 + k * 1024); } while (0)
#define PG8_LDB(dst, b, h) do { _Pragma("unroll") for (int n = 0; n < 2; ++n) _Pragma("unroll") for (int k = 0; k < 2; ++k) dst[n][k] = *(const PG8_LAS bf16x8*)(lds + PG8_SB(b, h) + boff + n * 2048 + k * 1024); } while (0)
#define PG8_MMA(ai, bj, At, Bt) do { __builtin_amdgcn_s_setprio(1); _Pragma("unroll") for (int m = 0; m < 4; ++m) _Pragma("unroll") for (int n = 0; n < 2; ++n) _Pragma("unroll") for (int k = 0; k < 2; ++k) \
        acc[ai][bj][m][n] = __builtin_amdgcn_mfma_f32_16x16x32_bf16(Bt[n][k], At[m][k], acc[ai][bj][m][n], 0, 0, 0); __builtin_amdgcn_s_setprio(0); } while (0)
#define PG8_WAIT_V(n) asm volatile("s_waitcnt vmcnt(" #n ")" ::: "memory")
#define PG8_WAIT_L(n) asm volatile("s_waitcnt lgkmcnt(" #n ")" ::: "memory")
#define PG8_BAR __builtin_amdgcn_s_barrier()
#define PG8_SCHED __builtin_amdgcn_sched_barrier(0)
    Unit cur, nxt; int ui = 0;
    if (!S.next(0, cur)) return;
    f32x4 acc[2][2][4][2];
#pragma unroll
    for (int a = 0; a < 2; ++a)
#pragma unroll
        for (int b = 0; b < 2; ++b)
#pragma unroll
            for (int m = 0; m < 4; ++m)
#pragma unroll
                for (int n = 0; n < 2; ++n) acc[a][b][m][n] = (f32x4){0.f, 0.f, 0.f, 0.f};
    bf16x8 At[4][2], B0[2][2], B1[2][2];
    const char* cA = (const char*)g.A + (size_t)cur.pm * tstep; const char* cB = (const char*)g.Bt + (size_t)cur.pn * tstep;
    S.a_ready(cur);
    if constexpr (SP2) {
        PG8_STAGE(PG8_SB(0, 0), cB, voffB); PG8_STAGE(PG8_SB(0, 1), cB + hstep, voffB); PG8_STAGE(PG8_SA(0, 0), cA, voffA); PG8_STAGE(PG8_SA(0, 1), cA + hstep, voffA);
        if (wr == 1) PG8_BAR;
        PG8_WAIT_V(2); PG8_BAR;
        PG8_STAGE(PG8_SB(1, 0), cB + kstep, voffB); PG8_STAGE(PG8_SA(1, 0), cA + kstep, voffA); PG8_STAGE(PG8_SB(1, 1), cB + hstep + kstep, voffB);
        PG8_WAIT_V(6); PG8_BAR;
    } else {
        PG8_STAGE(PG8_SB(0, 0), cB, voffB); PG8_STAGE(PG8_SA(0, 0), cA, voffA); PG8_STAGE(PG8_SB(0, 1), cB + hstep, voffB); PG8_STAGE(PG8_SA(0, 1), cA + hstep, voffA);
        if (wr == 1) PG8_BAR;
        PG8_WAIT_V(4); PG8_BAR;
        PG8_STAGE(PG8_SB(1, 0), cB + kstep, voffB); PG8_STAGE(PG8_SA(1, 0), cA + kstep, voffA); PG8_STAGE(PG8_SB(1, 1), cB + hstep + kstep, voffB);
        PG8_WAIT_V(6); PG8_BAR;
    }
    for (;;) {
        const bool has_next = S.next(ui + 1, nxt);
        const char* nA = has_next ? (const char*)g.A + (size_t)nxt.pm * tstep : cA; const char* nB = has_next ? (const char*)g.Bt + (size_t)nxt.pn * tstep : cB;
        for (int t = 0; t < nt; t += 2) {
            const bool last = (t == nt - 2);
            const char* a1 = cA + (size_t)(t + 1) * kstep;
            const char* a2 = last ? nA : cA + (size_t)(t + 2) * kstep; const char* b2 = last ? nB : cB + (size_t)(t + 2) * kstep;
            const char* a3 = a2 + kstep; const char* b3 = b2 + kstep;
            if (last && has_next) S.a_ready(nxt);
            if constexpr (SP2) {
            PG8_LDB(B0, 0, 0); PG8_LDB(B1, 0, 1); PG8_SCHED; PG8_LDA(At, 0, 0); PG8_STAGE(PG8_SA(1, 1), a1 + hstep, voffA);
            PG8_WAIT_V(8); PG8_WAIT_L(0); PG8_BAR; PG8_MMA(0, 0, At, B0); PG8_MMA(0, 1, At, B1); PG8_BAR; PG8_SCHED;
            PG8_LDA(At, 0, 1); PG8_STAGE(PG8_SB(0, 0), b2, voffB); PG8_STAGE(PG8_SB(0, 1), b2 + hstep, voffB); PG8_STAGE(PG8_SA(0, 0), a2, voffA);
            PG8_WAIT_V(8); PG8_WAIT_L(0); PG8_BAR; PG8_MMA(1, 0, At, B0); PG8_MMA(1, 1, At, B1); PG8_BAR; PG8_SCHED;
            PG8_LDB(B0, 1, 0); PG8_LDB(B1, 1, 1); PG8_SCHED; PG8_LDA(At, 1, 0); PG8_STAGE(PG8_SA(0, 1), a2 + hstep, voffA);
            PG8_WAIT_V(8); PG8_WAIT_L(0); PG8_BAR; PG8_MMA(0, 0, At, B0); PG8_MMA(0, 1, At, B1); PG8_BAR; PG8_SCHED;
            PG8_LDA(At, 1, 1); PG8_STAGE(PG8_SB(1, 0), b3, voffB); PG8_STAGE(PG8_SB(1, 1), b3 + hstep, voffB); PG8_STAGE(PG8_SA(1, 0), a3, voffA);
            PG8_WAIT_V(8); PG8_WAIT_L(0); PG8_BAR; PG8_MMA(1, 0, At, B0); PG8_MMA(1, 1, At, B1); PG8_BAR; PG8_SCHED;
            } else {
            PG8_LDB(B0, 0, 0); PG8_SCHED; PG8_LDA(At, 0, 0); PG8_STAGE(PG8_SA(1, 1), a1 + hstep, voffA);
            PG8_WAIT_L(8); PG8_BAR; PG8_WAIT_L(0); PG8_MMA(0, 0, At, B0); PG8_BAR; PG8_SCHED;
            PG8_LDB(B1, 0, 1); PG8_STAGE(PG8_SB(0, 0), b2, voffB);
            PG8_BAR; PG8_WAIT_L(0); PG8_MMA(0, 1, At, B1); PG8_BAR;
            PG8_LDA(At, 0, 1); PG8_STAGE(PG8_SA(0, 0), a2, voffA);
            PG8_BAR; PG8_WAIT_L(0); PG8_MMA(1, 0, At, B0); PG8_BAR; PG8_SCHED;
            PG8_STAGE(PG8_SB(0, 1), b2 + hstep, voffB);
            PG8_WAIT_V(6); PG8_BAR; PG8_MMA(1, 1, At, B1); PG8_BAR;
            PG8_LDB(B0, 1, 0); PG8_SCHED; PG8_LDA(At, 1, 0); PG8_STAGE(PG8_SA(0, 1), a2 + hstep, voffA);
            PG8_WAIT_L(8); PG8_BAR; PG8_WAIT_L(0); PG8_MMA(0, 0, At, B0); PG8_BAR; PG8_SCHED;
            PG8_LDB(B1, 1, 1); PG8_STAGE(PG8_SB(1, 0), b3, voffB);
            PG8_BAR; PG8_WAIT_L(0); PG8_MMA(0, 1, At, B1); PG8_BAR;
            PG8_LDA(At, 1, 1); PG8_STAGE(PG8_SA(1, 0), a3, voffA);
            PG8_BAR; PG8_WAIT_L(0); PG8_MMA(1, 0, At, B0); PG8_BAR; PG8_SCHED;
            PG8_STAGE(PG8_SB(1, 1), b3 + hstep, voffB);
            PG8_WAIT_V(6); PG8_BAR; PG8_MMA(1, 1, At, B1); PG8_BAR;
            }
        }
        if constexpr (ALIGN_EPI) { if (wr == 0) PG8_BAR; }
        if constexpr (!Epi::AFTER_DRAIN) { E(acc, cur, wr, wc, fr, fq); S.done(cur); }
        if (!has_next) break;
#pragma unroll
        for (int a = 0; a < 2; ++a)
#pragma unroll
            for (int b = 0; b < 2; ++b)
#pragma unroll
                for (int m = 0; m < 4; ++m)
#pragma unroll
                    for (int n = 0; n < 2; ++n) acc[a][b][m][n] = (f32x4){0.f, 0.f, 0.f, 0.f};
        cur = nxt; cA = nA; cB = nB; ++ui;
        if constexpr (ALIGN_EPI) { if (wr == 1) PG8_BAR; }
    }
    PG8_WAIT_V(0);
    if constexpr (!ALIGN_EPI) { if (wr == 0) PG8_BAR; }
    PG8_BAR;
    if constexpr (Epi::AFTER_DRAIN) { E.fused(acc, cur, wr, wc, fr, fq, lds, wid, lane); S.done(cur); }
#undef PG8_SA
#undef PG8_SB
#undef PG8_STAGE
#undef PG8_LDA
#undef PG8_LDB
#undef PG8_MMA
#undef PG8_WAIT_V
#undef PG8_WAIT_L
#undef PG8_BAR
#undef PG8_SCHED
}
}
constexpr int NWAVES = 8;
constexpr int BATCH = 4, T = 4096, D = 1024, M = BATCH * T;
constexpr int PROJ_W = 2832, NP = 2816, FF = 2816, NGU = 2 * FF, HD = 64;
constexpr int C_GQ = 0, C_GK = 512, C_GV = 1024, C_GZ = 1536, C_SQ = 2048, C_SK = 2560, C_SV = 2688;
constexpr float EPS = 1e-6f;
constexpr size_t MiB = 1u << 20;
constexpr size_t WS_CTL = 0, CTL_ZERO_BYTES = 1 * MiB;
constexpr size_t WS_MODF = 1 * MiB;
constexpr size_t WS_WAB = 1 * MiB + 256 * 1024;
constexpr size_t WS_GB = 2 * MiB;
constexpr size_t WS_WIN = 4 * MiB, WS_WOUT = 10 * MiB, WS_WGU = 12 * MiB, WS_WDN = 24 * MiB;
constexpr size_t WS_H = 32 * MiB;
constexpr size_t WS_PQ = 64 * MiB;
constexpr size_t WS_MIX = 160 * MiB;
constexpr size_t WS_CHKA = 192 * MiB;
constexpr size_t WS_DEC = 1 * MiB + 384 * 1024;
constexpr size_t WS_END = 256 * MiB;
constexpr int CW_BAR = 4096;
constexpr int CW_MODACC = 16384;
constexpr int RING_OFF = 0, RING_BYTES = 131072;
constexpr int LDSCTL_OFF = RING_BYTES, MISC_OFF = LDSCTL_OFF + 320;
constexpr int LDS_BYTES = 147456;
#define GAS __attribute__((address_space(1)))
#define LAS __attribute__((address_space(3)))
typedef unsigned short bf16;
typedef unsigned v4u __attribute__((ext_vector_type(4)));
typedef float f32x4 __attribute__((ext_vector_type(4)));
typedef short bf16x8 __attribute__((ext_vector_type(8)));
typedef GAS unsigned gu32;
typedef GAS unsigned long long gu64;
#define RLX_AGENT __ATOMIC_RELAXED, __HIP_MEMORY_SCOPE_AGENT
#define LDS_WAIT() asm volatile("s_waitcnt lgkmcnt(0)" ::: "memory")
#define VM_WAIT() asm volatile("s_waitcnt vmcnt(0)" ::: "memory")
__device__ __forceinline__ unsigned long long rt() { return __builtin_amdgcn_s_memrealtime(); }
__device__ __forceinline__ unsigned f2bf(float f) { unsigned u = __builtin_bit_cast(unsigned, f); return (u + 0x7fffu + ((u >> 16) & 1u)) >> 16; }
__device__ __forceinline__ unsigned pk2(float lo, float hi) { return f2bf(lo) | (f2bf(hi) << 16); }

#define XB_TMO      128
#define XB_XCNT(j)  (256  + 64 * (j))
#define XB_XSUB(j)  (1280 + 64 * (j))
#define XB_XGEN(j)  (2304 + 64 * (j))
#define XB_TOP      3328
#define XB_TOPGEN   3392
#define XCD_BAR_WORDS 3456
#define XB_SPIN_CAP (1u << 22)

__device__ __forceinline__ unsigned xb_ld(unsigned* p)              { return __hip_atomic_load(p, __ATOMIC_RELAXED, __HIP_MEMORY_SCOPE_AGENT); }
__device__ __forceinline__ unsigned xb_add(unsigned* p, unsigned v) { return __hip_atomic_fetch_add(p, v, __ATOMIC_RELAXED, __HIP_MEMORY_SCOPE_AGENT); }
__device__ __forceinline__ unsigned xb_xcc_id() { return (unsigned)__builtin_amdgcn_s_getreg((3 << 11) | 20) & 0xFu; }
#define XB_SPIN(cond, bar) do { unsigned _sp = 0; while (cond) { __builtin_amdgcn_s_sleep(1); \
    if ((++_sp & 255u) == 0u) { if (xb_ld(&(bar)[XB_TMO])) break; if (_sp > XB_SPIN_CAP) { atomicAdd(&(bar)[XB_TMO], 1u); break; } } } } while (0)

struct XcdBarrier {
    unsigned* bar; unsigned x;
    volatile LAS unsigned* st;
};

__device__ __forceinline__ XcdBarrier xcd_barrier_post(unsigned* bar, volatile LAS unsigned* st) {
    XcdBarrier b; b.bar = bar; b.x = xb_xcc_id(); b.st = st;
    if (threadIdx.x == 0) (void)xb_add(&bar[XB_XCNT(b.x)], 1u);
    return b;
}
__device__ __forceinline__ void xcd_barrier_complete(unsigned* bar, unsigned x, unsigned& nloc, unsigned& nx) {
    const unsigned G = gridDim.x * gridDim.y * gridDim.z;
    unsigned sum, cnt, mine, sp = 0u;
    for (;;) {
        sum = 0u; cnt = 0u; mine = 0u;
#pragma unroll
        for (unsigned j = 0; j < 16; ++j) { const unsigned c = xb_ld(&bar[XB_XCNT(j)]); sum += c; cnt += (c > 0u) ? 1u : 0u; mine = (j == x) ? c : mine; }
        if (sum == G) break;
        __builtin_amdgcn_s_sleep(1);
        if ((++sp & 255u) == 0u) { if (xb_ld(&bar[XB_TMO])) break; if (sp > XB_SPIN_CAP) { atomicAdd(&bar[XB_TMO], 1u); break; } }
    }
    nloc = mine > 0u ? mine : 1u; nx = cnt > 0u ? cnt : 1u;
}

__device__ __forceinline__ void xcd_barrier(const XcdBarrier& b) {
    asm volatile("s_waitcnt vmcnt(0)" ::: "memory");
    __syncthreads();
    if (threadIdx.x == 0) {
        unsigned* bar = b.bar;
        __builtin_amdgcn_s_waitcnt(0);
        unsigned nloc = b.st[0], nx = b.st[1];
        if (nloc == 0u) { xcd_barrier_complete(bar, b.x, nloc, nx); b.st[0] = nloc; b.st[1] = nx; }
        const unsigned old = xb_add(&bar[XB_XSUB(b.x)], 1u);
        const unsigned gen = old / nloc;
        if (old + 1u == (gen + 1u) * nloc) {
            __builtin_amdgcn_fence(__ATOMIC_RELEASE, "agent");
            asm volatile("s_waitcnt vmcnt(0)" ::: "memory");
            const unsigned og = xb_add(&bar[XB_TOP], 1u);
            const unsigned tg = og / nx;
            if (og + 1u == (tg + 1u) * nx) xb_add(&bar[XB_TOPGEN], 1u);
            else XB_SPIN(xb_ld(&bar[XB_TOPGEN]) == tg, bar);
            __builtin_amdgcn_fence(__ATOMIC_ACQUIRE, "agent");
            xb_add(&bar[XB_XGEN(b.x)], 1u);
            asm volatile("s_waitcnt vmcnt(0)" ::: "memory");
        } else {
            XB_SPIN(xb_ld(&bar[XB_XGEN(b.x)]) == gen, bar);
            __builtin_amdgcn_fence(__ATOMIC_ACQUIRE, "agent");
            asm volatile("s_waitcnt vmcnt(0)" ::: "memory");
        }
    }
    __syncthreads();
}
struct Frame {
    LAS unsigned char* lds;
    volatile LAS unsigned* MISC;
    gu32* ctl;
    int tid, lane, wave;
    int vcu, G;
    const float *x, *c, *w_ada, *b_ada, *norm1_w, *w_in, *conv_w, *a_log, *dt_bias, *gdn_norm_w, *q_norm_w, *k_norm_w, *sinks, *w_out, *norm2_w, *w_gate, *w_up, *w_down;
    float* out;
    float *modacc, *modf, *wab, *gb, *dec;
    bf16 *Win_t, *Wout_t, *Wgu_t, *Wdn_t, *H, *PQ, *MIX, *CHKA, *CHKU;
};
__device__ __forceinline__ float wave_sum(float v) {
#pragma unroll
    for (int o = 1; o < 64; o <<= 1) v += __shfl_xor(v, o);
    return v;
}
__device__ __forceinline__ float wave_max(float v) {
#pragma unroll
    for (int o = 1; o < 64; o <<= 1) v = fmaxf(v, __shfl_xor(v, o));
    return v;
}
__device__ __forceinline__ float bf2f(bf16 h) { return __uint_as_float((unsigned)h << 16); }
__device__ __forceinline__ float ld_f32_coh(const float* p) { return __uint_as_float(__hip_atomic_load((const unsigned*)p, RLX_AGENT)); }
__device__ __forceinline__ float silu(float x) { return x / (1.0f + __expf(-x)); }

__device__ __forceinline__ void tr_item(const float* W, int ldw, int src_col, bf16* WT, int K, int dst_row, int k0, LAS float* scr, int lane) {
#pragma unroll 8
    for (int i = 0; i < 32; ++i) { const int kk = 2 * i + (lane >> 5); scr[kk * 33 + (lane & 31)] = W[(size_t)(k0 + kk) * ldw + src_col + (lane & 31)]; }
    LDS_WAIT(); asm volatile("" ::: "memory");
    const int c = lane & 7;
#pragma unroll
    for (int j = 0; j < 4; ++j) { const int n = (lane >> 3) + 8 * j; const LAS float* s = scr + (8 * c) * 33 + n;
        v4u o; o.x = pk2(s[0 * 33], s[1 * 33]); o.y = pk2(s[2 * 33], s[3 * 33]); o.z = pk2(s[4 * 33], s[5 * 33]); o.w = pk2(s[6 * 33], s[7 * 33]);
        *(GAS v4u*)(WT + (size_t)(dst_row + n) * K + k0 + 8 * c) = o; }
    LDS_WAIT(); asm volatile("" ::: "memory");
}

__device__ __forceinline__ void p0_prologue(Frame& F) {
    LAS float* scr = (LAS float*)(F.lds + RING_OFF + F.wave * 16384);
    const int gw = F.vcu * NWAVES + F.wave, NGW = F.G * NWAVES, lane = F.lane;
    constexpr int I_ADA = 24 * 16, I_AB = 16, I_IN = 16 * (NP / 32), I_OUT = 16 * 32, I_GU = 16 * (NGU / 32), I_DN = (FF / 64) * 32;
    constexpr int NITEMS = I_ADA + I_AB + I_IN + I_OUT + I_GU + I_DN;
    for (int it = gw; it < NITEMS; it += NGW) {
        int r = it;
        if (r < I_ADA) {
            const int ct = r % 24, ks = r / 24, col = ct * 256 + lane, k0 = ks * 64;
            float acc[4][4];
#pragma unroll
            for (int j = 0; j < 4; ++j)
#pragma unroll
                for (int b = 0; b < 4; ++b) acc[j][b] = 0.f;
#pragma unroll 4
            for (int kk = 0; kk < 64; ++kk) { const int k = k0 + kk; float cb[4];
#pragma unroll
                for (int b = 0; b < 4; ++b) cb[b] = silu(F.c[b * D + k]);
#pragma unroll
                for (int j = 0; j < 4; ++j) { const float w = F.w_ada[(size_t)k * (6 * D) + col + 64 * j];
#pragma unroll
                    for (int b = 0; b < 4; ++b) acc[j][b] += cb[b] * w; } }
#pragma unroll
            for (int j = 0; j < 4; ++j)
#pragma unroll
                for (int b = 0; b < 4; ++b) atomicAdd(F.modacc + b * (6 * D) + col + 64 * j, acc[j][b]);
            continue;
        }
        r -= I_ADA;
        if (r < I_AB) {
            for (int i = 0; i < 16; ++i) { const int k = i * 64 + lane; F.wab[r * D + k] = F.w_in[(size_t)k * PROJ_W + 2048 + r]; }
            continue;
        }
        r -= I_AB;
        if (r < I_IN) { const int nb = r % (NP / 32), kb = r / (NP / 32), n0 = 32 * nb; tr_item(F.w_in, PROJ_W, n0 < 2048 ? n0 : n0 + 16, F.Win_t, D, n0, 64 * kb, scr, lane); continue; }
        r -= I_IN;
        if (r < I_OUT) { const int nb = r % 32, kb = r / 32; tr_item(F.w_out, D, 32 * nb, F.Wout_t, D, 32 * nb, 64 * kb, scr, lane); continue; }
        r -= I_OUT;
        if (r < I_GU) { const int nb = r % (NGU / 32), kb = r / (NGU / 32), n0 = 32 * nb, p = n0 >> 8, j = n0 & 255;
            if (j < 128) tr_item(F.w_gate, FF, 128 * p + j, F.Wgu_t, D, n0, 64 * kb, scr, lane);
            else         tr_item(F.w_up,   FF, 128 * p + j - 128, F.Wgu_t, D, n0, 64 * kb, scr, lane);
            continue; }
        r -= I_GU;
        { const int nb = r % 32, kb = r / 32; tr_item(F.w_down, D, 32 * nb, F.Wdn_t, FF, 32 * nb, 64 * kb, scr, lane); }
    }
}

template <int WHICH> __device__ __forceinline__ void norm_phase(Frame& F) {
    const int gw = F.vcu * NWAVES + F.wave, NGW = F.G * NWAVES, lane = F.lane;
    if (WHICH == 1) {
        for (int idx = gw * 64 + lane; idx < 4 * 6 * D; idx += NGW * 64) F.modf[idx] = ld_f32_coh(F.modacc + idx) + F.b_ada[idx % (6 * D)];
    }
    const float* src = (WHICH == 1) ? F.x : F.out;
    const float* nw = (WHICH == 1) ? F.norm1_w : F.norm2_w;
    for (int m0 = gw * 4; m0 < M; m0 += NGW * 4) {
        const int b = m0 / T;
        float gm[16], sh[16];
#pragma unroll
        for (int i = 0; i < 4; ++i)
#pragma unroll
            for (int e = 0; e < 4; ++e) { const int c = 256 * i + 4 * lane + e; float sc, sf;
                if (WHICH == 1) { sf = ld_f32_coh(F.modacc + b * 6 * D + c) + F.b_ada[c]; sc = ld_f32_coh(F.modacc + b * 6 * D + D + c) + F.b_ada[D + c]; }
                else { sf = F.modf[b * 6 * D + 3 * D + c]; sc = F.modf[b * 6 * D + 4 * D + c]; }
                gm[4 * i + e] = nw[c] * (1.0f + sc); sh[4 * i + e] = sf; }
        float h[4][16];
#pragma unroll
        for (int r = 0; r < 4; ++r) {
            const GAS f32x4* xr = (const GAS f32x4*)(src + (size_t)(m0 + r) * D) + lane;
            f32x4 v[4]; float ss = 0.f;
#pragma unroll
            for (int i = 0; i < 4; ++i) { v[i] = xr[64 * i]; ss += (v[i].x * v[i].x + v[i].y * v[i].y) + (v[i].z * v[i].z + v[i].w * v[i].w); }
            const float rstd = 1.0f / sqrtf(wave_sum(ss) * (1.0f / D) + EPS);
            GAS unsigned long long* o8 = (GAS unsigned long long*)(F.H + (size_t)(m0 + r) * D) + lane;
#pragma unroll
            for (int i = 0; i < 4; ++i) {
                const float a0 = v[i].x * rstd * gm[4 * i + 0] + sh[4 * i + 0], a1 = v[i].y * rstd * gm[4 * i + 1] + sh[4 * i + 1];
                const float a2 = v[i].z * rstd * gm[4 * i + 2] + sh[4 * i + 2], a3 = v[i].w * rstd * gm[4 * i + 3] + sh[4 * i + 3];
                h[r][4 * i + 0] = a0; h[r][4 * i + 1] = a1; h[r][4 * i + 2] = a2; h[r][4 * i + 3] = a3;
                o8[64 * i] = (unsigned long long)pk2(a0, a1) | ((unsigned long long)pk2(a2, a3) << 32); }
        }
        if (WHICH == 1) {
            float myv = 0.f;
            for (int j = 0; j < 16; ++j) {
                const GAS f32x4* wp = (const GAS f32x4*)(F.wab + j * D) + lane;
                f32x4 wv[4];
#pragma unroll
                for (int i = 0; i < 4; ++i) wv[i] = wp[64 * i];
#pragma unroll
                for (int r = 0; r < 4; ++r) { float p = 0.f;
#pragma unroll
                    for (int i = 0; i < 4; ++i) p += (h[r][4 * i] * wv[i].x + h[r][4 * i + 1] * wv[i].y) + (h[r][4 * i + 2] * wv[i].z + h[r][4 * i + 3] * wv[i].w);
                    p = wave_sum(p);
                    if (lane == r * 16 + j) myv = p; }
            }
            const int j = lane & 15, hh = j & 7;
            float val;
            if (j < 8) { const float xx = myv + F.dt_bias[hh]; const float sp = fmaxf(xx, 0.f) + log1pf(__expf(-fabsf(xx))); val = -__expf(F.a_log[hh]) * sp; }
            else val = 1.0f / (1.0f + __expf(-myv));
            F.gb[(size_t)m0 * 16 + lane] = val;
        }
    }
}

__device__ __forceinline__ void gdn_wave(Frame& F, int bh, LAS float* scr) {
    const int lane = F.lane, b = bh >> 3, hh = bh & 7;
    float S[64];
#pragma unroll
    for (int d = 0; d < 64; ++d) S[d] = 0.f;
    float wq[4], wk[4], wv[4];
#pragma unroll
    for (int j = 0; j < 4; ++j) { wq[j] = F.conv_w[j * 1536 + hh * 64 + lane]; wk[j] = F.conv_w[j * 1536 + 512 + hh * 64 + lane]; wv[j] = F.conv_w[j * 1536 + 1024 + hh * 64 + lane]; }
    const float nwg = F.gdn_norm_w[lane];
    float xq0 = 0.f, xq1 = 0.f, xq2 = 0.f, xk0 = 0.f, xk1 = 0.f, xk2 = 0.f, xv0 = 0.f, xv1 = 0.f, xv2 = 0.f;
    const size_t row0 = (size_t)b * T;
    const bf16* pq = F.PQ + row0 * NP + hh * 64 + lane;
    bf16 nq = pq[C_GQ], nk = pq[C_GK], nv = pq[C_GV], nz = pq[C_GZ];
    float ng = ld_f32_coh(F.gb + row0 * 16 + hh), nb = ld_f32_coh(F.gb + row0 * 16 + 8 + hh);
    for (int t = 0; t < T; ++t) {
        const float rq = bf2f(nq), rk = bf2f(nk), rv = bf2f(nv), rz = bf2f(nz), g = ng, beta = nb;
        if (t + 1 < T) { const bf16* p2 = pq + (size_t)(t + 1) * NP; nq = p2[C_GQ]; nk = p2[C_GK]; nv = p2[C_GV]; nz = p2[C_GZ];
            ng = ld_f32_coh(F.gb + (row0 + t + 1) * 16 + hh); nb = ld_f32_coh(F.gb + (row0 + t + 1) * 16 + 8 + hh); }
        float cq = wq[0] * xq0 + wq[1] * xq1 + wq[2] * xq2 + wq[3] * rq;
        float ck = wk[0] * xk0 + wk[1] * xk1 + wk[2] * xk2 + wk[3] * rk;
        float cv = wv[0] * xv0 + wv[1] * xv1 + wv[2] * xv2 + wv[3] * rv;
        xq0 = xq1; xq1 = xq2; xq2 = rq; xk0 = xk1; xk1 = xk2; xk2 = rk; xv0 = xv1; xv1 = xv2; xv2 = rv;
        cq = silu(cq); ck = silu(ck); cv = silu(cv);
        const float qn = cq / sqrtf(wave_sum(cq * cq) + EPS), kn = ck / sqrtf(wave_sum(ck * ck) + EPS);
        scr[lane] = kn; scr[64 + lane] = qn;
        LDS_WAIT(); asm volatile("" ::: "memory");
        const float a = __expf(g);
        float kd = 0.f;
#pragma unroll
        for (int d4 = 0; d4 < 16; ++d4) { const f32x4 kv = *(const LAS f32x4*)(scr + 4 * d4);
            kd += kv.x * S[4 * d4]; kd += kv.y * S[4 * d4 + 1]; kd += kv.z * S[4 * d4 + 2]; kd += kv.w * S[4 * d4 + 3]; }
        const float cc = beta * (cv - a * kd);
        float o = 0.f;
#pragma unroll
        for (int d4 = 0; d4 < 16; ++d4) { const f32x4 kv = *(const LAS f32x4*)(scr + 4 * d4); const f32x4 qv = *(const LAS f32x4*)(scr + 64 + 4 * d4);
            S[4 * d4] = a * S[4 * d4] + cc * kv.x; o += qv.x * S[4 * d4];
            S[4 * d4 + 1] = a * S[4 * d4 + 1] + cc * kv.y; o += qv.y * S[4 * d4 + 1];
            S[4 * d4 + 2] = a * S[4 * d4 + 2] + cc * kv.z; o += qv.z * S[4 * d4 + 2];
            S[4 * d4 + 3] = a * S[4 * d4 + 3] + cc * kv.w; o += qv.w * S[4 * d4 + 3]; }
        LDS_WAIT(); asm volatile("" ::: "memory");
        o *= 0.125f;
        const float on = o / sqrtf(wave_sum(o * o) * (1.0f / 64.0f) + EPS) * nwg * silu(rz);
        F.MIX[(row0 + t) * D + hh * 64 + lane] = (bf16)f2bf(on);
    }
}
__device__ __forceinline__ void swa_query(Frame& F, int item, LAS float* scr) {
    const int lane = F.lane, t = item & (T - 1), hq = (item >> 12) & 7, b = item >> 15, kvh = hq >> 2;
    const size_t row0 = (size_t)b * T;
    const float qraw = bf2f(F.PQ[(row0 + t) * NP + C_SQ + hq * 64 + lane]);
    const float qn = qraw / sqrtf(wave_sum(qraw * qraw) * (1.0f / 64.0f) + EPS) * F.q_norm_w[lane];
    scr[lane] = qn * F.k_norm_w[lane];
    LDS_WAIT(); asm volatile("" ::: "memory");
    const float slope = exp2f(-(float)(hq + 1)), sink = F.sinks[hq];
    float sc[2];
#pragma unroll
    for (int jj = 0; jj < 2; ++jj) {
        const int s = t - 127 + lane + 64 * jj;
        float v = -INFINITY;
        if (s >= 0) {
            const GAS v4u* kp = (const GAS v4u*)(F.PQ + (row0 + s) * NP + C_SK + kvh * 64);
            float dot = 0.f, ssk = 0.f;
#pragma unroll
            for (int c8 = 0; c8 < 8; ++c8) { const v4u kk = kp[c8]; const unsigned wds[4] = {kk.x, kk.y, kk.z, kk.w};
#pragma unroll
                for (int w = 0; w < 4; ++w) { const float k0 = __uint_as_float(wds[w] << 16), k1 = __uint_as_float(wds[w] & 0xffff0000u);
                    const float q0 = scr[c8 * 8 + 2 * w], q1 = scr[c8 * 8 + 2 * w + 1];
                    dot += q0 * k0 + q1 * k1; ssk += k0 * k0 + k1 * k1; } }
            v = dot / sqrtf(ssk * (1.0f / 64.0f) + EPS) * 0.125f - slope * (float)(t - s);
        }
        sc[jj] = v;
    }
    const float mx = fmaxf(wave_max(fmaxf(sc[0], sc[1])), sink);
    const float p0 = __expf(sc[0] - mx), p1 = __expf(sc[1] - mx);
    const float den = wave_sum(p0 + p1) + __expf(sink - mx);
    LDS_WAIT(); asm volatile("" ::: "memory");
    scr[64 + lane] = p0; scr[128 + lane] = p1;
    LDS_WAIT(); asm volatile("" ::: "memory");
    float o = 0.f;
    const int s0 = t - 127;
    const bf16* vp = F.PQ + row0 * NP + C_SV + kvh * 64 + lane;
    for (int j = (s0 < 0 ? -s0 : 0); j < 128; ++j) o += scr[64 + j] * bf2f(vp[(size_t)(s0 + j) * NP]);
    LDS_WAIT(); asm volatile("" ::: "memory");
    F.MIX[(row0 + t) * D + 512 + hq * 64 + lane] = (bf16)f2bf(o / den);
}
typedef short s16x4v __attribute__((ext_vector_type(4)));
typedef float f32x2_t __attribute__((ext_vector_type(2))); typedef __bf16 bf16x2_t __attribute__((ext_vector_type(2)));
__device__ __forceinline__ unsigned cvtpk(float lo, float hi) { f32x2_t v = {lo, hi}; bf16x2_t b = __builtin_convertvector(v, bf16x2_t); return __builtin_bit_cast(unsigned, b); }
__device__ __forceinline__ float rdlane(float v, int l) { return __int_as_float(__builtin_amdgcn_readlane(__float_as_int(v), l)); }
__device__ __forceinline__ bf16x8 pack8(const f32x4 a, const f32x4 b) {
    v4u w; w.x = cvtpk(a[0], a[1]); w.y = cvtpk(a[2], a[3]); w.z = cvtpk(b[0], b[1]); w.w = cvtpk(b[2], b[3]); return __builtin_bit_cast(bf16x8, w); }

__device__ __forceinline__ void gdn_prep_chunk(Frame& F, int ci, LAS unsigned char* wl  ) {
    const int lane = F.lane, bh = ci >> 6, n = ci & 63, b = bh >> 3, hh = bh & 7, fr = lane & 15, fq = lane >> 4;
    const size_t m0 = (size_t)b * T + 64 * n;
    bf16* const cA = F.CHKA + (size_t)ci * 16384;
    bf16* const cU = F.CHKU + (size_t)ci * 4096;
    const float g = ld_f32_coh(F.gb + (m0 + lane) * 16 + hh), beta = ld_f32_coh(F.gb + (m0 + lane) * 16 + 8 + hh);
    float G = g;
#pragma unroll
    for (int o = 1; o < 64; o <<= 1) { const float t = __shfl_up(G, o); if (lane >= o) G += t; }
    const float eG = __expf(G), Glast = __shfl(G, 63), kdsc = __expf(Glast - G), beG = beta * eG;
    if (lane == 0) F.dec[ci] = __expf(Glast);
    const int offcol = ((lane >> 5) * 64 + 16 * ((lane & 15) >> 2)) * 8 + 4 * ((lane >> 4) & 1) + (lane & 3);
    LAS bf16* const Qn = (LAS bf16*)wl; LAS bf16* const Kn = (LAS bf16*)(wl + 8192);
    {
        const bf16* src = F.PQ + m0 * NP + C_GQ + hh * 64 + lane;
        const float w0 = F.conv_w[hh * 64 + lane], w1 = F.conv_w[1536 + hh * 64 + lane], w2 = F.conv_w[2 * 1536 + hh * 64 + lane], w3 = F.conv_w[3 * 1536 + hh * 64 + lane];
        float x0 = 0.f, x1 = 0.f, x2 = 0.f;
        if (n > 0) { x0 = bf2f(*(src - 3 * NP)); x1 = bf2f(*(src - 2 * NP)); x2 = bf2f(*(src - NP)); }
        bf16* qd = cA + 4096 + offcol;
#pragma unroll
        for (int c = 0; c < 64; ++c) {
            const float r = bf2f(src[(size_t)c * NP]);
            const float cq = silu(w0 * x0 + w1 * x1 + w2 * x2 + w3 * r); x0 = x1; x1 = x2; x2 = r;
            const float qn = cq / sqrtf(wave_sum(cq * cq) + EPS);
            Qn[c * 64 + lane] = (bf16)f2bf(qn);
            qd[((c >> 4) * 128 + (c & 15)) * 8] = (bf16)f2bf(qn * rdlane(eG, c) * 0.125f);
        }
    }
    {
        const bf16* src = F.PQ + m0 * NP + C_GK + hh * 64 + lane;
        const float w0 = F.conv_w[512 + hh * 64 + lane], w1 = F.conv_w[1536 + 512 + hh * 64 + lane], w2 = F.conv_w[2 * 1536 + 512 + hh * 64 + lane], w3 = F.conv_w[3 * 1536 + 512 + hh * 64 + lane];
        float x0 = 0.f, x1 = 0.f, x2 = 0.f;
        if (n > 0) { x0 = bf2f(*(src - 3 * NP)); x1 = bf2f(*(src - 2 * NP)); x2 = bf2f(*(src - NP)); }
        bf16* kdt = cA + 3 * 4096 + (lane >> 4) * 2 * 64 * 8 + (lane & 15) * 8;
        float kq[4];
#pragma unroll
        for (int c = 0; c < 64; ++c) {
            const float r = bf2f(src[(size_t)c * NP]);
            const float ck = silu(w0 * x0 + w1 * x1 + w2 * x2 + w3 * r); x0 = x1; x1 = x2; x2 = r;
            const float kn = ck / sqrtf(wave_sum(ck * ck) + EPS);
            Kn[c * 64 + lane] = (bf16)f2bf(kn);
            kq[c & 3] = kn * rdlane(kdsc, c);
            if ((c & 3) == 3) { const int c0 = c - 3;
                unsigned long long pk = (unsigned long long)cvtpk(kq[0], kq[1]) | ((unsigned long long)cvtpk(kq[2], kq[3]) << 32);
                *(unsigned long long*)(kdt + ((c0 >> 5) * 64 + 16 * ((c0 & 15) >> 2)) * 8 + 4 * ((c0 >> 4) & 1)) = pk; }
        }
    }
    LDS_WAIT(); asm volatile("" ::: "memory");
    bf16x8 kf[4][2], qf[4][2];
#pragma unroll
    for (int blk = 0; blk < 4; ++blk)
#pragma unroll
        for (int kk = 0; kk < 2; ++kk) { kf[blk][kk] = *(const LAS bf16x8*)(Kn + (16 * blk + fr) * 64 + 32 * kk + 8 * fq); qf[blk][kk] = *(const LAS bf16x8*)(Qn + (16 * blk + fr) * 64 + 32 * kk + 8 * fq); }
    float Gcol[4], Bcol[4], Grow[4][4];
#pragma unroll
    for (int t = 0; t < 4; ++t) { Gcol[t] = __shfl(G, 16 * t + fr); Bcol[t] = __shfl(beta, 16 * t + fr);
#pragma unroll
        for (int i = 0; i < 4; ++i) Grow[t][i] = __shfl(G, 16 * t + 4 * fq + i); }
    LDS_WAIT(); asm volatile("" ::: "memory");
#pragma unroll
    for (int tc = 0; tc < 4; ++tc)
#pragma unroll
        for (int ks = 0; ks < 2; ++ks) {
            f32x4 v[2];
#pragma unroll
            for (int h2 = 0; h2 < 2; ++h2) { const int ts = 2 * ks + h2;
                if (ts <= tc) { f32x4 acc = (f32x4){0.f, 0.f, 0.f, 0.f};
                    acc = __builtin_amdgcn_mfma_f32_16x16x32_bf16(kf[ts][0], qf[tc][0], acc, 0, 0, 0); acc = __builtin_amdgcn_mfma_f32_16x16x32_bf16(kf[ts][1], qf[tc][1], acc, 0, 0, 0);
#pragma unroll
                    for (int i = 0; i < 4; ++i) { const int cidx = 16 * tc + fr, sidx = 16 * ts + 4 * fq + i; v[h2][i] = (cidx >= sidx) ? acc[i] * __expf(Gcol[tc] - Grow[ts][i]) * 0.125f : 0.f; }
                } else v[h2] = (f32x4){0.f, 0.f, 0.f, 0.f}; }
            *(bf16x8*)(cA + 2 * 4096 + ((tc * 2 + ks) * 64 + lane) * 8) = pack8(v[0], v[1]);
        }
    LAS bf16* const Am = (LAS bf16*)wl;
#pragma unroll
    for (int tc = 0; tc < 4; ++tc)
#pragma unroll
        for (int ts = 0; ts <= tc; ++ts) { f32x4 acc = (f32x4){0.f, 0.f, 0.f, 0.f};
            acc = __builtin_amdgcn_mfma_f32_16x16x32_bf16(kf[ts][0], kf[tc][0], acc, 0, 0, 0); acc = __builtin_amdgcn_mfma_f32_16x16x32_bf16(kf[ts][1], kf[tc][1], acc, 0, 0, 0);
            f32x4 a;
#pragma unroll
            for (int i = 0; i < 4; ++i) { const int cidx = 16 * tc + fr, sidx = 16 * ts + 4 * fq + i; a[i] = (cidx > sidx) ? Bcol[tc] * acc[i] * __expf(Gcol[tc] - Grow[ts][i]) : 0.f; }
            *(LAS unsigned long long*)(Am + (16 * tc + fr) * 64 + 16 * ts + 4 * fq) = (unsigned long long)cvtpk(a[0], a[1]) | ((unsigned long long)cvtpk(a[2], a[3]) << 32); }
    LDS_WAIT(); asm volatile("" ::: "memory");
    float Ar[64], xk[64];
#pragma unroll
    for (int c = 1; c < 64; ++c) Ar[c] = bf2f(Am[c * 64 + lane]);
#pragma unroll
    for (int c = 0; c < 64; ++c) xk[c] = bf2f(Kn[c * 64 + lane]) * rdlane(beG, c);
    LDS_WAIT(); asm volatile("" ::: "memory");
#pragma unroll
    for (int c = 1; c < 64; ++c) {
#pragma unroll
        for (int s = 0; s < c; ++s) xk[c] -= rdlane(Ar[c], s) * xk[s];
    }
    {
        bf16* wm = cA + offcol;
#pragma unroll
        for (int c = 0; c < 64; ++c) wm[((c >> 4) * 128 + (c & 15)) * 8] = (bf16)f2bf(-xk[c]);
    }
    float xv[64];
    {
        const bf16* src = F.PQ + m0 * NP + C_GV + hh * 64 + lane;
        const float w0 = F.conv_w[1024 + hh * 64 + lane], w1 = F.conv_w[1536 + 1024 + hh * 64 + lane], w2 = F.conv_w[2 * 1536 + 1024 + hh * 64 + lane], w3 = F.conv_w[3 * 1536 + 1024 + hh * 64 + lane];
        float x0 = 0.f, x1 = 0.f, x2 = 0.f;
        if (n > 0) { x0 = bf2f(*(src - 3 * NP)); x1 = bf2f(*(src - 2 * NP)); x2 = bf2f(*(src - NP)); }
#pragma unroll
        for (int c = 0; c < 64; ++c) {
            const float r = bf2f(src[(size_t)c * NP]);
            const float cv = silu(w0 * x0 + w1 * x1 + w2 * x2 + w3 * r); x0 = x1; x1 = x2; x2 = r;
            xv[c] = cv * rdlane(beta, c);
        }
    }
#pragma unroll
    for (int c = 1; c < 64; ++c) {
#pragma unroll
        for (int s = 0; s < c; ++s) xv[c] -= rdlane(Ar[c], s) * xv[s];
    }
    {
        bf16* up = cU + ((lane >> 4) * 4 * 64 + (lane & 15)) * 4;
#pragma unroll
        for (int c4 = 0; c4 < 16; ++c4) { const unsigned long long pk = (unsigned long long)cvtpk(xv[4 * c4], xv[4 * c4 + 1]) | ((unsigned long long)cvtpk(xv[4 * c4 + 2], xv[4 * c4 + 3]) << 32);
            *(unsigned long long*)(up + ((c4 >> 2) * 64 + 16 * (c4 & 3)) * 4) = pk; }
    }
    LDS_WAIT(); asm volatile("" ::: "memory");
}

#define GDN_BAR() do { asm volatile("" ::: "memory"); __builtin_amdgcn_s_barrier(); asm volatile("" ::: "memory"); } while (0)
__device__ __forceinline__ void gdn_scan(Frame& F, int bh) {
    const int lane = F.lane, wave = F.wave, b = bh >> 3, hh = bh & 7, fr = lane & 15, fq = lane >> 4;
    LAS unsigned char* const ring = F.lds + RING_OFF;
    constexpr int SLOT = 40960, OB0 = 122880, OB1 = 132096;
    const unsigned char* gA = (const unsigned char*)(F.CHKA + (size_t)bh * 64 * 16384);
    const unsigned char* gU = (const unsigned char*)(F.CHKU + (size_t)bh * 64 * 4096);
    if (wave >= 6) {
        const int nt = (wave - 6) * 64 + lane, oc = nt & 7;
        float nw[8];
#pragma unroll
        for (int j = 0; j < 8; ++j) nw[j] = F.gdn_norm_w[oc * 8 + j];
        const bf16* zp = F.PQ + ((size_t)b * T + (nt >> 3)) * NP + C_GZ + hh * 64 + oc * 8;
        bf16* mp = F.MIX + ((size_t)b * T + (nt >> 3)) * D + hh * 64 + oc * 8;
        v4u zc[4], zn[4];
#define GDN_NORM(nn) do { const LAS unsigned char* ob_ = ring + (((nn) & 1) ? OB1 : OB0); _Pragma("unroll") for (int k_ = 0; k_ < 4; ++k_) { \
            const v4u ov_ = *(const LAS v4u*)(ob_ + (nt + 128 * k_) * 16); const unsigned ow_[4] = {ov_.x, ov_.y, ov_.z, ov_.w}, zw_[4] = {zc[k_].x, zc[k_].y, zc[k_].z, zc[k_].w}; \
            float o_[8], z_[8]; float ss_ = 0.f; \
            _Pragma("unroll") for (int w_ = 0; w_ < 4; ++w_) { o_[2 * w_] = __uint_as_float(ow_[w_] << 16); o_[2 * w_ + 1] = __uint_as_float(ow_[w_] & 0xffff0000u); z_[2 * w_] = __uint_as_float(zw_[w_] << 16); z_[2 * w_ + 1] = __uint_as_float(zw_[w_] & 0xffff0000u); \
                ss_ += o_[2 * w_] * o_[2 * w_] + o_[2 * w_ + 1] * o_[2 * w_ + 1]; } \
            ss_ += __shfl_xor(ss_, 1); ss_ += __shfl_xor(ss_, 2); ss_ += __shfl_xor(ss_, 4); \
            const float rs_ = __builtin_amdgcn_rsqf(ss_ * (1.0f / 64.0f) + EPS); float r_[8]; \
            _Pragma("unroll") for (int j_ = 0; j_ < 8; ++j_) r_[j_] = o_[j_] * rs_ * nw[j_] * z_[j_];     \
            v4u w4_; w4_.x = cvtpk(r_[0], r_[1]); w4_.y = cvtpk(r_[2], r_[3]); w4_.z = cvtpk(r_[4], r_[5]); w4_.w = cvtpk(r_[6], r_[7]); \
            *(GAS v4u*)(mp + (size_t)(64 * (nn) + 16 * k_) * D) = w4_; } } while (0)
        GDN_BAR();
        for (int n = 0; n < 64; ++n) {
#pragma unroll
            for (int k = 0; k < 4; ++k) zn[k] = *(const GAS v4u*)(zp + (size_t)(64 * n + 16 * k) * NP);
            if (n > 0) GDN_NORM(n - 1);
#pragma unroll
            for (int k = 0; k < 4; ++k) zc[k] = zn[k];
            LDS_WAIT(); GDN_BAR();
        }
        GDN_NORM(63);
#undef GDN_NORM
    } else if (wave >= 4) {
        const int lw = wave - 4;
#define GDN_ISSUE(nn) do { const int n_ = (nn); const int sl_ = n_ % 3; _Pragma("unroll") for (int i_ = 0; i_ < 20; ++i_) { const int p_ = lw * 20 + i_; \
            const unsigned char* s_ = (p_ < 32) ? gA + (size_t)n_ * 32768 + p_ * 1024 : gU + (size_t)n_ * 8192 + (p_ - 32) * 1024; \
            __builtin_amdgcn_global_load_lds((const unsigned*)(s_ + lane * 16), (LAS unsigned*)(ring + sl_ * SLOT + p_ * 1024), 16, 0, 0); } } while (0)
        GDN_ISSUE(0); GDN_ISSUE(1);
        asm volatile("s_waitcnt vmcnt(20)" ::: "memory"); GDN_BAR();
        for (int n = 0; n < 64; ++n) {
            if (n + 2 < 64) { GDN_ISSUE(n + 2); asm volatile("s_waitcnt vmcnt(20)" ::: "memory"); } else asm volatile("s_waitcnt vmcnt(0)" ::: "memory");
            GDN_BAR();
        }
#undef GDN_ISSUE
    } else {
        const int ew = wave;
        f32x4 Sacc[4];
#pragma unroll
        for (int t = 0; t < 4; ++t) Sacc[t] = (f32x4){0.f, 0.f, 0.f, 0.f};
        const float* decp = F.dec + bh * 64;
        float dnext = ld_f32_coh(decp);
        GDN_BAR();
        for (int n = 0; n < 64; ++n) {
            const LAS unsigned char* sl = ring + (n % 3) * SLOT;
            LAS bf16* ob = (LAS bf16*)(ring + ((n & 1) ? OB1 : OB0)) + (4 * fq) * 64 + 16 * ew + fr;
            const float dec = dnext; if (n + 1 < 64) dnext = ld_f32_coh(decp + n + 1);
            f32x4 V[4], O[4];
#pragma unroll
            for (int mt = 0; mt < 4; ++mt) { const unsigned long long uu = *(const LAS unsigned long long*)(sl + 32768 + ((ew * 4 + mt) * 64 + lane) * 8); const unsigned lo = (unsigned)uu, hi = (unsigned)(uu >> 32);
                V[mt] = (f32x4){__uint_as_float(lo << 16), __uint_as_float(lo & 0xffff0000u), __uint_as_float(hi << 16), __uint_as_float(hi & 0xffff0000u)}; O[mt] = (f32x4){0.f, 0.f, 0.f, 0.f}; }
            bf16x8 Sb[2]; Sb[0] = pack8(Sacc[0], Sacc[1]); Sb[1] = pack8(Sacc[2], Sacc[3]);
#pragma unroll
            for (int mt = 0; mt < 4; ++mt)
#pragma unroll
                for (int ks = 0; ks < 2; ++ks) { const bf16x8 wf = *(const LAS bf16x8*)(sl + ((mt * 2 + ks) * 64 + lane) * 16), qf = *(const LAS bf16x8*)(sl + 8192 + ((mt * 2 + ks) * 64 + lane) * 16);
                    V[mt] = __builtin_amdgcn_mfma_f32_16x16x32_bf16(wf, Sb[ks], V[mt], 0, 0, 0); O[mt] = __builtin_amdgcn_mfma_f32_16x16x32_bf16(qf, Sb[ks], O[mt], 0, 0, 0); }
            bf16x8 Vb[2]; Vb[0] = pack8(V[0], V[1]); Vb[1] = pack8(V[2], V[3]);
#pragma unroll
            for (int t = 0; t < 4; ++t) Sacc[t] = Sacc[t] * dec;
#pragma unroll
            for (int mt = 0; mt < 4; ++mt)
#pragma unroll
                for (int ks = 0; ks < 2; ++ks) { const bf16x8 af = *(const LAS bf16x8*)(sl + 16384 + ((mt * 2 + ks) * 64 + lane) * 16), kf = *(const LAS bf16x8*)(sl + 24576 + ((mt * 2 + ks) * 64 + lane) * 16);
                    O[mt] = __builtin_amdgcn_mfma_f32_16x16x32_bf16(af, Vb[ks], O[mt], 0, 0, 0); Sacc[mt] = __builtin_amdgcn_mfma_f32_16x16x32_bf16(kf, Vb[ks], Sacc[mt], 0, 0, 0); }
#pragma unroll
            for (int mt = 0; mt < 4; ++mt)
#pragma unroll
                for (int i = 0; i < 4; ++i) ob[(16 * mt + i) * 64] = (bf16)(cvtpk(O[mt][i], O[mt][i]) & 0xffffu);
            LDS_WAIT(); GDN_BAR();
        }
    }
}
__device__ __forceinline__ void swa_unit(Frame& F, int unit, LAS unsigned char* L) {
    const int tid = F.tid, lane = F.lane, wave = F.wave, fr = lane & 15, fq = lane >> 4;
    const int blk = unit & 63, kvh = (unit >> 6) & 1, b = unit >> 7, t0 = blk * 64;
    const size_t row0 = (size_t)b * T;
    LAS bf16* const Ks = (LAS bf16*)L; LAS bf16* const Vt = (LAS bf16*)(L + 27648);
    for (int p = tid; p < 1536; p += NWAVES * 64) {
        const int key = p >> 3, oc = p & 7, s = t0 - 128 + key;
        v4u kv = (v4u){0u, 0u, 0u, 0u}, vv = (v4u){0u, 0u, 0u, 0u};
        if (s >= 0) { kv = *(const GAS v4u*)(F.PQ + (row0 + s) * NP + C_SK + kvh * 64 + oc * 8); vv = *(const GAS v4u*)(F.PQ + (row0 + s) * NP + C_SV + kvh * 64 + oc * 8); }
        const unsigned kw[4] = {kv.x, kv.y, kv.z, kv.w}, vw[4] = {vv.x, vv.y, vv.z, vv.w};
        float k[8]; float ss = 0.f;
#pragma unroll
        for (int w = 0; w < 4; ++w) { k[2 * w] = __uint_as_float(kw[w] << 16); k[2 * w + 1] = __uint_as_float(kw[w] & 0xffff0000u); ss += k[2 * w] * k[2 * w] + k[2 * w + 1] * k[2 * w + 1]; }
        ss += __shfl_xor(ss, 1); ss += __shfl_xor(ss, 2); ss += __shfl_xor(ss, 4);
        const float rstd = 1.0f / sqrtf(ss * (1.0f / 64.0f) + EPS);
#pragma unroll
        for (int j = 0; j < 8; ++j) k[j] = k[j] * rstd * F.k_norm_w[oc * 8 + j];
        v4u o; o.x = cvtpk(k[0], k[1]); o.y = cvtpk(k[2], k[3]); o.z = cvtpk(k[4], k[5]); o.w = cvtpk(k[6], k[7]);
        *(LAS v4u*)(Ks + key * 72 + oc * 8) = o;
#pragma unroll
        for (int w = 0; w < 4; ++w) { Vt[(oc * 8 + 2 * w) * 196 + key] = (bf16)(vw[w] & 0xffffu); Vt[(oc * 8 + 2 * w + 1) * 196 + key] = (bf16)(vw[w] >> 16); }
    }
    __syncthreads();
    const int hq = kvh * 4 + (wave >> 1);
    const float slope = exp2f(-(float)(hq + 1)), sink = F.sinks[hq];
#pragma unroll 1
    for (int qt = 0; qt < 2; ++qt) {
        const int tq0 = t0 + 32 * (wave & 1) + 16 * qt;
        bf16x8 qf[2];
        {
            const bf16* qp = F.PQ + (row0 + tq0 + fr) * NP + C_SQ + hq * 64 + 8 * fq;
            const v4u r0 = *(const GAS v4u*)qp, r1 = *(const GAS v4u*)(qp + 32);
            const unsigned qw[8] = {r0.x, r0.y, r0.z, r0.w, r1.x, r1.y, r1.z, r1.w};
            float q[16]; float ss = 0.f;
#pragma unroll
            for (int w = 0; w < 8; ++w) { q[2 * w] = __uint_as_float(qw[w] << 16); q[2 * w + 1] = __uint_as_float(qw[w] & 0xffff0000u); ss += q[2 * w] * q[2 * w] + q[2 * w + 1] * q[2 * w + 1]; }
            ss += __shfl_xor(ss, 16); ss += __shfl_xor(ss, 32);
            const float rstd = 0.125f / sqrtf(ss * (1.0f / 64.0f) + EPS);
#pragma unroll
            for (int kk = 0; kk < 2; ++kk) { float z[8];
#pragma unroll
                for (int j = 0; j < 8; ++j) z[j] = q[8 * kk + j] * rstd * F.q_norm_w[32 * kk + 8 * fq + j];
                v4u o; o.x = cvtpk(z[0], z[1]); o.y = cvtpk(z[2], z[3]); o.z = cvtpk(z[4], z[5]); o.w = cvtpk(z[6], z[7]); qf[kk] = __builtin_bit_cast(bf16x8, o); }
        }
        f32x4 sc[12]; float mx = -INFINITY;
#pragma unroll
        for (int nt = 0; nt < 12; ++nt) { f32x4 acc = (f32x4){0.f, 0.f, 0.f, 0.f};
#pragma unroll
            for (int kk = 0; kk < 2; ++kk) { const bf16x8 kf = *(const LAS bf16x8*)(Ks + (16 * nt + fr) * 72 + 32 * kk + 8 * fq); acc = __builtin_amdgcn_mfma_f32_16x16x32_bf16(kf, qf[kk], acc, 0, 0, 0); }
#pragma unroll
            for (int i = 0; i < 4; ++i) { const int s = t0 - 128 + 16 * nt + 4 * fq + i, dist = tq0 + fr - s; const bool ok = (s >= 0) && (dist >= 0) && (dist < 128);
                const float v = ok ? acc[i] - slope * (float)dist : -INFINITY; acc[i] = v; mx = fmaxf(mx, v); }
            sc[nt] = acc; }
        mx = fmaxf(mx, __shfl_xor(mx, 16)); mx = fmaxf(mx, __shfl_xor(mx, 32)); mx = fmaxf(mx, sink);
        float sum = 0.f;
#pragma unroll
        for (int nt = 0; nt < 12; ++nt)
#pragma unroll
            for (int i = 0; i < 4; ++i) { const float p = __expf(sc[nt][i] - mx); sc[nt][i] = p; sum += p; }
        sum += __shfl_xor(sum, 16); sum += __shfl_xor(sum, 32);
        const float den = sum + __expf(sink - mx);
        bf16x8 pf[6];
#pragma unroll
        for (int ks = 0; ks < 6; ++ks) pf[ks] = pack8(sc[2 * ks], sc[2 * ks + 1]);
        float rden[4];
#pragma unroll
        for (int i = 0; i < 4; ++i) rden[i] = 1.0f / __shfl(den, 4 * fq + i);
        bf16* op = F.MIX + (row0 + tq0 + 4 * fq) * D + 512 + hq * 64 + fr;
#pragma unroll 1
        for (int dt = 0; dt < 4; ++dt) { f32x4 oacc = (f32x4){0.f, 0.f, 0.f, 0.f};
#pragma unroll
            for (int ks = 0; ks < 6; ++ks) { const LAS bf16* vp = Vt + (16 * dt + fr) * 196 + 32 * ks + 4 * fq;
                const unsigned long long lo = *(const LAS unsigned long long*)vp, hi = *(const LAS unsigned long long*)(vp + 16);
                v4u vv; vv.x = (unsigned)lo; vv.y = (unsigned)(lo >> 32); vv.z = (unsigned)hi; vv.w = (unsigned)(hi >> 32);
                oacc = __builtin_amdgcn_mfma_f32_16x16x32_bf16(pf[ks], __builtin_bit_cast(bf16x8, vv), oacc, 0, 0, 0); }
#pragma unroll
            for (int i = 0; i < 4; ++i) op[(size_t)i * D + 16 * dt] = (bf16)f2bf(oacc[i] * rden[i]); }
    }
    __syncthreads();
}
__device__ __forceinline__ void p3a_prep(Frame& F) {
    LAS unsigned char* wl = F.lds + RING_OFF + F.wave * 16384;
    const int gw = F.vcu * NWAVES + F.wave, NGW = F.G * NWAVES;
    for (int ci = gw; ci < BATCH * 8 * (T / 64); ci += NGW) gdn_prep_chunk(F, ci, wl);
}
__device__ __forceinline__ void p3b_mixers(Frame& F) {
    const int bx = blockIdx.x;
    if (bx < 32) { gdn_scan(F, bx); return; }
    for (int u = bx - 32; u < BATCH * 2 * (T / 64); u += F.G - 32) swa_unit(F, u, F.lds + RING_OFF);
}

struct Args { const float* in[18]; float* out; unsigned char* ws; };
__global__ void __launch_bounds__(NWAVES * 64, 2) hymba_fwd(Args args) {
    extern __shared__ __attribute__((aligned(16))) unsigned char lds[];
    Frame F;
    F.lds = (LAS unsigned char*)lds;
    F.MISC = (volatile LAS unsigned*)(F.lds + MISC_OFF);
    F.tid = threadIdx.x; F.lane = F.tid & 63; F.wave = __builtin_amdgcn_readfirstlane(F.tid >> 6);
    F.G = gridDim.x; { const int bx = blockIdx.x; F.vcu = (F.G % 8 == 0) ? (bx % 8) * (F.G / 8) + bx / 8 : bx; }
    unsigned char* ws = args.ws;
    F.ctl = (gu32*)(ws + WS_CTL);
    F.x = args.in[0]; F.c = args.in[1]; F.w_ada = args.in[2]; F.b_ada = args.in[3]; F.norm1_w = args.in[4]; F.w_in = args.in[5]; F.conv_w = args.in[6];
    F.a_log = args.in[7]; F.dt_bias = args.in[8]; F.gdn_norm_w = args.in[9]; F.q_norm_w = args.in[10]; F.k_norm_w = args.in[11]; F.sinks = args.in[12];
    F.w_out = args.in[13]; F.norm2_w = args.in[14]; F.w_gate = args.in[15]; F.w_up = args.in[16]; F.w_down = args.in[17]; F.out = args.out;
    F.modacc = (float*)(ws + WS_CTL) + CW_MODACC; F.modf = (float*)(ws + WS_MODF); F.wab = (float*)(ws + WS_WAB); F.gb = (float*)(ws + WS_GB);
    F.Win_t = (bf16*)(ws + WS_WIN); F.Wout_t = (bf16*)(ws + WS_WOUT); F.Wgu_t = (bf16*)(ws + WS_WGU); F.Wdn_t = (bf16*)(ws + WS_WDN);
    F.H = (bf16*)(ws + WS_H); F.PQ = (bf16*)(ws + WS_PQ); F.MIX = (bf16*)(ws + WS_MIX); F.CHKA = (bf16*)(ws + WS_CHKA); F.CHKU = (bf16*)(ws + WS_H); F.dec = (float*)(ws + WS_DEC);
    for (int u = F.tid; u < (LDS_BYTES - LDSCTL_OFF) / 4; u += NWAVES * 64) ((LAS unsigned*)(F.lds + LDSCTL_OFF))[u] = 0u;
    __syncthreads();
    XcdBarrier bar = xcd_barrier_post((unsigned*)(F.ctl + CW_BAR), F.MISC + 8);
#define GRID_BAR() xcd_barrier(bar)

    p0_prologue(F); GRID_BAR();
    norm_phase<1>(F); GRID_BAR();
    { pg8::Gemm g{F.H, F.Win_t, M, NP, D}; pg8::StaticOrder S; S.init(M, NP, F.G, (int)blockIdx.x);
      pg8::EpiBf16Plain E{F.PQ, NP, C_GZ / 256, C_SQ / 256};
      pg8::gemm_phase<pg8::EpiBf16Plain, pg8::StaticOrder, true, true>(F.lds + RING_OFF, g, S, E); }
    GRID_BAR();
    p3a_prep(F); GRID_BAR();
    p3b_mixers(F); GRID_BAR();
    { pg8::Gemm g{F.MIX, F.Wout_t, M, D, D}; pg8::StaticOrder S; S.init(M, D, F.G, (int)blockIdx.x);
      pg8::EpiGateRes E{F.x, F.out, D, F.modf + 2 * D, 6 * D, T};
      pg8::gemm_phase<pg8::EpiGateRes, pg8::StaticOrder, true, true>(F.lds + RING_OFF, g, S, E); }
    GRID_BAR();
    norm_phase<2>(F); GRID_BAR();
    { pg8::Gemm g{F.H, F.Wgu_t, M, NGU, D}; pg8::StaticOrder S; S.init(M, NGU, F.G, (int)blockIdx.x);
      pg8::EpiSwiGLU E{F.PQ, FF};
      pg8::gemm_phase<pg8::EpiSwiGLU, pg8::StaticOrder, true, true>(F.lds + RING_OFF, g, S, E); }
    GRID_BAR();
    { pg8::Gemm g{F.PQ, F.Wdn_t, M, D, FF}; pg8::StaticOrder S; S.init(M, D, F.G, (int)blockIdx.x);
      pg8::EpiGateRes E{F.out, F.out, D, F.modf + 5 * D, 6 * D, T};
      pg8::gemm_phase<pg8::EpiGateRes, pg8::StaticOrder, true, true>(F.lds + RING_OFF, g, S, E); }
#undef GRID_BAR
}

extern "C" void kernel_launch(void* const* d_in, const int* in_sizes, int n_in, void* d_out, int out_size, void* d_ws, size_t ws_size, hipStream_t stream) {
    static int grid = 0;
    if (grid == 0) {
        if (n_in != 18 || in_sizes[0] != M * D || out_size != M * D || ws_size < WS_END) { fprintf(stderr, "kernel_launch: unexpected shapes (n_in %d, in0 %d, out %d, ws %zu); nothing launched\n", n_in, n_in > 0 ? in_sizes[0] : -1, out_size, ws_size); grid = -1; return; }
        int dev = 0, cus = 0;
        if (hipGetDevice(&dev) != hipSuccess || hipDeviceGetAttribute(&cus, hipDeviceAttributeMultiprocessorCount, dev) != hipSuccess) { grid = -1; return; }
        if (hipFuncSetAttribute((const void*)hymba_fwd, hipFuncAttributeMaxDynamicSharedMemorySize, LDS_BYTES) != hipSuccess) { fprintf(stderr, "kernel_launch: hipFuncSetAttribute failed\n"); grid = -1; return; }
        (void)hipGetLastError();
        grid = cus;
    }
    if (grid < 0) return;
    if (hipMemsetAsync((char*)d_ws + WS_CTL, 0, CTL_ZERO_BYTES, stream) != hipSuccess) { fprintf(stderr, "kernel_launch: hipMemsetAsync failed\n"); return; }
    Args a{};
    for (int i = 0; i < 18; ++i) a.in[i] = (const float*)d_in[i];
    a.out = (float*)d_out; a.ws = (unsigned char*)d_ws;
    hipLaunchKernelGGL(hymba_fwd, dim3(grid), dim3(NWAVES * 64), LDS_BYTES, stream, a);
    const hipError_t le = hipPeekAtLastError();
    if (le != hipSuccess) fprintf(stderr, "kernel_launch: launch failed: %s\n", hipGetErrorName(le));
}
```

```cpp
#include <hip/hip_runtime.h>
#include <cstdio>
#include <cstdint>
#include <cmath>
namespace pg8 {
#define PG8_LAS __attribute__((address_space(3)))
typedef unsigned short bf16_t;
typedef short bf16x8 __attribute__((ext_vector_type(8)));
typedef float f32x4 __attribute__((ext_vector_type(4)));
typedef unsigned u32x4 __attribute__((ext_vector_type(4)));
constexpr int BM = 256, BK = 64, HALF = 128, HTB = HALF * BK * 2  , STAGE_BYTES = 8 * HTB, NXCD = 8, WGM = 8;

__host__ __device__ __forceinline__ int lds_byte(int r, int c) { const int st = (r >> 4) * 2 + (c >> 5), rr = r & 15, cc = c & 31, ob = rr * 64 + cc * 2; return st * 1024 + (ob ^ (((ob >> 9) & 1) << 5)); }
__host__ __device__ __forceinline__ void stage_rc(int b, int& R, int& C) { const int st = b / 1024, sb = b % 1024, swz = sb ^ (((sb >> 9) & 1) << 5); R = (st >> 1) * 16 + swz / 64; C = (st & 1) * 32 + (swz % 64) / 2; }
__host__ __device__ __forceinline__ int perm32(int rho) { const int n = rho >> 4, i = rho & 15; return 8 * (i >> 2) + 4 * n + (i & 3); }

struct Unit { int pm, pn; };
struct Gemm { const bf16_t* A; const bf16_t* Bt; int M, N, K; };

struct StaticOrder {
    int nM, nN, nwg, G, c;
    __host__ __device__ void init(int M, int N, int G_, int c_) { nM = M / BM; nN = N / BM; nwg = nM * nN; G = G_; c = c_; }
    __host__ __device__ bool next(int i, Unit& u) const {
        const long L = (long)i * G + c; if (L >= nwg) return false;
        int wgid = (int)L; { const int q = nwg / NXCD, r = nwg % NXCD, xcd = wgid % NXCD, off = wgid / NXCD; wgid = (xcd < r ? xcd * (q + 1) : r * (q + 1) + (xcd - r) * q) + off; }
        const int nig = WGM * nN, gid = wgid / nig, fm = gid * WGM, gsz = (nM - fm) < WGM ? (nM - fm) : WGM;
        u.pm = fm + ((wgid % nig) % gsz); u.pn = (wgid % nig) / gsz; return true;
    }
    __device__ __forceinline__ void a_ready(const Unit&) const {}
    __device__ __forceinline__ void done(const Unit&) const {}
};

__device__ __forceinline__ unsigned cvt_pk_bf16(float lo, float hi) { unsigned r; asm volatile("v_cvt_pk_bf16_f32 %0, %1, %2" : "=v"(r) : "v"(lo), "v"(hi)); return r; }
__device__ __forceinline__ float silu_f(float x) { return x * __builtin_amdgcn_rcpf(1.0f + __expf(-x)); }

struct EpiBf16Plain {
    static constexpr bool PERM = true, AFTER_DRAIN = false;
    bf16_t* O; int ldc; int silu_lo, silu_hi;
    __device__ __forceinline__ void operator()(const f32x4 (&acc)[2][2][4][2], const Unit& u, int wr, int wc, int fr, int fq) const {
        const int row0 = u.pm * BM + wr * 64 + fr, col0 = u.pn * BM + wc * 32 + 8 * fq;
        const bool act = (u.pn >= silu_lo) && (u.pn < silu_hi);
#pragma unroll
        for (int ai = 0; ai < 2; ++ai)
#pragma unroll
            for (int m = 0; m < 4; ++m) { bf16_t* rowp = O + (size_t)(row0 + ai * HALF + m * 16) * ldc + col0;
#pragma unroll
                for (int bj = 0; bj < 2; ++bj) { f32x4 v0 = acc[ai][bj][m][0], v1 = acc[ai][bj][m][1];
                    if (act) {
#pragma unroll
                        for (int i = 0; i < 4; ++i) { v0[i] = silu_f(v0[i]); v1[i] = silu_f(v1[i]); } }
                    u32x4 w; w.x = cvt_pk_bf16(v0[0], v0[1]); w.y = cvt_pk_bf16(v0[2], v0[3]); w.z = cvt_pk_bf16(v1[0], v1[1]); w.w = cvt_pk_bf16(v1[2], v1[3]);
                    *(u32x4*)(rowp + bj * HALF) = w; } }
    }
};
struct EpiSwiGLU {
    static constexpr bool PERM = true, AFTER_DRAIN = false;
    bf16_t* O; int ldc;
    __device__ __forceinline__ void operator()(const f32x4 (&acc)[2][2][4][2], const Unit& u, int wr, int wc, int fr, int fq) const {
        const int row0 = u.pm * BM + wr * 64 + fr, col0 = u.pn * HALF + wc * 32 + 8 * fq;
#pragma unroll
        for (int ai = 0; ai < 2; ++ai)
#pragma unroll
            for (int m = 0; m < 4; ++m) { bf16_t* rowp = O + (size_t)(row0 + ai * HALF + m * 16) * ldc + col0;
                const f32x4 g0 = acc[ai][0][m][0], g1 = acc[ai][0][m][1], u0 = acc[ai][1][m][0], u1 = acc[ai][1][m][1];
                float a[8];
#pragma unroll
                for (int i = 0; i < 4; ++i) { a[i] = silu_f(g0[i]) * u0[i]; a[4 + i] = silu_f(g1[i]) * u1[i]; }
                u32x4 w; w.x = cvt_pk_bf16(a[0], a[1]); w.y = cvt_pk_bf16(a[2], a[3]); w.z = cvt_pk_bf16(a[4], a[5]); w.w = cvt_pk_bf16(a[6], a[7]);
                *(u32x4*)rowp = w; }
    }
};
struct EpiGateRes {
    static constexpr bool PERM = false, AFTER_DRAIN = false;
    const float* base; float* out; int ldc; const float* gate; int gstride; int rows_per_batch;
    __device__ __forceinline__ void operator()(const f32x4 (&acc)[2][2][4][2], const Unit& u, int wr, int wc, int fr, int fq) const {
        const int row0 = u.pm * BM + wr * 64 + fr, col0 = u.pn * BM + wc * 32 + 4 * fq;
        const float* gp = gate + (size_t)((u.pm * BM) / rows_per_batch) * gstride + col0;
        f32x4 gv[2][2];
#pragma unroll
        for (int bj = 0; bj < 2; ++bj)
#pragma unroll
            for (int n = 0; n < 2; ++n) gv[bj][n] = *(const f32x4*)(gp + bj * HALF + n * 16);
#pragma unroll
        for (int ai = 0; ai < 2; ++ai)
#pragma unroll
            for (int m = 0; m < 4; ++m) { const size_t off = (size_t)(row0 + ai * HALF + m * 16) * ldc + col0;
#pragma unroll
                for (int bj = 0; bj < 2; ++bj)
#pragma unroll
                    for (int n = 0; n < 2; ++n) { const f32x4 bs = *(const f32x4*)(base + off + bj * HALF + n * 16);
                        *(f32x4*)(out + off + bj * HALF + n * 16) = bs + gv[bj][n] * acc[ai][bj][m][n]; } }
    }
};

template <class Epi, class Sched, bool ALIGN_EPI = false, bool SP2 = false>
__device__ __forceinline__ void gemm_phase(PG8_LAS unsigned char* lds, const Gemm g, const Sched& S, const Epi& E) {
    const int tid = threadIdx.x, wid = __builtin_amdgcn_readfirstlane(tid >> 6), lane = tid & 63, wr = wid >> 2, wc = wid & 3, fr = lane & 15, fq = lane >> 4;
    const int K = g.K, nt = K / BK;
    unsigned voffA[2], voffB[2];
#pragma unroll
    for (int i = 0; i < 2; ++i) { int R, C; stage_rc(tid * 16 + i * 8192, R, C); const int Rb = Epi::PERM ? ((R & ~31) + perm32(R & 31)) : R;
        voffA[i] = (unsigned)(R * K + C) * 2u; voffB[i] = (unsigned)(Rb * K + C) * 2u; }
    const size_t kstep = (size_t)(BK * 2);
    const size_t hstep = (size_t)HALF * K * 2;
    const size_t tstep = 2 * hstep;
    const unsigned ldsw = (unsigned)wid * 1024u;
    const int aoff = lds_byte(wr * 64 + fr, fq * 8), boff = lds_byte(wc * 32 + fr, fq * 8);
#define PG8_SA(b, h) (((b) * 2 + (h)) * HTB)
#define PG8_SB(b, h) ((4 + (b) * 2 + (h)) * HTB)
#define PG8_STAGE(bufoff, gbase, voff) do { _Pragma("unroll") for (int _i = 0; _i < 2; ++_i) \
        __builtin_amdgcn_global_load_lds((const unsigned*)((const char*)(gbase) + (voff)[_i]), (PG8_LAS unsigned*)(lds + (bufoff) + ldsw + _i * 8192), 16, 0, 0); } while (0)
#define PG8_LDA(dst, b, h) do { _Pragma("unroll") for (int m = 0; m < 4; ++m) _Pragma("unroll") for (int k = 0; k < 2; ++k) dst[m][k] = *(const PG8_LAS bf16x8*)(lds + PG8_SA(b, h) + aoff + m * 2048 + k * 1024); } while (0)
#define PG8_LDB(dst, b, h) do { _Pragma("unroll") for (int n = 0; n < 2; ++n) _Pragma("unroll") for (int k = 0; k < 2; ++k) dst[n][k] = *(const PG8_LAS bf16x8*)(lds + PG8_SB(b, h) + boff + n * 2048 + k * 1024); } while (0)
#define PG8_MMA(ai, bj, At, Bt) do { __builtin_amdgcn_s_setprio(1); _Pragma("unroll") for (int m = 0; m < 4; ++m) _Pragma("unroll") for (int n = 0; n < 2; ++n) _Pragma("unroll") for (int k = 0; k < 2; ++k) \
        acc[ai][bj][m][n] = __builtin_amdgcn_mfma_f32_16x16x32_bf16(Bt[n][k], At[m][k], acc[ai][bj][m][n], 0, 0, 0); __builtin_amdgcn_s_setprio(0); } while (0)
#define PG8_WAIT_V(n) asm volatile("s_waitcnt vmcnt(" #n ")" ::: "memory")
#define PG8_WAIT_L(n) asm volatile("s_waitcnt lgkmcnt(" #n ")" ::: "memory")
#define PG8_BAR __builtin_amdgcn_s_barrier()
#define PG8_SCHED __builtin_amdgcn_sched_barrier(0)
    Unit cur, nxt; int ui = 0;
    if (!S.next(0, cur)) return;
    f32x4 acc[2][2][4][2];
#pragma unroll
    for (int a = 0; a < 2; ++a)
#pragma unroll
        for (int b = 0; b < 2; ++b)
#pragma unroll
            for (int m = 0; m < 4; ++m)
#pragma unroll
                for (int n = 0; n < 2; ++n) acc[a][b][m][n] = (f32x4){0.f, 0.f, 0.f, 0.f};
    bf16x8 At[4][2], B0[2][2], B1[2][2];
    const char* cA = (const char*)g.A + (size_t)cur.pm * tstep; const char* cB = (const char*)g.Bt + (size_t)cur.pn * tstep;
    S.a_ready(cur);
    if constexpr (SP2) {
        PG8_STAGE(PG8_SB(0, 0), cB, voffB); PG8_STAGE(PG8_SB(0, 1), cB + hstep, voffB); PG8_STAGE(PG8_SA(0, 0), cA, voffA); PG8_STAGE(PG8_SA(0, 1), cA + hstep, voffA);
        if (wr == 1) PG8_BAR;
        PG8_WAIT_V(2); PG8_BAR;
        PG8_STAGE(PG8_SB(1, 0), cB + kstep, voffB); PG8_STAGE(PG8_SA(1, 0), cA + kstep, voffA); PG8_STAGE(PG8_SB(1, 1), cB + hstep + kstep, voffB);
        PG8_WAIT_V(6); PG8_BAR;
    } else {
        PG8_STAGE(PG8_SB(0, 0), cB, voffB); PG8_STAGE(PG8_SA(0, 0), cA, voffA); PG8_STAGE(PG8_SB(0, 1), cB + hstep, voffB); PG8_STAGE(PG8_SA(0, 1), cA + hstep, voffA);
        if (wr == 1) PG8_BAR;
        PG8_WAIT_V(4); PG8_BAR;
        PG8_STAGE(PG8_SB(1, 0), cB + kstep, voffB); PG8_STAGE(PG8_SA(1, 0), cA + kstep, voffA); PG8_STAGE(PG8_SB(1, 1), cB + hstep + kstep, voffB);
        PG8_WAIT_V(6); PG8_BAR;
    }
    for (;;) {
        const bool has_next = S.next(ui + 1, nxt);
        const char* nA = has_next ? (const char*)g.A + (size_t)nxt.pm * tstep : cA; const char* nB = has_next ? (const char*)g.Bt + (size_t)nxt.pn * tstep : cB;
        for (int t = 0; t < nt; t += 2) {
            const bool last = (t == nt - 2);
            const char* a1 = cA + (size_t)(t + 1) * kstep;
            const char* a2 = last ? nA : cA + (size_t)(t + 2) * kstep; const char* b2 = last ? nB : cB + (size_t)(t + 2) * kstep;
            const char* a3 = a2 + kstep; const char* b3 = b2 + kstep;
            if (last && has_next) S.a_ready(nxt);
            if constexpr (SP2) {
            PG8_LDB(B0, 0, 0); PG8_LDB(B1, 0, 1); PG8_SCHED; PG8_LDA(At, 0, 0); PG8_STAGE(PG8_SA(1, 1), a1 + hstep, voffA);
            PG8_WAIT_V(8); PG8_WAIT_L(0); PG8_BAR; PG8_MMA(0, 0, At, B0); PG8_MMA(0, 1, At, B1); PG8_BAR; PG8_SCHED;
            PG8_LDA(At, 0, 1); PG8_STAGE(PG8_SB(0, 0), b2, voffB); PG8_STAGE(PG8_SB(0, 1), b2 + hstep, voffB); PG8_STAGE(PG8_SA(0, 0), a2, voffA);
            PG8_WAIT_V(8); PG8_WAIT_L(0); PG8_BAR; PG8_MMA(1, 0, At, B0); PG8_MMA(1, 1, At, B1); PG8_BAR; PG8_SCHED;
            PG8_LDB(B0, 1, 0); PG8_LDB(B1, 1, 1); PG8_SCHED; PG8_LDA(At, 1, 0); PG8_STAGE(PG8_SA(0, 1), a2 + hstep, voffA);
            PG8_WAIT_V(8); PG8_WAIT_L(0); PG8_BAR; PG8_MMA(0, 0, At, B0); PG8_MMA(0, 1, At, B1); PG8_BAR; PG8_SCHED;
            PG8_LDA(At, 1, 1); PG8_STAGE(PG8_SB(1, 0), b3, voffB); PG8_STAGE(PG8_SB(1, 1), b3 + hstep, voffB); PG8_STAGE(PG8_SA(1, 0), a3, voffA);
            PG8_WAIT_V(8); PG8_WAIT_L(0); PG8_BAR; PG8_MMA(1, 0, At, B0); PG8_MMA(1, 1, At, B1); PG8_BAR; PG8_SCHED;
            } else {
            PG8_LDB(B0, 0, 0); PG8_SCHED; PG8_LDA(At, 0, 0); PG8_STAGE(PG8_SA(1, 1), a1 + hstep, voffA);
            PG8_WAIT_L(8); PG8_BAR; PG8_WAIT_L(0); PG8_MMA(0, 0, At, B0); PG8_BAR; PG8_SCHED;
            PG8_LDB(B1, 0, 1); PG8_STAGE(PG8_SB(0, 0), b2, voffB);
            PG8_BAR; PG8_WAIT_L(0); PG8_MMA(0, 1, At, B1); PG8_BAR;
            PG8_LDA(At, 0, 1); PG8_STAGE(PG8_SA(0, 0), a2, voffA);
            PG8_BAR; PG8_WAIT_L(0); PG8_MMA(1, 0, At, B0); PG8_BAR; PG8_SCHED;
            PG8_STAGE(PG8_SB(0, 1), b2 + hstep, voffB);
            PG8_WAIT_V(6); PG8_BAR; PG8_MMA(1, 1, At, B1); PG8_BAR;
            PG8_LDB(B0, 1, 0); PG8_SCHED; PG8_LDA(At, 1, 0); PG8_STAGE(PG8_SA(0, 1), a2 + hstep, voffA);
            PG8_WAIT_L(8); PG8_BAR; PG8_WAIT_L(0); PG8_MMA(0, 0, At, B0); PG8_BAR; PG8_SCHED;
            PG8_LDB(B1, 1, 1); PG8_STAGE(PG8_SB(1, 0), b3, voffB);
            PG8_BAR; PG8_WAIT_L(0); PG8_MMA(0, 1, At, B1); PG8_BAR;
            PG8_LDA(At, 1, 1); PG8_STAGE(PG8_SA(1, 0), a3, voffA);
            PG8_BAR; PG8_WAIT_L(0); PG8_MMA(1, 0, At, B0); PG8_BAR; PG8_SCHED;
            PG8_STAGE(PG8_SB(1, 1), b3 + hstep, voffB);
            PG8_WAIT_V(6); PG8_BAR; PG8_MMA(1, 1, At, B1); PG8_BAR;
            }
        }
        if constexpr (ALIGN_EPI) { if (wr == 0) PG8_BAR; }
        if constexpr (!Epi::AFTER_DRAIN) { E(acc, cur, wr, wc, fr, fq); S.done(cur); }
        if (!has_next) break;
#pragma unroll
        for (int a = 0; a < 2; ++a)
#pragma unroll
            for (int b = 0; b < 2; ++b)
#pragma unroll
                for (int m = 0; m < 4; ++m)
#pragma unroll
                    for (int n = 0; n < 2; ++n) acc[a][b][m][n] = (f32x4){0.f, 0.f, 0.f, 0.f};
        cur = nxt; cA = nA; cB = nB; ++ui;
        if constexpr (ALIGN_EPI) { if (wr == 1) PG8_BAR; }
    }
    PG8_WAIT_V(0);
    if constexpr (!ALIGN_EPI) { if (wr == 0) PG8_BAR; }
    PG8_BAR;
    if constexpr (Epi::AFTER_DRAIN) { E.fused(acc, cur, wr, wc, fr, fq, lds, wid, lane); S.done(cur); }
#undef PG8_SA
#undef PG8_SB
#undef PG8_STAGE
#undef PG8_LDA
#undef PG8_LDB
#undef PG8_MMA
#undef PG8_WAIT_V
#undef PG8_WAIT_L
#undef PG8_BAR
#undef PG8_SCHED
}
}
constexpr int NWAVES = 8;
constexpr int BATCH = 4, T = 4096, D = 1024, M = BATCH * T;
constexpr int PROJ_W = 2832, NP = 2816, FF = 2816, NGU = 2 * FF, HD = 64;
constexpr int C_GQ = 0, C_GK = 512, C_GV = 1024, C_GZ = 1536, C_SQ = 2048, C_SK = 2560, C_SV = 2688;
constexpr float EPS = 1e-6f;
constexpr size_t MiB = 1u << 20;
constexpr size_t WS_CTL = 0, CTL_ZERO_BYTES = 1 * MiB;
constexpr size_t WS_MODF = 1 * MiB;
constexpr size_t WS_WAB = 1 * MiB + 256 * 1024;
constexpr size_t WS_GB = 2 * MiB;
constexpr size_t WS_WIN = 4 * MiB, WS_WOUT = 10 * MiB, WS_WGU = 12 * MiB, WS_WDN = 24 * MiB;
constexpr size_t WS_H = 32 * MiB;
constexpr size_t WS_PQ = 64 * MiB;
constexpr size_t WS_MIX = 160 * MiB;
constexpr size_t WS_CHKA = 192 * MiB;
constexpr size_t WS_DEC = 1 * MiB + 384 * 1024;
constexpr size_t WS_END = 256 * MiB;
constexpr int CW_BAR = 4096;
constexpr int CW_MODACC = 16384;
constexpr int RING_OFF = 0, RING_BYTES = 131072;
constexpr int LDSCTL_OFF = RING_BYTES, MISC_OFF = LDSCTL_OFF + 320;
constexpr int LDS_BYTES = 147456;
#define GAS __attribute__((address_space(1)))
#define LAS __attribute__((address_space(3)))
typedef unsigned short bf16;
typedef unsigned v4u __attribute__((ext_vector_type(4)));
typedef float f32x4 __attribute__((ext_vector_type(4)));
typedef short bf16x8 __attribute__((ext_vector_type(8)));
typedef GAS unsigned gu32;
typedef GAS unsigned long long gu64;
#define RLX_AGENT __ATOMIC_RELAXED, __HIP_MEMORY_SCOPE_AGENT
#define LDS_WAIT() asm volatile("s_waitcnt lgkmcnt(0)" ::: "memory")
#define VM_WAIT() asm volatile("s_waitcnt vmcnt(0)" ::: "memory")
__device__ __forceinline__ unsigned long long rt() { return __builtin_amdgcn_s_memrealtime(); }
__device__ __forceinline__ unsigned f2bf(float f) { unsigned u = __builtin_bit_cast(unsigned, f); return (u + 0x7fffu + ((u >> 16) & 1u)) >> 16; }
__device__ __forceinline__ unsigned pk2(float lo, float hi) { return f2bf(lo) | (f2bf(hi) << 16); }

#define XB_TMO      128
#define XB_XCNT(j)  (256  + 64 * (j))
#define XB_XSUB(j)  (1280 + 64 * (j))
#define XB_XGEN(j)  (2304 + 64 * (j))
#define XB_TOP      3328
#define XB_TOPGEN   3392
#define XCD_BAR_WORDS 3456
#define XB_SPIN_CAP (1u << 22)

__device__ __forceinline__ unsigned xb_ld(unsigned* p)              { return __hip_atomic_load(p, __ATOMIC_RELAXED, __HIP_MEMORY_SCOPE_AGENT); }
__device__ __forceinline__ unsigned xb_add(unsigned* p, unsigned v) { return __hip_atomic_fetch_add(p, v, __ATOMIC_RELAXED, __HIP_MEMORY_SCOPE_AGENT); }
__device__ __forceinline__ unsigned xb_xcc_id() { return (unsigned)__builtin_amdgcn_s_getreg((3 << 11) | 20) & 0xFu; }
#define XB_SPIN(cond, bar) do { unsigned _sp = 0; while (cond) { __builtin_amdgcn_s_sleep(1); \
    if ((++_sp & 255u) == 0u) { if (xb_ld(&(bar)[XB_TMO])) break; if (_sp > XB_SPIN_CAP) { atomicAdd(&(bar)[XB_TMO], 1u); break; } } } } while (0)

struct XcdBarrier {
    unsigned* bar; unsigned x;
    volatile LAS unsigned* st;
};

__device__ __forceinline__ XcdBarrier xcd_barrier_post(unsigned* bar, volatile LAS unsigned* st) {
    XcdBarrier b; b.bar = bar; b.x = xb_xcc_id(); b.st = st;
    if (threadIdx.x == 0) (void)xb_add(&bar[XB_XCNT(b.x)], 1u);
    return b;
}
__device__ __forceinline__ void xcd_barrier_complete(unsigned* bar, unsigned x, unsigned& nloc, unsigned& nx) {
    const unsigned G = gridDim.x * gridDim.y * gridDim.z;
    unsigned sum, cnt, mine, sp = 0u;
    for (;;) {
        sum = 0u; cnt = 0u; mine = 0u;
#pragma unroll
        for (unsigned j = 0; j < 16; ++j) { const unsigned c = xb_ld(&bar[XB_XCNT(j)]); sum += c; cnt += (c > 0u) ? 1u : 0u; mine = (j == x) ? c : mine; }
        if (sum == G) break;
        __builtin_amdgcn_s_sleep(1);
        if ((++sp & 255u) == 0u) { if (xb_ld(&bar[XB_TMO])) break; if (sp > XB_SPIN_CAP) { atomicAdd(&bar[XB_TMO], 1u); break; } }
    }
    nloc = mine > 0u ? mine : 1u; nx = cnt > 0u ? cnt : 1u;
}

__device__ __forceinline__ void xcd_barrier(const XcdBarrier& b) {
    asm volatile("s_waitcnt vmcnt(0)" ::: "memory");
    __syncthreads();
    if (threadIdx.x == 0) {
        unsigned* bar = b.bar;
        __builtin_amdgcn_s_waitcnt(0);
        unsigned nloc = b.st[0], nx = b.st[1];
        if (nloc == 0u) { xcd_barrier_complete(bar, b.x, nloc, nx); b.st[0] = nloc; b.st[1] = nx; }
        const unsigned old = xb_add(&bar[XB_XSUB(b.x)], 1u);
        const unsigned gen = old / nloc;
        if (old + 1u == (gen + 1u) * nloc) {
            __builtin_amdgcn_fence(__ATOMIC_RELEASE, "agent");
            asm volatile("s_waitcnt vmcnt(0)" ::: "memory");
            const unsigned og = xb_add(&bar[XB_TOP], 1u);
            const unsigned tg = og / nx;
            if (og + 1u == (tg + 1u) * nx) xb_add(&bar[XB_TOPGEN], 1u);
            else XB_SPIN(xb_ld(&bar[XB_TOPGEN]) == tg, bar);
            __builtin_amdgcn_fence(__ATOMIC_ACQUIRE, "agent");
            xb_add(&bar[XB_XGEN(b.x)], 1u);
            asm volatile("s_waitcnt vmcnt(0)" ::: "memory");
        } else {
            XB_SPIN(xb_ld(&bar[XB_XGEN(b.x)]) == gen, bar);
            __builtin_amdgcn_fence(__ATOMIC_ACQUIRE, "agent");
            asm volatile("s_waitcnt vmcnt(0)" ::: "memory");
        }
    }
    __syncthreads();
}
struct Frame {
    LAS unsigned char* lds;
    volatile LAS unsigned* MISC;
    gu32* ctl;
    int tid, lane, wave;
    int vcu, G;
    const float *x, *c, *w_ada, *b_ada, *norm1_w, *w_in, *conv_w, *a_log, *dt_bias, *gdn_norm_w, *q_norm_w, *k_norm_w, *sinks, *w_out, *norm2_w, *w_gate, *w_up, *w_down;
    float* out;
    float *modacc, *modf, *wab, *gb, *dec;
    bf16 *Win_t, *Wout_t, *Wgu_t, *Wdn_t, *H, *PQ, *MIX, *CHKA, *CHKU;
};
template <int CTRL, int ROWMASK, bool BC>
__device__ __forceinline__ float dpp_mov(float v) { return __int_as_float(__builtin_amdgcn_update_dpp(0, __float_as_int(v), CTRL, ROWMASK, 0xF, BC)); }
__device__ __forceinline__ float sum8(float v) { v += dpp_mov<0xB1, 0xF, true>(v); v += dpp_mov<0x4E, 0xF, true>(v); v += dpp_mov<0x141, 0xF, true>(v); return v; }
__device__ __forceinline__ float wave_sum(float v) {
    v = sum8(v); v += dpp_mov<0x140, 0xF, true>(v);
    v += dpp_mov<0x142, 0xA, false>(v); v += dpp_mov<0x143, 0xC, false>(v);
    return __int_as_float(__builtin_amdgcn_readlane(__float_as_int(v), 63));
}
__device__ __forceinline__ float fq_sum(float v) {
    auto r = __builtin_amdgcn_permlane16_swap(__float_as_uint(v), __float_as_uint(v), false, false); v = __uint_as_float(r[0]) + __uint_as_float(r[1]);
    auto s = __builtin_amdgcn_permlane32_swap(__float_as_uint(v), __float_as_uint(v), false, false); return __uint_as_float(s[0]) + __uint_as_float(s[1]);
}
__device__ __forceinline__ float fq_max(float v) {
    auto r = __builtin_amdgcn_permlane16_swap(__float_as_uint(v), __float_as_uint(v), false, false); v = fmaxf(__uint_as_float(r[0]), __uint_as_float(r[1]));
    auto s = __builtin_amdgcn_permlane32_swap(__float_as_uint(v), __float_as_uint(v), false, false); return fmaxf(__uint_as_float(s[0]), __uint_as_float(s[1]));
}
__device__ __forceinline__ float bf2f(bf16 h) { return __uint_as_float((unsigned)h << 16); }
__device__ __forceinline__ float ld_f32_coh(const float* p) { return __uint_as_float(__hip_atomic_load((const unsigned*)p, RLX_AGENT)); }
__device__ __forceinline__ float silu(float x) { return x * __builtin_amdgcn_rcpf(1.0f + __expf(-x)); }
__device__ __forceinline__ float rsq(float x) { return __builtin_amdgcn_rsqf(x); }

__device__ __forceinline__ void tr_item(const float* W, int ldw, int src_col, bf16* WT, int K, int dst_row, int k0, LAS float* scr, int lane) {
#pragma unroll 8
    for (int i = 0; i < 32; ++i) { const int kk = 2 * i + (lane >> 5); scr[kk * 33 + (lane & 31)] = W[(size_t)(k0 + kk) * ldw + src_col + (lane & 31)]; }
    LDS_WAIT(); asm volatile("" ::: "memory");
    const int c = lane & 7;
#pragma unroll
    for (int j = 0; j < 4; ++j) { const int n = (lane >> 3) + 8 * j; const LAS float* s = scr + (8 * c) * 33 + n;
        v4u o; o.x = pk2(s[0 * 33], s[1 * 33]); o.y = pk2(s[2 * 33], s[3 * 33]); o.z = pk2(s[4 * 33], s[5 * 33]); o.w = pk2(s[6 * 33], s[7 * 33]);
        *(GAS v4u*)(WT + (size_t)(dst_row + n) * K + k0 + 8 * c) = o; }
    LDS_WAIT(); asm volatile("" ::: "memory");
}

__device__ __forceinline__ void p0_prologue(Frame& F) {
    LAS float* scr = (LAS float*)(F.lds + RING_OFF + F.wave * 16384);
    const int gw = F.vcu * NWAVES + F.wave, NGW = F.G * NWAVES, lane = F.lane;
    constexpr int I_ADA = 24 * 16, I_AB = 16, I_IN = 16 * (NP / 32), I_OUT = 16 * 32, I_GU = 16 * (NGU / 32), I_DN = (FF / 64) * 32;
    constexpr int NITEMS = I_ADA + I_AB + I_IN + I_OUT + I_GU + I_DN;
    for (int it = gw; it < NITEMS; it += NGW) {
        int r = it;
        if (r < I_ADA) {
            const int ct = r % 24, ks = r / 24, col = ct * 256 + lane, k0 = ks * 64;
            float acc[4][4];
#pragma unroll
            for (int j = 0; j < 4; ++j)
#pragma unroll
                for (int b = 0; b < 4; ++b) acc[j][b] = 0.f;
#pragma unroll 4
            for (int kk = 0; kk < 64; ++kk) { const int k = k0 + kk; float cb[4];
#pragma unroll
                for (int b = 0; b < 4; ++b) cb[b] = silu(F.c[b * D + k]);
#pragma unroll
                for (int j = 0; j < 4; ++j) { const float w = F.w_ada[(size_t)k * (6 * D) + col + 64 * j];
#pragma unroll
                    for (int b = 0; b < 4; ++b) acc[j][b] += cb[b] * w; } }
#pragma unroll
            for (int j = 0; j < 4; ++j)
#pragma unroll
                for (int b = 0; b < 4; ++b) atomicAdd(F.modacc + b * (6 * D) + col + 64 * j, acc[j][b]);
            continue;
        }
        r -= I_ADA;
        if (r < I_AB) {
            for (int i = 0; i < 16; ++i) { const int k = i * 64 + lane; F.wab[r * D + k] = F.w_in[(size_t)k * PROJ_W + 2048 + r]; }
            continue;
        }
        r -= I_AB;
        if (r < I_IN) { const int nb = r % (NP / 32), kb = r / (NP / 32), n0 = 32 * nb; tr_item(F.w_in, PROJ_W, n0 < 2048 ? n0 : n0 + 16, F.Win_t, D, n0, 64 * kb, scr, lane); continue; }
        r -= I_IN;
        if (r < I_OUT) { const int nb = r % 32, kb = r / 32; tr_item(F.w_out, D, 32 * nb, F.Wout_t, D, 32 * nb, 64 * kb, scr, lane); continue; }
        r -= I_OUT;
        if (r < I_GU) { const int nb = r % (NGU / 32), kb = r / (NGU / 32), n0 = 32 * nb, p = n0 >> 8, j = n0 & 255;
            if (j < 128) tr_item(F.w_gate, FF, 128 * p + j, F.Wgu_t, D, n0, 64 * kb, scr, lane);
            else         tr_item(F.w_up,   FF, 128 * p + j - 128, F.Wgu_t, D, n0, 64 * kb, scr, lane);
            continue; }
        r -= I_GU;
        { const int nb = r % 32, kb = r / 32; tr_item(F.w_down, D, 32 * nb, F.Wdn_t, FF, 32 * nb, 64 * kb, scr, lane); }
    }
}

template <int WHICH> __device__ __forceinline__ void norm_phase(Frame& F) {
    const int gw = F.vcu * NWAVES + F.wave, NGW = F.G * NWAVES, lane = F.lane;
    if (WHICH == 1) {
        for (int idx = gw * 64 + lane; idx < 4 * 6 * D; idx += NGW * 64) F.modf[idx] = ld_f32_coh(F.modacc + idx) + F.b_ada[idx % (6 * D)];
    }
    const float* src = (WHICH == 1) ? F.x : F.out;
    const float* nw = (WHICH == 1) ? F.norm1_w : F.norm2_w;
    for (int m0 = gw * 4; m0 < M; m0 += NGW * 4) {
        const int b = m0 / T;
        float gm[16], sh[16];
#pragma unroll
        for (int i = 0; i < 4; ++i)
#pragma unroll
            for (int e = 0; e < 4; ++e) { const int c = 256 * i + 4 * lane + e; float sc, sf;
                if (WHICH == 1) { sf = ld_f32_coh(F.modacc + b * 6 * D + c) + F.b_ada[c]; sc = ld_f32_coh(F.modacc + b * 6 * D + D + c) + F.b_ada[D + c]; }
                else { sf = F.modf[b * 6 * D + 3 * D + c]; sc = F.modf[b * 6 * D + 4 * D + c]; }
                gm[4 * i + e] = nw[c] * (1.0f + sc); sh[4 * i + e] = sf; }
        float h[4][16];
#pragma unroll
        for (int r = 0; r < 4; ++r) {
            const GAS f32x4* xr = (const GAS f32x4*)(src + (size_t)(m0 + r) * D) + lane;
            f32x4 v[4]; float ss = 0.f;
#pragma unroll
            for (int i = 0; i < 4; ++i) { v[i] = xr[64 * i]; ss += (v[i].x * v[i].x + v[i].y * v[i].y) + (v[i].z * v[i].z + v[i].w * v[i].w); }
            const float rstd = rsq(wave_sum(ss) * (1.0f / D) + EPS);
            GAS unsigned long long* o8 = (GAS unsigned long long*)(F.H + (size_t)(m0 + r) * D) + lane;
#pragma unroll
            for (int i = 0; i < 4; ++i) {
                const float a0 = v[i].x * rstd * gm[4 * i + 0] + sh[4 * i + 0], a1 = v[i].y * rstd * gm[4 * i + 1] + sh[4 * i + 1];
                const float a2 = v[i].z * rstd * gm[4 * i + 2] + sh[4 * i + 2], a3 = v[i].w * rstd * gm[4 * i + 3] + sh[4 * i + 3];
                h[r][4 * i + 0] = a0; h[r][4 * i + 1] = a1; h[r][4 * i + 2] = a2; h[r][4 * i + 3] = a3;
                o8[64 * i] = (unsigned long long)pk2(a0, a1) | ((unsigned long long)pk2(a2, a3) << 32); }
        }
        if (WHICH == 1) {
            float myv = 0.f;
            for (int j = 0; j < 16; ++j) {
                const GAS f32x4* wp = (const GAS f32x4*)(F.wab + j * D) + lane;
                f32x4 wv[4];
#pragma unroll
                for (int i = 0; i < 4; ++i) wv[i] = wp[64 * i];
#pragma unroll
                for (int r = 0; r < 4; ++r) { float p = 0.f;
#pragma unroll
                    for (int i = 0; i < 4; ++i) p += (h[r][4 * i] * wv[i].x + h[r][4 * i + 1] * wv[i].y) + (h[r][4 * i + 2] * wv[i].z + h[r][4 * i + 3] * wv[i].w);
                    p = wave_sum(p);
                    if (lane == r * 16 + j) myv = p; }
            }
            const int j = lane & 15, hh = j & 7;
            float val;
            if (j < 8) { const float xx = myv + F.dt_bias[hh]; const float sp = fmaxf(xx, 0.f) + log1pf(__expf(-fabsf(xx))); val = -__expf(F.a_log[hh]) * sp; }
            else val = 1.0f / (1.0f + __expf(-myv));
            F.gb[(size_t)m0 * 16 + lane] = val;
        }
    }
}

typedef short s16x4v __attribute__((ext_vector_type(4)));
typedef float f32x2_t __attribute__((ext_vector_type(2))); typedef __bf16 bf16x2_t __attribute__((ext_vector_type(2)));
__device__ __forceinline__ unsigned cvtpk(float lo, float hi) { f32x2_t v = {lo, hi}; bf16x2_t b = __builtin_convertvector(v, bf16x2_t); return __builtin_bit_cast(unsigned, b); }
__device__ __forceinline__ float rdlane(float v, int l) { return __int_as_float(__builtin_amdgcn_readlane(__float_as_int(v), l)); }
__device__ __forceinline__ bf16x8 pack8(const f32x4 a, const f32x4 b) {
    v4u w; w.x = cvtpk(a[0], a[1]); w.y = cvtpk(a[2], a[3]); w.z = cvtpk(b[0], b[1]); w.w = cvtpk(b[2], b[3]); return __builtin_bit_cast(bf16x8, w); }

__device__ __forceinline__ void gdn_prep_chunk(Frame& F, int ci, LAS unsigned char* wl  ) {
    const int lane = F.lane, bh = ci >> 6, n = ci & 63, b = bh >> 3, hh = bh & 7, fr = lane & 15, fq = lane >> 4;
    const size_t m0 = (size_t)b * T + 64 * n;
    bf16* const cA = F.CHKA + (size_t)ci * 16384;
    bf16* const cU = F.CHKU + (size_t)ci * 4096;
    const float g = ld_f32_coh(F.gb + (m0 + lane) * 16 + hh), beta = ld_f32_coh(F.gb + (m0 + lane) * 16 + 8 + hh);
    float G = g;
#pragma unroll
    for (int o = 1; o < 64; o <<= 1) { const float t = __shfl_up(G, o); if (lane >= o) G += t; }
    const float eG = __expf(G), Glast = __shfl(G, 63), kdsc = __expf(Glast - G), beG = beta * eG;
    if (lane == 0) F.dec[ci] = __expf(Glast);
    LAS bf16* const Qn = (LAS bf16*)wl; LAS bf16* const Kn = (LAS bf16*)(wl + 8192);
    {
        const bf16* src = F.PQ + m0 * NP + C_GQ + hh * 64 + lane;
        const float w0 = F.conv_w[hh * 64 + lane], w1 = F.conv_w[1536 + hh * 64 + lane], w2 = F.conv_w[2 * 1536 + hh * 64 + lane], w3 = F.conv_w[3 * 1536 + hh * 64 + lane];
        float x0 = 0.f, x1 = 0.f, x2 = 0.f;
        if (n > 0) { x0 = bf2f(*(src - 3 * NP)); x1 = bf2f(*(src - 2 * NP)); x2 = bf2f(*(src - NP)); }
#pragma unroll
        for (int c = 0; c < 64; ++c) {
            const float r = bf2f(src[(size_t)c * NP]);
            const float cq = silu(w0 * x0 + w1 * x1 + w2 * x2 + w3 * r); x0 = x1; x1 = x2; x2 = r;
            const float qn = cq * rsq(wave_sum(cq * cq) + EPS);
            Qn[c * 64 + lane] = (bf16)f2bf(qn);
        }
    }
    {
        const bf16* src = F.PQ + m0 * NP + C_GK + hh * 64 + lane;
        const float w0 = F.conv_w[512 + hh * 64 + lane], w1 = F.conv_w[1536 + 512 + hh * 64 + lane], w2 = F.conv_w[2 * 1536 + 512 + hh * 64 + lane], w3 = F.conv_w[3 * 1536 + 512 + hh * 64 + lane];
        float x0 = 0.f, x1 = 0.f, x2 = 0.f;
        if (n > 0) { x0 = bf2f(*(src - 3 * NP)); x1 = bf2f(*(src - 2 * NP)); x2 = bf2f(*(src - NP)); }
        bf16* kdt = cA + 3 * 4096 + (lane >> 4) * 2 * 64 * 8 + (lane & 15) * 8;
        float kq[4];
#pragma unroll
        for (int c = 0; c < 64; ++c) {
            const float r = bf2f(src[(size_t)c * NP]);
            const float ck = silu(w0 * x0 + w1 * x1 + w2 * x2 + w3 * r); x0 = x1; x1 = x2; x2 = r;
            const float kn = ck * rsq(wave_sum(ck * ck) + EPS);
            Kn[c * 64 + lane] = (bf16)f2bf(kn);
            kq[c & 3] = kn * rdlane(kdsc, c);
            if ((c & 3) == 3) { const int c0 = c - 3;
                unsigned long long pk = (unsigned long long)cvtpk(kq[0], kq[1]) | ((unsigned long long)cvtpk(kq[2], kq[3]) << 32);
                *(unsigned long long*)(kdt + ((c0 >> 5) * 64 + 16 * ((c0 & 15) >> 2)) * 8 + 4 * ((c0 >> 4) & 1)) = pk; }
        }
    }
    LDS_WAIT(); asm volatile("" ::: "memory");
    bf16x8 kf[4][2], qf[4][2];
#pragma unroll
    for (int blk = 0; blk < 4; ++blk)
#pragma unroll
        for (int kk = 0; kk < 2; ++kk) { kf[blk][kk] = *(const LAS bf16x8*)(Kn + (16 * blk + fr) * 64 + 32 * kk + 8 * fq); qf[blk][kk] = *(const LAS bf16x8*)(Qn + (16 * blk + fr) * 64 + 32 * kk + 8 * fq); }
    float Gcol[4], Bcol[4], Grow[4][4];
#pragma unroll
    for (int t = 0; t < 4; ++t) { Gcol[t] = __shfl(G, 16 * t + fr); Bcol[t] = __shfl(beta, 16 * t + fr);
#pragma unroll
        for (int i = 0; i < 4; ++i) Grow[t][i] = __shfl(G, 16 * t + 4 * fq + i); }
#pragma unroll
    for (int mt = 0; mt < 4; ++mt) { const float esc = __expf(Gcol[mt]) * 0.125f;
#pragma unroll
        for (int ks = 0; ks < 2; ++ks) { const LAS bf16* qp_ = Qn + (16 * mt + fr) * 64 + 32 * ks + 4 * fq;
            const unsigned long long lo = *(const LAS unsigned long long*)qp_, hi = *(const LAS unsigned long long*)(qp_ + 16);
            const unsigned w_[4] = {(unsigned)lo, (unsigned)(lo >> 32), (unsigned)hi, (unsigned)(hi >> 32)}; v4u o_;
            o_.x = cvtpk(__uint_as_float(w_[0] << 16) * esc, __uint_as_float(w_[0] & 0xffff0000u) * esc); o_.y = cvtpk(__uint_as_float(w_[1] << 16) * esc, __uint_as_float(w_[1] & 0xffff0000u) * esc);
            o_.z = cvtpk(__uint_as_float(w_[2] << 16) * esc, __uint_as_float(w_[2] & 0xffff0000u) * esc); o_.w = cvtpk(__uint_as_float(w_[3] << 16) * esc, __uint_as_float(w_[3] & 0xffff0000u) * esc);
            *(GAS v4u*)(cA + 4096 + ((mt * 2 + ks) * 64 + lane) * 8) = o_; } }
    LDS_WAIT(); asm volatile("" ::: "memory");
#pragma unroll
    for (int tc = 0; tc < 4; ++tc)
#pragma unroll
        for (int ks = 0; ks < 2; ++ks) {
            f32x4 v[2];
#pragma unroll
            for (int h2 = 0; h2 < 2; ++h2) { const int ts = 2 * ks + h2;
                if (ts <= tc) { f32x4 acc = (f32x4){0.f, 0.f, 0.f, 0.f};
                    acc = __builtin_amdgcn_mfma_f32_16x16x32_bf16(kf[ts][0], qf[tc][0], acc, 0, 0, 0); acc = __builtin_amdgcn_mfma_f32_16x16x32_bf16(kf[ts][1], qf[tc][1], acc, 0, 0, 0);
#pragma unroll
                    for (int i = 0; i < 4; ++i) { const int cidx = 16 * tc + fr, sidx = 16 * ts + 4 * fq + i; v[h2][i] = (cidx >= sidx) ? acc[i] * __expf(Gcol[tc] - Grow[ts][i]) * 0.125f : 0.f; }
                } else v[h2] = (f32x4){0.f, 0.f, 0.f, 0.f}; }
            *(bf16x8*)(cA + 2 * 4096 + ((tc * 2 + ks) * 64 + lane) * 8) = pack8(v[0], v[1]);
        }
    LAS bf16* const Am = (LAS bf16*)wl;
#pragma unroll
    for (int tc = 0; tc < 4; ++tc)
#pragma unroll
        for (int ts = 0; ts <= tc; ++ts) { f32x4 acc = (f32x4){0.f, 0.f, 0.f, 0.f};
            acc = __builtin_amdgcn_mfma_f32_16x16x32_bf16(kf[ts][0], kf[tc][0], acc, 0, 0, 0); acc = __builtin_amdgcn_mfma_f32_16x16x32_bf16(kf[ts][1], kf[tc][1], acc, 0, 0, 0);
            f32x4 a;
#pragma unroll
            for (int i = 0; i < 4; ++i) { const int cidx = 16 * tc + fr, sidx = 16 * ts + 4 * fq + i; a[i] = (cidx > sidx) ? Bcol[tc] * acc[i] * __expf(Gcol[tc] - Grow[ts][i]) : 0.f; }
            *(LAS unsigned long long*)(Am + (16 * tc + fr) * 64 + 16 * ts + 4 * fq) = (unsigned long long)cvtpk(a[0], a[1]) | ((unsigned long long)cvtpk(a[2], a[3]) << 32); }
    LDS_WAIT(); asm volatile("" ::: "memory");
    float Ar[64], xk[64];
#pragma unroll
    for (int c = 1; c < 64; ++c) Ar[c] = bf2f(Am[c * 64 + lane]);
#pragma unroll
    for (int c = 0; c < 64; ++c) xk[c] = bf2f(Kn[c * 64 + lane]) * rdlane(beG, c);
    LDS_WAIT(); asm volatile("" ::: "memory");
#pragma unroll
    for (int c = 1; c < 64; ++c) {
#pragma unroll
        for (int s = 0; s < c; ++s) xk[c] -= rdlane(Ar[c], s) * xk[s];
    }
    {
#pragma unroll
        for (int c = 0; c < 64; ++c) Kn[c * 64 + lane] = (bf16)(cvtpk(-xk[c], -xk[c]) & 0xffffu);
        LDS_WAIT(); asm volatile("" ::: "memory");
#pragma unroll
        for (int mt = 0; mt < 4; ++mt)
#pragma unroll
            for (int ks = 0; ks < 2; ++ks) { const LAS bf16* wp_ = Kn + (16 * mt + fr) * 64 + 32 * ks + 4 * fq;
                const unsigned long long lo = *(const LAS unsigned long long*)wp_, hi = *(const LAS unsigned long long*)(wp_ + 16);
                v4u o_; o_.x = (unsigned)lo; o_.y = (unsigned)(lo >> 32); o_.z = (unsigned)hi; o_.w = (unsigned)(hi >> 32);
                *(GAS v4u*)(cA + ((mt * 2 + ks) * 64 + lane) * 8) = o_; }
    }
    float xv[64];
    {
        const bf16* src = F.PQ + m0 * NP + C_GV + hh * 64 + lane;
        const float w0 = F.conv_w[1024 + hh * 64 + lane], w1 = F.conv_w[1536 + 1024 + hh * 64 + lane], w2 = F.conv_w[2 * 1536 + 1024 + hh * 64 + lane], w3 = F.conv_w[3 * 1536 + 1024 + hh * 64 + lane];
        float x0 = 0.f, x1 = 0.f, x2 = 0.f;
        if (n > 0) { x0 = bf2f(*(src - 3 * NP)); x1 = bf2f(*(src - 2 * NP)); x2 = bf2f(*(src - NP)); }
#pragma unroll
        for (int c = 0; c < 64; ++c) {
            const float r = bf2f(src[(size_t)c * NP]);
            const float cv = silu(w0 * x0 + w1 * x1 + w2 * x2 + w3 * r); x0 = x1; x1 = x2; x2 = r;
            xv[c] = cv * rdlane(beta, c);
        }
    }
#pragma unroll
    for (int c = 1; c < 64; ++c) {
#pragma unroll
        for (int s = 0; s < c; ++s) xv[c] -= rdlane(Ar[c], s) * xv[s];
    }
    {
        bf16* up = cU + ((lane >> 4) * 4 * 64 + (lane & 15)) * 4;
#pragma unroll
        for (int c4 = 0; c4 < 16; ++c4) { const unsigned long long pk = (unsigned long long)cvtpk(xv[4 * c4], xv[4 * c4 + 1]) | ((unsigned long long)cvtpk(xv[4 * c4 + 2], xv[4 * c4 + 3]) << 32);
            *(unsigned long long*)(up + ((c4 >> 2) * 64 + 16 * (c4 & 3)) * 4) = pk; }
    }
    LDS_WAIT(); asm volatile("" ::: "memory");
}

#define GDN_BAR() do { asm volatile("" ::: "memory"); __builtin_amdgcn_s_barrier(); asm volatile("" ::: "memory"); } while (0)
__device__ __forceinline__ void gdn_scan(Frame& F, int bh) {
    const int lane = F.lane, wave = F.wave, b = bh >> 3, hh = bh & 7, fr = lane & 15, fq = lane >> 4;
    LAS unsigned char* const ring = F.lds + RING_OFF;
    constexpr int SLOT = 40960, OB0 = 122880, OB1 = 132096;
    const unsigned char* gA = (const unsigned char*)(F.CHKA + (size_t)bh * 64 * 16384);
    const unsigned char* gU = (const unsigned char*)(F.CHKU + (size_t)bh * 64 * 4096);
    if (wave >= 6) {
        const int nt = (wave - 6) * 64 + lane, oc = nt & 7;
        float nw[8];
#pragma unroll
        for (int j = 0; j < 8; ++j) nw[j] = F.gdn_norm_w[oc * 8 + j];
        const bf16* zp = F.PQ + ((size_t)b * T + (nt >> 3)) * NP + C_GZ + hh * 64 + oc * 8;
        bf16* mp = F.MIX + ((size_t)b * T + (nt >> 3)) * D + hh * 64 + oc * 8;
        v4u zc[4], zn[4];
#define GDN_NORM(nn) do { const LAS unsigned char* ob_ = ring + (((nn) & 1) ? OB1 : OB0); _Pragma("unroll") for (int k_ = 0; k_ < 4; ++k_) { \
            const v4u ov_ = *(const LAS v4u*)(ob_ + (nt + 128 * k_) * 16); const unsigned ow_[4] = {ov_.x, ov_.y, ov_.z, ov_.w}, zw_[4] = {zc[k_].x, zc[k_].y, zc[k_].z, zc[k_].w}; \
            float o_[8], z_[8]; float ss_ = 0.f; \
            _Pragma("unroll") for (int w_ = 0; w_ < 4; ++w_) { o_[2 * w_] = __uint_as_float(ow_[w_] << 16); o_[2 * w_ + 1] = __uint_as_float(ow_[w_] & 0xffff0000u); z_[2 * w_] = __uint_as_float(zw_[w_] << 16); z_[2 * w_ + 1] = __uint_as_float(zw_[w_] & 0xffff0000u); \
                ss_ += o_[2 * w_] * o_[2 * w_] + o_[2 * w_ + 1] * o_[2 * w_ + 1]; } \
            ss_ = sum8(ss_); \
            const float rs_ = __builtin_amdgcn_rsqf(ss_ * (1.0f / 64.0f) + EPS); float r_[8]; \
            _Pragma("unroll") for (int j_ = 0; j_ < 8; ++j_) r_[j_] = o_[j_] * rs_ * nw[j_] * z_[j_];     \
            v4u w4_; w4_.x = cvtpk(r_[0], r_[1]); w4_.y = cvtpk(r_[2], r_[3]); w4_.z = cvtpk(r_[4], r_[5]); w4_.w = cvtpk(r_[6], r_[7]); \
            *(GAS v4u*)(mp + (size_t)(64 * (nn) + 16 * k_) * D) = w4_; } } while (0)
        GDN_BAR();
        for (int n = 0; n < 64; ++n) {
#pragma unroll
            for (int k = 0; k < 4; ++k) zn[k] = *(const GAS v4u*)(zp + (size_t)(64 * n + 16 * k) * NP);
            if (n > 0) GDN_NORM(n - 1);
#pragma unroll
            for (int k = 0; k < 4; ++k) zc[k] = zn[k];
            LDS_WAIT(); GDN_BAR();
        }
        GDN_NORM(63);
#undef GDN_NORM
    } else if (wave >= 4) {
        const int lw = wave - 4;
#define GDN_ISSUE(nn) do { const int n_ = (nn); const int sl_ = n_ % 3; _Pragma("unroll") for (int i_ = 0; i_ < 20; ++i_) { const int p_ = lw * 20 + i_; \
            const unsigned char* s_ = (p_ < 32) ? gA + (size_t)n_ * 32768 + p_ * 1024 : gU + (size_t)n_ * 8192 + (p_ - 32) * 1024; \
            __builtin_amdgcn_global_load_lds((const unsigned*)(s_ + lane * 16), (LAS unsigned*)(ring + sl_ * SLOT + p_ * 1024), 16, 0, 0); } } while (0)
        GDN_ISSUE(0); GDN_ISSUE(1);
        asm volatile("s_waitcnt vmcnt(20)" ::: "memory"); GDN_BAR();
        for (int n = 0; n < 64; ++n) {
            if (n + 2 < 64) { GDN_ISSUE(n + 2); asm volatile("s_waitcnt vmcnt(20)" ::: "memory"); } else asm volatile("s_waitcnt vmcnt(0)" ::: "memory");
            GDN_BAR();
        }
#undef GDN_ISSUE
    } else {
        const int ew = wave;
        f32x4 Sacc[4];
#pragma unroll
        for (int t = 0; t < 4; ++t) Sacc[t] = (f32x4){0.f, 0.f, 0.f, 0.f};
        const float* decp = F.dec + bh * 64;
        float dnext = ld_f32_coh(decp);
        GDN_BAR();
        for (int n = 0; n < 64; ++n) {
            const LAS unsigned char* sl = ring + (n % 3) * SLOT;
            LAS bf16* ob = (LAS bf16*)(ring + ((n & 1) ? OB1 : OB0)) + (4 * fq) * 64 + 16 * ew + fr;
            const float dec = dnext; if (n + 1 < 64) dnext = ld_f32_coh(decp + n + 1);
            f32x4 V[4], O[4];
#pragma unroll
            for (int mt = 0; mt < 4; ++mt) { const unsigned long long uu = *(const LAS unsigned long long*)(sl + 32768 + ((ew * 4 + mt) * 64 + lane) * 8); const unsigned lo = (unsigned)uu, hi = (unsigned)(uu >> 32);
                V[mt] = (f32x4){__uint_as_float(lo << 16), __uint_as_float(lo & 0xffff0000u), __uint_as_float(hi << 16), __uint_as_float(hi & 0xffff0000u)}; O[mt] = (f32x4){0.f, 0.f, 0.f, 0.f}; }
            bf16x8 Sb[2]; Sb[0] = pack8(Sacc[0], Sacc[1]); Sb[1] = pack8(Sacc[2], Sacc[3]);
#pragma unroll
            for (int mt = 0; mt < 4; ++mt)
#pragma unroll
                for (int ks = 0; ks < 2; ++ks) { const bf16x8 wf = *(const LAS bf16x8*)(sl + ((mt * 2 + ks) * 64 + lane) * 16), qf = *(const LAS bf16x8*)(sl + 8192 + ((mt * 2 + ks) * 64 + lane) * 16);
                    V[mt] = __builtin_amdgcn_mfma_f32_16x16x32_bf16(wf, Sb[ks], V[mt], 0, 0, 0); O[mt] = __builtin_amdgcn_mfma_f32_16x16x32_bf16(qf, Sb[ks], O[mt], 0, 0, 0); }
            bf16x8 Vb[2]; Vb[0] = pack8(V[0], V[1]); Vb[1] = pack8(V[2], V[3]);
#pragma unroll
            for (int t = 0; t < 4; ++t) Sacc[t] = Sacc[t] * dec;
#pragma unroll
            for (int mt = 0; mt < 4; ++mt)
#pragma unroll
                for (int ks = 0; ks < 2; ++ks) { const bf16x8 af = *(const LAS bf16x8*)(sl + 16384 + ((mt * 2 + ks) * 64 + lane) * 16), kf = *(const LAS bf16x8*)(sl + 24576 + ((mt * 2 + ks) * 64 + lane) * 16);
                    O[mt] = __builtin_amdgcn_mfma_f32_16x16x32_bf16(af, Vb[ks], O[mt], 0, 0, 0); Sacc[mt] = __builtin_amdgcn_mfma_f32_16x16x32_bf16(kf, Vb[ks], Sacc[mt], 0, 0, 0); }
#pragma unroll
            for (int mt = 0; mt < 4; ++mt)
#pragma unroll
                for (int i = 0; i < 4; ++i) ob[(16 * mt + i) * 64] = (bf16)(cvtpk(O[mt][i], O[mt][i]) & 0xffffu);
            LDS_WAIT(); GDN_BAR();
        }
    }
}
__device__ __forceinline__ void swa_unit(Frame& F, int unit, LAS unsigned char* L) {
    const int tid = F.tid, lane = F.lane, wave = F.wave, fr = lane & 15, fq = lane >> 4;
    const int blk = unit & 63, kvh = (unit >> 6) & 1, b = unit >> 7, t0 = blk * 64;
    const size_t row0 = (size_t)b * T;
    LAS bf16* const Ks = (LAS bf16*)L; LAS bf16* const Vt = (LAS bf16*)(L + 27648);
    for (int p = tid; p < 1536; p += NWAVES * 64) {
        const int key = p >> 3, oc = p & 7, s = t0 - 128 + key;
        v4u kv = (v4u){0u, 0u, 0u, 0u}, vv = (v4u){0u, 0u, 0u, 0u};
        if (s >= 0) { kv = *(const GAS v4u*)(F.PQ + (row0 + s) * NP + C_SK + kvh * 64 + oc * 8); vv = *(const GAS v4u*)(F.PQ + (row0 + s) * NP + C_SV + kvh * 64 + oc * 8); }
        const unsigned kw[4] = {kv.x, kv.y, kv.z, kv.w}, vw[4] = {vv.x, vv.y, vv.z, vv.w};
        float k[8]; float ss = 0.f;
#pragma unroll
        for (int w = 0; w < 4; ++w) { k[2 * w] = __uint_as_float(kw[w] << 16); k[2 * w + 1] = __uint_as_float(kw[w] & 0xffff0000u); ss += k[2 * w] * k[2 * w] + k[2 * w + 1] * k[2 * w + 1]; }
        ss = sum8(ss);
        const float rstd = rsq(ss * (1.0f / 64.0f) + EPS);
#pragma unroll
        for (int j = 0; j < 8; ++j) k[j] = k[j] * rstd * F.k_norm_w[oc * 8 + j];
        v4u o; o.x = cvtpk(k[0], k[1]); o.y = cvtpk(k[2], k[3]); o.z = cvtpk(k[4], k[5]); o.w = cvtpk(k[6], k[7]);
        *(LAS v4u*)(Ks + key * 72 + oc * 8) = o;
#pragma unroll
        for (int w = 0; w < 4; ++w) { Vt[(oc * 8 + 2 * w) * 196 + key] = (bf16)(vw[w] & 0xffffu); Vt[(oc * 8 + 2 * w + 1) * 196 + key] = (bf16)(vw[w] >> 16); }
    }
    __syncthreads();
    const int hq = kvh * 4 + (wave >> 1);
    const float slope = exp2f(-(float)(hq + 1)), sink = F.sinks[hq];
#pragma unroll 1
    for (int qt = 0; qt < 2; ++qt) {
        const int tq0 = t0 + 32 * (wave & 1) + 16 * qt;
        bf16x8 qf[2];
        {
            const bf16* qp = F.PQ + (row0 + tq0 + fr) * NP + C_SQ + hq * 64 + 8 * fq;
            const v4u r0 = *(const GAS v4u*)qp, r1 = *(const GAS v4u*)(qp + 32);
            const unsigned qw[8] = {r0.x, r0.y, r0.z, r0.w, r1.x, r1.y, r1.z, r1.w};
            float q[16]; float ss = 0.f;
#pragma unroll
            for (int w = 0; w < 8; ++w) { q[2 * w] = __uint_as_float(qw[w] << 16); q[2 * w + 1] = __uint_as_float(qw[w] & 0xffff0000u); ss += q[2 * w] * q[2 * w] + q[2 * w + 1] * q[2 * w + 1]; }
            ss = fq_sum(ss);
            const float rstd = 0.125f * rsq(ss * (1.0f / 64.0f) + EPS);
#pragma unroll
            for (int kk = 0; kk < 2; ++kk) { float z[8];
#pragma unroll
                for (int j = 0; j < 8; ++j) z[j] = q[8 * kk + j] * rstd * F.q_norm_w[32 * kk + 8 * fq + j];
                v4u o; o.x = cvtpk(z[0], z[1]); o.y = cvtpk(z[2], z[3]); o.z = cvtpk(z[4], z[5]); o.w = cvtpk(z[6], z[7]); qf[kk] = __builtin_bit_cast(bf16x8, o); }
        }
        f32x4 sc[12]; float mx = -INFINITY;
#pragma unroll
        for (int nt = 0; nt < 12; ++nt) { f32x4 acc = (f32x4){0.f, 0.f, 0.f, 0.f};
#pragma unroll
            for (int kk = 0; kk < 2; ++kk) { const bf16x8 kf = *(const LAS bf16x8*)(Ks + (16 * nt + fr) * 72 + 32 * kk + 8 * fq); acc = __builtin_amdgcn_mfma_f32_16x16x32_bf16(kf, qf[kk], acc, 0, 0, 0); }
#pragma unroll
            for (int i = 0; i < 4; ++i) { const int s = t0 - 128 + 16 * nt + 4 * fq + i, dist = tq0 + fr - s; const bool ok = (s >= 0) && (dist >= 0) && (dist < 128);
                const float v = ok ? acc[i] - slope * (float)dist : -INFINITY; acc[i] = v; mx = fmaxf(mx, v); }
            sc[nt] = acc; if (nt & 1) __builtin_amdgcn_sched_barrier(0); }
        mx = fmaxf(fq_max(mx), sink);
        float sum = 0.f;
#pragma unroll
        for (int nt = 0; nt < 12; ++nt)
#pragma unroll
            for (int i = 0; i < 4; ++i) { const float p = __expf(sc[nt][i] - mx); sc[nt][i] = p; sum += p; }
        sum = fq_sum(sum);
        const float den = sum + __expf(sink - mx);
        bf16x8 pf[6];
#pragma unroll
        for (int ks = 0; ks < 6; ++ks) pf[ks] = pack8(sc[2 * ks], sc[2 * ks + 1]);
        float rden[4];
#pragma unroll
        for (int i = 0; i < 4; ++i) rden[i] = __builtin_amdgcn_rcpf(__shfl(den, 4 * fq + i));
        bf16* op = F.MIX + (row0 + tq0 + 4 * fq) * D + 512 + hq * 64 + fr;
#pragma unroll 1
        for (int dt = 0; dt < 4; ++dt) { f32x4 oacc = (f32x4){0.f, 0.f, 0.f, 0.f};
#pragma unroll
            for (int ks = 0; ks < 6; ++ks) { const LAS bf16* vp = Vt + (16 * dt + fr) * 196 + 32 * ks + 4 * fq;
                const unsigned long long lo = *(const LAS unsigned long long*)vp, hi = *(const LAS unsigned long long*)(vp + 16);
                v4u vv; vv.x = (unsigned)lo; vv.y = (unsigned)(lo >> 32); vv.z = (unsigned)hi; vv.w = (unsigned)(hi >> 32);
                oacc = __builtin_amdgcn_mfma_f32_16x16x32_bf16(pf[ks], __builtin_bit_cast(bf16x8, vv), oacc, 0, 0, 0); }
#pragma unroll
            for (int i = 0; i < 4; ++i) op[(size_t)i * D + 16 * dt] = (bf16)f2bf(oacc[i] * rden[i]); }
    }
    __syncthreads();
}
__device__ __forceinline__ void p3a_prep(Frame& F) {
    LAS unsigned char* wl = F.lds + RING_OFF + F.wave * 16384;
    const int gw = F.vcu * NWAVES + F.wave, NGW = F.G * NWAVES;
    for (int ci = gw; ci < BATCH * 8 * (T / 64); ci += NGW) gdn_prep_chunk(F, ci, wl);
}
__device__ __forceinline__ void p3b_mixers(Frame& F) {
    const int bx = blockIdx.x;
    if (bx < 32) gdn_scan(F, bx);
    else for (int u = bx - 32; u < BATCH * 2 * (T / 64); u += F.G - 32) swa_unit(F, u, F.lds + RING_OFF);
}

struct Args { const float* in[18]; float* out; unsigned char* ws; };
__global__ void __launch_bounds__(NWAVES * 64, 2) hymba_fwd(Args args) {
    extern __shared__ __attribute__((aligned(16))) unsigned char lds[];
    Frame F;
    F.lds = (LAS unsigned char*)lds;
    F.MISC = (volatile LAS unsigned*)(F.lds + MISC_OFF);
    F.tid = threadIdx.x; F.lane = F.tid & 63; F.wave = __builtin_amdgcn_readfirstlane(F.tid >> 6);
    F.G = gridDim.x; { const int bx = blockIdx.x; F.vcu = (F.G % 8 == 0) ? (bx % 8) * (F.G / 8) + bx / 8 : bx; }
    unsigned char* ws = args.ws;
    F.ctl = (gu32*)(ws + WS_CTL);
    F.x = args.in[0]; F.c = args.in[1]; F.w_ada = args.in[2]; F.b_ada = args.in[3]; F.norm1_w = args.in[4]; F.w_in = args.in[5]; F.conv_w = args.in[6];
    F.a_log = args.in[7]; F.dt_bias = args.in[8]; F.gdn_norm_w = args.in[9]; F.q_norm_w = args.in[10]; F.k_norm_w = args.in[11]; F.sinks = args.in[12];
    F.w_out = args.in[13]; F.norm2_w = args.in[14]; F.w_gate = args.in[15]; F.w_up = args.in[16]; F.w_down = args.in[17]; F.out = args.out;
    F.modacc = (float*)(ws + WS_CTL) + CW_MODACC; F.modf = (float*)(ws + WS_MODF); F.wab = (float*)(ws + WS_WAB); F.gb = (float*)(ws + WS_GB);
    F.Win_t = (bf16*)(ws + WS_WIN); F.Wout_t = (bf16*)(ws + WS_WOUT); F.Wgu_t = (bf16*)(ws + WS_WGU); F.Wdn_t = (bf16*)(ws + WS_WDN);
    F.H = (bf16*)(ws + WS_H); F.PQ = (bf16*)(ws + WS_PQ); F.MIX = (bf16*)(ws + WS_MIX); F.CHKA = (bf16*)(ws + WS_CHKA); F.CHKU = (bf16*)(ws + WS_H); F.dec = (float*)(ws + WS_DEC);
    for (int u = F.tid; u < (LDS_BYTES - LDSCTL_OFF) / 4; u += NWAVES * 64) ((LAS unsigned*)(F.lds + LDSCTL_OFF))[u] = 0u;
    __syncthreads();
    XcdBarrier bar = xcd_barrier_post((unsigned*)(F.ctl + CW_BAR), F.MISC + 8);
#define GRID_BAR() xcd_barrier(bar)

    p0_prologue(F); GRID_BAR();
    norm_phase<1>(F); GRID_BAR();
    { pg8::Gemm g{F.H, F.Win_t, M, NP, D}; pg8::StaticOrder S; S.init(M, NP, F.G, (int)blockIdx.x);
      pg8::EpiBf16Plain E{F.PQ, NP, C_GZ / 256, C_SQ / 256};
      pg8::gemm_phase<pg8::EpiBf16Plain, pg8::StaticOrder, true, true>(F.lds + RING_OFF, g, S, E); }
    GRID_BAR();
    p3a_prep(F); GRID_BAR();
    p3b_mixers(F); GRID_BAR();
    { pg8::Gemm g{F.MIX, F.Wout_t, M, D, D}; pg8::StaticOrder S; S.init(M, D, F.G, (int)blockIdx.x);
      pg8::EpiGateRes E{F.x, F.out, D, F.modf + 2 * D, 6 * D, T};
      pg8::gemm_phase<pg8::EpiGateRes, pg8::StaticOrder, true, true>(F.lds + RING_OFF, g, S, E); }
    GRID_BAR();
    norm_phase<2>(F); GRID_BAR();
    { pg8::Gemm g{F.H, F.Wgu_t, M, NGU, D}; pg8::StaticOrder S; S.init(M, NGU, F.G, (int)blockIdx.x);
      pg8::EpiSwiGLU E{F.PQ, FF};
      pg8::gemm_phase<pg8::EpiSwiGLU, pg8::StaticOrder, true, true>(F.lds + RING_OFF, g, S, E); }
    GRID_BAR();
    { pg8::Gemm g{F.PQ, F.Wdn_t, M, D, FF}; pg8::StaticOrder S; S.init(M, D, F.G, (int)blockIdx.x);
      pg8::EpiGateRes E{F.out, F.out, D, F.modf + 5 * D, 6 * D, T};
      pg8::gemm_phase<pg8::EpiGateRes, pg8::StaticOrder, true, true>(F.lds + RING_OFF, g, S, E); }
#undef GRID_BAR
}

extern "C" void kernel_launch(void* const* d_in, const int* in_sizes, int n_in, void* d_out, int out_size, void* d_ws, size_t ws_size, hipStream_t stream) {
    static int grid = 0;
    if (grid == 0) {
        if (n_in != 18 || in_sizes[0] != M * D || out_size != M * D || ws_size < WS_END) { fprintf(stderr, "kernel_launch: unexpected shapes (n_in %d, in0 %d, out %d, ws %zu); nothing launched\n", n_in, n_in > 0 ? in_sizes[0] : -1, out_size, ws_size); grid = -1; return; }
        int dev = 0, cus = 0;
        if (hipGetDevice(&dev) != hipSuccess || hipDeviceGetAttribute(&cus, hipDeviceAttributeMultiprocessorCount, dev) != hipSuccess) { grid = -1; return; }
        if (hipFuncSetAttribute((const void*)hymba_fwd, hipFuncAttributeMaxDynamicSharedMemorySize, LDS_BYTES) != hipSuccess) { fprintf(stderr, "kernel_launch: hipFuncSetAttribute failed\n"); grid = -1; return; }
        (void)hipGetLastError();
        grid = cus;
    }
    if (grid < 0) return;
    if (hipMemsetAsync((char*)d_ws + WS_CTL, 0, CTL_ZERO_BYTES, stream) != hipSuccess) { fprintf(stderr, "kernel_launch: hipMemsetAsync failed\n"); return; }
    Args a{};
    for (int i = 0; i < 18; ++i) a.in[i] = (const float*)d_in[i];
    a.out = (float*)d_out; a.ws = (unsigned char*)d_ws;
    hipLaunchKernelGGL(hymba_fwd, dim3(grid), dim3(NWAVES * 64), LDS_BYTES, stream, a);
    const hipError_t le = hipPeekAtLastError();
    if (le != hipSuccess) fprintf(stderr, "kernel_launch: launch failed: %s\n", hipGetErrorName(le));
}
```

```cpp
#include <hip/hip_runtime.h>
#include <cstdio>
#include <cstdint>
#include <cmath>
namespace pg8 {
#define PG8_LAS __attribute__((address_space(3)))
typedef unsigned short bf16_t;
typedef short bf16x8 __attribute__((ext_vector_type(8)));
typedef float f32x4 __attribute__((ext_vector_type(4)));
typedef unsigned u32x4 __attribute__((ext_vector_type(4)));
constexpr int BM = 256, BK = 64, HALF = 128, HTB = HALF * BK * 2  , STAGE_BYTES = 8 * HTB, NXCD = 8, WGM = 8;

__host__ __device__ __forceinline__ int lds_byte(int r, int c) { const int st = (r >> 4) * 2 + (c >> 5), rr = r & 15, cc = c & 31, ob = rr * 64 + cc * 2; return st * 1024 + (ob ^ (((ob >> 9) & 1) << 5)); }
__host__ __device__ __forceinline__ void stage_rc(int b, int& R, int& C) { const int st = b / 1024, sb = b % 1024, swz = sb ^ (((sb >> 9) & 1) << 5); R = (st >> 1) * 16 + swz / 64; C = (st & 1) * 32 + (swz % 64) / 2; }
__host__ __device__ __forceinline__ int perm32(int rho) { const int n = rho >> 4, i = rho & 15; return 8 * (i >> 2) + 4 * n + (i & 3); }

struct Unit { int pm, pn; };
struct Gemm { const bf16_t* A; const bf16_t* Bt; int M, N, K; };

struct StaticOrder {
    int nM, nN, nwg, G, c;
    __host__ __device__ void init(int M, int N, int G_, int c_) { nM = M / BM; nN = N / BM; nwg = nM * nN; G = G_; c = c_; }
    __host__ __device__ bool next(int i, Unit& u) const {
        const long L = (long)i * G + c; if (L >= nwg) return false;
        int wgid = (int)L; { const int q = nwg / NXCD, r = nwg % NXCD, xcd = wgid % NXCD, off = wgid / NXCD; wgid = (xcd < r ? xcd * (q + 1) : r * (q + 1) + (xcd - r) * q) + off; }
        const int nig = WGM * nN, gid = wgid / nig, fm = gid * WGM, gsz = (nM - fm) < WGM ? (nM - fm) : WGM;
        u.pm = fm + ((wgid % nig) % gsz); u.pn = (wgid % nig) / gsz; return true;
    }
    __device__ __forceinline__ void a_ready(const Unit&) const {}
    __device__ __forceinline__ void done(const Unit&) const {}
};

__device__ __forceinline__ unsigned cvt_pk_bf16(float lo, float hi) { unsigned r; asm volatile("v_cvt_pk_bf16_f32 %0, %1, %2" : "=v"(r) : "v"(lo), "v"(hi)); return r; }
__device__ __forceinline__ float silu_f(float x) { return x * __builtin_amdgcn_rcpf(1.0f + __expf(-x)); }

struct EpiBf16Plain {
    static constexpr bool PERM = true, AFTER_DRAIN = false;
    bf16_t* O; int ldc; int silu_lo, silu_hi;
    __device__ __forceinline__ void operator()(const f32x4 (&acc)[2][2][4][2], const Unit& u, int wr, int wc, int fr, int fq) const {
        const int row0 = u.pm * BM + wr * 64 + fr, col0 = u.pn * BM + wc * 32 + 8 * fq;
        const bool act = (u.pn >= silu_lo) && (u.pn < silu_hi);
#pragma unroll
        for (int ai = 0; ai < 2; ++ai)
#pragma unroll
            for (int m = 0; m < 4; ++m) { bf16_t* rowp = O + (size_t)(row0 + ai * HALF + m * 16) * ldc + col0;
#pragma unroll
                for (int bj = 0; bj < 2; ++bj) { f32x4 v0 = acc[ai][bj][m][0], v1 = acc[ai][bj][m][1];
                    if (act) {
#pragma unroll
                        for (int i = 0; i < 4; ++i) { v0[i] = silu_f(v0[i]); v1[i] = silu_f(v1[i]); } }
                    u32x4 w; w.x = cvt_pk_bf16(v0[0], v0[1]); w.y = cvt_pk_bf16(v0[2], v0[3]); w.z = cvt_pk_bf16(v1[0], v1[1]); w.w = cvt_pk_bf16(v1[2], v1[3]);
                    *(u32x4*)(rowp + bj * HALF) = w; } }
    }
};
struct EpiSwiGLU {
    static constexpr bool PERM = true, AFTER_DRAIN = false;
    bf16_t* O; int ldc;
    __device__ __forceinline__ void operator()(const f32x4 (&acc)[2][2][4][2], const Unit& u, int wr, int wc, int fr, int fq) const {
        const int row0 = u.pm * BM + wr * 64 + fr, col0 = u.pn * HALF + wc * 32 + 8 * fq;
#pragma unroll
        for (int ai = 0; ai < 2; ++ai)
#pragma unroll
            for (int m = 0; m < 4; ++m) { bf16_t* rowp = O + (size_t)(row0 + ai * HALF + m * 16) * ldc + col0;
                const f32x4 g0 = acc[ai][0][m][0], g1 = acc[ai][0][m][1], u0 = acc[ai][1][m][0], u1 = acc[ai][1][m][1];
                float a[8];
#pragma unroll
                for (int i = 0; i < 4; ++i) { a[i] = silu_f(g0[i]) * u0[i]; a[4 + i] = silu_f(g1[i]) * u1[i]; }
                u32x4 w; w.x = cvt_pk_bf16(a[0], a[1]); w.y = cvt_pk_bf16(a[2], a[3]); w.z = cvt_pk_bf16(a[4], a[5]); w.w = cvt_pk_bf16(a[6], a[7]);
                *(u32x4*)rowp = w; }
    }
};
struct EpiGateRes {
    static constexpr bool PERM = false, AFTER_DRAIN = false;
    const float* base; float* out; int ldc; const float* gate; int gstride; int rows_per_batch;
    __device__ __forceinline__ void operator()(const f32x4 (&acc)[2][2][4][2], const Unit& u, int wr, int wc, int fr, int fq) const {
        const int row0 = u.pm * BM + wr * 64 + fr, col0 = u.pn * BM + wc * 32 + 4 * fq;
        const float* gp = gate + (size_t)((u.pm * BM) / rows_per_batch) * gstride + col0;
        f32x4 gv[2][2];
#pragma unroll
        for (int bj = 0; bj < 2; ++bj)
#pragma unroll
            for (int n = 0; n < 2; ++n) gv[bj][n] = *(const f32x4*)(gp + bj * HALF + n * 16);
#pragma unroll
        for (int ai = 0; ai < 2; ++ai)
#pragma unroll
            for (int m = 0; m < 4; ++m) { const size_t off = (size_t)(row0 + ai * HALF + m * 16) * ldc + col0;
#pragma unroll
                for (int bj = 0; bj < 2; ++bj)
#pragma unroll
                    for (int n = 0; n < 2; ++n) { const f32x4 bs = *(const f32x4*)(base + off + bj * HALF + n * 16);
                        *(f32x4*)(out + off + bj * HALF + n * 16) = bs + gv[bj][n] * acc[ai][bj][m][n]; } }
    }
};
struct EpiGateResNorm {
    static constexpr bool PERM = false, AFTER_DRAIN = false;
    const float* base; float* out; int ldc; const float* gate; int gstride; int rows_per_batch; const float* gm; bf16_t* xg; float* rowss;
    __device__ __forceinline__ void operator()(const f32x4 (&acc)[2][2][4][2], const Unit& u, int wr, int wc, int fr, int fq) const {
        const int row0 = u.pm * BM + wr * 64 + fr, col0 = u.pn * BM + wc * 32 + 4 * fq, b = (u.pm * BM) / rows_per_batch;
        const float* gp = gate + (size_t)b * gstride + col0; const float* mp = gm + (size_t)b * ldc + col0;
        f32x4 gv[2][2], mv[2][2];
#pragma unroll
        for (int bj = 0; bj < 2; ++bj)
#pragma unroll
            for (int n = 0; n < 2; ++n) { gv[bj][n] = *(const f32x4*)(gp + bj * HALF + n * 16); mv[bj][n] = *(const f32x4*)(mp + bj * HALF + n * 16); }
#pragma unroll
        for (int ai = 0; ai < 2; ++ai)
#pragma unroll
            for (int m = 0; m < 4; ++m) { const int row = row0 + ai * HALF + m * 16; const size_t off = (size_t)row * ldc + col0; float ss = 0.f;
#pragma unroll
                for (int bj = 0; bj < 2; ++bj)
#pragma unroll
                    for (int n = 0; n < 2; ++n) { const f32x4 bs = *(const f32x4*)(base + off + bj * HALF + n * 16); const f32x4 o = bs + gv[bj][n] * acc[ai][bj][m][n];
                        *(f32x4*)(out + off + bj * HALF + n * 16) = o; ss += (o[0] * o[0] + o[1] * o[1]) + (o[2] * o[2] + o[3] * o[3]);
                        const f32x4 h = o * mv[bj][n];
                        *(unsigned long long*)(xg + off + bj * HALF + n * 16) = (unsigned long long)cvt_pk_bf16(h[0], h[1]) | ((unsigned long long)cvt_pk_bf16(h[2], h[3]) << 32); }
                { auto r = __builtin_amdgcn_permlane16_swap(__float_as_uint(ss), __float_as_uint(ss), false, false); ss = __uint_as_float(r[0]) + __uint_as_float(r[1]);
                  auto s = __builtin_amdgcn_permlane32_swap(__float_as_uint(ss), __float_as_uint(ss), false, false); ss = __uint_as_float(s[0]) + __uint_as_float(s[1]); }
                if (fq == 0) atomicAdd(rowss + row, ss); }
    }
};
struct EpiSwiGLUNorm {
    static constexpr bool PERM = true, AFTER_DRAIN = false;
    bf16_t* O; int ldc; const float* rowss; const float* bgu; int nbias; int rows_per_batch; float inv_k, eps;
    __device__ __forceinline__ void operator()(const f32x4 (&acc)[2][2][4][2], const Unit& u, int wr, int wc, int fr, int fq) const {
        const int row0 = u.pm * BM + wr * 64 + fr, col0 = u.pn * HALF + wc * 32 + 8 * fq, b = (u.pm * BM) / rows_per_batch;
        const float* bp = bgu + (size_t)b * nbias + u.pn * BM + wc * 32 + 8 * fq;
        const f32x4 bg0 = *(const f32x4*)bp, bg1 = *(const f32x4*)(bp + 4), bu0 = *(const f32x4*)(bp + HALF), bu1 = *(const f32x4*)(bp + HALF + 4);
#pragma unroll
        for (int ai = 0; ai < 2; ++ai)
#pragma unroll
            for (int m = 0; m < 4; ++m) { const int row = row0 + ai * HALF + m * 16; bf16_t* rowp = O + (size_t)row * ldc + col0;
                const float rs = __builtin_amdgcn_rsqf(rowss[row] * inv_k + eps);
                const f32x4 g0 = acc[ai][0][m][0] * rs + bg0, g1 = acc[ai][0][m][1] * rs + bg1, u0 = acc[ai][1][m][0] * rs + bu0, u1 = acc[ai][1][m][1] * rs + bu1;
                float a[8];
#pragma unroll
                for (int i = 0; i < 4; ++i) { a[i] = silu_f(g0[i]) * u0[i]; a[4 + i] = silu_f(g1[i]) * u1[i]; }
                u32x4 w; w.x = cvt_pk_bf16(a[0], a[1]); w.y = cvt_pk_bf16(a[2], a[3]); w.z = cvt_pk_bf16(a[4], a[5]); w.w = cvt_pk_bf16(a[6], a[7]);
                *(u32x4*)rowp = w; }
    }
};

template <class Epi, class Sched, bool ALIGN_EPI = false, bool SP2 = false>
__device__ __forceinline__ void gemm_phase(PG8_LAS unsigned char* lds, const Gemm g, const Sched& S, const Epi& E) {
    const int tid = threadIdx.x, wid = __builtin_amdgcn_readfirstlane(tid >> 6), lane = tid & 63, wr = wid >> 2, wc = wid & 3, fr = lane & 15, fq = lane >> 4;
    const int K = g.K, nt = K / BK;
    unsigned voffA[2], voffB[2];
#pragma unroll
    for (int i = 0; i < 2; ++i) { int R, C; stage_rc(tid * 16 + i * 8192, R, C); const int Rb = Epi::PERM ? ((R & ~31) + perm32(R & 31)) : R;
        voffA[i] = (unsigned)(R * K + C) * 2u; voffB[i] = (unsigned)(Rb * K + C) * 2u; }
    const size_t kstep = (size_t)(BK * 2);
    const size_t hstep = (size_t)HALF * K * 2;
    const size_t tstep = 2 * hstep;
    const unsigned ldsw = (unsigned)wid * 1024u;
    const int aoff = lds_byte(wr * 64 + fr, fq * 8), boff = lds_byte(wc * 32 + fr, fq * 8);
#define PG8_SA(b, h) (((b) * 2 + (h)) * HTB)
#define PG8_SB(b, h) ((4 + (b) * 2 + (h)) * HTB)
#define PG8_STAGE(bufoff, gbase, voff) do { _Pragma("unroll") for (int _i = 0; _i < 2; ++_i) \
        __builtin_amdgcn_global_load_lds((const unsigned*)((const char*)(gbase) + (voff)[_i]), (PG8_LAS unsigned*)(lds + (bufoff) + ldsw + _i * 8192), 16, 0, 0); } while (0)
#define PG8_LDA(dst, b, h) do { _Pragma("unroll") for (int m = 0; m < 4; ++m) _Pragma("unroll") for (int k = 0; k < 2; ++k) dst[m][k] = *(const PG8_LAS bf16x8*)(lds + PG8_SA(b, h) + aoff + m * 2048 + k * 1024); } while (0)
#define PG8_LDB(dst, b, h) do { _Pragma("unroll") for (int n = 0; n < 2; ++n) _Pragma("unroll") for (int k = 0; k < 2; ++k) dst[n][k] = *(const PG8_LAS bf16x8*)(lds + PG8_SB(b, h) + boff + n * 2048 + k * 1024); } while (0)
#define PG8_MMA(ai, bj, At, Bt) do { __builtin_amdgcn_s_setprio(1); _Pragma("unroll") for (int m = 0; m < 4; ++m) _Pragma("unroll") for (int n = 0; n < 2; ++n) _Pragma("unroll") for (int k = 0; k < 2; ++k) \
        acc[ai][bj][m][n] = __builtin_amdgcn_mfma_f32_16x16x32_bf16(Bt[n][k], At[m][k], acc[ai][bj][m][n], 0, 0, 0); __builtin_amdgcn_s_setprio(0); } while (0)
#define PG8_WAIT_V(n) asm volatile("s_waitcnt vmcnt(" #n ")" ::: "memory")
#define PG8_WAIT_L(n) asm volatile("s_waitcnt lgkmcnt(" #n ")" ::: "memory")
#define PG8_BAR __builtin_amdgcn_s_barrier()
#define PG8_SCHED __builtin_amdgcn_sched_barrier(0)
    Unit cur, nxt; int ui = 0;
    if (!S.next(0, cur)) return;
    f32x4 acc[2][2][4][2];
#pragma unroll
    for (int a = 0; a < 2; ++a)
#pragma unroll
        for (int b = 0; b < 2; ++b)
#pragma unroll
            for (int m = 0; m < 4; ++m)
#pragma unroll
                for (int n = 0; n < 2; ++n) acc[a][b][m][n] = (f32x4){0.f, 0.f, 0.f, 0.f};
    bf16x8 At[4][2], B0[2][2], B1[2][2];
    const char* cA = (const char*)g.A + (size_t)cur.pm * tstep; const char* cB = (const char*)g.Bt + (size_t)cur.pn * tstep;
    S.a_ready(cur);
    if constexpr (SP2) {
        PG8_STAGE(PG8_SB(0, 0), cB, voffB); PG8_STAGE(PG8_SB(0, 1), cB + hstep, voffB); PG8_STAGE(PG8_SA(0, 0), cA, voffA); PG8_STAGE(PG8_SA(0, 1), cA + hstep, voffA);
        if (wr == 1) PG8_BAR;
        PG8_WAIT_V(2); PG8_BAR;
        PG8_STAGE(PG8_SB(1, 0), cB + kstep, voffB); PG8_STAGE(PG8_SA(1, 0), cA + kstep, voffA); PG8_STAGE(PG8_SB(1, 1), cB + hstep + kstep, voffB);
        PG8_WAIT_V(6); PG8_BAR;
    } else {
        PG8_STAGE(PG8_SB(0, 0), cB, voffB); PG8_STAGE(PG8_SA(0, 0), cA, voffA); PG8_STAGE(PG8_SB(0, 1), cB + hstep, voffB); PG8_STAGE(PG8_SA(0, 1), cA + hstep, voffA);
        if (wr == 1) PG8_BAR;
        PG8_WAIT_V(4); PG8_BAR;
        PG8_STAGE(PG8_SB(1, 0), cB + kstep, voffB); PG8_STAGE(PG8_SA(1, 0), cA + kstep, voffA); PG8_STAGE(PG8_SB(1, 1), cB + hstep + kstep, voffB);
        PG8_WAIT_V(6); PG8_BAR;
    }
    for (;;) {
        const bool has_next = S.next(ui + 1, nxt);
        const char* nA = has_next ? (const char*)g.A + (size_t)nxt.pm * tstep : cA; const char* nB = has_next ? (const char*)g.Bt + (size_t)nxt.pn * tstep : cB;
        for (int t = 0; t < nt; t += 2) {
            const bool last = (t == nt - 2);
            const char* a1 = cA + (size_t)(t + 1) * kstep;
            const char* a2 = last ? nA : cA + (size_t)(t + 2) * kstep; const char* b2 = last ? nB : cB + (size_t)(t + 2) * kstep;
            const char* a3 = a2 + kstep; const char* b3 = b2 + kstep;
            if (last && has_next) S.a_ready(nxt);
            if constexpr (SP2) {
            PG8_LDB(B0, 0, 0); PG8_LDB(B1, 0, 1); PG8_SCHED; PG8_LDA(At, 0, 0); PG8_STAGE(PG8_SA(1, 1), a1 + hstep, voffA);
            PG8_WAIT_V(8); PG8_WAIT_L(0); PG8_BAR; PG8_MMA(0, 0, At, B0); PG8_MMA(0, 1, At, B1); PG8_BAR; PG8_SCHED;
            PG8_LDA(At, 0, 1); PG8_STAGE(PG8_SB(0, 0), b2, voffB); PG8_STAGE(PG8_SB(0, 1), b2 + hstep, voffB); PG8_STAGE(PG8_SA(0, 0), a2, voffA);
            PG8_WAIT_V(8); PG8_WAIT_L(0); PG8_BAR; PG8_MMA(1, 0, At, B0); PG8_MMA(1, 1, At, B1); PG8_BAR; PG8_SCHED;
            PG8_LDB(B0, 1, 0); PG8_LDB(B1, 1, 1); PG8_SCHED; PG8_LDA(At, 1, 0); PG8_STAGE(PG8_SA(0, 1), a2 + hstep, voffA);
            PG8_WAIT_V(8); PG8_WAIT_L(0); PG8_BAR; PG8_MMA(0, 0, At, B0); PG8_MMA(0, 1, At, B1); PG8_BAR; PG8_SCHED;
            PG8_LDA(At, 1, 1); PG8_STAGE(PG8_SB(1, 0), b3, voffB); PG8_STAGE(PG8_SB(1, 1), b3 + hstep, voffB); PG8_STAGE(PG8_SA(1, 0), a3, voffA);
            PG8_WAIT_V(8); PG8_WAIT_L(0); PG8_BAR; PG8_MMA(1, 0, At, B0); PG8_MMA(1, 1, At, B1); PG8_BAR; PG8_SCHED;
            } else {
            PG8_LDB(B0, 0, 0); PG8_SCHED; PG8_LDA(At, 0, 0); PG8_STAGE(PG8_SA(1, 1), a1 + hstep, voffA);
            PG8_WAIT_L(8); PG8_BAR; PG8_WAIT_L(0); PG8_MMA(0, 0, At, B0); PG8_BAR; PG8_SCHED;
            PG8_LDB(B1, 0, 1); PG8_STAGE(PG8_SB(0, 0), b2, voffB);
            PG8_BAR; PG8_WAIT_L(0); PG8_MMA(0, 1, At, B1); PG8_BAR;
            PG8_LDA(At, 0, 1); PG8_STAGE(PG8_SA(0, 0), a2, voffA);
            PG8_BAR; PG8_WAIT_L(0); PG8_MMA(1, 0, At, B0); PG8_BAR; PG8_SCHED;
            PG8_STAGE(PG8_SB(0, 1), b2 + hstep, voffB);
            PG8_WAIT_V(6); PG8_BAR; PG8_MMA(1, 1, At, B1); PG8_BAR;
            PG8_LDB(B0, 1, 0); PG8_SCHED; PG8_LDA(At, 1, 0); PG8_STAGE(PG8_SA(0, 1), a2 + hstep, voffA);
            PG8_WAIT_L(8); PG8_BAR; PG8_WAIT_L(0); PG8_MMA(0, 0, At, B0); PG8_BAR; PG8_SCHED;
            PG8_LDB(B1, 1, 1); PG8_STAGE(PG8_SB(1, 0), b3, voffB);
            PG8_BAR; PG8_WAIT_L(0); PG8_MMA(0, 1, At, B1); PG8_BAR;
            PG8_LDA(At, 1, 1); PG8_STAGE(PG8_SA(1, 0), a3, voffA);
            PG8_BAR; PG8_WAIT_L(0); PG8_MMA(1, 0, At, B0); PG8_BAR; PG8_SCHED;
            PG8_STAGE(PG8_SB(1, 1), b3 + hstep, voffB);
            PG8_WAIT_V(6); PG8_BAR; PG8_MMA(1, 1, At, B1); PG8_BAR;
            }
        }
        if constexpr (ALIGN_EPI) { if (wr == 0) PG8_BAR; }
        if constexpr (!Epi::AFTER_DRAIN) { E(acc, cur, wr, wc, fr, fq); S.done(cur); }
        if (!has_next) break;
#pragma unroll
        for (int a = 0; a < 2; ++a)
#pragma unroll
            for (int b = 0; b < 2; ++b)
#pragma unroll
                for (int m = 0; m < 4; ++m)
#pragma unroll
                    for (int n = 0; n < 2; ++n) acc[a][b][m][n] = (f32x4){0.f, 0.f, 0.f, 0.f};
        cur = nxt; cA = nA; cB = nB; ++ui;
        if constexpr (ALIGN_EPI) { if (wr == 1) PG8_BAR; }
    }
    PG8_WAIT_V(0);
    if constexpr (!ALIGN_EPI) { if (wr == 0) PG8_BAR; }
    PG8_BAR;
    if constexpr (Epi::AFTER_DRAIN) { E.fused(acc, cur, wr, wc, fr, fq, lds, wid, lane); S.done(cur); }
#undef PG8_SA
#undef PG8_SB
#undef PG8_STAGE
#undef PG8_LDA
#undef PG8_LDB
#undef PG8_MMA
#undef PG8_WAIT_V
#undef PG8_WAIT_L
#undef PG8_BAR
#undef PG8_SCHED
}
}
constexpr int NWAVES = 8;
constexpr int BATCH = 4, T = 4096, D = 1024, M = BATCH * T;
constexpr int PROJ_W = 2832, NP = 2816, FF = 2816, NGU = 2 * FF, HD = 64;
constexpr int C_GQ = 0, C_GK = 512, C_GV = 1024, C_GZ = 1536, C_SQ = 2048, C_SK = 2560, C_SV = 2688;
constexpr float EPS = 1e-6f;
constexpr size_t MiB = 1u << 20;
constexpr size_t WS_CTL = 0, CTL_ZERO_BYTES = 160 * 1024;
constexpr size_t WS_MODF = 1 * MiB;
constexpr size_t WS_WAB = 1 * MiB + 256 * 1024;
constexpr size_t WS_GB = 2 * MiB;
constexpr size_t WS_WIN = 4 * MiB, WS_WOUT = 10 * MiB, WS_WGU = 12 * MiB, WS_WDN = 24 * MiB;
constexpr size_t WS_H = 32 * MiB;
constexpr size_t WS_PQ = 64 * MiB;
constexpr size_t WS_MIX = 160 * MiB;
constexpr size_t WS_CHKA = 192 * MiB;
constexpr size_t WS_DEC = 1 * MiB + 384 * 1024;
constexpr size_t WS_GM2 = 1 * MiB + 400 * 1024;
constexpr size_t WS_BGU = 1 * MiB + 448 * 1024;
constexpr size_t WS_END = 256 * MiB;
constexpr int CW_BAR = 4096;
constexpr int CW_ROWSS = 65536;
constexpr int CW_MODACC = 16384;
constexpr int RING_OFF = 0, RING_BYTES = 131072;
constexpr int LDS_BYTES = 163840;
constexpr int LDSCTL_OFF = LDS_BYTES - 1024, MISC_OFF = LDSCTL_OFF + 320;
#define GAS __attribute__((address_space(1)))
#define LAS __attribute__((address_space(3)))
typedef unsigned short bf16;
typedef unsigned v4u __attribute__((ext_vector_type(4)));
typedef float f32x4 __attribute__((ext_vector_type(4)));
typedef short bf16x8 __attribute__((ext_vector_type(8)));
typedef GAS unsigned gu32;
typedef GAS unsigned long long gu64;
#define RLX_AGENT __ATOMIC_RELAXED, __HIP_MEMORY_SCOPE_AGENT
#define LDS_WAIT() asm volatile("s_waitcnt lgkmcnt(0)" ::: "memory")
#define VM_WAIT() asm volatile("s_waitcnt vmcnt(0)" ::: "memory")
__device__ __forceinline__ unsigned long long rt() { return __builtin_amdgcn_s_memrealtime(); }
__device__ __forceinline__ unsigned f2bf(float f) { unsigned u = __builtin_bit_cast(unsigned, f); return (u + 0x7fffu + ((u >> 16) & 1u)) >> 16; }
__device__ __forceinline__ unsigned pk2(float lo, float hi) { return f2bf(lo) | (f2bf(hi) << 16); }

#define XB_TMO      128
#define XB_XCNT(j)  (256  + 64 * (j))
#define XB_XSUB(j)  (1280 + 64 * (j))
#define XB_XGEN(j)  (2304 + 64 * (j))
#define XB_TOP      3328
#define XB_TOPGEN   3392
#define XCD_BAR_WORDS 3456
#define XB_SPIN_CAP (1u << 22)

__device__ __forceinline__ unsigned xb_ld(unsigned* p)              { return __hip_atomic_load(p, __ATOMIC_RELAXED, __HIP_MEMORY_SCOPE_AGENT); }
__device__ __forceinline__ unsigned xb_add(unsigned* p, unsigned v) { return __hip_atomic_fetch_add(p, v, __ATOMIC_RELAXED, __HIP_MEMORY_SCOPE_AGENT); }
__device__ __forceinline__ unsigned xb_xcc_id() { return (unsigned)__builtin_amdgcn_s_getreg((3 << 11) | 20) & 0xFu; }
#define XB_SPIN(cond, bar) do { unsigned _sp = 0; while (cond) { __builtin_amdgcn_s_sleep(1); \
    if ((++_sp & 255u) == 0u) { if (xb_ld(&(bar)[XB_TMO])) break; if (_sp > XB_SPIN_CAP) { atomicAdd(&(bar)[XB_TMO], 1u); break; } } } } while (0)

struct XcdBarrier {
    unsigned* bar; unsigned x;
    volatile LAS unsigned* st;
};

__device__ __forceinline__ XcdBarrier xcd_barrier_post(unsigned* bar, volatile LAS unsigned* st) {
    XcdBarrier b; b.bar = bar; b.x = xb_xcc_id(); b.st = st;
    if (threadIdx.x == 0) (void)xb_add(&bar[XB_XCNT(b.x)], 1u);
    return b;
}
__device__ __forceinline__ void xcd_barrier_complete(unsigned* bar, unsigned x, unsigned& nloc, unsigned& nx) {
    const unsigned G = gridDim.x * gridDim.y * gridDim.z;
    unsigned sum, cnt, mine, sp = 0u;
    for (;;) {
        sum = 0u; cnt = 0u; mine = 0u;
#pragma unroll
        for (unsigned j = 0; j < 16; ++j) { const unsigned c = xb_ld(&bar[XB_XCNT(j)]); sum += c; cnt += (c > 0u) ? 1u : 0u; mine = (j == x) ? c : mine; }
        if (sum == G) break;
        __builtin_amdgcn_s_sleep(1);
        if ((++sp & 255u) == 0u) { if (xb_ld(&bar[XB_TMO])) break; if (sp > XB_SPIN_CAP) { atomicAdd(&bar[XB_TMO], 1u); break; } }
    }
    nloc = mine > 0u ? mine : 1u; nx = cnt > 0u ? cnt : 1u;
}

__device__ __forceinline__ void xcd_barrier(const XcdBarrier& b) {
    asm volatile("s_waitcnt vmcnt(0)" ::: "memory");
    __syncthreads();
    if (threadIdx.x == 0) {
        unsigned* bar = b.bar;
        __builtin_amdgcn_s_waitcnt(0);
        unsigned nloc = b.st[0], nx = b.st[1];
        if (nloc == 0u) { xcd_barrier_complete(bar, b.x, nloc, nx); b.st[0] = nloc; b.st[1] = nx; }
        const unsigned old = xb_add(&bar[XB_XSUB(b.x)], 1u);
        const unsigned gen = old / nloc;
        if (old + 1u == (gen + 1u) * nloc) {
            __builtin_amdgcn_fence(__ATOMIC_RELEASE, "agent");
            asm volatile("s_waitcnt vmcnt(0)" ::: "memory");
            const unsigned og = xb_add(&bar[XB_TOP], 1u);
            const unsigned tg = og / nx;
            if (og + 1u == (tg + 1u) * nx) xb_add(&bar[XB_TOPGEN], 1u);
            else XB_SPIN(xb_ld(&bar[XB_TOPGEN]) == tg, bar);
            __builtin_amdgcn_fence(__ATOMIC_ACQUIRE, "agent");
            xb_add(&bar[XB_XGEN(b.x)], 1u);
            asm volatile("s_waitcnt vmcnt(0)" ::: "memory");
        } else {
            XB_SPIN(xb_ld(&bar[XB_XGEN(b.x)]) == gen, bar);
            __builtin_amdgcn_fence(__ATOMIC_ACQUIRE, "agent");
            asm volatile("s_waitcnt vmcnt(0)" ::: "memory");
        }
    }
    __syncthreads();
}
struct Frame {
    LAS unsigned char* lds;
    volatile LAS unsigned* MISC;
    gu32* ctl;
    int tid, lane, wave;
    int vcu, G;
    const float *x, *c, *w_ada, *b_ada, *norm1_w, *w_in, *conv_w, *a_log, *dt_bias, *gdn_norm_w, *q_norm_w, *k_norm_w, *sinks, *w_out, *norm2_w, *w_gate, *w_up, *w_down;
    float* out;
    float *modacc, *modf, *wab, *gb, *gm2, *bgu, *rowss, *dec;
    bf16 *Win_t, *Wout_t, *Wgu_t, *Wdn_t, *H, *PQ, *MIX, *CHKA, *CHKU, *ORAW;
};
template <int CTRL, int ROWMASK, bool BC>
__device__ __forceinline__ float dpp_mov(float v) { return __int_as_float(__builtin_amdgcn_update_dpp(0, __float_as_int(v), CTRL, ROWMASK, 0xF, BC)); }
__device__ __forceinline__ float sum8(float v) { v += dpp_mov<0xB1, 0xF, true>(v); v += dpp_mov<0x4E, 0xF, true>(v); v += dpp_mov<0x141, 0xF, true>(v); return v; }
__device__ __forceinline__ float wave_sum(float v) {
    v = sum8(v); v += dpp_mov<0x140, 0xF, true>(v);
    v += dpp_mov<0x142, 0xA, false>(v); v += dpp_mov<0x143, 0xC, false>(v);
    return __int_as_float(__builtin_amdgcn_readlane(__float_as_int(v), 63));
}
__device__ __forceinline__ float fq_sum(float v) {
    auto r = __builtin_amdgcn_permlane16_swap(__float_as_uint(v), __float_as_uint(v), false, false); v = __uint_as_float(r[0]) + __uint_as_float(r[1]);
    auto s = __builtin_amdgcn_permlane32_swap(__float_as_uint(v), __float_as_uint(v), false, false); return __uint_as_float(s[0]) + __uint_as_float(s[1]);
}
__device__ __forceinline__ float fq_max(float v) {
    auto r = __builtin_amdgcn_permlane16_swap(__float_as_uint(v), __float_as_uint(v), false, false); v = fmaxf(__uint_as_float(r[0]), __uint_as_float(r[1]));
    auto s = __builtin_amdgcn_permlane32_swap(__float_as_uint(v), __float_as_uint(v), false, false); return fmaxf(__uint_as_float(s[0]), __uint_as_float(s[1]));
}
typedef float f32x2_t __attribute__((ext_vector_type(2))); typedef __bf16 bf16x2_t __attribute__((ext_vector_type(2)));
__device__ __forceinline__ unsigned cvtpk(float lo, float hi) { f32x2_t v = {lo, hi}; bf16x2_t b = __builtin_convertvector(v, bf16x2_t); return __builtin_bit_cast(unsigned, b); }
__device__ __forceinline__ float bf2f(bf16 h) { return __uint_as_float((unsigned)h << 16); }
__device__ __forceinline__ float ld_f32_coh(const float* p) { return __uint_as_float(__hip_atomic_load((const unsigned*)p, RLX_AGENT)); }
__device__ __forceinline__ float silu(float x) { return x * __builtin_amdgcn_rcpf(1.0f + __expf(-x)); }
__device__ __forceinline__ float rsq(float x) { return __builtin_amdgcn_rsqf(x); }

__device__ __forceinline__ void tr_item64(const float* W, int ldw, int src_col, bf16* WT, int K, int dst_row, int k0, LAS bf16* tl, int lane) {
    const int cg = lane & 15, rr = lane >> 4;
    f32x4 v[16];
#pragma unroll
    for (int i = 0; i < 16; ++i) v[i] = *(const GAS f32x4*)(W + (size_t)(k0 + 4 * i + rr) * ldw + src_col + 4 * cg);
#pragma unroll
    for (int i = 0; i < 16; ++i) *(LAS unsigned long long*)(tl + (4 * i + rr) * 68 + 4 * cg) = (unsigned long long)cvtpk(v[i].x, v[i].y) | ((unsigned long long)cvtpk(v[i].z, v[i].w) << 32);
    LDS_WAIT(); asm volatile("" ::: "memory");
#pragma unroll
    for (int ii = 0; ii < 8; ++ii) { const int p = lane + 64 * ii, n = p >> 3, kc = p & 7; const LAS bf16* s = tl + (8 * kc) * 68 + n;
        v4u o; o.x = (unsigned)s[0] | ((unsigned)s[68] << 16); o.y = (unsigned)s[2 * 68] | ((unsigned)s[3 * 68] << 16); o.z = (unsigned)s[4 * 68] | ((unsigned)s[5 * 68] << 16); o.w = (unsigned)s[6 * 68] | ((unsigned)s[7 * 68] << 16);
        *(GAS v4u*)(WT + (size_t)(dst_row + n) * K + k0 + 8 * kc) = o; }
    LDS_WAIT(); asm volatile("" ::: "memory");
}

__device__ __forceinline__ void p0_prologue(Frame& F) {
    LAS bf16* tl = (LAS bf16*)(F.lds + RING_OFF + F.wave * 16384);
    const int gw = F.vcu * NWAVES + F.wave, NGW = F.G * NWAVES, lane = F.lane;
    constexpr int I_ADA = 24 * 32, I_AB = 16, I_IN = 16 * (NP / 64), I_OUT = 16 * 16, I_GU = 16 * (NGU / 64), I_DN = (FF / 64) * 16;
    constexpr int NITEMS = I_ADA + I_AB + I_IN + I_OUT + I_GU + I_DN;
    for (int it = gw; it < NITEMS; it += NGW) {
        int r = it;
        if (r < I_ADA) {
            const int ct = r % 24, ks = r / 24, col = ct * 256 + 4 * lane, k0 = ks * 32;
            f32x4 acc[4];
#pragma unroll
            for (int b = 0; b < 4; ++b) acc[b] = (f32x4){0.f, 0.f, 0.f, 0.f};
#pragma unroll 16
            for (int kk = 0; kk < 32; ++kk) { const int k = k0 + kk; const f32x4 w = *(const GAS f32x4*)(F.w_ada + (size_t)k * (6 * D) + col);
#pragma unroll
                for (int b = 0; b < 4; ++b) acc[b] += silu(F.c[b * D + k]) * w; }
#pragma unroll
            for (int b = 0; b < 4; ++b)
#pragma unroll
                for (int j = 0; j < 4; ++j) atomicAdd(F.modacc + b * (6 * D) + col + j, acc[b][j]);
            continue;
        }
        r -= I_ADA;
        if (r < I_AB) {
            for (int i = 0; i < 16; ++i) { const int k = i * 64 + lane; F.wab[r * D + k] = F.w_in[(size_t)k * PROJ_W + 2048 + r]; }
            continue;
        }
        r -= I_AB;
        if (r < I_IN) { const int nb = r % (NP / 64), kb = r / (NP / 64), n0 = 64 * nb; tr_item64(F.w_in, PROJ_W, n0 < 2048 ? n0 : n0 + 16, F.Win_t, D, n0, 64 * kb, tl, lane); continue; }
        r -= I_IN;
        if (r < I_OUT) { const int nb = r % 16, kb = r / 16; tr_item64(F.w_out, D, 64 * nb, F.Wout_t, D, 64 * nb, 64 * kb, tl, lane); continue; }
        r -= I_OUT;
        if (r < I_GU) { const int nb = r % (NGU / 64), kb = r / (NGU / 64), n0 = 64 * nb, p = n0 >> 8, j = n0 & 255;
            if (j < 128) tr_item64(F.w_gate, FF, 128 * p + j, F.Wgu_t, D, n0, 64 * kb, tl, lane);
            else         tr_item64(F.w_up,   FF, 128 * p + j - 128, F.Wgu_t, D, n0, 64 * kb, tl, lane);
            continue; }
        r -= I_GU;
        { const int nb = r % 16, kb = r / 16; tr_item64(F.w_down, D, 64 * nb, F.Wdn_t, FF, 64 * nb, 64 * kb, tl, lane); }
    }
}

template <int WHICH, bool GAB = (WHICH == 1)> __device__ __forceinline__ void norm_phase(Frame& F) {
    const int gw = F.vcu * NWAVES + F.wave, NGW = F.G * NWAVES, lane = F.lane;
    if (WHICH == 1) {
        for (int idx = gw * 64 + lane; idx < 4 * 6 * D; idx += NGW * 64) F.modf[idx] = F.modacc[idx] + F.b_ada[idx % (6 * D)];
        for (int idx = gw * 64 + lane; idx < 4 * D; idx += NGW * 64) { const int b_ = idx / D, c_ = idx % D; F.gm2[idx] = F.norm2_w[c_] * (1.0f + F.modacc[b_ * 6 * D + 4 * D + c_] + F.b_ada[4 * D + c_]); }
    }
    if (GAB) {
        for (int i = F.tid; i < 16 * D / 4; i += NWAVES * 64) ((LAS f32x4*)(F.lds + RING_OFF))[i] = ((const GAS f32x4*)F.wab)[i];
        __syncthreads();
    }
    const float* src = (WHICH == 1) ? F.x : F.out;
    const float* nw = (WHICH == 1) ? F.norm1_w : F.norm2_w;
    for (int m0 = gw * 4; m0 < M; m0 += NGW * 4) {
        const int b = m0 / T;
        float gm[16], sh[16];
#pragma unroll
        for (int i = 0; i < 4; ++i)
#pragma unroll
            for (int e = 0; e < 4; ++e) { const int c = 256 * i + 4 * lane + e; float sc, sf;
                if (WHICH == 1) { sf = F.modacc[b * 6 * D + c] + F.b_ada[c]; sc = F.modacc[b * 6 * D + D + c] + F.b_ada[D + c];     }
                else { sf = F.modf[b * 6 * D + 3 * D + c]; sc = F.modf[b * 6 * D + 4 * D + c]; }
                gm[4 * i + e] = nw[c] * (1.0f + sc); sh[4 * i + e] = sf; }
        float h[4][16];
        f32x4 v[4][4];
#pragma unroll
        for (int r = 0; r < 4; ++r) { const GAS f32x4* xr = (const GAS f32x4*)(src + (size_t)(m0 + r) * D) + lane;
#pragma unroll
            for (int i = 0; i < 4; ++i) v[r][i] = xr[64 * i]; }
#pragma unroll
        for (int r = 0; r < 4; ++r) {
            float ss = 0.f;
#pragma unroll
            for (int i = 0; i < 4; ++i) ss += (v[r][i].x * v[r][i].x + v[r][i].y * v[r][i].y) + (v[r][i].z * v[r][i].z + v[r][i].w * v[r][i].w);
            const float rstd = rsq(wave_sum(ss) * (1.0f / D) + EPS);
            GAS unsigned long long* o8 = (GAS unsigned long long*)(F.H + (size_t)(m0 + r) * D) + lane;
#pragma unroll
            for (int i = 0; i < 4; ++i) {
                const float a0 = v[r][i].x * rstd * gm[4 * i + 0] + sh[4 * i + 0], a1 = v[r][i].y * rstd * gm[4 * i + 1] + sh[4 * i + 1];
                const float a2 = v[r][i].z * rstd * gm[4 * i + 2] + sh[4 * i + 2], a3 = v[r][i].w * rstd * gm[4 * i + 3] + sh[4 * i + 3];
                h[r][4 * i + 0] = a0; h[r][4 * i + 1] = a1; h[r][4 * i + 2] = a2; h[r][4 * i + 3] = a3;
                o8[64 * i] = (unsigned long long)cvtpk(a0, a1) | ((unsigned long long)cvtpk(a2, a3) << 32); }
        }
        if (GAB) {
            float myv = 0.f;
#pragma unroll 4
            for (int j = 0; j < 16; ++j) {
                const LAS f32x4* wp = (const LAS f32x4*)(F.lds + RING_OFF) + j * (D / 4) + lane;
                f32x4 wv[4];
#pragma unroll
                for (int i = 0; i < 4; ++i) wv[i] = wp[64 * i];
#pragma unroll
                for (int r = 0; r < 4; ++r) { float p = 0.f;
#pragma unroll
                    for (int i = 0; i < 4; ++i) p += (h[r][4 * i] * wv[i].x + h[r][4 * i + 1] * wv[i].y) + (h[r][4 * i + 2] * wv[i].z + h[r][4 * i + 3] * wv[i].w);
                    p = wave_sum(p);
                    if (lane == r * 16 + j) myv = p; }
            }
            const int j = lane & 15, hh = j & 7;
            float val;
            if (j < 8) { const float xx = myv + F.dt_bias[hh]; const float sp = fmaxf(xx, 0.f) + log1pf(__expf(-fabsf(xx))); val = -__expf(F.a_log[hh]) * sp; }
            else val = 1.0f / (1.0f + __expf(-myv));
            F.gb[(size_t)m0 * 16 + lane] = val;
        }
    }
}

__device__ __forceinline__ float rdlane(float v, int l) { return __int_as_float(__builtin_amdgcn_readlane(__float_as_int(v), l)); }
__device__ __forceinline__ bf16x8 pack8(const f32x4 a, const f32x4 b) {
    v4u w; w.x = cvtpk(a[0], a[1]); w.y = cvtpk(a[2], a[3]); w.z = cvtpk(b[0], b[1]); w.w = cvtpk(b[2], b[3]); return __builtin_bit_cast(bf16x8, w); }
__device__ __forceinline__ bf16x8 tile_frag(const LAS bf16* tile, int t, int ks, int fr, int fq) {
    const LAS bf16* p = tile + (16 * t + fr) * 64 + 32 * ks + 4 * fq;
    const unsigned long long lo = *(const LAS unsigned long long*)p, hi = *(const LAS unsigned long long*)(p + 16);
    v4u v; v.x = (unsigned)lo; v.y = (unsigned)(lo >> 32); v.z = (unsigned)hi; v.w = (unsigned)(hi >> 32); return __builtin_bit_cast(bf16x8, v);
}
__device__ __forceinline__ float arow(unsigned packed, int hi, int s) { const unsigned u = (unsigned)__builtin_amdgcn_readlane((int)packed, s); return __uint_as_float(hi ? (u & 0xffff0000u) : (u << 16)); }
__device__ __forceinline__ unsigned long long pack4(float a, float b, float c, float d) { return (unsigned long long)cvtpk(a, b) | ((unsigned long long)cvtpk(c, d) << 32); }

typedef short s16x4 __attribute__((ext_vector_type(4)));
__device__ __forceinline__ s16x4 cvt4(const f32x4 v) { const unsigned lo = cvtpk(v[0], v[1]), hi = cvtpk(v[2], v[3]); typedef unsigned u32x2 __attribute__((ext_vector_type(2))); return __builtin_bit_cast(s16x4, (u32x2){lo, hi}); }
#define MFMA16(a, b, c) __builtin_amdgcn_mfma_f32_16x16x16bf16_1k((a), (b), (c), 0, 0, 0)
#define MFMA32(a, b, c) __builtin_amdgcn_mfma_f32_16x16x32_bf16((a), (b), (c), 0, 0, 0)

__device__ __forceinline__ void gdn_prep_chunk(Frame& F, int ci, LAS unsigned char* wl  ) {
    const int lane = F.lane, bh = ci >> 6, n = ci & 63, b = bh >> 3, hh = bh & 7, fr = lane & 15, fq = lane >> 4;
    const size_t m0 = (size_t)b * T + 64 * n;
    bf16* const cA = F.CHKA + (size_t)ci * 16384;
    bf16* const cU = F.CHKU + (size_t)ci * 8192;
    LAS bf16* const R0 = (LAS bf16*)wl;
    LAS bf16* const R1 = (LAS bf16*)(wl + 9728);
#define GDN_RAW(dst, col0) do { _Pragma("unroll") for (int i_ = 0; i_ < 9; ++i_) { long row_ = (long)m0 - 3 + 8 * i_ + (lane >> 3); row_ = row_ < 0 ? 0 : (row_ > M - 1 ? M - 1 : row_); \
        __builtin_amdgcn_global_load_lds((const unsigned*)(F.PQ + (size_t)row_ * NP + (col0) + hh * 64 + (lane & 7) * 8), (LAS unsigned*)((dst) + i_ * 512), 16, 0, 0); } } while (0)
    GDN_RAW(R0, C_GQ); GDN_RAW(R1, C_GK);
    const f32x4 z4 = (f32x4){0.f, 0.f, 0.f, 0.f};
    const float g = ld_f32_coh(F.gb + (m0 + lane) * 16 + hh), beta = ld_f32_coh(F.gb + (m0 + lane) * 16 + 8 + hh);
    float G = g;
#pragma unroll
    for (int o = 1; o < 64; o <<= 1) { const float t = __shfl_up(G, o); if (lane >= o) G += t; }
    const float eG = __expf(G), Glast = __shfl(G, 63), kdsc = __expf(Glast - G), beG = beta * eG;
    if (lane == 0) F.dec[ci] = __expf(Glast);
    asm volatile("s_waitcnt vmcnt(0)" ::: "memory");
    {
        const float w0 = F.conv_w[hh * 64 + lane], w1 = F.conv_w[1536 + hh * 64 + lane], w2 = F.conv_w[2 * 1536 + hh * 64 + lane], w3 = F.conv_w[3 * 1536 + hh * 64 + lane];
        float x0 = 0.f, x1 = 0.f, x2 = 0.f;
        if (n > 0) { x0 = bf2f(R0[lane]); x1 = bf2f(R0[64 + lane]); x2 = bf2f(R0[128 + lane]); }
#pragma unroll
        for (int c = 0; c < 64; ++c) {
            const float r = bf2f(R0[(c + 3) * 64 + lane]);
            const float cq = silu(w0 * x0 + w1 * x1 + w2 * x2 + w3 * r); x0 = x1; x1 = x2; x2 = r;
            const float qn = cq * rsq(wave_sum(cq * cq) + EPS);
            R0[c * 64 + lane] = (bf16)(cvtpk(qn, qn) & 0xffffu);
            if ((c & 15) == 15) __builtin_amdgcn_sched_barrier(0);
        }
    }
    {
        const float w0 = F.conv_w[512 + hh * 64 + lane], w1 = F.conv_w[1536 + 512 + hh * 64 + lane], w2 = F.conv_w[2 * 1536 + 512 + hh * 64 + lane], w3 = F.conv_w[3 * 1536 + 512 + hh * 64 + lane];
        float x0 = 0.f, x1 = 0.f, x2 = 0.f;
        if (n > 0) { x0 = bf2f(R1[lane]); x1 = bf2f(R1[64 + lane]); x2 = bf2f(R1[128 + lane]); }
#pragma unroll
        for (int c = 0; c < 64; ++c) {
            const float r = bf2f(R1[(c + 3) * 64 + lane]);
            const float ck = silu(w0 * x0 + w1 * x1 + w2 * x2 + w3 * r); x0 = x1; x1 = x2; x2 = r;
            const float kn = ck * rsq(wave_sum(ck * ck) + EPS);
            R1[c * 64 + lane] = (bf16)(cvtpk(kn, kn) & 0xffffu);
            if ((c & 15) == 15) __builtin_amdgcn_sched_barrier(0);
        }
    }
    LDS_WAIT(); asm volatile("" ::: "memory");
    bf16x8 kf[4][2], qf[4][2];
#pragma unroll
    for (int blk = 0; blk < 4; ++blk)
#pragma unroll
        for (int kk = 0; kk < 2; ++kk) { kf[blk][kk] = *(const LAS bf16x8*)(R1 + (16 * blk + fr) * 64 + 32 * kk + 8 * fq); qf[blk][kk] = *(const LAS bf16x8*)(R0 + (16 * blk + fr) * 64 + 32 * kk + 8 * fq); }
    float Gcol[4], Bcol[4], Grow[4][4];
#pragma unroll
    for (int t = 0; t < 4; ++t) { Gcol[t] = __shfl(G, 16 * t + fr); Bcol[t] = __shfl(beta, 16 * t + fr);
#pragma unroll
        for (int i = 0; i < 4; ++i) Grow[t][i] = __shfl(G, 16 * t + 4 * fq + i); }
#pragma unroll
    for (int mt = 0; mt < 4; ++mt) { const float esc = __expf(Gcol[mt]) * 0.125f;
#pragma unroll
        for (int ks = 0; ks < 2; ++ks) { const v4u q8 = __builtin_bit_cast(v4u, tile_frag(R0, mt, ks, fr, fq)); const unsigned w_[4] = {q8.x, q8.y, q8.z, q8.w}; v4u o_;
            o_.x = cvtpk(__uint_as_float(w_[0] << 16) * esc, __uint_as_float(w_[0] & 0xffff0000u) * esc); o_.y = cvtpk(__uint_as_float(w_[1] << 16) * esc, __uint_as_float(w_[1] & 0xffff0000u) * esc);
            o_.z = cvtpk(__uint_as_float(w_[2] << 16) * esc, __uint_as_float(w_[2] & 0xffff0000u) * esc); o_.w = cvtpk(__uint_as_float(w_[3] << 16) * esc, __uint_as_float(w_[3] & 0xffff0000u) * esc);
            *(GAS v4u*)(cA + 4096 + ((mt * 2 + ks) * 64 + lane) * 8) = o_; } }
    LDS_WAIT(); asm volatile("" ::: "memory");
#pragma unroll
    for (int tc = 0; tc < 4; ++tc)
#pragma unroll
        for (int ks = 0; ks < 2; ++ks) {
            f32x4 v[2];
#pragma unroll
            for (int h2 = 0; h2 < 2; ++h2) { const int ts = 2 * ks + h2;
                if (ts <= tc) { f32x4 acc = MFMA32(kf[ts][0], qf[tc][0], z4); acc = MFMA32(kf[ts][1], qf[tc][1], acc);
#pragma unroll
                    for (int i = 0; i < 4; ++i) { const int cidx = 16 * tc + fr, sidx = 16 * ts + 4 * fq + i; v[h2][i] = (cidx >= sidx) ? acc[i] * __expf(Gcol[tc] - Grow[ts][i]) * 0.125f : 0.f; }
                } else v[h2] = z4; }
            *(bf16x8*)(cA + 2 * 4096 + ((tc * 2 + ks) * 64 + lane) * 8) = pack8(v[0], v[1]);
        }
#pragma unroll
    for (int tc = 0; tc < 4; ++tc)
#pragma unroll
        for (int ts = 0; ts < 4; ++ts) { f32x4 a = z4;
            if (ts <= tc) { f32x4 acc = MFMA32(kf[ts][0], kf[tc][0], z4); acc = MFMA32(kf[ts][1], kf[tc][1], acc);
#pragma unroll
                for (int i = 0; i < 4; ++i) { const int cidx = 16 * tc + fr, sidx = 16 * ts + 4 * fq + i; a[i] = (cidx > sidx) ? Bcol[tc] * acc[i] * __expf(Gcol[tc] - Grow[ts][i]) : 0.f; } }
            *(LAS unsigned long long*)(R0 + (16 * tc + fr) * 64 + 16 * ts + 4 * fq) = pack4(a[0], a[1], a[2], a[3]); }
    bf16x8 RkB[4][2], KDf[4][2];
#pragma unroll
    for (int ks = 0; ks < 2; ++ks) { float sB[8], sD[8];
#pragma unroll
        for (int j = 0; j < 8; ++j) { const int tok = 32 * ks + 16 * (j >> 2) + 4 * fq + (j & 3); sB[j] = __shfl(beG, tok); sD[j] = __shfl(kdsc, tok); }
#pragma unroll
        for (int t = 0; t < 4; ++t) { float kv[8];
#pragma unroll
            for (int j = 0; j < 8; ++j) kv[j] = bf2f(R1[(32 * ks + 16 * (j >> 2) + 4 * fq + (j & 3)) * 64 + 16 * t + fr]);
            v4u a_, d_;
            a_.x = cvtpk(kv[0] * sB[0], kv[1] * sB[1]); a_.y = cvtpk(kv[2] * sB[2], kv[3] * sB[3]); a_.z = cvtpk(kv[4] * sB[4], kv[5] * sB[5]); a_.w = cvtpk(kv[6] * sB[6], kv[7] * sB[7]);
            d_.x = cvtpk(kv[0] * sD[0], kv[1] * sD[1]); d_.y = cvtpk(kv[2] * sD[2], kv[3] * sD[3]); d_.z = cvtpk(kv[4] * sD[4], kv[5] * sD[5]); d_.w = cvtpk(kv[6] * sD[6], kv[7] * sD[7]);
            RkB[t][ks] = __builtin_bit_cast(bf16x8, a_); KDf[t][ks] = __builtin_bit_cast(bf16x8, d_); } }
    LDS_WAIT(); asm volatile("" ::: "memory");
    {
        float X[16];
#pragma unroll
        for (int r = 0; r < 16; ++r) X[r] = (r == fr) ? 1.f : 0.f;
        const LAS bf16* ab = R0 + (16 * fq) * 64 + 16 * fq;
#pragma unroll
        for (int s = 0; s < 15; ++s) {
#pragma unroll
            for (int r = s + 1; r < 16; ++r) X[r] -= bf2f(ab[r * 64 + s]) * X[s];
            if ((s & 3) == 3) __builtin_amdgcn_sched_barrier(0);
        }
        LDS_WAIT(); asm volatile("" ::: "memory");
#pragma unroll
        for (int r = 0; r < 16; ++r) R0[(16 * fq + r) * 64 + 16 * fq + fr] = (bf16)(cvtpk(X[r], X[r]) & 0xffffu);
    }
    LDS_WAIT(); asm volatile("" ::: "memory");
    {
#define A16(i, k) (*(const LAS s16x4*)(R0 + (16 * (i) + fr) * 64 + 16 * (k) + 4 * fq))
        s16x4 Td[4];
#pragma unroll
        for (int j = 0; j < 3; ++j) { const LAS bf16* p = R0 + (16 * j + 4 * fq) * 64 + 16 * j + fr; typedef unsigned u32x2 __attribute__((ext_vector_type(2)));
            Td[j] = __builtin_bit_cast(s16x4, (u32x2){(unsigned)p[0] | ((unsigned)p[64] << 16), (unsigned)p[128] | ((unsigned)p[192] << 16)}); }
        f32x4 m10 = MFMA16(A16(1, 0), Td[0], z4);
        const f32x4 t10 = -MFMA16(A16(1, 1), cvt4(m10), z4);
        f32x4 m21 = MFMA16(A16(2, 1), Td[1], z4);
        f32x4 m20 = MFMA16(A16(2, 0), Td[0], z4); m20 = MFMA16(A16(2, 1), cvt4(t10), m20);
        const s16x4 a22 = A16(2, 2);
        const f32x4 t21 = -MFMA16(a22, cvt4(m21), z4), t20 = -MFMA16(a22, cvt4(m20), z4);
        f32x4 m32 = MFMA16(A16(3, 2), Td[2], z4);
        f32x4 m31 = MFMA16(A16(3, 1), Td[1], z4); m31 = MFMA16(A16(3, 2), cvt4(t21), m31);
        f32x4 m30 = MFMA16(A16(3, 0), Td[0], z4); m30 = MFMA16(A16(3, 1), cvt4(t10), m30); m30 = MFMA16(A16(3, 2), cvt4(t20), m30);
        const s16x4 a33 = A16(3, 3);
        const f32x4 t32 = -MFMA16(a33, cvt4(m32), z4), t31 = -MFMA16(a33, cvt4(m31), z4), t30 = -MFMA16(a33, cvt4(m30), z4);
        LDS_WAIT(); asm volatile("" ::: "memory");
#define TST(i, j, t) do { _Pragma("unroll") for (int r_ = 0; r_ < 4; ++r_) R0[(16 * (i) + 4 * fq + r_) * 64 + 16 * (j) + fr] = (bf16)(cvtpk((t)[r_], (t)[r_]) & 0xffffu); } while (0)
        TST(1, 0, t10); TST(2, 0, t20); TST(2, 1, t21); TST(3, 0, t30); TST(3, 1, t31); TST(3, 2, t32);
#undef TST
#undef A16
    }
    LDS_WAIT(); asm volatile("" ::: "memory");
#pragma unroll
    for (int ct = 0; ct < 4; ++ct) { const bf16x8 ta0 = tile_frag(R0, ct, 0, fr, fq), ta1 = tile_frag(R0, ct, 1, fr, fq);
#pragma unroll
        for (int dt = 0; dt < 4; ++dt) { f32x4 acc = MFMA32(ta0, RkB[dt][0], z4); if (ct >= 2) acc = MFMA32(ta1, RkB[dt][1], acc);
            *(LAS unsigned long long*)(R1 + (16 * dt + fr) * 64 + 16 * ct + 4 * fq) = pack4(acc[0], acc[1], acc[2], acc[3]); } }
    asm volatile("s_waitcnt vmcnt(0) lgkmcnt(0)" ::: "memory");
#pragma unroll
    for (int tn = 0; tn < 4; ++tn) {
        const bf16x8 qb0 = *(const GAS bf16x8*)(cA + 2 * 4096 + ((tn * 2) * 64 + lane) * 8), qb1 = *(const GAS bf16x8*)(cA + 2 * 4096 + ((tn * 2 + 1) * 64 + lane) * 8);
#pragma unroll
        for (int ks2 = 0; ks2 < 2; ++ks2) {
            const v4u qd8 = *(const GAS v4u*)(cA + 4096 + ((tn * 2 + ks2) * 64 + lane) * 8); const unsigned qw_[4] = {qd8.x, qd8.y, qd8.z, qd8.w};
            f32x4 pp[2], q2[2];
#pragma unroll
            for (int h2 = 0; h2 < 2; ++h2) { const int tm = 2 * ks2 + h2;
                const bf16x8 wa0 = tile_frag(R1, tm, 0, fr, fq), wa1 = tile_frag(R1, tm, 1, fr, fq);
                f32x4 a1 = MFMA32(wa0, KDf[tn][0], z4); a1 = MFMA32(wa1, KDf[tn][1], a1);
                f32x4 a2 = MFMA32(wa0, qb0, z4); a2 = MFMA32(wa1, qb1, a2);
                pp[h2] = -a1;
                q2[h2] = (f32x4){__uint_as_float(qw_[2 * h2] << 16), __uint_as_float(qw_[2 * h2] & 0xffff0000u), __uint_as_float(qw_[2 * h2 + 1] << 16), __uint_as_float(qw_[2 * h2 + 1] & 0xffff0000u)} - a2; }
            *(GAS bf16x8*)(cA + ((tn * 2 + ks2) * 64 + lane) * 8) = pack8(pp[0], pp[1]);
            *(GAS bf16x8*)(cA + 3 * 4096 + ((tn * 2 + ks2) * 64 + lane) * 8) = pack8(q2[0], q2[1]);
        }
    }
    LDS_WAIT(); asm volatile("" ::: "memory");
    GDN_RAW(R1, C_GV);
    asm volatile("s_waitcnt vmcnt(0)" ::: "memory");
    {
        const float w0 = F.conv_w[1024 + hh * 64 + lane], w1 = F.conv_w[1536 + 1024 + hh * 64 + lane], w2 = F.conv_w[2 * 1536 + 1024 + hh * 64 + lane], w3 = F.conv_w[3 * 1536 + 1024 + hh * 64 + lane];
        float x0 = 0.f, x1 = 0.f, x2 = 0.f;
        if (n > 0) { x0 = bf2f(R1[lane]); x1 = bf2f(R1[64 + lane]); x2 = bf2f(R1[128 + lane]); }
#pragma unroll
        for (int c = 0; c < 64; ++c) {
            const float r = bf2f(R1[(c + 3) * 64 + lane]);
            const float cv = silu(w0 * x0 + w1 * x1 + w2 * x2 + w3 * r); x0 = x1; x1 = x2; x2 = r;
            R1[c * 64 + lane] = (bf16)(cvtpk(cv, cv) & 0xffffu);
            if ((c & 15) == 15) __builtin_amdgcn_sched_barrier(0);
        }
    }
    LDS_WAIT(); asm volatile("" ::: "memory");
    bf16x8 RvB[4][2];
#pragma unroll
    for (int ks = 0; ks < 2; ++ks) { float sB[8];
#pragma unroll
        for (int j = 0; j < 8; ++j) sB[j] = __shfl(beta, 32 * ks + 16 * (j >> 2) + 4 * fq + (j & 3));
#pragma unroll
        for (int t = 0; t < 4; ++t) { float vv[8];
#pragma unroll
            for (int j = 0; j < 8; ++j) vv[j] = bf2f(R1[(32 * ks + 16 * (j >> 2) + 4 * fq + (j & 3)) * 64 + 16 * t + fr]) * sB[j];
            v4u a_; a_.x = cvtpk(vv[0], vv[1]); a_.y = cvtpk(vv[2], vv[3]); a_.z = cvtpk(vv[4], vv[5]); a_.w = cvtpk(vv[6], vv[7]);
            RvB[t][ks] = __builtin_bit_cast(bf16x8, a_); } }
    LDS_WAIT(); asm volatile("" ::: "memory");
#pragma unroll
    for (int ct = 0; ct < 4; ++ct) { const bf16x8 ta0 = tile_frag(R0, ct, 0, fr, fq), ta1 = tile_frag(R0, ct, 1, fr, fq);
#pragma unroll
        for (int et = 0; et < 4; ++et) { f32x4 acc = MFMA32(ta0, RvB[et][0], z4); if (ct >= 2) acc = MFMA32(ta1, RvB[et][1], acc);
            *(LAS unsigned long long*)(R1 + (16 * et + fr) * 64 + 16 * ct + 4 * fq) = pack4(acc[0], acc[1], acc[2], acc[3]); } }
    LDS_WAIT(); asm volatile("" ::: "memory");
#pragma unroll
    for (int et = 0; et < 4; ++et) {
        const bf16x8 ub0 = tile_frag(R1, et, 0, fr, fq), ub1 = tile_frag(R1, et, 1, fr, fq);
#pragma unroll
        for (int tm = 0; tm < 4; ++tm) {
            const bf16x8 qa0 = *(const GAS bf16x8*)(cA + 2 * 4096 + ((tm * 2) * 64 + lane) * 8), qa1 = *(const GAS bf16x8*)(cA + 2 * 4096 + ((tm * 2 + 1) * 64 + lane) * 8);
            f32x4 r = MFMA32(KDf[tm][0], ub0, z4); r = MFMA32(KDf[tm][1], ub1, r);
            f32x4 o = MFMA32(qa0, ub0, z4); o = MFMA32(qa1, ub1, o);
            *(GAS unsigned long long*)(cU + ((et * 4 + tm) * 64 + lane) * 4) = pack4(r[0], r[1], r[2], r[3]);
            *(GAS unsigned long long*)(cU + 4096 + ((et * 4 + tm) * 64 + lane) * 4) = pack4(o[0], o[1], o[2], o[3]);
        }
    }
    LDS_WAIT(); asm volatile("" ::: "memory");
}
#undef MFMA16
#undef MFMA32
#undef GDN_RAW

#define GDN_BAR() do { asm volatile("" ::: "memory"); __builtin_amdgcn_s_barrier(); asm volatile("" ::: "memory"); } while (0)
__device__ __forceinline__ void gdn_scan(Frame& F, int bh) {
    const int lane = F.lane, wave = F.wave, b = bh >> 3, hh = bh & 7, fr = lane & 15, fq = lane >> 4;
    LAS unsigned char* const ring = F.lds + RING_OFF;
    constexpr int SLOT = 32768, OB0 = 131072, OB1 = 139264;
    const unsigned char* gA = (const unsigned char*)(F.CHKA + (size_t)bh * 64 * 16384);
    const unsigned char* gU = (const unsigned char*)(F.CHKU + (size_t)bh * 64 * 8192);
    if (wave >= 4) {
        const int hw = wave - 4, nt = hw * 64 + lane;
        bf16* mp = F.MIX + ((size_t)b * T + (nt >> 3)) * D + hh * 64 + (nt & 7) * 8;
#define GDN_ISSUE(nn) do { const int n_ = (nn); const int sl_ = n_ & 3; _Pragma("unroll") for (int i_ = 0; i_ < 8; ++i_) { const int p_ = hw * 8 + i_; \
            const unsigned char* s_ = (p_ < 8) ? gA + (size_t)n_ * 32768 + p_ * 1024 : (p_ < 16) ? gA + (size_t)n_ * 32768 + 24576 + (p_ - 8) * 1024 : gU + (size_t)n_ * 16384 + (p_ - 16) * 1024; \
            __builtin_amdgcn_global_load_lds((const unsigned*)(s_ + lane * 16), (LAS unsigned*)(ring + sl_ * SLOT + p_ * 1024), 16, 0, 0); } } while (0)
#define GDN_COPY(nn) do { const LAS unsigned char* ob_ = ring + (((nn) & 1) ? OB1 : OB0); _Pragma("unroll") for (int k_ = 0; k_ < 2; ++k_) \
            *(GAS v4u*)(mp + (size_t)(64 * (nn) + 32 * k_) * D) = *(const LAS v4u*)(ob_ + (nt + 256 * k_) * 16); } while (0)
        GDN_ISSUE(0); GDN_ISSUE(1); GDN_ISSUE(2);
        asm volatile("s_waitcnt vmcnt(16)" ::: "memory"); GDN_BAR();
        for (int n = 0; n < 64; ++n) {
            if (n + 3 < 64) { GDN_ISSUE(n + 3); asm volatile("s_waitcnt vmcnt(16)" ::: "memory"); } else asm volatile("s_waitcnt vmcnt(0)" ::: "memory");
            if (n > 0) GDN_COPY(n - 1);
            LDS_WAIT(); GDN_BAR();
        }
        GDN_COPY(63);
#undef GDN_ISSUE
#undef GDN_COPY
    } else {
        const int ew = wave;
        f32x4 Sacc[4];
#pragma unroll
        for (int t = 0; t < 4; ++t) Sacc[t] = (f32x4){0.f, 0.f, 0.f, 0.f};
        const float decs = ld_f32_coh(F.dec + bh * 64 + lane);
        GDN_BAR();
        for (int n = 0; n < 64; ++n) {
            const LAS unsigned char* sl = ring + (n & 3) * SLOT;
            LAS bf16* ob = (LAS bf16*)(ring + ((n & 1) ? OB1 : OB0)) + (4 * fq) * 64 + 16 * ew + fr;
            const float dec = __int_as_float(__builtin_amdgcn_readlane(__float_as_int(decs), n));
            unsigned long long rf[4], of[4]; bf16x8 pf[8], qf[8];
#pragma unroll
            for (int t = 0; t < 4; ++t) { rf[t] = *(const LAS unsigned long long*)(sl + 16384 + ((ew * 4 + t) * 64 + lane) * 8); of[t] = *(const LAS unsigned long long*)(sl + 24576 + ((ew * 4 + t) * 64 + lane) * 8); }
#pragma unroll
            for (int f = 0; f < 8; ++f) { pf[f] = *(const LAS bf16x8*)(sl + (f * 64 + lane) * 16); qf[f] = *(const LAS bf16x8*)(sl + 8192 + (f * 64 + lane) * 16); }
            __builtin_amdgcn_sched_barrier(0);
            bf16x8 Sb[2]; Sb[0] = pack8(Sacc[0], Sacc[1]); Sb[1] = pack8(Sacc[2], Sacc[3]);
            f32x4 O[4];
#pragma unroll
            for (int t = 0; t < 4; ++t) { const unsigned rl = (unsigned)rf[t], rh = (unsigned)(rf[t] >> 32), ol = (unsigned)of[t], oh = (unsigned)(of[t] >> 32);
                Sacc[t] = Sacc[t] * dec + (f32x4){__uint_as_float(rl << 16), __uint_as_float(rl & 0xffff0000u), __uint_as_float(rh << 16), __uint_as_float(rh & 0xffff0000u)};
                O[t] = (f32x4){__uint_as_float(ol << 16), __uint_as_float(ol & 0xffff0000u), __uint_as_float(oh << 16), __uint_as_float(oh & 0xffff0000u)}; }
#pragma unroll
            for (int t = 0; t < 4; ++t)
#pragma unroll
                for (int ks = 0; ks < 2; ++ks) { const int f = t * 2 + ks;
                    Sacc[t] = __builtin_amdgcn_mfma_f32_16x16x32_bf16(pf[f], Sb[ks], Sacc[t], 0, 0, 0); O[t] = __builtin_amdgcn_mfma_f32_16x16x32_bf16(qf[f], Sb[ks], O[t], 0, 0, 0); }
#pragma unroll
            for (int t = 0; t < 4; ++t)
#pragma unroll
                for (int i = 0; i < 4; ++i) ob[(16 * t + i) * 64] = (bf16)(cvtpk(O[t][i], O[t][i]) & 0xffffu);
            LDS_WAIT(); GDN_BAR();
        }
    }
    asm volatile("s_waitcnt vmcnt(0)" ::: "memory"); GDN_BAR();
    {
        const int oc = F.tid & 7;
        float nw[8];
#pragma unroll
        for (int j = 0; j < 8; ++j) nw[j] = F.gdn_norm_w[oc * 8 + j];
        bf16* mp0 = F.MIX + ((size_t)b * T + (F.tid >> 3)) * D + hh * 64 + oc * 8;
        const bf16* zp0 = F.PQ + ((size_t)b * T + (F.tid >> 3)) * NP + C_GZ + hh * 64 + oc * 8;
#pragma unroll 1
        for (int it = 0; it < 4; ++it) {
            v4u ov[16], zv[16];
#pragma unroll
            for (int k = 0; k < 16; ++k) { const size_t r = (size_t)(it * 16 + k) * 64; ov[k] = *(const GAS v4u*)(mp0 + r * D); zv[k] = *(const GAS v4u*)(zp0 + r * NP); }
#pragma unroll
            for (int k = 0; k < 16; ++k) { const size_t r = (size_t)(it * 16 + k) * 64;
                const unsigned ow[4] = {ov[k].x, ov[k].y, ov[k].z, ov[k].w}, zw[4] = {zv[k].x, zv[k].y, zv[k].z, zv[k].w};
                float o[8], z[8]; float ss = 0.f;
#pragma unroll
                for (int w = 0; w < 4; ++w) { o[2 * w] = __uint_as_float(ow[w] << 16); o[2 * w + 1] = __uint_as_float(ow[w] & 0xffff0000u); z[2 * w] = __uint_as_float(zw[w] << 16); z[2 * w + 1] = __uint_as_float(zw[w] & 0xffff0000u);
                    ss += o[2 * w] * o[2 * w] + o[2 * w + 1] * o[2 * w + 1]; }
                ss = sum8(ss);
                const float rs = rsq(ss * (1.0f / 64.0f) + EPS);
                v4u w4; w4.x = cvtpk(o[0] * rs * nw[0] * z[0], o[1] * rs * nw[1] * z[1]); w4.y = cvtpk(o[2] * rs * nw[2] * z[2], o[3] * rs * nw[3] * z[3]);
                w4.z = cvtpk(o[4] * rs * nw[4] * z[4], o[5] * rs * nw[5] * z[5]); w4.w = cvtpk(o[6] * rs * nw[6] * z[6], o[7] * rs * nw[7] * z[7]);
                *(GAS v4u*)(mp0 + r * D) = w4; }
        }
    }
}
__device__ __forceinline__ void swa_unit(Frame& F, int unit, LAS unsigned char* L) {
    const int tid = F.tid, lane = F.lane, wave = F.wave, fr = lane & 15, fq = lane >> 4;
    const int blk = unit & 63, kvh = (unit >> 6) & 1, b = unit >> 7, t0 = blk * 64;
    const size_t row0 = (size_t)b * T;
    LAS bf16* const Ks = (LAS bf16*)L; LAS bf16* const Vt = (LAS bf16*)(L + 27648);
    for (int p = tid; p < 1536; p += NWAVES * 64) {
        const int key = p >> 3, oc = p & 7, s = t0 - 128 + key;
        v4u kv = (v4u){0u, 0u, 0u, 0u}, vv = (v4u){0u, 0u, 0u, 0u};
        if (s >= 0) { kv = *(const GAS v4u*)(F.PQ + (row0 + s) * NP + C_SK + kvh * 64 + oc * 8); vv = *(const GAS v4u*)(F.PQ + (row0 + s) * NP + C_SV + kvh * 64 + oc * 8); }
        const unsigned kw[4] = {kv.x, kv.y, kv.z, kv.w}, vw[4] = {vv.x, vv.y, vv.z, vv.w};
        float k[8]; float ss = 0.f;
#pragma unroll
        for (int w = 0; w < 4; ++w) { k[2 * w] = __uint_as_float(kw[w] << 16); k[2 * w + 1] = __uint_as_float(kw[w] & 0xffff0000u); ss += k[2 * w] * k[2 * w] + k[2 * w + 1] * k[2 * w + 1]; }
        ss = sum8(ss);
        const float rstd = rsq(ss * (1.0f / 64.0f) + EPS);
#pragma unroll
        for (int j = 0; j < 8; ++j) k[j] = k[j] * rstd * F.k_norm_w[oc * 8 + j];
        v4u o; o.x = cvtpk(k[0], k[1]); o.y = cvtpk(k[2], k[3]); o.z = cvtpk(k[4], k[5]); o.w = cvtpk(k[6], k[7]);
        *(LAS v4u*)(Ks + key * 72 + oc * 8) = o;
#pragma unroll
        for (int w = 0; w < 4; ++w) { Vt[(oc * 8 + 2 * w) * 196 + key] = (bf16)(vw[w] & 0xffffu); Vt[(oc * 8 + 2 * w + 1) * 196 + key] = (bf16)(vw[w] >> 16); }
    }
    __syncthreads();
    const int hq = kvh * 4 + (wave >> 1);
    const float slope = exp2f(-(float)(hq + 1)), sink = F.sinks[hq];
#pragma unroll 1
    for (int qt = 0; qt < 2; ++qt) {
        const int tq0 = t0 + 32 * (wave & 1) + 16 * qt;
        bf16x8 qf[2];
        {
            const bf16* qp = F.PQ + (row0 + tq0 + fr) * NP + C_SQ + hq * 64 + 8 * fq;
            const v4u r0 = *(const GAS v4u*)qp, r1 = *(const GAS v4u*)(qp + 32);
            const unsigned qw[8] = {r0.x, r0.y, r0.z, r0.w, r1.x, r1.y, r1.z, r1.w};
            float q[16]; float ss = 0.f;
#pragma unroll
            for (int w = 0; w < 8; ++w) { q[2 * w] = __uint_as_float(qw[w] << 16); q[2 * w + 1] = __uint_as_float(qw[w] & 0xffff0000u); ss += q[2 * w] * q[2 * w] + q[2 * w + 1] * q[2 * w + 1]; }
            ss = fq_sum(ss);
            const float rstd = 0.125f * rsq(ss * (1.0f / 64.0f) + EPS);
#pragma unroll
            for (int kk = 0; kk < 2; ++kk) { float z[8];
#pragma unroll
                for (int j = 0; j < 8; ++j) z[j] = q[8 * kk + j] * rstd * F.q_norm_w[32 * kk + 8 * fq + j];
                v4u o; o.x = cvtpk(z[0], z[1]); o.y = cvtpk(z[2], z[3]); o.z = cvtpk(z[4], z[5]); o.w = cvtpk(z[6], z[7]); qf[kk] = __builtin_bit_cast(bf16x8, o); }
        }
        f32x4 sc[12]; float mx = -INFINITY;
#pragma unroll
        for (int nt = 0; nt < 12; ++nt) { f32x4 acc = (f32x4){0.f, 0.f, 0.f, 0.f};
#pragma unroll
            for (int kk = 0; kk < 2; ++kk) { const bf16x8 kf = *(const LAS bf16x8*)(Ks + (16 * nt + fr) * 72 + 32 * kk + 8 * fq); acc = __builtin_amdgcn_mfma_f32_16x16x32_bf16(kf, qf[kk], acc, 0, 0, 0); }
#pragma unroll
            for (int i = 0; i < 4; ++i) { const int s = t0 - 128 + 16 * nt + 4 * fq + i, dist = tq0 + fr - s; const bool ok = (s >= 0) && (dist >= 0) && (dist < 128);
                const float v = ok ? acc[i] - slope * (float)dist : -INFINITY; acc[i] = v; mx = fmaxf(mx, v); }
            sc[nt] = acc; if (nt & 1) __builtin_amdgcn_sched_barrier(0); }
        mx = fmaxf(fq_max(mx), sink);
        float sum = 0.f;
#pragma unroll
        for (int nt = 0; nt < 12; ++nt)
#pragma unroll
            for (int i = 0; i < 4; ++i) { const float p = __expf(sc[nt][i] - mx); sc[nt][i] = p; sum += p; }
        sum = fq_sum(sum);
        const float den = sum + __expf(sink - mx);
        bf16x8 pf[6];
#pragma unroll
        for (int ks = 0; ks < 6; ++ks) pf[ks] = pack8(sc[2 * ks], sc[2 * ks + 1]);
        float rden[4];
#pragma unroll
        for (int i = 0; i < 4; ++i) rden[i] = __builtin_amdgcn_rcpf(__shfl(den, 4 * fq + i));
        bf16* op = F.MIX + (row0 + tq0 + 4 * fq) * D + 512 + hq * 64 + fr;
#pragma unroll 1
        for (int dt = 0; dt < 4; ++dt) { f32x4 oacc = (f32x4){0.f, 0.f, 0.f, 0.f};
#pragma unroll
            for (int ks = 0; ks < 6; ++ks) { const LAS bf16* vp = Vt + (16 * dt + fr) * 196 + 32 * ks + 4 * fq;
                const unsigned long long lo = *(const LAS unsigned long long*)vp, hi = *(const LAS unsigned long long*)(vp + 16);
                v4u vv; vv.x = (unsigned)lo; vv.y = (unsigned)(lo >> 32); vv.z = (unsigned)hi; vv.w = (unsigned)(hi >> 32);
                oacc = __builtin_amdgcn_mfma_f32_16x16x32_bf16(pf[ks], __builtin_bit_cast(bf16x8, vv), oacc, 0, 0, 0); }
#pragma unroll
            for (int i = 0; i < 4; ++i) op[(size_t)i * D + 16 * dt] = (bf16)f2bf(oacc[i] * rden[i]); }
    }
    __syncthreads();
}
__device__ __forceinline__ void p3a_prep(Frame& F) {
    LAS unsigned char* wl = F.lds + RING_OFF + F.wave * 19456;
    const int gw = F.vcu * NWAVES + F.wave, NGW = F.G * NWAVES;
    for (int ci = gw; ci < BATCH * 8 * (T / 64); ci += NGW) gdn_prep_chunk(F, ci, wl);
}
__device__ __forceinline__ void p3b_mixers(Frame& F) {
    const int bx = blockIdx.x;
    if (bx < 32) gdn_scan(F, bx);
    else for (int u = bx - 32; u < BATCH * 2 * (T / 64); u += F.G - 32) swa_unit(F, u, F.lds + RING_OFF);
}

struct Args { const float* in[18]; float* out; unsigned char* ws; };
__global__ void __launch_bounds__(NWAVES * 64, 2) hymba_fwd(Args args) {
    extern __shared__ __attribute__((aligned(16))) unsigned char lds[];
    Frame F;
    F.lds = (LAS unsigned char*)lds;
    F.MISC = (volatile LAS unsigned*)(F.lds + MISC_OFF);
    F.tid = threadIdx.x; F.lane = F.tid & 63; F.wave = __builtin_amdgcn_readfirstlane(F.tid >> 6);
    F.G = gridDim.x; { const int bx = blockIdx.x; F.vcu = (F.G % 8 == 0) ? (bx % 8) * (F.G / 8) + bx / 8 : bx; }
    unsigned char* ws = args.ws;
    F.ctl = (gu32*)(ws + WS_CTL);
    F.x = args.in[0]; F.c = args.in[1]; F.w_ada = args.in[2]; F.b_ada = args.in[3]; F.norm1_w = args.in[4]; F.w_in = args.in[5]; F.conv_w = args.in[6];
    F.a_log = args.in[7]; F.dt_bias = args.in[8]; F.gdn_norm_w = args.in[9]; F.q_norm_w = args.in[10]; F.k_norm_w = args.in[11]; F.sinks = args.in[12];
    F.w_out = args.in[13]; F.norm2_w = args.in[14]; F.w_gate = args.in[15]; F.w_up = args.in[16]; F.w_down = args.in[17]; F.out = args.out;
    F.modacc = (float*)(ws + WS_CTL) + CW_MODACC; F.modf = (float*)(ws + WS_MODF); F.wab = (float*)(ws + WS_WAB); F.gb = (float*)(ws + WS_GB); F.gm2 = (float*)(ws + WS_GM2); F.bgu = (float*)(ws + WS_BGU); F.rowss = (float*)(ws + WS_CTL) + CW_ROWSS;
    F.Win_t = (bf16*)(ws + WS_WIN); F.Wout_t = (bf16*)(ws + WS_WOUT); F.Wgu_t = (bf16*)(ws + WS_WGU); F.Wdn_t = (bf16*)(ws + WS_WDN);
    F.H = (bf16*)(ws + WS_H); F.PQ = (bf16*)(ws + WS_PQ); F.MIX = (bf16*)(ws + WS_MIX); F.CHKA = (bf16*)(ws + WS_CHKA); F.CHKU = (bf16*)(ws + WS_H); F.ORAW = (bf16*)(ws + WS_H + 16 * MiB); F.dec = (float*)(ws + WS_DEC);
    for (int u = F.tid; u < (LDS_BYTES - LDSCTL_OFF) / 4; u += NWAVES * 64) ((LAS unsigned*)(F.lds + LDSCTL_OFF))[u] = 0u;
    __syncthreads();
    XcdBarrier bar = xcd_barrier_post((unsigned*)(F.ctl + CW_BAR), F.MISC + 8);
#define GRID_BAR() xcd_barrier(bar)

    p0_prologue(F); GRID_BAR();
    norm_phase<1>(F); GRID_BAR();
    { pg8::Gemm g{F.H, F.Win_t, M, NP, D}; pg8::StaticOrder S; S.init(M, NP, F.G, (int)blockIdx.x);
      pg8::EpiBf16Plain E{F.PQ, NP, C_GZ / 256, C_SQ / 256};
      pg8::gemm_phase<pg8::EpiBf16Plain, pg8::StaticOrder, true, true>(F.lds + RING_OFF, g, S, E); }
    GRID_BAR();
    p3a_prep(F); GRID_BAR();
    p3b_mixers(F); GRID_BAR();
    { pg8::Gemm g{F.MIX, F.Wout_t, M, D, D}; pg8::StaticOrder S; S.init(M, D, F.G, (int)blockIdx.x);
      pg8::EpiGateRes E{F.x, F.out, D, F.modf + 2 * D, 6 * D, T};
      pg8::gemm_phase<pg8::EpiGateRes, pg8::StaticOrder, true, true>(F.lds + RING_OFF, g, S, E); }
    GRID_BAR();
    norm_phase<2>(F); GRID_BAR();
    { pg8::Gemm g{F.H, F.Wgu_t, M, NGU, D}; pg8::StaticOrder S; S.init(M, NGU, F.G, (int)blockIdx.x);
      pg8::EpiSwiGLU E{F.PQ, FF};
      pg8::gemm_phase<pg8::EpiSwiGLU, pg8::StaticOrder, true, true>(F.lds + RING_OFF, g, S, E); }
    GRID_BAR();
    { pg8::Gemm g{F.PQ, F.Wdn_t, M, D, FF}; pg8::StaticOrder S; S.init(M, D, F.G, (int)blockIdx.x);
      pg8::EpiGateRes E{F.out, F.out, D, F.modf + 5 * D, 6 * D, T};
      pg8::gemm_phase<pg8::EpiGateRes, pg8::StaticOrder, true, true>(F.lds + RING_OFF, g, S, E); }
#undef GRID_BAR
}

extern "C" void kernel_launch(void* const* d_in, const int* in_sizes, int n_in, void* d_out, int out_size, void* d_ws, size_t ws_size, hipStream_t stream) {
    static int grid = 0;
    if (grid == 0) {
        if (n_in != 18 || in_sizes[0] != M * D || out_size != M * D || ws_size < WS_END) { fprintf(stderr, "kernel_launch: unexpected shapes (n_in %d, in0 %d, out %d, ws %zu); nothing launched\n", n_in, n_in > 0 ? in_sizes[0] : -1, out_size, ws_size); grid = -1; return; }
        int dev = 0, cus = 0;
        if (hipGetDevice(&dev) != hipSuccess || hipDeviceGetAttribute(&cus, hipDeviceAttributeMultiprocessorCount, dev) != hipSuccess) { grid = -1; return; }
        if (hipFuncSetAttribute((const void*)hymba_fwd, hipFuncAttributeMaxDynamicSharedMemorySize, LDS_BYTES) != hipSuccess) { fprintf(stderr, "kernel_launch: hipFuncSetAttribute failed\n"); grid = -1; return; }
        (void)hipGetLastError();
        grid = cus;
    }
    if (grid < 0) return;
    if (hipMemsetAsync((char*)d_ws + WS_CTL, 0, CTL_ZERO_BYTES, stream) != hipSuccess) { fprintf(stderr, "kernel_launch: hipMemsetAsync failed\n"); return; }
    Args a{};
    for (int i = 0; i < 18; ++i) a.in[i] = (const float*)d_in[i];
    a.out = (float*)d_out; a.ws = (unsigned char*)d_ws;
    hipLaunchKernelGGL(hymba_fwd, dim3(grid), dim3(NWAVES * 64), LDS_BYTES, stream, a);
    const hipError_t le = hipPeekAtLastError();
    if (le != hipSuccess) fprintf(stderr, "kernel_launch: launch failed: %s\n", hipGetErrorName(le));
}
```

```cpp
#include <hip/hip_runtime.h>
#include <cstdio>
#include <cstdint>
#include <cmath>
namespace pg8 {
#define PG8_LAS __attribute__((address_space(3)))
typedef unsigned short bf16_t;
typedef short bf16x8 __attribute__((ext_vector_type(8)));
typedef float f32x4 __attribute__((ext_vector_type(4)));
typedef unsigned u32x4 __attribute__((ext_vector_type(4)));
constexpr int BM = 256, BK = 64, HALF = 128, HTB = HALF * BK * 2  , STAGE_BYTES = 8 * HTB, NXCD = 8, WGM = 8;

__host__ __device__ __forceinline__ int lds_byte(int r, int c) { const int st = (r >> 4) * 2 + (c >> 5), rr = r & 15, cc = c & 31, ob = rr * 64 + cc * 2; return st * 1024 + (ob ^ (((ob >> 9) & 1) << 5)); }
__host__ __device__ __forceinline__ void stage_rc(int b, int& R, int& C) { const int st = b / 1024, sb = b % 1024, swz = sb ^ (((sb >> 9) & 1) << 5); R = (st >> 1) * 16 + swz / 64; C = (st & 1) * 32 + (swz % 64) / 2; }
__host__ __device__ __forceinline__ int perm32(int rho) { const int n = rho >> 4, i = rho & 15; return 8 * (i >> 2) + 4 * n + (i & 3); }

struct Unit { int pm, pn; };
struct Gemm { const bf16_t* A; const bf16_t* Bt; int M, N, K; };

struct StaticOrder {
    int nM, nN, nwg, G, c;
    __host__ __device__ void init(int M, int N, int G_, int c_) { nM = M / BM; nN = N / BM; nwg = nM * nN; G = G_; c = c_; }
    __host__ __device__ bool next(int i, Unit& u) const {
        const long L = (long)i * G + c; if (L >= nwg) return false;
        int wgid = (int)L; { const int q = nwg / NXCD, r = nwg % NXCD, xcd = wgid % NXCD, off = wgid / NXCD; wgid = (xcd < r ? xcd * (q + 1) : r * (q + 1) + (xcd - r) * q) + off; }
        const int nig = WGM * nN, gid = wgid / nig, fm = gid * WGM, gsz = (nM - fm) < WGM ? (nM - fm) : WGM;
        u.pm = fm + ((wgid % nig) % gsz); u.pn = (wgid % nig) / gsz; return true;
    }
    __device__ __forceinline__ void a_ready(const Unit&) const {}
    __device__ __forceinline__ void done(const Unit&) const {}
};

__device__ __forceinline__ unsigned cvt_pk_bf16(float lo, float hi) { unsigned r; asm volatile("v_cvt_pk_bf16_f32 %0, %1, %2" : "=v"(r) : "v"(lo), "v"(hi)); return r; }
__device__ __forceinline__ float silu_f(float x) { return x * __builtin_amdgcn_rcpf(1.0f + __expf(-x)); }

struct EpiBf16Plain {
    static constexpr bool PERM = true, AFTER_DRAIN = false;
    bf16_t* O; int ldc; int silu_lo, silu_hi;
    __device__ __forceinline__ void operator()(const f32x4 (&acc)[2][2][4][2], const Unit& u, int wr, int wc, int fr, int fq) const {
        const int row0 = u.pm * BM + wr * 64 + fr, col0 = u.pn * BM + wc * 32 + 8 * fq;
        const bool act = (u.pn >= silu_lo) && (u.pn < silu_hi);
#pragma unroll
        for (int ai = 0; ai < 2; ++ai)
#pragma unroll
            for (int m = 0; m < 4; ++m) { bf16_t* rowp = O + (size_t)(row0 + ai * HALF + m * 16) * ldc + col0;
#pragma unroll
                for (int bj = 0; bj < 2; ++bj) { f32x4 v0 = acc[ai][bj][m][0], v1 = acc[ai][bj][m][1];
                    if (act) {
#pragma unroll
                        for (int i = 0; i < 4; ++i) { v0[i] = silu_f(v0[i]); v1[i] = silu_f(v1[i]); } }
                    u32x4 w; w.x = cvt_pk_bf16(v0[0], v0[1]); w.y = cvt_pk_bf16(v0[2], v0[3]); w.z = cvt_pk_bf16(v1[0], v1[1]); w.w = cvt_pk_bf16(v1[2], v1[3]);
                    *(u32x4*)(rowp + bj * HALF) = w; } }
    }
};
struct EpiSwiGLU {
    static constexpr bool PERM = true, AFTER_DRAIN = false;
    bf16_t* O; int ldc;
    __device__ __forceinline__ void operator()(const f32x4 (&acc)[2][2][4][2], const Unit& u, int wr, int wc, int fr, int fq) const {
        const int row0 = u.pm * BM + wr * 64 + fr, col0 = u.pn * HALF + wc * 32 + 8 * fq;
#pragma unroll
        for (int ai = 0; ai < 2; ++ai)
#pragma unroll
            for (int m = 0; m < 4; ++m) { bf16_t* rowp = O + (size_t)(row0 + ai * HALF + m * 16) * ldc + col0;
                const f32x4 g0 = acc[ai][0][m][0], g1 = acc[ai][0][m][1], u0 = acc[ai][1][m][0], u1 = acc[ai][1][m][1];
                float a[8];
#pragma unroll
                for (int i = 0; i < 4; ++i) { a[i] = silu_f(g0[i]) * u0[i]; a[4 + i] = silu_f(g1[i]) * u1[i]; }
                u32x4 w; w.x = cvt_pk_bf16(a[0], a[1]); w.y = cvt_pk_bf16(a[2], a[3]); w.z = cvt_pk_bf16(a[4], a[5]); w.w = cvt_pk_bf16(a[6], a[7]);
                *(u32x4*)rowp = w; }
    }
};
struct EpiGateRes {
    static constexpr bool PERM = false, AFTER_DRAIN = false;
    const float* base; float* out; int ldc; const float* gate; int gstride; int rows_per_batch;
    __device__ __forceinline__ void operator()(const f32x4 (&acc)[2][2][4][2], const Unit& u, int wr, int wc, int fr, int fq) const {
        const int row0 = u.pm * BM + wr * 64 + fr, col0 = u.pn * BM + wc * 32 + 4 * fq;
        const float* gp = gate + (size_t)((u.pm * BM) / rows_per_batch) * gstride + col0;
        f32x4 gv[2][2];
#pragma unroll
        for (int bj = 0; bj < 2; ++bj)
#pragma unroll
            for (int n = 0; n < 2; ++n) gv[bj][n] = *(const f32x4*)(gp + bj * HALF + n * 16);
#pragma unroll
        for (int ai = 0; ai < 2; ++ai)
#pragma unroll
            for (int m = 0; m < 4; ++m) { const size_t off = (size_t)(row0 + ai * HALF + m * 16) * ldc + col0;
#pragma unroll
                for (int bj = 0; bj < 2; ++bj)
#pragma unroll
                    for (int n = 0; n < 2; ++n) { const f32x4 bs = *(const f32x4*)(base + off + bj * HALF + n * 16);
                        *(f32x4*)(out + off + bj * HALF + n * 16) = bs + gv[bj][n] * acc[ai][bj][m][n]; } }
    }
};
struct PanelRms {
    unsigned* xbuf;
    unsigned* cnt;
    unsigned* tmo;
    int ntn; unsigned code;
    __device__ __forceinline__ bool run(const f32x4 (&v)[2][2][4][2], const Unit& u, int wr, int wc, int fr, int fq, PG8_LAS unsigned char* lds, int wid, int lane) const {
        PG8_LAS float* P = (PG8_LAS float*)lds;
        PG8_LAS float* S = (PG8_LAS float*)(lds + 4096);
        PG8_LAS unsigned* flag = (PG8_LAS unsigned*)(lds + 4096 + 1024);
#pragma unroll
        for (int ai = 0; ai < 2; ++ai)
#pragma unroll
            for (int m = 0; m < 4; ++m) { float s = 0.f;
#pragma unroll
                for (int bj = 0; bj < 2; ++bj)
#pragma unroll
                    for (int n = 0; n < 2; ++n) { const f32x4 x = v[ai][bj][m][n]; s += (x[0] * x[0] + x[1] * x[1]) + (x[2] * x[2] + x[3] * x[3]); }
                s += __shfl_xor(s, 16); s += __shfl_xor(s, 32);
                if (fq == 0) P[(ai * HALF + wr * 64 + m * 16 + fr) * 4 + wc] = s; }
        asm volatile("s_waitcnt lgkmcnt(0)" ::: "memory"); __builtin_amdgcn_s_barrier(); asm volatile("" ::: "memory");
        const int row = wid * 32 + (lane & 31);
        if (lane < 32) { const float t = (P[row * 4 + 0] + P[row * 4 + 1]) + (P[row * 4 + 2] + P[row * 4 + 3]);
            __hip_atomic_store(xbuf + ((size_t)(u.pm * BM + row) * 4 + u.pn), __float_as_uint(t), __ATOMIC_RELAXED, __HIP_MEMORY_SCOPE_AGENT); }
        asm volatile("s_waitcnt vmcnt(0)" ::: "memory");
        if (lane == 0) __hip_atomic_fetch_add(cnt + 64 * u.pm, 1u, __ATOMIC_RELAXED, __HIP_MEMORY_SCOPE_AGENT);
        if (wid == 0) {
            bool dead = false; const unsigned long long t0 = __builtin_amdgcn_s_memrealtime(); const unsigned want = 8u * (unsigned)ntn;
            for (;;) {
                if ((unsigned)__builtin_amdgcn_readfirstlane(__hip_atomic_load(cnt + 64 * u.pm, __ATOMIC_RELAXED, __HIP_MEMORY_SCOPE_AGENT)) >= want) break;
                if (__builtin_amdgcn_s_memrealtime() - t0 > 2000000ull) {
                    if (lane == 0) { unsigned expect = 0u; __hip_atomic_compare_exchange_strong(tmo + 1, &expect, code | (unsigned)(u.pm & 0xff), __ATOMIC_RELAXED, __ATOMIC_RELAXED, __HIP_MEMORY_SCOPE_AGENT);
                                     __hip_atomic_store(tmo, 1u, __ATOMIC_RELAXED, __HIP_MEMORY_SCOPE_AGENT); }
                    dead = true; break; }
                __builtin_amdgcn_s_sleep(2);
            }
            __builtin_amdgcn_fence(__ATOMIC_ACQUIRE, "agent");
            if (lane == 0) flag[0] = dead ? 1u : 0u;
        }
        asm volatile("s_waitcnt vmcnt(0) lgkmcnt(0)" ::: "memory"); __builtin_amdgcn_s_barrier(); asm volatile("" ::: "memory");
        const bool bad = flag[0] != 0u;
        if (lane < 32) { const unsigned* slot = xbuf + (size_t)(u.pm * BM + row) * 4; float t = 0.f;
#pragma unroll
            for (int k = 0; k < 4; ++k) if (k < ntn) t += __uint_as_float(__hip_atomic_load(slot + k, __ATOMIC_RELAXED, __HIP_MEMORY_SCOPE_AGENT));
            S[row] = t; }
        asm volatile("s_waitcnt lgkmcnt(0)" ::: "memory"); __builtin_amdgcn_s_barrier(); asm volatile("" ::: "memory");
        return bad;
    }
};
struct EpiGateResRms {
    static constexpr bool PERM = false, AFTER_DRAIN = true;
    const float* base; float* out; int ldc; const float* gate; const float* gm; const float* sh; int gstride, mstride; int rows_per_batch; bf16_t* xg; PanelRms st; float inv_n, eps;
    __device__ __forceinline__ void fused(f32x4 (&acc)[2][2][4][2], const Unit& u, int wr, int wc, int fr, int fq, PG8_LAS unsigned char* lds, int wid, int lane) const {
        const PG8_LAS float* S = (const PG8_LAS float*)(lds + 4096);
        const int row0 = u.pm * BM + wr * 64 + fr, col0 = u.pn * BM + wc * 32 + 4 * fq, b = (u.pm * BM) / rows_per_batch;
        {
            const float* gp = gate + (size_t)b * gstride + col0;
#pragma unroll
            for (int bj = 0; bj < 2; ++bj)
#pragma unroll
                for (int n = 0; n < 2; ++n) { const f32x4 gv = *(const f32x4*)(gp + bj * HALF + n * 16);
#pragma unroll
                    for (int ai = 0; ai < 2; ++ai)
#pragma unroll
                        for (int m = 0; m < 4; ++m) { const size_t off = (size_t)(row0 + ai * HALF + m * 16) * ldc + col0 + bj * HALF + n * 16;
                            const f32x4 o = *(const f32x4*)(base + off) + gv * acc[ai][bj][m][n]; acc[ai][bj][m][n] = o; *(f32x4*)(out + off) = o; }
                    asm volatile("" ::: "memory"); }
        }
        const bool bad = st.run(acc, u, wr, wc, fr, fq, lds, wid, lane);
        const float* mp = gm + (size_t)b * mstride + col0; const float* sp = sh + (size_t)b * gstride + col0;
#pragma unroll
        for (int bj = 0; bj < 2; ++bj)
#pragma unroll
            for (int n = 0; n < 2; ++n) { const f32x4 mv = *(const f32x4*)(mp + bj * HALF + n * 16), sv = *(const f32x4*)(sp + bj * HALF + n * 16);
#pragma unroll
                for (int ai = 0; ai < 2; ++ai)
#pragma unroll
                    for (int m = 0; m < 4; ++m) { const int r = ai * HALF + wr * 64 + m * 16 + fr; const float rs = __builtin_amdgcn_rsqf(S[r] * inv_n + eps);
                        const f32x4 h = acc[ai][bj][m][n] * rs * mv + sv;
                        unsigned long long w = (unsigned long long)cvt_pk_bf16(h[0], h[1]) | ((unsigned long long)cvt_pk_bf16(h[2], h[3]) << 32);
                        if (bad) w = 0x7fc07fc07fc07fc0ull;
                        *(unsigned long long*)(xg + (size_t)(u.pm * BM + r) * ldc + col0 + bj * HALF + n * 16) = w; } }
    }
};

template <class Epi, class Sched, bool ALIGN_EPI = false, bool SP2 = false>
__device__ __forceinline__ void gemm_phase(PG8_LAS unsigned char* lds, const Gemm g, const Sched& S, const Epi& E) {
    const int tid = threadIdx.x, wid = __builtin_amdgcn_readfirstlane(tid >> 6), lane = tid & 63, wr = wid >> 2, wc = wid & 3, fr = lane & 15, fq = lane >> 4;
    const int K = g.K, nt = K / BK;
    unsigned voffA[2], voffB[2];
#pragma unroll
    for (int i = 0; i < 2; ++i) { int R, C; stage_rc(tid * 16 + i * 8192, R, C); const int Rb = Epi::PERM ? ((R & ~31) + perm32(R & 31)) : R;
        voffA[i] = (unsigned)(R * K + C) * 2u; voffB[i] = (unsigned)(Rb * K + C) * 2u; }
    const size_t kstep = (size_t)(BK * 2);
    const size_t hstep = (size_t)HALF * K * 2;
    const size_t tstep = 2 * hstep;
    const unsigned ldsw = (unsigned)wid * 1024u;
    const int aoff = lds_byte(wr * 64 + fr, fq * 8), boff = lds_byte(wc * 32 + fr, fq * 8);
#define PG8_SA(b, h) (((b) * 2 + (h)) * HTB)
#define PG8_SB(b, h) ((4 + (b) * 2 + (h)) * HTB)
#define PG8_STAGE(bufoff, gbase, voff) do { _Pragma("unroll") for (int _i = 0; _i < 2; ++_i) \
        __builtin_amdgcn_global_load_lds((const unsigned*)((const char*)(gbase) + (voff)[_i]), (PG8_LAS unsigned*)(lds + (bufoff) + ldsw + _i * 8192), 16, 0, 0); } while (0)
#define PG8_LDA(dst, b, h) do { _Pragma("unroll") for (int m = 0; m < 4; ++m) _Pragma("unroll") for (int k = 0; k < 2; ++k) dst[m][k] = *(const PG8_LAS bf16x8*)(lds + PG8_SA(b, h) + aoff + m * 2048 + k * 1024); } while (0)
#define PG8_LDB(dst, b, h) do { _Pragma("unroll") for (int n = 0; n < 2; ++n) _Pragma("unroll") for (int k = 0; k < 2; ++k) dst[n][k] = *(const PG8_LAS bf16x8*)(lds + PG8_SB(b, h) + boff + n * 2048 + k * 1024); } while (0)
#define PG8_MMA(ai, bj, At, Bt) do { __builtin_amdgcn_s_setprio(1); _Pragma("unroll") for (int m = 0; m < 4; ++m) _Pragma("unroll") for (int n = 0; n < 2; ++n) _Pragma("unroll") for (int k = 0; k < 2; ++k) \
        acc[ai][bj][m][n] = __builtin_amdgcn_mfma_f32_16x16x32_bf16(Bt[n][k], At[m][k], acc[ai][bj][m][n], 0, 0, 0); __builtin_amdgcn_s_setprio(0); } while (0)
#define PG8_WAIT_V(n) asm volatile("s_waitcnt vmcnt(" #n ")" ::: "memory")
#define PG8_WAIT_L(n) asm volatile("s_waitcnt lgkmcnt(" #n ")" ::: "memory")
#define PG8_BAR __builtin_amdgcn_s_barrier()
#define PG8_SCHED __builtin_amdgcn_sched_barrier(0)
    Unit cur, nxt; int ui = 0;
    if (!S.next(0, cur)) return;
    f32x4 acc[2][2][4][2];
#pragma unroll
    for (int a = 0; a < 2; ++a)
#pragma unroll
        for (int b = 0; b < 2; ++b)
#pragma unroll
            for (int m = 0; m < 4; ++m)
#pragma unroll
                for (int n = 0; n < 2; ++n) acc[a][b][m][n] = (f32x4){0.f, 0.f, 0.f, 0.f};
    bf16x8 At[4][2], B0[2][2], B1[2][2];
    const char* cA = (const char*)g.A + (size_t)cur.pm * tstep; const char* cB = (const char*)g.Bt + (size_t)cur.pn * tstep;
    S.a_ready(cur);
    if constexpr (SP2) {
        PG8_STAGE(PG8_SB(0, 0), cB, voffB); PG8_STAGE(PG8_SB(0, 1), cB + hstep, voffB); PG8_STAGE(PG8_SA(0, 0), cA, voffA); PG8_STAGE(PG8_SA(0, 1), cA + hstep, voffA);
        if (wr == 1) PG8_BAR;
        PG8_WAIT_V(2); PG8_BAR;
        PG8_STAGE(PG8_SB(1, 0), cB + kstep, voffB); PG8_STAGE(PG8_SA(1, 0), cA + kstep, voffA); PG8_STAGE(PG8_SB(1, 1), cB + hstep + kstep, voffB);
        PG8_WAIT_V(6); PG8_BAR;
    } else {
        PG8_STAGE(PG8_SB(0, 0), cB, voffB); PG8_STAGE(PG8_SA(0, 0), cA, voffA); PG8_STAGE(PG8_SB(0, 1), cB + hstep, voffB); PG8_STAGE(PG8_SA(0, 1), cA + hstep, voffA);
        if (wr == 1) PG8_BAR;
        PG8_WAIT_V(4); PG8_BAR;
        PG8_STAGE(PG8_SB(1, 0), cB + kstep, voffB); PG8_STAGE(PG8_SA(1, 0), cA + kstep, voffA); PG8_STAGE(PG8_SB(1, 1), cB + hstep + kstep, voffB);
        PG8_WAIT_V(6); PG8_BAR;
    }
    for (;;) {
        const bool has_next = S.next(ui + 1, nxt);
        const char* nA = has_next ? (const char*)g.A + (size_t)nxt.pm * tstep : cA; const char* nB = has_next ? (const char*)g.Bt + (size_t)nxt.pn * tstep : cB;
        for (int t = 0; t < nt; t += 2) {
            const bool last = (t == nt - 2);
            const char* a1 = cA + (size_t)(t + 1) * kstep;
            const char* a2 = last ? nA : cA + (size_t)(t + 2) * kstep; const char* b2 = last ? nB : cB + (size_t)(t + 2) * kstep;
            const char* a3 = a2 + kstep; const char* b3 = b2 + kstep;
            if (last && has_next) S.a_ready(nxt);
            if constexpr (SP2) {
            PG8_LDB(B0, 0, 0); PG8_LDB(B1, 0, 1); PG8_SCHED; PG8_LDA(At, 0, 0); PG8_STAGE(PG8_SA(1, 1), a1 + hstep, voffA);
            PG8_WAIT_V(8); PG8_WAIT_L(0); PG8_BAR; PG8_MMA(0, 0, At, B0); PG8_MMA(0, 1, At, B1); PG8_BAR; PG8_SCHED;
            PG8_LDA(At, 0, 1); PG8_STAGE(PG8_SB(0, 0), b2, voffB); PG8_STAGE(PG8_SB(0, 1), b2 + hstep, voffB); PG8_STAGE(PG8_SA(0, 0), a2, voffA);
            PG8_WAIT_V(8); PG8_WAIT_L(0); PG8_BAR; PG8_MMA(1, 0, At, B0); PG8_MMA(1, 1, At, B1); PG8_BAR; PG8_SCHED;
            PG8_LDB(B0, 1, 0); PG8_LDB(B1, 1, 1); PG8_SCHED; PG8_LDA(At, 1, 0); PG8_STAGE(PG8_SA(0, 1), a2 + hstep, voffA);
            PG8_WAIT_V(8); PG8_WAIT_L(0); PG8_BAR; PG8_MMA(0, 0, At, B0); PG8_MMA(0, 1, At, B1); PG8_BAR; PG8_SCHED;
            PG8_LDA(At, 1, 1); PG8_STAGE(PG8_SB(1, 0), b3, voffB); PG8_STAGE(PG8_SB(1, 1), b3 + hstep, voffB); PG8_STAGE(PG8_SA(1, 0), a3, voffA);
            PG8_WAIT_V(8); PG8_WAIT_L(0); PG8_BAR; PG8_MMA(1, 0, At, B0); PG8_MMA(1, 1, At, B1); PG8_BAR; PG8_SCHED;
            } else {
            PG8_LDB(B0, 0, 0); PG8_SCHED; PG8_LDA(At, 0, 0); PG8_STAGE(PG8_SA(1, 1), a1 + hstep, voffA);
            PG8_WAIT_L(8); PG8_BAR; PG8_WAIT_L(0); PG8_MMA(0, 0, At, B0); PG8_BAR; PG8_SCHED;
            PG8_LDB(B1, 0, 1); PG8_STAGE(PG8_SB(0, 0), b2, voffB);
            PG8_BAR; PG8_WAIT_L(0); PG8_MMA(0, 1, At, B1); PG8_BAR;
            PG8_LDA(At, 0, 1); PG8_STAGE(PG8_SA(0, 0), a2, voffA);
            PG8_BAR; PG8_WAIT_L(0); PG8_MMA(1, 0, At, B0); PG8_BAR; PG8_SCHED;
            PG8_STAGE(PG8_SB(0, 1), b2 + hstep, voffB);
            PG8_WAIT_V(6); PG8_BAR; PG8_MMA(1, 1, At, B1); PG8_BAR;
            PG8_LDB(B0, 1, 0); PG8_SCHED; PG8_LDA(At, 1, 0); PG8_STAGE(PG8_SA(0, 1), a2 + hstep, voffA);
            PG8_WAIT_L(8); PG8_BAR; PG8_WAIT_L(0); PG8_MMA(0, 0, At, B0); PG8_BAR; PG8_SCHED;
            PG8_LDB(B1, 1, 1); PG8_STAGE(PG8_SB(1, 0), b3, voffB);
            PG8_BAR; PG8_WAIT_L(0); PG8_MMA(0, 1, At, B1); PG8_BAR;
            PG8_LDA(At, 1, 1); PG8_STAGE(PG8_SA(1, 0), a3, voffA);
            PG8_BAR; PG8_WAIT_L(0); PG8_MMA(1, 0, At, B0); PG8_BAR; PG8_SCHED;
            PG8_STAGE(PG8_SB(1, 1), b3 + hstep, voffB);
            PG8_WAIT_V(6); PG8_BAR; PG8_MMA(1, 1, At, B1); PG8_BAR;
            }
        }
        if constexpr (ALIGN_EPI) { if (wr == 0) PG8_BAR; }
        if constexpr (!Epi::AFTER_DRAIN) { E(acc, cur, wr, wc, fr, fq); S.done(cur); }
        if (!has_next) break;
#pragma unroll
        for (int a = 0; a < 2; ++a)
#pragma unroll
            for (int b = 0; b < 2; ++b)
#pragma unroll
                for (int m = 0; m < 4; ++m)
#pragma unroll
                    for (int n = 0; n < 2; ++n) acc[a][b][m][n] = (f32x4){0.f, 0.f, 0.f, 0.f};
        cur = nxt; cA = nA; cB = nB; ++ui;
        if constexpr (ALIGN_EPI) { if (wr == 1) PG8_BAR; }
    }
    PG8_WAIT_V(0);
    if constexpr (!ALIGN_EPI) { if (wr == 0) PG8_BAR; }
    PG8_BAR;
    if constexpr (Epi::AFTER_DRAIN) { E.fused(acc, cur, wr, wc, fr, fq, lds, wid, lane); S.done(cur); }
#undef PG8_SA
#undef PG8_SB
#undef PG8_STAGE
#undef PG8_LDA
#undef PG8_LDB
#undef PG8_MMA
#undef PG8_WAIT_V
#undef PG8_WAIT_L
#undef PG8_BAR
#undef PG8_SCHED
}
}
constexpr int NWAVES = 8;
constexpr int BATCH = 4, T = 4096, D = 1024, M = BATCH * T;
constexpr int PROJ_W = 2832, NP = 2816, FF = 2816, NGU = 2 * FF, HD = 64;
constexpr int C_GQ = 0, C_GK = 512, C_GV = 1024, C_GZ = 1536, C_SQ = 2048, C_SK = 2560, C_SV = 2688;
constexpr float EPS = 1e-6f;
constexpr size_t MiB = 1u << 20;
constexpr size_t WS_CTL = 0, CTL_ZERO_BYTES = 256 * 1024;
constexpr size_t WS_MODF = 1 * MiB;
constexpr size_t WS_WAB = 1 * MiB + 256 * 1024;
constexpr size_t WS_GB = 2 * MiB;
constexpr size_t WS_WIN = 4 * MiB, WS_WOUT = 10 * MiB, WS_WGU = 12 * MiB, WS_WDN = 24 * MiB;
constexpr size_t WS_H = 32 * MiB;
constexpr size_t WS_PQ = 64 * MiB;
constexpr size_t WS_MIX = 160 * MiB;
constexpr size_t WS_CHKA = 192 * MiB;
constexpr size_t WS_DEC = 1 * MiB + 384 * 1024;
constexpr size_t WS_XBUF = 1 * MiB + 600 * 1024;
constexpr size_t WS_GM2 = 1 * MiB + 400 * 1024;
constexpr size_t WS_BGU = 1 * MiB + 448 * 1024;
constexpr size_t WS_END = 256 * MiB;
constexpr int CW_BAR = 4096;
constexpr int CW_PANEL = 49152;
constexpr int CW_ROWSS = 65536;
constexpr int CW_MODACC = 16384;
constexpr int RING_OFF = 0, RING_BYTES = 131072;
constexpr int LDS_BYTES = 163840;
constexpr int LDSCTL_OFF = LDS_BYTES - 1024, MISC_OFF = LDSCTL_OFF + 320;
#define GAS __attribute__((address_space(1)))
#define LAS __attribute__((address_space(3)))
typedef unsigned short bf16;
typedef unsigned v4u __attribute__((ext_vector_type(4)));
typedef float f32x4 __attribute__((ext_vector_type(4)));
typedef short bf16x8 __attribute__((ext_vector_type(8)));
typedef GAS unsigned gu32;
typedef GAS unsigned long long gu64;
#define RLX_AGENT __ATOMIC_RELAXED, __HIP_MEMORY_SCOPE_AGENT
#define LDS_WAIT() asm volatile("s_waitcnt lgkmcnt(0)" ::: "memory")
#define VM_WAIT() asm volatile("s_waitcnt vmcnt(0)" ::: "memory")
__device__ __forceinline__ unsigned long long rt() { return __builtin_amdgcn_s_memrealtime(); }
__device__ __forceinline__ unsigned f2bf(float f) { unsigned u = __builtin_bit_cast(unsigned, f); return (u + 0x7fffu + ((u >> 16) & 1u)) >> 16; }
__device__ __forceinline__ unsigned pk2(float lo, float hi) { return f2bf(lo) | (f2bf(hi) << 16); }

#define XB_TMO      128
#define XB_XCNT(j)  (256  + 64 * (j))
#define XB_XSUB(j)  (1280 + 64 * (j))
#define XB_XGEN(j)  (2304 + 64 * (j))
#define XB_TOP      3328
#define XB_TOPGEN   3392
#define XCD_BAR_WORDS 3456
#define XB_SPIN_CAP (1u << 22)

__device__ __forceinline__ unsigned xb_ld(unsigned* p)              { return __hip_atomic_load(p, __ATOMIC_RELAXED, __HIP_MEMORY_SCOPE_AGENT); }
__device__ __forceinline__ unsigned xb_add(unsigned* p, unsigned v) { return __hip_atomic_fetch_add(p, v, __ATOMIC_RELAXED, __HIP_MEMORY_SCOPE_AGENT); }
__device__ __forceinline__ unsigned xb_xcc_id() { return (unsigned)__builtin_amdgcn_s_getreg((3 << 11) | 20) & 0xFu; }
#define XB_SPIN(cond, bar) do { unsigned _sp = 0; while (cond) { __builtin_amdgcn_s_sleep(1); \
    if ((++_sp & 255u) == 0u) { if (xb_ld(&(bar)[XB_TMO])) break; if (_sp > XB_SPIN_CAP) { atomicAdd(&(bar)[XB_TMO], 1u); break; } } } } while (0)

struct XcdBarrier {
    unsigned* bar; unsigned x;
    volatile LAS unsigned* st;
};

__device__ __forceinline__ XcdBarrier xcd_barrier_post(unsigned* bar, volatile LAS unsigned* st) {
    XcdBarrier b; b.bar = bar; b.x = xb_xcc_id(); b.st = st;
    if (threadIdx.x == 0) (void)xb_add(&bar[XB_XCNT(b.x)], 1u);
    return b;
}
__device__ __forceinline__ void xcd_barrier_complete(unsigned* bar, unsigned x, unsigned& nloc, unsigned& nx) {
    const unsigned G = gridDim.x * gridDim.y * gridDim.z;
    unsigned sum, cnt, mine, sp = 0u;
    for (;;) {
        sum = 0u; cnt = 0u; mine = 0u;
#pragma unroll
        for (unsigned j = 0; j < 16; ++j) { const unsigned c = xb_ld(&bar[XB_XCNT(j)]); sum += c; cnt += (c > 0u) ? 1u : 0u; mine = (j == x) ? c : mine; }
        if (sum == G) break;
        __builtin_amdgcn_s_sleep(1);
        if ((++sp & 255u) == 0u) { if (xb_ld(&bar[XB_TMO])) break; if (sp > XB_SPIN_CAP) { atomicAdd(&bar[XB_TMO], 1u); break; } }
    }
    nloc = mine > 0u ? mine : 1u; nx = cnt > 0u ? cnt : 1u;
}

__device__ __forceinline__ void xcd_barrier(const XcdBarrier& b) {
    asm volatile("s_waitcnt vmcnt(0)" ::: "memory");
    __syncthreads();
    if (threadIdx.x == 0) {
        unsigned* bar = b.bar;
        __builtin_amdgcn_s_waitcnt(0);
        unsigned nloc = b.st[0], nx = b.st[1];
        if (nloc == 0u) { xcd_barrier_complete(bar, b.x, nloc, nx); b.st[0] = nloc; b.st[1] = nx; }
        const unsigned old = xb_add(&bar[XB_XSUB(b.x)], 1u);
        const unsigned gen = old / nloc;
        if (old + 1u == (gen + 1u) * nloc) {
            __builtin_amdgcn_fence(__ATOMIC_RELEASE, "agent");
            asm volatile("s_waitcnt vmcnt(0)" ::: "memory");
            const unsigned og = xb_add(&bar[XB_TOP], 1u);
            const unsigned tg = og / nx;
            if (og + 1u == (tg + 1u) * nx) xb_add(&bar[XB_TOPGEN], 1u);
            else XB_SPIN(xb_ld(&bar[XB_TOPGEN]) == tg, bar);
            __builtin_amdgcn_fence(__ATOMIC_ACQUIRE, "agent");
            xb_add(&bar[XB_XGEN(b.x)], 1u);
            asm volatile("s_waitcnt vmcnt(0)" ::: "memory");
        } else {
            XB_SPIN(xb_ld(&bar[XB_XGEN(b.x)]) == gen, bar);
            __builtin_amdgcn_fence(__ATOMIC_ACQUIRE, "agent");
            asm volatile("s_waitcnt vmcnt(0)" ::: "memory");
        }
    }
    __syncthreads();
}
struct Frame {
    LAS unsigned char* lds;
    volatile LAS unsigned* MISC;
    gu32* ctl;
    int tid, lane, wave;
    int vcu, G;
    const float *x, *c, *w_ada, *b_ada, *norm1_w, *w_in, *conv_w, *a_log, *dt_bias, *gdn_norm_w, *q_norm_w, *k_norm_w, *sinks, *w_out, *norm2_w, *w_gate, *w_up, *w_down;
    float* out;
    float *modacc, *modf, *wab, *gb, *gm2, *bgu, *rowss, *dec;
    bf16 *Win_t, *Wout_t, *Wgu_t, *Wdn_t, *H, *PQ, *MIX, *CHKA, *CHKU, *CHKT, *ORAW;
};
template <int CTRL, int ROWMASK, bool BC>
__device__ __forceinline__ float dpp_mov(float v) { return __int_as_float(__builtin_amdgcn_update_dpp(0, __float_as_int(v), CTRL, ROWMASK, 0xF, BC)); }
__device__ __forceinline__ float sum8(float v) { v += dpp_mov<0xB1, 0xF, true>(v); v += dpp_mov<0x4E, 0xF, true>(v); v += dpp_mov<0x141, 0xF, true>(v); return v; }
__device__ __forceinline__ float wave_sum(float v) {
    v = sum8(v); v += dpp_mov<0x140, 0xF, true>(v);
    v += dpp_mov<0x142, 0xA, false>(v); v += dpp_mov<0x143, 0xC, false>(v);
    return __int_as_float(__builtin_amdgcn_readlane(__float_as_int(v), 63));
}
__device__ __forceinline__ float fq_sum(float v) {
    auto r = __builtin_amdgcn_permlane16_swap(__float_as_uint(v), __float_as_uint(v), false, false); v = __uint_as_float(r[0]) + __uint_as_float(r[1]);
    auto s = __builtin_amdgcn_permlane32_swap(__float_as_uint(v), __float_as_uint(v), false, false); return __uint_as_float(s[0]) + __uint_as_float(s[1]);
}
__device__ __forceinline__ float fq_max(float v) {
    auto r = __builtin_amdgcn_permlane16_swap(__float_as_uint(v), __float_as_uint(v), false, false); v = fmaxf(__uint_as_float(r[0]), __uint_as_float(r[1]));
    auto s = __builtin_amdgcn_permlane32_swap(__float_as_uint(v), __float_as_uint(v), false, false); return fmaxf(__uint_as_float(s[0]), __uint_as_float(s[1]));
}
typedef float f32x2_t __attribute__((ext_vector_type(2))); typedef __bf16 bf16x2_t __attribute__((ext_vector_type(2)));
__device__ __forceinline__ unsigned cvtpk(float lo, float hi) { f32x2_t v = {lo, hi}; bf16x2_t b = __builtin_convertvector(v, bf16x2_t); return __builtin_bit_cast(unsigned, b); }
__device__ __forceinline__ float bf2f(bf16 h) { return __uint_as_float((unsigned)h << 16); }
__device__ __forceinline__ float ld_f32_coh(const float* p) { return __uint_as_float(__hip_atomic_load((const unsigned*)p, RLX_AGENT)); }
__device__ __forceinline__ float silu(float x) { return x * __builtin_amdgcn_rcpf(1.0f + __expf(-x)); }
__device__ __forceinline__ float rsq(float x) { return __builtin_amdgcn_rsqf(x); }

__device__ __forceinline__ void tr_item64(const float* W, int ldw, int src_col, bf16* WT, int K, int dst_row, int k0, LAS bf16* tl, int lane) {
    const int cg = lane & 15, rr = lane >> 4;
    f32x4 v[16];
#pragma unroll
    for (int i = 0; i < 16; ++i) v[i] = *(const GAS f32x4*)(W + (size_t)(k0 + 4 * i + rr) * ldw + src_col + 4 * cg);
#pragma unroll
    for (int i = 0; i < 16; ++i) *(LAS unsigned long long*)(tl + (4 * i + rr) * 68 + 4 * cg) = (unsigned long long)cvtpk(v[i].x, v[i].y) | ((unsigned long long)cvtpk(v[i].z, v[i].w) << 32);
    LDS_WAIT(); asm volatile("" ::: "memory");
#pragma unroll
    for (int ii = 0; ii < 8; ++ii) { const int p = lane + 64 * ii, n = p >> 3, kc = p & 7; const LAS bf16* s = tl + (8 * kc) * 68 + n;
        v4u o; o.x = (unsigned)s[0] | ((unsigned)s[68] << 16); o.y = (unsigned)s[2 * 68] | ((unsigned)s[3 * 68] << 16); o.z = (unsigned)s[4 * 68] | ((unsigned)s[5 * 68] << 16); o.w = (unsigned)s[6 * 68] | ((unsigned)s[7 * 68] << 16);
        *(GAS v4u*)(WT + (size_t)(dst_row + n) * K + k0 + 8 * kc) = o; }
    LDS_WAIT(); asm volatile("" ::: "memory");
}

__device__ __forceinline__ void p0_prologue(Frame& F) {
    LAS bf16* tl = (LAS bf16*)(F.lds + RING_OFF + F.wave * 16384);
    const int gw = F.vcu * NWAVES + F.wave, NGW = F.G * NWAVES, lane = F.lane;
    constexpr int I_ADA = 24 * 32, I_AB = 16, I_IN = 16 * (NP / 64), I_OUT = 16 * 16, I_GU = 16 * (NGU / 64), I_DN = (FF / 64) * 16;
    constexpr int NITEMS = I_ADA + I_AB + I_IN + I_OUT + I_GU + I_DN;
    for (int it = gw; it < NITEMS; it += NGW) {
        int r = it;
        if (r < I_ADA) {
            const int ct = r % 24, ks = r / 24, col = ct * 256 + 4 * lane, k0 = ks * 32;
            f32x4 acc[4];
#pragma unroll
            for (int b = 0; b < 4; ++b) acc[b] = (f32x4){0.f, 0.f, 0.f, 0.f};
#pragma unroll 16
            for (int kk = 0; kk < 32; ++kk) { const int k = k0 + kk; const f32x4 w = *(const GAS f32x4*)(F.w_ada + (size_t)k * (6 * D) + col);
#pragma unroll
                for (int b = 0; b < 4; ++b) acc[b] += silu(F.c[b * D + k]) * w; }
#pragma unroll
            for (int b = 0; b < 4; ++b)
#pragma unroll
                for (int j = 0; j < 4; ++j) atomicAdd(F.modacc + b * (6 * D) + col + j, acc[b][j]);
            continue;
        }
        r -= I_ADA;
        if (r < I_AB) {
            for (int i = 0; i < 16; ++i) { const int k = i * 64 + lane; F.wab[r * D + k] = F.w_in[(size_t)k * PROJ_W + 2048 + r]; }
            continue;
        }
        r -= I_AB;
        if (r < I_IN) { const int nb = r % (NP / 64), kb = r / (NP / 64), n0 = 64 * nb; tr_item64(F.w_in, PROJ_W, n0 < 2048 ? n0 : n0 + 16, F.Win_t, D, n0, 64 * kb, tl, lane); continue; }
        r -= I_IN;
        if (r < I_OUT) { const int nb = r % 16, kb = r / 16; tr_item64(F.w_out, D, 64 * nb, F.Wout_t, D, 64 * nb, 64 * kb, tl, lane); continue; }
        r -= I_OUT;
        if (r < I_GU) { const int nb = r % (NGU / 64), kb = r / (NGU / 64), n0 = 64 * nb, p = n0 >> 8, j = n0 & 255;
            if (j < 128) tr_item64(F.w_gate, FF, 128 * p + j, F.Wgu_t, D, n0, 64 * kb, tl, lane);
            else         tr_item64(F.w_up,   FF, 128 * p + j - 128, F.Wgu_t, D, n0, 64 * kb, tl, lane);
            continue; }
        r -= I_GU;
        { const int nb = r % 16, kb = r / 16; tr_item64(F.w_down, D, 64 * nb, F.Wdn_t, FF, 64 * nb, 64 * kb, tl, lane); }
    }
}

template <int WHICH, bool GAB = (WHICH == 1)> __device__ __forceinline__ void norm_phase(Frame& F) {
    const int gw = F.vcu * NWAVES + F.wave, NGW = F.G * NWAVES, lane = F.lane;
    if (WHICH == 1) {
        for (int idx = gw * 64 + lane; idx < 4 * 6 * D; idx += NGW * 64) F.modf[idx] = F.modacc[idx] + F.b_ada[idx % (6 * D)];
        for (int idx = gw * 64 + lane; idx < 4 * D; idx += NGW * 64) { const int b_ = idx / D, c_ = idx % D; F.gm2[idx] = F.norm2_w[c_] * (1.0f + F.modacc[b_ * 6 * D + 4 * D + c_] + F.b_ada[4 * D + c_]); }
    }
    if (GAB) {
        for (int i = F.tid; i < 16 * D / 4; i += NWAVES * 64) ((LAS f32x4*)(F.lds + RING_OFF))[i] = ((const GAS f32x4*)F.wab)[i];
        __syncthreads();
    }
    const float* src = (WHICH == 1) ? F.x : F.out;
    const float* nw = (WHICH == 1) ? F.norm1_w : F.norm2_w;
    for (int m0 = gw * 4; m0 < M; m0 += NGW * 4) {
        const int b = m0 / T;
        float gm[16], sh[16];
#pragma unroll
        for (int i = 0; i < 4; ++i)
#pragma unroll
            for (int e = 0; e < 4; ++e) { const int c = 256 * i + 4 * lane + e; float sc, sf;
                if (WHICH == 1) { sf = F.modacc[b * 6 * D + c] + F.b_ada[c]; sc = F.modacc[b * 6 * D + D + c] + F.b_ada[D + c];     }
                else { sf = F.modf[b * 6 * D + 3 * D + c]; sc = F.modf[b * 6 * D + 4 * D + c]; }
                gm[4 * i + e] = nw[c] * (1.0f + sc); sh[4 * i + e] = sf; }
        float h[4][16];
        f32x4 v[4][4];
#pragma unroll
        for (int r = 0; r < 4; ++r) { const GAS f32x4* xr = (const GAS f32x4*)(src + (size_t)(m0 + r) * D) + lane;
#pragma unroll
            for (int i = 0; i < 4; ++i) v[r][i] = xr[64 * i]; }
#pragma unroll
        for (int r = 0; r < 4; ++r) {
            float ss = 0.f;
#pragma unroll
            for (int i = 0; i < 4; ++i) ss += (v[r][i].x * v[r][i].x + v[r][i].y * v[r][i].y) + (v[r][i].z * v[r][i].z + v[r][i].w * v[r][i].w);
            const float rstd = rsq(wave_sum(ss) * (1.0f / D) + EPS);
            GAS unsigned long long* o8 = (GAS unsigned long long*)(F.H + (size_t)(m0 + r) * D) + lane;
#pragma unroll
            for (int i = 0; i < 4; ++i) {
                const float a0 = v[r][i].x * rstd * gm[4 * i + 0] + sh[4 * i + 0], a1 = v[r][i].y * rstd * gm[4 * i + 1] + sh[4 * i + 1];
                const float a2 = v[r][i].z * rstd * gm[4 * i + 2] + sh[4 * i + 2], a3 = v[r][i].w * rstd * gm[4 * i + 3] + sh[4 * i + 3];
                h[r][4 * i + 0] = a0; h[r][4 * i + 1] = a1; h[r][4 * i + 2] = a2; h[r][4 * i + 3] = a3;
                o8[64 * i] = (unsigned long long)cvtpk(a0, a1) | ((unsigned long long)cvtpk(a2, a3) << 32); }
        }
        if (GAB) {
            float myv = 0.f;
#pragma unroll 4
            for (int j = 0; j < 16; ++j) {
                const LAS f32x4* wp = (const LAS f32x4*)(F.lds + RING_OFF) + j * (D / 4) + lane;
                f32x4 wv[4];
#pragma unroll
                for (int i = 0; i < 4; ++i) wv[i] = wp[64 * i];
#pragma unroll
                for (int r = 0; r < 4; ++r) { float p = 0.f;
#pragma unroll
                    for (int i = 0; i < 4; ++i) p += (h[r][4 * i] * wv[i].x + h[r][4 * i + 1] * wv[i].y) + (h[r][4 * i + 2] * wv[i].z + h[r][4 * i + 3] * wv[i].w);
                    p = wave_sum(p);
                    if (lane == r * 16 + j) myv = p; }
            }
            const int j = lane & 15, hh = j & 7;
            float val;
            if (j < 8) { const float xx = myv + F.dt_bias[hh]; const float sp = fmaxf(xx, 0.f) + log1pf(__expf(-fabsf(xx))); val = -__expf(F.a_log[hh]) * sp; }
            else val = 1.0f / (1.0f + __expf(-myv));
            F.gb[(size_t)m0 * 16 + lane] = val;
        }
    }
}

__device__ __forceinline__ float rdlane(float v, int l) { return __int_as_float(__builtin_amdgcn_readlane(__float_as_int(v), l)); }
__device__ __forceinline__ bf16x8 pack8(const f32x4 a, const f32x4 b) {
    v4u w; w.x = cvtpk(a[0], a[1]); w.y = cvtpk(a[2], a[3]); w.z = cvtpk(b[0], b[1]); w.w = cvtpk(b[2], b[3]); return __builtin_bit_cast(bf16x8, w); }
__device__ __forceinline__ bf16x8 tile_frag(const LAS bf16* tile, int t, int ks, int fr, int fq) {
    const LAS bf16* p = tile + (16 * t + fr) * 64 + 32 * ks + 4 * fq;
    const unsigned long long lo = *(const LAS unsigned long long*)p, hi = *(const LAS unsigned long long*)(p + 16);
    v4u v; v.x = (unsigned)lo; v.y = (unsigned)(lo >> 32); v.z = (unsigned)hi; v.w = (unsigned)(hi >> 32); return __builtin_bit_cast(bf16x8, v);
}
__device__ __forceinline__ float arow(unsigned packed, int hi, int s) { const unsigned u = (unsigned)__builtin_amdgcn_readlane((int)packed, s); return __uint_as_float(hi ? (u & 0xffff0000u) : (u << 16)); }
__device__ __forceinline__ unsigned long long pack4(float a, float b, float c, float d) { return (unsigned long long)cvtpk(a, b) | ((unsigned long long)cvtpk(c, d) << 32); }

typedef short s16x4 __attribute__((ext_vector_type(4)));
__device__ __forceinline__ s16x4 cvt4(const f32x4 v) { const unsigned lo = cvtpk(v[0], v[1]), hi = cvtpk(v[2], v[3]); typedef unsigned u32x2 __attribute__((ext_vector_type(2))); return __builtin_bit_cast(s16x4, (u32x2){lo, hi}); }
#define MFMA16(a, b, c) __builtin_amdgcn_mfma_f32_16x16x16bf16_1k((a), (b), (c), 0, 0, 0)
#define MFMA32(a, b, c) __builtin_amdgcn_mfma_f32_16x16x32_bf16((a), (b), (c), 0, 0, 0)

__device__ __forceinline__ void gdn_prep_chunk(Frame& F, int ci, LAS unsigned char* wl  ) {
    const int lane = F.lane, bh = ci >> 6, n = ci & 63, b = bh >> 3, hh = bh & 7, fr = lane & 15, fq = lane >> 4;
    const size_t m0 = (size_t)b * T + 64 * n;
    bf16* const cA = F.CHKA + (size_t)ci * 8192;
    bf16* const cT = F.CHKT + (size_t)ci * 8192;
    bf16* const cU = F.CHKU + (size_t)ci * 8192;
    LAS bf16* const R0 = (LAS bf16*)wl;
    LAS bf16* const R1 = (LAS bf16*)(wl + 9728);
#define GDN_RAW(dst, col0) do { _Pragma("unroll") for (int i_ = 0; i_ < 9; ++i_) { long row_ = (long)m0 - 3 + 8 * i_ + (lane >> 3); row_ = row_ < 0 ? 0 : (row_ > M - 1 ? M - 1 : row_); \
        __builtin_amdgcn_global_load_lds((const unsigned*)(F.PQ + (size_t)row_ * NP + (col0) + hh * 64 + (lane & 7) * 8), (LAS unsigned*)((dst) + i_ * 512), 16, 0, 0); } } while (0)
    GDN_RAW(R0, C_GQ); GDN_RAW(R1, C_GK);
    const f32x4 z4 = (f32x4){0.f, 0.f, 0.f, 0.f};
    const float g = ld_f32_coh(F.gb + (m0 + lane) * 16 + hh), beta = ld_f32_coh(F.gb + (m0 + lane) * 16 + 8 + hh);
    float G = g;
#pragma unroll
    for (int o = 1; o < 64; o <<= 1) { const float t = __shfl_up(G, o); if (lane >= o) G += t; }
    const float eG = __expf(G), Glast = __shfl(G, 63), kdsc = __expf(Glast - G), beG = beta * eG;
    if (lane == 0) F.dec[ci] = __expf(Glast);
    asm volatile("s_waitcnt vmcnt(0)" ::: "memory");
    {
        const float w0 = F.conv_w[hh * 64 + lane], w1 = F.conv_w[1536 + hh * 64 + lane], w2 = F.conv_w[2 * 1536 + hh * 64 + lane], w3 = F.conv_w[3 * 1536 + hh * 64 + lane];
        float x0 = 0.f, x1 = 0.f, x2 = 0.f;
        if (n > 0) { x0 = bf2f(R0[lane]); x1 = bf2f(R0[64 + lane]); x2 = bf2f(R0[128 + lane]); }
#pragma unroll
        for (int c = 0; c < 64; ++c) {
            const float r = bf2f(R0[(c + 3) * 64 + lane]);
            const float cq = silu(w0 * x0 + w1 * x1 + w2 * x2 + w3 * r); x0 = x1; x1 = x2; x2 = r;
            const float qn = cq * rsq(wave_sum(cq * cq) + EPS);
            R0[c * 64 + lane] = (bf16)(cvtpk(qn, qn) & 0xffffu);
            if ((c & 15) == 15) __builtin_amdgcn_sched_barrier(0);
        }
    }
    {
        const float w0 = F.conv_w[512 + hh * 64 + lane], w1 = F.conv_w[1536 + 512 + hh * 64 + lane], w2 = F.conv_w[2 * 1536 + 512 + hh * 64 + lane], w3 = F.conv_w[3 * 1536 + 512 + hh * 64 + lane];
        float x0 = 0.f, x1 = 0.f, x2 = 0.f;
        if (n > 0) { x0 = bf2f(R1[lane]); x1 = bf2f(R1[64 + lane]); x2 = bf2f(R1[128 + lane]); }
#pragma unroll
        for (int c = 0; c < 64; ++c) {
            const float r = bf2f(R1[(c + 3) * 64 + lane]);
            const float ck = silu(w0 * x0 + w1 * x1 + w2 * x2 + w3 * r); x0 = x1; x1 = x2; x2 = r;
            const float kn = ck * rsq(wave_sum(ck * ck) + EPS);
            R1[c * 64 + lane] = (bf16)(cvtpk(kn, kn) & 0xffffu);
            if ((c & 15) == 15) __builtin_amdgcn_sched_barrier(0);
        }
    }
    LDS_WAIT(); asm volatile("" ::: "memory");
    bf16x8 kf[4][2], qf[4][2];
#pragma unroll
    for (int blk = 0; blk < 4; ++blk)
#pragma unroll
        for (int kk = 0; kk < 2; ++kk) { kf[blk][kk] = *(const LAS bf16x8*)(R1 + (16 * blk + fr) * 64 + 32 * kk + 8 * fq); qf[blk][kk] = *(const LAS bf16x8*)(R0 + (16 * blk + fr) * 64 + 32 * kk + 8 * fq); }
    float Gcol[4], Bcol[4], Grow[4][4];
#pragma unroll
    for (int t = 0; t < 4; ++t) { Gcol[t] = __shfl(G, 16 * t + fr); Bcol[t] = __shfl(beta, 16 * t + fr);
#pragma unroll
        for (int i = 0; i < 4; ++i) Grow[t][i] = __shfl(G, 16 * t + 4 * fq + i); }
#pragma unroll
    for (int mt = 0; mt < 4; ++mt) { const float esc = __expf(Gcol[mt]) * 0.125f;
#pragma unroll
        for (int ks = 0; ks < 2; ++ks) { const v4u q8 = __builtin_bit_cast(v4u, tile_frag(R0, mt, ks, fr, fq)); const unsigned w_[4] = {q8.x, q8.y, q8.z, q8.w}; v4u o_;
            o_.x = cvtpk(__uint_as_float(w_[0] << 16) * esc, __uint_as_float(w_[0] & 0xffff0000u) * esc); o_.y = cvtpk(__uint_as_float(w_[1] << 16) * esc, __uint_as_float(w_[1] & 0xffff0000u) * esc);
            o_.z = cvtpk(__uint_as_float(w_[2] << 16) * esc, __uint_as_float(w_[2] & 0xffff0000u) * esc); o_.w = cvtpk(__uint_as_float(w_[3] << 16) * esc, __uint_as_float(w_[3] & 0xffff0000u) * esc);
            *(GAS v4u*)(cT + ((mt * 2 + ks) * 64 + lane) * 8) = o_; } }
    LDS_WAIT(); asm volatile("" ::: "memory");
#pragma unroll
    for (int tc = 0; tc < 4; ++tc)
#pragma unroll
        for (int ks = 0; ks < 2; ++ks) {
            f32x4 v[2];
#pragma unroll
            for (int h2 = 0; h2 < 2; ++h2) { const int ts = 2 * ks + h2;
                if (ts <= tc) { f32x4 acc = MFMA32(kf[ts][0], qf[tc][0], z4); acc = MFMA32(kf[ts][1], qf[tc][1], acc);
#pragma unroll
                    for (int i = 0; i < 4; ++i) { const int cidx = 16 * tc + fr, sidx = 16 * ts + 4 * fq + i; v[h2][i] = (cidx >= sidx) ? acc[i] * __expf(Gcol[tc] - Grow[ts][i]) * 0.125f : 0.f; }
                } else v[h2] = z4; }
            *(bf16x8*)(cT + 4096 + ((tc * 2 + ks) * 64 + lane) * 8) = pack8(v[0], v[1]);
        }
#pragma unroll
    for (int tc = 0; tc < 4; ++tc)
#pragma unroll
        for (int ts = 0; ts < 4; ++ts) { f32x4 a = z4;
            if (ts <= tc) { f32x4 acc = MFMA32(kf[ts][0], kf[tc][0], z4); acc = MFMA32(kf[ts][1], kf[tc][1], acc);
#pragma unroll
                for (int i = 0; i < 4; ++i) { const int cidx = 16 * tc + fr, sidx = 16 * ts + 4 * fq + i; a[i] = (cidx > sidx) ? Bcol[tc] * acc[i] * __expf(Gcol[tc] - Grow[ts][i]) : 0.f; } }
            *(LAS unsigned long long*)(R0 + (16 * tc + fr) * 64 + 16 * ts + 4 * fq) = pack4(a[0], a[1], a[2], a[3]); }
    bf16x8 RkB[4][2], KDf[4][2];
#pragma unroll
    for (int ks = 0; ks < 2; ++ks) { float sB[8], sD[8];
#pragma unroll
        for (int j = 0; j < 8; ++j) { const int tok = 32 * ks + 16 * (j >> 2) + 4 * fq + (j & 3); sB[j] = __shfl(beG, tok); sD[j] = __shfl(kdsc, tok); }
#pragma unroll
        for (int t = 0; t < 4; ++t) { float kv[8];
#pragma unroll
            for (int j = 0; j < 8; ++j) kv[j] = bf2f(R1[(32 * ks + 16 * (j >> 2) + 4 * fq + (j & 3)) * 64 + 16 * t + fr]);
            v4u a_, d_;
            a_.x = cvtpk(kv[0] * sB[0], kv[1] * sB[1]); a_.y = cvtpk(kv[2] * sB[2], kv[3] * sB[3]); a_.z = cvtpk(kv[4] * sB[4], kv[5] * sB[5]); a_.w = cvtpk(kv[6] * sB[6], kv[7] * sB[7]);
            d_.x = cvtpk(kv[0] * sD[0], kv[1] * sD[1]); d_.y = cvtpk(kv[2] * sD[2], kv[3] * sD[3]); d_.z = cvtpk(kv[4] * sD[4], kv[5] * sD[5]); d_.w = cvtpk(kv[6] * sD[6], kv[7] * sD[7]);
            RkB[t][ks] = __builtin_bit_cast(bf16x8, a_); KDf[t][ks] = __builtin_bit_cast(bf16x8, d_); } }
    LDS_WAIT(); asm volatile("" ::: "memory");
    {
        float X[16];
#pragma unroll
        for (int r = 0; r < 16; ++r) X[r] = (r == fr) ? 1.f : 0.f;
        const LAS bf16* ab = R0 + (16 * fq) * 64 + 16 * fq;
#pragma unroll
        for (int s = 0; s < 15; ++s) {
#pragma unroll
            for (int r = s + 1; r < 16; ++r) X[r] -= bf2f(ab[r * 64 + s]) * X[s];
            if ((s & 3) == 3) __builtin_amdgcn_sched_barrier(0);
        }
        LDS_WAIT(); asm volatile("" ::: "memory");
#pragma unroll
        for (int r = 0; r < 16; ++r) R0[(16 * fq + r) * 64 + 16 * fq + fr] = (bf16)(cvtpk(X[r], X[r]) & 0xffffu);
    }
    LDS_WAIT(); asm volatile("" ::: "memory");
    {
#define A16(i, k) (*(const LAS s16x4*)(R0 + (16 * (i) + fr) * 64 + 16 * (k) + 4 * fq))
        s16x4 Td[4];
#pragma unroll
        for (int j = 0; j < 3; ++j) { const LAS bf16* p = R0 + (16 * j + 4 * fq) * 64 + 16 * j + fr; typedef unsigned u32x2 __attribute__((ext_vector_type(2)));
            Td[j] = __builtin_bit_cast(s16x4, (u32x2){(unsigned)p[0] | ((unsigned)p[64] << 16), (unsigned)p[128] | ((unsigned)p[192] << 16)}); }
        f32x4 m10 = MFMA16(A16(1, 0), Td[0], z4);
        const f32x4 t10 = -MFMA16(A16(1, 1), cvt4(m10), z4);
        f32x4 m21 = MFMA16(A16(2, 1), Td[1], z4);
        f32x4 m20 = MFMA16(A16(2, 0), Td[0], z4); m20 = MFMA16(A16(2, 1), cvt4(t10), m20);
        const s16x4 a22 = A16(2, 2);
        const f32x4 t21 = -MFMA16(a22, cvt4(m21), z4), t20 = -MFMA16(a22, cvt4(m20), z4);
        f32x4 m32 = MFMA16(A16(3, 2), Td[2], z4);
        f32x4 m31 = MFMA16(A16(3, 1), Td[1], z4); m31 = MFMA16(A16(3, 2), cvt4(t21), m31);
        f32x4 m30 = MFMA16(A16(3, 0), Td[0], z4); m30 = MFMA16(A16(3, 1), cvt4(t10), m30); m30 = MFMA16(A16(3, 2), cvt4(t20), m30);
        const s16x4 a33 = A16(3, 3);
        const f32x4 t32 = -MFMA16(a33, cvt4(m32), z4), t31 = -MFMA16(a33, cvt4(m31), z4), t30 = -MFMA16(a33, cvt4(m30), z4);
        LDS_WAIT(); asm volatile("" ::: "memory");
#define TST(i, j, t) do { _Pragma("unroll") for (int r_ = 0; r_ < 4; ++r_) R0[(16 * (i) + 4 * fq + r_) * 64 + 16 * (j) + fr] = (bf16)(cvtpk((t)[r_], (t)[r_]) & 0xffffu); } while (0)
        TST(1, 0, t10); TST(2, 0, t20); TST(2, 1, t21); TST(3, 0, t30); TST(3, 1, t31); TST(3, 2, t32);
#undef TST
#undef A16
    }
    LDS_WAIT(); asm volatile("" ::: "memory");
#pragma unroll
    for (int ct = 0; ct < 4; ++ct) { const bf16x8 ta0 = tile_frag(R0, ct, 0, fr, fq), ta1 = tile_frag(R0, ct, 1, fr, fq);
#pragma unroll
        for (int dt = 0; dt < 4; ++dt) { f32x4 acc = MFMA32(ta0, RkB[dt][0], z4); if (ct >= 2) acc = MFMA32(ta1, RkB[dt][1], acc);
            *(LAS unsigned long long*)(R1 + (16 * dt + fr) * 64 + 16 * ct + 4 * fq) = pack4(acc[0], acc[1], acc[2], acc[3]); } }
    asm volatile("s_waitcnt vmcnt(0) lgkmcnt(0)" ::: "memory");
#pragma unroll
    for (int tn = 0; tn < 4; ++tn) {
        const bf16x8 qb0 = *(const GAS bf16x8*)(cT + 4096 + ((tn * 2) * 64 + lane) * 8), qb1 = *(const GAS bf16x8*)(cT + 4096 + ((tn * 2 + 1) * 64 + lane) * 8);
#pragma unroll
        for (int ks2 = 0; ks2 < 2; ++ks2) {
            const v4u qd8 = *(const GAS v4u*)(cT + ((tn * 2 + ks2) * 64 + lane) * 8); const unsigned qw_[4] = {qd8.x, qd8.y, qd8.z, qd8.w};
            f32x4 pp[2], q2[2];
#pragma unroll
            for (int h2 = 0; h2 < 2; ++h2) { const int tm = 2 * ks2 + h2;
                const bf16x8 wa0 = tile_frag(R1, tm, 0, fr, fq), wa1 = tile_frag(R1, tm, 1, fr, fq);
                f32x4 a1 = MFMA32(wa0, KDf[tn][0], z4); a1 = MFMA32(wa1, KDf[tn][1], a1);
                f32x4 a2 = MFMA32(wa0, qb0, z4); a2 = MFMA32(wa1, qb1, a2);
                pp[h2] = -a1;
                q2[h2] = (f32x4){__uint_as_float(qw_[2 * h2] << 16), __uint_as_float(qw_[2 * h2] & 0xffff0000u), __uint_as_float(qw_[2 * h2 + 1] << 16), __uint_as_float(qw_[2 * h2 + 1] & 0xffff0000u)} - a2; }
            *(GAS bf16x8*)(cA + ((tn * 2 + ks2) * 64 + lane) * 8) = pack8(pp[0], pp[1]);
            *(GAS bf16x8*)(cA + 4096 + ((tn * 2 + ks2) * 64 + lane) * 8) = pack8(q2[0], q2[1]);
        }
    }
    LDS_WAIT(); asm volatile("" ::: "memory");
    GDN_RAW(R1, C_GV);
    asm volatile("s_waitcnt vmcnt(0)" ::: "memory");
    {
        const float w0 = F.conv_w[1024 + hh * 64 + lane], w1 = F.conv_w[1536 + 1024 + hh * 64 + lane], w2 = F.conv_w[2 * 1536 + 1024 + hh * 64 + lane], w3 = F.conv_w[3 * 1536 + 1024 + hh * 64 + lane];
        float x0 = 0.f, x1 = 0.f, x2 = 0.f;
        if (n > 0) { x0 = bf2f(R1[lane]); x1 = bf2f(R1[64 + lane]); x2 = bf2f(R1[128 + lane]); }
#pragma unroll
        for (int c = 0; c < 64; ++c) {
            const float r = bf2f(R1[(c + 3) * 64 + lane]);
            const float cv = silu(w0 * x0 + w1 * x1 + w2 * x2 + w3 * r); x0 = x1; x1 = x2; x2 = r;
            R1[c * 64 + lane] = (bf16)(cvtpk(cv, cv) & 0xffffu);
            if ((c & 15) == 15) __builtin_amdgcn_sched_barrier(0);
        }
    }
    LDS_WAIT(); asm volatile("" ::: "memory");
    bf16x8 RvB[4][2];
#pragma unroll
    for (int ks = 0; ks < 2; ++ks) { float sB[8];
#pragma unroll
        for (int j = 0; j < 8; ++j) sB[j] = __shfl(beta, 32 * ks + 16 * (j >> 2) + 4 * fq + (j & 3));
#pragma unroll
        for (int t = 0; t < 4; ++t) { float vv[8];
#pragma unroll
            for (int j = 0; j < 8; ++j) vv[j] = bf2f(R1[(32 * ks + 16 * (j >> 2) + 4 * fq + (j & 3)) * 64 + 16 * t + fr]) * sB[j];
            v4u a_; a_.x = cvtpk(vv[0], vv[1]); a_.y = cvtpk(vv[2], vv[3]); a_.z = cvtpk(vv[4], vv[5]); a_.w = cvtpk(vv[6], vv[7]);
            RvB[t][ks] = __builtin_bit_cast(bf16x8, a_); } }
    LDS_WAIT(); asm volatile("" ::: "memory");
#pragma unroll
    for (int ct = 0; ct < 4; ++ct) { const bf16x8 ta0 = tile_frag(R0, ct, 0, fr, fq), ta1 = tile_frag(R0, ct, 1, fr, fq);
#pragma unroll
        for (int et = 0; et < 4; ++et) { f32x4 acc = MFMA32(ta0, RvB[et][0], z4); if (ct >= 2) acc = MFMA32(ta1, RvB[et][1], acc);
            *(LAS unsigned long long*)(R1 + (16 * et + fr) * 64 + 16 * ct + 4 * fq) = pack4(acc[0], acc[1], acc[2], acc[3]); } }
    LDS_WAIT(); asm volatile("" ::: "memory");
#pragma unroll
    for (int et = 0; et < 4; ++et) {
        const bf16x8 ub0 = tile_frag(R1, et, 0, fr, fq), ub1 = tile_frag(R1, et, 1, fr, fq);
#pragma unroll
        for (int tm = 0; tm < 4; ++tm) {
            const bf16x8 qa0 = *(const GAS bf16x8*)(cT + 4096 + ((tm * 2) * 64 + lane) * 8), qa1 = *(const GAS bf16x8*)(cT + 4096 + ((tm * 2 + 1) * 64 + lane) * 8);
            f32x4 r = MFMA32(KDf[tm][0], ub0, z4); r = MFMA32(KDf[tm][1], ub1, r);
            f32x4 o = MFMA32(qa0, ub0, z4); o = MFMA32(qa1, ub1, o);
            *(GAS unsigned long long*)(cU + ((et * 4 + tm) * 64 + lane) * 4) = pack4(r[0], r[1], r[2], r[3]);
            *(GAS unsigned long long*)(cU + 4096 + ((et * 4 + tm) * 64 + lane) * 4) = pack4(o[0], o[1], o[2], o[3]);
        }
    }
    LDS_WAIT(); asm volatile("" ::: "memory");
}
#undef MFMA16
#undef MFMA32
#undef GDN_RAW

#define GDN_BAR() do { asm volatile("" ::: "memory"); __builtin_amdgcn_s_barrier(); asm volatile("" ::: "memory"); } while (0)
__device__ __forceinline__ void gdn_scan(Frame& F, int bh) {
    const int lane = F.lane, wave = F.wave, b = bh >> 3, hh = bh & 7, fr = lane & 15, fq = lane >> 4;
    LAS unsigned char* const ring = F.lds + RING_OFF;
    constexpr int SLOT = 32768, OB0 = 131072, OB1 = 139264;
    const unsigned char* gA = (const unsigned char*)(F.CHKA + (size_t)bh * 64 * 8192);
    const unsigned char* gU = (const unsigned char*)(F.CHKU + (size_t)bh * 64 * 8192);
    if (wave >= 4) {
        const int hw = wave - 4, nt = hw * 64 + lane;
        bf16* mp = F.ORAW + ((size_t)b * T + (nt >> 3)) * 512 + hh * 64 + (nt & 7) * 8;
#define GDN_ISSUE(nn) do { const int n_ = (nn); const int sl_ = n_ & 3; _Pragma("unroll") for (int i_ = 0; i_ < 8; ++i_) { const int p_ = hw * 8 + i_; \
            const unsigned char* s_ = (p_ < 16) ? gA + (size_t)n_ * 16384 + p_ * 1024 : gU + (size_t)n_ * 16384 + (p_ - 16) * 1024; \
            __builtin_amdgcn_global_load_lds((const unsigned*)(s_ + lane * 16), (LAS unsigned*)(ring + sl_ * SLOT + p_ * 1024), 16, 0, 0); } } while (0)
#define GDN_COPY(nn) do { const LAS unsigned char* ob_ = ring + (((nn) & 1) ? OB1 : OB0); _Pragma("unroll") for (int k_ = 0; k_ < 2; ++k_) \
            *(GAS v4u*)(mp + (size_t)(64 * (nn) + 32 * k_) * 512) = *(const LAS v4u*)(ob_ + (nt + 256 * k_) * 16); } while (0)
        GDN_ISSUE(0); GDN_ISSUE(1); GDN_ISSUE(2);
        asm volatile("s_waitcnt vmcnt(16)" ::: "memory"); GDN_BAR();
        for (int n = 0; n < 64; ++n) {
            if (n + 3 < 64) { GDN_ISSUE(n + 3); asm volatile("s_waitcnt vmcnt(16)" ::: "memory"); } else asm volatile("s_waitcnt vmcnt(0)" ::: "memory");
            if (n > 0) GDN_COPY(n - 1);
            LDS_WAIT(); GDN_BAR();
        }
        GDN_COPY(63);
#undef GDN_ISSUE
#undef GDN_COPY
    } else {
        const int ew = wave;
        f32x4 Sacc[4];
#pragma unroll
        for (int t = 0; t < 4; ++t) Sacc[t] = (f32x4){0.f, 0.f, 0.f, 0.f};
        const float decs = ld_f32_coh(F.dec + bh * 64 + lane);
        GDN_BAR();
        for (int n = 0; n < 64; ++n) {
            const LAS unsigned char* sl = ring + (n & 3) * SLOT;
            LAS bf16* ob = (LAS bf16*)(ring + ((n & 1) ? OB1 : OB0)) + (4 * fq) * 64 + 16 * ew + fr;
            const float dec = __int_as_float(__builtin_amdgcn_readlane(__float_as_int(decs), n));
            unsigned long long rf[4], of[4]; bf16x8 pf[8], qf[8];
#pragma unroll
            for (int t = 0; t < 4; ++t) { rf[t] = *(const LAS unsigned long long*)(sl + 16384 + ((ew * 4 + t) * 64 + lane) * 8); of[t] = *(const LAS unsigned long long*)(sl + 24576 + ((ew * 4 + t) * 64 + lane) * 8); }
#pragma unroll
            for (int f = 0; f < 8; ++f) { pf[f] = *(const LAS bf16x8*)(sl + (f * 64 + lane) * 16); qf[f] = *(const LAS bf16x8*)(sl + 8192 + (f * 64 + lane) * 16); }
            __builtin_amdgcn_sched_barrier(0);
            bf16x8 Sb[2]; Sb[0] = pack8(Sacc[0], Sacc[1]); Sb[1] = pack8(Sacc[2], Sacc[3]);
            f32x4 O[4];
#pragma unroll
            for (int t = 0; t < 4; ++t) { const unsigned rl = (unsigned)rf[t], rh = (unsigned)(rf[t] >> 32), ol = (unsigned)of[t], oh = (unsigned)(of[t] >> 32);
                Sacc[t] = Sacc[t] * dec + (f32x4){__uint_as_float(rl << 16), __uint_as_float(rl & 0xffff0000u), __uint_as_float(rh << 16), __uint_as_float(rh & 0xffff0000u)};
                O[t] = (f32x4){__uint_as_float(ol << 16), __uint_as_float(ol & 0xffff0000u), __uint_as_float(oh << 16), __uint_as_float(oh & 0xffff0000u)}; }
#pragma unroll
            for (int t = 0; t < 4; ++t)
#pragma unroll
                for (int ks = 0; ks < 2; ++ks) { const int f = t * 2 + ks;
                    Sacc[t] = __builtin_amdgcn_mfma_f32_16x16x32_bf16(pf[f], Sb[ks], Sacc[t], 0, 0, 0); O[t] = __builtin_amdgcn_mfma_f32_16x16x32_bf16(qf[f], Sb[ks], O[t], 0, 0, 0); }
#pragma unroll
            for (int t = 0; t < 4; ++t)
#pragma unroll
                for (int i = 0; i < 4; ++i) ob[(16 * t + i) * 64] = (bf16)(cvtpk(O[t][i], O[t][i]) & 0xffffu);
            LDS_WAIT(); GDN_BAR();
        }
    }
}
__device__ __forceinline__ void gdn_norm_rows(Frame& F, int r0) {
    const int oc = F.tid & 7, hd = (F.tid >> 3) & 7;
    float nw[8];
#pragma unroll
    for (int j = 0; j < 8; ++j) nw[j] = F.gdn_norm_w[oc * 8 + j];
#pragma unroll 1
    for (int it = 0; it < 4; ++it) {
        v4u ov[8], zv[8];
#pragma unroll
        for (int k = 0; k < 8; ++k) { const size_t row = (size_t)r0 + (it * 8 + k) * 8 + (F.tid >> 6); ov[k] = *(const GAS v4u*)(F.ORAW + row * 512 + hd * 64 + oc * 8); zv[k] = *(const GAS v4u*)(F.PQ + row * NP + C_GZ + hd * 64 + oc * 8); }
#pragma unroll
        for (int k = 0; k < 8; ++k) { const size_t row = (size_t)r0 + (it * 8 + k) * 8 + (F.tid >> 6);
            const unsigned ow[4] = {ov[k].x, ov[k].y, ov[k].z, ov[k].w}, zw[4] = {zv[k].x, zv[k].y, zv[k].z, zv[k].w};
            float o[8], z[8]; float ss = 0.f;
#pragma unroll
            for (int w = 0; w < 4; ++w) { o[2 * w] = __uint_as_float(ow[w] << 16); o[2 * w + 1] = __uint_as_float(ow[w] & 0xffff0000u); z[2 * w] = __uint_as_float(zw[w] << 16); z[2 * w + 1] = __uint_as_float(zw[w] & 0xffff0000u);
                ss += o[2 * w] * o[2 * w] + o[2 * w + 1] * o[2 * w + 1]; }
            ss = sum8(ss);
            const float rs = rsq(ss * (1.0f / 64.0f) + EPS);
            v4u w4; w4.x = cvtpk(o[0] * rs * nw[0] * z[0], o[1] * rs * nw[1] * z[1]); w4.y = cvtpk(o[2] * rs * nw[2] * z[2], o[3] * rs * nw[3] * z[3]);
            w4.z = cvtpk(o[4] * rs * nw[4] * z[4], o[5] * rs * nw[5] * z[5]); w4.w = cvtpk(o[6] * rs * nw[6] * z[6], o[7] * rs * nw[7] * z[7]);
            *(GAS v4u*)(F.MIX + row * D + hd * 64 + oc * 8) = w4; }
    }
    asm volatile("s_waitcnt vmcnt(0)" ::: "memory"); __syncthreads();
}
__device__ __forceinline__ void swa_unit(Frame& F, int unit, LAS unsigned char* L) {
    const int tid = F.tid, lane = F.lane, wave = F.wave, fr = lane & 15, fq = lane >> 4;
    const int blk = unit & 63, kvh = (unit >> 6) & 1, b = unit >> 7, t0 = blk * 64;
    const size_t row0 = (size_t)b * T;
    LAS bf16* const Ks = (LAS bf16*)L; LAS bf16* const Vt = (LAS bf16*)(L + 27648);
    for (int p = tid; p < 1536; p += NWAVES * 64) {
        const int key = p >> 3, oc = p & 7, s = t0 - 128 + key;
        v4u kv = (v4u){0u, 0u, 0u, 0u}, vv = (v4u){0u, 0u, 0u, 0u};
        if (s >= 0) { kv = *(const GAS v4u*)(F.PQ + (row0 + s) * NP + C_SK + kvh * 64 + oc * 8); vv = *(const GAS v4u*)(F.PQ + (row0 + s) * NP + C_SV + kvh * 64 + oc * 8); }
        const unsigned kw[4] = {kv.x, kv.y, kv.z, kv.w}, vw[4] = {vv.x, vv.y, vv.z, vv.w};
        float k[8]; float ss = 0.f;
#pragma unroll
        for (int w = 0; w < 4; ++w) { k[2 * w] = __uint_as_float(kw[w] << 16); k[2 * w + 1] = __uint_as_float(kw[w] & 0xffff0000u); ss += k[2 * w] * k[2 * w] + k[2 * w + 1] * k[2 * w + 1]; }
        ss = sum8(ss);
        const float rstd = rsq(ss * (1.0f / 64.0f) + EPS);
#pragma unroll
        for (int j = 0; j < 8; ++j) k[j] = k[j] * rstd * F.k_norm_w[oc * 8 + j];
        v4u o; o.x = cvtpk(k[0], k[1]); o.y = cvtpk(k[2], k[3]); o.z = cvtpk(k[4], k[5]); o.w = cvtpk(k[6], k[7]);
        *(LAS v4u*)(Ks + key * 72 + oc * 8) = o;
#pragma unroll
        for (int w = 0; w < 4; ++w) { Vt[(oc * 8 + 2 * w) * 196 + key] = (bf16)(vw[w] & 0xffffu); Vt[(oc * 8 + 2 * w + 1) * 196 + key] = (bf16)(vw[w] >> 16); }
    }
    __syncthreads();
    const int hq = kvh * 4 + (wave >> 1);
    const float slope = exp2f(-(float)(hq + 1)), sink = F.sinks[hq];
#pragma unroll 1
    for (int qt = 0; qt < 2; ++qt) {
        const int tq0 = t0 + 32 * (wave & 1) + 16 * qt;
        bf16x8 qf[2];
        {
            const bf16* qp = F.PQ + (row0 + tq0 + fr) * NP + C_SQ + hq * 64 + 8 * fq;
            const v4u r0 = *(const GAS v4u*)qp, r1 = *(const GAS v4u*)(qp + 32);
            const unsigned qw[8] = {r0.x, r0.y, r0.z, r0.w, r1.x, r1.y, r1.z, r1.w};
            float q[16]; float ss = 0.f;
#pragma unroll
            for (int w = 0; w < 8; ++w) { q[2 * w] = __uint_as_float(qw[w] << 16); q[2 * w + 1] = __uint_as_float(qw[w] & 0xffff0000u); ss += q[2 * w] * q[2 * w] + q[2 * w + 1] * q[2 * w + 1]; }
            ss = fq_sum(ss);
            const float rstd = 0.125f * rsq(ss * (1.0f / 64.0f) + EPS);
#pragma unroll
            for (int kk = 0; kk < 2; ++kk) { float z[8];
#pragma unroll
                for (int j = 0; j < 8; ++j) z[j] = q[8 * kk + j] * rstd * F.q_norm_w[32 * kk + 8 * fq + j];
                v4u o; o.x = cvtpk(z[0], z[1]); o.y = cvtpk(z[2], z[3]); o.z = cvtpk(z[4], z[5]); o.w = cvtpk(z[6], z[7]); qf[kk] = __builtin_bit_cast(bf16x8, o); }
        }
        f32x4 sc[12]; float mx = -INFINITY;
#pragma unroll
        for (int nt = 0; nt < 12; ++nt) { f32x4 acc = (f32x4){0.f, 0.f, 0.f, 0.f};
#pragma unroll
            for (int kk = 0; kk < 2; ++kk) { const bf16x8 kf = *(const LAS bf16x8*)(Ks + (16 * nt + fr) * 72 + 32 * kk + 8 * fq); acc = __builtin_amdgcn_mfma_f32_16x16x32_bf16(kf, qf[kk], acc, 0, 0, 0); }
#pragma unroll
            for (int i = 0; i < 4; ++i) { const int s = t0 - 128 + 16 * nt + 4 * fq + i, dist = tq0 + fr - s; const bool ok = (s >= 0) && (dist >= 0) && (dist < 128);
                const float v = ok ? acc[i] - slope * (float)dist : -INFINITY; acc[i] = v; mx = fmaxf(mx, v); }
            sc[nt] = acc; if (nt & 1) __builtin_amdgcn_sched_barrier(0); }
        mx = fmaxf(fq_max(mx), sink);
        float sum = 0.f;
#pragma unroll
        for (int nt = 0; nt < 12; ++nt)
#pragma unroll
            for (int i = 0; i < 4; ++i) { const float p = __expf(sc[nt][i] - mx); sc[nt][i] = p; sum += p; }
        sum = fq_sum(sum);
        const float den = sum + __expf(sink - mx);
        bf16x8 pf[6];
#pragma unroll
        for (int ks = 0; ks < 6; ++ks) pf[ks] = pack8(sc[2 * ks], sc[2 * ks + 1]);
        float rden[4];
#pragma unroll
        for (int i = 0; i < 4; ++i) rden[i] = __builtin_amdgcn_rcpf(__shfl(den, 4 * fq + i));
        bf16* op = F.MIX + (row0 + tq0 + 4 * fq) * D + 512 + hq * 64 + fr;
#pragma unroll 1
        for (int dt = 0; dt < 4; ++dt) { f32x4 oacc = (f32x4){0.f, 0.f, 0.f, 0.f};
#pragma unroll
            for (int ks = 0; ks < 6; ++ks) { const LAS bf16* vp = Vt + (16 * dt + fr) * 196 + 32 * ks + 4 * fq;
                const unsigned long long lo = *(const LAS unsigned long long*)vp, hi = *(const LAS unsigned long long*)(vp + 16);
                v4u vv; vv.x = (unsigned)lo; vv.y = (unsigned)(lo >> 32); vv.z = (unsigned)hi; vv.w = (unsigned)(hi >> 32);
                oacc = __builtin_amdgcn_mfma_f32_16x16x32_bf16(pf[ks], __builtin_bit_cast(bf16x8, vv), oacc, 0, 0, 0); }
#pragma unroll
            for (int i = 0; i < 4; ++i) op[(size_t)i * D + 16 * dt] = (bf16)f2bf(oacc[i] * rden[i]); }
    }
    __syncthreads();
}
__device__ __forceinline__ void p3a_prep(Frame& F) {
    LAS unsigned char* wl = F.lds + RING_OFF + F.wave * 19456;
    const int gw = F.vcu * NWAVES + F.wave, NGW = F.G * NWAVES;
    for (int ci = gw; ci < BATCH * 8 * (T / 64); ci += NGW) gdn_prep_chunk(F, ci, wl);
}
__device__ __forceinline__ void p3b_mixers(Frame& F) {
    const int bx = blockIdx.x;
    if (bx < 32) gdn_scan(F, bx);
    else for (int u = bx - 32; u < BATCH * 2 * (T / 64); u += F.G - 32) swa_unit(F, u, F.lds + RING_OFF);
}

struct Args { const float* in[18]; float* out; unsigned char* ws; };
__global__ void __launch_bounds__(NWAVES * 64, 2) hymba_fwd(Args args) {
    extern __shared__ __attribute__((aligned(16))) unsigned char lds[];
    Frame F;
    F.lds = (LAS unsigned char*)lds;
    F.MISC = (volatile LAS unsigned*)(F.lds + MISC_OFF);
    F.tid = threadIdx.x; F.lane = F.tid & 63; F.wave = __builtin_amdgcn_readfirstlane(F.tid >> 6);
    F.G = gridDim.x; { const int bx = blockIdx.x; F.vcu = (F.G % 8 == 0) ? (bx % 8) * (F.G / 8) + bx / 8 : bx; }
    unsigned char* ws = args.ws;
    F.ctl = (gu32*)(ws + WS_CTL);
    F.x = args.in[0]; F.c = args.in[1]; F.w_ada = args.in[2]; F.b_ada = args.in[3]; F.norm1_w = args.in[4]; F.w_in = args.in[5]; F.conv_w = args.in[6];
    F.a_log = args.in[7]; F.dt_bias = args.in[8]; F.gdn_norm_w = args.in[9]; F.q_norm_w = args.in[10]; F.k_norm_w = args.in[11]; F.sinks = args.in[12];
    F.w_out = args.in[13]; F.norm2_w = args.in[14]; F.w_gate = args.in[15]; F.w_up = args.in[16]; F.w_down = args.in[17]; F.out = args.out;
    F.modacc = (float*)(ws + WS_CTL) + CW_MODACC; F.modf = (float*)(ws + WS_MODF); F.wab = (float*)(ws + WS_WAB); F.gb = (float*)(ws + WS_GB); F.gm2 = (float*)(ws + WS_GM2); F.bgu = (float*)(ws + WS_BGU); F.rowss = (float*)(ws + WS_CTL) + CW_ROWSS;
    F.Win_t = (bf16*)(ws + WS_WIN); F.Wout_t = (bf16*)(ws + WS_WOUT); F.Wgu_t = (bf16*)(ws + WS_WGU); F.Wdn_t = (bf16*)(ws + WS_WDN);
    F.H = (bf16*)(ws + WS_H); F.PQ = (bf16*)(ws + WS_PQ); F.MIX = (bf16*)(ws + WS_MIX); F.CHKA = (bf16*)(ws + WS_CHKA); F.CHKU = (bf16*)(ws + WS_H); F.CHKT = (bf16*)(ws + WS_CHKA + 32 * MiB); F.ORAW = (bf16*)(ws + WS_CHKA + 32 * MiB); F.dec = (float*)(ws + WS_DEC);
    for (int u = F.tid; u < (LDS_BYTES - LDSCTL_OFF) / 4; u += NWAVES * 64) ((LAS unsigned*)(F.lds + LDSCTL_OFF))[u] = 0u;
    __syncthreads();
    XcdBarrier bar = xcd_barrier_post((unsigned*)(F.ctl + CW_BAR), F.MISC + 8);
#define GRID_BAR() xcd_barrier(bar)

    p0_prologue(F); GRID_BAR();
    norm_phase<1>(F); GRID_BAR();
    { pg8::Gemm g{F.H, F.Win_t, M, NP, D}; pg8::StaticOrder S; S.init(M, NP, F.G, (int)blockIdx.x);
      pg8::EpiBf16Plain E{F.PQ, NP, C_GZ / 256, C_SQ / 256};
      pg8::gemm_phase<pg8::EpiBf16Plain, pg8::StaticOrder, true, true>(F.lds + RING_OFF, g, S, E); }
    GRID_BAR();
    p3a_prep(F); GRID_BAR();
    p3b_mixers(F); GRID_BAR();
    { pg8::Gemm g{F.MIX, F.Wout_t, M, D, D}; pg8::StaticOrder S; S.init(M, D, F.G, (int)blockIdx.x);
      { pg8::Unit u0; for (int i = 0; S.next(i, u0); ++i) gdn_norm_rows(F, u0.pm * 256); }
      pg8::EpiGateRes E{F.x, F.out, D, F.modf + 2 * D, 6 * D, T};
      pg8::gemm_phase<pg8::EpiGateRes, pg8::StaticOrder, true, true>(F.lds + RING_OFF, g, S, E); }
    GRID_BAR();
    norm_phase<2>(F); GRID_BAR();
    { pg8::Gemm g{F.H, F.Wgu_t, M, NGU, D}; pg8::StaticOrder S; S.init(M, NGU, F.G, (int)blockIdx.x);
      pg8::EpiSwiGLU E{F.PQ, FF};
      pg8::gemm_phase<pg8::EpiSwiGLU, pg8::StaticOrder, true, true>(F.lds + RING_OFF, g, S, E); }
    GRID_BAR();
    { pg8::Gemm g{F.PQ, F.Wdn_t, M, D, FF}; pg8::StaticOrder S; S.init(M, D, F.G, (int)blockIdx.x);
      pg8::EpiGateRes E{F.out, F.out, D, F.modf + 5 * D, 6 * D, T};
      pg8::gemm_phase<pg8::EpiGateRes, pg8::StaticOrder, true, true>(F.lds + RING_OFF, g, S, E); }
#undef GRID_BAR
}

extern "C" void kernel_launch(void* const* d_in, const int* in_sizes, int n_in, void* d_out, int out_size, void* d_ws, size_t ws_size, hipStream_t stream) {
    static int grid = 0;
    if (grid == 0) {
        if (n_in != 18 || in_sizes[0] != M * D || out_size != M * D || ws_size < WS_END) { fprintf(stderr, "kernel_launch: unexpected shapes (n_in %d, in0 %d, out %d, ws %zu); nothing launched\n", n_in, n_in > 0 ? in_sizes[0] : -1, out_size, ws_size); grid = -1; return; }
        int dev = 0, cus = 0;
        if (hipGetDevice(&dev) != hipSuccess || hipDeviceGetAttribute(&cus, hipDeviceAttributeMultiprocessorCount, dev) != hipSuccess) { grid = -1; return; }
        if (hipFuncSetAttribute((const void*)hymba_fwd, hipFuncAttributeMaxDynamicSharedMemorySize, LDS_BYTES) != hipSuccess) { fprintf(stderr, "kernel_launch: hipFuncSetAttribute failed\n"); grid = -1; return; }
        (void)hipGetLastError();
        grid = cus;
    }
    if (grid < 0) return;
    if (hipMemsetAsync((char*)d_ws + WS_CTL, 0, CTL_ZERO_BYTES, stream) != hipSuccess) { fprintf(stderr, "kernel_launch: hipMemsetAsync failed\n"); return; }
    Args a{};
    for (int i = 0; i < 18; ++i) a.in[i] = (const float*)d_in[i];
    a.out = (float*)d_out; a.ws = (unsigned char*)d_ws;
    hipLaunchKernelGGL(hymba_fwd, dim3(grid), dim3(NWAVES * 64), LDS_BYTES, stream, a);
    const hipError_t le = hipPeekAtLastError();
    if (le != hipSuccess) fprintf(stderr, "kernel_launch: launch failed: %s\n", hipGetErrorName(le));
}
```

```cpp
#include <hip/hip_runtime.h>
#include <cstdio>
#include <cstdint>
#include <cmath>
namespace pg8 {
#define PG8_LAS __attribute__((address_space(3)))
typedef unsigned short bf16_t;
typedef short bf16x8 __attribute__((ext_vector_type(8)));
typedef float f32x4 __attribute__((ext_vector_type(4)));
typedef unsigned u32x4 __attribute__((ext_vector_type(4)));
constexpr int BM = 256, BK = 64, HALF = 128, HTB = HALF * BK * 2  , STAGE_BYTES = 8 * HTB, NXCD = 8, WGM = 8;

__host__ __device__ __forceinline__ int lds_byte(int r, int c) { const int st = (r >> 4) * 2 + (c >> 5), rr = r & 15, cc = c & 31, ob = rr * 64 + cc * 2; return st * 1024 + (ob ^ (((ob >> 9) & 1) << 5)); }
__host__ __device__ __forceinline__ void stage_rc(int b, int& R, int& C) { const int st = b / 1024, sb = b % 1024, swz = sb ^ (((sb >> 9) & 1) << 5); R = (st >> 1) * 16 + swz / 64; C = (st & 1) * 32 + (swz % 64) / 2; }
__host__ __device__ __forceinline__ int perm32(int rho) { const int n = rho >> 4, i = rho & 15; return 8 * (i >> 2) + 4 * n + (i & 3); }

struct Unit { int pm, pn; };
struct Gemm { const bf16_t* A; const bf16_t* Bt; int M, N, K; };

struct StaticOrder {
    int nM, nN, nwg, G, c;
    __host__ __device__ void init(int M, int N, int G_, int c_) { nM = M / BM; nN = N / BM; nwg = nM * nN; G = G_; c = c_; }
    __host__ __device__ bool next(int i, Unit& u) const {
        const long L = (long)i * G + c; if (L >= nwg) return false;
        int wgid = (int)L; { const int q = nwg / NXCD, r = nwg % NXCD, xcd = wgid % NXCD, off = wgid / NXCD; wgid = (xcd < r ? xcd * (q + 1) : r * (q + 1) + (xcd - r) * q) + off; }
        const int nig = WGM * nN, gid = wgid / nig, fm = gid * WGM, gsz = (nM - fm) < WGM ? (nM - fm) : WGM;
        u.pm = fm + ((wgid % nig) % gsz); u.pn = (wgid % nig) / gsz; return true;
    }
    __device__ __forceinline__ void a_ready(const Unit&) const {}
    __device__ __forceinline__ void done(const Unit&) const {}
};

__device__ __forceinline__ unsigned cvt_pk_bf16(float lo, float hi) { unsigned r; asm volatile("v_cvt_pk_bf16_f32 %0, %1, %2" : "=v"(r) : "v"(lo), "v"(hi)); return r; }
__device__ __forceinline__ float silu_f(float x) { return x * __builtin_amdgcn_rcpf(1.0f + __expf(-x)); }

struct EpiBf16Plain {
    static constexpr bool PERM = true, AFTER_DRAIN = false;
    bf16_t* O; int ldc; int silu_lo, silu_hi;
    __device__ __forceinline__ void operator()(const f32x4 (&acc)[2][2][4][2], const Unit& u, int wr, int wc, int fr, int fq) const {
        const int row0 = u.pm * BM + wr * 64 + fr, col0 = u.pn * BM + wc * 32 + 8 * fq;
        const bool act = (u.pn >= silu_lo) && (u.pn < silu_hi);
#pragma unroll
        for (int ai = 0; ai < 2; ++ai)
#pragma unroll
            for (int m = 0; m < 4; ++m) { bf16_t* rowp = O + (size_t)(row0 + ai * HALF + m * 16) * ldc + col0;
#pragma unroll
                for (int bj = 0; bj < 2; ++bj) { f32x4 v0 = acc[ai][bj][m][0], v1 = acc[ai][bj][m][1];
                    if (act) {
#pragma unroll
                        for (int i = 0; i < 4; ++i) { v0[i] = silu_f(v0[i]); v1[i] = silu_f(v1[i]); } }
                    u32x4 w; w.x = cvt_pk_bf16(v0[0], v0[1]); w.y = cvt_pk_bf16(v0[2], v0[3]); w.z = cvt_pk_bf16(v1[0], v1[1]); w.w = cvt_pk_bf16(v1[2], v1[3]);
                    *(u32x4*)(rowp + bj * HALF) = w; } }
    }
};
struct EpiSwiGLU {
    static constexpr bool PERM = true, AFTER_DRAIN = false;
    bf16_t* O; int ldc;
    __device__ __forceinline__ void operator()(const f32x4 (&acc)[2][2][4][2], const Unit& u, int wr, int wc, int fr, int fq) const {
        const int row0 = u.pm * BM + wr * 64 + fr, col0 = u.pn * HALF + wc * 32 + 8 * fq;
#pragma unroll
        for (int ai = 0; ai < 2; ++ai)
#pragma unroll
            for (int m = 0; m < 4; ++m) { bf16_t* rowp = O + (size_t)(row0 + ai * HALF + m * 16) * ldc + col0;
                const f32x4 g0 = acc[ai][0][m][0], g1 = acc[ai][0][m][1], u0 = acc[ai][1][m][0], u1 = acc[ai][1][m][1];
                float a[8];
#pragma unroll
                for (int i = 0; i < 4; ++i) { a[i] = silu_f(g0[i]) * u0[i]; a[4 + i] = silu_f(g1[i]) * u1[i]; }
                u32x4 w; w.x = cvt_pk_bf16(a[0], a[1]); w.y = cvt_pk_bf16(a[2], a[3]); w.z = cvt_pk_bf16(a[4], a[5]); w.w = cvt_pk_bf16(a[6], a[7]);
                *(u32x4*)rowp = w; }
    }
};
struct EpiGateRes {
    static constexpr bool PERM = false, AFTER_DRAIN = false;
    const float* base; float* out; int ldc; const float* gate; int gstride; int rows_per_batch;
    __device__ __forceinline__ void operator()(const f32x4 (&acc)[2][2][4][2], const Unit& u, int wr, int wc, int fr, int fq) const {
        const int row0 = u.pm * BM + wr * 64 + fr, col0 = u.pn * BM + wc * 32 + 4 * fq;
        const float* gp = gate + (size_t)((u.pm * BM) / rows_per_batch) * gstride + col0;
        f32x4 gv[2][2];
#pragma unroll
        for (int bj = 0; bj < 2; ++bj)
#pragma unroll
            for (int n = 0; n < 2; ++n) gv[bj][n] = *(const f32x4*)(gp + bj * HALF + n * 16);
#pragma unroll
        for (int ai = 0; ai < 2; ++ai)
#pragma unroll
            for (int m = 0; m < 4; ++m) { const size_t off = (size_t)(row0 + ai * HALF + m * 16) * ldc + col0;
#pragma unroll
                for (int bj = 0; bj < 2; ++bj)
#pragma unroll
                    for (int n = 0; n < 2; ++n) { const f32x4 bs = *(const f32x4*)(base + off + bj * HALF + n * 16);
                        *(f32x4*)(out + off + bj * HALF + n * 16) = bs + gv[bj][n] * acc[ai][bj][m][n]; } }
    }
};
struct EpiGateResToBf16 {
    static constexpr bool PERM = false, AFTER_DRAIN = false;
    const float* base; bf16_t* out; int ldc; const float* gate; int gstride; int rows_per_batch;
    __device__ __forceinline__ void operator()(const f32x4 (&acc)[2][2][4][2], const Unit& u, int wr, int wc, int fr, int fq) const {
        const int row0 = u.pm * BM + wr * 64 + fr, col0 = u.pn * BM + wc * 32 + 4 * fq;
        const float* gp = gate + (size_t)((u.pm * BM) / rows_per_batch) * gstride + col0;
        f32x4 gv[2][2];
#pragma unroll
        for (int bj = 0; bj < 2; ++bj)
#pragma unroll
            for (int n = 0; n < 2; ++n) gv[bj][n] = *(const f32x4*)(gp + bj * HALF + n * 16);
#pragma unroll
        for (int ai = 0; ai < 2; ++ai)
#pragma unroll
            for (int m = 0; m < 4; ++m) { const size_t off = (size_t)(row0 + ai * HALF + m * 16) * ldc + col0;
#pragma unroll
                for (int bj = 0; bj < 2; ++bj)
#pragma unroll
                    for (int n = 0; n < 2; ++n) { const f32x4 o = *(const f32x4*)(base + off + bj * HALF + n * 16) + gv[bj][n] * acc[ai][bj][m][n];
                        *(unsigned long long*)(out + off + bj * HALF + n * 16) = (unsigned long long)cvt_pk_bf16(o[0], o[1]) | ((unsigned long long)cvt_pk_bf16(o[2], o[3]) << 32); } }
    }
};
struct EpiGateResFromBf16 {
    static constexpr bool PERM = false, AFTER_DRAIN = false;
    const bf16_t* base; float* out; int ldc; const float* gate; int gstride; int rows_per_batch;
    __device__ __forceinline__ void operator()(const f32x4 (&acc)[2][2][4][2], const Unit& u, int wr, int wc, int fr, int fq) const {
        const int row0 = u.pm * BM + wr * 64 + fr, col0 = u.pn * BM + wc * 32 + 4 * fq;
        const float* gp = gate + (size_t)((u.pm * BM) / rows_per_batch) * gstride + col0;
        f32x4 gv[2][2];
#pragma unroll
        for (int bj = 0; bj < 2; ++bj)
#pragma unroll
            for (int n = 0; n < 2; ++n) gv[bj][n] = *(const f32x4*)(gp + bj * HALF + n * 16);
#pragma unroll
        for (int ai = 0; ai < 2; ++ai)
#pragma unroll
            for (int m = 0; m < 4; ++m) { const size_t off = (size_t)(row0 + ai * HALF + m * 16) * ldc + col0;
#pragma unroll
                for (int bj = 0; bj < 2; ++bj)
#pragma unroll
                    for (int n = 0; n < 2; ++n) { const unsigned long long bb = *(const unsigned long long*)(base + off + bj * HALF + n * 16); const unsigned lo = (unsigned)bb, hi = (unsigned)(bb >> 32);
                        const f32x4 bs = (f32x4){__uint_as_float(lo << 16), __uint_as_float(lo & 0xffff0000u), __uint_as_float(hi << 16), __uint_as_float(hi & 0xffff0000u)};
                        *(f32x4*)(out + off + bj * HALF + n * 16) = bs + gv[bj][n] * acc[ai][bj][m][n]; } }
    }
};

struct PanelRms {
    unsigned* xbuf;
    unsigned* cnt;
    unsigned* tmo;
    int ntn; unsigned code;
    __device__ __forceinline__ bool run(const f32x4 (&v)[2][2][4][2], const Unit& u, int wr, int wc, int fr, int fq, PG8_LAS unsigned char* lds, int wid, int lane) const {
        PG8_LAS float* P = (PG8_LAS float*)lds;
        PG8_LAS float* S = (PG8_LAS float*)(lds + 4096);
        PG8_LAS unsigned* flag = (PG8_LAS unsigned*)(lds + 4096 + 1024);
#pragma unroll
        for (int ai = 0; ai < 2; ++ai)
#pragma unroll
            for (int m = 0; m < 4; ++m) { float s = 0.f;
#pragma unroll
                for (int bj = 0; bj < 2; ++bj)
#pragma unroll
                    for (int n = 0; n < 2; ++n) { const f32x4 x = v[ai][bj][m][n]; s += (x[0] * x[0] + x[1] * x[1]) + (x[2] * x[2] + x[3] * x[3]); }
                s += __shfl_xor(s, 16); s += __shfl_xor(s, 32);
                if (fq == 0) P[(ai * HALF + wr * 64 + m * 16 + fr) * 4 + wc] = s; }
        asm volatile("s_waitcnt lgkmcnt(0)" ::: "memory"); __builtin_amdgcn_s_barrier(); asm volatile("" ::: "memory");
        const int row = wid * 32 + (lane & 31);
        if (lane < 32) { const float t = (P[row * 4 + 0] + P[row * 4 + 1]) + (P[row * 4 + 2] + P[row * 4 + 3]);
            __hip_atomic_store(xbuf + ((size_t)(u.pm * BM + row) * 4 + u.pn), __float_as_uint(t), __ATOMIC_RELAXED, __HIP_MEMORY_SCOPE_AGENT); }
        asm volatile("s_waitcnt vmcnt(0)" ::: "memory");
        if (lane == 0) __hip_atomic_fetch_add(cnt + 64 * u.pm, 1u, __ATOMIC_RELAXED, __HIP_MEMORY_SCOPE_AGENT);
        if (wid == 0) {
            bool dead = false; const unsigned long long t0 = __builtin_amdgcn_s_memrealtime(); const unsigned want = 8u * (unsigned)ntn;
            for (;;) {
                if ((unsigned)__builtin_amdgcn_readfirstlane(__hip_atomic_load(cnt + 64 * u.pm, __ATOMIC_RELAXED, __HIP_MEMORY_SCOPE_AGENT)) >= want) break;
                if (__builtin_amdgcn_s_memrealtime() - t0 > 2000000ull) {
                    if (lane == 0) { unsigned expect = 0u; __hip_atomic_compare_exchange_strong(tmo + 1, &expect, code | (unsigned)(u.pm & 0xff), __ATOMIC_RELAXED, __ATOMIC_RELAXED, __HIP_MEMORY_SCOPE_AGENT);
                                     __hip_atomic_store(tmo, 1u, __ATOMIC_RELAXED, __HIP_MEMORY_SCOPE_AGENT); }
                    dead = true; break; }
                __builtin_amdgcn_s_sleep(2);
            }
            __builtin_amdgcn_fence(__ATOMIC_ACQUIRE, "agent");
            if (lane == 0) flag[0] = dead ? 1u : 0u;
        }
        asm volatile("s_waitcnt vmcnt(0) lgkmcnt(0)" ::: "memory"); __builtin_amdgcn_s_barrier(); asm volatile("" ::: "memory");
        const bool bad = flag[0] != 0u;
        if (lane < 32) { const unsigned* slot = xbuf + (size_t)(u.pm * BM + row) * 4; float t = 0.f;
#pragma unroll
            for (int k = 0; k < 4; ++k) if (k < ntn) t += __uint_as_float(__hip_atomic_load(slot + k, __ATOMIC_RELAXED, __HIP_MEMORY_SCOPE_AGENT));
            S[row] = t; }
        asm volatile("s_waitcnt lgkmcnt(0)" ::: "memory"); __builtin_amdgcn_s_barrier(); asm volatile("" ::: "memory");
        return bad;
    }
};
struct EpiGateResRms {
    static constexpr bool PERM = false, AFTER_DRAIN = true;
    const float* base; float* out; int ldc; const float* gate; const float* gm; const float* sh; int gstride, mstride; int rows_per_batch; bf16_t* xg; PanelRms st; float inv_n, eps;
    __device__ __forceinline__ void fused(f32x4 (&acc)[2][2][4][2], const Unit& u, int wr, int wc, int fr, int fq, PG8_LAS unsigned char* lds, int wid, int lane) const {
        const PG8_LAS float* S = (const PG8_LAS float*)(lds + 4096);
        const int row0 = u.pm * BM + wr * 64 + fr, col0 = u.pn * BM + wc * 32 + 4 * fq, b = (u.pm * BM) / rows_per_batch;
        {
            const float* gp = gate + (size_t)b * gstride + col0;
#pragma unroll
            for (int bj = 0; bj < 2; ++bj)
#pragma unroll
                for (int n = 0; n < 2; ++n) { const f32x4 gv = *(const f32x4*)(gp + bj * HALF + n * 16);
#pragma unroll
                    for (int ai = 0; ai < 2; ++ai)
#pragma unroll
                        for (int m = 0; m < 4; ++m) { const size_t off = (size_t)(row0 + ai * HALF + m * 16) * ldc + col0 + bj * HALF + n * 16;
                            const f32x4 o = *(const f32x4*)(base + off) + gv * acc[ai][bj][m][n]; acc[ai][bj][m][n] = o; *(f32x4*)(out + off) = o; }
                    asm volatile("" ::: "memory"); }
        }
        const bool bad = st.run(acc, u, wr, wc, fr, fq, lds, wid, lane);
        const float* mp = gm + (size_t)b * mstride + col0; const float* sp = sh + (size_t)b * gstride + col0;
#pragma unroll
        for (int bj = 0; bj < 2; ++bj)
#pragma unroll
            for (int n = 0; n < 2; ++n) { const f32x4 mv = *(const f32x4*)(mp + bj * HALF + n * 16), sv = *(const f32x4*)(sp + bj * HALF + n * 16);
#pragma unroll
                for (int ai = 0; ai < 2; ++ai)
#pragma unroll
                    for (int m = 0; m < 4; ++m) { const int r = ai * HALF + wr * 64 + m * 16 + fr; const float rs = __builtin_amdgcn_rsqf(S[r] * inv_n + eps);
                        const f32x4 h = acc[ai][bj][m][n] * rs * mv + sv;
                        unsigned long long w = (unsigned long long)cvt_pk_bf16(h[0], h[1]) | ((unsigned long long)cvt_pk_bf16(h[2], h[3]) << 32);
                        if (bad) w = 0x7fc07fc07fc07fc0ull;
                        *(unsigned long long*)(xg + (size_t)(u.pm * BM + r) * ldc + col0 + bj * HALF + n * 16) = w; } }
    }
};

template <class Epi, class Sched, bool ALIGN_EPI = false, bool SP2 = false>
__device__ __forceinline__ void gemm_phase(PG8_LAS unsigned char* lds, const Gemm g, const Sched& S, const Epi& E) {
    int tid_ = threadIdx.x; asm volatile("" : "+v"(tid_));
    const int tid = tid_, wid = __builtin_amdgcn_readfirstlane(tid >> 6), lane = tid & 63, wr = wid >> 2, wc = wid & 3, fr = lane & 15, fq = lane >> 4;
    const int K = g.K, nt = K / BK;
    unsigned voffA[2], voffB[2];
#pragma unroll
    for (int i = 0; i < 2; ++i) { int R, C; stage_rc(tid * 16 + i * 8192, R, C); const int Rb = Epi::PERM ? ((R & ~31) + perm32(R & 31)) : R;
        voffA[i] = (unsigned)(R * K + C) * 2u; voffB[i] = (unsigned)(Rb * K + C) * 2u; }
    const size_t kstep = (size_t)(BK * 2);
    const size_t hstep = (size_t)HALF * K * 2;
    const size_t tstep = 2 * hstep;
    const unsigned ldsw = (unsigned)wid * 1024u;
    const int aoff = lds_byte(wr * 64 + fr, fq * 8), boff = lds_byte(wc * 32 + fr, fq * 8);
#define PG8_SA(b, h) (((b) * 2 + (h)) * HTB)
#define PG8_SB(b, h) ((4 + (b) * 2 + (h)) * HTB)
#define PG8_STAGE(bufoff, gbase, voff) do { _Pragma("unroll") for (int _i = 0; _i < 2; ++_i) \
        __builtin_amdgcn_global_load_lds((const unsigned*)((const char*)(gbase) + (voff)[_i]), (PG8_LAS unsigned*)(lds + (bufoff) + ldsw + _i * 8192), 16, 0, 0); } while (0)
#define PG8_LDA(dst, b, h) do { _Pragma("unroll") for (int m = 0; m < 4; ++m) _Pragma("unroll") for (int k = 0; k < 2; ++k) dst[m][k] = *(const PG8_LAS bf16x8*)(lds + PG8_SA(b, h) + aoff + m * 2048 + k * 1024); } while (0)
#define PG8_LDB(dst, b, h) do { _Pragma("unroll") for (int n = 0; n < 2; ++n) _Pragma("unroll") for (int k = 0; k < 2; ++k) dst[n][k] = *(const PG8_LAS bf16x8*)(lds + PG8_SB(b, h) + boff + n * 2048 + k * 1024); } while (0)
#define PG8_MMA(ai, bj, At, Bt) do { __builtin_amdgcn_s_setprio(1); _Pragma("unroll") for (int m = 0; m < 4; ++m) _Pragma("unroll") for (int n = 0; n < 2; ++n) _Pragma("unroll") for (int k = 0; k < 2; ++k) \
        acc[ai][bj][m][n] = __builtin_amdgcn_mfma_f32_16x16x32_bf16(Bt[n][k], At[m][k], acc[ai][bj][m][n], 0, 0, 0); __builtin_amdgcn_s_setprio(0); } while (0)
#define PG8_WAIT_V(n) asm volatile("s_waitcnt vmcnt(" #n ")" ::: "memory")
#define PG8_WAIT_L(n) asm volatile("s_waitcnt lgkmcnt(" #n ")" ::: "memory")
#define PG8_BAR __builtin_amdgcn_s_barrier()
#define PG8_SCHED __builtin_amdgcn_sched_barrier(0)
    Unit cur, nxt; int ui = 0;
    if (!S.next(0, cur)) return;
    f32x4 acc[2][2][4][2];
#pragma unroll
    for (int a = 0; a < 2; ++a)
#pragma unroll
        for (int b = 0; b < 2; ++b)
#pragma unroll
            for (int m = 0; m < 4; ++m)
#pragma unroll
                for (int n = 0; n < 2; ++n) acc[a][b][m][n] = (f32x4){0.f, 0.f, 0.f, 0.f};
    bf16x8 At[4][2], B0[2][2], B1[2][2];
    const char* cA = (const char*)g.A + (size_t)cur.pm * tstep; const char* cB = (const char*)g.Bt + (size_t)cur.pn * tstep;
    S.a_ready(cur);
    if constexpr (SP2) {
        PG8_STAGE(PG8_SB(0, 0), cB, voffB); PG8_STAGE(PG8_SB(0, 1), cB + hstep, voffB); PG8_STAGE(PG8_SA(0, 0), cA, voffA); PG8_STAGE(PG8_SA(0, 1), cA + hstep, voffA);
        if (wr == 1) PG8_BAR;
        PG8_WAIT_V(2); PG8_BAR;
        PG8_STAGE(PG8_SB(1, 0), cB + kstep, voffB); PG8_STAGE(PG8_SA(1, 0), cA + kstep, voffA); PG8_STAGE(PG8_SB(1, 1), cB + hstep + kstep, voffB);
        PG8_WAIT_V(6); PG8_BAR;
    } else {
        PG8_STAGE(PG8_SB(0, 0), cB, voffB); PG8_STAGE(PG8_SA(0, 0), cA, voffA); PG8_STAGE(PG8_SB(0, 1), cB + hstep, voffB); PG8_STAGE(PG8_SA(0, 1), cA + hstep, voffA);
        if (wr == 1) PG8_BAR;
        PG8_WAIT_V(4); PG8_BAR;
        PG8_STAGE(PG8_SB(1, 0), cB + kstep, voffB); PG8_STAGE(PG8_SA(1, 0), cA + kstep, voffA); PG8_STAGE(PG8_SB(1, 1), cB + hstep + kstep, voffB);
        PG8_WAIT_V(6); PG8_BAR;
    }
    for (;;) {
        const bool has_next = S.next(ui + 1, nxt);
        const char* nA = has_next ? (const char*)g.A + (size_t)nxt.pm * tstep : cA; const char* nB = has_next ? (const char*)g.Bt + (size_t)nxt.pn * tstep : cB;
        for (int t = 0; t < nt; t += 2) {
            const bool last = (t == nt - 2);
            const char* a1 = cA + (size_t)(t + 1) * kstep;
            const char* a2 = last ? nA : cA + (size_t)(t + 2) * kstep; const char* b2 = last ? nB : cB + (size_t)(t + 2) * kstep;
            const char* a3 = a2 + kstep; const char* b3 = b2 + kstep;
            if (last && has_next) S.a_ready(nxt);
            if constexpr (SP2) {
            PG8_LDB(B0, 0, 0); PG8_LDB(B1, 0, 1); PG8_SCHED; PG8_LDA(At, 0, 0); PG8_STAGE(PG8_SA(1, 1), a1 + hstep, voffA);
            PG8_WAIT_V(8); PG8_WAIT_L(0); PG8_BAR; PG8_MMA(0, 0, At, B0); PG8_MMA(0, 1, At, B1); PG8_BAR; PG8_SCHED;
            PG8_LDA(At, 0, 1); PG8_STAGE(PG8_SB(0, 0), b2, voffB); PG8_STAGE(PG8_SB(0, 1), b2 + hstep, voffB); PG8_STAGE(PG8_SA(0, 0), a2, voffA);
            PG8_WAIT_V(8); PG8_WAIT_L(0); PG8_BAR; PG8_MMA(1, 0, At, B0); PG8_MMA(1, 1, At, B1); PG8_BAR; PG8_SCHED;
            PG8_LDB(B0, 1, 0); PG8_LDB(B1, 1, 1); PG8_SCHED; PG8_LDA(At, 1, 0); PG8_STAGE(PG8_SA(0, 1), a2 + hstep, voffA);
            PG8_WAIT_V(8); PG8_WAIT_L(0); PG8_BAR; PG8_MMA(0, 0, At, B0); PG8_MMA(0, 1, At, B1); PG8_BAR; PG8_SCHED;
            PG8_LDA(At, 1, 1); PG8_STAGE(PG8_SB(1, 0), b3, voffB); PG8_STAGE(PG8_SB(1, 1), b3 + hstep, voffB); PG8_STAGE(PG8_SA(1, 0), a3, voffA);
            PG8_WAIT_V(8); PG8_WAIT_L(0); PG8_BAR; PG8_MMA(1, 0, At, B0); PG8_MMA(1, 1, At, B1); PG8_BAR; PG8_SCHED;
            } else {
            PG8_LDB(B0, 0, 0); PG8_SCHED; PG8_LDA(At, 0, 0); PG8_STAGE(PG8_SA(1, 1), a1 + hstep, voffA);
            PG8_WAIT_L(8); PG8_BAR; PG8_WAIT_L(0); PG8_MMA(0, 0, At, B0); PG8_BAR; PG8_SCHED;
            PG8_LDB(B1, 0, 1); PG8_STAGE(PG8_SB(0, 0), b2, voffB);
            PG8_BAR; PG8_WAIT_L(0); PG8_MMA(0, 1, At, B1); PG8_BAR;
            PG8_LDA(At, 0, 1); PG8_STAGE(PG8_SA(0, 0), a2, voffA);
            PG8_BAR; PG8_WAIT_L(0); PG8_MMA(1, 0, At, B0); PG8_BAR; PG8_SCHED;
            PG8_STAGE(PG8_SB(0, 1), b2 + hstep, voffB);
            PG8_WAIT_V(6); PG8_BAR; PG8_MMA(1, 1, At, B1); PG8_BAR;
            PG8_LDB(B0, 1, 0); PG8_SCHED; PG8_LDA(At, 1, 0); PG8_STAGE(PG8_SA(0, 1), a2 + hstep, voffA);
            PG8_WAIT_L(8); PG8_BAR; PG8_WAIT_L(0); PG8_MMA(0, 0, At, B0); PG8_BAR; PG8_SCHED;
            PG8_LDB(B1, 1, 1); PG8_STAGE(PG8_SB(1, 0), b3, voffB);
            PG8_BAR; PG8_WAIT_L(0); PG8_MMA(0, 1, At, B1); PG8_BAR;
            PG8_LDA(At, 1, 1); PG8_STAGE(PG8_SA(1, 0), a3, voffA);
            PG8_BAR; PG8_WAIT_L(0); PG8_MMA(1, 0, At, B0); PG8_BAR; PG8_SCHED;
            PG8_STAGE(PG8_SB(1, 1), b3 + hstep, voffB);
            PG8_WAIT_V(6); PG8_BAR; PG8_MMA(1, 1, At, B1); PG8_BAR;
            }
        }
        if constexpr (ALIGN_EPI) { if (wr == 0) PG8_BAR; }
        if constexpr (!Epi::AFTER_DRAIN) { E(acc, cur, wr, wc, fr, fq); S.done(cur); }
        if (!has_next) break;
#pragma unroll
        for (int a = 0; a < 2; ++a)
#pragma unroll
            for (int b = 0; b < 2; ++b)
#pragma unroll
                for (int m = 0; m < 4; ++m)
#pragma unroll
                    for (int n = 0; n < 2; ++n) acc[a][b][m][n] = (f32x4){0.f, 0.f, 0.f, 0.f};
        cur = nxt; cA = nA; cB = nB; ++ui;
        if constexpr (ALIGN_EPI) { if (wr == 1) PG8_BAR; }
    }
    PG8_WAIT_V(0);
    if constexpr (!ALIGN_EPI) { if (wr == 0) PG8_BAR; }
    PG8_BAR;
    if constexpr (Epi::AFTER_DRAIN) { E.fused(acc, cur, wr, wc, fr, fq, lds, wid, lane); S.done(cur); }
#undef PG8_SA
#undef PG8_SB
#undef PG8_STAGE
#undef PG8_LDA
#undef PG8_LDB
#undef PG8_MMA
#undef PG8_WAIT_V
#undef PG8_WAIT_L
#undef PG8_BAR
#undef PG8_SCHED
}
}
constexpr int NWAVES = 8;
constexpr int BATCH = 4, T = 4096, D = 1024, M = BATCH * T;
constexpr int PROJ_W = 2832, NP = 2816, FF = 2816, NGU = 2 * FF, HD = 64;
constexpr int C_GQ = 0, C_GK = 512, C_GV = 1024, C_GZ = 1536, C_SQ = 2048, C_SK = 2560, C_SV = 2688;
constexpr float EPS = 1e-6f;
constexpr size_t MiB = 1u << 20;
constexpr size_t WS_CTL = 0, CTL_ZERO_BYTES = 256 * 1024;
constexpr size_t WS_MODF = 1 * MiB;
constexpr size_t WS_WAB = 1 * MiB + 256 * 1024;
constexpr size_t WS_GB = 2 * MiB;
constexpr size_t WS_WIN = 4 * MiB, WS_WOUT = 10 * MiB, WS_WGU = 12 * MiB, WS_WDN = 24 * MiB;
constexpr size_t WS_H = 32 * MiB;
constexpr size_t WS_PQ = 64 * MiB;
constexpr size_t WS_MIX = 160 * MiB;
constexpr size_t WS_CHKA = 192 * MiB;
constexpr size_t WS_DEC = 1 * MiB + 384 * 1024;
constexpr size_t WS_XBUF = 1 * MiB + 600 * 1024;
constexpr size_t WS_GM2 = 1 * MiB + 400 * 1024;
constexpr size_t WS_BGU = 1 * MiB + 448 * 1024;
constexpr size_t WS_END = 256 * MiB;
constexpr int CW_BAR = 4096;
constexpr int CW_PANEL = 49152;
constexpr int CW_ROWSS = 65536;
constexpr int CW_MODACC = 16384;
constexpr int RING_OFF = 0, RING_BYTES = 131072;
constexpr int LDS_BYTES = 163840;
constexpr int LDSCTL_OFF = LDS_BYTES - 1024, MISC_OFF = LDSCTL_OFF + 320;
#define GAS __attribute__((address_space(1)))
#define LAS __attribute__((address_space(3)))
typedef unsigned short bf16;
typedef unsigned v4u __attribute__((ext_vector_type(4)));
typedef float f32x4 __attribute__((ext_vector_type(4)));
typedef short bf16x8 __attribute__((ext_vector_type(8)));
typedef GAS unsigned gu32;
typedef GAS unsigned long long gu64;
#define RLX_AGENT __ATOMIC_RELAXED, __HIP_MEMORY_SCOPE_AGENT
#define LDS_WAIT() asm volatile("s_waitcnt lgkmcnt(0)" ::: "memory")
#define VM_WAIT() asm volatile("s_waitcnt vmcnt(0)" ::: "memory")
__device__ __forceinline__ unsigned long long rt() { return __builtin_amdgcn_s_memrealtime(); }
__device__ __forceinline__ unsigned f2bf(float f) { unsigned u = __builtin_bit_cast(unsigned, f); return (u + 0x7fffu + ((u >> 16) & 1u)) >> 16; }
__device__ __forceinline__ unsigned pk2(float lo, float hi) { return f2bf(lo) | (f2bf(hi) << 16); }

#define XB_TMO      128
#define XB_XCNT(j)  (256  + 64 * (j))
#define XB_XSUB(j)  (1280 + 64 * (j))
#define XB_XGEN(j)  (2304 + 64 * (j))
#define XB_TOP      3328
#define XB_TOPGEN   3392
#define XCD_BAR_WORDS 3456
#define XB_SPIN_CAP (1u << 22)

__device__ __forceinline__ unsigned xb_ld(unsigned* p)              { return __hip_atomic_load(p, __ATOMIC_RELAXED, __HIP_MEMORY_SCOPE_AGENT); }
__device__ __forceinline__ unsigned xb_add(unsigned* p, unsigned v) { return __hip_atomic_fetch_add(p, v, __ATOMIC_RELAXED, __HIP_MEMORY_SCOPE_AGENT); }
__device__ __forceinline__ unsigned xb_xcc_id() { return (unsigned)__builtin_amdgcn_s_getreg((3 << 11) | 20) & 0xFu; }
#define XB_SPIN(cond, bar) do { unsigned _sp = 0; while (cond) { __builtin_amdgcn_s_sleep(1); \
    if ((++_sp & 255u) == 0u) { if (xb_ld(&(bar)[XB_TMO])) break; if (_sp > XB_SPIN_CAP) { atomicAdd(&(bar)[XB_TMO], 1u); break; } } } } while (0)

struct XcdBarrier {
    unsigned* bar; unsigned x;
    volatile LAS unsigned* st;
};

__device__ __forceinline__ XcdBarrier xcd_barrier_post(unsigned* bar, volatile LAS unsigned* st) {
    XcdBarrier b; b.bar = bar; b.x = xb_xcc_id(); b.st = st;
    if (threadIdx.x == 0) (void)xb_add(&bar[XB_XCNT(b.x)], 1u);
    return b;
}
__device__ __forceinline__ void xcd_barrier_complete(unsigned* bar, unsigned x, unsigned& nloc, unsigned& nx) {
    const unsigned G = gridDim.x * gridDim.y * gridDim.z;
    unsigned sum, cnt, mine, sp = 0u;
    for (;;) {
        sum = 0u; cnt = 0u; mine = 0u;
#pragma unroll
        for (unsigned j = 0; j < 16; ++j) { const unsigned c = xb_ld(&bar[XB_XCNT(j)]); sum += c; cnt += (c > 0u) ? 1u : 0u; mine = (j == x) ? c : mine; }
        if (sum == G) break;
        __builtin_amdgcn_s_sleep(1);
        if ((++sp & 255u) == 0u) { if (xb_ld(&bar[XB_TMO])) break; if (sp > XB_SPIN_CAP) { atomicAdd(&bar[XB_TMO], 1u); break; } }
    }
    nloc = mine > 0u ? mine : 1u; nx = cnt > 0u ? cnt : 1u;
}

__device__ __forceinline__ void xcd_barrier(const XcdBarrier& b) {
    asm volatile("s_waitcnt vmcnt(0)" ::: "memory");
    __syncthreads();
    if (threadIdx.x == 0) {
        unsigned* bar = b.bar;
        __builtin_amdgcn_s_waitcnt(0);
        unsigned nloc = b.st[0], nx = b.st[1];
        if (nloc == 0u) { xcd_barrier_complete(bar, b.x, nloc, nx); b.st[0] = nloc; b.st[1] = nx; }
        const unsigned old = xb_add(&bar[XB_XSUB(b.x)], 1u);
        const unsigned gen = old / nloc;
        if (old + 1u == (gen + 1u) * nloc) {
            __builtin_amdgcn_fence(__ATOMIC_RELEASE, "agent");
            asm volatile("s_waitcnt vmcnt(0)" ::: "memory");
            const unsigned og = xb_add(&bar[XB_TOP], 1u);
            const unsigned tg = og / nx;
            if (og + 1u == (tg + 1u) * nx) xb_add(&bar[XB_TOPGEN], 1u);
            else XB_SPIN(xb_ld(&bar[XB_TOPGEN]) == tg, bar);
            __builtin_amdgcn_fence(__ATOMIC_ACQUIRE, "agent");
            xb_add(&bar[XB_XGEN(b.x)], 1u);
            asm volatile("s_waitcnt vmcnt(0)" ::: "memory");
        } else {
            XB_SPIN(xb_ld(&bar[XB_XGEN(b.x)]) == gen, bar);
            __builtin_amdgcn_fence(__ATOMIC_ACQUIRE, "agent");
            asm volatile("s_waitcnt vmcnt(0)" ::: "memory");
        }
    }
    __syncthreads();
}
struct Frame {
    LAS unsigned char* lds;
    volatile LAS unsigned* MISC;
    gu32* ctl;
    int tid, lane, wave;
    int vcu, G;
    const float *x, *c, *w_ada, *b_ada, *norm1_w, *w_in, *conv_w, *a_log, *dt_bias, *gdn_norm_w, *q_norm_w, *k_norm_w, *sinks, *w_out, *norm2_w, *w_gate, *w_up, *w_down;
    float* out;
    float *modacc, *modf, *wab, *gb, *gm2, *bgu, *rowss, *dec;
    bf16 *Win_t, *Wout_t, *Wgu_t, *Wdn_t, *H, *PQ, *MIX, *X1B, *CHKA, *CHKU, *CHKT, *ORAW;
};
template <int CTRL, int ROWMASK, bool BC>
__device__ __forceinline__ float dpp_mov(float v) { return __int_as_float(__builtin_amdgcn_update_dpp(0, __float_as_int(v), CTRL, ROWMASK, 0xF, BC)); }
__device__ __forceinline__ float sum8(float v) { v += dpp_mov<0xB1, 0xF, true>(v); v += dpp_mov<0x4E, 0xF, true>(v); v += dpp_mov<0x141, 0xF, true>(v); return v; }
__device__ __forceinline__ float wave_sum(float v) {
    v = sum8(v); v += dpp_mov<0x140, 0xF, true>(v);
    v += dpp_mov<0x142, 0xA, false>(v); v += dpp_mov<0x143, 0xC, false>(v);
    return __int_as_float(__builtin_amdgcn_readlane(__float_as_int(v), 63));
}
__device__ __forceinline__ float fq_sum(float v) {
    auto r = __builtin_amdgcn_permlane16_swap(__float_as_uint(v), __float_as_uint(v), false, false); v = __uint_as_float(r[0]) + __uint_as_float(r[1]);
    auto s = __builtin_amdgcn_permlane32_swap(__float_as_uint(v), __float_as_uint(v), false, false); return __uint_as_float(s[0]) + __uint_as_float(s[1]);
}
__device__ __forceinline__ float fq_max(float v) {
    auto r = __builtin_amdgcn_permlane16_swap(__float_as_uint(v), __float_as_uint(v), false, false); v = fmaxf(__uint_as_float(r[0]), __uint_as_float(r[1]));
    auto s = __builtin_amdgcn_permlane32_swap(__float_as_uint(v), __float_as_uint(v), false, false); return fmaxf(__uint_as_float(s[0]), __uint_as_float(s[1]));
}
typedef float f32x2_t __attribute__((ext_vector_type(2))); typedef __bf16 bf16x2_t __attribute__((ext_vector_type(2)));
__device__ __forceinline__ unsigned cvtpk(float lo, float hi) { f32x2_t v = {lo, hi}; bf16x2_t b = __builtin_convertvector(v, bf16x2_t); return __builtin_bit_cast(unsigned, b); }
__device__ __forceinline__ float bf2f(bf16 h) { return __uint_as_float((unsigned)h << 16); }
__device__ __forceinline__ float ld_f32_coh(const float* p) { return __uint_as_float(__hip_atomic_load((const unsigned*)p, RLX_AGENT)); }
__device__ __forceinline__ float silu(float x) { return x * __builtin_amdgcn_rcpf(1.0f + __expf(-x)); }
__device__ __forceinline__ float rsq(float x) { return __builtin_amdgcn_rsqf(x); }

__device__ __forceinline__ void tr_item64(const float* W, int ldw, int src_col, bf16* WT, int K, int dst_row, int k0, LAS bf16* tl, int lane) {
    const int cg = lane & 15, rr = lane >> 4;
    f32x4 v[16];
#pragma unroll
    for (int i = 0; i < 16; ++i) v[i] = *(const GAS f32x4*)(W + (size_t)(k0 + 4 * i + rr) * ldw + src_col + 4 * cg);
#pragma unroll
    for (int i = 0; i < 16; ++i) *(LAS unsigned long long*)(tl + (4 * i + rr) * 68 + 4 * cg) = (unsigned long long)cvtpk(v[i].x, v[i].y) | ((unsigned long long)cvtpk(v[i].z, v[i].w) << 32);
    LDS_WAIT(); asm volatile("" ::: "memory");
#pragma unroll
    for (int ii = 0; ii < 8; ++ii) { const int p = lane + 64 * ii, n = p >> 3, kc = p & 7; const LAS bf16* s = tl + (8 * kc) * 68 + n;
        v4u o; o.x = (unsigned)s[0] | ((unsigned)s[68] << 16); o.y = (unsigned)s[2 * 68] | ((unsigned)s[3 * 68] << 16); o.z = (unsigned)s[4 * 68] | ((unsigned)s[5 * 68] << 16); o.w = (unsigned)s[6 * 68] | ((unsigned)s[7 * 68] << 16);
        *(GAS v4u*)(WT + (size_t)(dst_row + n) * K + k0 + 8 * kc) = o; }
    LDS_WAIT(); asm volatile("" ::: "memory");
}

__device__ __forceinline__ void p0_prologue(Frame& F) {
    LAS bf16* tl = (LAS bf16*)(F.lds + RING_OFF + F.wave * 16384);
    const int gw = F.vcu * NWAVES + F.wave, NGW = F.G * NWAVES, lane = F.lane;
    constexpr int I_ADA = 24 * 32, I_AB = 16, I_IN = 16 * (NP / 64), I_OUT = 16 * 16, I_GU = 16 * (NGU / 64), I_DN = (FF / 64) * 16;
    constexpr int NITEMS = I_ADA + I_AB + I_IN + I_OUT + I_GU + I_DN;
    for (int it = gw; it < NITEMS; it += NGW) {
        int r = it;
        if (r < I_ADA) {
            const int ct = r % 24, ks = r / 24, col = ct * 256 + 4 * lane, k0 = ks * 32;
            f32x4 acc[4];
#pragma unroll
            for (int b = 0; b < 4; ++b) acc[b] = (f32x4){0.f, 0.f, 0.f, 0.f};
#pragma unroll 16
            for (int kk = 0; kk < 32; ++kk) { const int k = k0 + kk; const f32x4 w = *(const GAS f32x4*)(F.w_ada + (size_t)k * (6 * D) + col);
#pragma unroll
                for (int b = 0; b < 4; ++b) acc[b] += silu(F.c[b * D + k]) * w; }
#pragma unroll
            for (int b = 0; b < 4; ++b)
#pragma unroll
                for (int j = 0; j < 4; ++j) atomicAdd(F.modacc + b * (6 * D) + col + j, acc[b][j]);
            continue;
        }
        r -= I_ADA;
        if (r < I_AB) {
            for (int i = 0; i < 16; ++i) { const int k = i * 64 + lane; F.wab[r * D + k] = F.w_in[(size_t)k * PROJ_W + 2048 + r]; }
            continue;
        }
        r -= I_AB;
        if (r < I_IN) { const int nb = r % (NP / 64), kb = r / (NP / 64), n0 = 64 * nb; tr_item64(F.w_in, PROJ_W, n0 < 2048 ? n0 : n0 + 16, F.Win_t, D, n0, 64 * kb, tl, lane); continue; }
        r -= I_IN;
        if (r < I_OUT) { const int nb = r % 16, kb = r / 16; tr_item64(F.w_out, D, 64 * nb, F.Wout_t, D, 64 * nb, 64 * kb, tl, lane); continue; }
        r -= I_OUT;
        if (r < I_GU) { const int nb = r % (NGU / 64), kb = r / (NGU / 64), n0 = 64 * nb, p = n0 >> 8, j = n0 & 255;
            if (j < 128) tr_item64(F.w_gate, FF, 128 * p + j, F.Wgu_t, D, n0, 64 * kb, tl, lane);
            else         tr_item64(F.w_up,   FF, 128 * p + j - 128, F.Wgu_t, D, n0, 64 * kb, tl, lane);
            continue; }
        r -= I_GU;
        { const int nb = r % 16, kb = r / 16; tr_item64(F.w_down, D, 64 * nb, F.Wdn_t, FF, 64 * nb, 64 * kb, tl, lane); }
    }
}

template <int WHICH, bool GAB = (WHICH == 1)> __device__ __forceinline__ void norm_phase(Frame& F) {
    const int gw = F.vcu * NWAVES + F.wave, NGW = F.G * NWAVES, lane = F.lane;
    if (WHICH == 1) {
        for (int idx = gw * 64 + lane; idx < 4 * 6 * D; idx += NGW * 64) F.modf[idx] = F.modacc[idx] + F.b_ada[idx % (6 * D)];
        for (int idx = gw * 64 + lane; idx < 4 * D; idx += NGW * 64) { const int b_ = idx / D, c_ = idx % D; F.gm2[idx] = F.norm2_w[c_] * (1.0f + F.modacc[b_ * 6 * D + 4 * D + c_] + F.b_ada[4 * D + c_]); }
    }
    if (GAB) {
        for (int i = F.tid; i < 16 * D / 4; i += NWAVES * 64) ((LAS f32x4*)(F.lds + RING_OFF))[i] = ((const GAS f32x4*)F.wab)[i];
        __syncthreads();
    }
    const float* src = (WHICH == 1) ? F.x : F.out;
    const float* nw = (WHICH == 1) ? F.norm1_w : F.norm2_w;
    for (int m0 = gw * 4; m0 < M; m0 += NGW * 4) {
        const int b = m0 / T;
        float gm[16], sh[16];
#pragma unroll
        for (int i = 0; i < 4; ++i)
#pragma unroll
            for (int e = 0; e < 4; ++e) { const int c = 256 * i + 4 * lane + e; float sc, sf;
                if (WHICH == 1) { sf = F.modacc[b * 6 * D + c] + F.b_ada[c]; sc = F.modacc[b * 6 * D + D + c] + F.b_ada[D + c];     }
                else { sf = F.modf[b * 6 * D + 3 * D + c]; sc = F.modf[b * 6 * D + 4 * D + c]; }
                gm[4 * i + e] = nw[c] * (1.0f + sc); sh[4 * i + e] = sf; }
        float h[4][16];
        f32x4 v[4][4];
#pragma unroll
        for (int r = 0; r < 4; ++r) {
            if (WHICH == 1) { const GAS f32x4* xr = (const GAS f32x4*)(src + (size_t)(m0 + r) * D) + lane;
#pragma unroll
                for (int i = 0; i < 4; ++i) v[r][i] = xr[64 * i]; }
            else { const GAS unsigned long long* xr = (const GAS unsigned long long*)(F.X1B + (size_t)(m0 + r) * D) + lane;
#pragma unroll
                for (int i = 0; i < 4; ++i) { const unsigned long long bb = xr[64 * i]; const unsigned lo = (unsigned)bb, hi = (unsigned)(bb >> 32);
                    v[r][i] = (f32x4){__uint_as_float(lo << 16), __uint_as_float(lo & 0xffff0000u), __uint_as_float(hi << 16), __uint_as_float(hi & 0xffff0000u)}; } } }
#pragma unroll
        for (int r = 0; r < 4; ++r) {
            float ss = 0.f;
#pragma unroll
            for (int i = 0; i < 4; ++i) ss += (v[r][i].x * v[r][i].x + v[r][i].y * v[r][i].y) + (v[r][i].z * v[r][i].z + v[r][i].w * v[r][i].w);
            const float rstd = rsq(wave_sum(ss) * (1.0f / D) + EPS);
            GAS unsigned long long* o8 = (GAS unsigned long long*)(F.H + (size_t)(m0 + r) * D) + lane;
#pragma unroll
            for (int i = 0; i < 4; ++i) {
                const float a0 = v[r][i].x * rstd * gm[4 * i + 0] + sh[4 * i + 0], a1 = v[r][i].y * rstd * gm[4 * i + 1] + sh[4 * i + 1];
                const float a2 = v[r][i].z * rstd * gm[4 * i + 2] + sh[4 * i + 2], a3 = v[r][i].w * rstd * gm[4 * i + 3] + sh[4 * i + 3];
                h[r][4 * i + 0] = a0; h[r][4 * i + 1] = a1; h[r][4 * i + 2] = a2; h[r][4 * i + 3] = a3;
                o8[64 * i] = (unsigned long long)cvtpk(a0, a1) | ((unsigned long long)cvtpk(a2, a3) << 32); }
        }
        if (GAB) {
            float myv = 0.f;
#pragma unroll 4
            for (int j = 0; j < 16; ++j) {
                const LAS f32x4* wp = (const LAS f32x4*)(F.lds + RING_OFF) + j * (D / 4) + lane;
                f32x4 wv[4];
#pragma unroll
                for (int i = 0; i < 4; ++i) wv[i] = wp[64 * i];
#pragma unroll
                for (int r = 0; r < 4; ++r) { float p = 0.f;
#pragma unroll
                    for (int i = 0; i < 4; ++i) p += (h[r][4 * i] * wv[i].x + h[r][4 * i + 1] * wv[i].y) + (h[r][4 * i + 2] * wv[i].z + h[r][4 * i + 3] * wv[i].w);
                    p = wave_sum(p);
                    if (lane == r * 16 + j) myv = p; }
            }
            const int j = lane & 15, hh = j & 7;
            float val;
            if (j < 8) { const float xx = myv + F.dt_bias[hh]; const float sp = fmaxf(xx, 0.f) + log1pf(__expf(-fabsf(xx))); val = -__expf(F.a_log[hh]) * sp; }
            else val = 1.0f / (1.0f + __expf(-myv));
            F.gb[(size_t)m0 * 16 + lane] = val;
        }
    }
}

__device__ __forceinline__ float rdlane(float v, int l) { return __int_as_float(__builtin_amdgcn_readlane(__float_as_int(v), l)); }
__device__ __forceinline__ bf16x8 pack8(const f32x4 a, const f32x4 b) {
    v4u w; w.x = cvtpk(a[0], a[1]); w.y = cvtpk(a[2], a[3]); w.z = cvtpk(b[0], b[1]); w.w = cvtpk(b[2], b[3]); return __builtin_bit_cast(bf16x8, w); }
__device__ __forceinline__ bf16x8 tile_frag(const LAS bf16* tile, int t, int ks, int fr, int fq) {
    const LAS bf16* p = tile + (16 * t + fr) * 64 + 32 * ks + 4 * fq;
    const unsigned long long lo = *(const LAS unsigned long long*)p, hi = *(const LAS unsigned long long*)(p + 16);
    v4u v; v.x = (unsigned)lo; v.y = (unsigned)(lo >> 32); v.z = (unsigned)hi; v.w = (unsigned)(hi >> 32); return __builtin_bit_cast(bf16x8, v);
}
__device__ __forceinline__ float arow(unsigned packed, int hi, int s) { const unsigned u = (unsigned)__builtin_amdgcn_readlane((int)packed, s); return __uint_as_float(hi ? (u & 0xffff0000u) : (u << 16)); }
__device__ __forceinline__ unsigned long long pack4(float a, float b, float c, float d) { return (unsigned long long)cvtpk(a, b) | ((unsigned long long)cvtpk(c, d) << 32); }

typedef short s16x4 __attribute__((ext_vector_type(4)));
__device__ __forceinline__ s16x4 cvt4(const f32x4 v) { const unsigned lo = cvtpk(v[0], v[1]), hi = cvtpk(v[2], v[3]); typedef unsigned u32x2 __attribute__((ext_vector_type(2))); return __builtin_bit_cast(s16x4, (u32x2){lo, hi}); }
#define MFMA16(a, b, c) __builtin_amdgcn_mfma_f32_16x16x16bf16_1k((a), (b), (c), 0, 0, 0)
#define MFMA32(a, b, c) __builtin_amdgcn_mfma_f32_16x16x32_bf16((a), (b), (c), 0, 0, 0)

__device__ __forceinline__ void gdn_prep_chunk(Frame& F, int ci, LAS unsigned char* wl  ) {
    const int lane = F.lane, bh = ci >> 6, n = ci & 63, b = bh >> 3, hh = bh & 7, fr = lane & 15, fq = lane >> 4;
    const size_t m0 = (size_t)b * T + 64 * n;
    bf16* const cA = F.CHKA + (size_t)ci * 8192;
    bf16* const cT = F.CHKT + (size_t)ci * 8192;
    bf16* const cU = F.CHKU + (size_t)ci * 8192;
    LAS bf16* const R0 = (LAS bf16*)wl;
    LAS bf16* const R1 = (LAS bf16*)(wl + 9728);
#define GDN_RAW(dst, col0) do { _Pragma("unroll") for (int i_ = 0; i_ < 9; ++i_) { long row_ = (long)m0 - 3 + 8 * i_ + (lane >> 3); row_ = row_ < 0 ? 0 : (row_ > M - 1 ? M - 1 : row_); \
        __builtin_amdgcn_global_load_lds((const unsigned*)(F.PQ + (size_t)row_ * NP + (col0) + hh * 64 + (lane & 7) * 8), (LAS unsigned*)((dst) + i_ * 512), 16, 0, 0); } } while (0)
    GDN_RAW(R0, C_GQ); GDN_RAW(R1, C_GK);
    const f32x4 z4 = (f32x4){0.f, 0.f, 0.f, 0.f};
    const float g = ld_f32_coh(F.gb + (m0 + lane) * 16 + hh), beta = ld_f32_coh(F.gb + (m0 + lane) * 16 + 8 + hh);
    float G = g;
#pragma unroll
    for (int o = 1; o < 64; o <<= 1) { const float t = __shfl_up(G, o); if (lane >= o) G += t; }
    const float eG = __expf(G), Glast = __shfl(G, 63), kdsc = __expf(Glast - G), beG = beta * eG;
    if (lane == 0) F.dec[ci] = __expf(Glast);
    asm volatile("s_waitcnt vmcnt(0)" ::: "memory");
    {
        const float w0 = F.conv_w[hh * 64 + lane], w1 = F.conv_w[1536 + hh * 64 + lane], w2 = F.conv_w[2 * 1536 + hh * 64 + lane], w3 = F.conv_w[3 * 1536 + hh * 64 + lane];
        float x0 = 0.f, x1 = 0.f, x2 = 0.f;
        if (n > 0) { x0 = bf2f(R0[lane]); x1 = bf2f(R0[64 + lane]); x2 = bf2f(R0[128 + lane]); }
#pragma unroll
        for (int c = 0; c < 64; ++c) {
            const float r = bf2f(R0[(c + 3) * 64 + lane]);
            const float cq = silu(w0 * x0 + w1 * x1 + w2 * x2 + w3 * r); x0 = x1; x1 = x2; x2 = r;
            R0[c * 64 + lane] = (bf16)(cvtpk(cq, cq) & 0xffffu);
            if ((c & 15) == 15) __builtin_amdgcn_sched_barrier(0);
        }
    }
    {
        const float w0 = F.conv_w[512 + hh * 64 + lane], w1 = F.conv_w[1536 + 512 + hh * 64 + lane], w2 = F.conv_w[2 * 1536 + 512 + hh * 64 + lane], w3 = F.conv_w[3 * 1536 + 512 + hh * 64 + lane];
        float x0 = 0.f, x1 = 0.f, x2 = 0.f;
        if (n > 0) { x0 = bf2f(R1[lane]); x1 = bf2f(R1[64 + lane]); x2 = bf2f(R1[128 + lane]); }
#pragma unroll
        for (int c = 0; c < 64; ++c) {
            const float r = bf2f(R1[(c + 3) * 64 + lane]);
            const float ck = silu(w0 * x0 + w1 * x1 + w2 * x2 + w3 * r); x0 = x1; x1 = x2; x2 = r;
            R1[c * 64 + lane] = (bf16)(cvtpk(ck, ck) & 0xffffu);
            if ((c & 15) == 15) __builtin_amdgcn_sched_barrier(0);
        }
    }
    LDS_WAIT(); asm volatile("" ::: "memory"); __builtin_amdgcn_sched_barrier(0);
    bf16x8 kf[4][2], qf[4][2];
#pragma unroll
    for (int blk = 0; blk < 4; ++blk)
#pragma unroll
        for (int kk = 0; kk < 2; ++kk) { kf[blk][kk] = *(const LAS bf16x8*)(R1 + (16 * blk + fr) * 64 + 32 * kk + 8 * fq); qf[blk][kk] = *(const LAS bf16x8*)(R0 + (16 * blk + fr) * 64 + 32 * kk + 8 * fq); }
    float rqc[4], rkc[4];
#pragma unroll
    for (int t = 0; t < 4; ++t) { f32x4 dq = MFMA32(qf[t][0], qf[t][0], z4); dq = MFMA32(qf[t][1], qf[t][1], dq); f32x4 dk = MFMA32(kf[t][0], kf[t][0], z4); dk = MFMA32(kf[t][1], kf[t][1], dk);
        const int di = fr & 3; const bool on = (fq == (fr >> 2));
        const float vq = di == 0 ? dq[0] : di == 1 ? dq[1] : di == 2 ? dq[2] : dq[3], vk = di == 0 ? dk[0] : di == 1 ? dk[1] : di == 2 ? dk[2] : dk[3];
        rqc[t] = rsq(fq_sum(on ? vq : 0.f) + EPS); rkc[t] = rsq(fq_sum(on ? vk : 0.f) + EPS); }
    const float rk_tok = fq == 0 ? rkc[0] : fq == 1 ? rkc[1] : fq == 2 ? rkc[2] : rkc[3];
    const float beGn = beG * rk_tok, kdscn = kdsc * rk_tok;
    float Gcol[4], Bcol[4];
#pragma unroll
    for (int t = 0; t < 4; ++t) { Gcol[t] = __shfl(G, 16 * t + fr); Bcol[t] = __shfl(beta, 16 * t + fr) * rkc[t]; }
#pragma unroll
    for (int mt = 0; mt < 4; ++mt) { const float esc = __expf(Gcol[mt]) * 0.125f * rqc[mt];
#pragma unroll
        for (int ks = 0; ks < 2; ++ks) { const v4u q8 = __builtin_bit_cast(v4u, tile_frag(R0, mt, ks, fr, fq)); const unsigned w_[4] = {q8.x, q8.y, q8.z, q8.w}; v4u o_;
            o_.x = cvtpk(__uint_as_float(w_[0] << 16) * esc, __uint_as_float(w_[0] & 0xffff0000u) * esc); o_.y = cvtpk(__uint_as_float(w_[1] << 16) * esc, __uint_as_float(w_[1] & 0xffff0000u) * esc);
            o_.z = cvtpk(__uint_as_float(w_[2] << 16) * esc, __uint_as_float(w_[2] & 0xffff0000u) * esc); o_.w = cvtpk(__uint_as_float(w_[3] << 16) * esc, __uint_as_float(w_[3] & 0xffff0000u) * esc);
            *(GAS v4u*)(cT + ((mt * 2 + ks) * 64 + lane) * 8) = o_; } }
    LDS_WAIT(); asm volatile("" ::: "memory"); __builtin_amdgcn_sched_barrier(0);
#pragma unroll
    for (int ks = 0; ks < 2; ++ks) { float Grow[2][4], Krow[2][4];
#pragma unroll
        for (int h2 = 0; h2 < 2; ++h2)
#pragma unroll
            for (int i = 0; i < 4; ++i) { Grow[h2][i] = __shfl(G, 16 * (2 * ks + h2) + 4 * fq + i); Krow[h2][i] = __shfl(rk_tok, 16 * (2 * ks + h2) + 4 * fq + i); }
#pragma unroll
        for (int tc = 0; tc < 4; ++tc) {
            f32x4 v[2];
#pragma unroll
            for (int h2 = 0; h2 < 2; ++h2) { const int ts = 2 * ks + h2;
                if (ts <= tc) { f32x4 acc = MFMA32(kf[ts][0], qf[tc][0], z4); acc = MFMA32(kf[ts][1], qf[tc][1], acc);
#pragma unroll
                    for (int i = 0; i < 4; ++i) { const int cidx = 16 * tc + fr, sidx = 16 * ts + 4 * fq + i; v[h2][i] = (cidx >= sidx) ? acc[i] * __expf(Gcol[tc] - Grow[h2][i]) * (0.125f * rqc[tc]) * Krow[h2][i] : 0.f; }
                } else v[h2] = z4; }
            *(bf16x8*)(cT + 4096 + ((tc * 2 + ks) * 64 + lane) * 8) = pack8(v[0], v[1]);
        } }
#pragma unroll
    for (int ts = 0; ts < 4; ++ts) { float Grow[4], Krow[4];
#pragma unroll
        for (int i = 0; i < 4; ++i) { Grow[i] = __shfl(G, 16 * ts + 4 * fq + i); Krow[i] = __shfl(rk_tok, 16 * ts + 4 * fq + i); }
#pragma unroll
        for (int tc = 0; tc < 4; ++tc) { f32x4 a = z4;
            if (ts <= tc) { f32x4 acc = MFMA32(kf[ts][0], kf[tc][0], z4); acc = MFMA32(kf[ts][1], kf[tc][1], acc);
#pragma unroll
                for (int i = 0; i < 4; ++i) { const int cidx = 16 * tc + fr, sidx = 16 * ts + 4 * fq + i; a[i] = (cidx > sidx) ? Bcol[tc] * Krow[i] * acc[i] * __expf(Gcol[tc] - Grow[i]) : 0.f; } }
            *(LAS unsigned long long*)(R0 + (16 * tc + fr) * 64 + 16 * ts + 4 * fq) = pack4(a[0], a[1], a[2], a[3]); } }
    bf16x8 RkB[4][2], KDf[4][2];
#pragma unroll
    for (int ks = 0; ks < 2; ++ks) { float sB[8], sD[8];
#pragma unroll
        for (int j = 0; j < 8; ++j) { const int tok = 32 * ks + 16 * (j >> 2) + 4 * fq + (j & 3); sB[j] = __shfl(beGn, tok); sD[j] = __shfl(kdscn, tok); }
#pragma unroll
        for (int t = 0; t < 4; ++t) { float kv[8];
#pragma unroll
            for (int j = 0; j < 8; ++j) kv[j] = bf2f(R1[(32 * ks + 16 * (j >> 2) + 4 * fq + (j & 3)) * 64 + 16 * t + fr]);
            v4u a_, d_;
            a_.x = cvtpk(kv[0] * sB[0], kv[1] * sB[1]); a_.y = cvtpk(kv[2] * sB[2], kv[3] * sB[3]); a_.z = cvtpk(kv[4] * sB[4], kv[5] * sB[5]); a_.w = cvtpk(kv[6] * sB[6], kv[7] * sB[7]);
            d_.x = cvtpk(kv[0] * sD[0], kv[1] * sD[1]); d_.y = cvtpk(kv[2] * sD[2], kv[3] * sD[3]); d_.z = cvtpk(kv[4] * sD[4], kv[5] * sD[5]); d_.w = cvtpk(kv[6] * sD[6], kv[7] * sD[7]);
            RkB[t][ks] = __builtin_bit_cast(bf16x8, a_); KDf[t][ks] = __builtin_bit_cast(bf16x8, d_); } }
    LDS_WAIT(); asm volatile("" ::: "memory"); __builtin_amdgcn_sched_barrier(0);
    {
        float X[16];
#pragma unroll
        for (int r = 0; r < 16; ++r) X[r] = (r == fr) ? 1.f : 0.f;
        const LAS bf16* ab = R0 + (16 * fq) * 64 + 16 * fq;
#pragma unroll
        for (int s = 0; s < 15; ++s) {
#pragma unroll
            for (int r = s + 1; r < 16; ++r) X[r] -= bf2f(ab[r * 64 + s]) * X[s];
            if ((s & 3) == 3) __builtin_amdgcn_sched_barrier(0);
        }
        LDS_WAIT(); asm volatile("" ::: "memory"); __builtin_amdgcn_sched_barrier(0);
#pragma unroll
        for (int r = 0; r < 16; ++r) R0[(16 * fq + r) * 64 + 16 * fq + fr] = (bf16)(cvtpk(X[r], X[r]) & 0xffffu);
    }
    LDS_WAIT(); asm volatile("" ::: "memory"); __builtin_amdgcn_sched_barrier(0);
    {
#define A16(i, k) (*(const LAS s16x4*)(R0 + (16 * (i) + fr) * 64 + 16 * (k) + 4 * fq))
        s16x4 Td[4];
#pragma unroll
        for (int j = 0; j < 3; ++j) { const LAS bf16* p = R0 + (16 * j + 4 * fq) * 64 + 16 * j + fr; typedef unsigned u32x2 __attribute__((ext_vector_type(2)));
            Td[j] = __builtin_bit_cast(s16x4, (u32x2){(unsigned)p[0] | ((unsigned)p[64] << 16), (unsigned)p[128] | ((unsigned)p[192] << 16)}); }
        f32x4 m10 = MFMA16(A16(1, 0), Td[0], z4);
        const f32x4 t10 = -MFMA16(A16(1, 1), cvt4(m10), z4);
        f32x4 m21 = MFMA16(A16(2, 1), Td[1], z4);
        f32x4 m20 = MFMA16(A16(2, 0), Td[0], z4); m20 = MFMA16(A16(2, 1), cvt4(t10), m20);
        const s16x4 a22 = A16(2, 2);
        const f32x4 t21 = -MFMA16(a22, cvt4(m21), z4), t20 = -MFMA16(a22, cvt4(m20), z4);
        f32x4 m32 = MFMA16(A16(3, 2), Td[2], z4);
        f32x4 m31 = MFMA16(A16(3, 1), Td[1], z4); m31 = MFMA16(A16(3, 2), cvt4(t21), m31);
        f32x4 m30 = MFMA16(A16(3, 0), Td[0], z4); m30 = MFMA16(A16(3, 1), cvt4(t10), m30); m30 = MFMA16(A16(3, 2), cvt4(t20), m30);
        const s16x4 a33 = A16(3, 3);
        const f32x4 t32 = -MFMA16(a33, cvt4(m32), z4), t31 = -MFMA16(a33, cvt4(m31), z4), t30 = -MFMA16(a33, cvt4(m30), z4);
        LDS_WAIT(); asm volatile("" ::: "memory"); __builtin_amdgcn_sched_barrier(0);
#define TST(i, j, t) do { _Pragma("unroll") for (int r_ = 0; r_ < 4; ++r_) R0[(16 * (i) + 4 * fq + r_) * 64 + 16 * (j) + fr] = (bf16)(cvtpk((t)[r_], (t)[r_]) & 0xffffu); } while (0)
        TST(1, 0, t10); TST(2, 0, t20); TST(2, 1, t21); TST(3, 0, t30); TST(3, 1, t31); TST(3, 2, t32);
#undef TST
#undef A16
    }
    LDS_WAIT(); asm volatile("" ::: "memory"); __builtin_amdgcn_sched_barrier(0);
#pragma unroll
    for (int ct = 0; ct < 4; ++ct) { const bf16x8 ta0 = tile_frag(R0, ct, 0, fr, fq), ta1 = tile_frag(R0, ct, 1, fr, fq);
#pragma unroll
        for (int dt = 0; dt < 4; ++dt) { f32x4 acc = MFMA32(ta0, RkB[dt][0], z4); if (ct >= 2) acc = MFMA32(ta1, RkB[dt][1], acc);
            *(LAS unsigned long long*)(R1 + (16 * dt + fr) * 64 + 16 * ct + 4 * fq) = pack4(acc[0], acc[1], acc[2], acc[3]); } }
    LDS_WAIT(); asm volatile("" ::: "memory");
    asm volatile("s_waitcnt vmcnt(0)" ::: "memory");
    v4u qdf[8]; bf16x8 qkf[8];
#pragma unroll
    for (int f = 0; f < 8; ++f) { qdf[f] = *(const GAS v4u*)(cT + (f * 64 + lane) * 8); qkf[f] = *(const GAS bf16x8*)(cT + 4096 + (f * 64 + lane) * 8); }
    bf16x8 waf[4][2];
#pragma unroll
    for (int tm = 0; tm < 4; ++tm) { waf[tm][0] = tile_frag(R1, tm, 0, fr, fq); waf[tm][1] = tile_frag(R1, tm, 1, fr, fq); }
    LDS_WAIT(); asm volatile("" ::: "memory");
    GDN_RAW(R1, C_GV);
#pragma unroll
    for (int tn = 0; tn < 4; ++tn) {
#pragma unroll
        for (int ks2 = 0; ks2 < 2; ++ks2) {
            const v4u qd8 = qdf[tn * 2 + ks2]; const unsigned qw_[4] = {qd8.x, qd8.y, qd8.z, qd8.w};
            f32x4 pp[2], q2[2];
#pragma unroll
            for (int h2 = 0; h2 < 2; ++h2) { const int tm = 2 * ks2 + h2;
                f32x4 a1 = MFMA32(waf[tm][0], KDf[tn][0], z4); a1 = MFMA32(waf[tm][1], KDf[tn][1], a1);
                f32x4 a2 = MFMA32(waf[tm][0], qkf[tn * 2], z4); a2 = MFMA32(waf[tm][1], qkf[tn * 2 + 1], a2);
                pp[h2] = -a1;
                q2[h2] = (f32x4){__uint_as_float(qw_[2 * h2] << 16), __uint_as_float(qw_[2 * h2] & 0xffff0000u), __uint_as_float(qw_[2 * h2 + 1] << 16), __uint_as_float(qw_[2 * h2 + 1] & 0xffff0000u)} - a2; }
            *(GAS bf16x8*)(cA + ((tn * 2 + ks2) * 64 + lane) * 8) = pack8(pp[0], pp[1]);
            *(GAS bf16x8*)(cA + 4096 + ((tn * 2 + ks2) * 64 + lane) * 8) = pack8(q2[0], q2[1]);
        }
    }
    asm volatile("s_waitcnt vmcnt(0)" ::: "memory");
    {
        const float w0 = F.conv_w[1024 + hh * 64 + lane], w1 = F.conv_w[1536 + 1024 + hh * 64 + lane], w2 = F.conv_w[2 * 1536 + 1024 + hh * 64 + lane], w3 = F.conv_w[3 * 1536 + 1024 + hh * 64 + lane];
        float x0 = 0.f, x1 = 0.f, x2 = 0.f;
        if (n > 0) { x0 = bf2f(R1[lane]); x1 = bf2f(R1[64 + lane]); x2 = bf2f(R1[128 + lane]); }
#pragma unroll
        for (int c = 0; c < 64; ++c) {
            const float r = bf2f(R1[(c + 3) * 64 + lane]);
            const float cv = silu(w0 * x0 + w1 * x1 + w2 * x2 + w3 * r); x0 = x1; x1 = x2; x2 = r;
            R1[c * 64 + lane] = (bf16)(cvtpk(cv, cv) & 0xffffu);
            if ((c & 15) == 15) __builtin_amdgcn_sched_barrier(0);
        }
    }
    LDS_WAIT(); asm volatile("" ::: "memory"); __builtin_amdgcn_sched_barrier(0);
    bf16x8 RvB[4][2];
#pragma unroll
    for (int ks = 0; ks < 2; ++ks) { float sB[8];
#pragma unroll
        for (int j = 0; j < 8; ++j) sB[j] = __shfl(beta, 32 * ks + 16 * (j >> 2) + 4 * fq + (j & 3));
#pragma unroll
        for (int t = 0; t < 4; ++t) { float vv[8];
#pragma unroll
            for (int j = 0; j < 8; ++j) vv[j] = bf2f(R1[(32 * ks + 16 * (j >> 2) + 4 * fq + (j & 3)) * 64 + 16 * t + fr]) * sB[j];
            v4u a_; a_.x = cvtpk(vv[0], vv[1]); a_.y = cvtpk(vv[2], vv[3]); a_.z = cvtpk(vv[4], vv[5]); a_.w = cvtpk(vv[6], vv[7]);
            RvB[t][ks] = __builtin_bit_cast(bf16x8, a_); } }
    LDS_WAIT(); asm volatile("" ::: "memory"); __builtin_amdgcn_sched_barrier(0);
#pragma unroll
    for (int ct = 0; ct < 4; ++ct) { const bf16x8 ta0 = tile_frag(R0, ct, 0, fr, fq), ta1 = tile_frag(R0, ct, 1, fr, fq);
#pragma unroll
        for (int et = 0; et < 4; ++et) { f32x4 acc = MFMA32(ta0, RvB[et][0], z4); if (ct >= 2) acc = MFMA32(ta1, RvB[et][1], acc);
            *(LAS unsigned long long*)(R1 + (16 * et + fr) * 64 + 16 * ct + 4 * fq) = pack4(acc[0], acc[1], acc[2], acc[3]); } }
    LDS_WAIT(); asm volatile("" ::: "memory"); __builtin_amdgcn_sched_barrier(0);
#pragma unroll
    for (int et = 0; et < 4; ++et) {
        const bf16x8 ub0 = tile_frag(R1, et, 0, fr, fq), ub1 = tile_frag(R1, et, 1, fr, fq);
#pragma unroll
        for (int tm = 0; tm < 4; ++tm) {
            const bf16x8 qa0 = qkf[tm * 2], qa1 = qkf[tm * 2 + 1];
            f32x4 r = MFMA32(KDf[tm][0], ub0, z4); r = MFMA32(KDf[tm][1], ub1, r);
            f32x4 o = MFMA32(qa0, ub0, z4); o = MFMA32(qa1, ub1, o);
            *(GAS unsigned long long*)(cU + ((et * 4 + tm) * 64 + lane) * 4) = pack4(r[0], r[1], r[2], r[3]);
            *(GAS unsigned long long*)(cU + 4096 + ((et * 4 + tm) * 64 + lane) * 4) = pack4(o[0], o[1], o[2], o[3]);
        }
    }
    LDS_WAIT(); asm volatile("" ::: "memory"); __builtin_amdgcn_sched_barrier(0);
}
#undef MFMA16
#undef MFMA32
#undef GDN_RAW

#define GDN_BAR() do { asm volatile("" ::: "memory"); __builtin_amdgcn_s_barrier(); asm volatile("" ::: "memory"); } while (0)
__device__ __forceinline__ void gdn_scan(Frame& F, int bh) {
    const int lane = F.lane, wave = F.wave, b = bh >> 3, hh = bh & 7, fr = lane & 15, fq = lane >> 4;
    LAS unsigned char* const ring = F.lds + RING_OFF;
    constexpr int SLOT = 32768, OB0 = 131072, OB1 = 139264;
    const unsigned char* gA = (const unsigned char*)(F.CHKA + (size_t)bh * 64 * 8192);
    const unsigned char* gU = (const unsigned char*)(F.CHKU + (size_t)bh * 64 * 8192);
    if (wave >= 4) {
        const int hw = wave - 4, nt = hw * 64 + lane;
        bf16* mp = F.ORAW + ((size_t)b * T + (nt >> 3)) * 512 + hh * 64 + (nt & 7) * 8;
#define GDN_ISSUE(nn) do { const int n_ = (nn); const int sl_ = n_ & 3; _Pragma("unroll") for (int i_ = 0; i_ < 8; ++i_) { const int p_ = hw * 8 + i_; \
            const unsigned char* s_ = (p_ < 16) ? gA + (size_t)n_ * 16384 + p_ * 1024 : gU + (size_t)n_ * 16384 + (p_ - 16) * 1024; \
            __builtin_amdgcn_global_load_lds((const unsigned*)(s_ + lane * 16), (LAS unsigned*)(ring + sl_ * SLOT + p_ * 1024), 16, 0, 0); } } while (0)
#define GDN_COPY(nn) do { const LAS unsigned char* ob_ = ring + (((nn) & 1) ? OB1 : OB0); _Pragma("unroll") for (int k_ = 0; k_ < 2; ++k_) \
            *(GAS v4u*)(mp + (size_t)(64 * (nn) + 32 * k_) * 512) = *(const LAS v4u*)(ob_ + (nt + 256 * k_) * 16); } while (0)
        GDN_ISSUE(0); GDN_ISSUE(1); GDN_ISSUE(2);
        asm volatile("s_waitcnt vmcnt(16)" ::: "memory"); GDN_BAR();
        for (int n = 0; n < 64; ++n) {
            if (n + 3 < 64) { GDN_ISSUE(n + 3); asm volatile("s_waitcnt vmcnt(16)" ::: "memory"); } else asm volatile("s_waitcnt vmcnt(0)" ::: "memory");
            if (n > 0) GDN_COPY(n - 1);
            LDS_WAIT(); GDN_BAR();
        }
        GDN_COPY(63);
#undef GDN_ISSUE
#undef GDN_COPY
    } else {
        const int ew = wave;
        f32x4 Sacc[4];
#pragma unroll
        for (int t = 0; t < 4; ++t) Sacc[t] = (f32x4){0.f, 0.f, 0.f, 0.f};
        const float decs = ld_f32_coh(F.dec + bh * 64 + lane);
        GDN_BAR();
        for (int n = 0; n < 64; ++n) {
            const LAS unsigned char* sl = ring + (n & 3) * SLOT;
            LAS bf16* ob = (LAS bf16*)(ring + ((n & 1) ? OB1 : OB0)) + (4 * fq) * 64 + 16 * ew + fr;
            const float dec = __int_as_float(__builtin_amdgcn_readlane(__float_as_int(decs), n));
            unsigned long long rf[4], of[4]; bf16x8 pf[8], qf[8];
#pragma unroll
            for (int t = 0; t < 4; ++t) { rf[t] = *(const LAS unsigned long long*)(sl + 16384 + ((ew * 4 + t) * 64 + lane) * 8); of[t] = *(const LAS unsigned long long*)(sl + 24576 + ((ew * 4 + t) * 64 + lane) * 8); }
#pragma unroll
            for (int f = 0; f < 8; ++f) { pf[f] = *(const LAS bf16x8*)(sl + (f * 64 + lane) * 16); qf[f] = *(const LAS bf16x8*)(sl + 8192 + (f * 64 + lane) * 16); }
            __builtin_amdgcn_sched_barrier(0);
            bf16x8 Sb[2]; Sb[0] = pack8(Sacc[0], Sacc[1]); Sb[1] = pack8(Sacc[2], Sacc[3]);
            f32x4 O[4];
#pragma unroll
            for (int t = 0; t < 4; ++t) { const unsigned rl = (unsigned)rf[t], rh = (unsigned)(rf[t] >> 32), ol = (unsigned)of[t], oh = (unsigned)(of[t] >> 32);
                Sacc[t] = Sacc[t] * dec + (f32x4){__uint_as_float(rl << 16), __uint_as_float(rl & 0xffff0000u), __uint_as_float(rh << 16), __uint_as_float(rh & 0xffff0000u)};
                O[t] = (f32x4){__uint_as_float(ol << 16), __uint_as_float(ol & 0xffff0000u), __uint_as_float(oh << 16), __uint_as_float(oh & 0xffff0000u)}; }
#pragma unroll
            for (int t = 0; t < 4; ++t)
#pragma unroll
                for (int ks = 0; ks < 2; ++ks) { const int f = t * 2 + ks;
                    Sacc[t] = __builtin_amdgcn_mfma_f32_16x16x32_bf16(pf[f], Sb[ks], Sacc[t], 0, 0, 0); O[t] = __builtin_amdgcn_mfma_f32_16x16x32_bf16(qf[f], Sb[ks], O[t], 0, 0, 0); }
#pragma unroll
            for (int t = 0; t < 4; ++t)
#pragma unroll
                for (int i = 0; i < 4; ++i) ob[(16 * t + i) * 64] = (bf16)(cvtpk(O[t][i], O[t][i]) & 0xffffu);
            LDS_WAIT(); GDN_BAR();
        }
    }
}
__device__ __forceinline__ void gdn_norm_rows(Frame& F, int r0) {
    const int oc = F.tid & 7, hd = (F.tid >> 3) & 7;
    float nw[8];
#pragma unroll
    for (int j = 0; j < 8; ++j) nw[j] = F.gdn_norm_w[oc * 8 + j];
#pragma unroll 1
    for (int it = 0; it < 4; ++it) {
        v4u ov[8], zv[8];
#pragma unroll
        for (int k = 0; k < 8; ++k) { const size_t row = (size_t)r0 + (it * 8 + k) * 8 + (F.tid >> 6); ov[k] = *(const GAS v4u*)(F.ORAW + row * 512 + hd * 64 + oc * 8); zv[k] = *(const GAS v4u*)(F.PQ + row * NP + C_GZ + hd * 64 + oc * 8); }
#pragma unroll
        for (int k = 0; k < 8; ++k) { const size_t row = (size_t)r0 + (it * 8 + k) * 8 + (F.tid >> 6);
            const unsigned ow[4] = {ov[k].x, ov[k].y, ov[k].z, ov[k].w}, zw[4] = {zv[k].x, zv[k].y, zv[k].z, zv[k].w};
            float o[8], z[8]; float ss = 0.f;
#pragma unroll
            for (int w = 0; w < 4; ++w) { o[2 * w] = __uint_as_float(ow[w] << 16); o[2 * w + 1] = __uint_as_float(ow[w] & 0xffff0000u); z[2 * w] = __uint_as_float(zw[w] << 16); z[2 * w + 1] = __uint_as_float(zw[w] & 0xffff0000u);
                ss += o[2 * w] * o[2 * w] + o[2 * w + 1] * o[2 * w + 1]; }
            ss = sum8(ss);
            const float rs = rsq(ss * (1.0f / 64.0f) + EPS);
            v4u w4; w4.x = cvtpk(o[0] * rs * nw[0] * z[0], o[1] * rs * nw[1] * z[1]); w4.y = cvtpk(o[2] * rs * nw[2] * z[2], o[3] * rs * nw[3] * z[3]);
            w4.z = cvtpk(o[4] * rs * nw[4] * z[4], o[5] * rs * nw[5] * z[5]); w4.w = cvtpk(o[6] * rs * nw[6] * z[6], o[7] * rs * nw[7] * z[7]);
            *(GAS v4u*)(F.MIX + row * D + hd * 64 + oc * 8) = w4; }
    }
    asm volatile("s_waitcnt vmcnt(0)" ::: "memory"); __syncthreads();
}
__device__ __forceinline__ void swa_unit(Frame& F, int unit, LAS unsigned char* L) {
    const int tid = F.tid, lane = F.lane, wave = F.wave, fr = lane & 15, fq = lane >> 4;
    const int blk = unit & 63, kvh = (unit >> 6) & 1, b = unit >> 7, t0 = blk * 64;
    const size_t row0 = (size_t)b * T;
    LAS bf16* const Ks = (LAS bf16*)L; LAS bf16* const Vt = (LAS bf16*)(L + 27648);
    for (int p = tid; p < 1536; p += NWAVES * 64) {
        const int key = p >> 3, oc = p & 7, s = t0 - 128 + key;
        v4u kv = (v4u){0u, 0u, 0u, 0u}, vv = (v4u){0u, 0u, 0u, 0u};
        if (s >= 0) { kv = *(const GAS v4u*)(F.PQ + (row0 + s) * NP + C_SK + kvh * 64 + oc * 8); vv = *(const GAS v4u*)(F.PQ + (row0 + s) * NP + C_SV + kvh * 64 + oc * 8); }
        const unsigned kw[4] = {kv.x, kv.y, kv.z, kv.w}, vw[4] = {vv.x, vv.y, vv.z, vv.w};
        float k[8]; float ss = 0.f;
#pragma unroll
        for (int w = 0; w < 4; ++w) { k[2 * w] = __uint_as_float(kw[w] << 16); k[2 * w + 1] = __uint_as_float(kw[w] & 0xffff0000u); ss += k[2 * w] * k[2 * w] + k[2 * w + 1] * k[2 * w + 1]; }
        ss = sum8(ss);
        const float rstd = rsq(ss * (1.0f / 64.0f) + EPS);
#pragma unroll
        for (int j = 0; j < 8; ++j) k[j] = k[j] * rstd * F.k_norm_w[oc * 8 + j];
        v4u o; o.x = cvtpk(k[0], k[1]); o.y = cvtpk(k[2], k[3]); o.z = cvtpk(k[4], k[5]); o.w = cvtpk(k[6], k[7]);
        *(LAS v4u*)(Ks + key * 72 + oc * 8) = o;
#pragma unroll
        for (int w = 0; w < 4; ++w) { Vt[(oc * 8 + 2 * w) * 196 + key] = (bf16)(vw[w] & 0xffffu); Vt[(oc * 8 + 2 * w + 1) * 196 + key] = (bf16)(vw[w] >> 16); }
    }
    __syncthreads();
    const int hq = kvh * 4 + (wave >> 1);
    const float slope = exp2f(-(float)(hq + 1)), sink = F.sinks[hq];
#pragma unroll 1
    for (int qt = 0; qt < 2; ++qt) {
        const int tq0 = t0 + 32 * (wave & 1) + 16 * qt;
        bf16x8 qf[2];
        {
            const bf16* qp = F.PQ + (row0 + tq0 + fr) * NP + C_SQ + hq * 64 + 8 * fq;
            const v4u r0 = *(const GAS v4u*)qp, r1 = *(const GAS v4u*)(qp + 32);
            const unsigned qw[8] = {r0.x, r0.y, r0.z, r0.w, r1.x, r1.y, r1.z, r1.w};
            float q[16]; float ss = 0.f;
#pragma unroll
            for (int w = 0; w < 8; ++w) { q[2 * w] = __uint_as_float(qw[w] << 16); q[2 * w + 1] = __uint_as_float(qw[w] & 0xffff0000u); ss += q[2 * w] * q[2 * w] + q[2 * w + 1] * q[2 * w + 1]; }
            ss = fq_sum(ss);
            const float rstd = 0.125f * rsq(ss * (1.0f / 64.0f) + EPS);
#pragma unroll
            for (int kk = 0; kk < 2; ++kk) { float z[8];
#pragma unroll
                for (int j = 0; j < 8; ++j) z[j] = q[8 * kk + j] * rstd * F.q_norm_w[32 * kk + 8 * fq + j];
                v4u o; o.x = cvtpk(z[0], z[1]); o.y = cvtpk(z[2], z[3]); o.z = cvtpk(z[4], z[5]); o.w = cvtpk(z[6], z[7]); qf[kk] = __builtin_bit_cast(bf16x8, o); }
        }
        f32x4 sc[12]; float mx = -INFINITY;
#pragma unroll
        for (int nt = 0; nt < 12; ++nt) { f32x4 acc = (f32x4){0.f, 0.f, 0.f, 0.f};
#pragma unroll
            for (int kk = 0; kk < 2; ++kk) { const bf16x8 kf = *(const LAS bf16x8*)(Ks + (16 * nt + fr) * 72 + 32 * kk + 8 * fq); acc = __builtin_amdgcn_mfma_f32_16x16x32_bf16(kf, qf[kk], acc, 0, 0, 0); }
#pragma unroll
            for (int i = 0; i < 4; ++i) { const int s = t0 - 128 + 16 * nt + 4 * fq + i, dist = tq0 + fr - s; const bool ok = (s >= 0) && (dist >= 0) && (dist < 128);
                const float v = ok ? acc[i] - slope * (float)dist : -INFINITY; acc[i] = v; mx = fmaxf(mx, v); }
            sc[nt] = acc; if (nt & 1) __builtin_amdgcn_sched_barrier(0); }
        mx = fmaxf(fq_max(mx), sink);
        float sum = 0.f;
#pragma unroll
        for (int nt = 0; nt < 12; ++nt)
#pragma unroll
            for (int i = 0; i < 4; ++i) { const float p = __expf(sc[nt][i] - mx); sc[nt][i] = p; sum += p; }
        sum = fq_sum(sum);
        const float den = sum + __expf(sink - mx);
        bf16x8 pf[6];
#pragma unroll
        for (int ks = 0; ks < 6; ++ks) pf[ks] = pack8(sc[2 * ks], sc[2 * ks + 1]);
        float rden[4];
#pragma unroll
        for (int i = 0; i < 4; ++i) rden[i] = __builtin_amdgcn_rcpf(__shfl(den, 4 * fq + i));
        bf16* op = F.MIX + (row0 + tq0 + 4 * fq) * D + 512 + hq * 64 + fr;
#pragma unroll 1
        for (int dt = 0; dt < 4; ++dt) { f32x4 oacc = (f32x4){0.f, 0.f, 0.f, 0.f};
#pragma unroll
            for (int ks = 0; ks < 6; ++ks) { const LAS bf16* vp = Vt + (16 * dt + fr) * 196 + 32 * ks + 4 * fq;
                const unsigned long long lo = *(const LAS unsigned long long*)vp, hi = *(const LAS unsigned long long*)(vp + 16);
                v4u vv; vv.x = (unsigned)lo; vv.y = (unsigned)(lo >> 32); vv.z = (unsigned)hi; vv.w = (unsigned)(hi >> 32);
                oacc = __builtin_amdgcn_mfma_f32_16x16x32_bf16(pf[ks], __builtin_bit_cast(bf16x8, vv), oacc, 0, 0, 0); }
#pragma unroll
            for (int i = 0; i < 4; ++i) op[(size_t)i * D + 16 * dt] = (bf16)f2bf(oacc[i] * rden[i]); }
    }
    __syncthreads();
}
__device__ __forceinline__ void p3a_prep(Frame& F) {
    LAS unsigned char* wl = F.lds + RING_OFF + F.wave * 19456;
    const int gw = F.vcu * NWAVES + F.wave, NGW = F.G * NWAVES;
    for (int ci = gw; ci < BATCH * 8 * (T / 64); ci += NGW) gdn_prep_chunk(F, ci, wl);
}
__device__ __forceinline__ void p3b_mixers(Frame& F) {
    const int bx = blockIdx.x;
    if (bx < 32) gdn_scan(F, bx);
    else for (int u = bx - 32; u < BATCH * 2 * (T / 64); u += F.G - 32) swa_unit(F, u, F.lds + RING_OFF);
}

struct Args { const float* in[18]; float* out; unsigned char* ws; };
__global__ void __launch_bounds__(NWAVES * 64, 2) hymba_fwd(Args args) {
    extern __shared__ __attribute__((aligned(16))) unsigned char lds[];
    Frame F;
    F.lds = (LAS unsigned char*)lds;
    F.MISC = (volatile LAS unsigned*)(F.lds + MISC_OFF);
    F.tid = threadIdx.x; F.lane = F.tid & 63; F.wave = __builtin_amdgcn_readfirstlane(F.tid >> 6);
    F.G = gridDim.x; { const int bx = blockIdx.x; F.vcu = (F.G % 8 == 0) ? (bx % 8) * (F.G / 8) + bx / 8 : bx; }
    unsigned char* ws = args.ws;
    F.ctl = (gu32*)(ws + WS_CTL);
    F.x = args.in[0]; F.c = args.in[1]; F.w_ada = args.in[2]; F.b_ada = args.in[3]; F.norm1_w = args.in[4]; F.w_in = args.in[5]; F.conv_w = args.in[6];
    F.a_log = args.in[7]; F.dt_bias = args.in[8]; F.gdn_norm_w = args.in[9]; F.q_norm_w = args.in[10]; F.k_norm_w = args.in[11]; F.sinks = args.in[12];
    F.w_out = args.in[13]; F.norm2_w = args.in[14]; F.w_gate = args.in[15]; F.w_up = args.in[16]; F.w_down = args.in[17]; F.out = args.out;
    F.modacc = (float*)(ws + WS_CTL) + CW_MODACC; F.modf = (float*)(ws + WS_MODF); F.wab = (float*)(ws + WS_WAB); F.gb = (float*)(ws + WS_GB); F.gm2 = (float*)(ws + WS_GM2); F.bgu = (float*)(ws + WS_BGU); F.rowss = (float*)(ws + WS_CTL) + CW_ROWSS;
    F.Win_t = (bf16*)(ws + WS_WIN); F.Wout_t = (bf16*)(ws + WS_WOUT); F.Wgu_t = (bf16*)(ws + WS_WGU); F.Wdn_t = (bf16*)(ws + WS_WDN);
    F.H = (bf16*)(ws + WS_H); F.PQ = (bf16*)(ws + WS_PQ); F.MIX = (bf16*)(ws + WS_MIX); F.CHKA = (bf16*)(ws + WS_CHKA); F.CHKU = (bf16*)(ws + WS_H); F.X1B = (bf16*)(ws + WS_CHKA); F.CHKT = (bf16*)(ws + WS_CHKA + 32 * MiB); F.ORAW = (bf16*)(ws + WS_CHKA + 32 * MiB); F.dec = (float*)(ws + WS_DEC);
    for (int u = F.tid; u < (LDS_BYTES - LDSCTL_OFF) / 4; u += NWAVES * 64) ((LAS unsigned*)(F.lds + LDSCTL_OFF))[u] = 0u;
    __syncthreads();
    XcdBarrier bar = xcd_barrier_post((unsigned*)(F.ctl + CW_BAR), F.MISC + 8);
#define GRID_BAR() xcd_barrier(bar)

    p0_prologue(F); GRID_BAR();
    norm_phase<1>(F); GRID_BAR();
    { pg8::Gemm g{F.H, F.Win_t, M, NP, D}; pg8::StaticOrder S; S.init(M, NP, F.G, (int)blockIdx.x);
      pg8::EpiBf16Plain E{F.PQ, NP, C_GZ / 256, C_SQ / 256};
      pg8::gemm_phase<pg8::EpiBf16Plain, pg8::StaticOrder, true, true>(F.lds + RING_OFF, g, S, E); }
    GRID_BAR();
    p3a_prep(F); GRID_BAR();
    p3b_mixers(F); GRID_BAR();
    { pg8::Gemm g{F.MIX, F.Wout_t, M, D, D}; pg8::StaticOrder S; S.init(M, D, F.G, (int)blockIdx.x);
      { pg8::Unit u0; for (int i = 0; S.next(i, u0); ++i) gdn_norm_rows(F, u0.pm * 256); }
      pg8::EpiGateResToBf16 E{F.x, F.X1B, D, F.modf + 2 * D, 6 * D, T};
      pg8::gemm_phase<pg8::EpiGateResToBf16, pg8::StaticOrder, true, true>(F.lds + RING_OFF, g, S, E); }
    GRID_BAR();
    norm_phase<2>(F); GRID_BAR();
    { pg8::Gemm g{F.H, F.Wgu_t, M, NGU, D}; pg8::StaticOrder S; S.init(M, NGU, F.G, (int)blockIdx.x);
      pg8::EpiSwiGLU E{F.PQ, FF};
      pg8::gemm_phase<pg8::EpiSwiGLU, pg8::StaticOrder, true, true>(F.lds + RING_OFF, g, S, E); }
    GRID_BAR();
    { pg8::Gemm g{F.PQ, F.Wdn_t, M, D, FF}; pg8::StaticOrder S; S.init(M, D, F.G, (int)blockIdx.x);
      pg8::EpiGateResFromBf16 E{F.X1B, F.out, D, F.modf + 5 * D, 6 * D, T};
      pg8::gemm_phase<pg8::EpiGateResFromBf16, pg8::StaticOrder, true, true>(F.lds + RING_OFF, g, S, E); }
#undef GRID_BAR
}

extern "C" void kernel_launch(void* const* d_in, const int* in_sizes, int n_in, void* d_out, int out_size, void* d_ws, size_t ws_size, hipStream_t stream) {
    static int grid = 0;
    if (grid == 0) {
        if (n_in != 18 || in_sizes[0] != M * D || out_size != M * D || ws_size < WS_END) { fprintf(stderr, "kernel_launch: unexpected shapes (n_in %d, in0 %d, out %d, ws %zu); nothing launched\n", n_in, n_in > 0 ? in_sizes[0] : -1, out_size, ws_size); grid = -1; return; }
        int dev = 0, cus = 0;
        if (hipGetDevice(&dev) != hipSuccess || hipDeviceGetAttribute(&cus, hipDeviceAttributeMultiprocessorCount, dev) != hipSuccess) { grid = -1; return; }
        if (hipFuncSetAttribute((const void*)hymba_fwd, hipFuncAttributeMaxDynamicSharedMemorySize, LDS_BYTES) != hipSuccess) { fprintf(stderr, "kernel_launch: hipFuncSetAttribute failed\n"); grid = -1; return; }
        (void)hipGetLastError();
        grid = cus;
    }
    if (grid < 0) return;
    if (hipMemsetAsync((char*)d_ws + WS_CTL, 0, CTL_ZERO_BYTES, stream) != hipSuccess) { fprintf(stderr, "kernel_launch: hipMemsetAsync failed\n"); return; }
    Args a{};
    for (int i = 0; i < 18; ++i) a.in[i] = (const float*)d_in[i];
    a.out = (float*)d_out; a.ws = (unsigned char*)d_ws;
    hipLaunchKernelGGL(hymba_fwd, dim3(grid), dim3(NWAVES * 64), LDS_BYTES, stream, a);
    const hipError_t le = hipPeekAtLastError();
    if (le != hipSuccess) fprintf(stderr, "kernel_launch: launch failed: %s\n", hipGetErrorName(le));
}
```

```cpp
#include <hip/hip_runtime.h>
#include <cstdio>
#include <cstdint>
#include <cmath>
namespace pg8 {
#define PG8_LAS __attribute__((address_space(3)))
typedef unsigned short bf16_t;
typedef short bf16x8 __attribute__((ext_vector_type(8)));
typedef float f32x4 __attribute__((ext_vector_type(4)));
typedef unsigned u32x4 __attribute__((ext_vector_type(4)));
constexpr int BM = 256, BK = 64, HALF = 128, HTB = HALF * BK * 2  , STAGE_BYTES = 8 * HTB, NXCD = 8, WGM = 8;

__host__ __device__ __forceinline__ int lds_byte(int r, int c) { const int st = (r >> 4) * 2 + (c >> 5), rr = r & 15, cc = c & 31, ob = rr * 64 + cc * 2; return st * 1024 + (ob ^ (((ob >> 9) & 1) << 5)); }
__host__ __device__ __forceinline__ void stage_rc(int b, int& R, int& C) { const int st = b / 1024, sb = b % 1024, swz = sb ^ (((sb >> 9) & 1) << 5); R = (st >> 1) * 16 + swz / 64; C = (st & 1) * 32 + (swz % 64) / 2; }
__host__ __device__ __forceinline__ int perm32(int rho) { const int n = rho >> 4, i = rho & 15; return 8 * (i >> 2) + 4 * n + (i & 3); }

struct Unit { int pm, pn; };
struct Gemm { const bf16_t* A; const bf16_t* Bt; int M, N, K; };

struct StaticOrder {
    int nM, nN, nwg, G, c;
    __host__ __device__ void init(int M, int N, int G_, int c_) { nM = M / BM; nN = N / BM; nwg = nM * nN; G = G_; c = c_; }
    __host__ __device__ bool next(int i, Unit& u) const {
        const long L = (long)i * G + c; if (L >= nwg) return false;
        int wgid = (int)L; { const int q = nwg / NXCD, r = nwg % NXCD, xcd = wgid % NXCD, off = wgid / NXCD; wgid = (xcd < r ? xcd * (q + 1) : r * (q + 1) + (xcd - r) * q) + off; }
        const int nig = WGM * nN, gid = wgid / nig, fm = gid * WGM, gsz = (nM - fm) < WGM ? (nM - fm) : WGM;
        u.pm = fm + ((wgid % nig) % gsz); u.pn = (wgid % nig) / gsz; return true;
    }
    __device__ __forceinline__ void a_ready(const Unit&) const {}
    __device__ __forceinline__ void done(const Unit&) const {}
};

__device__ __forceinline__ unsigned cvt_pk_bf16(float lo, float hi) { unsigned r; asm volatile("v_cvt_pk_bf16_f32 %0, %1, %2" : "=v"(r) : "v"(lo), "v"(hi)); return r; }
__device__ __forceinline__ float silu_f(float x) { return x * __builtin_amdgcn_rcpf(1.0f + __expf(-x)); }

struct EpiBf16Plain {
    static constexpr bool PERM = true, AFTER_DRAIN = false;
    bf16_t* O; int ldc; int silu_lo, silu_hi;
    __device__ __forceinline__ void operator()(const f32x4 (&acc)[2][2][4][2], const Unit& u, int wr, int wc, int fr, int fq) const {
        const int row0 = u.pm * BM + wr * 64 + fr, col0 = u.pn * BM + wc * 32 + 8 * fq;
        const bool act = (u.pn >= silu_lo) && (u.pn < silu_hi);
#pragma unroll
        for (int ai = 0; ai < 2; ++ai)
#pragma unroll
            for (int m = 0; m < 4; ++m) { bf16_t* rowp = O + (size_t)(row0 + ai * HALF + m * 16) * ldc + col0;
#pragma unroll
                for (int bj = 0; bj < 2; ++bj) { f32x4 v0 = acc[ai][bj][m][0], v1 = acc[ai][bj][m][1];
                    if (act) {
#pragma unroll
                        for (int i = 0; i < 4; ++i) { v0[i] = silu_f(v0[i]); v1[i] = silu_f(v1[i]); } }
                    u32x4 w; w.x = cvt_pk_bf16(v0[0], v0[1]); w.y = cvt_pk_bf16(v0[2], v0[3]); w.z = cvt_pk_bf16(v1[0], v1[1]); w.w = cvt_pk_bf16(v1[2], v1[3]);
                    *(u32x4*)(rowp + bj * HALF) = w; } }
    }
};
struct EpiSwiGLU {
    static constexpr bool PERM = true, AFTER_DRAIN = false;
    bf16_t* O; int ldc;
    __device__ __forceinline__ void operator()(const f32x4 (&acc)[2][2][4][2], const Unit& u, int wr, int wc, int fr, int fq) const {
        const int row0 = u.pm * BM + wr * 64 + fr, col0 = u.pn * HALF + wc * 32 + 8 * fq;
#pragma unroll
        for (int ai = 0; ai < 2; ++ai)
#pragma unroll
            for (int m = 0; m < 4; ++m) { bf16_t* rowp = O + (size_t)(row0 + ai * HALF + m * 16) * ldc + col0;
                const f32x4 g0 = acc[ai][0][m][0], g1 = acc[ai][0][m][1], u0 = acc[ai][1][m][0], u1 = acc[ai][1][m][1];
                float a[8];
#pragma unroll
                for (int i = 0; i < 4; ++i) { a[i] = silu_f(g0[i]) * u0[i]; a[4 + i] = silu_f(g1[i]) * u1[i]; }
                u32x4 w; w.x = cvt_pk_bf16(a[0], a[1]); w.y = cvt_pk_bf16(a[2], a[3]); w.z = cvt_pk_bf16(a[4], a[5]); w.w = cvt_pk_bf16(a[6], a[7]);
                *(u32x4*)rowp = w; }
    }
};
struct EpiGateRes {
    static constexpr bool PERM = false, AFTER_DRAIN = false;
    const float* base; float* out; int ldc; const float* gate; int gstride; int rows_per_batch;
    __device__ __forceinline__ void operator()(const f32x4 (&acc)[2][2][4][2], const Unit& u, int wr, int wc, int fr, int fq) const {
        const int row0 = u.pm * BM + wr * 64 + fr, col0 = u.pn * BM + wc * 32 + 4 * fq;
        const float* gp = gate + (size_t)((u.pm * BM) / rows_per_batch) * gstride + col0;
        f32x4 gv[2][2];
#pragma unroll
        for (int bj = 0; bj < 2; ++bj)
#pragma unroll
            for (int n = 0; n < 2; ++n) gv[bj][n] = *(const f32x4*)(gp + bj * HALF + n * 16);
#pragma unroll
        for (int ai = 0; ai < 2; ++ai)
#pragma unroll
            for (int m = 0; m < 4; ++m) { const size_t off = (size_t)(row0 + ai * HALF + m * 16) * ldc + col0;
#pragma unroll
                for (int bj = 0; bj < 2; ++bj)
#pragma unroll
                    for (int n = 0; n < 2; ++n) { const f32x4 bs = *(const f32x4*)(base + off + bj * HALF + n * 16);
                        *(f32x4*)(out + off + bj * HALF + n * 16) = bs + gv[bj][n] * acc[ai][bj][m][n]; } }
    }
};
struct EpiGateResToBf16 {
    static constexpr bool PERM = false, AFTER_DRAIN = false;
    const float* base; bf16_t* out; int ldc; const float* gate; int gstride; int rows_per_batch;
    __device__ __forceinline__ void operator()(const f32x4 (&acc)[2][2][4][2], const Unit& u, int wr, int wc, int fr, int fq) const {
        const int row0 = u.pm * BM + wr * 64 + fr, col0 = u.pn * BM + wc * 32 + 4 * fq;
        const float* gp = gate + (size_t)((u.pm * BM) / rows_per_batch) * gstride + col0;
        f32x4 gv[2][2];
#pragma unroll
        for (int bj = 0; bj < 2; ++bj)
#pragma unroll
            for (int n = 0; n < 2; ++n) gv[bj][n] = *(const f32x4*)(gp + bj * HALF + n * 16);
#pragma unroll
        for (int ai = 0; ai < 2; ++ai)
#pragma unroll
            for (int m = 0; m < 4; ++m) { const size_t off = (size_t)(row0 + ai * HALF + m * 16) * ldc + col0;
#pragma unroll
                for (int bj = 0; bj < 2; ++bj)
#pragma unroll
                    for (int n = 0; n < 2; ++n) { const f32x4 o = *(const f32x4*)(base + off + bj * HALF + n * 16) + gv[bj][n] * acc[ai][bj][m][n];
                        *(unsigned long long*)(out + off + bj * HALF + n * 16) = (unsigned long long)cvt_pk_bf16(o[0], o[1]) | ((unsigned long long)cvt_pk_bf16(o[2], o[3]) << 32); } }
    }
};
struct EpiGateResFromBf16 {
    static constexpr bool PERM = false, AFTER_DRAIN = false;
    const bf16_t* base; float* out; int ldc; const float* gate; int gstride; int rows_per_batch;
    __device__ __forceinline__ void operator()(const f32x4 (&acc)[2][2][4][2], const Unit& u, int wr, int wc, int fr, int fq) const {
        const int row0 = u.pm * BM + wr * 64 + fr, col0 = u.pn * BM + wc * 32 + 4 * fq;
        const float* gp = gate + (size_t)((u.pm * BM) / rows_per_batch) * gstride + col0;
        f32x4 gv[2][2];
#pragma unroll
        for (int bj = 0; bj < 2; ++bj)
#pragma unroll
            for (int n = 0; n < 2; ++n) gv[bj][n] = *(const f32x4*)(gp + bj * HALF + n * 16);
#pragma unroll
        for (int ai = 0; ai < 2; ++ai)
#pragma unroll
            for (int m = 0; m < 4; ++m) { const size_t off = (size_t)(row0 + ai * HALF + m * 16) * ldc + col0;
#pragma unroll
                for (int bj = 0; bj < 2; ++bj)
#pragma unroll
                    for (int n = 0; n < 2; ++n) { const unsigned long long bb = *(const unsigned long long*)(base + off + bj * HALF + n * 16); const unsigned lo = (unsigned)bb, hi = (unsigned)(bb >> 32);
                        const f32x4 bs = (f32x4){__uint_as_float(lo << 16), __uint_as_float(lo & 0xffff0000u), __uint_as_float(hi << 16), __uint_as_float(hi & 0xffff0000u)};
                        *(f32x4*)(out + off + bj * HALF + n * 16) = bs + gv[bj][n] * acc[ai][bj][m][n]; } }
    }
};

struct PanelRms {
    unsigned* xbuf;
    unsigned* cnt;
    unsigned* tmo;
    int ntn; unsigned code;
    __device__ __forceinline__ bool run(const f32x4 (&v)[2][2][4][2], const Unit& u, int wr, int wc, int fr, int fq, PG8_LAS unsigned char* lds, int wid, int lane) const {
        PG8_LAS float* P = (PG8_LAS float*)lds;
        PG8_LAS float* S = (PG8_LAS float*)(lds + 4096);
        PG8_LAS unsigned* flag = (PG8_LAS unsigned*)(lds + 4096 + 1024);
#pragma unroll
        for (int ai = 0; ai < 2; ++ai)
#pragma unroll
            for (int m = 0; m < 4; ++m) { float s = 0.f;
#pragma unroll
                for (int bj = 0; bj < 2; ++bj)
#pragma unroll
                    for (int n = 0; n < 2; ++n) { const f32x4 x = v[ai][bj][m][n]; s += (x[0] * x[0] + x[1] * x[1]) + (x[2] * x[2] + x[3] * x[3]); }
                s += __shfl_xor(s, 16); s += __shfl_xor(s, 32);
                if (fq == 0) P[(ai * HALF + wr * 64 + m * 16 + fr) * 4 + wc] = s; }
        asm volatile("s_waitcnt lgkmcnt(0)" ::: "memory"); __builtin_amdgcn_s_barrier(); asm volatile("" ::: "memory");
        const int row = wid * 32 + (lane & 31);
        if (lane < 32) { const float t = (P[row * 4 + 0] + P[row * 4 + 1]) + (P[row * 4 + 2] + P[row * 4 + 3]);
            __hip_atomic_store(xbuf + ((size_t)(u.pm * BM + row) * 4 + u.pn), __float_as_uint(t), __ATOMIC_RELAXED, __HIP_MEMORY_SCOPE_AGENT); }
        asm volatile("s_waitcnt vmcnt(0)" ::: "memory");
        if (lane == 0) __hip_atomic_fetch_add(cnt + 64 * u.pm, 1u, __ATOMIC_RELAXED, __HIP_MEMORY_SCOPE_AGENT);
        if (wid == 0) {
            bool dead = false; const unsigned long long t0 = __builtin_amdgcn_s_memrealtime(); const unsigned want = 8u * (unsigned)ntn;
            for (;;) {
                if ((unsigned)__builtin_amdgcn_readfirstlane(__hip_atomic_load(cnt + 64 * u.pm, __ATOMIC_RELAXED, __HIP_MEMORY_SCOPE_AGENT)) >= want) break;
                if (__builtin_amdgcn_s_memrealtime() - t0 > 2000000ull) {
                    if (lane == 0) { unsigned expect = 0u; __hip_atomic_compare_exchange_strong(tmo + 1, &expect, code | (unsigned)(u.pm & 0xff), __ATOMIC_RELAXED, __ATOMIC_RELAXED, __HIP_MEMORY_SCOPE_AGENT);
                                     __hip_atomic_store(tmo, 1u, __ATOMIC_RELAXED, __HIP_MEMORY_SCOPE_AGENT); }
                    dead = true; break; }
                __builtin_amdgcn_s_sleep(2);
            }
            __builtin_amdgcn_fence(__ATOMIC_ACQUIRE, "agent");
            if (lane == 0) flag[0] = dead ? 1u : 0u;
        }
        asm volatile("s_waitcnt vmcnt(0) lgkmcnt(0)" ::: "memory"); __builtin_amdgcn_s_barrier(); asm volatile("" ::: "memory");
        const bool bad = flag[0] != 0u;
        if (lane < 32) { const unsigned* slot = xbuf + (size_t)(u.pm * BM + row) * 4; float t = 0.f;
#pragma unroll
            for (int k = 0; k < 4; ++k) if (k < ntn) t += __uint_as_float(__hip_atomic_load(slot + k, __ATOMIC_RELAXED, __HIP_MEMORY_SCOPE_AGENT));
            S[row] = t; }
        asm volatile("s_waitcnt lgkmcnt(0)" ::: "memory"); __builtin_amdgcn_s_barrier(); asm volatile("" ::: "memory");
        return bad;
    }
};
struct EpiGateResRms {
    static constexpr bool PERM = false, AFTER_DRAIN = true;
    const float* base; float* out; int ldc; const float* gate; const float* gm; const float* sh; int gstride, mstride; int rows_per_batch; bf16_t* xg; PanelRms st; float inv_n, eps;
    __device__ __forceinline__ void fused(f32x4 (&acc)[2][2][4][2], const Unit& u, int wr, int wc, int fr, int fq, PG8_LAS unsigned char* lds, int wid, int lane) const {
        const PG8_LAS float* S = (const PG8_LAS float*)(lds + 4096);
        const int row0 = u.pm * BM + wr * 64 + fr, col0 = u.pn * BM + wc * 32 + 4 * fq, b = (u.pm * BM) / rows_per_batch;
        {
            const float* gp = gate + (size_t)b * gstride + col0;
#pragma unroll
            for (int bj = 0; bj < 2; ++bj)
#pragma unroll
                for (int n = 0; n < 2; ++n) { const f32x4 gv = *(const f32x4*)(gp + bj * HALF + n * 16);
#pragma unroll
                    for (int ai = 0; ai < 2; ++ai)
#pragma unroll
                        for (int m = 0; m < 4; ++m) { const size_t off = (size_t)(row0 + ai * HALF + m * 16) * ldc + col0 + bj * HALF + n * 16;
                            const f32x4 o = *(const f32x4*)(base + off) + gv * acc[ai][bj][m][n]; acc[ai][bj][m][n] = o; *(f32x4*)(out + off) = o; }
                    asm volatile("" ::: "memory"); }
        }
        const bool bad = st.run(acc, u, wr, wc, fr, fq, lds, wid, lane);
        const float* mp = gm + (size_t)b * mstride + col0; const float* sp = sh + (size_t)b * gstride + col0;
#pragma unroll
        for (int bj = 0; bj < 2; ++bj)
#pragma unroll
            for (int n = 0; n < 2; ++n) { const f32x4 mv = *(const f32x4*)(mp + bj * HALF + n * 16), sv = *(const f32x4*)(sp + bj * HALF + n * 16);
#pragma unroll
                for (int ai = 0; ai < 2; ++ai)
#pragma unroll
                    for (int m = 0; m < 4; ++m) { const int r = ai * HALF + wr * 64 + m * 16 + fr; const float rs = __builtin_amdgcn_rsqf(S[r] * inv_n + eps);
                        const f32x4 h = acc[ai][bj][m][n] * rs * mv + sv;
                        unsigned long long w = (unsigned long long)cvt_pk_bf16(h[0], h[1]) | ((unsigned long long)cvt_pk_bf16(h[2], h[3]) << 32);
                        if (bad) w = 0x7fc07fc07fc07fc0ull;
                        *(unsigned long long*)(xg + (size_t)(u.pm * BM + r) * ldc + col0 + bj * HALF + n * 16) = w; } }
    }
};

template <class Epi, class Sched, bool ALIGN_EPI = false, bool SP2 = false>
__device__ __forceinline__ void gemm_phase(PG8_LAS unsigned char* lds, const Gemm g, const Sched& S, const Epi& E) {
    int tid_ = threadIdx.x; asm volatile("" : "+v"(tid_));
    const int tid = tid_, wid = __builtin_amdgcn_readfirstlane(tid >> 6), lane = tid & 63, wr = wid >> 2, wc = wid & 3, fr = lane & 15, fq = lane >> 4;
    const int K = g.K, nt = K / BK;
    unsigned voffA[2], voffB[2];
#pragma unroll
    for (int i = 0; i < 2; ++i) { int R, C; stage_rc(tid * 16 + i * 8192, R, C); const int Rb = Epi::PERM ? ((R & ~31) + perm32(R & 31)) : R;
        voffA[i] = (unsigned)(R * K + C) * 2u; voffB[i] = (unsigned)(Rb * K + C) * 2u; }
    const size_t kstep = (size_t)(BK * 2);
    const size_t hstep = (size_t)HALF * K * 2;
    const size_t tstep = 2 * hstep;
    const unsigned ldsw = (unsigned)wid * 1024u;
    const int aoff = lds_byte(wr * 64 + fr, fq * 8), boff = lds_byte(wc * 32 + fr, fq * 8);
#define PG8_SA(b, h) (((b) * 2 + (h)) * HTB)
#define PG8_SB(b, h) ((4 + (b) * 2 + (h)) * HTB)
#define PG8_STAGE(bufoff, gbase, voff) do { _Pragma("unroll") for (int _i = 0; _i < 2; ++_i) \
        __builtin_amdgcn_global_load_lds((const unsigned*)((const char*)(gbase) + (voff)[_i]), (PG8_LAS unsigned*)(lds + (bufoff) + ldsw + _i * 8192), 16, 0, 0); } while (0)
#define PG8_LDA(dst, b, h) do { _Pragma("unroll") for (int m = 0; m < 4; ++m) _Pragma("unroll") for (int k = 0; k < 2; ++k) dst[m][k] = *(const PG8_LAS bf16x8*)(lds + PG8_SA(b, h) + aoff + m * 2048 + k * 1024); } while (0)
#define PG8_LDB(dst, b, h) do { _Pragma("unroll") for (int n = 0; n < 2; ++n) _Pragma("unroll") for (int k = 0; k < 2; ++k) dst[n][k] = *(const PG8_LAS bf16x8*)(lds + PG8_SB(b, h) + boff + n * 2048 + k * 1024); } while (0)
#define PG8_MMA(ai, bj, At, Bt) do { __builtin_amdgcn_s_setprio(1); _Pragma("unroll") for (int m = 0; m < 4; ++m) _Pragma("unroll") for (int n = 0; n < 2; ++n) _Pragma("unroll") for (int k = 0; k < 2; ++k) \
        acc[ai][bj][m][n] = __builtin_amdgcn_mfma_f32_16x16x32_bf16(Bt[n][k], At[m][k], acc[ai][bj][m][n], 0, 0, 0); __builtin_amdgcn_s_setprio(0); } while (0)
#define PG8_WAIT_V(n) asm volatile("s_waitcnt vmcnt(" #n ")" ::: "memory")
#define PG8_WAIT_L(n) asm volatile("s_waitcnt lgkmcnt(" #n ")" ::: "memory")
#define PG8_BAR __builtin_amdgcn_s_barrier()
#define PG8_SCHED __builtin_amdgcn_sched_barrier(0)
    Unit cur, nxt; int ui = 0;
    if (!S.next(0, cur)) return;
    f32x4 acc[2][2][4][2];
#pragma unroll
    for (int a = 0; a < 2; ++a)
#pragma unroll
        for (int b = 0; b < 2; ++b)
#pragma unroll
            for (int m = 0; m < 4; ++m)
#pragma unroll
                for (int n = 0; n < 2; ++n) acc[a][b][m][n] = (f32x4){0.f, 0.f, 0.f, 0.f};
    bf16x8 At[4][2], B0[2][2], B1[2][2];
    const char* cA = (const char*)g.A + (size_t)cur.pm * tstep; const char* cB = (const char*)g.Bt + (size_t)cur.pn * tstep;
    S.a_ready(cur);
    if constexpr (SP2) {
        PG8_STAGE(PG8_SB(0, 0), cB, voffB); PG8_STAGE(PG8_SB(0, 1), cB + hstep, voffB); PG8_STAGE(PG8_SA(0, 0), cA, voffA); PG8_STAGE(PG8_SA(0, 1), cA + hstep, voffA);
        if (wr == 1) PG8_BAR;
        PG8_WAIT_V(2); PG8_BAR;
        PG8_STAGE(PG8_SB(1, 0), cB + kstep, voffB); PG8_STAGE(PG8_SA(1, 0), cA + kstep, voffA); PG8_STAGE(PG8_SB(1, 1), cB + hstep + kstep, voffB);
        PG8_WAIT_V(6); PG8_BAR;
    } else {
        PG8_STAGE(PG8_SB(0, 0), cB, voffB); PG8_STAGE(PG8_SA(0, 0), cA, voffA); PG8_STAGE(PG8_SB(0, 1), cB + hstep, voffB); PG8_STAGE(PG8_SA(0, 1), cA + hstep, voffA);
        if (wr == 1) PG8_BAR;
        PG8_WAIT_V(4); PG8_BAR;
        PG8_STAGE(PG8_SB(1, 0), cB + kstep, voffB); PG8_STAGE(PG8_SA(1, 0), cA + kstep, voffA); PG8_STAGE(PG8_SB(1, 1), cB + hstep + kstep, voffB);
        PG8_WAIT_V(6); PG8_BAR;
    }
    for (;;) {
        const bool has_next = S.next(ui + 1, nxt);
        const char* nA = has_next ? (const char*)g.A + (size_t)nxt.pm * tstep : cA; const char* nB = has_next ? (const char*)g.Bt + (size_t)nxt.pn * tstep : cB;
        for (int t = 0; t < nt; t += 2) {
            const bool last = (t == nt - 2);
            const char* a1 = cA + (size_t)(t + 1) * kstep;
            const char* a2 = last ? nA : cA + (size_t)(t + 2) * kstep; const char* b2 = last ? nB : cB + (size_t)(t + 2) * kstep;
            const char* a3 = a2 + kstep; const char* b3 = b2 + kstep;
            if (last && has_next) S.a_ready(nxt);
            if constexpr (SP2) {
            PG8_LDB(B0, 0, 0); PG8_LDB(B1, 0, 1); PG8_SCHED; PG8_LDA(At, 0, 0); PG8_STAGE(PG8_SA(1, 1), a1 + hstep, voffA);
            PG8_WAIT_V(8); PG8_WAIT_L(0); PG8_BAR; PG8_MMA(0, 0, At, B0); PG8_MMA(0, 1, At, B1); PG8_BAR; PG8_SCHED;
            PG8_LDA(At, 0, 1); PG8_STAGE(PG8_SB(0, 0), b2, voffB); PG8_STAGE(PG8_SB(0, 1), b2 + hstep, voffB); PG8_STAGE(PG8_SA(0, 0), a2, voffA);
            PG8_WAIT_V(8); PG8_WAIT_L(0); PG8_BAR; PG8_MMA(1, 0, At, B0); PG8_MMA(1, 1, At, B1); PG8_BAR; PG8_SCHED;
            PG8_LDB(B0, 1, 0); PG8_LDB(B1, 1, 1); PG8_SCHED; PG8_LDA(At, 1, 0); PG8_STAGE(PG8_SA(0, 1), a2 + hstep, voffA);
            PG8_WAIT_V(8); PG8_WAIT_L(0); PG8_BAR; PG8_MMA(0, 0, At, B0); PG8_MMA(0, 1, At, B1); PG8_BAR; PG8_SCHED;
            PG8_LDA(At, 1, 1); PG8_STAGE(PG8_SB(1, 0), b3, voffB); PG8_STAGE(PG8_SB(1, 1), b3 + hstep, voffB); PG8_STAGE(PG8_SA(1, 0), a3, voffA);
            PG8_WAIT_V(8); PG8_WAIT_L(0); PG8_BAR; PG8_MMA(1, 0, At, B0); PG8_MMA(1, 1, At, B1); PG8_BAR; PG8_SCHED;
            } else {
            PG8_LDB(B0, 0, 0); PG8_SCHED; PG8_LDA(At, 0, 0); PG8_STAGE(PG8_SA(1, 1), a1 + hstep, voffA);
            PG8_WAIT_L(8); PG8_BAR; PG8_WAIT_L(0); PG8_MMA(0, 0, At, B0); PG8_BAR; PG8_SCHED;
            PG8_LDB(B1, 0, 1); PG8_STAGE(PG8_SB(0, 0), b2, voffB);
            PG8_BAR; PG8_WAIT_L(0); PG8_MMA(0, 1, At, B1); PG8_BAR;
            PG8_LDA(At, 0, 1); PG8_STAGE(PG8_SA(0, 0), a2, voffA);
            PG8_BAR; PG8_WAIT_L(0); PG8_MMA(1, 0, At, B0); PG8_BAR; PG8_SCHED;
            PG8_STAGE(PG8_SB(0, 1), b2 + hstep, voffB);
            PG8_WAIT_V(6); PG8_BAR; PG8_MMA(1, 1, At, B1); PG8_BAR;
            PG8_LDB(B0, 1, 0); PG8_SCHED; PG8_LDA(At, 1, 0); PG8_STAGE(PG8_SA(0, 1), a2 + hstep, voffA);
            PG8_WAIT_L(8); PG8_BAR; PG8_WAIT_L(0); PG8_MMA(0, 0, At, B0); PG8_BAR; PG8_SCHED;
            PG8_LDB(B1, 1, 1); PG8_STAGE(PG8_SB(1, 0), b3, voffB);
            PG8_BAR; PG8_WAIT_L(0); PG8_MMA(0, 1, At, B1); PG8_BAR;
            PG8_LDA(At, 1, 1); PG8_STAGE(PG8_SA(1, 0), a3, voffA);
            PG8_BAR; PG8_WAIT_L(0); PG8_MMA(1, 0, At, B0); PG8_BAR; PG8_SCHED;
            PG8_STAGE(PG8_SB(1, 1), b3 + hstep, voffB);
            PG8_WAIT_V(6); PG8_BAR; PG8_MMA(1, 1, At, B1); PG8_BAR;
            }
        }
        if constexpr (ALIGN_EPI) { if (wr == 0) PG8_BAR; }
        if constexpr (!Epi::AFTER_DRAIN) { E(acc, cur, wr, wc, fr, fq); S.done(cur); }
        if (!has_next) break;
#pragma unroll
        for (int a = 0; a < 2; ++a)
#pragma unroll
            for (int b = 0; b < 2; ++b)
#pragma unroll
                for (int m = 0; m < 4; ++m)
#pragma unroll
                    for (int n = 0; n < 2; ++n) acc[a][b][m][n] = (f32x4){0.f, 0.f, 0.f, 0.f};
        cur = nxt; cA = nA; cB = nB; ++ui;
        if constexpr (ALIGN_EPI) { if (wr == 1) PG8_BAR; }
    }
    PG8_WAIT_V(0);
    if constexpr (!ALIGN_EPI) { if (wr == 0) PG8_BAR; }
    PG8_BAR;
    if constexpr (Epi::AFTER_DRAIN) { E.fused(acc, cur, wr, wc, fr, fq, lds, wid, lane); S.done(cur); }
#undef PG8_SA
#undef PG8_SB
#undef PG8_STAGE
#undef PG8_LDA
#undef PG8_LDB
#undef PG8_MMA
#undef PG8_WAIT_V
#undef PG8_WAIT_L
#undef PG8_BAR
#undef PG8_SCHED
}
}
constexpr int NWAVES = 8;
constexpr int BATCH = 4, T = 4096, D = 1024, M = BATCH * T;
constexpr int PROJ_W = 2832, NP = 2816, FF = 2816, NGU = 2 * FF, HD = 64;
constexpr int C_GQ = 0, C_GK = 512, C_GV = 1024, C_GZ = 1536, C_SQ = 2048, C_SK = 2560, C_SV = 2688;
constexpr float EPS = 1e-6f;
constexpr size_t MiB = 1u << 20;
constexpr size_t WS_CTL = 0, CTL_ZERO_BYTES = 256 * 1024;
constexpr size_t WS_MODF = 1 * MiB;
constexpr size_t WS_WAB = 1 * MiB + 256 * 1024;
constexpr size_t WS_GB = 2 * MiB;
constexpr size_t WS_WIN = 4 * MiB, WS_WOUT = 10 * MiB, WS_WGU = 12 * MiB, WS_WDN = 24 * MiB;
constexpr size_t WS_H = 32 * MiB;
constexpr size_t WS_PQ = 64 * MiB;
constexpr size_t WS_MIX = 160 * MiB;
constexpr size_t WS_CHKA = 192 * MiB;
constexpr size_t WS_DEC = 1 * MiB + 384 * 1024;
constexpr size_t WS_XBUF = 1 * MiB + 600 * 1024;
constexpr size_t WS_GM2 = 1 * MiB + 400 * 1024;
constexpr size_t WS_BGU = 1 * MiB + 448 * 1024;
constexpr size_t WS_END = 256 * MiB;
constexpr int CW_BAR = 4096;
constexpr int CW_PANEL = 49152;
constexpr int CW_ROWSS = 65536;
constexpr int CW_MODACC = 16384;
constexpr int RING_OFF = 0, RING_BYTES = 131072;
constexpr int LDS_BYTES = 163840;
constexpr int LDSCTL_OFF = LDS_BYTES - 1024, MISC_OFF = LDSCTL_OFF + 320;
#define GAS __attribute__((address_space(1)))
#define LAS __attribute__((address_space(3)))
typedef unsigned short bf16;
typedef unsigned v4u __attribute__((ext_vector_type(4)));
typedef float f32x4 __attribute__((ext_vector_type(4)));
typedef short bf16x8 __attribute__((ext_vector_type(8)));
typedef GAS unsigned gu32;
typedef GAS unsigned long long gu64;
#define RLX_AGENT __ATOMIC_RELAXED, __HIP_MEMORY_SCOPE_AGENT
#define LDS_WAIT() asm volatile("s_waitcnt lgkmcnt(0)" ::: "memory")
#define VM_WAIT() asm volatile("s_waitcnt vmcnt(0)" ::: "memory")
__device__ __forceinline__ unsigned long long rt() { return __builtin_amdgcn_s_memrealtime(); }
__device__ __forceinline__ unsigned f2bf(float f) { unsigned u = __builtin_bit_cast(unsigned, f); return (u + 0x7fffu + ((u >> 16) & 1u)) >> 16; }
__device__ __forceinline__ unsigned pk2(float lo, float hi) { return f2bf(lo) | (f2bf(hi) << 16); }

#define XB_TMO      128
#define XB_XCNT(j)  (256  + 64 * (j))
#define XB_XSUB(j)  (1280 + 64 * (j))
#define XB_XGEN(j)  (2304 + 64 * (j))
#define XB_TOP      3328
#define XB_TOPGEN   3392
#define XCD_BAR_WORDS 3456
#define XB_SPIN_CAP (1u << 22)

__device__ __forceinline__ unsigned xb_ld(unsigned* p)              { return __hip_atomic_load(p, __ATOMIC_RELAXED, __HIP_MEMORY_SCOPE_AGENT); }
__device__ __forceinline__ unsigned xb_add(unsigned* p, unsigned v) { return __hip_atomic_fetch_add(p, v, __ATOMIC_RELAXED, __HIP_MEMORY_SCOPE_AGENT); }
__device__ __forceinline__ unsigned xb_xcc_id() { return (unsigned)__builtin_amdgcn_s_getreg((3 << 11) | 20) & 0xFu; }
#define XB_SPIN(cond, bar) do { unsigned _sp = 0; while (cond) { __builtin_amdgcn_s_sleep(1); \
    if ((++_sp & 255u) == 0u) { if (xb_ld(&(bar)[XB_TMO])) break; if (_sp > XB_SPIN_CAP) { atomicAdd(&(bar)[XB_TMO], 1u); break; } } } } while (0)

struct XcdBarrier {
    unsigned* bar; unsigned x;
    volatile LAS unsigned* st;
};

__device__ __forceinline__ XcdBarrier xcd_barrier_post(unsigned* bar, volatile LAS unsigned* st) {
    XcdBarrier b; b.bar = bar; b.x = xb_xcc_id(); b.st = st;
    if (threadIdx.x == 0) (void)xb_add(&bar[XB_XCNT(b.x)], 1u);
    return b;
}
__device__ __forceinline__ void xcd_barrier_complete(unsigned* bar, unsigned x, unsigned& nloc, unsigned& nx) {
    const unsigned G = gridDim.x * gridDim.y * gridDim.z;
    unsigned sum, cnt, mine, sp = 0u;
    for (;;) {
        sum = 0u; cnt = 0u; mine = 0u;
#pragma unroll
        for (unsigned j = 0; j < 16; ++j) { const unsigned c = xb_ld(&bar[XB_XCNT(j)]); sum += c; cnt += (c > 0u) ? 1u : 0u; mine = (j == x) ? c : mine; }
        if (sum == G) break;
        __builtin_amdgcn_s_sleep(1);
        if ((++sp & 255u) == 0u) { if (xb_ld(&bar[XB_TMO])) break; if (sp > XB_SPIN_CAP) { atomicAdd(&bar[XB_TMO], 1u); break; } }
    }
    nloc = mine > 0u ? mine : 1u; nx = cnt > 0u ? cnt : 1u;
}

__device__ __forceinline__ void xcd_barrier(const XcdBarrier& b) {
    asm volatile("s_waitcnt vmcnt(0)" ::: "memory");
    __syncthreads();
    if (threadIdx.x == 0) {
        unsigned* bar = b.bar;
        __builtin_amdgcn_s_waitcnt(0);
        unsigned nloc = b.st[0], nx = b.st[1];
        if (nloc == 0u) { xcd_barrier_complete(bar, b.x, nloc, nx); b.st[0] = nloc; b.st[1] = nx; }
        const unsigned old = xb_add(&bar[XB_XSUB(b.x)], 1u);
        const unsigned gen = old / nloc;
        if (old + 1u == (gen + 1u) * nloc) {
            __builtin_amdgcn_fence(__ATOMIC_RELEASE, "agent");
            asm volatile("s_waitcnt vmcnt(0)" ::: "memory");
            const unsigned og = xb_add(&bar[XB_TOP], 1u);
            const unsigned tg = og / nx;
            if (og + 1u == (tg + 1u) * nx) xb_add(&bar[XB_TOPGEN], 1u);
            else XB_SPIN(xb_ld(&bar[XB_TOPGEN]) == tg, bar);
            __builtin_amdgcn_fence(__ATOMIC_ACQUIRE, "agent");
            xb_add(&bar[XB_XGEN(b.x)], 1u);
            asm volatile("s_waitcnt vmcnt(0)" ::: "memory");
        } else {
            XB_SPIN(xb_ld(&bar[XB_XGEN(b.x)]) == gen, bar);
            __builtin_amdgcn_fence(__ATOMIC_ACQUIRE, "agent");
            asm volatile("s_waitcnt vmcnt(0)" ::: "memory");
        }
    }
    __syncthreads();
}
struct Frame {
    LAS unsigned char* lds;
    volatile LAS unsigned* MISC;
    gu32* ctl;
    int tid, lane, wave;
    int vcu, G;
    const float *x, *c, *w_ada, *b_ada, *norm1_w, *w_in, *conv_w, *a_log, *dt_bias, *gdn_norm_w, *q_norm_w, *k_norm_w, *sinks, *w_out, *norm2_w, *w_gate, *w_up, *w_down;
    float* out;
    float *modacc, *modf, *wab, *gb, *gm2, *bgu, *rowss, *dec;
    bf16 *Win_t, *Wout_t, *Wgu_t, *Wdn_t, *H, *PQ, *MIX, *X1B, *CHKA, *CHKU, *CHKT, *ORAW;
};
template <int CTRL, int ROWMASK, bool BC>
__device__ __forceinline__ float dpp_mov(float v) { return __int_as_float(__builtin_amdgcn_update_dpp(0, __float_as_int(v), CTRL, ROWMASK, 0xF, BC)); }
__device__ __forceinline__ float sum8(float v) { v += dpp_mov<0xB1, 0xF, true>(v); v += dpp_mov<0x4E, 0xF, true>(v); v += dpp_mov<0x141, 0xF, true>(v); return v; }
__device__ __forceinline__ float wave_sum(float v) {
    v = sum8(v); v += dpp_mov<0x140, 0xF, true>(v);
    v += dpp_mov<0x142, 0xA, false>(v); v += dpp_mov<0x143, 0xC, false>(v);
    return __int_as_float(__builtin_amdgcn_readlane(__float_as_int(v), 63));
}
__device__ __forceinline__ float fq_sum(float v) {
    auto r = __builtin_amdgcn_permlane16_swap(__float_as_uint(v), __float_as_uint(v), false, false); v = __uint_as_float(r[0]) + __uint_as_float(r[1]);
    auto s = __builtin_amdgcn_permlane32_swap(__float_as_uint(v), __float_as_uint(v), false, false); return __uint_as_float(s[0]) + __uint_as_float(s[1]);
}
__device__ __forceinline__ float fq_max(float v) {
    auto r = __builtin_amdgcn_permlane16_swap(__float_as_uint(v), __float_as_uint(v), false, false); v = fmaxf(__uint_as_float(r[0]), __uint_as_float(r[1]));
    auto s = __builtin_amdgcn_permlane32_swap(__float_as_uint(v), __float_as_uint(v), false, false); return fmaxf(__uint_as_float(s[0]), __uint_as_float(s[1]));
}
typedef float f32x2_t __attribute__((ext_vector_type(2))); typedef __bf16 bf16x2_t __attribute__((ext_vector_type(2)));
__device__ __forceinline__ unsigned cvtpk(float lo, float hi) { f32x2_t v = {lo, hi}; bf16x2_t b = __builtin_convertvector(v, bf16x2_t); return __builtin_bit_cast(unsigned, b); }
__device__ __forceinline__ float bf2f(bf16 h) { return __uint_as_float((unsigned)h << 16); }
__device__ __forceinline__ float ld_f32_coh(const float* p) { return __uint_as_float(__hip_atomic_load((const unsigned*)p, RLX_AGENT)); }
__device__ __forceinline__ float silu(float x) { return x * __builtin_amdgcn_rcpf(1.0f + __expf(-x)); }
__device__ __forceinline__ float rsq(float x) { return __builtin_amdgcn_rsqf(x); }

__device__ __forceinline__ void tr_item64(const float* W, int ldw, int src_col, bf16* WT, int K, int dst_row, int k0, LAS bf16* tl, int lane) {
    const int cg = lane & 15, rr = lane >> 4;
    f32x4 v[16];
#pragma unroll
    for (int i = 0; i < 16; ++i) v[i] = *(const GAS f32x4*)(W + (size_t)(k0 + 4 * i + rr) * ldw + src_col + 4 * cg);
#pragma unroll
    for (int i = 0; i < 16; ++i) *(LAS unsigned long long*)(tl + (4 * i + rr) * 68 + 4 * cg) = (unsigned long long)cvtpk(v[i].x, v[i].y) | ((unsigned long long)cvtpk(v[i].z, v[i].w) << 32);
    LDS_WAIT(); asm volatile("" ::: "memory");
#pragma unroll
    for (int ii = 0; ii < 8; ++ii) { const int p = lane + 64 * ii, n = p >> 3, kc = p & 7; const LAS bf16* s = tl + (8 * kc) * 68 + n;
        v4u o; o.x = (unsigned)s[0] | ((unsigned)s[68] << 16); o.y = (unsigned)s[2 * 68] | ((unsigned)s[3 * 68] << 16); o.z = (unsigned)s[4 * 68] | ((unsigned)s[5 * 68] << 16); o.w = (unsigned)s[6 * 68] | ((unsigned)s[7 * 68] << 16);
        *(GAS v4u*)(WT + (size_t)(dst_row + n) * K + k0 + 8 * kc) = o; }
    LDS_WAIT(); asm volatile("" ::: "memory");
}

__device__ __forceinline__ void p0_prologue(Frame& F) {
    LAS bf16* tl = (LAS bf16*)(F.lds + RING_OFF + F.wave * 16384);
    const int gw = F.vcu * NWAVES + F.wave, NGW = F.G * NWAVES, lane = F.lane;
    constexpr int I_ADA = 24 * 32, I_AB = 16, I_IN = 16 * (NP / 64), I_OUT = 16 * 16, I_GU = 16 * (NGU / 64), I_DN = (FF / 64) * 16;
    constexpr int NITEMS = I_ADA + I_AB + I_IN + I_OUT + I_GU + I_DN;
    for (int it = gw; it < NITEMS; it += NGW) {
        int r = it;
        if (r < I_ADA) {
            const int ct = r % 24, ks = r / 24, col = ct * 256 + 4 * lane, k0 = ks * 32;
            f32x4 acc[4];
#pragma unroll
            for (int b = 0; b < 4; ++b) acc[b] = (f32x4){0.f, 0.f, 0.f, 0.f};
#pragma unroll 16
            for (int kk = 0; kk < 32; ++kk) { const int k = k0 + kk; const f32x4 w = *(const GAS f32x4*)(F.w_ada + (size_t)k * (6 * D) + col);
#pragma unroll
                for (int b = 0; b < 4; ++b) acc[b] += silu(F.c[b * D + k]) * w; }
#pragma unroll
            for (int b = 0; b < 4; ++b)
#pragma unroll
                for (int j = 0; j < 4; ++j) atomicAdd(F.modacc + b * (6 * D) + col + j, acc[b][j]);
            continue;
        }
        r -= I_ADA;
        if (r < I_AB) {
            for (int i = 0; i < 16; ++i) { const int k = i * 64 + lane; F.wab[r * D + k] = F.w_in[(size_t)k * PROJ_W + 2048 + r]; }
            continue;
        }
        r -= I_AB;
        if (r < I_IN) { const int nb = r % (NP / 64), kb = r / (NP / 64), n0 = 64 * nb; tr_item64(F.w_in, PROJ_W, n0 < 2048 ? n0 : n0 + 16, F.Win_t, D, n0, 64 * kb, tl, lane); continue; }
        r -= I_IN;
        if (r < I_OUT) { const int nb = r % 16, kb = r / 16; tr_item64(F.w_out, D, 64 * nb, F.Wout_t, D, 64 * nb, 64 * kb, tl, lane); continue; }
        r -= I_OUT;
        if (r < I_GU) { const int nb = r % (NGU / 64), kb = r / (NGU / 64), n0 = 64 * nb, p = n0 >> 8, j = n0 & 255;
            if (j < 128) tr_item64(F.w_gate, FF, 128 * p + j, F.Wgu_t, D, n0, 64 * kb, tl, lane);
            else         tr_item64(F.w_up,   FF, 128 * p + j - 128, F.Wgu_t, D, n0, 64 * kb, tl, lane);
            continue; }
        r -= I_GU;
        { const int nb = r % 16, kb = r / 16; tr_item64(F.w_down, D, 64 * nb, F.Wdn_t, FF, 64 * nb, 64 * kb, tl, lane); }
    }
}

template <int WHICH, bool GAB = (WHICH == 1)> __device__ __forceinline__ void norm_phase(Frame& F) {
    const int gw = F.vcu * NWAVES + F.wave, NGW = F.G * NWAVES, lane = F.lane;
    if (WHICH == 1) {
        for (int idx = gw * 64 + lane; idx < 4 * 6 * D; idx += NGW * 64) F.modf[idx] = F.modacc[idx] + F.b_ada[idx % (6 * D)];
        for (int idx = gw * 64 + lane; idx < 4 * D; idx += NGW * 64) { const int b_ = idx / D, c_ = idx % D; F.gm2[idx] = F.norm2_w[c_] * (1.0f + F.modacc[b_ * 6 * D + 4 * D + c_] + F.b_ada[4 * D + c_]); }
    }
    if (GAB) {
        for (int i = F.tid; i < 16 * D / 4; i += NWAVES * 64) ((LAS f32x4*)(F.lds + RING_OFF))[i] = ((const GAS f32x4*)F.wab)[i];
        __syncthreads();
    }
    const float* src = (WHICH == 1) ? F.x : F.out;
    const float* nw = (WHICH == 1) ? F.norm1_w : F.norm2_w;
    for (int m0 = gw * 4; m0 < M; m0 += NGW * 4) {
        const int b = m0 / T;
        float gm[16], sh[16];
#pragma unroll
        for (int i = 0; i < 4; ++i)
#pragma unroll
            for (int e = 0; e < 4; ++e) { const int c = 256 * i + 4 * lane + e; float sc, sf;
                if (WHICH == 1) { sf = F.modacc[b * 6 * D + c] + F.b_ada[c]; sc = F.modacc[b * 6 * D + D + c] + F.b_ada[D + c];     }
                else { sf = F.modf[b * 6 * D + 3 * D + c]; sc = F.modf[b * 6 * D + 4 * D + c]; }
                gm[4 * i + e] = nw[c] * (1.0f + sc); sh[4 * i + e] = sf; }
        float h[4][16];
        f32x4 v[4][4];
#pragma unroll
        for (int r = 0; r < 4; ++r) {
            if (WHICH == 1) { const GAS f32x4* xr = (const GAS f32x4*)(src + (size_t)(m0 + r) * D) + lane;
#pragma unroll
                for (int i = 0; i < 4; ++i) v[r][i] = xr[64 * i]; }
            else { const GAS unsigned long long* xr = (const GAS unsigned long long*)(F.X1B + (size_t)(m0 + r) * D) + lane;
#pragma unroll
                for (int i = 0; i < 4; ++i) { const unsigned long long bb = xr[64 * i]; const unsigned lo = (unsigned)bb, hi = (unsigned)(bb >> 32);
                    v[r][i] = (f32x4){__uint_as_float(lo << 16), __uint_as_float(lo & 0xffff0000u), __uint_as_float(hi << 16), __uint_as_float(hi & 0xffff0000u)}; } } }
#pragma unroll
        for (int r = 0; r < 4; ++r) {
            float ss = 0.f;
#pragma unroll
            for (int i = 0; i < 4; ++i) ss += (v[r][i].x * v[r][i].x + v[r][i].y * v[r][i].y) + (v[r][i].z * v[r][i].z + v[r][i].w * v[r][i].w);
            const float rstd = rsq(wave_sum(ss) * (1.0f / D) + EPS);
            GAS unsigned long long* o8 = (GAS unsigned long long*)(F.H + (size_t)(m0 + r) * D) + lane;
#pragma unroll
            for (int i = 0; i < 4; ++i) {
                const float a0 = v[r][i].x * rstd * gm[4 * i + 0] + sh[4 * i + 0], a1 = v[r][i].y * rstd * gm[4 * i + 1] + sh[4 * i + 1];
                const float a2 = v[r][i].z * rstd * gm[4 * i + 2] + sh[4 * i + 2], a3 = v[r][i].w * rstd * gm[4 * i + 3] + sh[4 * i + 3];
                h[r][4 * i + 0] = a0; h[r][4 * i + 1] = a1; h[r][4 * i + 2] = a2; h[r][4 * i + 3] = a3;
                o8[64 * i] = (unsigned long long)cvtpk(a0, a1) | ((unsigned long long)cvtpk(a2, a3) << 32); }
        }
        if (GAB) {
            float myv = 0.f;
#pragma unroll 4
            for (int j = 0; j < 16; ++j) {
                const LAS f32x4* wp = (const LAS f32x4*)(F.lds + RING_OFF) + j * (D / 4) + lane;
                f32x4 wv[4];
#pragma unroll
                for (int i = 0; i < 4; ++i) wv[i] = wp[64 * i];
#pragma unroll
                for (int r = 0; r < 4; ++r) { float p = 0.f;
#pragma unroll
                    for (int i = 0; i < 4; ++i) p += (h[r][4 * i] * wv[i].x + h[r][4 * i + 1] * wv[i].y) + (h[r][4 * i + 2] * wv[i].z + h[r][4 * i + 3] * wv[i].w);
                    p = wave_sum(p);
                    if (lane == r * 16 + j) myv = p; }
            }
            const int j = lane & 15, hh = j & 7;
            float val;
            if (j < 8) { const float xx = myv + F.dt_bias[hh]; const float sp = fmaxf(xx, 0.f) + log1pf(__expf(-fabsf(xx))); val = -__expf(F.a_log[hh]) * sp; }
            else val = 1.0f / (1.0f + __expf(-myv));
            F.gb[(size_t)m0 * 16 + lane] = val;
        }
    }
}

__device__ __forceinline__ float rdlane(float v, int l) { return __int_as_float(__builtin_amdgcn_readlane(__float_as_int(v), l)); }
__device__ __forceinline__ bf16x8 pack8(const f32x4 a, const f32x4 b) {
    v4u w; w.x = cvtpk(a[0], a[1]); w.y = cvtpk(a[2], a[3]); w.z = cvtpk(b[0], b[1]); w.w = cvtpk(b[2], b[3]); return __builtin_bit_cast(bf16x8, w); }
__device__ __forceinline__ bf16x8 tile_frag(const LAS bf16* tile, int t, int ks, int fr, int fq) {
    const LAS bf16* p = tile + (16 * t + fr) * 64 + 32 * ks + 4 * fq;
    const unsigned long long lo = *(const LAS unsigned long long*)p, hi = *(const LAS unsigned long long*)(p + 16);
    v4u v; v.x = (unsigned)lo; v.y = (unsigned)(lo >> 32); v.z = (unsigned)hi; v.w = (unsigned)(hi >> 32); return __builtin_bit_cast(bf16x8, v);
}
__device__ __forceinline__ float arow(unsigned packed, int hi, int s) { const unsigned u = (unsigned)__builtin_amdgcn_readlane((int)packed, s); return __uint_as_float(hi ? (u & 0xffff0000u) : (u << 16)); }
__device__ __forceinline__ unsigned long long pack4(float a, float b, float c, float d) { return (unsigned long long)cvtpk(a, b) | ((unsigned long long)cvtpk(c, d) << 32); }

typedef short s16x4 __attribute__((ext_vector_type(4)));
__device__ __forceinline__ s16x4 cvt4(const f32x4 v) { const unsigned lo = cvtpk(v[0], v[1]), hi = cvtpk(v[2], v[3]); typedef unsigned u32x2 __attribute__((ext_vector_type(2))); return __builtin_bit_cast(s16x4, (u32x2){lo, hi}); }
#define MFMA16(a, b, c) __builtin_amdgcn_mfma_f32_16x16x16bf16_1k((a), (b), (c), 0, 0, 0)
#define MFMA32(a, b, c) __builtin_amdgcn_mfma_f32_16x16x32_bf16((a), (b), (c), 0, 0, 0)

__device__ __forceinline__ void gdn_prep_chunk(Frame& F, int ci, LAS unsigned char* wl  ) {
    const int lane = F.lane, bh = ci >> 6, n = ci & 63, b = bh >> 3, hh = bh & 7, fr = lane & 15, fq = lane >> 4;
    const size_t m0 = (size_t)b * T + 64 * n;
    bf16* const cA = F.CHKA + (size_t)ci * 8192;
    bf16* const cT = F.CHKT + (size_t)ci * 8192;
    bf16* const cU = F.CHKU + (size_t)ci * 8192;
    LAS bf16* const R0 = (LAS bf16*)wl;
    LAS bf16* const R1 = (LAS bf16*)(wl + 9728);
#define GDN_RAW(dst, col0) do { _Pragma("unroll") for (int i_ = 0; i_ < 9; ++i_) { long row_ = (long)m0 - 3 + 8 * i_ + (lane >> 3); row_ = row_ < 0 ? 0 : (row_ > M - 1 ? M - 1 : row_); \
        __builtin_amdgcn_global_load_lds((const unsigned*)(F.PQ + (size_t)row_ * NP + (col0) + hh * 64 + (lane & 7) * 8), (LAS unsigned*)((dst) + i_ * 512), 16, 0, 0); } } while (0)
    GDN_RAW(R0, C_GQ); GDN_RAW(R1, C_GK);
    const f32x4 z4 = (f32x4){0.f, 0.f, 0.f, 0.f};
    const float g = ld_f32_coh(F.gb + (m0 + lane) * 16 + hh), beta = ld_f32_coh(F.gb + (m0 + lane) * 16 + 8 + hh);
    float G = g;
#pragma unroll
    for (int o = 1; o < 64; o <<= 1) { const float t = __shfl_up(G, o); if (lane >= o) G += t; }
    const float eG = __expf(G), Glast = __shfl(G, 63), kdsc = __expf(Glast - G), beG = beta * eG;
    if (lane == 0) F.dec[ci] = __expf(Glast);
    asm volatile("s_waitcnt vmcnt(0)" ::: "memory");
    {
        const float a0 = F.conv_w[hh * 64 + lane], a1 = F.conv_w[1536 + hh * 64 + lane], a2 = F.conv_w[2 * 1536 + hh * 64 + lane], a3 = F.conv_w[3 * 1536 + hh * 64 + lane];
        const float b0 = F.conv_w[512 + hh * 64 + lane], b1 = F.conv_w[1536 + 512 + hh * 64 + lane], b2 = F.conv_w[2 * 1536 + 512 + hh * 64 + lane], b3 = F.conv_w[3 * 1536 + 512 + hh * 64 + lane];
        float x0 = 0.f, x1 = 0.f, x2 = 0.f, y0 = 0.f, y1 = 0.f, y2 = 0.f;
        if (n > 0) { x0 = bf2f(R0[lane]); x1 = bf2f(R0[64 + lane]); x2 = bf2f(R0[128 + lane]); y0 = bf2f(R1[lane]); y1 = bf2f(R1[64 + lane]); y2 = bf2f(R1[128 + lane]); }
#pragma unroll
        for (int c = 0; c < 64; ++c) {
            const float rq = bf2f(R0[(c + 3) * 64 + lane]), rk = bf2f(R1[(c + 3) * 64 + lane]);
            const float cq = silu(a0 * x0 + a1 * x1 + a2 * x2 + a3 * rq), ck = silu(b0 * y0 + b1 * y1 + b2 * y2 + b3 * rk);
            x0 = x1; x1 = x2; x2 = rq; y0 = y1; y1 = y2; y2 = rk;
            R0[c * 64 + lane] = (bf16)(cvtpk(cq, cq) & 0xffffu);
            R1[c * 64 + lane] = (bf16)(cvtpk(ck, ck) & 0xffffu);
            if ((c & 15) == 15) __builtin_amdgcn_sched_barrier(0);
        }
    }
    LDS_WAIT(); asm volatile("" ::: "memory"); __builtin_amdgcn_sched_barrier(0);
    bf16x8 kf[4][2], qf[4][2];
#pragma unroll
    for (int blk = 0; blk < 4; ++blk)
#pragma unroll
        for (int kk = 0; kk < 2; ++kk) { kf[blk][kk] = *(const LAS bf16x8*)(R1 + (16 * blk + fr) * 64 + 32 * kk + 8 * fq); qf[blk][kk] = *(const LAS bf16x8*)(R0 + (16 * blk + fr) * 64 + 32 * kk + 8 * fq); }
    float rqc[4], rkc[4];
#pragma unroll
    for (int t = 0; t < 4; ++t) { f32x4 dq = MFMA32(qf[t][0], qf[t][0], z4); dq = MFMA32(qf[t][1], qf[t][1], dq); f32x4 dk = MFMA32(kf[t][0], kf[t][0], z4); dk = MFMA32(kf[t][1], kf[t][1], dk);
        const int di = fr & 3; const bool on = (fq == (fr >> 2));
        const float vq = di == 0 ? dq[0] : di == 1 ? dq[1] : di == 2 ? dq[2] : dq[3], vk = di == 0 ? dk[0] : di == 1 ? dk[1] : di == 2 ? dk[2] : dk[3];
        rqc[t] = rsq(fq_sum(on ? vq : 0.f) + EPS); rkc[t] = rsq(fq_sum(on ? vk : 0.f) + EPS); }
    const float rk_tok = fq == 0 ? rkc[0] : fq == 1 ? rkc[1] : fq == 2 ? rkc[2] : rkc[3];
    const float beGn = beG * rk_tok, kdscn = kdsc * rk_tok;
    float Gcol[4], Bcol[4];
#pragma unroll
    for (int t = 0; t < 4; ++t) { Gcol[t] = __shfl(G, 16 * t + fr); Bcol[t] = __shfl(beta, 16 * t + fr) * rkc[t]; }
#pragma unroll
    for (int mt = 0; mt < 4; ++mt) { const float esc = __expf(Gcol[mt]) * 0.125f * rqc[mt];
#pragma unroll
        for (int ks = 0; ks < 2; ++ks) { const v4u q8 = __builtin_bit_cast(v4u, tile_frag(R0, mt, ks, fr, fq)); const unsigned w_[4] = {q8.x, q8.y, q8.z, q8.w}; v4u o_;
            o_.x = cvtpk(__uint_as_float(w_[0] << 16) * esc, __uint_as_float(w_[0] & 0xffff0000u) * esc); o_.y = cvtpk(__uint_as_float(w_[1] << 16) * esc, __uint_as_float(w_[1] & 0xffff0000u) * esc);
            o_.z = cvtpk(__uint_as_float(w_[2] << 16) * esc, __uint_as_float(w_[2] & 0xffff0000u) * esc); o_.w = cvtpk(__uint_as_float(w_[3] << 16) * esc, __uint_as_float(w_[3] & 0xffff0000u) * esc);
            *(GAS v4u*)(cT + ((mt * 2 + ks) * 64 + lane) * 8) = o_; } }
    LDS_WAIT(); asm volatile("" ::: "memory"); __builtin_amdgcn_sched_barrier(0);
#pragma unroll
    for (int ks = 0; ks < 2; ++ks) { float Grow[2][4], Krow[2][4];
#pragma unroll
        for (int h2 = 0; h2 < 2; ++h2)
#pragma unroll
            for (int i = 0; i < 4; ++i) { Grow[h2][i] = __shfl(G, 16 * (2 * ks + h2) + 4 * fq + i); Krow[h2][i] = __shfl(rk_tok, 16 * (2 * ks + h2) + 4 * fq + i); }
#pragma unroll
        for (int tc = 0; tc < 4; ++tc) {
            f32x4 v[2];
#pragma unroll
            for (int h2 = 0; h2 < 2; ++h2) { const int ts = 2 * ks + h2;
                if (ts <= tc) { f32x4 acc = MFMA32(kf[ts][0], qf[tc][0], z4); acc = MFMA32(kf[ts][1], qf[tc][1], acc);
#pragma unroll
                    for (int i = 0; i < 4; ++i) { const int cidx = 16 * tc + fr, sidx = 16 * ts + 4 * fq + i; v[h2][i] = (cidx >= sidx) ? acc[i] * __expf(Gcol[tc] - Grow[h2][i]) * (0.125f * rqc[tc]) * Krow[h2][i] : 0.f; }
                } else v[h2] = z4; }
            *(bf16x8*)(cT + 4096 + ((tc * 2 + ks) * 64 + lane) * 8) = pack8(v[0], v[1]);
        } }
#pragma unroll
    for (int ts = 0; ts < 4; ++ts) { float Grow[4], Krow[4];
#pragma unroll
        for (int i = 0; i < 4; ++i) { Grow[i] = __shfl(G, 16 * ts + 4 * fq + i); Krow[i] = __shfl(rk_tok, 16 * ts + 4 * fq + i); }
#pragma unroll
        for (int tc = 0; tc < 4; ++tc) { f32x4 a = z4;
            if (ts <= tc) { f32x4 acc = MFMA32(kf[ts][0], kf[tc][0], z4); acc = MFMA32(kf[ts][1], kf[tc][1], acc);
#pragma unroll
                for (int i = 0; i < 4; ++i) { const int cidx = 16 * tc + fr, sidx = 16 * ts + 4 * fq + i; a[i] = (cidx > sidx) ? Bcol[tc] * Krow[i] * acc[i] * __expf(Gcol[tc] - Grow[i]) : 0.f; } }
            *(LAS unsigned long long*)(R0 + (16 * tc + fr) * 64 + 16 * ts + 4 * fq) = pack4(a[0], a[1], a[2], a[3]); } }
    bf16x8 RkB[4][2], KDf[4][2];
#pragma unroll
    for (int ks = 0; ks < 2; ++ks) { float sB[8], sD[8];
#pragma unroll
        for (int j = 0; j < 8; ++j) { const int tok = 32 * ks + 16 * (j >> 2) + 4 * fq + (j & 3); sB[j] = __shfl(beGn, tok); sD[j] = __shfl(kdscn, tok); }
#pragma unroll
        for (int t = 0; t < 4; ++t) { float kv[8];
#pragma unroll
            for (int j = 0; j < 8; ++j) kv[j] = bf2f(R1[(32 * ks + 16 * (j >> 2) + 4 * fq + (j & 3)) * 64 + 16 * t + fr]);
            v4u a_, d_;
            a_.x = cvtpk(kv[0] * sB[0], kv[1] * sB[1]); a_.y = cvtpk(kv[2] * sB[2], kv[3] * sB[3]); a_.z = cvtpk(kv[4] * sB[4], kv[5] * sB[5]); a_.w = cvtpk(kv[6] * sB[6], kv[7] * sB[7]);
            d_.x = cvtpk(kv[0] * sD[0], kv[1] * sD[1]); d_.y = cvtpk(kv[2] * sD[2], kv[3] * sD[3]); d_.z = cvtpk(kv[4] * sD[4], kv[5] * sD[5]); d_.w = cvtpk(kv[6] * sD[6], kv[7] * sD[7]);
            RkB[t][ks] = __builtin_bit_cast(bf16x8, a_); KDf[t][ks] = __builtin_bit_cast(bf16x8, d_); } }
    LDS_WAIT(); asm volatile("" ::: "memory"); __builtin_amdgcn_sched_barrier(0);
    {
        float X[16];
#pragma unroll
        for (int r = 0; r < 16; ++r) X[r] = (r == fr) ? 1.f : 0.f;
        const LAS bf16* ab = R0 + (16 * fq) * 64 + 16 * fq;
#pragma unroll
        for (int s = 0; s < 15; ++s) {
#pragma unroll
            for (int r = s + 1; r < 16; ++r) X[r] -= bf2f(ab[r * 64 + s]) * X[s];
            if ((s & 3) == 3) __builtin_amdgcn_sched_barrier(0);
        }
        LDS_WAIT(); asm volatile("" ::: "memory"); __builtin_amdgcn_sched_barrier(0);
#pragma unroll
        for (int r = 0; r < 16; ++r) R0[(16 * fq + r) * 64 + 16 * fq + fr] = (bf16)(cvtpk(X[r], X[r]) & 0xffffu);
    }
    LDS_WAIT(); asm volatile("" ::: "memory"); __builtin_amdgcn_sched_barrier(0);
    {
#define A16(i, k) (*(const LAS s16x4*)(R0 + (16 * (i) + fr) * 64 + 16 * (k) + 4 * fq))
        s16x4 Td[4];
#pragma unroll
        for (int j = 0; j < 3; ++j) { const LAS bf16* p = R0 + (16 * j + 4 * fq) * 64 + 16 * j + fr; typedef unsigned u32x2 __attribute__((ext_vector_type(2)));
            Td[j] = __builtin_bit_cast(s16x4, (u32x2){(unsigned)p[0] | ((unsigned)p[64] << 16), (unsigned)p[128] | ((unsigned)p[192] << 16)}); }
        f32x4 m10 = MFMA16(A16(1, 0), Td[0], z4);
        const f32x4 t10 = -MFMA16(A16(1, 1), cvt4(m10), z4);
        f32x4 m21 = MFMA16(A16(2, 1), Td[1], z4);
        f32x4 m20 = MFMA16(A16(2, 0), Td[0], z4); m20 = MFMA16(A16(2, 1), cvt4(t10), m20);
        const s16x4 a22 = A16(2, 2);
        const f32x4 t21 = -MFMA16(a22, cvt4(m21), z4), t20 = -MFMA16(a22, cvt4(m20), z4);
        f32x4 m32 = MFMA16(A16(3, 2), Td[2], z4);
        f32x4 m31 = MFMA16(A16(3, 1), Td[1], z4); m31 = MFMA16(A16(3, 2), cvt4(t21), m31);
        f32x4 m30 = MFMA16(A16(3, 0), Td[0], z4); m30 = MFMA16(A16(3, 1), cvt4(t10), m30); m30 = MFMA16(A16(3, 2), cvt4(t20), m30);
        const s16x4 a33 = A16(3, 3);
        const f32x4 t32 = -MFMA16(a33, cvt4(m32), z4), t31 = -MFMA16(a33, cvt4(m31), z4), t30 = -MFMA16(a33, cvt4(m30), z4);
        LDS_WAIT(); asm volatile("" ::: "memory"); __builtin_amdgcn_sched_barrier(0);
#define TST(i, j, t) do { _Pragma("unroll") for (int r_ = 0; r_ < 4; ++r_) R0[(16 * (i) + 4 * fq + r_) * 64 + 16 * (j) + fr] = (bf16)(cvtpk((t)[r_], (t)[r_]) & 0xffffu); } while (0)
        TST(1, 0, t10); TST(2, 0, t20); TST(2, 1, t21); TST(3, 0, t30); TST(3, 1, t31); TST(3, 2, t32);
#undef TST
#undef A16
    }
    LDS_WAIT(); asm volatile("" ::: "memory"); __builtin_amdgcn_sched_barrier(0);
#pragma unroll
    for (int ct = 0; ct < 4; ++ct) { const bf16x8 ta0 = tile_frag(R0, ct, 0, fr, fq), ta1 = tile_frag(R0, ct, 1, fr, fq);
#pragma unroll
        for (int dt = 0; dt < 4; ++dt) { f32x4 acc = MFMA32(ta0, RkB[dt][0], z4); if (ct >= 2) acc = MFMA32(ta1, RkB[dt][1], acc);
            *(LAS unsigned long long*)(R1 + (16 * dt + fr) * 64 + 16 * ct + 4 * fq) = pack4(acc[0], acc[1], acc[2], acc[3]); } }
    LDS_WAIT(); asm volatile("" ::: "memory");
    asm volatile("s_waitcnt vmcnt(0)" ::: "memory");
    v4u qdf[8]; bf16x8 qkf[8];
#pragma unroll
    for (int f = 0; f < 8; ++f) { qdf[f] = *(const GAS v4u*)(cT + (f * 64 + lane) * 8); qkf[f] = *(const GAS bf16x8*)(cT + 4096 + (f * 64 + lane) * 8); }
    bf16x8 waf[4][2];
#pragma unroll
    for (int tm = 0; tm < 4; ++tm) { waf[tm][0] = tile_frag(R1, tm, 0, fr, fq); waf[tm][1] = tile_frag(R1, tm, 1, fr, fq); }
    LDS_WAIT(); asm volatile("" ::: "memory");
    GDN_RAW(R1, C_GV);
#pragma unroll
    for (int tn = 0; tn < 4; ++tn) {
#pragma unroll
        for (int ks2 = 0; ks2 < 2; ++ks2) {
            const v4u qd8 = qdf[tn * 2 + ks2]; const unsigned qw_[4] = {qd8.x, qd8.y, qd8.z, qd8.w};
            f32x4 pp[2], q2[2];
#pragma unroll
            for (int h2 = 0; h2 < 2; ++h2) { const int tm = 2 * ks2 + h2;
                f32x4 a1 = MFMA32(waf[tm][0], KDf[tn][0], z4); a1 = MFMA32(waf[tm][1], KDf[tn][1], a1);
                f32x4 a2 = MFMA32(waf[tm][0], qkf[tn * 2], z4); a2 = MFMA32(waf[tm][1], qkf[tn * 2 + 1], a2);
                pp[h2] = -a1;
                q2[h2] = (f32x4){__uint_as_float(qw_[2 * h2] << 16), __uint_as_float(qw_[2 * h2] & 0xffff0000u), __uint_as_float(qw_[2 * h2 + 1] << 16), __uint_as_float(qw_[2 * h2 + 1] & 0xffff0000u)} - a2; }
            *(GAS bf16x8*)(cA + ((tn * 2 + ks2) * 64 + lane) * 8) = pack8(pp[0], pp[1]);
            *(GAS bf16x8*)(cA + 4096 + ((tn * 2 + ks2) * 64 + lane) * 8) = pack8(q2[0], q2[1]);
        }
    }
    asm volatile("s_waitcnt vmcnt(0)" ::: "memory");
    {
        const float w0 = F.conv_w[1024 + hh * 64 + lane], w1 = F.conv_w[1536 + 1024 + hh * 64 + lane], w2 = F.conv_w[2 * 1536 + 1024 + hh * 64 + lane], w3 = F.conv_w[3 * 1536 + 1024 + hh * 64 + lane];
        float x0 = 0.f, x1 = 0.f, x2 = 0.f;
        if (n > 0) { x0 = bf2f(R1[lane]); x1 = bf2f(R1[64 + lane]); x2 = bf2f(R1[128 + lane]); }
#pragma unroll
        for (int c = 0; c < 64; ++c) {
            const float r = bf2f(R1[(c + 3) * 64 + lane]);
            const float cv = silu(w0 * x0 + w1 * x1 + w2 * x2 + w3 * r); x0 = x1; x1 = x2; x2 = r;
            R1[c * 64 + lane] = (bf16)(cvtpk(cv, cv) & 0xffffu);
            if ((c & 15) == 15) __builtin_amdgcn_sched_barrier(0);
        }
    }
    LDS_WAIT(); asm volatile("" ::: "memory"); __builtin_amdgcn_sched_barrier(0);
    bf16x8 RvB[4][2];
#pragma unroll
    for (int ks = 0; ks < 2; ++ks) { float sB[8];
#pragma unroll
        for (int j = 0; j < 8; ++j) sB[j] = __shfl(beta, 32 * ks + 16 * (j >> 2) + 4 * fq + (j & 3));
#pragma unroll
        for (int t = 0; t < 4; ++t) { float vv[8];
#pragma unroll
            for (int j = 0; j < 8; ++j) vv[j] = bf2f(R1[(32 * ks + 16 * (j >> 2) + 4 * fq + (j & 3)) * 64 + 16 * t + fr]) * sB[j];
            v4u a_; a_.x = cvtpk(vv[0], vv[1]); a_.y = cvtpk(vv[2], vv[3]); a_.z = cvtpk(vv[4], vv[5]); a_.w = cvtpk(vv[6], vv[7]);
            RvB[t][ks] = __builtin_bit_cast(bf16x8, a_); } }
    LDS_WAIT(); asm volatile("" ::: "memory"); __builtin_amdgcn_sched_barrier(0);
#pragma unroll
    for (int ct = 0; ct < 4; ++ct) { const bf16x8 ta0 = tile_frag(R0, ct, 0, fr, fq), ta1 = tile_frag(R0, ct, 1, fr, fq);
#pragma unroll
        for (int et = 0; et < 4; ++et) { f32x4 acc = MFMA32(ta0, RvB[et][0], z4); if (ct >= 2) acc = MFMA32(ta1, RvB[et][1], acc);
            *(LAS unsigned long long*)(R1 + (16 * et + fr) * 64 + 16 * ct + 4 * fq) = pack4(acc[0], acc[1], acc[2], acc[3]); } }
    LDS_WAIT(); asm volatile("" ::: "memory"); __builtin_amdgcn_sched_barrier(0);
#pragma unroll
    for (int et = 0; et < 4; ++et) {
        const bf16x8 ub0 = tile_frag(R1, et, 0, fr, fq), ub1 = tile_frag(R1, et, 1, fr, fq);
#pragma unroll
        for (int tm = 0; tm < 4; ++tm) {
            const bf16x8 qa0 = qkf[tm * 2], qa1 = qkf[tm * 2 + 1];
            f32x4 r = MFMA32(KDf[tm][0], ub0, z4); r = MFMA32(KDf[tm][1], ub1, r);
            f32x4 o = MFMA32(qa0, ub0, z4); o = MFMA32(qa1, ub1, o);
            *(GAS unsigned long long*)(cU + ((et * 4 + tm) * 64 + lane) * 4) = pack4(r[0], r[1], r[2], r[3]);
            *(GAS unsigned long long*)(cU + 4096 + ((et * 4 + tm) * 64 + lane) * 4) = pack4(o[0], o[1], o[2], o[3]);
        }
    }
    LDS_WAIT(); asm volatile("" ::: "memory"); __builtin_amdgcn_sched_barrier(0);
}
#undef MFMA16
#undef MFMA32
#undef GDN_RAW

#define GDN_BAR() do { asm volatile("" ::: "memory"); __builtin_amdgcn_s_barrier(); asm volatile("" ::: "memory"); } while (0)
__device__ __forceinline__ void gdn_scan(Frame& F, int bh) {
    const int lane = F.lane, wave = F.wave, b = bh >> 3, hh = bh & 7, fr = lane & 15, fq = lane >> 4;
    LAS unsigned char* const ring = F.lds + RING_OFF;
    constexpr int SLOT = 32768, OB0 = 131072, OB1 = 139264;
    const unsigned char* gA = (const unsigned char*)(F.CHKA + (size_t)bh * 64 * 8192);
    const unsigned char* gU = (const unsigned char*)(F.CHKU + (size_t)bh * 64 * 8192);
    if (wave >= 4) {
        const int hw = wave - 4, nt = hw * 64 + lane;
        bf16* mp = F.ORAW + ((size_t)b * T + (nt >> 3)) * 512 + hh * 64 + (nt & 7) * 8;
#define GDN_ISSUE(nn) do { const int n_ = (nn); const int sl_ = n_ & 3; _Pragma("unroll") for (int i_ = 0; i_ < 8; ++i_) { const int p_ = hw * 8 + i_; \
            const unsigned char* s_ = (p_ < 16) ? gA + (size_t)n_ * 16384 + p_ * 1024 : gU + (size_t)n_ * 16384 + (p_ - 16) * 1024; \
            __builtin_amdgcn_global_load_lds((const unsigned*)(s_ + lane * 16), (LAS unsigned*)(ring + sl_ * SLOT + p_ * 1024), 16, 0, 0); } } while (0)
#define GDN_COPY(nn) do { const LAS unsigned char* ob_ = ring + (((nn) & 1) ? OB1 : OB0); _Pragma("unroll") for (int k_ = 0; k_ < 2; ++k_) \
            *(GAS v4u*)(mp + (size_t)(64 * (nn) + 32 * k_) * 512) = *(const LAS v4u*)(ob_ + (nt + 256 * k_) * 16); } while (0)
        GDN_ISSUE(0); GDN_ISSUE(1); GDN_ISSUE(2);
        asm volatile("s_waitcnt vmcnt(16)" ::: "memory"); GDN_BAR();
        for (int n = 0; n < 64; ++n) {
            if (n + 3 < 64) { GDN_ISSUE(n + 3); asm volatile("s_waitcnt vmcnt(16)" ::: "memory"); } else asm volatile("s_waitcnt vmcnt(0)" ::: "memory");
            if (n > 0) GDN_COPY(n - 1);
            LDS_WAIT(); GDN_BAR();
        }
        GDN_COPY(63);
#undef GDN_ISSUE
#undef GDN_COPY
    } else {
        const int ew = wave;
        f32x4 Sacc[4];
#pragma unroll
        for (int t = 0; t < 4; ++t) Sacc[t] = (f32x4){0.f, 0.f, 0.f, 0.f};
        const float decs = ld_f32_coh(F.dec + bh * 64 + lane);
        GDN_BAR();
        for (int n = 0; n < 64; ++n) {
            const LAS unsigned char* sl = ring + (n & 3) * SLOT;
            LAS bf16* ob = (LAS bf16*)(ring + ((n & 1) ? OB1 : OB0)) + (4 * fq) * 64 + 16 * ew + fr;
            const float dec = __int_as_float(__builtin_amdgcn_readlane(__float_as_int(decs), n));
            unsigned long long rf[4], of[4]; bf16x8 pf[8], qf[8];
#pragma unroll
            for (int t = 0; t < 4; ++t) { rf[t] = *(const LAS unsigned long long*)(sl + 16384 + ((ew * 4 + t) * 64 + lane) * 8); of[t] = *(const LAS unsigned long long*)(sl + 24576 + ((ew * 4 + t) * 64 + lane) * 8); }
#pragma unroll
            for (int f = 0; f < 8; ++f) { pf[f] = *(const LAS bf16x8*)(sl + (f * 64 + lane) * 16); qf[f] = *(const LAS bf16x8*)(sl + 8192 + (f * 64 + lane) * 16); }
            __builtin_amdgcn_sched_barrier(0);
            bf16x8 Sb[2]; Sb[0] = pack8(Sacc[0], Sacc[1]); Sb[1] = pack8(Sacc[2], Sacc[3]);
            f32x4 O[4];
#pragma unroll
            for (int t = 0; t < 4; ++t) { const unsigned rl = (unsigned)rf[t], rh = (unsigned)(rf[t] >> 32), ol = (unsigned)of[t], oh = (unsigned)(of[t] >> 32);
                Sacc[t] = Sacc[t] * dec + (f32x4){__uint_as_float(rl << 16), __uint_as_float(rl & 0xffff0000u), __uint_as_float(rh << 16), __uint_as_float(rh & 0xffff0000u)};
                O[t] = (f32x4){__uint_as_float(ol << 16), __uint_as_float(ol & 0xffff0000u), __uint_as_float(oh << 16), __uint_as_float(oh & 0xffff0000u)}; }
#pragma unroll
            for (int t = 0; t < 4; ++t)
#pragma unroll
                for (int ks = 0; ks < 2; ++ks) { const int f = t * 2 + ks;
                    Sacc[t] = __builtin_amdgcn_mfma_f32_16x16x32_bf16(pf[f], Sb[ks], Sacc[t], 0, 0, 0); O[t] = __builtin_amdgcn_mfma_f32_16x16x32_bf16(qf[f], Sb[ks], O[t], 0, 0, 0); }
#pragma unroll
            for (int t = 0; t < 4; ++t)
#pragma unroll
                for (int i = 0; i < 4; ++i) ob[(16 * t + i) * 64] = (bf16)(cvtpk(O[t][i], O[t][i]) & 0xffffu);
            LDS_WAIT(); GDN_BAR();
        }
    }
}
__device__ __forceinline__ void gdn_norm_rows(Frame& F, int r0) {
    const int oc = F.tid & 7, hd = (F.tid >> 3) & 7;
    float nw[8];
#pragma unroll
    for (int j = 0; j < 8; ++j) nw[j] = F.gdn_norm_w[oc * 8 + j];
#pragma unroll 1
    for (int it = 0; it < 4; ++it) {
        v4u ov[8], zv[8];
#pragma unroll
        for (int k = 0; k < 8; ++k) { const size_t row = (size_t)r0 + (it * 8 + k) * 8 + (F.tid >> 6); ov[k] = *(const GAS v4u*)(F.ORAW + row * 512 + hd * 64 + oc * 8); zv[k] = *(const GAS v4u*)(F.PQ + row * NP + C_GZ + hd * 64 + oc * 8); }
#pragma unroll
        for (int k = 0; k < 8; ++k) { const size_t row = (size_t)r0 + (it * 8 + k) * 8 + (F.tid >> 6);
            const unsigned ow[4] = {ov[k].x, ov[k].y, ov[k].z, ov[k].w}, zw[4] = {zv[k].x, zv[k].y, zv[k].z, zv[k].w};
            float o[8], z[8]; float ss = 0.f;
#pragma unroll
            for (int w = 0; w < 4; ++w) { o[2 * w] = __uint_as_float(ow[w] << 16); o[2 * w + 1] = __uint_as_float(ow[w] & 0xffff0000u); z[2 * w] = __uint_as_float(zw[w] << 16); z[2 * w + 1] = __uint_as_float(zw[w] & 0xffff0000u);
                ss += o[2 * w] * o[2 * w] + o[2 * w + 1] * o[2 * w + 1]; }
            ss = sum8(ss);
            const float rs = rsq(ss * (1.0f / 64.0f) + EPS);
            v4u w4; w4.x = cvtpk(o[0] * rs * nw[0] * z[0], o[1] * rs * nw[1] * z[1]); w4.y = cvtpk(o[2] * rs * nw[2] * z[2], o[3] * rs * nw[3] * z[3]);
            w4.z = cvtpk(o[4] * rs * nw[4] * z[4], o[5] * rs * nw[5] * z[5]); w4.w = cvtpk(o[6] * rs * nw[6] * z[6], o[7] * rs * nw[7] * z[7]);
            *(GAS v4u*)(F.MIX + row * D + hd * 64 + oc * 8) = w4; }
    }
    asm volatile("s_waitcnt vmcnt(0)" ::: "memory"); __syncthreads();
}
__device__ __forceinline__ void swa_unit(Frame& F, int unit, LAS unsigned char* L) {
    const int tid = F.tid, lane = F.lane, wave = F.wave, fr = lane & 15, fq = lane >> 4;
    const int blk = unit & 63, kvh = (unit >> 6) & 1, b = unit >> 7, t0 = blk * 64;
    const size_t row0 = (size_t)b * T;
    LAS bf16* const Ks = (LAS bf16*)L; LAS bf16* const Vt = (LAS bf16*)(L + 27648);
    for (int p = tid; p < 1536; p += NWAVES * 64) {
        const int key = p >> 3, oc = p & 7, s = t0 - 128 + key;
        v4u kv = (v4u){0u, 0u, 0u, 0u}, vv = (v4u){0u, 0u, 0u, 0u};
        if (s >= 0) { kv = *(const GAS v4u*)(F.PQ + (row0 + s) * NP + C_SK + kvh * 64 + oc * 8); vv = *(const GAS v4u*)(F.PQ + (row0 + s) * NP + C_SV + kvh * 64 + oc * 8); }
        const unsigned kw[4] = {kv.x, kv.y, kv.z, kv.w}, vw[4] = {vv.x, vv.y, vv.z, vv.w};
        float k[8]; float ss = 0.f;
#pragma unroll
        for (int w = 0; w < 4; ++w) { k[2 * w] = __uint_as_float(kw[w] << 16); k[2 * w + 1] = __uint_as_float(kw[w] & 0xffff0000u); ss += k[2 * w] * k[2 * w] + k[2 * w + 1] * k[2 * w + 1]; }
        ss = sum8(ss);
        const float rstd = rsq(ss * (1.0f / 64.0f) + EPS);
#pragma unroll
        for (int j = 0; j < 8; ++j) k[j] = k[j] * rstd * F.k_norm_w[oc * 8 + j];
        v4u o; o.x = cvtpk(k[0], k[1]); o.y = cvtpk(k[2], k[3]); o.z = cvtpk(k[4], k[5]); o.w = cvtpk(k[6], k[7]);
        *(LAS v4u*)(Ks + key * 72 + oc * 8) = o;
#pragma unroll
        for (int w = 0; w < 4; ++w) { Vt[(oc * 8 + 2 * w) * 196 + key] = (bf16)(vw[w] & 0xffffu); Vt[(oc * 8 + 2 * w + 1) * 196 + key] = (bf16)(vw[w] >> 16); }
    }
    __syncthreads();
    const int hq = kvh * 4 + (wave >> 1);
    const float slope = exp2f(-(float)(hq + 1)), sink = F.sinks[hq];
#pragma unroll 1
    for (int qt = 0; qt < 2; ++qt) {
        const int tq0 = t0 + 32 * (wave & 1) + 16 * qt;
        bf16x8 qf[2];
        {
            const bf16* qp = F.PQ + (row0 + tq0 + fr) * NP + C_SQ + hq * 64 + 8 * fq;
            const v4u r0 = *(const GAS v4u*)qp, r1 = *(const GAS v4u*)(qp + 32);
            const unsigned qw[8] = {r0.x, r0.y, r0.z, r0.w, r1.x, r1.y, r1.z, r1.w};
            float q[16]; float ss = 0.f;
#pragma unroll
            for (int w = 0; w < 8; ++w) { q[2 * w] = __uint_as_float(qw[w] << 16); q[2 * w + 1] = __uint_as_float(qw[w] & 0xffff0000u); ss += q[2 * w] * q[2 * w] + q[2 * w + 1] * q[2 * w + 1]; }
            ss = fq_sum(ss);
            const float rstd = 0.125f * rsq(ss * (1.0f / 64.0f) + EPS);
#pragma unroll
            for (int kk = 0; kk < 2; ++kk) { float z[8];
#pragma unroll
                for (int j = 0; j < 8; ++j) z[j] = q[8 * kk + j] * rstd * F.q_norm_w[32 * kk + 8 * fq + j];
                v4u o; o.x = cvtpk(z[0], z[1]); o.y = cvtpk(z[2], z[3]); o.z = cvtpk(z[4], z[5]); o.w = cvtpk(z[6], z[7]); qf[kk] = __builtin_bit_cast(bf16x8, o); }
        }
        f32x4 sc[12]; float mx = -INFINITY;
#pragma unroll
        for (int nt = 0; nt < 12; ++nt) { f32x4 acc = (f32x4){0.f, 0.f, 0.f, 0.f};
#pragma unroll
            for (int kk = 0; kk < 2; ++kk) { const bf16x8 kf = *(const LAS bf16x8*)(Ks + (16 * nt + fr) * 72 + 32 * kk + 8 * fq); acc = __builtin_amdgcn_mfma_f32_16x16x32_bf16(kf, qf[kk], acc, 0, 0, 0); }
#pragma unroll
            for (int i = 0; i < 4; ++i) { const int s = t0 - 128 + 16 * nt + 4 * fq + i, dist = tq0 + fr - s; const bool ok = (s >= 0) && (dist >= 0) && (dist < 128);
                const float v = ok ? acc[i] - slope * (float)dist : -INFINITY; acc[i] = v; mx = fmaxf(mx, v); }
            sc[nt] = acc; if (nt & 1) __builtin_amdgcn_sched_barrier(0); }
        mx = fmaxf(fq_max(mx), sink);
        float sum = 0.f;
#pragma unroll
        for (int nt = 0; nt < 12; ++nt)
#pragma unroll
            for (int i = 0; i < 4; ++i) { const float p = __expf(sc[nt][i] - mx); sc[nt][i] = p; sum += p; }
        sum = fq_sum(sum);
        const float den = sum + __expf(sink - mx);
        bf16x8 pf[6];
#pragma unroll
        for (int ks = 0; ks < 6; ++ks) pf[ks] = pack8(sc[2 * ks], sc[2 * ks + 1]);
        float rden[4];
#pragma unroll
        for (int i = 0; i < 4; ++i) rden[i] = __builtin_amdgcn_rcpf(__shfl(den, 4 * fq + i));
        bf16* op = F.MIX + (row0 + tq0 + 4 * fq) * D + 512 + hq * 64 + fr;
#pragma unroll 1
        for (int dt = 0; dt < 4; ++dt) { f32x4 oacc = (f32x4){0.f, 0.f, 0.f, 0.f};
#pragma unroll
            for (int ks = 0; ks < 6; ++ks) { const LAS bf16* vp = Vt + (16 * dt + fr) * 196 + 32 * ks + 4 * fq;
                const unsigned long long lo = *(const LAS unsigned long long*)vp, hi = *(const LAS unsigned long long*)(vp + 16);
                v4u vv; vv.x = (unsigned)lo; vv.y = (unsigned)(lo >> 32); vv.z = (unsigned)hi; vv.w = (unsigned)(hi >> 32);
                oacc = __builtin_amdgcn_mfma_f32_16x16x32_bf16(pf[ks], __builtin_bit_cast(bf16x8, vv), oacc, 0, 0, 0); }
#pragma unroll
            for (int i = 0; i < 4; ++i) op[(size_t)i * D + 16 * dt] = (bf16)f2bf(oacc[i] * rden[i]); }
    }
    __syncthreads();
}
__device__ __forceinline__ void p3a_prep(Frame& F) {
    LAS unsigned char* wl = F.lds + RING_OFF + F.wave * 19456;
    const int gw = F.vcu * NWAVES + F.wave, NGW = F.G * NWAVES;
    for (int ci = gw; ci < BATCH * 8 * (T / 64); ci += NGW) gdn_prep_chunk(F, ci, wl);
}
__device__ __forceinline__ void p3b_mixers(Frame& F) {
    const int bx = blockIdx.x;
    if (bx < 32) gdn_scan(F, bx);
    else for (int u = bx - 32; u < BATCH * 2 * (T / 64); u += F.G - 32) swa_unit(F, u, F.lds + RING_OFF);
}

struct Args { const float* in[18]; float* out; unsigned char* ws; };
__global__ void __launch_bounds__(NWAVES * 64, 2) hymba_fwd(Args args) {
    extern __shared__ __attribute__((aligned(16))) unsigned char lds[];
    Frame F;
    F.lds = (LAS unsigned char*)lds;
    F.MISC = (volatile LAS unsigned*)(F.lds + MISC_OFF);
    F.tid = threadIdx.x; F.lane = F.tid & 63; F.wave = __builtin_amdgcn_readfirstlane(F.tid >> 6);
    F.G = gridDim.x; { const int bx = blockIdx.x; F.vcu = (F.G % 8 == 0) ? (bx % 8) * (F.G / 8) + bx / 8 : bx; }
    unsigned char* ws = args.ws;
    F.ctl = (gu32*)(ws + WS_CTL);
    F.x = args.in[0]; F.c = args.in[1]; F.w_ada = args.in[2]; F.b_ada = args.in[3]; F.norm1_w = args.in[4]; F.w_in = args.in[5]; F.conv_w = args.in[6];
    F.a_log = args.in[7]; F.dt_bias = args.in[8]; F.gdn_norm_w = args.in[9]; F.q_norm_w = args.in[10]; F.k_norm_w = args.in[11]; F.sinks = args.in[12];
    F.w_out = args.in[13]; F.norm2_w = args.in[14]; F.w_gate = args.in[15]; F.w_up = args.in[16]; F.w_down = args.in[17]; F.out = args.out;
    F.modacc = (float*)(ws + WS_CTL) + CW_MODACC; F.modf = (float*)(ws + WS_MODF); F.wab = (float*)(ws + WS_WAB); F.gb = (float*)(ws + WS_GB); F.gm2 = (float*)(ws + WS_GM2); F.bgu = (float*)(ws + WS_BGU); F.rowss = (float*)(ws + WS_CTL) + CW_ROWSS;
    F.Win_t = (bf16*)(ws + WS_WIN); F.Wout_t = (bf16*)(ws + WS_WOUT); F.Wgu_t = (bf16*)(ws + WS_WGU); F.Wdn_t = (bf16*)(ws + WS_WDN);
    F.H = (bf16*)(ws + WS_H); F.PQ = (bf16*)(ws + WS_PQ); F.MIX = (bf16*)(ws + WS_MIX); F.CHKA = (bf16*)(ws + WS_CHKA); F.CHKU = (bf16*)(ws + WS_H); F.X1B = (bf16*)(ws + WS_CHKA); F.CHKT = (bf16*)(ws + WS_CHKA + 32 * MiB); F.ORAW = (bf16*)(ws + WS_CHKA + 32 * MiB); F.dec = (float*)(ws + WS_DEC);
    for (int u = F.tid; u < (LDS_BYTES - LDSCTL_OFF) / 4; u += NWAVES * 64) ((LAS unsigned*)(F.lds + LDSCTL_OFF))[u] = 0u;
    __syncthreads();
    XcdBarrier bar = xcd_barrier_post((unsigned*)(F.ctl + CW_BAR), F.MISC + 8);
#define GRID_BAR() do { xcd_barrier(bar); int t_ = F.tid; asm volatile("" : "+v"(t_)); F.tid = t_; F.lane = t_ & 63; } while (0)

    p0_prologue(F); GRID_BAR();
    norm_phase<1>(F); GRID_BAR();
    { pg8::Gemm g{F.H, F.Win_t, M, NP, D}; pg8::StaticOrder S; S.init(M, NP, F.G, (int)blockIdx.x);
      pg8::EpiBf16Plain E{F.PQ, NP, C_GZ / 256, C_SQ / 256};
      pg8::gemm_phase<pg8::EpiBf16Plain, pg8::StaticOrder, true, true>(F.lds + RING_OFF, g, S, E); }
    GRID_BAR();
    p3a_prep(F); GRID_BAR();
    p3b_mixers(F); GRID_BAR();
    { pg8::Gemm g{F.MIX, F.Wout_t, M, D, D}; pg8::StaticOrder S; S.init(M, D, F.G, (int)blockIdx.x);
      { pg8::Unit u0; for (int i = 0; S.next(i, u0); ++i) gdn_norm_rows(F, u0.pm * 256); }
      pg8::EpiGateResToBf16 E{F.x, F.X1B, D, F.modf + 2 * D, 6 * D, T};
      pg8::gemm_phase<pg8::EpiGateResToBf16, pg8::StaticOrder, true, true>(F.lds + RING_OFF, g, S, E); }
    GRID_BAR();
    norm_phase<2>(F); GRID_BAR();
    { pg8::Gemm g{F.H, F.Wgu_t, M, NGU, D}; pg8::StaticOrder S; S.init(M, NGU, F.G, (int)blockIdx.x);
      pg8::EpiSwiGLU E{F.PQ, FF};
      pg8::gemm_phase<pg8::EpiSwiGLU, pg8::StaticOrder, true, true>(F.lds + RING_OFF, g, S, E); }
    GRID_BAR();
    { pg8::Gemm g{F.PQ, F.Wdn_t, M, D, FF}; pg8::StaticOrder S; S.init(M, D, F.G, (int)blockIdx.x);
      pg8::EpiGateResFromBf16 E{F.X1B, F.out, D, F.modf + 5 * D, 6 * D, T};
      pg8::gemm_phase<pg8::EpiGateResFromBf16, pg8::StaticOrder, true, true>(F.lds + RING_OFF, g, S, E); }
#undef GRID_BAR
}

extern "C" void kernel_launch(void* const* d_in, const int* in_sizes, int n_in, void* d_out, int out_size, void* d_ws, size_t ws_size, hipStream_t stream) {
    static int grid = 0;
    if (grid == 0) {
        if (n_in != 18 || in_sizes[0] != M * D || out_size != M * D || ws_size < WS_END) { fprintf(stderr, "kernel_launch: unexpected shapes (n_in %d, in0 %d, out %d, ws %zu); nothing launched\n", n_in, n_in > 0 ? in_sizes[0] : -1, out_size, ws_size); grid = -1; return; }
        int dev = 0, cus = 0;
        if (hipGetDevice(&dev) != hipSuccess || hipDeviceGetAttribute(&cus, hipDeviceAttributeMultiprocessorCount, dev) != hipSuccess) { grid = -1; return; }
        if (hipFuncSetAttribute((const void*)hymba_fwd, hipFuncAttributeMaxDynamicSharedMemorySize, LDS_BYTES) != hipSuccess) { fprintf(stderr, "kernel_launch: hipFuncSetAttribute failed\n"); grid = -1; return; }
        (void)hipGetLastError();
        grid = cus;
    }
    if (grid < 0) return;
    if (hipMemsetAsync((char*)d_ws + WS_CTL, 0, CTL_ZERO_BYTES, stream) != hipSuccess) { fprintf(stderr, "kernel_launch: hipMemsetAsync failed\n"); return; }
    Args a{};
    for (int i = 0; i < 18; ++i) a.in[i] = (const float*)d_in[i];
    a.out = (float*)d_out; a.ws = (unsigned char*)d_ws;
    hipLaunchKernelGGL(hymba_fwd, dim3(grid), dim3(NWAVES * 64), LDS_BYTES, stream, a);
    const hipError_t le = hipPeekAtLastError();
    if (le != hipSuccess) fprintf(stderr, "kernel_launch: launch failed: %s\n", hipGetErrorName(le));
}
```

```cpp
#include <hip/hip_runtime.h>
#include <cstdio>
#include <cstdint>
#include <cmath>
namespace pg8 {
#define PG8_LAS __attribute__((address_space(3)))
typedef unsigned short bf16_t;
typedef short bf16x8 __attribute__((ext_vector_type(8)));
typedef float f32x4 __attribute__((ext_vector_type(4)));
typedef unsigned u32x4 __attribute__((ext_vector_type(4)));
constexpr int BM = 256, BK = 64, HALF = 128, HTB = HALF * BK * 2  , STAGE_BYTES = 8 * HTB, NXCD = 8, WGM = 8;

__host__ __device__ __forceinline__ int lds_byte(int r, int c) { const int st = (r >> 4) * 2 + (c >> 5), rr = r & 15, cc = c & 31, ob = rr * 64 + cc * 2; return st * 1024 + (ob ^ (((ob >> 9) & 1) << 5)); }
__host__ __device__ __forceinline__ void stage_rc(int b, int& R, int& C) { const int st = b / 1024, sb = b % 1024, swz = sb ^ (((sb >> 9) & 1) << 5); R = (st >> 1) * 16 + swz / 64; C = (st & 1) * 32 + (swz % 64) / 2; }
__host__ __device__ __forceinline__ int perm32(int rho) { const int n = rho >> 4, i = rho & 15; return 8 * (i >> 2) + 4 * n + (i & 3); }

struct Unit { int pm, pn; };
struct Gemm { const bf16_t* A; const bf16_t* Bt; int M, N, K; };

struct StaticOrder {
    int nM, nN, nwg, G, c;
    __host__ __device__ void init(int M, int N, int G_, int c_) { nM = M / BM; nN = N / BM; nwg = nM * nN; G = G_; c = c_; }
    __host__ __device__ bool next(int i, Unit& u) const {
        const long L = (long)i * G + c; if (L >= nwg) return false;
        int wgid = (int)L; { const int q = nwg / NXCD, r = nwg % NXCD, xcd = wgid % NXCD, off = wgid / NXCD; wgid = (xcd < r ? xcd * (q + 1) : r * (q + 1) + (xcd - r) * q) + off; }
        const int nig = WGM * nN, gid = wgid / nig, fm = gid * WGM, gsz = (nM - fm) < WGM ? (nM - fm) : WGM;
        u.pm = fm + ((wgid % nig) % gsz); u.pn = (wgid % nig) / gsz; return true;
    }
    __device__ __forceinline__ void a_ready(const Unit&) const {}
    __device__ __forceinline__ void done(const Unit&) const {}
};

__device__ __forceinline__ unsigned cvt_pk_bf16(float lo, float hi) { unsigned r; asm volatile("v_cvt_pk_bf16_f32 %0, %1, %2" : "=v"(r) : "v"(lo), "v"(hi)); return r; }
__device__ __forceinline__ float silu_f(float x) { return x * __builtin_amdgcn_rcpf(1.0f + __expf(-x)); }

struct EpiBf16Plain {
    static constexpr bool PERM = true, AFTER_DRAIN = false;
    bf16_t* O; int ldc; int silu_lo, silu_hi;
    __device__ __forceinline__ void operator()(const f32x4 (&acc)[2][2][4][2], const Unit& u, int wr, int wc, int fr, int fq) const {
        const int row0 = u.pm * BM + wr * 64 + fr, col0 = u.pn * BM + wc * 32 + 8 * fq;
        const bool act = (u.pn >= silu_lo) && (u.pn < silu_hi);
#pragma unroll
        for (int ai = 0; ai < 2; ++ai)
#pragma unroll
            for (int m = 0; m < 4; ++m) { bf16_t* rowp = O + (size_t)(row0 + ai * HALF + m * 16) * ldc + col0;
#pragma unroll
                for (int bj = 0; bj < 2; ++bj) { f32x4 v0 = acc[ai][bj][m][0], v1 = acc[ai][bj][m][1];
                    if (act) {
#pragma unroll
                        for (int i = 0; i < 4; ++i) { v0[i] = silu_f(v0[i]); v1[i] = silu_f(v1[i]); } }
                    u32x4 w; w.x = cvt_pk_bf16(v0[0], v0[1]); w.y = cvt_pk_bf16(v0[2], v0[3]); w.z = cvt_pk_bf16(v1[0], v1[1]); w.w = cvt_pk_bf16(v1[2], v1[3]);
                    *(u32x4*)(rowp + bj * HALF) = w; } }
    }
};
struct EpiSwiGLU {
    static constexpr bool PERM = true, AFTER_DRAIN = false;
    bf16_t* O; int ldc;
    __device__ __forceinline__ void operator()(const f32x4 (&acc)[2][2][4][2], const Unit& u, int wr, int wc, int fr, int fq) const {
        const int row0 = u.pm * BM + wr * 64 + fr, col0 = u.pn * HALF + wc * 32 + 8 * fq;
#pragma unroll
        for (int ai = 0; ai < 2; ++ai)
#pragma unroll
            for (int m = 0; m < 4; ++m) { bf16_t* rowp = O + (size_t)(row0 + ai * HALF + m * 16) * ldc + col0;
                const f32x4 g0 = acc[ai][0][m][0], g1 = acc[ai][0][m][1], u0 = acc[ai][1][m][0], u1 = acc[ai][1][m][1];
                float a[8];
#pragma unroll
                for (int i = 0; i < 4; ++i) { a[i] = silu_f(g0[i]) * u0[i]; a[4 + i] = silu_f(g1[i]) * u1[i]; }
                u32x4 w; w.x = cvt_pk_bf16(a[0], a[1]); w.y = cvt_pk_bf16(a[2], a[3]); w.z = cvt_pk_bf16(a[4], a[5]); w.w = cvt_pk_bf16(a[6], a[7]);
                *(u32x4*)rowp = w; }
    }
};
struct EpiGateResToBf16 {
    static constexpr bool PERM = false, AFTER_DRAIN = false;
    const float* base; bf16_t* out; int ldc; const float* gate; int gstride; int rows_per_batch;
    __device__ __forceinline__ void operator()(const f32x4 (&acc)[2][2][4][2], const Unit& u, int wr, int wc, int fr, int fq) const {
        const int row0 = u.pm * BM + wr * 64 + fr, col0 = u.pn * BM + wc * 32 + 4 * fq;
        const float* gp = gate + (size_t)((u.pm * BM) / rows_per_batch) * gstride + col0;
        f32x4 gv[2][2];
#pragma unroll
        for (int bj = 0; bj < 2; ++bj)
#pragma unroll
            for (int n = 0; n < 2; ++n) gv[bj][n] = *(const f32x4*)(gp + bj * HALF + n * 16);
#pragma unroll
        for (int ai = 0; ai < 2; ++ai)
#pragma unroll
            for (int m = 0; m < 4; ++m) { const size_t off = (size_t)(row0 + ai * HALF + m * 16) * ldc + col0;
#pragma unroll
                for (int bj = 0; bj < 2; ++bj)
#pragma unroll
                    for (int n = 0; n < 2; ++n) { const f32x4 o = *(const f32x4*)(base + off + bj * HALF + n * 16) + gv[bj][n] * acc[ai][bj][m][n];
                        *(unsigned long long*)(out + off + bj * HALF + n * 16) = (unsigned long long)cvt_pk_bf16(o[0], o[1]) | ((unsigned long long)cvt_pk_bf16(o[2], o[3]) << 32); } }
    }
};
struct EpiGateResFromBf16 {
    static constexpr bool PERM = false, AFTER_DRAIN = false;
    const bf16_t* base; float* out; int ldc; const float* gate; int gstride; int rows_per_batch;
    __device__ __forceinline__ void operator()(const f32x4 (&acc)[2][2][4][2], const Unit& u, int wr, int wc, int fr, int fq) const {
        const int row0 = u.pm * BM + wr * 64 + fr, col0 = u.pn * BM + wc * 32 + 4 * fq;
        const float* gp = gate + (size_t)((u.pm * BM) / rows_per_batch) * gstride + col0;
        f32x4 gv[2][2];
#pragma unroll
        for (int bj = 0; bj < 2; ++bj)
#pragma unroll
            for (int n = 0; n < 2; ++n) gv[bj][n] = *(const f32x4*)(gp + bj * HALF + n * 16);
#pragma unroll
        for (int ai = 0; ai < 2; ++ai)
#pragma unroll
            for (int m = 0; m < 4; ++m) { const size_t off = (size_t)(row0 + ai * HALF + m * 16) * ldc + col0;
#pragma unroll
                for (int bj = 0; bj < 2; ++bj)
#pragma unroll
                    for (int n = 0; n < 2; ++n) { const unsigned long long bb = *(const unsigned long long*)(base + off + bj * HALF + n * 16); const unsigned lo = (unsigned)bb, hi = (unsigned)(bb >> 32);
                        const f32x4 bs = (f32x4){__uint_as_float(lo << 16), __uint_as_float(lo & 0xffff0000u), __uint_as_float(hi << 16), __uint_as_float(hi & 0xffff0000u)};
                        *(f32x4*)(out + off + bj * HALF + n * 16) = bs + gv[bj][n] * acc[ai][bj][m][n]; } }
    }
};

template <class Epi, class Sched, bool ALIGN_EPI = false, bool SP2 = false>
__device__ __forceinline__ void gemm_phase(PG8_LAS unsigned char* lds, const Gemm g, const Sched& S, const Epi& E) {
    int tid_ = threadIdx.x; asm volatile("" : "+v"(tid_));
    const int tid = tid_, wid = __builtin_amdgcn_readfirstlane(tid >> 6), lane = tid & 63, wr = wid >> 2, wc = wid & 3, fr = lane & 15, fq = lane >> 4;
    const int K = g.K, nt = K / BK;
    unsigned voffA[2], voffB[2];
#pragma unroll
    for (int i = 0; i < 2; ++i) { int R, C; stage_rc(tid * 16 + i * 8192, R, C); const int Rb = Epi::PERM ? ((R & ~31) + perm32(R & 31)) : R;
        voffA[i] = (unsigned)(R * K + C) * 2u; voffB[i] = (unsigned)(Rb * K + C) * 2u; }
    const size_t kstep = (size_t)(BK * 2);
    const size_t hstep = (size_t)HALF * K * 2;
    const size_t tstep = 2 * hstep;
    const unsigned ldsw = (unsigned)wid * 1024u;
    const int aoff = lds_byte(wr * 64 + fr, fq * 8), boff = lds_byte(wc * 32 + fr, fq * 8);
#define PG8_SA(b, h) (((b) * 2 + (h)) * HTB)
#define PG8_SB(b, h) ((4 + (b) * 2 + (h)) * HTB)
#define PG8_STAGE(bufoff, gbase, voff) do { _Pragma("unroll") for (int _i = 0; _i < 2; ++_i) \
        __builtin_amdgcn_global_load_lds((const unsigned*)((const char*)(gbase) + (voff)[_i]), (PG8_LAS unsigned*)(lds + (bufoff) + ldsw + _i * 8192), 16, 0, 0); } while (0)
#define PG8_LDA(dst, b, h) do { _Pragma("unroll") for (int m = 0; m < 4; ++m) _Pragma("unroll") for (int k = 0; k < 2; ++k) dst[m][k] = *(const PG8_LAS bf16x8*)(lds + PG8_SA(b, h) + aoff + m * 2048 + k * 1024); } while (0)
#define PG8_LDB(dst, b, h) do { _Pragma("unroll") for (int n = 0; n < 2; ++n) _Pragma("unroll") for (int k = 0; k < 2; ++k) dst[n][k] = *(const PG8_LAS bf16x8*)(lds + PG8_SB(b, h) + boff + n * 2048 + k * 1024); } while (0)
#define PG8_MMA(ai, bj, At, Bt) do { __builtin_amdgcn_s_setprio(1); _Pragma("unroll") for (int m = 0; m < 4; ++m) _Pragma("unroll") for (int n = 0; n < 2; ++n) _Pragma("unroll") for (int k = 0; k < 2; ++k) \
        acc[ai][bj][m][n] = __builtin_amdgcn_mfma_f32_16x16x32_bf16(Bt[n][k], At[m][k], acc[ai][bj][m][n], 0, 0, 0); __builtin_amdgcn_s_setprio(0); } while (0)
#define PG8_WAIT_V(n) asm volatile("s_waitcnt vmcnt(" #n ")" ::: "memory")
#define PG8_WAIT_L(n) asm volatile("s_waitcnt lgkmcnt(" #n ")" ::: "memory")
#define PG8_BAR __builtin_amdgcn_s_barrier()
#define PG8_SCHED __builtin_amdgcn_sched_barrier(0)
    Unit cur, nxt; int ui = 0;
    if (!S.next(0, cur)) return;
    f32x4 acc[2][2][4][2];
#pragma unroll
    for (int a = 0; a < 2; ++a)
#pragma unroll
        for (int b = 0; b < 2; ++b)
#pragma unroll
            for (int m = 0; m < 4; ++m)
#pragma unroll
                for (int n = 0; n < 2; ++n) acc[a][b][m][n] = (f32x4){0.f, 0.f, 0.f, 0.f};
    bf16x8 At[4][2], B0[2][2], B1[2][2];
    const char* cA = (const char*)g.A + (size_t)cur.pm * tstep; const char* cB = (const char*)g.Bt + (size_t)cur.pn * tstep;
    S.a_ready(cur);
    if constexpr (SP2) {
        PG8_STAGE(PG8_SB(0, 0), cB, voffB); PG8_STAGE(PG8_SB(0, 1), cB + hstep, voffB); PG8_STAGE(PG8_SA(0, 0), cA, voffA); PG8_STAGE(PG8_SA(0, 1), cA + hstep, voffA);
        if (wr == 1) PG8_BAR;
        PG8_WAIT_V(2); PG8_BAR;
        PG8_STAGE(PG8_SB(1, 0), cB + kstep, voffB); PG8_STAGE(PG8_SA(1, 0), cA + kstep, voffA); PG8_STAGE(PG8_SB(1, 1), cB + hstep + kstep, voffB);
        PG8_WAIT_V(6); PG8_BAR;
    } else {
        PG8_STAGE(PG8_SB(0, 0), cB, voffB); PG8_STAGE(PG8_SA(0, 0), cA, voffA); PG8_STAGE(PG8_SB(0, 1), cB + hstep, voffB); PG8_STAGE(PG8_SA(0, 1), cA + hstep, voffA);
        if (wr == 1) PG8_BAR;
        PG8_WAIT_V(4); PG8_BAR;
        PG8_STAGE(PG8_SB(1, 0), cB + kstep, voffB); PG8_STAGE(PG8_SA(1, 0), cA + kstep, voffA); PG8_STAGE(PG8_SB(1, 1), cB + hstep + kstep, voffB);
        PG8_WAIT_V(6); PG8_BAR;
    }
    for (;;) {
        const bool has_next = S.next(ui + 1, nxt);
        const char* nA = has_next ? (const char*)g.A + (size_t)nxt.pm * tstep : cA; const char* nB = has_next ? (const char*)g.Bt + (size_t)nxt.pn * tstep : cB;
        for (int t = 0; t < nt; t += 2) {
            const bool last = (t == nt - 2);
            const char* a1 = cA + (size_t)(t + 1) * kstep;
            const char* a2 = last ? nA : cA + (size_t)(t + 2) * kstep; const char* b2 = last ? nB : cB + (size_t)(t + 2) * kstep;
            const char* a3 = a2 + kstep; const char* b3 = b2 + kstep;
            if (last && has_next) S.a_ready(nxt);
            if constexpr (SP2) {
            PG8_LDB(B0, 0, 0); PG8_LDB(B1, 0, 1); PG8_SCHED; PG8_LDA(At, 0, 0); PG8_STAGE(PG8_SA(1, 1), a1 + hstep, voffA);
            PG8_WAIT_V(8); PG8_WAIT_L(0); PG8_BAR; PG8_MMA(0, 0, At, B0); PG8_MMA(0, 1, At, B1); PG8_BAR; PG8_SCHED;
            PG8_LDA(At, 0, 1); PG8_STAGE(PG8_SB(0, 0), b2, voffB); PG8_STAGE(PG8_SB(0, 1), b2 + hstep, voffB); PG8_STAGE(PG8_SA(0, 0), a2, voffA);
            PG8_WAIT_V(8); PG8_WAIT_L(0); PG8_BAR; PG8_MMA(1, 0, At, B0); PG8_MMA(1, 1, At, B1); PG8_BAR; PG8_SCHED;
            PG8_LDB(B0, 1, 0); PG8_LDB(B1, 1, 1); PG8_SCHED; PG8_LDA(At, 1, 0); PG8_STAGE(PG8_SA(0, 1), a2 + hstep, voffA);
            PG8_WAIT_V(8); PG8_WAIT_L(0); PG8_BAR; PG8_MMA(0, 0, At, B0); PG8_MMA(0, 1, At, B1); PG8_BAR; PG8_SCHED;
            PG8_LDA(At, 1, 1); PG8_STAGE(PG8_SB(1, 0), b3, voffB); PG8_STAGE(PG8_SB(1, 1), b3 + hstep, voffB); PG8_STAGE(PG8_SA(1, 0), a3, voffA);
            PG8_WAIT_V(8); PG8_WAIT_L(0); PG8_BAR; PG8_MMA(1, 0, At, B0); PG8_MMA(1, 1, At, B1); PG8_BAR; PG8_SCHED;
            } else {
            PG8_LDB(B0, 0, 0); PG8_SCHED; PG8_LDA(At, 0, 0); PG8_STAGE(PG8_SA(1, 1), a1 + hstep, voffA);
            PG8_WAIT_L(8); PG8_BAR; PG8_WAIT_L(0); PG8_MMA(0, 0, At, B0); PG8_BAR; PG8_SCHED;
            PG8_LDB(B1, 0, 1); PG8_STAGE(PG8_SB(0, 0), b2, voffB);
            PG8_BAR; PG8_WAIT_L(0); PG8_MMA(0, 1, At, B1); PG8_BAR;
            PG8_LDA(At, 0, 1); PG8_STAGE(PG8_SA(0, 0), a2, voffA);
            PG8_BAR; PG8_WAIT_L(0); PG8_MMA(1, 0, At, B0); PG8_BAR; PG8_SCHED;
            PG8_STAGE(PG8_SB(0, 1), b2 + hstep, voffB);
            PG8_WAIT_V(6); PG8_BAR; PG8_MMA(1, 1, At, B1); PG8_BAR;
            PG8_LDB(B0, 1, 0); PG8_SCHED; PG8_LDA(At, 1, 0); PG8_STAGE(PG8_SA(0, 1), a2 + hstep, voffA);
            PG8_WAIT_L(8); PG8_BAR; PG8_WAIT_L(0); PG8_MMA(0, 0, At, B0); PG8_BAR; PG8_SCHED;
            PG8_LDB(B1, 1, 1); PG8_STAGE(PG8_SB(1, 0), b3, voffB);
            PG8_BAR; PG8_WAIT_L(0); PG8_MMA(0, 1, At, B1); PG8_BAR;
            PG8_LDA(At, 1, 1); PG8_STAGE(PG8_SA(1, 0), a3, voffA);
            PG8_BAR; PG8_WAIT_L(0); PG8_MMA(1, 0, At, B0); PG8_BAR; PG8_SCHED;
            PG8_STAGE(PG8_SB(1, 1), b3 + hstep, voffB);
            PG8_WAIT_V(6); PG8_BAR; PG8_MMA(1, 1, At, B1); PG8_BAR;
            }
        }
        if constexpr (ALIGN_EPI) { if (wr == 0) PG8_BAR; }
        if constexpr (!Epi::AFTER_DRAIN) { E(acc, cur, wr, wc, fr, fq); S.done(cur); }
        if (!has_next) break;
#pragma unroll
        for (int a = 0; a < 2; ++a)
#pragma unroll
            for (int b = 0; b < 2; ++b)
#pragma unroll
                for (int m = 0; m < 4; ++m)
#pragma unroll
                    for (int n = 0; n < 2; ++n) acc[a][b][m][n] = (f32x4){0.f, 0.f, 0.f, 0.f};
        cur = nxt; cA = nA; cB = nB; ++ui;
        if constexpr (ALIGN_EPI) { if (wr == 1) PG8_BAR; }
    }
    PG8_WAIT_V(0);
    if constexpr (!ALIGN_EPI) { if (wr == 0) PG8_BAR; }
    PG8_BAR;
    if constexpr (Epi::AFTER_DRAIN) { E.fused(acc, cur, wr, wc, fr, fq, lds, wid, lane); S.done(cur); }
#undef PG8_SA
#undef PG8_SB
#undef PG8_STAGE
#undef PG8_LDA
#undef PG8_LDB
#undef PG8_MMA
#undef PG8_WAIT_V
#undef PG8_WAIT_L
#undef PG8_BAR
#undef PG8_SCHED
}
}
constexpr int NWAVES = 8;
constexpr int BATCH = 4, T = 4096, D = 1024, M = BATCH * T;
constexpr int PROJ_W = 2832, NP = 3072, FF = 2816, NGU = 2 * FF, HD = 64;
constexpr int C_GQ = 0, C_GK = 512, C_GV = 1024, C_GZ = 1536, C_SQ = 2048, C_SK = 2560, C_SV = 2688, C_GA = 2816, C_GB = 2824;
constexpr float EPS = 1e-6f;
constexpr size_t MiB = 1u << 20;
constexpr size_t WS_CTL = 0, CTL_ZERO_BYTES = 256 * 1024;
constexpr size_t WS_MODF = 1 * MiB;
constexpr size_t WS_DEC = 1 * MiB + 384 * 1024;
constexpr size_t WS_WIN = 4 * MiB, WS_WOUT = 10 * MiB, WS_WGU = 12 * MiB, WS_WDN = 24 * MiB;
constexpr size_t WS_H = 32 * MiB;
constexpr size_t WS_PQ = 64 * MiB;
constexpr size_t WS_MIX = 160 * MiB;
constexpr size_t WS_CHKA = 192 * MiB;
constexpr size_t WS_END = 256 * MiB;
constexpr int CW_BAR = 4096;
constexpr int CW_MODACC = 16384;
constexpr int RING_OFF = 0, RING_BYTES = 131072;
constexpr int LDS_BYTES = 163840;
constexpr int LDSCTL_OFF = LDS_BYTES - 1024, MISC_OFF = LDSCTL_OFF + 320;
#define GAS __attribute__((address_space(1)))
#define LAS __attribute__((address_space(3)))
typedef unsigned short bf16;
typedef unsigned v4u __attribute__((ext_vector_type(4)));
typedef float f32x4 __attribute__((ext_vector_type(4)));
typedef short bf16x8 __attribute__((ext_vector_type(8)));
typedef GAS unsigned gu32;
typedef GAS unsigned long long gu64;
#define RLX_AGENT __ATOMIC_RELAXED, __HIP_MEMORY_SCOPE_AGENT
#define LDS_WAIT() asm volatile("s_waitcnt lgkmcnt(0)" ::: "memory")
#define VM_WAIT() asm volatile("s_waitcnt vmcnt(0)" ::: "memory")
__device__ __forceinline__ unsigned long long rt() { return __builtin_amdgcn_s_memrealtime(); }
__device__ __forceinline__ unsigned f2bf(float f) { unsigned u = __builtin_bit_cast(unsigned, f); return (u + 0x7fffu + ((u >> 16) & 1u)) >> 16; }
__device__ __forceinline__ unsigned pk2(float lo, float hi) { return f2bf(lo) | (f2bf(hi) << 16); }

#define XB_TMO      128
#define XB_XCNT(j)  (256  + 64 * (j))
#define XB_XSUB(j)  (1280 + 64 * (j))
#define XB_XGEN(j)  (2304 + 64 * (j))
#define XB_TOP      3328
#define XB_TOPGEN   3392
#define XCD_BAR_WORDS 3456
#define XB_SPIN_CAP (1u << 22)

__device__ __forceinline__ unsigned xb_ld(unsigned* p)              { return __hip_atomic_load(p, __ATOMIC_RELAXED, __HIP_MEMORY_SCOPE_AGENT); }
__device__ __forceinline__ unsigned xb_add(unsigned* p, unsigned v) { return __hip_atomic_fetch_add(p, v, __ATOMIC_RELAXED, __HIP_MEMORY_SCOPE_AGENT); }
__device__ __forceinline__ unsigned xb_xcc_id() { return (unsigned)__builtin_amdgcn_s_getreg((3 << 11) | 20) & 0xFu; }
#define XB_SPIN(cond, bar) do { unsigned _sp = 0; while (cond) { __builtin_amdgcn_s_sleep(1); \
    if ((++_sp & 255u) == 0u) { if (xb_ld(&(bar)[XB_TMO])) break; if (_sp > XB_SPIN_CAP) { atomicAdd(&(bar)[XB_TMO], 1u); break; } } } } while (0)

struct XcdBarrier {
    unsigned* bar; unsigned x;
    volatile LAS unsigned* st;
};

__device__ __forceinline__ XcdBarrier xcd_barrier_post(unsigned* bar, volatile LAS unsigned* st) {
    XcdBarrier b; b.bar = bar; b.x = xb_xcc_id(); b.st = st;
    if (threadIdx.x == 0) (void)xb_add(&bar[XB_XCNT(b.x)], 1u);
    return b;
}
__device__ __forceinline__ void xcd_barrier_complete(unsigned* bar, unsigned x, unsigned& nloc, unsigned& nx) {
    const unsigned G = gridDim.x * gridDim.y * gridDim.z;
    unsigned sum, cnt, mine, sp = 0u;
    for (;;) {
        sum = 0u; cnt = 0u; mine = 0u;
#pragma unroll
        for (unsigned j = 0; j < 16; ++j) { const unsigned c = xb_ld(&bar[XB_XCNT(j)]); sum += c; cnt += (c > 0u) ? 1u : 0u; mine = (j == x) ? c : mine; }
        if (sum == G) break;
        __builtin_amdgcn_s_sleep(1);
        if ((++sp & 255u) == 0u) { if (xb_ld(&bar[XB_TMO])) break; if (sp > XB_SPIN_CAP) { atomicAdd(&bar[XB_TMO], 1u); break; } }
    }
    nloc = mine > 0u ? mine : 1u; nx = cnt > 0u ? cnt : 1u;
}

__device__ __forceinline__ void xcd_barrier(const XcdBarrier& b) {
    asm volatile("s_waitcnt vmcnt(0)" ::: "memory");
    __syncthreads();
    if (threadIdx.x == 0) {
        unsigned* bar = b.bar;
        __builtin_amdgcn_s_waitcnt(0);
        unsigned nloc = b.st[0], nx = b.st[1];
        if (nloc == 0u) { xcd_barrier_complete(bar, b.x, nloc, nx); b.st[0] = nloc; b.st[1] = nx; }
        const unsigned old = xb_add(&bar[XB_XSUB(b.x)], 1u);
        const unsigned gen = old / nloc;
        if (old + 1u == (gen + 1u) * nloc) {
            __builtin_amdgcn_fence(__ATOMIC_RELEASE, "agent");
            asm volatile("s_waitcnt vmcnt(0)" ::: "memory");
            const unsigned og = xb_add(&bar[XB_TOP], 1u);
            const unsigned tg = og / nx;
            if (og + 1u == (tg + 1u) * nx) xb_add(&bar[XB_TOPGEN], 1u);
            else XB_SPIN(xb_ld(&bar[XB_TOPGEN]) == tg, bar);
            __builtin_amdgcn_fence(__ATOMIC_ACQUIRE, "agent");
            xb_add(&bar[XB_XGEN(b.x)], 1u);
            asm volatile("s_waitcnt vmcnt(0)" ::: "memory");
        } else {
            XB_SPIN(xb_ld(&bar[XB_XGEN(b.x)]) == gen, bar);
            __builtin_amdgcn_fence(__ATOMIC_ACQUIRE, "agent");
            asm volatile("s_waitcnt vmcnt(0)" ::: "memory");
        }
    }
    __syncthreads();
}
struct Frame {
    LAS unsigned char* lds;
    volatile LAS unsigned* MISC;
    gu32* ctl;
    int tid, lane, wave;
    int vcu, G;
    const float *x, *c, *w_ada, *b_ada, *norm1_w, *w_in, *conv_w, *a_log, *dt_bias, *gdn_norm_w, *q_norm_w, *k_norm_w, *sinks, *w_out, *norm2_w, *w_gate, *w_up, *w_down;
    float* out;
    float *modacc, *modf, *dec;
    bf16 *Win_t, *Wout_t, *Wgu_t, *Wdn_t, *H, *PQ, *MIX, *X1B, *CHKA, *CHKU, *CHKT, *ORAW;
};
template <int CTRL, int ROWMASK, bool BC>
__device__ __forceinline__ float dpp_mov(float v) { return __int_as_float(__builtin_amdgcn_update_dpp(0, __float_as_int(v), CTRL, ROWMASK, 0xF, BC)); }
__device__ __forceinline__ float sum8(float v) { v += dpp_mov<0xB1, 0xF, true>(v); v += dpp_mov<0x4E, 0xF, true>(v); v += dpp_mov<0x141, 0xF, true>(v); return v; }
__device__ __forceinline__ float wave_sum(float v) {
    v = sum8(v); v += dpp_mov<0x140, 0xF, true>(v);
    v += dpp_mov<0x142, 0xA, false>(v); v += dpp_mov<0x143, 0xC, false>(v);
    return __int_as_float(__builtin_amdgcn_readlane(__float_as_int(v), 63));
}
__device__ __forceinline__ float fq_sum(float v) {
    auto r = __builtin_amdgcn_permlane16_swap(__float_as_uint(v), __float_as_uint(v), false, false); v = __uint_as_float(r[0]) + __uint_as_float(r[1]);
    auto s = __builtin_amdgcn_permlane32_swap(__float_as_uint(v), __float_as_uint(v), false, false); return __uint_as_float(s[0]) + __uint_as_float(s[1]);
}
__device__ __forceinline__ float fq_max(float v) {
    auto r = __builtin_amdgcn_permlane16_swap(__float_as_uint(v), __float_as_uint(v), false, false); v = fmaxf(__uint_as_float(r[0]), __uint_as_float(r[1]));
    auto s = __builtin_amdgcn_permlane32_swap(__float_as_uint(v), __float_as_uint(v), false, false); return fmaxf(__uint_as_float(s[0]), __uint_as_float(s[1]));
}
typedef float f32x2_t __attribute__((ext_vector_type(2))); typedef __bf16 bf16x2_t __attribute__((ext_vector_type(2)));
__device__ __forceinline__ unsigned cvtpk(float lo, float hi) { f32x2_t v = {lo, hi}; bf16x2_t b = __builtin_convertvector(v, bf16x2_t); return __builtin_bit_cast(unsigned, b); }
__device__ __forceinline__ float bf2f(bf16 h) { return __uint_as_float((unsigned)h << 16); }
__device__ __forceinline__ float ld_f32_coh(const float* p) { return __uint_as_float(__hip_atomic_load((const unsigned*)p, RLX_AGENT)); }
__device__ __forceinline__ float silu(float x) { return x * __builtin_amdgcn_rcpf(1.0f + __expf(-x)); }
__device__ __forceinline__ float rsq(float x) { return __builtin_amdgcn_rsqf(x); }

__device__ __forceinline__ void tr_item64(const float* W, int ldw, int src_col, bf16* WT, int K, int dst_row, int k0, LAS bf16* tl, int lane) {
    const int cg = lane & 15, rr = lane >> 4;
    f32x4 v[16];
#pragma unroll
    for (int i = 0; i < 16; ++i) v[i] = *(const GAS f32x4*)(W + (size_t)(k0 + 4 * i + rr) * ldw + src_col + 4 * cg);
#pragma unroll
    for (int i = 0; i < 16; ++i) *(LAS unsigned long long*)(tl + (4 * i + rr) * 68 + 4 * cg) = (unsigned long long)cvtpk(v[i].x, v[i].y) | ((unsigned long long)cvtpk(v[i].z, v[i].w) << 32);
    LDS_WAIT(); asm volatile("" ::: "memory");
#pragma unroll
    for (int ii = 0; ii < 8; ++ii) { const int p = lane + 64 * ii, n = p >> 3, kc = p & 7; const LAS bf16* s = tl + (8 * kc) * 68 + n;
        v4u o; o.x = (unsigned)s[0] | ((unsigned)s[68] << 16); o.y = (unsigned)s[2 * 68] | ((unsigned)s[3 * 68] << 16); o.z = (unsigned)s[4 * 68] | ((unsigned)s[5 * 68] << 16); o.w = (unsigned)s[6 * 68] | ((unsigned)s[7 * 68] << 16);
        *(GAS v4u*)(WT + (size_t)(dst_row + n) * K + k0 + 8 * kc) = o; }
    LDS_WAIT(); asm volatile("" ::: "memory");
}

__device__ __forceinline__ void p0_prologue(Frame& F) {
    LAS bf16* tl = (LAS bf16*)(F.lds + RING_OFF + F.wave * 16384);
    const int gw = F.vcu * NWAVES + F.wave, NGW = F.G * NWAVES, lane = F.lane;
    constexpr int I_ADA = 24 * 32, I_IN = 16 * (NP / 64), I_OUT = 16 * 16, I_GU = 16 * (NGU / 64), I_DN = (FF / 64) * 16;
    constexpr int NITEMS = I_ADA + I_IN + I_OUT + I_GU + I_DN;
    for (int it = gw; it < NITEMS; it += NGW) {
        int r = it;
        if (r < I_ADA) {
            const int ct = r % 24, ks = r / 24, col = ct * 256 + 4 * lane, k0 = ks * 32;
            f32x4 acc[4];
#pragma unroll
            for (int b = 0; b < 4; ++b) acc[b] = (f32x4){0.f, 0.f, 0.f, 0.f};
#pragma unroll 16
            for (int kk = 0; kk < 32; ++kk) { const int k = k0 + kk; const f32x4 w = *(const GAS f32x4*)(F.w_ada + (size_t)k * (6 * D) + col);
#pragma unroll
                for (int b = 0; b < 4; ++b) acc[b] += silu(F.c[b * D + k]) * w; }
#pragma unroll
            for (int b = 0; b < 4; ++b)
#pragma unroll
                for (int j = 0; j < 4; ++j) atomicAdd(F.modacc + b * (6 * D) + col + j, acc[b][j]);
            continue;
        }
        r -= I_ADA;
        if (r < I_IN) { const int nb = r % (NP / 64), kb = r / (NP / 64), n0 = 64 * nb;
            tr_item64(F.w_in, PROJ_W, n0 < 2048 ? n0 : (n0 < 2816 ? n0 + 16 : (n0 == 2816 ? 2048 : 0)), F.Win_t, D, n0, 64 * kb, tl, lane); continue; }
        r -= I_IN;
        if (r < I_OUT) { const int nb = r % 16, kb = r / 16; tr_item64(F.w_out, D, 64 * nb, F.Wout_t, D, 64 * nb, 64 * kb, tl, lane); continue; }
        r -= I_OUT;
        if (r < I_GU) { const int nb = r % (NGU / 64), kb = r / (NGU / 64), n0 = 64 * nb, p = n0 >> 8, j = n0 & 255;
            if (j < 128) tr_item64(F.w_gate, FF, 128 * p + j, F.Wgu_t, D, n0, 64 * kb, tl, lane);
            else         tr_item64(F.w_up,   FF, 128 * p + j - 128, F.Wgu_t, D, n0, 64 * kb, tl, lane);
            continue; }
        r -= I_GU;
        { const int nb = r % 16, kb = r / 16; tr_item64(F.w_down, D, 64 * nb, F.Wdn_t, FF, 64 * nb, 64 * kb, tl, lane); }
    }
}

template <int WHICH> __device__ __forceinline__ void norm_phase(Frame& F) {
    const int gw = F.vcu * NWAVES + F.wave, NGW = F.G * NWAVES, lane = F.lane;
    if (WHICH == 1) {
        for (int idx = gw * 64 + lane; idx < 4 * 6 * D; idx += NGW * 64) F.modf[idx] = F.modacc[idx] + F.b_ada[idx % (6 * D)];
    }
    const float* nw = (WHICH == 1) ? F.norm1_w : F.norm2_w;
    constexpr int R = (WHICH == 1) ? 4 : 8;
    for (int m0 = gw * R; m0 < M; m0 += NGW * R) {
        const int b = m0 / T;
        f32x4 v[R][4];
#pragma unroll
        for (int r = 0; r < R; ++r) {
            if (WHICH == 1) { const GAS f32x4* xr = (const GAS f32x4*)(F.x + (size_t)(m0 + r) * D) + lane;
#pragma unroll
                for (int i = 0; i < 4; ++i) v[r][i] = xr[64 * i]; }
            else { const GAS unsigned long long* xr = (const GAS unsigned long long*)(F.X1B + (size_t)(m0 + r) * D) + lane;
#pragma unroll
                for (int i = 0; i < 4; ++i) { const unsigned long long bb = xr[64 * i]; const unsigned lo = (unsigned)bb, hi = (unsigned)(bb >> 32);
                    v[r][i] = (f32x4){__uint_as_float(lo << 16), __uint_as_float(lo & 0xffff0000u), __uint_as_float(hi << 16), __uint_as_float(hi & 0xffff0000u)}; } } }
        f32x4 gm[4], sh[4];
#pragma unroll
        for (int i = 0; i < 4; ++i) { const int c = 256 * i + 4 * lane; f32x4 sc, sf;
            if (WHICH == 1) { sf = *(const GAS f32x4*)(F.modacc + b * 6 * D + c) + *(const GAS f32x4*)(F.b_ada + c); sc = *(const GAS f32x4*)(F.modacc + b * 6 * D + D + c) + *(const GAS f32x4*)(F.b_ada + D + c); }
            else { sf = *(const GAS f32x4*)(F.modf + b * 6 * D + 3 * D + c); sc = *(const GAS f32x4*)(F.modf + b * 6 * D + 4 * D + c); }
            gm[i] = *(const GAS f32x4*)(nw + c) * (sc + 1.0f); sh[i] = sf; }
#pragma unroll
        for (int r = 0; r < R; ++r) {
            float ss = 0.f;
#pragma unroll
            for (int i = 0; i < 4; ++i) ss += (v[r][i].x * v[r][i].x + v[r][i].y * v[r][i].y) + (v[r][i].z * v[r][i].z + v[r][i].w * v[r][i].w);
            const float rstd = rsq(wave_sum(ss) * (1.0f / D) + EPS);
            GAS unsigned long long* o8 = (GAS unsigned long long*)(F.H + (size_t)(m0 + r) * D) + lane;
#pragma unroll
            for (int i = 0; i < 4; ++i) { const f32x4 a = v[r][i] * rstd * gm[i] + sh[i];
                o8[64 * i] = (unsigned long long)cvtpk(a[0], a[1]) | ((unsigned long long)cvtpk(a[2], a[3]) << 32); }
        }
    }
}

__device__ __forceinline__ float rdlane(float v, int l) { return __int_as_float(__builtin_amdgcn_readlane(__float_as_int(v), l)); }
__device__ __forceinline__ bf16x8 pack8(const f32x4 a, const f32x4 b) {
    v4u w; w.x = cvtpk(a[0], a[1]); w.y = cvtpk(a[2], a[3]); w.z = cvtpk(b[0], b[1]); w.w = cvtpk(b[2], b[3]); return __builtin_bit_cast(bf16x8, w); }
__device__ __forceinline__ bf16x8 tile_frag(const LAS bf16* tile, int t, int ks, int fr, int fq) {
    const LAS bf16* p = tile + (16 * t + fr) * 64 + 32 * ks + 4 * fq;
    const unsigned long long lo = *(const LAS unsigned long long*)p, hi = *(const LAS unsigned long long*)(p + 16);
    v4u v; v.x = (unsigned)lo; v.y = (unsigned)(lo >> 32); v.z = (unsigned)hi; v.w = (unsigned)(hi >> 32); return __builtin_bit_cast(bf16x8, v);
}
__device__ __forceinline__ unsigned long long pack4(float a, float b, float c, float d) { return (unsigned long long)cvtpk(a, b) | ((unsigned long long)cvtpk(c, d) << 32); }

typedef short s16x4 __attribute__((ext_vector_type(4)));
__device__ __forceinline__ s16x4 cvt4(const f32x4 v) { const unsigned lo = cvtpk(v[0], v[1]), hi = cvtpk(v[2], v[3]); typedef unsigned u32x2 __attribute__((ext_vector_type(2))); return __builtin_bit_cast(s16x4, (u32x2){lo, hi}); }
#define MFMA16(a, b, c) __builtin_amdgcn_mfma_f32_16x16x16bf16_1k((a), (b), (c), 0, 0, 0)
#define MFMA32(a, b, c) __builtin_amdgcn_mfma_f32_16x16x32_bf16((a), (b), (c), 0, 0, 0)

__device__ __forceinline__ void gdn_prep_chunk(Frame& F, int ci, LAS unsigned char* wl  ) {
    const int lane = F.lane, bh = ci >> 6, n = ci & 63, b = bh >> 3, hh = bh & 7, fr = lane & 15, fq = lane >> 4;
    const size_t m0 = (size_t)b * T + 64 * n;
    bf16* const cA = F.CHKA + (size_t)ci * 8192;
    bf16* const cT = F.CHKT + (size_t)ci * 8192;
    bf16* const cU = F.CHKU + (size_t)ci * 8192;
    LAS bf16* const R0 = (LAS bf16*)wl;
    LAS bf16* const R1 = (LAS bf16*)(wl + 9728);
#define GDN_RAW(dst, col0) do { _Pragma("unroll") for (int i_ = 0; i_ < 9; ++i_) { long row_ = (long)m0 - 3 + 8 * i_ + (lane >> 3); row_ = row_ < 0 ? 0 : (row_ > M - 1 ? M - 1 : row_); \
        __builtin_amdgcn_global_load_lds((const unsigned*)(F.PQ + (size_t)row_ * NP + (col0) + hh * 64 + (lane & 7) * 8), (LAS unsigned*)((dst) + i_ * 512), 16, 0, 0); } } while (0)
    GDN_RAW(R0, C_GQ); GDN_RAW(R1, C_GK);
    const f32x4 z4 = (f32x4){0.f, 0.f, 0.f, 0.f};
    float g, beta;
    {
        const float ga = bf2f(F.PQ[(m0 + lane) * NP + C_GA + hh]), gbv = bf2f(F.PQ[(m0 + lane) * NP + C_GB + hh]);
        const float xx = ga + F.dt_bias[hh]; g = -__expf(F.a_log[hh]) * (fmaxf(xx, 0.f) + log1pf(__expf(-fabsf(xx)))); beta = __builtin_amdgcn_rcpf(1.0f + __expf(-gbv));
    }
    float G = g;
#pragma unroll
    for (int o = 1; o < 64; o <<= 1) { const float t = __shfl_up(G, o); if (lane >= o) G += t; }
    const float eG = __expf(G), Glast = __shfl(G, 63), kdsc = __expf(Glast - G), beG = beta * eG;
    if (lane == 0) F.dec[ci] = __expf(Glast);
    asm volatile("s_waitcnt vmcnt(0)" ::: "memory");
    {
        const float a0 = F.conv_w[hh * 64 + lane], a1 = F.conv_w[1536 + hh * 64 + lane], a2 = F.conv_w[2 * 1536 + hh * 64 + lane], a3 = F.conv_w[3 * 1536 + hh * 64 + lane];
        const float b0 = F.conv_w[512 + hh * 64 + lane], b1 = F.conv_w[1536 + 512 + hh * 64 + lane], b2 = F.conv_w[2 * 1536 + 512 + hh * 64 + lane], b3 = F.conv_w[3 * 1536 + 512 + hh * 64 + lane];
        float x0 = 0.f, x1 = 0.f, x2 = 0.f, y0 = 0.f, y1 = 0.f, y2 = 0.f;
        if (n > 0) { x0 = bf2f(R0[lane]); x1 = bf2f(R0[64 + lane]); x2 = bf2f(R0[128 + lane]); y0 = bf2f(R1[lane]); y1 = bf2f(R1[64 + lane]); y2 = bf2f(R1[128 + lane]); }
#pragma unroll
        for (int c = 0; c < 64; ++c) {
            const float rq = bf2f(R0[(c + 3) * 64 + lane]), rk = bf2f(R1[(c + 3) * 64 + lane]);
            const float cq = silu(a0 * x0 + a1 * x1 + a2 * x2 + a3 * rq), ck = silu(b0 * y0 + b1 * y1 + b2 * y2 + b3 * rk);
            x0 = x1; x1 = x2; x2 = rq; y0 = y1; y1 = y2; y2 = rk;
            R0[c * 64 + lane] = (bf16)(cvtpk(cq, cq) & 0xffffu);
            R1[c * 64 + lane] = (bf16)(cvtpk(ck, ck) & 0xffffu);
            if ((c & 15) == 15) __builtin_amdgcn_sched_barrier(0);
        }
    }
    LDS_WAIT(); asm volatile("" ::: "memory"); __builtin_amdgcn_sched_barrier(0);
    bf16x8 kf[4][2], qf[4][2];
#pragma unroll
    for (int blk = 0; blk < 4; ++blk)
#pragma unroll
        for (int kk = 0; kk < 2; ++kk) { kf[blk][kk] = *(const LAS bf16x8*)(R1 + (16 * blk + fr) * 64 + 32 * kk + 8 * fq); qf[blk][kk] = *(const LAS bf16x8*)(R0 + (16 * blk + fr) * 64 + 32 * kk + 8 * fq); }
    float rqc[4], rkc[4];
#pragma unroll
    for (int t = 0; t < 4; ++t) { f32x4 dq = MFMA32(qf[t][0], qf[t][0], z4); dq = MFMA32(qf[t][1], qf[t][1], dq); f32x4 dk = MFMA32(kf[t][0], kf[t][0], z4); dk = MFMA32(kf[t][1], kf[t][1], dk);
        const int di = fr & 3; const bool on = (fq == (fr >> 2));
        const float vq = di == 0 ? dq[0] : di == 1 ? dq[1] : di == 2 ? dq[2] : dq[3], vk = di == 0 ? dk[0] : di == 1 ? dk[1] : di == 2 ? dk[2] : dk[3];
        rqc[t] = rsq(fq_sum(on ? vq : 0.f) + EPS); rkc[t] = rsq(fq_sum(on ? vk : 0.f) + EPS); }
    const float rk_tok = fq == 0 ? rkc[0] : fq == 1 ? rkc[1] : fq == 2 ? rkc[2] : rkc[3];
    const float beGn = beG * rk_tok, kdscn = kdsc * rk_tok;
    float Gcol[4], Bcol[4];
#pragma unroll
    for (int t = 0; t < 4; ++t) { Gcol[t] = __shfl(G, 16 * t + fr); Bcol[t] = __shfl(beta, 16 * t + fr) * rkc[t]; }
#pragma unroll
    for (int mt = 0; mt < 4; ++mt) { const float esc = __expf(Gcol[mt]) * 0.125f * rqc[mt];
#pragma unroll
        for (int ks = 0; ks < 2; ++ks) { const v4u q8 = __builtin_bit_cast(v4u, tile_frag(R0, mt, ks, fr, fq)); const unsigned w_[4] = {q8.x, q8.y, q8.z, q8.w}; v4u o_;
            o_.x = cvtpk(__uint_as_float(w_[0] << 16) * esc, __uint_as_float(w_[0] & 0xffff0000u) * esc); o_.y = cvtpk(__uint_as_float(w_[1] << 16) * esc, __uint_as_float(w_[1] & 0xffff0000u) * esc);
            o_.z = cvtpk(__uint_as_float(w_[2] << 16) * esc, __uint_as_float(w_[2] & 0xffff0000u) * esc); o_.w = cvtpk(__uint_as_float(w_[3] << 16) * esc, __uint_as_float(w_[3] & 0xffff0000u) * esc);
            *(GAS v4u*)(cT + ((mt * 2 + ks) * 64 + lane) * 8) = o_; } }
    LDS_WAIT(); asm volatile("" ::: "memory"); __builtin_amdgcn_sched_barrier(0);
#pragma unroll
    for (int ks = 0; ks < 2; ++ks) { float Grow[2][4], Krow[2][4];
#pragma unroll
        for (int h2 = 0; h2 < 2; ++h2)
#pragma unroll
            for (int i = 0; i < 4; ++i) { Grow[h2][i] = __shfl(G, 16 * (2 * ks + h2) + 4 * fq + i); Krow[h2][i] = __shfl(rk_tok, 16 * (2 * ks + h2) + 4 * fq + i); }
#pragma unroll
        for (int tc = 0; tc < 4; ++tc) {
            f32x4 v[2];
#pragma unroll
            for (int h2 = 0; h2 < 2; ++h2) { const int ts = 2 * ks + h2;
                if (ts <= tc) { f32x4 acc = MFMA32(kf[ts][0], qf[tc][0], z4); acc = MFMA32(kf[ts][1], qf[tc][1], acc);
#pragma unroll
                    for (int i = 0; i < 4; ++i) { const int cidx = 16 * tc + fr, sidx = 16 * ts + 4 * fq + i; v[h2][i] = (cidx >= sidx) ? acc[i] * __expf(Gcol[tc] - Grow[h2][i]) * (0.125f * rqc[tc]) * Krow[h2][i] : 0.f; }
                } else v[h2] = z4; }
            *(bf16x8*)(cT + 4096 + ((tc * 2 + ks) * 64 + lane) * 8) = pack8(v[0], v[1]);
        } }
#pragma unroll
    for (int ts = 0; ts < 4; ++ts) { float Grow[4], Krow[4];
#pragma unroll
        for (int i = 0; i < 4; ++i) { Grow[i] = __shfl(G, 16 * ts + 4 * fq + i); Krow[i] = __shfl(rk_tok, 16 * ts + 4 * fq + i); }
#pragma unroll
        for (int tc = 0; tc < 4; ++tc) { f32x4 a = z4;
            if (ts <= tc) { f32x4 acc = MFMA32(kf[ts][0], kf[tc][0], z4); acc = MFMA32(kf[ts][1], kf[tc][1], acc);
#pragma unroll
                for (int i = 0; i < 4; ++i) { const int cidx = 16 * tc + fr, sidx = 16 * ts + 4 * fq + i; a[i] = (cidx > sidx) ? Bcol[tc] * Krow[i] * acc[i] * __expf(Gcol[tc] - Grow[i]) : 0.f; } }
            *(LAS unsigned long long*)(R0 + (16 * tc + fr) * 64 + 16 * ts + 4 * fq) = pack4(a[0], a[1], a[2], a[3]); } }
    bf16x8 RkB[4][2], KDf[4][2];
#pragma unroll
    for (int ks = 0; ks < 2; ++ks) { float sB[8], sD[8];
#pragma unroll
        for (int j = 0; j < 8; ++j) { const int tok = 32 * ks + 16 * (j >> 2) + 4 * fq + (j & 3); sB[j] = __shfl(beGn, tok); sD[j] = __shfl(kdscn, tok); }
#pragma unroll
        for (int t = 0; t < 4; ++t) { float kv[8];
#pragma unroll
            for (int j = 0; j < 8; ++j) kv[j] = bf2f(R1[(32 * ks + 16 * (j >> 2) + 4 * fq + (j & 3)) * 64 + 16 * t + fr]);
            v4u a_, d_;
            a_.x = cvtpk(kv[0] * sB[0], kv[1] * sB[1]); a_.y = cvtpk(kv[2] * sB[2], kv[3] * sB[3]); a_.z = cvtpk(kv[4] * sB[4], kv[5] * sB[5]); a_.w = cvtpk(kv[6] * sB[6], kv[7] * sB[7]);
            d_.x = cvtpk(kv[0] * sD[0], kv[1] * sD[1]); d_.y = cvtpk(kv[2] * sD[2], kv[3] * sD[3]); d_.z = cvtpk(kv[4] * sD[4], kv[5] * sD[5]); d_.w = cvtpk(kv[6] * sD[6], kv[7] * sD[7]);
            RkB[t][ks] = __builtin_bit_cast(bf16x8, a_); KDf[t][ks] = __builtin_bit_cast(bf16x8, d_); } }
    LDS_WAIT(); asm volatile("" ::: "memory"); __builtin_amdgcn_sched_barrier(0);
    {
        float X[16];
#pragma unroll
        for (int r = 0; r < 16; ++r) X[r] = (r == fr) ? 1.f : 0.f;
        const LAS bf16* ab = R0 + (16 * fq) * 64 + 16 * fq;
#pragma unroll
        for (int s = 0; s < 15; ++s) {
#pragma unroll
            for (int r = s + 1; r < 16; ++r) X[r] -= bf2f(ab[r * 64 + s]) * X[s];
            if ((s & 3) == 3) __builtin_amdgcn_sched_barrier(0);
        }
        LDS_WAIT(); asm volatile("" ::: "memory"); __builtin_amdgcn_sched_barrier(0);
#pragma unroll
        for (int r = 0; r < 16; ++r) R0[(16 * fq + r) * 64 + 16 * fq + fr] = (bf16)(cvtpk(X[r], X[r]) & 0xffffu);
    }
    LDS_WAIT(); asm volatile("" ::: "memory"); __builtin_amdgcn_sched_barrier(0);
    {
#define A16(i, k) (*(const LAS s16x4*)(R0 + (16 * (i) + fr) * 64 + 16 * (k) + 4 * fq))
        s16x4 Td[4];
#pragma unroll
        for (int j = 0; j < 3; ++j) { const LAS bf16* p = R0 + (16 * j + 4 * fq) * 64 + 16 * j + fr; typedef unsigned u32x2 __attribute__((ext_vector_type(2)));
            Td[j] = __builtin_bit_cast(s16x4, (u32x2){(unsigned)p[0] | ((unsigned)p[64] << 16), (unsigned)p[128] | ((unsigned)p[192] << 16)}); }
        f32x4 m10 = MFMA16(A16(1, 0), Td[0], z4);
        const f32x4 t10 = -MFMA16(A16(1, 1), cvt4(m10), z4);
        f32x4 m21 = MFMA16(A16(2, 1), Td[1], z4);
        f32x4 m20 = MFMA16(A16(2, 0), Td[0], z4); m20 = MFMA16(A16(2, 1), cvt4(t10), m20);
        const s16x4 a22 = A16(2, 2);
        const f32x4 t21 = -MFMA16(a22, cvt4(m21), z4), t20 = -MFMA16(a22, cvt4(m20), z4);
        f32x4 m32 = MFMA16(A16(3, 2), Td[2], z4);
        f32x4 m31 = MFMA16(A16(3, 1), Td[1], z4); m31 = MFMA16(A16(3, 2), cvt4(t21), m31);
        f32x4 m30 = MFMA16(A16(3, 0), Td[0], z4); m30 = MFMA16(A16(3, 1), cvt4(t10), m30); m30 = MFMA16(A16(3, 2), cvt4(t20), m30);
        const s16x4 a33 = A16(3, 3);
        const f32x4 t32 = -MFMA16(a33, cvt4(m32), z4), t31 = -MFMA16(a33, cvt4(m31), z4), t30 = -MFMA16(a33, cvt4(m30), z4);
        LDS_WAIT(); asm volatile("" ::: "memory"); __builtin_amdgcn_sched_barrier(0);
#define TST(i, j, t) do { _Pragma("unroll") for (int r_ = 0; r_ < 4; ++r_) R0[(16 * (i) + 4 * fq + r_) * 64 + 16 * (j) + fr] = (bf16)(cvtpk((t)[r_], (t)[r_]) & 0xffffu); } while (0)
        TST(1, 0, t10); TST(2, 0, t20); TST(2, 1, t21); TST(3, 0, t30); TST(3, 1, t31); TST(3, 2, t32);
#undef TST
#undef A16
    }
    LDS_WAIT(); asm volatile("" ::: "memory"); __builtin_amdgcn_sched_barrier(0);
#pragma unroll
    for (int ct = 0; ct < 4; ++ct) { const bf16x8 ta0 = tile_frag(R0, ct, 0, fr, fq), ta1 = tile_frag(R0, ct, 1, fr, fq);
#pragma unroll
        for (int dt = 0; dt < 4; ++dt) { f32x4 acc = MFMA32(ta0, RkB[dt][0], z4); if (ct >= 2) acc = MFMA32(ta1, RkB[dt][1], acc);
            *(LAS unsigned long long*)(R1 + (16 * dt + fr) * 64 + 16 * ct + 4 * fq) = pack4(acc[0], acc[1], acc[2], acc[3]); } }
    LDS_WAIT(); asm volatile("" ::: "memory");
    asm volatile("s_waitcnt vmcnt(0)" ::: "memory");
    v4u qdf[8]; bf16x8 qkf[8];
#pragma unroll
    for (int f = 0; f < 8; ++f) { qdf[f] = *(const GAS v4u*)(cT + (f * 64 + lane) * 8); qkf[f] = *(const GAS bf16x8*)(cT + 4096 + (f * 64 + lane) * 8); }
    bf16x8 waf[4][2];
#pragma unroll
    for (int tm = 0; tm < 4; ++tm) { waf[tm][0] = tile_frag(R1, tm, 0, fr, fq); waf[tm][1] = tile_frag(R1, tm, 1, fr, fq); }
    LDS_WAIT(); asm volatile("" ::: "memory");
    GDN_RAW(R1, C_GV);
#pragma unroll
    for (int tn = 0; tn < 4; ++tn) {
#pragma unroll
        for (int ks2 = 0; ks2 < 2; ++ks2) {
            const v4u qd8 = qdf[tn * 2 + ks2]; const unsigned qw_[4] = {qd8.x, qd8.y, qd8.z, qd8.w};
            f32x4 pp[2], q2[2];
#pragma unroll
            for (int h2 = 0; h2 < 2; ++h2) { const int tm = 2 * ks2 + h2;
                f32x4 a1 = MFMA32(waf[tm][0], KDf[tn][0], z4); a1 = MFMA32(waf[tm][1], KDf[tn][1], a1);
                f32x4 a2 = MFMA32(waf[tm][0], qkf[tn * 2], z4); a2 = MFMA32(waf[tm][1], qkf[tn * 2 + 1], a2);
                pp[h2] = -a1;
                q2[h2] = (f32x4){__uint_as_float(qw_[2 * h2] << 16), __uint_as_float(qw_[2 * h2] & 0xffff0000u), __uint_as_float(qw_[2 * h2 + 1] << 16), __uint_as_float(qw_[2 * h2 + 1] & 0xffff0000u)} - a2; }
            *(GAS bf16x8*)(cA + ((tn * 2 + ks2) * 64 + lane) * 8) = pack8(pp[0], pp[1]);
            *(GAS bf16x8*)(cA + 4096 + ((tn * 2 + ks2) * 64 + lane) * 8) = pack8(q2[0], q2[1]);
        }
    }
    asm volatile("s_waitcnt vmcnt(0)" ::: "memory");
    {
        const float w0 = F.conv_w[1024 + hh * 64 + lane], w1 = F.conv_w[1536 + 1024 + hh * 64 + lane], w2 = F.conv_w[2 * 1536 + 1024 + hh * 64 + lane], w3 = F.conv_w[3 * 1536 + 1024 + hh * 64 + lane];
        float x0 = 0.f, x1 = 0.f, x2 = 0.f;
        if (n > 0) { x0 = bf2f(R1[lane]); x1 = bf2f(R1[64 + lane]); x2 = bf2f(R1[128 + lane]); }
#pragma unroll
        for (int c = 0; c < 64; ++c) {
            const float r = bf2f(R1[(c + 3) * 64 + lane]);
            const float cv = silu(w0 * x0 + w1 * x1 + w2 * x2 + w3 * r); x0 = x1; x1 = x2; x2 = r;
            R1[c * 64 + lane] = (bf16)(cvtpk(cv, cv) & 0xffffu);
            if ((c & 15) == 15) __builtin_amdgcn_sched_barrier(0);
        }
    }
    LDS_WAIT(); asm volatile("" ::: "memory"); __builtin_amdgcn_sched_barrier(0);
    bf16x8 RvB[4][2];
#pragma unroll
    for (int ks = 0; ks < 2; ++ks) { float sB[8];
#pragma unroll
        for (int j = 0; j < 8; ++j) sB[j] = __shfl(beta, 32 * ks + 16 * (j >> 2) + 4 * fq + (j & 3));
#pragma unroll
        for (int t = 0; t < 4; ++t) { float vv[8];
#pragma unroll
            for (int j = 0; j < 8; ++j) vv[j] = bf2f(R1[(32 * ks + 16 * (j >> 2) + 4 * fq + (j & 3)) * 64 + 16 * t + fr]) * sB[j];
            v4u a_; a_.x = cvtpk(vv[0], vv[1]); a_.y = cvtpk(vv[2], vv[3]); a_.z = cvtpk(vv[4], vv[5]); a_.w = cvtpk(vv[6], vv[7]);
            RvB[t][ks] = __builtin_bit_cast(bf16x8, a_); } }
    LDS_WAIT(); asm volatile("" ::: "memory"); __builtin_amdgcn_sched_barrier(0);
#pragma unroll
    for (int ct = 0; ct < 4; ++ct) { const bf16x8 ta0 = tile_frag(R0, ct, 0, fr, fq), ta1 = tile_frag(R0, ct, 1, fr, fq);
#pragma unroll
        for (int et = 0; et < 4; ++et) { f32x4 acc = MFMA32(ta0, RvB[et][0], z4); if (ct >= 2) acc = MFMA32(ta1, RvB[et][1], acc);
            *(LAS unsigned long long*)(R1 + (16 * et + fr) * 64 + 16 * ct + 4 * fq) = pack4(acc[0], acc[1], acc[2], acc[3]); } }
    LDS_WAIT(); asm volatile("" ::: "memory"); __builtin_amdgcn_sched_barrier(0);
#pragma unroll
    for (int et = 0; et < 4; ++et) {
        const bf16x8 ub0 = tile_frag(R1, et, 0, fr, fq), ub1 = tile_frag(R1, et, 1, fr, fq);
#pragma unroll
        for (int tm = 0; tm < 4; ++tm) {
            const bf16x8 qa0 = qkf[tm * 2], qa1 = qkf[tm * 2 + 1];
            f32x4 r = MFMA32(KDf[tm][0], ub0, z4); r = MFMA32(KDf[tm][1], ub1, r);
            f32x4 o = MFMA32(qa0, ub0, z4); o = MFMA32(qa1, ub1, o);
            *(GAS unsigned long long*)(cU + ((et * 4 + tm) * 64 + lane) * 4) = pack4(r[0], r[1], r[2], r[3]);
            *(GAS unsigned long long*)(cU + 4096 + ((et * 4 + tm) * 64 + lane) * 4) = pack4(o[0], o[1], o[2], o[3]);
        }
    }
    LDS_WAIT(); asm volatile("" ::: "memory"); __builtin_amdgcn_sched_barrier(0);
}
#undef MFMA16
#undef MFMA32
#undef GDN_RAW

#define GDN_BAR() do { asm volatile("" ::: "memory"); __builtin_amdgcn_s_barrier(); asm volatile("" ::: "memory"); } while (0)
__device__ __forceinline__ void gdn_scan(Frame& F, int bh) {
    const int lane = F.lane, wave = F.wave, b = bh >> 3, hh = bh & 7, fr = lane & 15, fq = lane >> 4;
    LAS unsigned char* const ring = F.lds + RING_OFF;
    constexpr int SLOT = 32768, OB0 = 131072, OB1 = 139264;
    const unsigned char* gA = (const unsigned char*)(F.CHKA + (size_t)bh * 64 * 8192);
    const unsigned char* gU = (const unsigned char*)(F.CHKU + (size_t)bh * 64 * 8192);
    if (wave >= 4) {
        const int hw = wave - 4, nt = hw * 64 + lane;
        bf16* mp = F.ORAW + ((size_t)b * T + (nt >> 3)) * 512 + hh * 64 + (nt & 7) * 8;
#define GDN_ISSUE(nn) do { const int n_ = (nn); const int sl_ = n_ & 3; _Pragma("unroll") for (int i_ = 0; i_ < 8; ++i_) { const int p_ = hw * 8 + i_; \
            const unsigned char* s_ = (p_ < 16) ? gA + (size_t)n_ * 16384 + p_ * 1024 : gU + (size_t)n_ * 16384 + (p_ - 16) * 1024; \
            __builtin_amdgcn_global_load_lds((const unsigned*)(s_ + lane * 16), (LAS unsigned*)(ring + sl_ * SLOT + p_ * 1024), 16, 0, 0); } } while (0)
#define GDN_COPY(nn) do { const LAS unsigned char* ob_ = ring + (((nn) & 1) ? OB1 : OB0); _Pragma("unroll") for (int k_ = 0; k_ < 2; ++k_) \
            *(GAS v4u*)(mp + (size_t)(64 * (nn) + 32 * k_) * 512) = *(const LAS v4u*)(ob_ + (nt + 256 * k_) * 16); } while (0)
        GDN_ISSUE(0); GDN_ISSUE(1); GDN_ISSUE(2);
        asm volatile("s_waitcnt vmcnt(16)" ::: "memory"); GDN_BAR();
        for (int n = 0; n < 64; ++n) {
            if (n + 3 < 64) { GDN_ISSUE(n + 3); asm volatile("s_waitcnt vmcnt(16)" ::: "memory"); } else asm volatile("s_waitcnt vmcnt(0)" ::: "memory");
            if (n > 0) GDN_COPY(n - 1);
            LDS_WAIT(); GDN_BAR();
        }
        GDN_COPY(63);
#undef GDN_ISSUE
#undef GDN_COPY
    } else {
        const int ew = wave;
        f32x4 Sacc[4];
#pragma unroll
        for (int t = 0; t < 4; ++t) Sacc[t] = (f32x4){0.f, 0.f, 0.f, 0.f};
        const float decs = ld_f32_coh(F.dec + bh * 64 + lane);
        GDN_BAR();
        for (int n = 0; n < 64; ++n) {
            const LAS unsigned char* sl = ring + (n & 3) * SLOT;
            LAS bf16* ob = (LAS bf16*)(ring + ((n & 1) ? OB1 : OB0)) + (4 * fq) * 64 + 16 * ew + fr;
            const float dec = __int_as_float(__builtin_amdgcn_readlane(__float_as_int(decs), n));
            unsigned long long rf[4], of[4]; bf16x8 pf[8], qf[8];
#pragma unroll
            for (int t = 0; t < 4; ++t) { rf[t] = *(const LAS unsigned long long*)(sl + 16384 + ((ew * 4 + t) * 64 + lane) * 8); of[t] = *(const LAS unsigned long long*)(sl + 24576 + ((ew * 4 + t) * 64 + lane) * 8); }
#pragma unroll
            for (int f = 0; f < 8; ++f) { pf[f] = *(const LAS bf16x8*)(sl + (f * 64 + lane) * 16); qf[f] = *(const LAS bf16x8*)(sl + 8192 + (f * 64 + lane) * 16); }
            __builtin_amdgcn_sched_barrier(0);
            bf16x8 Sb[2]; Sb[0] = pack8(Sacc[0], Sacc[1]); Sb[1] = pack8(Sacc[2], Sacc[3]);
            f32x4 O[4];
#pragma unroll
            for (int t = 0; t < 4; ++t) { const unsigned rl = (unsigned)rf[t], rh = (unsigned)(rf[t] >> 32), ol = (unsigned)of[t], oh = (unsigned)(of[t] >> 32);
                Sacc[t] = Sacc[t] * dec + (f32x4){__uint_as_float(rl << 16), __uint_as_float(rl & 0xffff0000u), __uint_as_float(rh << 16), __uint_as_float(rh & 0xffff0000u)};
                O[t] = (f32x4){__uint_as_float(ol << 16), __uint_as_float(ol & 0xffff0000u), __uint_as_float(oh << 16), __uint_as_float(oh & 0xffff0000u)}; }
#pragma unroll
            for (int t = 0; t < 4; ++t)
#pragma unroll
                for (int ks = 0; ks < 2; ++ks) { const int f = t * 2 + ks;
                    Sacc[t] = __builtin_amdgcn_mfma_f32_16x16x32_bf16(pf[f], Sb[ks], Sacc[t], 0, 0, 0); O[t] = __builtin_amdgcn_mfma_f32_16x16x32_bf16(qf[f], Sb[ks], O[t], 0, 0, 0); }
#pragma unroll
            for (int t = 0; t < 4; ++t)
#pragma unroll
                for (int i = 0; i < 4; ++i) ob[(16 * t + i) * 64] = (bf16)(cvtpk(O[t][i], O[t][i]) & 0xffffu);
            LDS_WAIT(); GDN_BAR();
        }
    }
}
__device__ __forceinline__ void gdn_norm_rows(Frame& F, int r0) {
    const int oc = F.tid & 7, hd = (F.tid >> 3) & 7;
    float nw[8];
#pragma unroll
    for (int j = 0; j < 8; ++j) nw[j] = F.gdn_norm_w[oc * 8 + j];
#pragma unroll 1
    for (int it = 0; it < 4; ++it) {
        v4u ov[8], zv[8];
#pragma unroll
        for (int k = 0; k < 8; ++k) { const size_t row = (size_t)r0 + (it * 8 + k) * 8 + (F.tid >> 6); ov[k] = *(const GAS v4u*)(F.ORAW + row * 512 + hd * 64 + oc * 8); zv[k] = *(const GAS v4u*)(F.PQ + row * NP + C_GZ + hd * 64 + oc * 8); }
#pragma unroll
        for (int k = 0; k < 8; ++k) { const size_t row = (size_t)r0 + (it * 8 + k) * 8 + (F.tid >> 6);
            const unsigned ow[4] = {ov[k].x, ov[k].y, ov[k].z, ov[k].w}, zw[4] = {zv[k].x, zv[k].y, zv[k].z, zv[k].w};
            float o[8], z[8]; float ss = 0.f;
#pragma unroll
            for (int w = 0; w < 4; ++w) { o[2 * w] = __uint_as_float(ow[w] << 16); o[2 * w + 1] = __uint_as_float(ow[w] & 0xffff0000u); z[2 * w] = __uint_as_float(zw[w] << 16); z[2 * w + 1] = __uint_as_float(zw[w] & 0xffff0000u);
                ss += o[2 * w] * o[2 * w] + o[2 * w + 1] * o[2 * w + 1]; }
            ss = sum8(ss);
            const float rs = rsq(ss * (1.0f / 64.0f) + EPS);
            v4u w4; w4.x = cvtpk(o[0] * rs * nw[0] * z[0], o[1] * rs * nw[1] * z[1]); w4.y = cvtpk(o[2] * rs * nw[2] * z[2], o[3] * rs * nw[3] * z[3]);
            w4.z = cvtpk(o[4] * rs * nw[4] * z[4], o[5] * rs * nw[5] * z[5]); w4.w = cvtpk(o[6] * rs * nw[6] * z[6], o[7] * rs * nw[7] * z[7]);
            *(GAS v4u*)(F.MIX + row * D + hd * 64 + oc * 8) = w4; }
    }
    asm volatile("s_waitcnt vmcnt(0)" ::: "memory"); __syncthreads();
}
__device__ __forceinline__ void swa_unit(Frame& F, int unit, LAS unsigned char* L) {
    const int tid = F.tid, lane = F.lane, wave = F.wave, fr = lane & 15, fq = lane >> 4;
    const int blk = unit & 63, kvh = (unit >> 6) & 1, b = unit >> 7, t0 = blk * 64;
    const size_t row0 = (size_t)b * T;
    LAS bf16* const Ks = (LAS bf16*)L; LAS bf16* const Vt = (LAS bf16*)(L + 27648);
    for (int p = tid; p < 1536; p += NWAVES * 64) {
        const int key = p >> 3, oc = p & 7, s = t0 - 128 + key;
        v4u kv = (v4u){0u, 0u, 0u, 0u}, vv = (v4u){0u, 0u, 0u, 0u};
        if (s >= 0) { kv = *(const GAS v4u*)(F.PQ + (row0 + s) * NP + C_SK + kvh * 64 + oc * 8); vv = *(const GAS v4u*)(F.PQ + (row0 + s) * NP + C_SV + kvh * 64 + oc * 8); }
        const unsigned kw[4] = {kv.x, kv.y, kv.z, kv.w}, vw[4] = {vv.x, vv.y, vv.z, vv.w};
        float k[8]; float ss = 0.f;
#pragma unroll
        for (int w = 0; w < 4; ++w) { k[2 * w] = __uint_as_float(kw[w] << 16); k[2 * w + 1] = __uint_as_float(kw[w] & 0xffff0000u); ss += k[2 * w] * k[2 * w] + k[2 * w + 1] * k[2 * w + 1]; }
        ss = sum8(ss);
        const float rstd = rsq(ss * (1.0f / 64.0f) + EPS);
#pragma unroll
        for (int j = 0; j < 8; ++j) k[j] = k[j] * rstd * F.k_norm_w[oc * 8 + j];
        v4u o; o.x = cvtpk(k[0], k[1]); o.y = cvtpk(k[2], k[3]); o.z = cvtpk(k[4], k[5]); o.w = cvtpk(k[6], k[7]);
        *(LAS v4u*)(Ks + key * 72 + oc * 8) = o;
#pragma unroll
        for (int w = 0; w < 4; ++w) { Vt[(oc * 8 + 2 * w) * 196 + key] = (bf16)(vw[w] & 0xffffu); Vt[(oc * 8 + 2 * w + 1) * 196 + key] = (bf16)(vw[w] >> 16); }
    }
    __syncthreads();
    const int hq = kvh * 4 + (wave >> 1);
    const float slope = exp2f(-(float)(hq + 1)), sink = F.sinks[hq];
#pragma unroll 1
    for (int qt = 0; qt < 2; ++qt) {
        const int tq0 = t0 + 32 * (wave & 1) + 16 * qt;
        bf16x8 qf[2];
        {
            const bf16* qp = F.PQ + (row0 + tq0 + fr) * NP + C_SQ + hq * 64 + 8 * fq;
            const v4u r0 = *(const GAS v4u*)qp, r1 = *(const GAS v4u*)(qp + 32);
            const unsigned qw[8] = {r0.x, r0.y, r0.z, r0.w, r1.x, r1.y, r1.z, r1.w};
            float q[16]; float ss = 0.f;
#pragma unroll
            for (int w = 0; w < 8; ++w) { q[2 * w] = __uint_as_float(qw[w] << 16); q[2 * w + 1] = __uint_as_float(qw[w] & 0xffff0000u); ss += q[2 * w] * q[2 * w] + q[2 * w + 1] * q[2 * w + 1]; }
            ss = fq_sum(ss);
            const float rstd = 0.125f * rsq(ss * (1.0f / 64.0f) + EPS);
#pragma unroll
            for (int kk = 0; kk < 2; ++kk) { float z[8];
#pragma unroll
                for (int j = 0; j < 8; ++j) z[j] = q[8 * kk + j] * rstd * F.q_norm_w[32 * kk + 8 * fq + j];
                v4u o; o.x = cvtpk(z[0], z[1]); o.y = cvtpk(z[2], z[3]); o.z = cvtpk(z[4], z[5]); o.w = cvtpk(z[6], z[7]); qf[kk] = __builtin_bit_cast(bf16x8, o); }
        }
        f32x4 sc[12]; float mx = -INFINITY;
#pragma unroll
        for (int nt = 0; nt < 12; ++nt) { f32x4 acc = (f32x4){0.f, 0.f, 0.f, 0.f};
#pragma unroll
            for (int kk = 0; kk < 2; ++kk) { const bf16x8 kf = *(const LAS bf16x8*)(Ks + (16 * nt + fr) * 72 + 32 * kk + 8 * fq); acc = __builtin_amdgcn_mfma_f32_16x16x32_bf16(kf, qf[kk], acc, 0, 0, 0); }
#pragma unroll
            for (int i = 0; i < 4; ++i) { const int s = t0 - 128 + 16 * nt + 4 * fq + i, dist = tq0 + fr - s; const bool ok = (s >= 0) && (dist >= 0) && (dist < 128);
                const float v = ok ? acc[i] - slope * (float)dist : -INFINITY; acc[i] = v; mx = fmaxf(mx, v); }
            sc[nt] = acc; if (nt & 1) __builtin_amdgcn_sched_barrier(0); }
        mx = fmaxf(fq_max(mx), sink);
        float sum = 0.f;
#pragma unroll
        for (int nt = 0; nt < 12; ++nt)
#pragma unroll
            for (int i = 0; i < 4; ++i) { const float p = __expf(sc[nt][i] - mx); sc[nt][i] = p; sum += p; }
        sum = fq_sum(sum);
        const float den = sum + __expf(sink - mx);
        bf16x8 pf[6];
#pragma unroll
        for (int ks = 0; ks < 6; ++ks) pf[ks] = pack8(sc[2 * ks], sc[2 * ks + 1]);
        float rden[4];
#pragma unroll
        for (int i = 0; i < 4; ++i) rden[i] = __builtin_amdgcn_rcpf(__shfl(den, 4 * fq + i));
        bf16* op = F.MIX + (row0 + tq0 + 4 * fq) * D + 512 + hq * 64 + fr;
#pragma unroll 1
        for (int dt = 0; dt < 4; ++dt) { f32x4 oacc = (f32x4){0.f, 0.f, 0.f, 0.f};
#pragma unroll
            for (int ks = 0; ks < 6; ++ks) { const LAS bf16* vp = Vt + (16 * dt + fr) * 196 + 32 * ks + 4 * fq;
                const unsigned long long lo = *(const LAS unsigned long long*)vp, hi = *(const LAS unsigned long long*)(vp + 16);
                v4u vv; vv.x = (unsigned)lo; vv.y = (unsigned)(lo >> 32); vv.z = (unsigned)hi; vv.w = (unsigned)(hi >> 32);
                oacc = __builtin_amdgcn_mfma_f32_16x16x32_bf16(pf[ks], __builtin_bit_cast(bf16x8, vv), oacc, 0, 0, 0); }
#pragma unroll
            for (int i = 0; i < 4; ++i) op[(size_t)i * D + 16 * dt] = (bf16)f2bf(oacc[i] * rden[i]); }
    }
    __syncthreads();
}
__device__ __forceinline__ void p3a_prep(Frame& F) {
    LAS unsigned char* wl = F.lds + RING_OFF + F.wave * 19456;
    const int gw = F.vcu * NWAVES + F.wave, NGW = F.G * NWAVES;
    for (int ci = gw; ci < BATCH * 8 * (T / 64); ci += NGW) gdn_prep_chunk(F, ci, wl);
}
__device__ __forceinline__ void p3b_mixers(Frame& F) {
    const int bx = blockIdx.x;
    if (bx < 32) gdn_scan(F, bx);
    else for (int u = bx - 32; u < BATCH * 2 * (T / 64); u += F.G - 32) swa_unit(F, u, F.lds + RING_OFF);
}

struct Args { const float* in[18]; float* out; unsigned char* ws; };
__global__ void __launch_bounds__(NWAVES * 64, 2) hymba_fwd(Args args) {
    extern __shared__ __attribute__((aligned(16))) unsigned char lds[];
    Frame F;
    F.lds = (LAS unsigned char*)lds;
    F.MISC = (volatile LAS unsigned*)(F.lds + MISC_OFF);
    F.tid = threadIdx.x; F.lane = F.tid & 63; F.wave = __builtin_amdgcn_readfirstlane(F.tid >> 6);
    F.G = gridDim.x; { const int bx = blockIdx.x; F.vcu = (F.G % 8 == 0) ? (bx % 8) * (F.G / 8) + bx / 8 : bx; }
    unsigned char* ws = args.ws;
    F.ctl = (gu32*)(ws + WS_CTL);
    F.x = args.in[0]; F.c = args.in[1]; F.w_ada = args.in[2]; F.b_ada = args.in[3]; F.norm1_w = args.in[4]; F.w_in = args.in[5]; F.conv_w = args.in[6];
    F.a_log = args.in[7]; F.dt_bias = args.in[8]; F.gdn_norm_w = args.in[9]; F.q_norm_w = args.in[10]; F.k_norm_w = args.in[11]; F.sinks = args.in[12];
    F.w_out = args.in[13]; F.norm2_w = args.in[14]; F.w_gate = args.in[15]; F.w_up = args.in[16]; F.w_down = args.in[17]; F.out = args.out;
    F.modacc = (float*)(ws + WS_CTL) + CW_MODACC; F.modf = (float*)(ws + WS_MODF);
    F.Win_t = (bf16*)(ws + WS_WIN); F.Wout_t = (bf16*)(ws + WS_WOUT); F.Wgu_t = (bf16*)(ws + WS_WGU); F.Wdn_t = (bf16*)(ws + WS_WDN);
    F.H = (bf16*)(ws + WS_H); F.PQ = (bf16*)(ws + WS_PQ); F.MIX = (bf16*)(ws + WS_MIX); F.CHKA = (bf16*)(ws + WS_CHKA); F.CHKU = (bf16*)(ws + WS_H); F.X1B = (bf16*)(ws + WS_CHKA); F.CHKT = (bf16*)(ws + WS_CHKA + 32 * MiB); F.ORAW = (bf16*)(ws + WS_CHKA + 32 * MiB); F.dec = (float*)(ws + WS_DEC);
    for (int u = F.tid; u < (LDS_BYTES - LDSCTL_OFF) / 4; u += NWAVES * 64) ((LAS unsigned*)(F.lds + LDSCTL_OFF))[u] = 0u;
    __syncthreads();
    XcdBarrier bar = xcd_barrier_post((unsigned*)(F.ctl + CW_BAR), F.MISC + 8);
#define GRID_BAR() do { xcd_barrier(bar); int t_ = F.tid; asm volatile("" : "+v"(t_)); F.tid = t_; F.lane = t_ & 63; } while (0)

    p0_prologue(F); GRID_BAR();
    norm_phase<1>(F); GRID_BAR();
    { pg8::Gemm g{F.H, F.Win_t, M, NP, D}; pg8::StaticOrder S; S.init(M, NP, F.G, (int)blockIdx.x);
      pg8::EpiBf16Plain E{F.PQ, NP, C_GZ / 256, C_SQ / 256};
      pg8::gemm_phase<pg8::EpiBf16Plain, pg8::StaticOrder, true, true>(F.lds + RING_OFF, g, S, E); }
    GRID_BAR();
    p3a_prep(F); GRID_BAR();
    p3b_mixers(F); GRID_BAR();
    { pg8::Gemm g{F.MIX, F.Wout_t, M, D, D}; pg8::StaticOrder S; S.init(M, D, F.G, (int)blockIdx.x);
      { pg8::Unit u0; for (int i = 0; S.next(i, u0); ++i) gdn_norm_rows(F, u0.pm * 256); }
      pg8::EpiGateResToBf16 E{F.x, F.X1B, D, F.modf + 2 * D, 6 * D, T};
      pg8::gemm_phase<pg8::EpiGateResToBf16, pg8::StaticOrder, true, true>(F.lds + RING_OFF, g, S, E); }
    GRID_BAR();
    norm_phase<2>(F); GRID_BAR();
    { pg8::Gemm g{F.H, F.Wgu_t, M, NGU, D}; pg8::StaticOrder S; S.init(M, NGU, F.G, (int)blockIdx.x);
      pg8::EpiSwiGLU E{F.PQ, FF};
      pg8::gemm_phase<pg8::EpiSwiGLU, pg8::StaticOrder, true, true>(F.lds + RING_OFF, g, S, E); }
    GRID_BAR();
    { pg8::Gemm g{F.PQ, F.Wdn_t, M, D, FF}; pg8::StaticOrder S; S.init(M, D, F.G, (int)blockIdx.x);
      pg8::EpiGateResFromBf16 E{F.X1B, F.out, D, F.modf + 5 * D, 6 * D, T};
      pg8::gemm_phase<pg8::EpiGateResFromBf16, pg8::StaticOrder, true, true>(F.lds + RING_OFF, g, S, E); }
#undef GRID_BAR
}

extern "C" void kernel_launch(void* const* d_in, const int* in_sizes, int n_in, void* d_out, int out_size, void* d_ws, size_t ws_size, hipStream_t stream) {
    static int grid = 0;
    if (grid == 0) {
        if (n_in != 18 || in_sizes[0] != M * D || out_size != M * D || ws_size < WS_END) { fprintf(stderr, "kernel_launch: unexpected shapes (n_in %d, in0 %d, out %d, ws %zu); nothing launched\n", n_in, n_in > 0 ? in_sizes[0] : -1, out_size, ws_size); grid = -1; return; }
        int dev = 0, cus = 0;
        if (hipGetDevice(&dev) != hipSuccess || hipDeviceGetAttribute(&cus, hipDeviceAttributeMultiprocessorCount, dev) != hipSuccess) { grid = -1; return; }
        if (hipFuncSetAttribute((const void*)hymba_fwd, hipFuncAttributeMaxDynamicSharedMemorySize, LDS_BYTES) != hipSuccess) { fprintf(stderr, "kernel_launch: hipFuncSetAttribute failed\n"); grid = -1; return; }
        (void)hipGetLastError();
        grid = cus;
    }
    if (grid < 0) return;
    if (hipMemsetAsync((char*)d_ws + WS_CTL, 0, CTL_ZERO_BYTES, stream) != hipSuccess) { fprintf(stderr, "kernel_launch: hipMemsetAsync failed\n"); return; }
    Args a{};
    for (int i = 0; i < 18; ++i) a.in[i] = (const float*)d_in[i];
    a.out = (float*)d_out; a.ws = (unsigned char*)d_ws;
    hipLaunchKernelGGL(hymba_fwd, dim3(grid), dim3(NWAVES * 64), LDS_BYTES, stream, a);
    const hipError_t le = hipPeekAtLastError();
    if (le != hipSuccess) fprintf(stderr, "kernel_launch: launch failed: %s\n", hipGetErrorName(le));
}
```

```cpp
#include <hip/hip_runtime.h>
#include <cstdio>
#include <cstdint>
#include <cmath>
namespace pg8 {
#define PG8_LAS __attribute__((address_space(3)))
typedef unsigned short bf16_t;
typedef short bf16x8 __attribute__((ext_vector_type(8)));
typedef float f32x4 __attribute__((ext_vector_type(4)));
typedef unsigned u32x4 __attribute__((ext_vector_type(4)));
constexpr int BM = 256, BK = 64, HALF = 128, HTB = HALF * BK * 2  , STAGE_BYTES = 8 * HTB, NXCD = 8, WGM = 8;

__host__ __device__ __forceinline__ int lds_byte(int r, int c) { const int st = (r >> 4) * 2 + (c >> 5), rr = r & 15, cc = c & 31, ob = rr * 64 + cc * 2; return st * 1024 + (ob ^ (((ob >> 9) & 1) << 5)); }
__host__ __device__ __forceinline__ void stage_rc(int b, int& R, int& C) { const int st = b / 1024, sb = b % 1024, swz = sb ^ (((sb >> 9) & 1) << 5); R = (st >> 1) * 16 + swz / 64; C = (st & 1) * 32 + (swz % 64) / 2; }
__host__ __device__ __forceinline__ int perm32(int rho) { const int n = rho >> 4, i = rho & 15; return 8 * (i >> 2) + 4 * n + (i & 3); }

struct Unit { int pm, pn; };
struct Gemm { const bf16_t* A; const bf16_t* Bt; int M, N, K; };

struct StaticOrder {
    int nM, nN, nwg, G, c;
    __host__ __device__ void init(int M, int N, int G_, int c_) { nM = M / BM; nN = N / BM; nwg = nM * nN; G = G_; c = c_; }
    __host__ __device__ bool next(int i, Unit& u) const {
        const long L = (long)i * G + c; if (L >= nwg) return false;
        int wgid = (int)L; { const int q = nwg / NXCD, r = nwg % NXCD, xcd = wgid % NXCD, off = wgid / NXCD; wgid = (xcd < r ? xcd * (q + 1) : r * (q + 1) + (xcd - r) * q) + off; }
        const int nig = WGM * nN, gid = wgid / nig, fm = gid * WGM, gsz = (nM - fm) < WGM ? (nM - fm) : WGM;
        u.pm = fm + ((wgid % nig) % gsz); u.pn = (wgid % nig) / gsz; return true;
    }
    __device__ __forceinline__ void a_ready(const Unit&) const {}
    __device__ __forceinline__ void done(const Unit&) const {}
};

__device__ __forceinline__ unsigned cvt_pk_bf16(float lo, float hi) { unsigned r; asm volatile("v_cvt_pk_bf16_f32 %0, %1, %2" : "=v"(r) : "v"(lo), "v"(hi)); return r; }
__device__ __forceinline__ float silu_f(float x) { return x * __builtin_amdgcn_rcpf(1.0f + __expf(-x)); }

struct EpiBf16Plain {
    static constexpr bool PERM = true, AFTER_DRAIN = false;
    bf16_t* O; int ldc; int silu_lo, silu_hi;
    __device__ __forceinline__ void operator()(const f32x4 (&acc)[2][2][4][2], const Unit& u, int wr, int wc, int fr, int fq) const {
        const int row0 = u.pm * BM + wr * 64 + fr, col0 = u.pn * BM + wc * 32 + 8 * fq;
        const bool act = (u.pn >= silu_lo) && (u.pn < silu_hi);
#pragma unroll
        for (int ai = 0; ai < 2; ++ai)
#pragma unroll
            for (int m = 0; m < 4; ++m) { bf16_t* rowp = O + (size_t)(row0 + ai * HALF + m * 16) * ldc + col0;
#pragma unroll
                for (int bj = 0; bj < 2; ++bj) { f32x4 v0 = acc[ai][bj][m][0], v1 = acc[ai][bj][m][1];
                    if (act) {
#pragma unroll
                        for (int i = 0; i < 4; ++i) { v0[i] = silu_f(v0[i]); v1[i] = silu_f(v1[i]); } }
                    u32x4 w; w.x = cvt_pk_bf16(v0[0], v0[1]); w.y = cvt_pk_bf16(v0[2], v0[3]); w.z = cvt_pk_bf16(v1[0], v1[1]); w.w = cvt_pk_bf16(v1[2], v1[3]);
                    *(u32x4*)(rowp + bj * HALF) = w; } }
    }
};
struct EpiSwiGLU {
    static constexpr bool PERM = true, AFTER_DRAIN = false;
    bf16_t* O; int ldc;
    __device__ __forceinline__ void operator()(const f32x4 (&acc)[2][2][4][2], const Unit& u, int wr, int wc, int fr, int fq) const {
        const int row0 = u.pm * BM + wr * 64 + fr, col0 = u.pn * HALF + wc * 32 + 8 * fq;
#pragma unroll
        for (int ai = 0; ai < 2; ++ai)
#pragma unroll
            for (int m = 0; m < 4; ++m) { bf16_t* rowp = O + (size_t)(row0 + ai * HALF + m * 16) * ldc + col0;
                const f32x4 g0 = acc[ai][0][m][0], g1 = acc[ai][0][m][1], u0 = acc[ai][1][m][0], u1 = acc[ai][1][m][1];
                float a[8];
#pragma unroll
                for (int i = 0; i < 4; ++i) { a[i] = silu_f(g0[i]) * u0[i]; a[4 + i] = silu_f(g1[i]) * u1[i]; }
                u32x4 w; w.x = cvt_pk_bf16(a[0], a[1]); w.y = cvt_pk_bf16(a[2], a[3]); w.z = cvt_pk_bf16(a[4], a[5]); w.w = cvt_pk_bf16(a[6], a[7]);
                *(u32x4*)rowp = w; }
    }
};
struct EpiGateResToBf16 {
    static constexpr bool PERM = false, AFTER_DRAIN = false;
    const float* base; bf16_t* out; int ldc; const float* gate; int gstride; int rows_per_batch;
    __device__ __forceinline__ void operator()(const f32x4 (&acc)[2][2][4][2], const Unit& u, int wr, int wc, int fr, int fq) const {
        const int row0 = u.pm * BM + wr * 64 + fr, col0 = u.pn * BM + wc * 32 + 4 * fq;
        const float* gp = gate + (size_t)((u.pm * BM) / rows_per_batch) * gstride + col0;
        f32x4 gv[2][2];
#pragma unroll
        for (int bj = 0; bj < 2; ++bj)
#pragma unroll
            for (int n = 0; n < 2; ++n) gv[bj][n] = *(const f32x4*)(gp + bj * HALF + n * 16);
#pragma unroll
        for (int ai = 0; ai < 2; ++ai)
#pragma unroll
            for (int m = 0; m < 4; ++m) { const size_t off = (size_t)(row0 + ai * HALF + m * 16) * ldc + col0;
#pragma unroll
                for (int bj = 0; bj < 2; ++bj)
#pragma unroll
                    for (int n = 0; n < 2; ++n) { const f32x4 o = *(const f32x4*)(base + off + bj * HALF + n * 16) + gv[bj][n] * acc[ai][bj][m][n];
                        *(unsigned long long*)(out + off + bj * HALF + n * 16) = (unsigned long long)cvt_pk_bf16(o[0], o[1]) | ((unsigned long long)cvt_pk_bf16(o[2], o[3]) << 32); } }
    }
};
struct EpiGateResFromBf16 {
    static constexpr bool PERM = false, AFTER_DRAIN = false;
    const bf16_t* base; float* out; int ldc; const float* gate; int gstride; int rows_per_batch;
    __device__ __forceinline__ void operator()(const f32x4 (&acc)[2][2][4][2], const Unit& u, int wr, int wc, int fr, int fq) const {
        const int row0 = u.pm * BM + wr * 64 + fr, col0 = u.pn * BM + wc * 32 + 4 * fq;
        const float* gp = gate + (size_t)((u.pm * BM) / rows_per_batch) * gstride + col0;
        f32x4 gv[2][2];
#pragma unroll
        for (int bj = 0; bj < 2; ++bj)
#pragma unroll
            for (int n = 0; n < 2; ++n) gv[bj][n] = *(const f32x4*)(gp + bj * HALF + n * 16);
#pragma unroll
        for (int ai = 0; ai < 2; ++ai)
#pragma unroll
            for (int m = 0; m < 4; ++m) { const size_t off = (size_t)(row0 + ai * HALF + m * 16) * ldc + col0;
#pragma unroll
                for (int bj = 0; bj < 2; ++bj)
#pragma unroll
                    for (int n = 0; n < 2; ++n) { const unsigned long long bb = *(const unsigned long long*)(base + off + bj * HALF + n * 16); const unsigned lo = (unsigned)bb, hi = (unsigned)(bb >> 32);
                        const f32x4 bs = (f32x4){__uint_as_float(lo << 16), __uint_as_float(lo & 0xffff0000u), __uint_as_float(hi << 16), __uint_as_float(hi & 0xffff0000u)};
                        *(f32x4*)(out + off + bj * HALF + n * 16) = bs + gv[bj][n] * acc[ai][bj][m][n]; } }
    }
};

template <class Epi, class Sched, bool ALIGN_EPI = false, bool SP2 = false>
__device__ __forceinline__ void gemm_phase(PG8_LAS unsigned char* lds, const Gemm g, const Sched& S, const Epi& E) {
    int tid_ = threadIdx.x; asm volatile("" : "+v"(tid_));
    const int tid = tid_, wid = __builtin_amdgcn_readfirstlane(tid >> 6), lane = tid & 63, wr = wid >> 2, wc = wid & 3, fr = lane & 15, fq = lane >> 4;
    const int K = g.K, nt = K / BK;
    unsigned voffA[2], voffB[2];
#pragma unroll
    for (int i = 0; i < 2; ++i) { int R, C; stage_rc(tid * 16 + i * 8192, R, C); const int Rb = Epi::PERM ? ((R & ~31) + perm32(R & 31)) : R;
        voffA[i] = (unsigned)(R * K + C) * 2u; voffB[i] = (unsigned)(Rb * K + C) * 2u; }
    const size_t kstep = (size_t)(BK * 2);
    const size_t hstep = (size_t)HALF * K * 2;
    const size_t tstep = 2 * hstep;
    const unsigned ldsw = (unsigned)wid * 1024u;
    const int aoff = lds_byte(wr * 64 + fr, fq * 8), boff = lds_byte(wc * 32 + fr, fq * 8);
#define PG8_SA(b, h) (((b) * 2 + (h)) * HTB)
#define PG8_SB(b, h) ((4 + (b) * 2 + (h)) * HTB)
#define PG8_STAGE(bufoff, gbase, voff) do { _Pragma("unroll") for (int _i = 0; _i < 2; ++_i) \
        __builtin_amdgcn_global_load_lds((const unsigned*)((const char*)(gbase) + (voff)[_i]), (PG8_LAS unsigned*)(lds + (bufoff) + ldsw + _i * 8192), 16, 0, 0); } while (0)
#define PG8_LDA(dst, b, h) do { _Pragma("unroll") for (int m = 0; m < 4; ++m) _Pragma("unroll") for (int k = 0; k < 2; ++k) dst[m][k] = *(const PG8_LAS bf16x8*)(lds + PG8_SA(b, h) + aoff + m * 2048 + k * 1024); } while (0)
#define PG8_LDB(dst, b, h) do { _Pragma("unroll") for (int n = 0; n < 2; ++n) _Pragma("unroll") for (int k = 0; k < 2; ++k) dst[n][k] = *(const PG8_LAS bf16x8*)(lds + PG8_SB(b, h) + boff + n * 2048 + k * 1024); } while (0)
#define PG8_MMA(ai, bj, At, Bt) do { __builtin_amdgcn_s_setprio(1); _Pragma("unroll") for (int m = 0; m < 4; ++m) _Pragma("unroll") for (int n = 0; n < 2; ++n) _Pragma("unroll") for (int k = 0; k < 2; ++k) \
        acc[ai][bj][m][n] = __builtin_amdgcn_mfma_f32_16x16x32_bf16(Bt[n][k], At[m][k], acc[ai][bj][m][n], 0, 0, 0); __builtin_amdgcn_s_setprio(0); } while (0)
#define PG8_WAIT_V(n) asm volatile("s_waitcnt vmcnt(" #n ")" ::: "memory")
#define PG8_WAIT_L(n) asm volatile("s_waitcnt lgkmcnt(" #n ")" ::: "memory")
#define PG8_BAR __builtin_amdgcn_s_barrier()
#define PG8_SCHED __builtin_amdgcn_sched_barrier(0)
    Unit cur, nxt; int ui = 0;
    if (!S.next(0, cur)) return;
    f32x4 acc[2][2][4][2];
#pragma unroll
    for (int a = 0; a < 2; ++a)
#pragma unroll
        for (int b = 0; b < 2; ++b)
#pragma unroll
            for (int m = 0; m < 4; ++m)
#pragma unroll
                for (int n = 0; n < 2; ++n) acc[a][b][m][n] = (f32x4){0.f, 0.f, 0.f, 0.f};
    bf16x8 At[4][2], B0[2][2], B1[2][2];
    const char* cA = (const char*)g.A + (size_t)cur.pm * tstep; const char* cB = (const char*)g.Bt + (size_t)cur.pn * tstep;
    S.a_ready(cur);
    if constexpr (SP2) {
        PG8_STAGE(PG8_SB(0, 0), cB, voffB); PG8_STAGE(PG8_SB(0, 1), cB + hstep, voffB); PG8_STAGE(PG8_SA(0, 0), cA, voffA); PG8_STAGE(PG8_SA(0, 1), cA + hstep, voffA);
        if (wr == 1) PG8_BAR;
        PG8_WAIT_V(2); PG8_BAR;
        PG8_STAGE(PG8_SB(1, 0), cB + kstep, voffB); PG8_STAGE(PG8_SA(1, 0), cA + kstep, voffA); PG8_STAGE(PG8_SB(1, 1), cB + hstep + kstep, voffB);
        PG8_WAIT_V(6); PG8_BAR;
    } else {
        PG8_STAGE(PG8_SB(0, 0), cB, voffB); PG8_STAGE(PG8_SA(0, 0), cA, voffA); PG8_STAGE(PG8_SB(0, 1), cB + hstep, voffB); PG8_STAGE(PG8_SA(0, 1), cA + hstep, voffA);
        if (wr == 1) PG8_BAR;
        PG8_WAIT_V(4); PG8_BAR;
        PG8_STAGE(PG8_SB(1, 0), cB + kstep, voffB); PG8_STAGE(PG8_SA(1, 0), cA + kstep, voffA); PG8_STAGE(PG8_SB(1, 1), cB + hstep + kstep, voffB);
        PG8_WAIT_V(6); PG8_BAR;
    }
    for (;;) {
        const bool has_next = S.next(ui + 1, nxt);
        const char* nA = has_next ? (const char*)g.A + (size_t)nxt.pm * tstep : cA; const char* nB = has_next ? (const char*)g.Bt + (size_t)nxt.pn * tstep : cB;
        for (int t = 0; t < nt; t += 2) {
            const bool last = (t == nt - 2);
            const char* a1 = cA + (size_t)(t + 1) * kstep;
            const char* a2 = last ? nA : cA + (size_t)(t + 2) * kstep; const char* b2 = last ? nB : cB + (size_t)(t + 2) * kstep;
            const char* a3 = a2 + kstep; const char* b3 = b2 + kstep;
            if (last && has_next) S.a_ready(nxt);
            if constexpr (SP2) {
            PG8_LDB(B0, 0, 0); PG8_LDB(B1, 0, 1); PG8_SCHED; PG8_LDA(At, 0, 0); PG8_STAGE(PG8_SA(1, 1), a1 + hstep, voffA);
            PG8_WAIT_V(8); PG8_WAIT_L(0); PG8_BAR; PG8_MMA(0, 0, At, B0); PG8_MMA(0, 1, At, B1); PG8_BAR; PG8_SCHED;
            PG8_LDA(At, 0, 1); PG8_STAGE(PG8_SB(0, 0), b2, voffB); PG8_STAGE(PG8_SB(0, 1), b2 + hstep, voffB); PG8_STAGE(PG8_SA(0, 0), a2, voffA);
            PG8_WAIT_V(8); PG8_WAIT_L(0); PG8_BAR; PG8_MMA(1, 0, At, B0); PG8_MMA(1, 1, At, B1); PG8_BAR; PG8_SCHED;
            PG8_LDB(B0, 1, 0); PG8_LDB(B1, 1, 1); PG8_SCHED; PG8_LDA(At, 1, 0); PG8_STAGE(PG8_SA(0, 1), a2 + hstep, voffA);
            PG8_WAIT_V(8); PG8_WAIT_L(0); PG8_BAR; PG8_MMA(0, 0, At, B0); PG8_MMA(0, 1, At, B1); PG8_BAR; PG8_SCHED;
            PG8_LDA(At, 1, 1); PG8_STAGE(PG8_SB(1, 0), b3, voffB); PG8_STAGE(PG8_SB(1, 1), b3 + hstep, voffB); PG8_STAGE(PG8_SA(1, 0), a3, voffA);
            PG8_WAIT_V(8); PG8_WAIT_L(0); PG8_BAR; PG8_MMA(1, 0, At, B0); PG8_MMA(1, 1, At, B1); PG8_BAR; PG8_SCHED;
            } else {
            PG8_LDB(B0, 0, 0); PG8_SCHED; PG8_LDA(At, 0, 0); PG8_STAGE(PG8_SA(1, 1), a1 + hstep, voffA);
            PG8_WAIT_L(8); PG8_BAR; PG8_WAIT_L(0); PG8_MMA(0, 0, At, B0); PG8_BAR; PG8_SCHED;
            PG8_LDB(B1, 0, 1); PG8_STAGE(PG8_SB(0, 0), b2, voffB);
            PG8_BAR; PG8_WAIT_L(0); PG8_MMA(0, 1, At, B1); PG8_BAR;
            PG8_LDA(At, 0, 1); PG8_STAGE(PG8_SA(0, 0), a2, voffA);
            PG8_BAR; PG8_WAIT_L(0); PG8_MMA(1, 0, At, B0); PG8_BAR; PG8_SCHED;
            PG8_STAGE(PG8_SB(0, 1), b2 + hstep, voffB);
            PG8_WAIT_V(6); PG8_BAR; PG8_MMA(1, 1, At, B1); PG8_BAR;
            PG8_LDB(B0, 1, 0); PG8_SCHED; PG8_LDA(At, 1, 0); PG8_STAGE(PG8_SA(0, 1), a2 + hstep, voffA);
            PG8_WAIT_L(8); PG8_BAR; PG8_WAIT_L(0); PG8_MMA(0, 0, At, B0); PG8_BAR; PG8_SCHED;
            PG8_LDB(B1, 1, 1); PG8_STAGE(PG8_SB(1, 0), b3, voffB);
            PG8_BAR; PG8_WAIT_L(0); PG8_MMA(0, 1, At, B1); PG8_BAR;
            PG8_LDA(At, 1, 1); PG8_STAGE(PG8_SA(1, 0), a3, voffA);
            PG8_BAR; PG8_WAIT_L(0); PG8_MMA(1, 0, At, B0); PG8_BAR; PG8_SCHED;
            PG8_STAGE(PG8_SB(1, 1), b3 + hstep, voffB);
            PG8_WAIT_V(6); PG8_BAR; PG8_MMA(1, 1, At, B1); PG8_BAR;
            }
        }
        if constexpr (ALIGN_EPI) { if (wr == 0) PG8_BAR; }
        if constexpr (!Epi::AFTER_DRAIN) { E(acc, cur, wr, wc, fr, fq); S.done(cur); }
        if (!has_next) break;
#pragma unroll
        for (int a = 0; a < 2; ++a)
#pragma unroll
            for (int b = 0; b < 2; ++b)
#pragma unroll
                for (int m = 0; m < 4; ++m)
#pragma unroll
                    for (int n = 0; n < 2; ++n) acc[a][b][m][n] = (f32x4){0.f, 0.f, 0.f, 0.f};
        cur = nxt; cA = nA; cB = nB; ++ui;
        if constexpr (ALIGN_EPI) { if (wr == 1) PG8_BAR; }
    }
    PG8_WAIT_V(0);
    if constexpr (!ALIGN_EPI) { if (wr == 0) PG8_BAR; }
    PG8_BAR;
    if constexpr (Epi::AFTER_DRAIN) { E.fused(acc, cur, wr, wc, fr, fq, lds, wid, lane); S.done(cur); }
#undef PG8_SA
#undef PG8_SB
#undef PG8_STAGE
#undef PG8_LDA
#undef PG8_LDB
#undef PG8_MMA
#undef PG8_WAIT_V
#undef PG8_WAIT_L
#undef PG8_BAR
#undef PG8_SCHED
}
}
constexpr int NWAVES = 8;
constexpr int BATCH = 4, T = 4096, D = 1024, M = BATCH * T;
constexpr int PROJ_W = 2832, NP = 3072, FF = 2816, NGU = 2 * FF, HD = 64;
constexpr int C_GQ = 0, C_GK = 512, C_GV = 1024, C_GZ = 1536, C_SQ = 2048, C_SK = 2560, C_SV = 2688, C_GA = 2816, C_GB = 2824;
constexpr float EPS = 1e-6f;
constexpr size_t MiB = 1u << 20;
constexpr size_t WS_CTL = 0, CTL_ZERO_BYTES = 256 * 1024;
constexpr size_t WS_MODF = 1 * MiB;
constexpr size_t WS_DEC = 1 * MiB + 384 * 1024;
constexpr size_t WS_WIN = 4 * MiB, WS_WOUT = 10 * MiB, WS_WGU = 12 * MiB, WS_WDN = 24 * MiB;
constexpr size_t WS_H = 32 * MiB;
constexpr size_t WS_PQ = 64 * MiB;
constexpr size_t WS_MIX = 160 * MiB;
constexpr size_t WS_CHKA = 192 * MiB;
constexpr size_t WS_END = 256 * MiB;
constexpr int CW_BAR = 4096;
constexpr int CW_MODACC = 16384;
constexpr int RING_OFF = 0, RING_BYTES = 131072;
constexpr int LDS_BYTES = 163840;
constexpr int LDSCTL_OFF = LDS_BYTES - 1024, MISC_OFF = LDSCTL_OFF + 320;
#define GAS __attribute__((address_space(1)))
#define LAS __attribute__((address_space(3)))
typedef unsigned short bf16;
typedef unsigned v4u __attribute__((ext_vector_type(4)));
typedef float f32x4 __attribute__((ext_vector_type(4)));
typedef short bf16x8 __attribute__((ext_vector_type(8)));
typedef GAS unsigned gu32;
typedef GAS unsigned long long gu64;
#define RLX_AGENT __ATOMIC_RELAXED, __HIP_MEMORY_SCOPE_AGENT
#define LDS_WAIT() asm volatile("s_waitcnt lgkmcnt(0)" ::: "memory")
#define VM_WAIT() asm volatile("s_waitcnt vmcnt(0)" ::: "memory")
__device__ __forceinline__ unsigned long long rt() { return __builtin_amdgcn_s_memrealtime(); }
__device__ __forceinline__ unsigned f2bf(float f) { unsigned u = __builtin_bit_cast(unsigned, f); return (u + 0x7fffu + ((u >> 16) & 1u)) >> 16; }
__device__ __forceinline__ unsigned pk2(float lo, float hi) { return f2bf(lo) | (f2bf(hi) << 16); }

#define XB_TMO      128
#define XB_XCNT(j)  (256  + 64 * (j))
#define XB_XSUB(j)  (1280 + 64 * (j))
#define XB_XGEN(j)  (2304 + 64 * (j))
#define XB_TOP      3328
#define XB_TOPGEN   3392
#define XCD_BAR_WORDS 3456
#define XB_SPIN_CAP (1u << 22)

__device__ __forceinline__ unsigned xb_ld(unsigned* p)              { return __hip_atomic_load(p, __ATOMIC_RELAXED, __HIP_MEMORY_SCOPE_AGENT); }
__device__ __forceinline__ unsigned xb_add(unsigned* p, unsigned v) { return __hip_atomic_fetch_add(p, v, __ATOMIC_RELAXED, __HIP_MEMORY_SCOPE_AGENT); }
__device__ __forceinline__ unsigned xb_xcc_id() { return (unsigned)__builtin_amdgcn_s_getreg((3 << 11) | 20) & 0xFu; }
#define XB_SPIN(cond, bar) do { unsigned _sp = 0; while (cond) { __builtin_amdgcn_s_sleep(1); \
    if ((++_sp & 255u) == 0u) { if (xb_ld(&(bar)[XB_TMO])) break; if (_sp > XB_SPIN_CAP) { atomicAdd(&(bar)[XB_TMO], 1u); break; } } } } while (0)

struct XcdBarrier {
    unsigned* bar; unsigned x;
    volatile LAS unsigned* st;
};

__device__ __forceinline__ XcdBarrier xcd_barrier_post(unsigned* bar, volatile LAS unsigned* st) {
    XcdBarrier b; b.bar = bar; b.x = xb_xcc_id(); b.st = st;
    if (threadIdx.x == 0) (void)xb_add(&bar[XB_XCNT(b.x)], 1u);
    return b;
}
__device__ __forceinline__ void xcd_barrier_complete(unsigned* bar, unsigned x, unsigned& nloc, unsigned& nx) {
    const unsigned G = gridDim.x * gridDim.y * gridDim.z;
    unsigned sum, cnt, mine, sp = 0u;
    for (;;) {
        sum = 0u; cnt = 0u; mine = 0u;
#pragma unroll
        for (unsigned j = 0; j < 16; ++j) { const unsigned c = xb_ld(&bar[XB_XCNT(j)]); sum += c; cnt += (c > 0u) ? 1u : 0u; mine = (j == x) ? c : mine; }
        if (sum == G) break;
        __builtin_amdgcn_s_sleep(1);
        if ((++sp & 255u) == 0u) { if (xb_ld(&bar[XB_TMO])) break; if (sp > XB_SPIN_CAP) { atomicAdd(&bar[XB_TMO], 1u); break; } }
    }
    nloc = mine > 0u ? mine : 1u; nx = cnt > 0u ? cnt : 1u;
}

__device__ __forceinline__ void xcd_barrier(const XcdBarrier& b) {
    asm volatile("s_waitcnt vmcnt(0)" ::: "memory");
    __syncthreads();
    if (threadIdx.x == 0) {
        unsigned* bar = b.bar;
        __builtin_amdgcn_s_waitcnt(0);
        unsigned nloc = b.st[0], nx = b.st[1];
        if (nloc == 0u) { xcd_barrier_complete(bar, b.x, nloc, nx); b.st[0] = nloc; b.st[1] = nx; }
        const unsigned old = xb_add(&bar[XB_XSUB(b.x)], 1u);
        const unsigned gen = old / nloc;
        if (old + 1u == (gen + 1u) * nloc) {
            __builtin_amdgcn_fence(__ATOMIC_RELEASE, "agent");
            asm volatile("s_waitcnt vmcnt(0)" ::: "memory");
            const unsigned og = xb_add(&bar[XB_TOP], 1u);
            const unsigned tg = og / nx;
            if (og + 1u == (tg + 1u) * nx) xb_add(&bar[XB_TOPGEN], 1u);
            else XB_SPIN(xb_ld(&bar[XB_TOPGEN]) == tg, bar);
            __builtin_amdgcn_fence(__ATOMIC_ACQUIRE, "agent");
            xb_add(&bar[XB_XGEN(b.x)], 1u);
            asm volatile("s_waitcnt vmcnt(0)" ::: "memory");
        } else {
            XB_SPIN(xb_ld(&bar[XB_XGEN(b.x)]) == gen, bar);
            __builtin_amdgcn_fence(__ATOMIC_ACQUIRE, "agent");
            asm volatile("s_waitcnt vmcnt(0)" ::: "memory");
        }
    }
    __syncthreads();
}
struct Frame {
    LAS unsigned char* lds;
    volatile LAS unsigned* MISC;
    gu32* ctl;
    int tid, lane, wave;
    int vcu, G;
    const float *x, *c, *w_ada, *b_ada, *norm1_w, *w_in, *conv_w, *a_log, *dt_bias, *gdn_norm_w, *q_norm_w, *k_norm_w, *sinks, *w_out, *norm2_w, *w_gate, *w_up, *w_down;
    float* out;
    float *modacc, *modf, *dec;
    bf16 *Win_t, *Wout_t, *Wgu_t, *Wdn_t, *H, *PQ, *MIX, *X1B, *CHKA, *CHKU, *CHKT, *ORAW;
};
template <int CTRL, int ROWMASK, bool BC>
__device__ __forceinline__ float dpp_mov(float v) { return __int_as_float(__builtin_amdgcn_update_dpp(0, __float_as_int(v), CTRL, ROWMASK, 0xF, BC)); }
__device__ __forceinline__ float sum8(float v) { v += dpp_mov<0xB1, 0xF, true>(v); v += dpp_mov<0x4E, 0xF, true>(v); v += dpp_mov<0x141, 0xF, true>(v); return v; }
__device__ __forceinline__ float wave_sum(float v) {
    v = sum8(v); v += dpp_mov<0x140, 0xF, true>(v);
    v += dpp_mov<0x142, 0xA, false>(v); v += dpp_mov<0x143, 0xC, false>(v);
    return __int_as_float(__builtin_amdgcn_readlane(__float_as_int(v), 63));
}
__device__ __forceinline__ float fq_sum(float v) {
    auto r = __builtin_amdgcn_permlane16_swap(__float_as_uint(v), __float_as_uint(v), false, false); v = __uint_as_float(r[0]) + __uint_as_float(r[1]);
    auto s = __builtin_amdgcn_permlane32_swap(__float_as_uint(v), __float_as_uint(v), false, false); return __uint_as_float(s[0]) + __uint_as_float(s[1]);
}
__device__ __forceinline__ float fq_max(float v) {
    auto r = __builtin_amdgcn_permlane16_swap(__float_as_uint(v), __float_as_uint(v), false, false); v = fmaxf(__uint_as_float(r[0]), __uint_as_float(r[1]));
    auto s = __builtin_amdgcn_permlane32_swap(__float_as_uint(v), __float_as_uint(v), false, false); return fmaxf(__uint_as_float(s[0]), __uint_as_float(s[1]));
}
typedef float f32x2_t __attribute__((ext_vector_type(2))); typedef __bf16 bf16x2_t __attribute__((ext_vector_type(2)));
__device__ __forceinline__ unsigned cvtpk(float lo, float hi) { f32x2_t v = {lo, hi}; bf16x2_t b = __builtin_convertvector(v, bf16x2_t); return __builtin_bit_cast(unsigned, b); }
__device__ __forceinline__ float bf2f(bf16 h) { return __uint_as_float((unsigned)h << 16); }
__device__ __forceinline__ float ld_f32_coh(const float* p) { return __uint_as_float(__hip_atomic_load((const unsigned*)p, RLX_AGENT)); }
__device__ __forceinline__ float silu(float x) { return x * __builtin_amdgcn_rcpf(1.0f + __expf(-x)); }
__device__ __forceinline__ float rsq(float x) { return __builtin_amdgcn_rsqf(x); }

__device__ __forceinline__ void tr_item64(const float* W, int ldw, int src_col, bf16* WT, int K, int dst_row, int k0, LAS bf16* tl, int lane) {
    const int cg = lane & 15, rr = lane >> 4;
    f32x4 v[16];
#pragma unroll
    for (int i = 0; i < 16; ++i) v[i] = *(const GAS f32x4*)(W + (size_t)(k0 + 4 * i + rr) * ldw + src_col + 4 * cg);
#pragma unroll
    for (int i = 0; i < 16; ++i) *(LAS unsigned long long*)(tl + (4 * i + rr) * 68 + 4 * cg) = (unsigned long long)cvtpk(v[i].x, v[i].y) | ((unsigned long long)cvtpk(v[i].z, v[i].w) << 32);
    LDS_WAIT(); asm volatile("" ::: "memory");
#pragma unroll
    for (int ii = 0; ii < 8; ++ii) { const int p = lane + 64 * ii, n = p >> 3, kc = p & 7; const LAS bf16* s = tl + (8 * kc) * 68 + n;
        v4u o; o.x = (unsigned)s[0] | ((unsigned)s[68] << 16); o.y = (unsigned)s[2 * 68] | ((unsigned)s[3 * 68] << 16); o.z = (unsigned)s[4 * 68] | ((unsigned)s[5 * 68] << 16); o.w = (unsigned)s[6 * 68] | ((unsigned)s[7 * 68] << 16);
        *(GAS v4u*)(WT + (size_t)(dst_row + n) * K + k0 + 8 * kc) = o; }
    LDS_WAIT(); asm volatile("" ::: "memory");
}

__device__ __forceinline__ void p0_prologue(Frame& F) {
    LAS bf16* tl = (LAS bf16*)(F.lds + RING_OFF + F.wave * 16384);
    const int gw = F.vcu * NWAVES + F.wave, NGW = F.G * NWAVES, lane = F.lane;
    if ((int)blockIdx.x < 24 * 8) {
        const int ct = blockIdx.x % 24, kg = blockIdx.x / 24, col = ct * 256 + 4 * lane, k0 = kg * 128 + F.wave * 16;
        f32x4 w[16];
#pragma unroll
        for (int kk = 0; kk < 16; ++kk) w[kk] = *(const GAS f32x4*)(F.w_ada + (size_t)(k0 + kk) * (6 * D) + col);
        f32x4 acc[4];
#pragma unroll
        for (int b = 0; b < 4; ++b) acc[b] = (f32x4){0.f, 0.f, 0.f, 0.f};
#pragma unroll
        for (int kk = 0; kk < 16; ++kk)
#pragma unroll
            for (int b = 0; b < 4; ++b) acc[b] += silu(F.c[b * D + k0 + kk]) * w[kk];
        LAS f32x4* rd = (LAS f32x4*)(F.lds + RING_OFF + F.wave * 16384 + 12288);
#pragma unroll
        for (int b = 0; b < 4; ++b) rd[b * 64 + lane] = acc[b];
        __syncthreads();
#pragma unroll
        for (int j = 0; j < 2; ++j) { const int e = F.tid * 2 + j, bb = e >> 8, c = e & 255; float s = 0.f;
#pragma unroll
            for (int wv = 0; wv < 8; ++wv) s += ((const LAS float*)(F.lds + RING_OFF + wv * 16384 + 12288))[(bb * 64 + (c >> 2)) * 4 + (c & 3)];
            atomicAdd(F.modacc + bb * (6 * D) + ct * 256 + c, s); }
        __syncthreads();
    }
    constexpr int I_IN = 16 * (NP / 64), I_OUT = 16 * 16, I_GU = 16 * (NGU / 64), I_DN = (FF / 64) * 16;
    constexpr int NITEMS = I_IN + I_OUT + I_GU + I_DN;
    for (int it = gw; it < NITEMS; it += NGW) {
        int r = it;
        if (r < I_IN) { const int nb = r % (NP / 64), kb = r / (NP / 64), n0 = 64 * nb;
            tr_item64(F.w_in, PROJ_W, n0 < 2048 ? n0 : (n0 < 2816 ? n0 + 16 : (n0 == 2816 ? 2048 : 0)), F.Win_t, D, n0, 64 * kb, tl, lane); continue; }
        r -= I_IN;
        if (r < I_OUT) { const int nb = r % 16, kb = r / 16; tr_item64(F.w_out, D, 64 * nb, F.Wout_t, D, 64 * nb, 64 * kb, tl, lane); continue; }
        r -= I_OUT;
        if (r < I_GU) { const int nb = r % (NGU / 64), kb = r / (NGU / 64), n0 = 64 * nb, p = n0 >> 8, j = n0 & 255;
            if (j < 128) tr_item64(F.w_gate, FF, 128 * p + j, F.Wgu_t, D, n0, 64 * kb, tl, lane);
            else         tr_item64(F.w_up,   FF, 128 * p + j - 128, F.Wgu_t, D, n0, 64 * kb, tl, lane);
            continue; }
        r -= I_GU;
        { const int nb = r % 16, kb = r / 16; tr_item64(F.w_down, D, 64 * nb, F.Wdn_t, FF, 64 * nb, 64 * kb, tl, lane); }
    }
}

template <int WHICH> __device__ __forceinline__ void norm_phase(Frame& F) {
    const int gw = F.vcu * NWAVES + F.wave, NGW = F.G * NWAVES, lane = F.lane;
    if (WHICH == 1) {
        for (int idx = gw * 64 + lane; idx < 4 * 6 * D; idx += NGW * 64) F.modf[idx] = F.modacc[idx] + F.b_ada[idx % (6 * D)];
    }
    const float* nw = (WHICH == 1) ? F.norm1_w : F.norm2_w;
    constexpr int R = (WHICH == 1) ? 4 : 8;
    for (int m0 = gw * R; m0 < M; m0 += NGW * R) {
        const int b = m0 / T;
        f32x4 v[R][4];
#pragma unroll
        for (int r = 0; r < R; ++r) {
            if (WHICH == 1) { const GAS f32x4* xr = (const GAS f32x4*)(F.x + (size_t)(m0 + r) * D) + lane;
#pragma unroll
                for (int i = 0; i < 4; ++i) v[r][i] = xr[64 * i]; }
            else { const GAS unsigned long long* xr = (const GAS unsigned long long*)(F.X1B + (size_t)(m0 + r) * D) + lane;
#pragma unroll
                for (int i = 0; i < 4; ++i) { const unsigned long long bb = xr[64 * i]; const unsigned lo = (unsigned)bb, hi = (unsigned)(bb >> 32);
                    v[r][i] = (f32x4){__uint_as_float(lo << 16), __uint_as_float(lo & 0xffff0000u), __uint_as_float(hi << 16), __uint_as_float(hi & 0xffff0000u)}; } } }
        f32x4 gm[4], sh[4];
#pragma unroll
        for (int i = 0; i < 4; ++i) { const int c = 256 * i + 4 * lane; f32x4 sc, sf;
            if (WHICH == 1) { sf = *(const GAS f32x4*)(F.modacc + b * 6 * D + c) + *(const GAS f32x4*)(F.b_ada + c); sc = *(const GAS f32x4*)(F.modacc + b * 6 * D + D + c) + *(const GAS f32x4*)(F.b_ada + D + c); }
            else { sf = *(const GAS f32x4*)(F.modf + b * 6 * D + 3 * D + c); sc = *(const GAS f32x4*)(F.modf + b * 6 * D + 4 * D + c); }
            gm[i] = *(const GAS f32x4*)(nw + c) * (sc + 1.0f); sh[i] = sf; }
#pragma unroll
        for (int r = 0; r < R; ++r) {
            float ss = 0.f;
#pragma unroll
            for (int i = 0; i < 4; ++i) ss += (v[r][i].x * v[r][i].x + v[r][i].y * v[r][i].y) + (v[r][i].z * v[r][i].z + v[r][i].w * v[r][i].w);
            const float rstd = rsq(wave_sum(ss) * (1.0f / D) + EPS);
            GAS unsigned long long* o8 = (GAS unsigned long long*)(F.H + (size_t)(m0 + r) * D) + lane;
#pragma unroll
            for (int i = 0; i < 4; ++i) { const f32x4 a = v[r][i] * rstd * gm[i] + sh[i];
                o8[64 * i] = (unsigned long long)cvtpk(a[0], a[1]) | ((unsigned long long)cvtpk(a[2], a[3]) << 32); }
        }
    }
}

__device__ __forceinline__ float rdlane(float v, int l) { return __int_as_float(__builtin_amdgcn_readlane(__float_as_int(v), l)); }
__device__ __forceinline__ bf16x8 pack8(const f32x4 a, const f32x4 b) {
    v4u w; w.x = cvtpk(a[0], a[1]); w.y = cvtpk(a[2], a[3]); w.z = cvtpk(b[0], b[1]); w.w = cvtpk(b[2], b[3]); return __builtin_bit_cast(bf16x8, w); }
__device__ __forceinline__ bf16x8 tile_frag(const LAS bf16* tile, int t, int ks, int fr, int fq) {
    const LAS bf16* p = tile + (16 * t + fr) * 64 + 32 * ks + 4 * fq;
    const unsigned long long lo = *(const LAS unsigned long long*)p, hi = *(const LAS unsigned long long*)(p + 16);
    v4u v; v.x = (unsigned)lo; v.y = (unsigned)(lo >> 32); v.z = (unsigned)hi; v.w = (unsigned)(hi >> 32); return __builtin_bit_cast(bf16x8, v);
}
__device__ __forceinline__ unsigned long long pack4(float a, float b, float c, float d) { return (unsigned long long)cvtpk(a, b) | ((unsigned long long)cvtpk(c, d) << 32); }

typedef short s16x4 __attribute__((ext_vector_type(4)));
__device__ __forceinline__ s16x4 cvt4(const f32x4 v) { const unsigned lo = cvtpk(v[0], v[1]), hi = cvtpk(v[2], v[3]); typedef unsigned u32x2 __attribute__((ext_vector_type(2))); return __builtin_bit_cast(s16x4, (u32x2){lo, hi}); }
#define MFMA16(a, b, c) __builtin_amdgcn_mfma_f32_16x16x16bf16_1k((a), (b), (c), 0, 0, 0)
#define MFMA32(a, b, c) __builtin_amdgcn_mfma_f32_16x16x32_bf16((a), (b), (c), 0, 0, 0)

__device__ __forceinline__ void gdn_prep_chunk(Frame& F, int ci, LAS unsigned char* wl  ) {
    const int lane = F.lane, bh = ci >> 6, n = ci & 63, b = bh >> 3, hh = bh & 7, fr = lane & 15, fq = lane >> 4;
    const size_t m0 = (size_t)b * T + 64 * n;
    bf16* const cA = F.CHKA + (size_t)ci * 8192;
    bf16* const cT = F.CHKT + (size_t)ci * 8192;
    bf16* const cU = F.CHKU + (size_t)ci * 8192;
    LAS bf16* const R0 = (LAS bf16*)wl;
    LAS bf16* const R1 = (LAS bf16*)(wl + 9728);
#define GDN_RAW(dst, col0) do { _Pragma("unroll") for (int i_ = 0; i_ < 9; ++i_) { long row_ = (long)m0 - 3 + 8 * i_ + (lane >> 3); row_ = row_ < 0 ? 0 : (row_ > M - 1 ? M - 1 : row_); \
        __builtin_amdgcn_global_load_lds((const unsigned*)(F.PQ + (size_t)row_ * NP + (col0) + hh * 64 + (lane & 7) * 8), (LAS unsigned*)((dst) + i_ * 512), 16, 0, 0); } } while (0)
    GDN_RAW(R0, C_GQ); GDN_RAW(R1, C_GK);
    const f32x4 z4 = (f32x4){0.f, 0.f, 0.f, 0.f};
    float g, beta;
    {
        const float ga = bf2f(F.PQ[(m0 + lane) * NP + C_GA + hh]), gbv = bf2f(F.PQ[(m0 + lane) * NP + C_GB + hh]);
        const float xx = ga + F.dt_bias[hh]; g = -__expf(F.a_log[hh]) * (fmaxf(xx, 0.f) + log1pf(__expf(-fabsf(xx)))); beta = __builtin_amdgcn_rcpf(1.0f + __expf(-gbv));
    }
    float G = g;
#pragma unroll
    for (int o = 1; o < 64; o <<= 1) { const float t = __shfl_up(G, o); if (lane >= o) G += t; }
    const float eG = __expf(G), Glast = __shfl(G, 63), kdsc = __expf(Glast - G), beG = beta * eG;
    if (lane == 0) F.dec[ci] = __expf(Glast);
    asm volatile("s_waitcnt vmcnt(0)" ::: "memory");
    {
        const float a0 = F.conv_w[hh * 64 + lane], a1 = F.conv_w[1536 + hh * 64 + lane], a2 = F.conv_w[2 * 1536 + hh * 64 + lane], a3 = F.conv_w[3 * 1536 + hh * 64 + lane];
        const float b0 = F.conv_w[512 + hh * 64 + lane], b1 = F.conv_w[1536 + 512 + hh * 64 + lane], b2 = F.conv_w[2 * 1536 + 512 + hh * 64 + lane], b3 = F.conv_w[3 * 1536 + 512 + hh * 64 + lane];
        float x0 = 0.f, x1 = 0.f, x2 = 0.f, y0 = 0.f, y1 = 0.f, y2 = 0.f;
        if (n > 0) { x0 = bf2f(R0[lane]); x1 = bf2f(R0[64 + lane]); x2 = bf2f(R0[128 + lane]); y0 = bf2f(R1[lane]); y1 = bf2f(R1[64 + lane]); y2 = bf2f(R1[128 + lane]); }
#pragma unroll
        for (int c = 0; c < 64; ++c) {
            const float rq = bf2f(R0[(c + 3) * 64 + lane]), rk = bf2f(R1[(c + 3) * 64 + lane]);
            const float cq = silu(a0 * x0 + a1 * x1 + a2 * x2 + a3 * rq), ck = silu(b0 * y0 + b1 * y1 + b2 * y2 + b3 * rk);
            x0 = x1; x1 = x2; x2 = rq; y0 = y1; y1 = y2; y2 = rk;
            R0[c * 64 + lane] = (bf16)(cvtpk(cq, cq) & 0xffffu);
            R1[c * 64 + lane] = (bf16)(cvtpk(ck, ck) & 0xffffu);
            if ((c & 15) == 15) __builtin_amdgcn_sched_barrier(0);
        }
    }
    LDS_WAIT(); asm volatile("" ::: "memory"); __builtin_amdgcn_sched_barrier(0);
    bf16x8 kf[4][2], qf[4][2];
#pragma unroll
    for (int blk = 0; blk < 4; ++blk)
#pragma unroll
        for (int kk = 0; kk < 2; ++kk) { kf[blk][kk] = *(const LAS bf16x8*)(R1 + (16 * blk + fr) * 64 + 32 * kk + 8 * fq); qf[blk][kk] = *(const LAS bf16x8*)(R0 + (16 * blk + fr) * 64 + 32 * kk + 8 * fq); }
    float rqc[4], rkc[4];
#pragma unroll
    for (int t = 0; t < 4; ++t) { f32x4 dq = MFMA32(qf[t][0], qf[t][0], z4); dq = MFMA32(qf[t][1], qf[t][1], dq); f32x4 dk = MFMA32(kf[t][0], kf[t][0], z4); dk = MFMA32(kf[t][1], kf[t][1], dk);
        const int di = fr & 3; const bool on = (fq == (fr >> 2));
        const float vq = di == 0 ? dq[0] : di == 1 ? dq[1] : di == 2 ? dq[2] : dq[3], vk = di == 0 ? dk[0] : di == 1 ? dk[1] : di == 2 ? dk[2] : dk[3];
        rqc[t] = rsq(fq_sum(on ? vq : 0.f) + EPS); rkc[t] = rsq(fq_sum(on ? vk : 0.f) + EPS); }
    const float rk_tok = fq == 0 ? rkc[0] : fq == 1 ? rkc[1] : fq == 2 ? rkc[2] : rkc[3];
    const float beGn = beG * rk_tok, kdscn = kdsc * rk_tok;
    float Gcol[4], Bcol[4];
#pragma unroll
    for (int t = 0; t < 4; ++t) { Gcol[t] = __shfl(G, 16 * t + fr); Bcol[t] = __shfl(beta, 16 * t + fr) * rkc[t]; }
#pragma unroll
    for (int mt = 0; mt < 4; ++mt) { const float esc = __expf(Gcol[mt]) * 0.125f * rqc[mt];
#pragma unroll
        for (int ks = 0; ks < 2; ++ks) { const v4u q8 = __builtin_bit_cast(v4u, tile_frag(R0, mt, ks, fr, fq)); const unsigned w_[4] = {q8.x, q8.y, q8.z, q8.w}; v4u o_;
            o_.x = cvtpk(__uint_as_float(w_[0] << 16) * esc, __uint_as_float(w_[0] & 0xffff0000u) * esc); o_.y = cvtpk(__uint_as_float(w_[1] << 16) * esc, __uint_as_float(w_[1] & 0xffff0000u) * esc);
            o_.z = cvtpk(__uint_as_float(w_[2] << 16) * esc, __uint_as_float(w_[2] & 0xffff0000u) * esc); o_.w = cvtpk(__uint_as_float(w_[3] << 16) * esc, __uint_as_float(w_[3] & 0xffff0000u) * esc);
            *(GAS v4u*)(cT + ((mt * 2 + ks) * 64 + lane) * 8) = o_; } }
    LDS_WAIT(); asm volatile("" ::: "memory"); __builtin_amdgcn_sched_barrier(0);
#pragma unroll
    for (int ks = 0; ks < 2; ++ks) { float Grow[2][4], Krow[2][4];
#pragma unroll
        for (int h2 = 0; h2 < 2; ++h2)
#pragma unroll
            for (int i = 0; i < 4; ++i) { Grow[h2][i] = __shfl(G, 16 * (2 * ks + h2) + 4 * fq + i); Krow[h2][i] = __shfl(rk_tok, 16 * (2 * ks + h2) + 4 * fq + i); }
#pragma unroll
        for (int tc = 0; tc < 4; ++tc) {
            f32x4 v[2];
#pragma unroll
            for (int h2 = 0; h2 < 2; ++h2) { const int ts = 2 * ks + h2;
                if (ts <= tc) { f32x4 acc = MFMA32(kf[ts][0], qf[tc][0], z4); acc = MFMA32(kf[ts][1], qf[tc][1], acc);
#pragma unroll
                    for (int i = 0; i < 4; ++i) { const int cidx = 16 * tc + fr, sidx = 16 * ts + 4 * fq + i; v[h2][i] = (cidx >= sidx) ? acc[i] * __expf(Gcol[tc] - Grow[h2][i]) * (0.125f * rqc[tc]) * Krow[h2][i] : 0.f; }
                } else v[h2] = z4; }
            *(bf16x8*)(cT + 4096 + ((tc * 2 + ks) * 64 + lane) * 8) = pack8(v[0], v[1]);
        } }
#pragma unroll
    for (int ts = 0; ts < 4; ++ts) { float Grow[4], Krow[4];
#pragma unroll
        for (int i = 0; i < 4; ++i) { Grow[i] = __shfl(G, 16 * ts + 4 * fq + i); Krow[i] = __shfl(rk_tok, 16 * ts + 4 * fq + i); }
#pragma unroll
        for (int tc = 0; tc < 4; ++tc) { f32x4 a = z4;
            if (ts <= tc) { f32x4 acc = MFMA32(kf[ts][0], kf[tc][0], z4); acc = MFMA32(kf[ts][1], kf[tc][1], acc);
#pragma unroll
                for (int i = 0; i < 4; ++i) { const int cidx = 16 * tc + fr, sidx = 16 * ts + 4 * fq + i; a[i] = (cidx > sidx) ? Bcol[tc] * Krow[i] * acc[i] * __expf(Gcol[tc] - Grow[i]) : 0.f; } }
            *(LAS unsigned long long*)(R0 + (16 * tc + fr) * 64 + 16 * ts + 4 * fq) = pack4(a[0], a[1], a[2], a[3]); } }
    bf16x8 RkB[4][2], KDf[4][2];
#pragma unroll
    for (int ks = 0; ks < 2; ++ks) { float sB[8], sD[8];
#pragma unroll
        for (int j = 0; j < 8; ++j) { const int tok = 32 * ks + 16 * (j >> 2) + 4 * fq + (j & 3); sB[j] = __shfl(beGn, tok); sD[j] = __shfl(kdscn, tok); }
#pragma unroll
        for (int t = 0; t < 4; ++t) { float kv[8];
#pragma unroll
            for (int j = 0; j < 8; ++j) kv[j] = bf2f(R1[(32 * ks + 16 * (j >> 2) + 4 * fq + (j & 3)) * 64 + 16 * t + fr]);
            v4u a_, d_;
            a_.x = cvtpk(kv[0] * sB[0], kv[1] * sB[1]); a_.y = cvtpk(kv[2] * sB[2], kv[3] * sB[3]); a_.z = cvtpk(kv[4] * sB[4], kv[5] * sB[5]); a_.w = cvtpk(kv[6] * sB[6], kv[7] * sB[7]);
            d_.x = cvtpk(kv[0] * sD[0], kv[1] * sD[1]); d_.y = cvtpk(kv[2] * sD[2], kv[3] * sD[3]); d_.z = cvtpk(kv[4] * sD[4], kv[5] * sD[5]); d_.w = cvtpk(kv[6] * sD[6], kv[7] * sD[7]);
            RkB[t][ks] = __builtin_bit_cast(bf16x8, a_); KDf[t][ks] = __builtin_bit_cast(bf16x8, d_); } }
    LDS_WAIT(); asm volatile("" ::: "memory"); __builtin_amdgcn_sched_barrier(0);
    {
        float X[16];
#pragma unroll
        for (int r = 0; r < 16; ++r) X[r] = (r == fr) ? 1.f : 0.f;
        const LAS bf16* ab = R0 + (16 * fq) * 64 + 16 * fq;
#pragma unroll
        for (int s = 0; s < 15; ++s) {
#pragma unroll
            for (int r = s + 1; r < 16; ++r) X[r] -= bf2f(ab[r * 64 + s]) * X[s];
            if ((s & 3) == 3) __builtin_amdgcn_sched_barrier(0);
        }
        LDS_WAIT(); asm volatile("" ::: "memory"); __builtin_amdgcn_sched_barrier(0);
#pragma unroll
        for (int r = 0; r < 16; ++r) R0[(16 * fq + r) * 64 + 16 * fq + fr] = (bf16)(cvtpk(X[r], X[r]) & 0xffffu);
    }
    LDS_WAIT(); asm volatile("" ::: "memory"); __builtin_amdgcn_sched_barrier(0);
    {
#define A16(i, k) (*(const LAS s16x4*)(R0 + (16 * (i) + fr) * 64 + 16 * (k) + 4 * fq))
        s16x4 Td[4];
#pragma unroll
        for (int j = 0; j < 3; ++j) { const LAS bf16* p = R0 + (16 * j + 4 * fq) * 64 + 16 * j + fr; typedef unsigned u32x2 __attribute__((ext_vector_type(2)));
            Td[j] = __builtin_bit_cast(s16x4, (u32x2){(unsigned)p[0] | ((unsigned)p[64] << 16), (unsigned)p[128] | ((unsigned)p[192] << 16)}); }
        f32x4 m10 = MFMA16(A16(1, 0), Td[0], z4);
        const f32x4 t10 = -MFMA16(A16(1, 1), cvt4(m10), z4);
        f32x4 m21 = MFMA16(A16(2, 1), Td[1], z4);
        f32x4 m20 = MFMA16(A16(2, 0), Td[0], z4); m20 = MFMA16(A16(2, 1), cvt4(t10), m20);
        const s16x4 a22 = A16(2, 2);
        const f32x4 t21 = -MFMA16(a22, cvt4(m21), z4), t20 = -MFMA16(a22, cvt4(m20), z4);
        f32x4 m32 = MFMA16(A16(3, 2), Td[2], z4);
        f32x4 m31 = MFMA16(A16(3, 1), Td[1], z4); m31 = MFMA16(A16(3, 2), cvt4(t21), m31);
        f32x4 m30 = MFMA16(A16(3, 0), Td[0], z4); m30 = MFMA16(A16(3, 1), cvt4(t10), m30); m30 = MFMA16(A16(3, 2), cvt4(t20), m30);
        const s16x4 a33 = A16(3, 3);
        const f32x4 t32 = -MFMA16(a33, cvt4(m32), z4), t31 = -MFMA16(a33, cvt4(m31), z4), t30 = -MFMA16(a33, cvt4(m30), z4);
        LDS_WAIT(); asm volatile("" ::: "memory"); __builtin_amdgcn_sched_barrier(0);
#define TST(i, j, t) do { _Pragma("unroll") for (int r_ = 0; r_ < 4; ++r_) R0[(16 * (i) + 4 * fq + r_) * 64 + 16 * (j) + fr] = (bf16)(cvtpk((t)[r_], (t)[r_]) & 0xffffu); } while (0)
        TST(1, 0, t10); TST(2, 0, t20); TST(2, 1, t21); TST(3, 0, t30); TST(3, 1, t31); TST(3, 2, t32);
#undef TST
#undef A16
    }
    LDS_WAIT(); asm volatile("" ::: "memory"); __builtin_amdgcn_sched_barrier(0);
#pragma unroll
    for (int ct = 0; ct < 4; ++ct) { const bf16x8 ta0 = tile_frag(R0, ct, 0, fr, fq), ta1 = tile_frag(R0, ct, 1, fr, fq);
#pragma unroll
        for (int dt = 0; dt < 4; ++dt) { f32x4 acc = MFMA32(ta0, RkB[dt][0], z4); if (ct >= 2) acc = MFMA32(ta1, RkB[dt][1], acc);
            *(LAS unsigned long long*)(R1 + (16 * dt + fr) * 64 + 16 * ct + 4 * fq) = pack4(acc[0], acc[1], acc[2], acc[3]); } }
    LDS_WAIT(); asm volatile("" ::: "memory");
    asm volatile("s_waitcnt vmcnt(0)" ::: "memory");
    v4u qdf[8]; bf16x8 qkf[8];
#pragma unroll
    for (int f = 0; f < 8; ++f) { qdf[f] = *(const GAS v4u*)(cT + (f * 64 + lane) * 8); qkf[f] = *(const GAS bf16x8*)(cT + 4096 + (f * 64 + lane) * 8); }
    bf16x8 waf[4][2];
#pragma unroll
    for (int tm = 0; tm < 4; ++tm) { waf[tm][0] = tile_frag(R1, tm, 0, fr, fq); waf[tm][1] = tile_frag(R1, tm, 1, fr, fq); }
    LDS_WAIT(); asm volatile("" ::: "memory");
    GDN_RAW(R1, C_GV);
#pragma unroll
    for (int tn = 0; tn < 4; ++tn) {
#pragma unroll
        for (int ks2 = 0; ks2 < 2; ++ks2) {
            const v4u qd8 = qdf[tn * 2 + ks2]; const unsigned qw_[4] = {qd8.x, qd8.y, qd8.z, qd8.w};
            f32x4 pp[2], q2[2];
#pragma unroll
            for (int h2 = 0; h2 < 2; ++h2) { const int tm = 2 * ks2 + h2;
                f32x4 a1 = MFMA32(waf[tm][0], KDf[tn][0], z4); a1 = MFMA32(waf[tm][1], KDf[tn][1], a1);
                f32x4 a2 = MFMA32(waf[tm][0], qkf[tn * 2], z4); a2 = MFMA32(waf[tm][1], qkf[tn * 2 + 1], a2);
                pp[h2] = -a1;
                q2[h2] = (f32x4){__uint_as_float(qw_[2 * h2] << 16), __uint_as_float(qw_[2 * h2] & 0xffff0000u), __uint_as_float(qw_[2 * h2 + 1] << 16), __uint_as_float(qw_[2 * h2 + 1] & 0xffff0000u)} - a2; }
            *(GAS bf16x8*)(cA + ((tn * 2 + ks2) * 64 + lane) * 8) = pack8(pp[0], pp[1]);
            *(GAS bf16x8*)(cA + 4096 + ((tn * 2 + ks2) * 64 + lane) * 8) = pack8(q2[0], q2[1]);
        }
    }
    asm volatile("s_waitcnt vmcnt(0)" ::: "memory");
    {
        const float w0 = F.conv_w[1024 + hh * 64 + lane], w1 = F.conv_w[1536 + 1024 + hh * 64 + lane], w2 = F.conv_w[2 * 1536 + 1024 + hh * 64 + lane], w3 = F.conv_w[3 * 1536 + 1024 + hh * 64 + lane];
        float x0 = 0.f, x1 = 0.f, x2 = 0.f;
        if (n > 0) { x0 = bf2f(R1[lane]); x1 = bf2f(R1[64 + lane]); x2 = bf2f(R1[128 + lane]); }
#pragma unroll
        for (int c = 0; c < 64; ++c) {
            const float r = bf2f(R1[(c + 3) * 64 + lane]);
            const float cv = silu(w0 * x0 + w1 * x1 + w2 * x2 + w3 * r); x0 = x1; x1 = x2; x2 = r;
            R1[c * 64 + lane] = (bf16)(cvtpk(cv, cv) & 0xffffu);
            if ((c & 15) == 15) __builtin_amdgcn_sched_barrier(0);
        }
    }
    LDS_WAIT(); asm volatile("" ::: "memory"); __builtin_amdgcn_sched_barrier(0);
    bf16x8 RvB[4][2];
#pragma unroll
    for (int ks = 0; ks < 2; ++ks) { float sB[8];
#pragma unroll
        for (int j = 0; j < 8; ++j) sB[j] = __shfl(beta, 32 * ks + 16 * (j >> 2) + 4 * fq + (j & 3));
#pragma unroll
        for (int t = 0; t < 4; ++t) { float vv[8];
#pragma unroll
            for (int j = 0; j < 8; ++j) vv[j] = bf2f(R1[(32 * ks + 16 * (j >> 2) + 4 * fq + (j & 3)) * 64 + 16 * t + fr]) * sB[j];
            v4u a_; a_.x = cvtpk(vv[0], vv[1]); a_.y = cvtpk(vv[2], vv[3]); a_.z = cvtpk(vv[4], vv[5]); a_.w = cvtpk(vv[6], vv[7]);
            RvB[t][ks] = __builtin_bit_cast(bf16x8, a_); } }
    LDS_WAIT(); asm volatile("" ::: "memory"); __builtin_amdgcn_sched_barrier(0);
#pragma unroll
    for (int ct = 0; ct < 4; ++ct) { const bf16x8 ta0 = tile_frag(R0, ct, 0, fr, fq), ta1 = tile_frag(R0, ct, 1, fr, fq);
#pragma unroll
        for (int et = 0; et < 4; ++et) { f32x4 acc = MFMA32(ta0, RvB[et][0], z4); if (ct >= 2) acc = MFMA32(ta1, RvB[et][1], acc);
            *(LAS unsigned long long*)(R1 + (16 * et + fr) * 64 + 16 * ct + 4 * fq) = pack4(acc[0], acc[1], acc[2], acc[3]); } }
    LDS_WAIT(); asm volatile("" ::: "memory"); __builtin_amdgcn_sched_barrier(0);
#pragma unroll
    for (int et = 0; et < 4; ++et) {
        const bf16x8 ub0 = tile_frag(R1, et, 0, fr, fq), ub1 = tile_frag(R1, et, 1, fr, fq);
#pragma unroll
        for (int tm = 0; tm < 4; ++tm) {
            const bf16x8 qa0 = qkf[tm * 2], qa1 = qkf[tm * 2 + 1];
            f32x4 r = MFMA32(KDf[tm][0], ub0, z4); r = MFMA32(KDf[tm][1], ub1, r);
            f32x4 o = MFMA32(qa0, ub0, z4); o = MFMA32(qa1, ub1, o);
            *(GAS unsigned long long*)(cU + ((et * 4 + tm) * 64 + lane) * 4) = pack4(r[0], r[1], r[2], r[3]);
            *(GAS unsigned long long*)(cU + 4096 + ((et * 4 + tm) * 64 + lane) * 4) = pack4(o[0], o[1], o[2], o[3]);
        }
    }
    LDS_WAIT(); asm volatile("" ::: "memory"); __builtin_amdgcn_sched_barrier(0);
}
#undef MFMA16
#undef MFMA32
#undef GDN_RAW

#define GDN_BAR() do { asm volatile("" ::: "memory"); __builtin_amdgcn_s_barrier(); asm volatile("" ::: "memory"); } while (0)
__device__ __forceinline__ void gdn_scan(Frame& F, int bh) {
    const int lane = F.lane, wave = F.wave, b = bh >> 3, hh = bh & 7, fr = lane & 15, fq = lane >> 4;
    LAS unsigned char* const ring = F.lds + RING_OFF;
    constexpr int SLOT = 32768, OB0 = 131072, OB1 = 139264;
    const unsigned char* gA = (const unsigned char*)(F.CHKA + (size_t)bh * 64 * 8192);
    const unsigned char* gU = (const unsigned char*)(F.CHKU + (size_t)bh * 64 * 8192);
    if (wave >= 4) {
        const int hw = wave - 4, nt = hw * 64 + lane;
        bf16* mp = F.ORAW + ((size_t)b * T + (nt >> 3)) * 512 + hh * 64 + (nt & 7) * 8;
#define GDN_ISSUE(nn) do { const int n_ = (nn); const int sl_ = n_ & 3; _Pragma("unroll") for (int i_ = 0; i_ < 8; ++i_) { const int p_ = hw * 8 + i_; \
            const unsigned char* s_ = (p_ < 16) ? gA + (size_t)n_ * 16384 + p_ * 1024 : gU + (size_t)n_ * 16384 + (p_ - 16) * 1024; \
            __builtin_amdgcn_global_load_lds((const unsigned*)(s_ + lane * 16), (LAS unsigned*)(ring + sl_ * SLOT + p_ * 1024), 16, 0, 0); } } while (0)
#define GDN_COPY(nn) do { const LAS unsigned char* ob_ = ring + (((nn) & 1) ? OB1 : OB0); _Pragma("unroll") for (int k_ = 0; k_ < 2; ++k_) \
            *(GAS v4u*)(mp + (size_t)(64 * (nn) + 32 * k_) * 512) = *(const LAS v4u*)(ob_ + (nt + 256 * k_) * 16); } while (0)
        GDN_ISSUE(0); GDN_ISSUE(1); GDN_ISSUE(2);
        asm volatile("s_waitcnt vmcnt(16)" ::: "memory"); GDN_BAR();
        for (int n = 0; n < 64; ++n) {
            if (n + 3 < 64) { GDN_ISSUE(n + 3); asm volatile("s_waitcnt vmcnt(16)" ::: "memory"); } else asm volatile("s_waitcnt vmcnt(0)" ::: "memory");
            if (n > 0) GDN_COPY(n - 1);
            LDS_WAIT(); GDN_BAR();
        }
        GDN_COPY(63);
#undef GDN_ISSUE
#undef GDN_COPY
    } else {
        const int ew = wave;
        f32x4 Sacc[4];
#pragma unroll
        for (int t = 0; t < 4; ++t) Sacc[t] = (f32x4){0.f, 0.f, 0.f, 0.f};
        const float decs = ld_f32_coh(F.dec + bh * 64 + lane);
        GDN_BAR();
        for (int n = 0; n < 64; ++n) {
            const LAS unsigned char* sl = ring + (n & 3) * SLOT;
            LAS bf16* ob = (LAS bf16*)(ring + ((n & 1) ? OB1 : OB0)) + (4 * fq) * 64 + 16 * ew + fr;
            const float dec = __int_as_float(__builtin_amdgcn_readlane(__float_as_int(decs), n));
            unsigned long long rf[4], of[4]; bf16x8 pf[8], qf[8];
#pragma unroll
            for (int t = 0; t < 4; ++t) { rf[t] = *(const LAS unsigned long long*)(sl + 16384 + ((ew * 4 + t) * 64 + lane) * 8); of[t] = *(const LAS unsigned long long*)(sl + 24576 + ((ew * 4 + t) * 64 + lane) * 8); }
#pragma unroll
            for (int f = 0; f < 8; ++f) { pf[f] = *(const LAS bf16x8*)(sl + (f * 64 + lane) * 16); qf[f] = *(const LAS bf16x8*)(sl + 8192 + (f * 64 + lane) * 16); }
            __builtin_amdgcn_sched_barrier(0);
            bf16x8 Sb[2]; Sb[0] = pack8(Sacc[0], Sacc[1]); Sb[1] = pack8(Sacc[2], Sacc[3]);
            f32x4 O[4];
#pragma unroll
            for (int t = 0; t < 4; ++t) { const unsigned rl = (unsigned)rf[t], rh = (unsigned)(rf[t] >> 32), ol = (unsigned)of[t], oh = (unsigned)(of[t] >> 32);
                Sacc[t] = Sacc[t] * dec + (f32x4){__uint_as_float(rl << 16), __uint_as_float(rl & 0xffff0000u), __uint_as_float(rh << 16), __uint_as_float(rh & 0xffff0000u)};
                O[t] = (f32x4){__uint_as_float(ol << 16), __uint_as_float(ol & 0xffff0000u), __uint_as_float(oh << 16), __uint_as_float(oh & 0xffff0000u)}; }
#pragma unroll
            for (int t = 0; t < 4; ++t)
#pragma unroll
                for (int ks = 0; ks < 2; ++ks) { const int f = t * 2 + ks;
                    Sacc[t] = __builtin_amdgcn_mfma_f32_16x16x32_bf16(pf[f], Sb[ks], Sacc[t], 0, 0, 0); O[t] = __builtin_amdgcn_mfma_f32_16x16x32_bf16(qf[f], Sb[ks], O[t], 0, 0, 0); }
#pragma unroll
            for (int t = 0; t < 4; ++t)
#pragma unroll
                for (int i = 0; i < 4; ++i) ob[(16 * t + i) * 64] = (bf16)(cvtpk(O[t][i], O[t][i]) & 0xffffu);
            LDS_WAIT(); GDN_BAR();
        }
    }
}
__device__ __forceinline__ void gdn_norm_rows(Frame& F, int r0) {
    const int oc = F.tid & 7, hd = (F.tid >> 3) & 7;
    float nw[8];
#pragma unroll
    for (int j = 0; j < 8; ++j) nw[j] = F.gdn_norm_w[oc * 8 + j];
#pragma unroll 1
    for (int it = 0; it < 4; ++it) {
        v4u ov[8], zv[8];
#pragma unroll
        for (int k = 0; k < 8; ++k) { const size_t row = (size_t)r0 + (it * 8 + k) * 8 + (F.tid >> 6); ov[k] = *(const GAS v4u*)(F.ORAW + row * 512 + hd * 64 + oc * 8); zv[k] = *(const GAS v4u*)(F.PQ + row * NP + C_GZ + hd * 64 + oc * 8); }
#pragma unroll
        for (int k = 0; k < 8; ++k) { const size_t row = (size_t)r0 + (it * 8 + k) * 8 + (F.tid >> 6);
            const unsigned ow[4] = {ov[k].x, ov[k].y, ov[k].z, ov[k].w}, zw[4] = {zv[k].x, zv[k].y, zv[k].z, zv[k].w};
            float o[8], z[8]; float ss = 0.f;
#pragma unroll
            for (int w = 0; w < 4; ++w) { o[2 * w] = __uint_as_float(ow[w] << 16); o[2 * w + 1] = __uint_as_float(ow[w] & 0xffff0000u); z[2 * w] = __uint_as_float(zw[w] << 16); z[2 * w + 1] = __uint_as_float(zw[w] & 0xffff0000u);
                ss += o[2 * w] * o[2 * w] + o[2 * w + 1] * o[2 * w + 1]; }
            ss = sum8(ss);
            const float rs = rsq(ss * (1.0f / 64.0f) + EPS);
            v4u w4; w4.x = cvtpk(o[0] * rs * nw[0] * z[0], o[1] * rs * nw[1] * z[1]); w4.y = cvtpk(o[2] * rs * nw[2] * z[2], o[3] * rs * nw[3] * z[3]);
            w4.z = cvtpk(o[4] * rs * nw[4] * z[4], o[5] * rs * nw[5] * z[5]); w4.w = cvtpk(o[6] * rs * nw[6] * z[6], o[7] * rs * nw[7] * z[7]);
            *(GAS v4u*)(F.MIX + row * D + hd * 64 + oc * 8) = w4; }
    }
    asm volatile("s_waitcnt vmcnt(0)" ::: "memory"); __syncthreads();
}
__device__ __forceinline__ void swa_unit(Frame& F, int unit, LAS unsigned char* L) {
    const int tid = F.tid, lane = F.lane, wave = F.wave, fr = lane & 15, fq = lane >> 4;
    const int blk = unit & 63, kvh = (unit >> 6) & 1, b = unit >> 7, t0 = blk * 64;
    const size_t row0 = (size_t)b * T;
    LAS bf16* const Ks = (LAS bf16*)L; LAS bf16* const Vt = (LAS bf16*)(L + 27648);
    for (int p = tid; p < 1536; p += NWAVES * 64) {
        const int key = p >> 3, oc = p & 7, s = t0 - 128 + key;
        v4u kv = (v4u){0u, 0u, 0u, 0u}, vv = (v4u){0u, 0u, 0u, 0u};
        if (s >= 0) { kv = *(const GAS v4u*)(F.PQ + (row0 + s) * NP + C_SK + kvh * 64 + oc * 8); vv = *(const GAS v4u*)(F.PQ + (row0 + s) * NP + C_SV + kvh * 64 + oc * 8); }
        const unsigned kw[4] = {kv.x, kv.y, kv.z, kv.w}, vw[4] = {vv.x, vv.y, vv.z, vv.w};
        float k[8]; float ss = 0.f;
#pragma unroll
        for (int w = 0; w < 4; ++w) { k[2 * w] = __uint_as_float(kw[w] << 16); k[2 * w + 1] = __uint_as_float(kw[w] & 0xffff0000u); ss += k[2 * w] * k[2 * w] + k[2 * w + 1] * k[2 * w + 1]; }
        ss = sum8(ss);
        const float rstd = rsq(ss * (1.0f / 64.0f) + EPS);
#pragma unroll
        for (int j = 0; j < 8; ++j) k[j] = k[j] * rstd * F.k_norm_w[oc * 8 + j];
        v4u o; o.x = cvtpk(k[0], k[1]); o.y = cvtpk(k[2], k[3]); o.z = cvtpk(k[4], k[5]); o.w = cvtpk(k[6], k[7]);
        *(LAS v4u*)(Ks + key * 72 + oc * 8) = o;
#pragma unroll
        for (int w = 0; w < 4; ++w) { Vt[(oc * 8 + 2 * w) * 196 + key] = (bf16)(vw[w] & 0xffffu); Vt[(oc * 8 + 2 * w + 1) * 196 + key] = (bf16)(vw[w] >> 16); }
    }
    __syncthreads();
    const int hq = kvh * 4 + (wave >> 1);
    const float slope = exp2f(-(float)(hq + 1)), sink = F.sinks[hq];
#pragma unroll 1
    for (int qt = 0; qt < 2; ++qt) {
        const int tq0 = t0 + 32 * (wave & 1) + 16 * qt;
        bf16x8 qf[2];
        {
            const bf16* qp = F.PQ + (row0 + tq0 + fr) * NP + C_SQ + hq * 64 + 8 * fq;
            const v4u r0 = *(const GAS v4u*)qp, r1 = *(const GAS v4u*)(qp + 32);
            const unsigned qw[8] = {r0.x, r0.y, r0.z, r0.w, r1.x, r1.y, r1.z, r1.w};
            float q[16]; float ss = 0.f;
#pragma unroll
            for (int w = 0; w < 8; ++w) { q[2 * w] = __uint_as_float(qw[w] << 16); q[2 * w + 1] = __uint_as_float(qw[w] & 0xffff0000u); ss += q[2 * w] * q[2 * w] + q[2 * w + 1] * q[2 * w + 1]; }
            ss = fq_sum(ss);
            const float rstd = 0.125f * rsq(ss * (1.0f / 64.0f) + EPS);
#pragma unroll
            for (int kk = 0; kk < 2; ++kk) { float z[8];
#pragma unroll
                for (int j = 0; j < 8; ++j) z[j] = q[8 * kk + j] * rstd * F.q_norm_w[32 * kk + 8 * fq + j];
                v4u o; o.x = cvtpk(z[0], z[1]); o.y = cvtpk(z[2], z[3]); o.z = cvtpk(z[4], z[5]); o.w = cvtpk(z[6], z[7]); qf[kk] = __builtin_bit_cast(bf16x8, o); }
        }
        f32x4 sc[12]; float mx = -INFINITY;
#pragma unroll
        for (int nt = 0; nt < 12; ++nt) { f32x4 acc = (f32x4){0.f, 0.f, 0.f, 0.f};
#pragma unroll
            for (int kk = 0; kk < 2; ++kk) { const bf16x8 kf = *(const LAS bf16x8*)(Ks + (16 * nt + fr) * 72 + 32 * kk + 8 * fq); acc = __builtin_amdgcn_mfma_f32_16x16x32_bf16(kf, qf[kk], acc, 0, 0, 0); }
#pragma unroll
            for (int i = 0; i < 4; ++i) { const int s = t0 - 128 + 16 * nt + 4 * fq + i, dist = tq0 + fr - s; const bool ok = (s >= 0) && (dist >= 0) && (dist < 128);
                const float v = ok ? acc[i] - slope * (float)dist : -INFINITY; acc[i] = v; mx = fmaxf(mx, v); }
            sc[nt] = acc; if (nt & 1) __builtin_amdgcn_sched_barrier(0); }
        mx = fmaxf(fq_max(mx), sink);
        float sum = 0.f;
#pragma unroll
        for (int nt = 0; nt < 12; ++nt)
#pragma unroll
            for (int i = 0; i < 4; ++i) { const float p = __expf(sc[nt][i] - mx); sc[nt][i] = p; sum += p; }
        sum = fq_sum(sum);
        const float den = sum + __expf(sink - mx);
        bf16x8 pf[6];
#pragma unroll
        for (int ks = 0; ks < 6; ++ks) pf[ks] = pack8(sc[2 * ks], sc[2 * ks + 1]);
        float rden[4];
#pragma unroll
        for (int i = 0; i < 4; ++i) rden[i] = __builtin_amdgcn_rcpf(__shfl(den, 4 * fq + i));
        bf16* op = F.MIX + (row0 + tq0 + 4 * fq) * D + 512 + hq * 64 + fr;
#pragma unroll 1
        for (int dt = 0; dt < 4; ++dt) { f32x4 oacc = (f32x4){0.f, 0.f, 0.f, 0.f};
#pragma unroll
            for (int ks = 0; ks < 6; ++ks) { const LAS bf16* vp = Vt + (16 * dt + fr) * 196 + 32 * ks + 4 * fq;
                const unsigned long long lo = *(const LAS unsigned long long*)vp, hi = *(const LAS unsigned long long*)(vp + 16);
                v4u vv; vv.x = (unsigned)lo; vv.y = (unsigned)(lo >> 32); vv.z = (unsigned)hi; vv.w = (unsigned)(hi >> 32);
                oacc = __builtin_amdgcn_mfma_f32_16x16x32_bf16(pf[ks], __builtin_bit_cast(bf16x8, vv), oacc, 0, 0, 0); }
#pragma unroll
            for (int i = 0; i < 4; ++i) op[(size_t)i * D + 16 * dt] = (bf16)f2bf(oacc[i] * rden[i]); }
    }
    __syncthreads();
}
__device__ __forceinline__ void p3a_prep(Frame& F) {
    LAS unsigned char* wl = F.lds + RING_OFF + F.wave * 19456;
    const int gw = F.vcu * NWAVES + F.wave, NGW = F.G * NWAVES;
    for (int ci = gw; ci < BATCH * 8 * (T / 64); ci += NGW) gdn_prep_chunk(F, ci, wl);
}
__device__ __forceinline__ void p3b_mixers(Frame& F) {
    const int bx = blockIdx.x;
    if (bx < 32) gdn_scan(F, bx);
    else for (int u = bx - 32; u < BATCH * 2 * (T / 64); u += F.G - 32) swa_unit(F, u, F.lds + RING_OFF);
}

struct Args { const float* in[18]; float* out; unsigned char* ws; };
__global__ void __launch_bounds__(NWAVES * 64, 2) hymba_fwd(Args args) {
    extern __shared__ __attribute__((aligned(16))) unsigned char lds[];
    Frame F;
    F.lds = (LAS unsigned char*)lds;
    F.MISC = (volatile LAS unsigned*)(F.lds + MISC_OFF);
    F.tid = threadIdx.x; F.lane = F.tid & 63; F.wave = __builtin_amdgcn_readfirstlane(F.tid >> 6);
    F.G = gridDim.x; { const int bx = blockIdx.x; F.vcu = (F.G % 8 == 0) ? (bx % 8) * (F.G / 8) + bx / 8 : bx; }
    unsigned char* ws = args.ws;
    F.ctl = (gu32*)(ws + WS_CTL);
    F.x = args.in[0]; F.c = args.in[1]; F.w_ada = args.in[2]; F.b_ada = args.in[3]; F.norm1_w = args.in[4]; F.w_in = args.in[5]; F.conv_w = args.in[6];
    F.a_log = args.in[7]; F.dt_bias = args.in[8]; F.gdn_norm_w = args.in[9]; F.q_norm_w = args.in[10]; F.k_norm_w = args.in[11]; F.sinks = args.in[12];
    F.w_out = args.in[13]; F.norm2_w = args.in[14]; F.w_gate = args.in[15]; F.w_up = args.in[16]; F.w_down = args.in[17]; F.out = args.out;
    F.modacc = (float*)(ws + WS_CTL) + CW_MODACC; F.modf = (float*)(ws + WS_MODF);
    F.Win_t = (bf16*)(ws + WS_WIN); F.Wout_t = (bf16*)(ws + WS_WOUT); F.Wgu_t = (bf16*)(ws + WS_WGU); F.Wdn_t = (bf16*)(ws + WS_WDN);
    F.H = (bf16*)(ws + WS_H); F.PQ = (bf16*)(ws + WS_PQ); F.MIX = (bf16*)(ws + WS_MIX); F.CHKA = (bf16*)(ws + WS_CHKA); F.CHKU = (bf16*)(ws + WS_H); F.X1B = (bf16*)(ws + WS_CHKA); F.CHKT = (bf16*)(ws + WS_CHKA + 32 * MiB); F.ORAW = (bf16*)(ws + WS_CHKA + 32 * MiB); F.dec = (float*)(ws + WS_DEC);
    for (int u = F.tid; u < (LDS_BYTES - LDSCTL_OFF) / 4; u += NWAVES * 64) ((LAS unsigned*)(F.lds + LDSCTL_OFF))[u] = 0u;
    __syncthreads();
    XcdBarrier bar = xcd_barrier_post((unsigned*)(F.ctl + CW_BAR), F.MISC + 8);
#define GRID_BAR() do { xcd_barrier(bar); int t_ = F.tid; asm volatile("" : "+v"(t_)); F.tid = t_; F.lane = t_ & 63; } while (0)

    p0_prologue(F); GRID_BAR();
    norm_phase<1>(F); GRID_BAR();
    { pg8::Gemm g{F.H, F.Win_t, M, NP, D}; pg8::StaticOrder S; S.init(M, NP, F.G, (int)blockIdx.x);
      pg8::EpiBf16Plain E{F.PQ, NP, C_GZ / 256, C_SQ / 256};
      pg8::gemm_phase<pg8::EpiBf16Plain, pg8::StaticOrder, true, true>(F.lds + RING_OFF, g, S, E); }
    GRID_BAR();
    p3a_prep(F); GRID_BAR();
    p3b_mixers(F); GRID_BAR();
    { pg8::Gemm g{F.MIX, F.Wout_t, M, D, D}; pg8::StaticOrder S; S.init(M, D, F.G, (int)blockIdx.x);
      { pg8::Unit u0; for (int i = 0; S.next(i, u0); ++i) gdn_norm_rows(F, u0.pm * 256); }
      pg8::EpiGateResToBf16 E{F.x, F.X1B, D, F.modf + 2 * D, 6 * D, T};
      pg8::gemm_phase<pg8::EpiGateResToBf16, pg8::StaticOrder, true, true>(F.lds + RING_OFF, g, S, E); }
    GRID_BAR();
    norm_phase<2>(F); GRID_BAR();
    { pg8::Gemm g{F.H, F.Wgu_t, M, NGU, D}; pg8::StaticOrder S; S.init(M, NGU, F.G, (int)blockIdx.x);
      pg8::EpiSwiGLU E{F.PQ, FF};
      pg8::gemm_phase<pg8::EpiSwiGLU, pg8::StaticOrder, true, true>(F.lds + RING_OFF, g, S, E); }
    GRID_BAR();
    { pg8::Gemm g{F.PQ, F.Wdn_t, M, D, FF}; pg8::StaticOrder S; S.init(M, D, F.G, (int)blockIdx.x);
      pg8::EpiGateResFromBf16 E{F.X1B, F.out, D, F.modf + 5 * D, 6 * D, T};
      pg8::gemm_phase<pg8::EpiGateResFromBf16, pg8::StaticOrder, true, true>(F.lds + RING_OFF, g, S, E); }
#undef GRID_BAR
}

extern "C" void kernel_launch(void* const* d_in, const int* in_sizes, int n_in, void* d_out, int out_size, void* d_ws, size_t ws_size, hipStream_t stream) {
    static int grid = 0;
    if (grid == 0) {
        if (n_in != 18 || in_sizes[0] != M * D || out_size != M * D || ws_size < WS_END) { fprintf(stderr, "kernel_launch: unexpected shapes (n_in %d, in0 %d, out %d, ws %zu); nothing launched\n", n_in, n_in > 0 ? in_sizes[0] : -1, out_size, ws_size); grid = -1; return; }
        int dev = 0, cus = 0;
        if (hipGetDevice(&dev) != hipSuccess || hipDeviceGetAttribute(&cus, hipDeviceAttributeMultiprocessorCount, dev) != hipSuccess) { grid = -1; return; }
        if (hipFuncSetAttribute((const void*)hymba_fwd, hipFuncAttributeMaxDynamicSharedMemorySize, LDS_BYTES) != hipSuccess) { fprintf(stderr, "kernel_launch: hipFuncSetAttribute failed\n"); grid = -1; return; }
        (void)hipGetLastError();
        grid = cus;
    }
    if (grid < 0) return;
    if (hipMemsetAsync((char*)d_ws + WS_CTL, 0, CTL_ZERO_BYTES, stream) != hipSuccess) { fprintf(stderr, "kernel_launch: hipMemsetAsync failed\n"); return; }
    Args a{};
    for (int i = 0; i < 18; ++i) a.in[i] = (const float*)d_in[i];
    a.out = (float*)d_out; a.ws = (unsigned char*)d_ws;
    hipLaunchKernelGGL(hymba_fwd, dim3(grid), dim3(NWAVES * 64), LDS_BYTES, stream, a);
    const hipError_t le = hipPeekAtLastError();
    if (le != hipSuccess) fprintf(stderr, "kernel_launch: launch failed: %s\n", hipGetErrorName(le));
}
```

```cpp
#include <hip/hip_runtime.h>
#include <cstdio>
#include <cstdint>
#include <cmath>
namespace pg8 {
#define PG8_LAS __attribute__((address_space(3)))
typedef unsigned short bf16_t;
typedef short bf16x8 __attribute__((ext_vector_type(8)));
typedef float f32x4 __attribute__((ext_vector_type(4)));
typedef unsigned u32x4 __attribute__((ext_vector_type(4)));
constexpr int BM = 256, BK = 64, HALF = 128, HTB = HALF * BK * 2  , STAGE_BYTES = 8 * HTB, NXCD = 8, WGM = 8;

__host__ __device__ __forceinline__ int lds_byte(int r, int c) { const int st = (r >> 4) * 2 + (c >> 5), rr = r & 15, cc = c & 31, ob = rr * 64 + cc * 2; return st * 1024 + (ob ^ (((ob >> 9) & 1) << 5)); }
__host__ __device__ __forceinline__ void stage_rc(int b, int& R, int& C) { const int st = b / 1024, sb = b % 1024, swz = sb ^ (((sb >> 9) & 1) << 5); R = (st >> 1) * 16 + swz / 64; C = (st & 1) * 32 + (swz % 64) / 2; }
__host__ __device__ __forceinline__ int perm32(int rho) { const int n = rho >> 4, i = rho & 15; return 8 * (i >> 2) + 4 * n + (i & 3); }

struct Unit { int pm, pn; };
struct Gemm { const bf16_t* A; const bf16_t* Bt; int M, N, K; };

struct StaticOrder {
    int nM, nN, nwg, G, c;
    __host__ __device__ void init(int M, int N, int G_, int c_) { nM = M / BM; nN = N / BM; nwg = nM * nN; G = G_; c = c_; }
    __host__ __device__ bool next(int i, Unit& u) const {
        const long L = (long)i * G + c; if (L >= nwg) return false;
        int wgid = (int)L; { const int q = nwg / NXCD, r = nwg % NXCD, xcd = wgid % NXCD, off = wgid / NXCD; wgid = (xcd < r ? xcd * (q + 1) : r * (q + 1) + (xcd - r) * q) + off; }
        const int nig = WGM * nN, gid = wgid / nig, fm = gid * WGM, gsz = (nM - fm) < WGM ? (nM - fm) : WGM;
        u.pm = fm + ((wgid % nig) % gsz); u.pn = (wgid % nig) / gsz; return true;
    }
    __device__ __forceinline__ void a_ready(const Unit&) const {}
    __device__ __forceinline__ void done(const Unit&) const {}
};

__device__ __forceinline__ unsigned cvt_pk_bf16(float lo, float hi) { unsigned r; asm volatile("v_cvt_pk_bf16_f32 %0, %1, %2" : "=v"(r) : "v"(lo), "v"(hi)); return r; }
__device__ __forceinline__ float silu_f(float x) { return x * __builtin_amdgcn_rcpf(1.0f + __expf(-x)); }

struct EpiBf16Plain {
    static constexpr bool PERM = true, AFTER_DRAIN = false;
    bf16_t* O; int ldc; int silu_lo, silu_hi;
    __device__ __forceinline__ void operator()(const f32x4 (&acc)[2][2][4][2], const Unit& u, int wr, int wc, int fr, int fq) const {
        const int row0 = u.pm * BM + wr * 64 + fr, col0 = u.pn * BM + wc * 32 + 8 * fq;
        const bool act = (u.pn >= silu_lo) && (u.pn < silu_hi);
#pragma unroll
        for (int ai = 0; ai < 2; ++ai)
#pragma unroll
            for (int m = 0; m < 4; ++m) { bf16_t* rowp = O + (size_t)(row0 + ai * HALF + m * 16) * ldc + col0;
#pragma unroll
                for (int bj = 0; bj < 2; ++bj) { f32x4 v0 = acc[ai][bj][m][0], v1 = acc[ai][bj][m][1];
                    if (act) {
#pragma unroll
                        for (int i = 0; i < 4; ++i) { v0[i] = silu_f(v0[i]); v1[i] = silu_f(v1[i]); } }
                    u32x4 w; w.x = cvt_pk_bf16(v0[0], v0[1]); w.y = cvt_pk_bf16(v0[2], v0[3]); w.z = cvt_pk_bf16(v1[0], v1[1]); w.w = cvt_pk_bf16(v1[2], v1[3]);
                    *(u32x4*)(rowp + bj * HALF) = w; } }
    }
};
struct EpiSwiGLU {
    static constexpr bool PERM = true, AFTER_DRAIN = false;
    bf16_t* O; int ldc;
    __device__ __forceinline__ void operator()(const f32x4 (&acc)[2][2][4][2], const Unit& u, int wr, int wc, int fr, int fq) const {
        const int row0 = u.pm * BM + wr * 64 + fr, col0 = u.pn * HALF + wc * 32 + 8 * fq;
#pragma unroll
        for (int ai = 0; ai < 2; ++ai)
#pragma unroll
            for (int m = 0; m < 4; ++m) { bf16_t* rowp = O + (size_t)(row0 + ai * HALF + m * 16) * ldc + col0;
                const f32x4 g0 = acc[ai][0][m][0], g1 = acc[ai][0][m][1], u0 = acc[ai][1][m][0], u1 = acc[ai][1][m][1];
                float a[8];
#pragma unroll
                for (int i = 0; i < 4; ++i) { a[i] = silu_f(g0[i]) * u0[i]; a[4 + i] = silu_f(g1[i]) * u1[i]; }
                u32x4 w; w.x = cvt_pk_bf16(a[0], a[1]); w.y = cvt_pk_bf16(a[2], a[3]); w.z = cvt_pk_bf16(a[4], a[5]); w.w = cvt_pk_bf16(a[6], a[7]);
                *(u32x4*)rowp = w; }
    }
};
struct EpiGateResToBf16 {
    static constexpr bool PERM = false, AFTER_DRAIN = false;
    const float* base; bf16_t* out; int ldc; const float* gate; int gstride; int rows_per_batch;
    __device__ __forceinline__ void operator()(const f32x4 (&acc)[2][2][4][2], const Unit& u, int wr, int wc, int fr, int fq) const {
        const int row0 = u.pm * BM + wr * 64 + fr, col0 = u.pn * BM + wc * 32 + 4 * fq;
        const float* gp = gate + (size_t)((u.pm * BM) / rows_per_batch) * gstride + col0;
        f32x4 gv[2][2];
#pragma unroll
        for (int bj = 0; bj < 2; ++bj)
#pragma unroll
            for (int n = 0; n < 2; ++n) gv[bj][n] = *(const f32x4*)(gp + bj * HALF + n * 16);
#pragma unroll
        for (int ai = 0; ai < 2; ++ai)
#pragma unroll
            for (int m = 0; m < 4; ++m) { const size_t off = (size_t)(row0 + ai * HALF + m * 16) * ldc + col0;
#pragma unroll
                for (int bj = 0; bj < 2; ++bj)
#pragma unroll
                    for (int n = 0; n < 2; ++n) { const f32x4 o = *(const f32x4*)(base + off + bj * HALF + n * 16) + gv[bj][n] * acc[ai][bj][m][n];
                        *(unsigned long long*)(out + off + bj * HALF + n * 16) = (unsigned long long)cvt_pk_bf16(o[0], o[1]) | ((unsigned long long)cvt_pk_bf16(o[2], o[3]) << 32); } }
    }
};
struct EpiGateResFromBf16 {
    static constexpr bool PERM = false, AFTER_DRAIN = false;
    const bf16_t* base; float* out; int ldc; const float* gate; int gstride; int rows_per_batch;
    __device__ __forceinline__ void operator()(const f32x4 (&acc)[2][2][4][2], const Unit& u, int wr, int wc, int fr, int fq) const {
        const int row0 = u.pm * BM + wr * 64 + fr, col0 = u.pn * BM + wc * 32 + 4 * fq;
        const float* gp = gate + (size_t)((u.pm * BM) / rows_per_batch) * gstride + col0;
        f32x4 gv[2][2];
#pragma unroll
        for (int bj = 0; bj < 2; ++bj)
#pragma unroll
            for (int n = 0; n < 2; ++n) gv[bj][n] = *(const f32x4*)(gp + bj * HALF + n * 16);
#pragma unroll
        for (int ai = 0; ai < 2; ++ai)
#pragma unroll
            for (int m = 0; m < 4; ++m) { const size_t off = (size_t)(row0 + ai * HALF + m * 16) * ldc + col0;
#pragma unroll
                for (int bj = 0; bj < 2; ++bj)
#pragma unroll
                    for (int n = 0; n < 2; ++n) { const unsigned long long bb = *(const unsigned long long*)(base + off + bj * HALF + n * 16); const unsigned lo = (unsigned)bb, hi = (unsigned)(bb >> 32);
                        const f32x4 bs = (f32x4){__uint_as_float(lo << 16), __uint_as_float(lo & 0xffff0000u), __uint_as_float(hi << 16), __uint_as_float(hi & 0xffff0000u)};
                        *(f32x4*)(out + off + bj * HALF + n * 16) = bs + gv[bj][n] * acc[ai][bj][m][n]; } }
    }
};

template <class Epi, class Sched, bool ALIGN_EPI = false, bool SP2 = false>
__device__ __forceinline__ void gemm_phase(PG8_LAS unsigned char* lds, const Gemm g, const Sched& S, const Epi& E) {
    int tid_ = threadIdx.x; asm volatile("" : "+v"(tid_));
    const int tid = tid_, wid = __builtin_amdgcn_readfirstlane(tid >> 6), lane = tid & 63, wr = wid >> 2, wc = wid & 3, fr = lane & 15, fq = lane >> 4;
    const int K = g.K, nt = K / BK;
    unsigned voffA[2], voffB[2];
#pragma unroll
    for (int i = 0; i < 2; ++i) { int R, C; stage_rc(tid * 16 + i * 8192, R, C); const int Rb = Epi::PERM ? ((R & ~31) + perm32(R & 31)) : R;
        voffA[i] = (unsigned)(R * K + C) * 2u; voffB[i] = (unsigned)(Rb * K + C) * 2u; }
    const size_t kstep = (size_t)(BK * 2);
    const size_t hstep = (size_t)HALF * K * 2;
    const size_t tstep = 2 * hstep;
    const unsigned ldsw = (unsigned)wid * 1024u;
    const int aoff = lds_byte(wr * 64 + fr, fq * 8), boff = lds_byte(wc * 32 + fr, fq * 8);
#define PG8_SA(b, h) (((b) * 2 + (h)) * HTB)
#define PG8_SB(b, h) ((4 + (b) * 2 + (h)) * HTB)
#define PG8_STAGE(bufoff, gbase, voff) do { _Pragma("unroll") for (int _i = 0; _i < 2; ++_i) \
        __builtin_amdgcn_global_load_lds((const unsigned*)((const char*)(gbase) + (voff)[_i]), (PG8_LAS unsigned*)(lds + (bufoff) + ldsw + _i * 8192), 16, 0, 0); } while (0)
#define PG8_LDA(dst, b, h) do { _Pragma("unroll") for (int m = 0; m < 4; ++m) _Pragma("unroll") for (int k = 0; k < 2; ++k) dst[m][k] = *(const PG8_LAS bf16x8*)(lds + PG8_SA(b, h) + aoff + m * 2048 + k * 1024); } while (0)
#define PG8_LDB(dst, b, h) do { _Pragma("unroll") for (int n = 0; n < 2; ++n) _Pragma("unroll") for (int k = 0; k < 2; ++k) dst[n][k] = *(const PG8_LAS bf16x8*)(lds + PG8_SB(b, h) + boff + n * 2048 + k * 1024); } while (0)
#define PG8_MMA(ai, bj, At, Bt) do { __builtin_amdgcn_s_setprio(1); _Pragma("unroll") for (int m = 0; m < 4; ++m) _Pragma("unroll") for (int n = 0; n < 2; ++n) _Pragma("unroll") for (int k = 0; k < 2; ++k) \
        acc[ai][bj][m][n] = __builtin_amdgcn_mfma_f32_16x16x32_bf16(Bt[n][k], At[m][k], acc[ai][bj][m][n], 0, 0, 0); __builtin_amdgcn_s_setprio(0); } while (0)
#define PG8_WAIT_V(n) asm volatile("s_waitcnt vmcnt(" #n ")" ::: "memory")
#define PG8_WAIT_L(n) asm volatile("s_waitcnt lgkmcnt(" #n ")" ::: "memory")
#define PG8_BAR __builtin_amdgcn_s_barrier()
#define PG8_SCHED __builtin_amdgcn_sched_barrier(0)
    Unit cur, nxt; int ui = 0;
    if (!S.next(0, cur)) return;
    f32x4 acc[2][2][4][2];
#pragma unroll
    for (int a = 0; a < 2; ++a)
#pragma unroll
        for (int b = 0; b < 2; ++b)
#pragma unroll
            for (int m = 0; m < 4; ++m)
#pragma unroll
                for (int n = 0; n < 2; ++n) acc[a][b][m][n] = (f32x4){0.f, 0.f, 0.f, 0.f};
    bf16x8 At[4][2], B0[2][2], B1[2][2];
    const char* cA = (const char*)g.A + (size_t)cur.pm * tstep; const char* cB = (const char*)g.Bt + (size_t)cur.pn * tstep;
    S.a_ready(cur);
    if constexpr (SP2) {
        PG8_STAGE(PG8_SB(0, 0), cB, voffB); PG8_STAGE(PG8_SB(0, 1), cB + hstep, voffB); PG8_STAGE(PG8_SA(0, 0), cA, voffA); PG8_STAGE(PG8_SA(0, 1), cA + hstep, voffA);
        if (wr == 1) PG8_BAR;
        PG8_WAIT_V(2); PG8_BAR;
        PG8_STAGE(PG8_SB(1, 0), cB + kstep, voffB); PG8_STAGE(PG8_SA(1, 0), cA + kstep, voffA); PG8_STAGE(PG8_SB(1, 1), cB + hstep + kstep, voffB);
        PG8_WAIT_V(6); PG8_BAR;
    } else {
        PG8_STAGE(PG8_SB(0, 0), cB, voffB); PG8_STAGE(PG8_SA(0, 0), cA, voffA); PG8_STAGE(PG8_SB(0, 1), cB + hstep, voffB); PG8_STAGE(PG8_SA(0, 1), cA + hstep, voffA);
        if (wr == 1) PG8_BAR;
        PG8_WAIT_V(4); PG8_BAR;
        PG8_STAGE(PG8_SB(1, 0), cB + kstep, voffB); PG8_STAGE(PG8_SA(1, 0), cA + kstep, voffA); PG8_STAGE(PG8_SB(1, 1), cB + hstep + kstep, voffB);
        PG8_WAIT_V(6); PG8_BAR;
    }
    for (;;) {
        const bool has_next = S.next(ui + 1, nxt);
        const char* nA = has_next ? (const char*)g.A + (size_t)nxt.pm * tstep : cA; const char* nB = has_next ? (const char*)g.Bt + (size_t)nxt.pn * tstep : cB;
        for (int t = 0; t < nt; t += 2) {
            const bool last = (t == nt - 2);
            const char* a1 = cA + (size_t)(t + 1) * kstep;
            const char* a2 = last ? nA : cA + (size_t)(t + 2) * kstep; const char* b2 = last ? nB : cB + (size_t)(t + 2) * kstep;
            const char* a3 = a2 + kstep; const char* b3 = b2 + kstep;
            if (last && has_next) S.a_ready(nxt);
            if constexpr (SP2) {
            PG8_LDB(B0, 0, 0); PG8_LDB(B1, 0, 1); PG8_SCHED; PG8_LDA(At, 0, 0); PG8_STAGE(PG8_SA(1, 1), a1 + hstep, voffA);
            PG8_WAIT_V(8); PG8_WAIT_L(0); PG8_BAR; PG8_MMA(0, 0, At, B0); PG8_MMA(0, 1, At, B1); PG8_BAR; PG8_SCHED;
            PG8_LDA(At, 0, 1); PG8_STAGE(PG8_SB(0, 0), b2, voffB); PG8_STAGE(PG8_SB(0, 1), b2 + hstep, voffB); PG8_STAGE(PG8_SA(0, 0), a2, voffA);
            PG8_WAIT_V(8); PG8_WAIT_L(0); PG8_BAR; PG8_MMA(1, 0, At, B0); PG8_MMA(1, 1, At, B1); PG8_BAR; PG8_SCHED;
            PG8_LDB(B0, 1, 0); PG8_LDB(B1, 1, 1); PG8_SCHED; PG8_LDA(At, 1, 0); PG8_STAGE(PG8_SA(0, 1), a2 + hstep, voffA);
            PG8_WAIT_V(8); PG8_WAIT_L(0); PG8_BAR; PG8_MMA(0, 0, At, B0); PG8_MMA(0, 1, At, B1); PG8_BAR; PG8_SCHED;
            PG8_LDA(At, 1, 1); PG8_STAGE(PG8_SB(1, 0), b3, voffB); PG8_STAGE(PG8_SB(1, 1), b3 + hstep, voffB); PG8_STAGE(PG8_SA(1, 0), a3, voffA);
            PG8_WAIT_V(8); PG8_WAIT_L(0); PG8_BAR; PG8_MMA(1, 0, At, B0); PG8_MMA(1, 1, At, B1); PG8_BAR; PG8_SCHED;
            } else {
            PG8_LDB(B0, 0, 0); PG8_SCHED; PG8_LDA(At, 0, 0); PG8_STAGE(PG8_SA(1, 1), a1 + hstep, voffA);
            PG8_WAIT_L(8); PG8_BAR; PG8_WAIT_L(0); PG8_MMA(0, 0, At, B0); PG8_BAR; PG8_SCHED;
            PG8_LDB(B1, 0, 1); PG8_STAGE(PG8_SB(0, 0), b2, voffB);
            PG8_BAR; PG8_WAIT_L(0); PG8_MMA(0, 1, At, B1); PG8_BAR;
            PG8_LDA(At, 0, 1); PG8_STAGE(PG8_SA(0, 0), a2, voffA);
            PG8_BAR; PG8_WAIT_L(0); PG8_MMA(1, 0, At, B0); PG8_BAR; PG8_SCHED;
            PG8_STAGE(PG8_SB(0, 1), b2 + hstep, voffB);
            PG8_WAIT_V(6); PG8_BAR; PG8_MMA(1, 1, At, B1); PG8_BAR;
            PG8_LDB(B0, 1, 0); PG8_SCHED; PG8_LDA(At, 1, 0); PG8_STAGE(PG8_SA(0, 1), a2 + hstep, voffA);
            PG8_WAIT_L(8); PG8_BAR; PG8_WAIT_L(0); PG8_MMA(0, 0, At, B0); PG8_BAR; PG8_SCHED;
            PG8_LDB(B1, 1, 1); PG8_STAGE(PG8_SB(1, 0), b3, voffB);
            PG8_BAR; PG8_WAIT_L(0); PG8_MMA(0, 1, At, B1); PG8_BAR;
            PG8_LDA(At, 1, 1); PG8_STAGE(PG8_SA(1, 0), a3, voffA);
            PG8_BAR; PG8_WAIT_L(0); PG8_MMA(1, 0, At, B0); PG8_BAR; PG8_SCHED;
            PG8_STAGE(PG8_SB(1, 1), b3 + hstep, voffB);
            PG8_WAIT_V(6); PG8_BAR; PG8_MMA(1, 1, At, B1); PG8_BAR;
            }
        }
        if constexpr (ALIGN_EPI) { if (wr == 0) PG8_BAR; }
        if constexpr (!Epi::AFTER_DRAIN) { E(acc, cur, wr, wc, fr, fq); S.done(cur); }
        if (!has_next) break;
#pragma unroll
        for (int a = 0; a < 2; ++a)
#pragma unroll
            for (int b = 0; b < 2; ++b)
#pragma unroll
                for (int m = 0; m < 4; ++m)
#pragma unroll
                    for (int n = 0; n < 2; ++n) acc[a][b][m][n] = (f32x4){0.f, 0.f, 0.f, 0.f};
        cur = nxt; cA = nA; cB = nB; ++ui;
        if constexpr (ALIGN_EPI) { if (wr == 1) PG8_BAR; }
    }
    PG8_WAIT_V(0);
    if constexpr (!ALIGN_EPI) { if (wr == 0) PG8_BAR; }
    PG8_BAR;
    if constexpr (Epi::AFTER_DRAIN) { E.fused(acc, cur, wr, wc, fr, fq, lds, wid, lane); S.done(cur); }
#undef PG8_SA
#undef PG8_SB
#undef PG8_STAGE
#undef PG8_LDA
#undef PG8_LDB
#undef PG8_MMA
#undef PG8_WAIT_V
#undef PG8_WAIT_L
#undef PG8_BAR
#undef PG8_SCHED
}
}
constexpr int NWAVES = 8;
constexpr int BATCH = 4, T = 4096, D = 1024, M = BATCH * T;
constexpr int PROJ_W = 2832, NP = 3072, FF = 2816, NGU = 2 * FF, HD = 64;
constexpr int C_GQ = 0, C_GK = 512, C_GV = 1024, C_GZ = 1536, C_SQ = 2048, C_SK = 2560, C_SV = 2688, C_GA = 2816, C_GB = 2824;
constexpr float EPS = 1e-6f;
constexpr size_t MiB = 1u << 20;
constexpr size_t WS_CTL = 0, CTL_ZERO_BYTES = 256 * 1024;
constexpr size_t WS_MODF = 1 * MiB;
constexpr size_t WS_DEC = 1 * MiB + 384 * 1024;
constexpr size_t WS_WIN = 4 * MiB, WS_WOUT = 10 * MiB, WS_WGU = 12 * MiB, WS_WDN = 24 * MiB;
constexpr size_t WS_H = 32 * MiB;
constexpr size_t WS_PQ = 64 * MiB;
constexpr size_t WS_MIX = 160 * MiB;
constexpr size_t WS_CHKA = 192 * MiB;
constexpr size_t WS_END = 256 * MiB;
constexpr int CW_ADA = 1024;
constexpr int CW_BAR = 4096;
constexpr int CW_MODACC = 16384;
constexpr int RING_OFF = 0, RING_BYTES = 131072;
constexpr int LDS_BYTES = 163840;
constexpr int LDSCTL_OFF = LDS_BYTES - 1024, MISC_OFF = LDSCTL_OFF + 320;
#define GAS __attribute__((address_space(1)))
#define LAS __attribute__((address_space(3)))
typedef unsigned short bf16;
typedef unsigned v4u __attribute__((ext_vector_type(4)));
typedef float f32x4 __attribute__((ext_vector_type(4)));
typedef short bf16x8 __attribute__((ext_vector_type(8)));
typedef GAS unsigned gu32;
typedef GAS unsigned long long gu64;
#define RLX_AGENT __ATOMIC_RELAXED, __HIP_MEMORY_SCOPE_AGENT
#define LDS_WAIT() asm volatile("s_waitcnt lgkmcnt(0)" ::: "memory")
#define VM_WAIT() asm volatile("s_waitcnt vmcnt(0)" ::: "memory")
__device__ __forceinline__ unsigned long long rt() { return __builtin_amdgcn_s_memrealtime(); }
__device__ __forceinline__ unsigned f2bf(float f) { unsigned u = __builtin_bit_cast(unsigned, f); return (u + 0x7fffu + ((u >> 16) & 1u)) >> 16; }
__device__ __forceinline__ unsigned pk2(float lo, float hi) { return f2bf(lo) | (f2bf(hi) << 16); }

#define XB_TMO      128
#define XB_XCNT(j)  (256  + 64 * (j))
#define XB_XSUB(j)  (1280 + 64 * (j))
#define XB_XGEN(j)  (2304 + 64 * (j))
#define XB_TOP      3328
#define XB_TOPGEN   3392
#define XCD_BAR_WORDS 3456
#define XB_SPIN_CAP (1u << 22)

__device__ __forceinline__ unsigned xb_ld(unsigned* p)              { return __hip_atomic_load(p, __ATOMIC_RELAXED, __HIP_MEMORY_SCOPE_AGENT); }
__device__ __forceinline__ unsigned xb_add(unsigned* p, unsigned v) { return __hip_atomic_fetch_add(p, v, __ATOMIC_RELAXED, __HIP_MEMORY_SCOPE_AGENT); }
__device__ __forceinline__ unsigned xb_xcc_id() { return (unsigned)__builtin_amdgcn_s_getreg((3 << 11) | 20) & 0xFu; }
#define XB_SPIN(cond, bar) do { unsigned _sp = 0; while (cond) { __builtin_amdgcn_s_sleep(1); \
    if ((++_sp & 255u) == 0u) { if (xb_ld(&(bar)[XB_TMO])) break; if (_sp > XB_SPIN_CAP) { atomicAdd(&(bar)[XB_TMO], 1u); break; } } } } while (0)

struct XcdBarrier {
    unsigned* bar; unsigned x;
    volatile LAS unsigned* st;
};

__device__ __forceinline__ XcdBarrier xcd_barrier_post(unsigned* bar, volatile LAS unsigned* st) {
    XcdBarrier b; b.bar = bar; b.x = xb_xcc_id(); b.st = st;
    if (threadIdx.x == 0) (void)xb_add(&bar[XB_XCNT(b.x)], 1u);
    return b;
}
__device__ __forceinline__ void xcd_barrier_complete(unsigned* bar, unsigned x, unsigned& nloc, unsigned& nx) {
    const unsigned G = gridDim.x * gridDim.y * gridDim.z;
    unsigned sum, cnt, mine, sp = 0u;
    for (;;) {
        sum = 0u; cnt = 0u; mine = 0u;
#pragma unroll
        for (unsigned j = 0; j < 16; ++j) { const unsigned c = xb_ld(&bar[XB_XCNT(j)]); sum += c; cnt += (c > 0u) ? 1u : 0u; mine = (j == x) ? c : mine; }
        if (sum == G) break;
        __builtin_amdgcn_s_sleep(1);
        if ((++sp & 255u) == 0u) { if (xb_ld(&bar[XB_TMO])) break; if (sp > XB_SPIN_CAP) { atomicAdd(&bar[XB_TMO], 1u); break; } }
    }
    nloc = mine > 0u ? mine : 1u; nx = cnt > 0u ? cnt : 1u;
}

__device__ __forceinline__ void xcd_barrier(const XcdBarrier& b) {
    asm volatile("s_waitcnt vmcnt(0)" ::: "memory");
    __syncthreads();
    if (threadIdx.x == 0) {
        unsigned* bar = b.bar;
        __builtin_amdgcn_s_waitcnt(0);
        unsigned nloc = b.st[0], nx = b.st[1];
        if (nloc == 0u) { xcd_barrier_complete(bar, b.x, nloc, nx); b.st[0] = nloc; b.st[1] = nx; }
        const unsigned old = xb_add(&bar[XB_XSUB(b.x)], 1u);
        const unsigned gen = old / nloc;
        if (old + 1u == (gen + 1u) * nloc) {
            __builtin_amdgcn_fence(__ATOMIC_RELEASE, "agent");
            asm volatile("s_waitcnt vmcnt(0)" ::: "memory");
            const unsigned og = xb_add(&bar[XB_TOP], 1u);
            const unsigned tg = og / nx;
            if (og + 1u == (tg + 1u) * nx) xb_add(&bar[XB_TOPGEN], 1u);
            else XB_SPIN(xb_ld(&bar[XB_TOPGEN]) == tg, bar);
            __builtin_amdgcn_fence(__ATOMIC_ACQUIRE, "agent");
            xb_add(&bar[XB_XGEN(b.x)], 1u);
            asm volatile("s_waitcnt vmcnt(0)" ::: "memory");
        } else {
            XB_SPIN(xb_ld(&bar[XB_XGEN(b.x)]) == gen, bar);
            __builtin_amdgcn_fence(__ATOMIC_ACQUIRE, "agent");
            asm volatile("s_waitcnt vmcnt(0)" ::: "memory");
        }
    }
    __syncthreads();
}
struct Frame {
    LAS unsigned char* lds;
    volatile LAS unsigned* MISC;
    gu32* ctl;
    int tid, lane, wave;
    int vcu, G;
    const float *x, *c, *w_ada, *b_ada, *norm1_w, *w_in, *conv_w, *a_log, *dt_bias, *gdn_norm_w, *q_norm_w, *k_norm_w, *sinks, *w_out, *norm2_w, *w_gate, *w_up, *w_down;
    float* out;
    float *modacc, *modf, *dec;
    bf16 *Win_t, *Wout_t, *Wgu_t, *Wdn_t, *H, *PQ, *MIX, *X1B, *CHKA, *CHKU, *CHKT, *ORAW;
};
template <int CTRL, int ROWMASK, bool BC>
__device__ __forceinline__ float dpp_mov(float v) { return __int_as_float(__builtin_amdgcn_update_dpp(0, __float_as_int(v), CTRL, ROWMASK, 0xF, BC)); }
__device__ __forceinline__ float sum8(float v) { v += dpp_mov<0xB1, 0xF, true>(v); v += dpp_mov<0x4E, 0xF, true>(v); v += dpp_mov<0x141, 0xF, true>(v); return v; }
__device__ __forceinline__ float wave_sum(float v) {
    v = sum8(v); v += dpp_mov<0x140, 0xF, true>(v);
    v += dpp_mov<0x142, 0xA, false>(v); v += dpp_mov<0x143, 0xC, false>(v);
    return __int_as_float(__builtin_amdgcn_readlane(__float_as_int(v), 63));
}
__device__ __forceinline__ float fq_sum(float v) {
    auto r = __builtin_amdgcn_permlane16_swap(__float_as_uint(v), __float_as_uint(v), false, false); v = __uint_as_float(r[0]) + __uint_as_float(r[1]);
    auto s = __builtin_amdgcn_permlane32_swap(__float_as_uint(v), __float_as_uint(v), false, false); return __uint_as_float(s[0]) + __uint_as_float(s[1]);
}
__device__ __forceinline__ float fq_max(float v) {
    auto r = __builtin_amdgcn_permlane16_swap(__float_as_uint(v), __float_as_uint(v), false, false); v = fmaxf(__uint_as_float(r[0]), __uint_as_float(r[1]));
    auto s = __builtin_amdgcn_permlane32_swap(__float_as_uint(v), __float_as_uint(v), false, false); return fmaxf(__uint_as_float(s[0]), __uint_as_float(s[1]));
}
typedef float f32x2_t __attribute__((ext_vector_type(2))); typedef __bf16 bf16x2_t __attribute__((ext_vector_type(2)));
__device__ __forceinline__ unsigned cvtpk(float lo, float hi) { f32x2_t v = {lo, hi}; bf16x2_t b = __builtin_convertvector(v, bf16x2_t); return __builtin_bit_cast(unsigned, b); }
__device__ __forceinline__ float bf2f(bf16 h) { return __uint_as_float((unsigned)h << 16); }
__device__ __forceinline__ float ld_f32_coh(const float* p) { return __uint_as_float(__hip_atomic_load((const unsigned*)p, RLX_AGENT)); }
__device__ __forceinline__ float silu(float x) { return x * __builtin_amdgcn_rcpf(1.0f + __expf(-x)); }
__device__ __forceinline__ float rsq(float x) { return __builtin_amdgcn_rsqf(x); }

__device__ __forceinline__ void tr_item64(const float* W, int ldw, int src_col, bf16* WT, int K, int dst_row, int k0, LAS bf16* tl, int lane) {
    const int cg = lane & 15, rr = lane >> 4;
    f32x4 v[16];
#pragma unroll
    for (int i = 0; i < 16; ++i) v[i] = *(const GAS f32x4*)(W + (size_t)(k0 + 4 * i + rr) * ldw + src_col + 4 * cg);
#pragma unroll
    for (int i = 0; i < 16; ++i) *(LAS unsigned long long*)(tl + (4 * i + rr) * 68 + 4 * cg) = (unsigned long long)cvtpk(v[i].x, v[i].y) | ((unsigned long long)cvtpk(v[i].z, v[i].w) << 32);
    LDS_WAIT(); asm volatile("" ::: "memory");
#pragma unroll
    for (int ii = 0; ii < 8; ++ii) { const int p = lane + 64 * ii, n = p >> 3, kc = p & 7; const LAS bf16* s = tl + (8 * kc) * 68 + n;
        v4u o; o.x = (unsigned)s[0] | ((unsigned)s[68] << 16); o.y = (unsigned)s[2 * 68] | ((unsigned)s[3 * 68] << 16); o.z = (unsigned)s[4 * 68] | ((unsigned)s[5 * 68] << 16); o.w = (unsigned)s[6 * 68] | ((unsigned)s[7 * 68] << 16);
        *(GAS v4u*)(WT + (size_t)(dst_row + n) * K + k0 + 8 * kc) = o; }
    LDS_WAIT(); asm volatile("" ::: "memory");
}

__device__ __forceinline__ void p0_prologue(Frame& F) {
    LAS bf16* tl = (LAS bf16*)(F.lds + RING_OFF + F.wave * 16384);
    const int gw = F.vcu * NWAVES + F.wave, NGW = F.G * NWAVES, lane = F.lane;
    if ((int)blockIdx.x < 24 * 8) {
        const int ct = blockIdx.x % 24, kg = blockIdx.x / 24, col = ct * 256 + 4 * lane, k0 = kg * 128 + F.wave * 16;
        f32x4 w[16];
#pragma unroll
        for (int kk = 0; kk < 16; ++kk) w[kk] = *(const GAS f32x4*)(F.w_ada + (size_t)(k0 + kk) * (6 * D) + col);
        f32x4 acc[4];
#pragma unroll
        for (int b = 0; b < 4; ++b) acc[b] = (f32x4){0.f, 0.f, 0.f, 0.f};
#pragma unroll
        for (int kk = 0; kk < 16; ++kk)
#pragma unroll
            for (int b = 0; b < 4; ++b) acc[b] += silu(F.c[b * D + k0 + kk]) * w[kk];
        LAS f32x4* rd = (LAS f32x4*)(F.lds + RING_OFF + F.wave * 16384 + 12288);
#pragma unroll
        for (int b = 0; b < 4; ++b) rd[b * 64 + lane] = acc[b];
        __syncthreads();
#pragma unroll
        for (int j = 0; j < 2; ++j) { const int e = F.tid * 2 + j, bb = e >> 8, c = e & 255; float s = 0.f;
#pragma unroll
            for (int wv = 0; wv < 8; ++wv) s += ((const LAS float*)(F.lds + RING_OFF + wv * 16384 + 12288))[(bb * 64 + (c >> 2)) * 4 + (c & 3)];
            const float prev = atomicAdd(F.modacc + bb * (6 * D) + ct * 256 + c, s); asm volatile("" :: "v"(prev)); }
        __syncthreads();
        if (F.tid == 0) (void)xb_add((unsigned*)(F.ctl + CW_ADA), 1u);
    }
    constexpr int I_IN = 16 * (NP / 64), I_OUT = 16 * 16, I_GU = 16 * (NGU / 64), I_DN = (FF / 64) * 16;
    constexpr int NITEMS = I_IN + I_OUT + I_GU + I_DN;
    for (int it = gw; it < NITEMS; it += NGW) {
        int r = it;
        if (r < I_IN) { const int nb = r % (NP / 64), kb = r / (NP / 64), n0 = 64 * nb;
            tr_item64(F.w_in, PROJ_W, n0 < 2048 ? n0 : (n0 < 2816 ? n0 + 16 : (n0 == 2816 ? 2048 : 0)), F.Win_t, D, n0, 64 * kb, tl, lane); continue; }
        r -= I_IN;
        if (r < I_OUT) { const int nb = r % 16, kb = r / 16; tr_item64(F.w_out, D, 64 * nb, F.Wout_t, D, 64 * nb, 64 * kb, tl, lane); continue; }
        r -= I_OUT;
        if (r < I_GU) { const int nb = r % (NGU / 64), kb = r / (NGU / 64), n0 = 64 * nb, p = n0 >> 8, j = n0 & 255;
            if (j < 128) tr_item64(F.w_gate, FF, 128 * p + j, F.Wgu_t, D, n0, 64 * kb, tl, lane);
            else         tr_item64(F.w_up,   FF, 128 * p + j - 128, F.Wgu_t, D, n0, 64 * kb, tl, lane);
            continue; }
        r -= I_GU;
        { const int nb = r % 16, kb = r / 16; tr_item64(F.w_down, D, 64 * nb, F.Wdn_t, FF, 64 * nb, 64 * kb, tl, lane); }
    }
}

template <int WHICH> __device__ __forceinline__ void norm_phase(Frame& F) {
    const int gw = F.vcu * NWAVES + F.wave, NGW = F.G * NWAVES, lane = F.lane;
    if (WHICH == 1) {
        if (F.tid == 0) { unsigned* bw = (unsigned*)(F.ctl + CW_BAR); XB_SPIN(xb_ld((unsigned*)(F.ctl + CW_ADA)) < 192u, bw); __builtin_amdgcn_fence(__ATOMIC_ACQUIRE, "agent"); asm volatile("s_waitcnt vmcnt(0)" ::: "memory"); }
        __syncthreads();
        for (int idx = gw * 64 + lane; idx < 4 * 6 * D; idx += NGW * 64) F.modf[idx] = F.modacc[idx] + F.b_ada[idx % (6 * D)];
    }
    const float* nw = (WHICH == 1) ? F.norm1_w : F.norm2_w;
    constexpr int R = (WHICH == 1) ? 4 : 8;
    for (int m0 = gw * R; m0 < M; m0 += NGW * R) {
        const int b = m0 / T;
        f32x4 v[R][4];
#pragma unroll
        for (int r = 0; r < R; ++r) {
            if (WHICH == 1) { const GAS f32x4* xr = (const GAS f32x4*)(F.x + (size_t)(m0 + r) * D) + lane;
#pragma unroll
                for (int i = 0; i < 4; ++i) v[r][i] = xr[64 * i]; }
            else { const GAS unsigned long long* xr = (const GAS unsigned long long*)(F.X1B + (size_t)(m0 + r) * D) + lane;
#pragma unroll
                for (int i = 0; i < 4; ++i) { const unsigned long long bb = xr[64 * i]; const unsigned lo = (unsigned)bb, hi = (unsigned)(bb >> 32);
                    v[r][i] = (f32x4){__uint_as_float(lo << 16), __uint_as_float(lo & 0xffff0000u), __uint_as_float(hi << 16), __uint_as_float(hi & 0xffff0000u)}; } } }
        f32x4 gm[4], sh[4];
#pragma unroll
        for (int i = 0; i < 4; ++i) { const int c = 256 * i + 4 * lane; f32x4 sc, sf;
            if (WHICH == 1) { sf = *(const GAS f32x4*)(F.modacc + b * 6 * D + c) + *(const GAS f32x4*)(F.b_ada + c); sc = *(const GAS f32x4*)(F.modacc + b * 6 * D + D + c) + *(const GAS f32x4*)(F.b_ada + D + c); }
            else { sf = *(const GAS f32x4*)(F.modf + b * 6 * D + 3 * D + c); sc = *(const GAS f32x4*)(F.modf + b * 6 * D + 4 * D + c); }
            gm[i] = *(const GAS f32x4*)(nw + c) * (sc + 1.0f); sh[i] = sf; }
#pragma unroll
        for (int r = 0; r < R; ++r) {
            float ss = 0.f;
#pragma unroll
            for (int i = 0; i < 4; ++i) ss += (v[r][i].x * v[r][i].x + v[r][i].y * v[r][i].y) + (v[r][i].z * v[r][i].z + v[r][i].w * v[r][i].w);
            const float rstd = rsq(wave_sum(ss) * (1.0f / D) + EPS);
            GAS unsigned long long* o8 = (GAS unsigned long long*)(F.H + (size_t)(m0 + r) * D) + lane;
#pragma unroll
            for (int i = 0; i < 4; ++i) { const f32x4 a = v[r][i] * rstd * gm[i] + sh[i];
                o8[64 * i] = (unsigned long long)cvtpk(a[0], a[1]) | ((unsigned long long)cvtpk(a[2], a[3]) << 32); }
        }
    }
}

__device__ __forceinline__ float rdlane(float v, int l) { return __int_as_float(__builtin_amdgcn_readlane(__float_as_int(v), l)); }
__device__ __forceinline__ bf16x8 pack8(const f32x4 a, const f32x4 b) {
    v4u w; w.x = cvtpk(a[0], a[1]); w.y = cvtpk(a[2], a[3]); w.z = cvtpk(b[0], b[1]); w.w = cvtpk(b[2], b[3]); return __builtin_bit_cast(bf16x8, w); }
__device__ __forceinline__ bf16x8 tile_frag(const LAS bf16* tile, int t, int ks, int fr, int fq) {
    const LAS bf16* p = tile + (16 * t + fr) * 64 + 32 * ks + 4 * fq;
    const unsigned long long lo = *(const LAS unsigned long long*)p, hi = *(const LAS unsigned long long*)(p + 16);
    v4u v; v.x = (unsigned)lo; v.y = (unsigned)(lo >> 32); v.z = (unsigned)hi; v.w = (unsigned)(hi >> 32); return __builtin_bit_cast(bf16x8, v);
}
__device__ __forceinline__ unsigned long long pack4(float a, float b, float c, float d) { return (unsigned long long)cvtpk(a, b) | ((unsigned long long)cvtpk(c, d) << 32); }

typedef short s16x4 __attribute__((ext_vector_type(4)));
__device__ __forceinline__ s16x4 cvt4(const f32x4 v) { const unsigned lo = cvtpk(v[0], v[1]), hi = cvtpk(v[2], v[3]); typedef unsigned u32x2 __attribute__((ext_vector_type(2))); return __builtin_bit_cast(s16x4, (u32x2){lo, hi}); }
#define MFMA16(a, b, c) __builtin_amdgcn_mfma_f32_16x16x16bf16_1k((a), (b), (c), 0, 0, 0)
#define MFMA32(a, b, c) __builtin_amdgcn_mfma_f32_16x16x32_bf16((a), (b), (c), 0, 0, 0)

__device__ __forceinline__ void gdn_prep_chunk(Frame& F, int ci, LAS unsigned char* wl  ) {
    const int lane = F.lane, bh = ci >> 6, n = ci & 63, b = bh >> 3, hh = bh & 7, fr = lane & 15, fq = lane >> 4;
    const size_t m0 = (size_t)b * T + 64 * n;
    bf16* const cA = F.CHKA + (size_t)ci * 8192;
    bf16* const cT = F.CHKT + (size_t)ci * 8192;
    bf16* const cU = F.CHKU + (size_t)ci * 8192;
    LAS bf16* const R0 = (LAS bf16*)wl;
    LAS bf16* const R1 = (LAS bf16*)(wl + 9728);
#define GDN_RAW(dst, col0) do { _Pragma("unroll") for (int i_ = 0; i_ < 9; ++i_) { long row_ = (long)m0 - 3 + 8 * i_ + (lane >> 3); row_ = row_ < 0 ? 0 : (row_ > M - 1 ? M - 1 : row_); \
        __builtin_amdgcn_global_load_lds((const unsigned*)(F.PQ + (size_t)row_ * NP + (col0) + hh * 64 + (lane & 7) * 8), (LAS unsigned*)((dst) + i_ * 512), 16, 0, 0); } } while (0)
    GDN_RAW(R0, C_GQ); GDN_RAW(R1, C_GK);
    const f32x4 z4 = (f32x4){0.f, 0.f, 0.f, 0.f};
    float g, beta;
    {
        const float ga = bf2f(F.PQ[(m0 + lane) * NP + C_GA + hh]), gbv = bf2f(F.PQ[(m0 + lane) * NP + C_GB + hh]);
        const float xx = ga + F.dt_bias[hh]; g = -__expf(F.a_log[hh]) * (fmaxf(xx, 0.f) + log1pf(__expf(-fabsf(xx)))); beta = __builtin_amdgcn_rcpf(1.0f + __expf(-gbv));
    }
    float G = g;
#pragma unroll
    for (int o = 1; o < 64; o <<= 1) { const float t = __shfl_up(G, o); if (lane >= o) G += t; }
    const float eG = __expf(G), Glast = __shfl(G, 63), kdsc = __expf(Glast - G), beG = beta * eG;
    if (lane == 0) F.dec[ci] = __expf(Glast);
    asm volatile("s_waitcnt vmcnt(0)" ::: "memory");
    {
        const float a0 = F.conv_w[hh * 64 + lane], a1 = F.conv_w[1536 + hh * 64 + lane], a2 = F.conv_w[2 * 1536 + hh * 64 + lane], a3 = F.conv_w[3 * 1536 + hh * 64 + lane];
        const float b0 = F.conv_w[512 + hh * 64 + lane], b1 = F.conv_w[1536 + 512 + hh * 64 + lane], b2 = F.conv_w[2 * 1536 + 512 + hh * 64 + lane], b3 = F.conv_w[3 * 1536 + 512 + hh * 64 + lane];
        float x0 = 0.f, x1 = 0.f, x2 = 0.f, y0 = 0.f, y1 = 0.f, y2 = 0.f;
        if (n > 0) { x0 = bf2f(R0[lane]); x1 = bf2f(R0[64 + lane]); x2 = bf2f(R0[128 + lane]); y0 = bf2f(R1[lane]); y1 = bf2f(R1[64 + lane]); y2 = bf2f(R1[128 + lane]); }
#pragma unroll
        for (int c = 0; c < 64; ++c) {
            const float rq = bf2f(R0[(c + 3) * 64 + lane]), rk = bf2f(R1[(c + 3) * 64 + lane]);
            const float cq = silu(a0 * x0 + a1 * x1 + a2 * x2 + a3 * rq), ck = silu(b0 * y0 + b1 * y1 + b2 * y2 + b3 * rk);
            x0 = x1; x1 = x2; x2 = rq; y0 = y1; y1 = y2; y2 = rk;
            R0[c * 64 + lane] = (bf16)(cvtpk(cq, cq) & 0xffffu);
            R1[c * 64 + lane] = (bf16)(cvtpk(ck, ck) & 0xffffu);
            if ((c & 15) == 15) __builtin_amdgcn_sched_barrier(0);
        }
    }
    LDS_WAIT(); asm volatile("" ::: "memory"); __builtin_amdgcn_sched_barrier(0);
    bf16x8 kf[4][2], qf[4][2];
#pragma unroll
    for (int blk = 0; blk < 4; ++blk)
#pragma unroll
        for (int kk = 0; kk < 2; ++kk) { kf[blk][kk] = *(const LAS bf16x8*)(R1 + (16 * blk + fr) * 64 + 32 * kk + 8 * fq); qf[blk][kk] = *(const LAS bf16x8*)(R0 + (16 * blk + fr) * 64 + 32 * kk + 8 * fq); }
    float rqc[4], rkc[4];
#pragma unroll
    for (int t = 0; t < 4; ++t) { f32x4 dq = MFMA32(qf[t][0], qf[t][0], z4); dq = MFMA32(qf[t][1], qf[t][1], dq); f32x4 dk = MFMA32(kf[t][0], kf[t][0], z4); dk = MFMA32(kf[t][1], kf[t][1], dk);
        const int di = fr & 3; const bool on = (fq == (fr >> 2));
        const float vq = di == 0 ? dq[0] : di == 1 ? dq[1] : di == 2 ? dq[2] : dq[3], vk = di == 0 ? dk[0] : di == 1 ? dk[1] : di == 2 ? dk[2] : dk[3];
        rqc[t] = rsq(fq_sum(on ? vq : 0.f) + EPS); rkc[t] = rsq(fq_sum(on ? vk : 0.f) + EPS); }
    const float rk_tok = fq == 0 ? rkc[0] : fq == 1 ? rkc[1] : fq == 2 ? rkc[2] : rkc[3];
    const float beGn = beG * rk_tok, kdscn = kdsc * rk_tok;
    float Gcol[4], Bcol[4];
#pragma unroll
    for (int t = 0; t < 4; ++t) { Gcol[t] = __shfl(G, 16 * t + fr); Bcol[t] = __shfl(beta, 16 * t + fr) * rkc[t]; }
#pragma unroll
    for (int mt = 0; mt < 4; ++mt) { const float esc = __expf(Gcol[mt]) * 0.125f * rqc[mt];
#pragma unroll
        for (int ks = 0; ks < 2; ++ks) { const v4u q8 = __builtin_bit_cast(v4u, tile_frag(R0, mt, ks, fr, fq)); const unsigned w_[4] = {q8.x, q8.y, q8.z, q8.w}; v4u o_;
            o_.x = cvtpk(__uint_as_float(w_[0] << 16) * esc, __uint_as_float(w_[0] & 0xffff0000u) * esc); o_.y = cvtpk(__uint_as_float(w_[1] << 16) * esc, __uint_as_float(w_[1] & 0xffff0000u) * esc);
            o_.z = cvtpk(__uint_as_float(w_[2] << 16) * esc, __uint_as_float(w_[2] & 0xffff0000u) * esc); o_.w = cvtpk(__uint_as_float(w_[3] << 16) * esc, __uint_as_float(w_[3] & 0xffff0000u) * esc);
            *(GAS v4u*)(cT + ((mt * 2 + ks) * 64 + lane) * 8) = o_; } }
    LDS_WAIT(); asm volatile("" ::: "memory"); __builtin_amdgcn_sched_barrier(0);
#pragma unroll
    for (int ks = 0; ks < 2; ++ks) { float Grow[2][4], Krow[2][4];
#pragma unroll
        for (int h2 = 0; h2 < 2; ++h2)
#pragma unroll
            for (int i = 0; i < 4; ++i) { Grow[h2][i] = __shfl(G, 16 * (2 * ks + h2) + 4 * fq + i); Krow[h2][i] = __shfl(rk_tok, 16 * (2 * ks + h2) + 4 * fq + i); }
#pragma unroll
        for (int tc = 0; tc < 4; ++tc) {
            f32x4 v[2];
#pragma unroll
            for (int h2 = 0; h2 < 2; ++h2) { const int ts = 2 * ks + h2;
                if (ts <= tc) { f32x4 acc = MFMA32(kf[ts][0], qf[tc][0], z4); acc = MFMA32(kf[ts][1], qf[tc][1], acc);
#pragma unroll
                    for (int i = 0; i < 4; ++i) { const int cidx = 16 * tc + fr, sidx = 16 * ts + 4 * fq + i; v[h2][i] = (cidx >= sidx) ? acc[i] * __expf(Gcol[tc] - Grow[h2][i]) * (0.125f * rqc[tc]) * Krow[h2][i] : 0.f; }
                } else v[h2] = z4; }
            *(bf16x8*)(cT + 4096 + ((tc * 2 + ks) * 64 + lane) * 8) = pack8(v[0], v[1]);
        } }
#pragma unroll
    for (int ts = 0; ts < 4; ++ts) { float Grow[4], Krow[4];
#pragma unroll
        for (int i = 0; i < 4; ++i) { Grow[i] = __shfl(G, 16 * ts + 4 * fq + i); Krow[i] = __shfl(rk_tok, 16 * ts + 4 * fq + i); }
#pragma unroll
        for (int tc = 0; tc < 4; ++tc) { f32x4 a = z4;
            if (ts <= tc) { f32x4 acc = MFMA32(kf[ts][0], kf[tc][0], z4); acc = MFMA32(kf[ts][1], kf[tc][1], acc);
#pragma unroll
                for (int i = 0; i < 4; ++i) { const int cidx = 16 * tc + fr, sidx = 16 * ts + 4 * fq + i; a[i] = (cidx > sidx) ? Bcol[tc] * Krow[i] * acc[i] * __expf(Gcol[tc] - Grow[i]) : 0.f; } }
            *(LAS unsigned long long*)(R0 + (16 * tc + fr) * 64 + 16 * ts + 4 * fq) = pack4(a[0], a[1], a[2], a[3]); } }
    bf16x8 RkB[4][2], KDf[4][2];
#pragma unroll
    for (int ks = 0; ks < 2; ++ks) { float sB[8], sD[8];
#pragma unroll
        for (int j = 0; j < 8; ++j) { const int tok = 32 * ks + 16 * (j >> 2) + 4 * fq + (j & 3); sB[j] = __shfl(beGn, tok); sD[j] = __shfl(kdscn, tok); }
#pragma unroll
        for (int t = 0; t < 4; ++t) { float kv[8];
#pragma unroll
            for (int j = 0; j < 8; ++j) kv[j] = bf2f(R1[(32 * ks + 16 * (j >> 2) + 4 * fq + (j & 3)) * 64 + 16 * t + fr]);
            v4u a_, d_;
            a_.x = cvtpk(kv[0] * sB[0], kv[1] * sB[1]); a_.y = cvtpk(kv[2] * sB[2], kv[3] * sB[3]); a_.z = cvtpk(kv[4] * sB[4], kv[5] * sB[5]); a_.w = cvtpk(kv[6] * sB[6], kv[7] * sB[7]);
            d_.x = cvtpk(kv[0] * sD[0], kv[1] * sD[1]); d_.y = cvtpk(kv[2] * sD[2], kv[3] * sD[3]); d_.z = cvtpk(kv[4] * sD[4], kv[5] * sD[5]); d_.w = cvtpk(kv[6] * sD[6], kv[7] * sD[7]);
            RkB[t][ks] = __builtin_bit_cast(bf16x8, a_); KDf[t][ks] = __builtin_bit_cast(bf16x8, d_); } }
    LDS_WAIT(); asm volatile("" ::: "memory"); __builtin_amdgcn_sched_barrier(0);
    {
        float X[16];
#pragma unroll
        for (int r = 0; r < 16; ++r) X[r] = (r == fr) ? 1.f : 0.f;
        const LAS bf16* ab = R0 + (16 * fq) * 64 + 16 * fq;
#pragma unroll
        for (int s = 0; s < 15; ++s) {
#pragma unroll
            for (int r = s + 1; r < 16; ++r) X[r] -= bf2f(ab[r * 64 + s]) * X[s];
            if ((s & 3) == 3) __builtin_amdgcn_sched_barrier(0);
        }
        LDS_WAIT(); asm volatile("" ::: "memory"); __builtin_amdgcn_sched_barrier(0);
#pragma unroll
        for (int r = 0; r < 16; ++r) R0[(16 * fq + r) * 64 + 16 * fq + fr] = (bf16)(cvtpk(X[r], X[r]) & 0xffffu);
    }
    LDS_WAIT(); asm volatile("" ::: "memory"); __builtin_amdgcn_sched_barrier(0);
    {
#define A16(i, k) (*(const LAS s16x4*)(R0 + (16 * (i) + fr) * 64 + 16 * (k) + 4 * fq))
        s16x4 Td[4];
#pragma unroll
        for (int j = 0; j < 3; ++j) { const LAS bf16* p = R0 + (16 * j + 4 * fq) * 64 + 16 * j + fr; typedef unsigned u32x2 __attribute__((ext_vector_type(2)));
            Td[j] = __builtin_bit_cast(s16x4, (u32x2){(unsigned)p[0] | ((unsigned)p[64] << 16), (unsigned)p[128] | ((unsigned)p[192] << 16)}); }
        f32x4 m10 = MFMA16(A16(1, 0), Td[0], z4);
        const f32x4 t10 = -MFMA16(A16(1, 1), cvt4(m10), z4);
        f32x4 m21 = MFMA16(A16(2, 1), Td[1], z4);
        f32x4 m20 = MFMA16(A16(2, 0), Td[0], z4); m20 = MFMA16(A16(2, 1), cvt4(t10), m20);
        const s16x4 a22 = A16(2, 2);
        const f32x4 t21 = -MFMA16(a22, cvt4(m21), z4), t20 = -MFMA16(a22, cvt4(m20), z4);
        f32x4 m32 = MFMA16(A16(3, 2), Td[2], z4);
        f32x4 m31 = MFMA16(A16(3, 1), Td[1], z4); m31 = MFMA16(A16(3, 2), cvt4(t21), m31);
        f32x4 m30 = MFMA16(A16(3, 0), Td[0], z4); m30 = MFMA16(A16(3, 1), cvt4(t10), m30); m30 = MFMA16(A16(3, 2), cvt4(t20), m30);
        const s16x4 a33 = A16(3, 3);
        const f32x4 t32 = -MFMA16(a33, cvt4(m32), z4), t31 = -MFMA16(a33, cvt4(m31), z4), t30 = -MFMA16(a33, cvt4(m30), z4);
        LDS_WAIT(); asm volatile("" ::: "memory"); __builtin_amdgcn_sched_barrier(0);
#define TST(i, j, t) do { _Pragma("unroll") for (int r_ = 0; r_ < 4; ++r_) R0[(16 * (i) + 4 * fq + r_) * 64 + 16 * (j) + fr] = (bf16)(cvtpk((t)[r_], (t)[r_]) & 0xffffu); } while (0)
        TST(1, 0, t10); TST(2, 0, t20); TST(2, 1, t21); TST(3, 0, t30); TST(3, 1, t31); TST(3, 2, t32);
#undef TST
#undef A16
    }
    LDS_WAIT(); asm volatile("" ::: "memory"); __builtin_amdgcn_sched_barrier(0);
#pragma unroll
    for (int ct = 0; ct < 4; ++ct) { const bf16x8 ta0 = tile_frag(R0, ct, 0, fr, fq), ta1 = tile_frag(R0, ct, 1, fr, fq);
#pragma unroll
        for (int dt = 0; dt < 4; ++dt) { f32x4 acc = MFMA32(ta0, RkB[dt][0], z4); if (ct >= 2) acc = MFMA32(ta1, RkB[dt][1], acc);
            *(LAS unsigned long long*)(R1 + (16 * dt + fr) * 64 + 16 * ct + 4 * fq) = pack4(acc[0], acc[1], acc[2], acc[3]); } }
    LDS_WAIT(); asm volatile("" ::: "memory");
    asm volatile("s_waitcnt vmcnt(0)" ::: "memory");
    v4u qdf[8]; bf16x8 qkf[8];
#pragma unroll
    for (int f = 0; f < 8; ++f) { qdf[f] = *(const GAS v4u*)(cT + (f * 64 + lane) * 8); qkf[f] = *(const GAS bf16x8*)(cT + 4096 + (f * 64 + lane) * 8); }
    bf16x8 waf[4][2];
#pragma unroll
    for (int tm = 0; tm < 4; ++tm) { waf[tm][0] = tile_frag(R1, tm, 0, fr, fq); waf[tm][1] = tile_frag(R1, tm, 1, fr, fq); }
    LDS_WAIT(); asm volatile("" ::: "memory");
    GDN_RAW(R1, C_GV);
#pragma unroll
    for (int tn = 0; tn < 4; ++tn) {
#pragma unroll
        for (int ks2 = 0; ks2 < 2; ++ks2) {
            const v4u qd8 = qdf[tn * 2 + ks2]; const unsigned qw_[4] = {qd8.x, qd8.y, qd8.z, qd8.w};
            f32x4 pp[2], q2[2];
#pragma unroll
            for (int h2 = 0; h2 < 2; ++h2) { const int tm = 2 * ks2 + h2;
                f32x4 a1 = MFMA32(waf[tm][0], KDf[tn][0], z4); a1 = MFMA32(waf[tm][1], KDf[tn][1], a1);
                f32x4 a2 = MFMA32(waf[tm][0], qkf[tn * 2], z4); a2 = MFMA32(waf[tm][1], qkf[tn * 2 + 1], a2);
                pp[h2] = -a1;
                q2[h2] = (f32x4){__uint_as_float(qw_[2 * h2] << 16), __uint_as_float(qw_[2 * h2] & 0xffff0000u), __uint_as_float(qw_[2 * h2 + 1] << 16), __uint_as_float(qw_[2 * h2 + 1] & 0xffff0000u)} - a2; }
            *(GAS bf16x8*)(cA + ((tn * 2 + ks2) * 64 + lane) * 8) = pack8(pp[0], pp[1]);
            *(GAS bf16x8*)(cA + 4096 + ((tn * 2 + ks2) * 64 + lane) * 8) = pack8(q2[0], q2[1]);
        }
    }
    asm volatile("s_waitcnt vmcnt(0)" ::: "memory");
    {
        const float w0 = F.conv_w[1024 + hh * 64 + lane], w1 = F.conv_w[1536 + 1024 + hh * 64 + lane], w2 = F.conv_w[2 * 1536 + 1024 + hh * 64 + lane], w3 = F.conv_w[3 * 1536 + 1024 + hh * 64 + lane];
        float x0 = 0.f, x1 = 0.f, x2 = 0.f;
        if (n > 0) { x0 = bf2f(R1[lane]); x1 = bf2f(R1[64 + lane]); x2 = bf2f(R1[128 + lane]); }
#pragma unroll
        for (int c = 0; c < 64; ++c) {
            const float r = bf2f(R1[(c + 3) * 64 + lane]);
            const float cv = silu(w0 * x0 + w1 * x1 + w2 * x2 + w3 * r); x0 = x1; x1 = x2; x2 = r;
            R1[c * 64 + lane] = (bf16)(cvtpk(cv, cv) & 0xffffu);
            if ((c & 15) == 15) __builtin_amdgcn_sched_barrier(0);
        }
    }
    LDS_WAIT(); asm volatile("" ::: "memory"); __builtin_amdgcn_sched_barrier(0);
    bf16x8 RvB[4][2];
#pragma unroll
    for (int ks = 0; ks < 2; ++ks) { float sB[8];
#pragma unroll
        for (int j = 0; j < 8; ++j) sB[j] = __shfl(beta, 32 * ks + 16 * (j >> 2) + 4 * fq + (j & 3));
#pragma unroll
        for (int t = 0; t < 4; ++t) { float vv[8];
#pragma unroll
            for (int j = 0; j < 8; ++j) vv[j] = bf2f(R1[(32 * ks + 16 * (j >> 2) + 4 * fq + (j & 3)) * 64 + 16 * t + fr]) * sB[j];
            v4u a_; a_.x = cvtpk(vv[0], vv[1]); a_.y = cvtpk(vv[2], vv[3]); a_.z = cvtpk(vv[4], vv[5]); a_.w = cvtpk(vv[6], vv[7]);
            RvB[t][ks] = __builtin_bit_cast(bf16x8, a_); } }
    LDS_WAIT(); asm volatile("" ::: "memory"); __builtin_amdgcn_sched_barrier(0);
#pragma unroll
    for (int ct = 0; ct < 4; ++ct) { const bf16x8 ta0 = tile_frag(R0, ct, 0, fr, fq), ta1 = tile_frag(R0, ct, 1, fr, fq);
#pragma unroll
        for (int et = 0; et < 4; ++et) { f32x4 acc = MFMA32(ta0, RvB[et][0], z4); if (ct >= 2) acc = MFMA32(ta1, RvB[et][1], acc);
            *(LAS unsigned long long*)(R1 + (16 * et + fr) * 64 + 16 * ct + 4 * fq) = pack4(acc[0], acc[1], acc[2], acc[3]); } }
    LDS_WAIT(); asm volatile("" ::: "memory"); __builtin_amdgcn_sched_barrier(0);
#pragma unroll
    for (int et = 0; et < 4; ++et) {
        const bf16x8 ub0 = tile_frag(R1, et, 0, fr, fq), ub1 = tile_frag(R1, et, 1, fr, fq);
#pragma unroll
        for (int tm = 0; tm < 4; ++tm) {
            const bf16x8 qa0 = qkf[tm * 2], qa1 = qkf[tm * 2 + 1];
            f32x4 r = MFMA32(KDf[tm][0], ub0, z4); r = MFMA32(KDf[tm][1], ub1, r);
            f32x4 o = MFMA32(qa0, ub0, z4); o = MFMA32(qa1, ub1, o);
            *(GAS unsigned long long*)(cU + ((et * 4 + tm) * 64 + lane) * 4) = pack4(r[0], r[1], r[2], r[3]);
            *(GAS unsigned long long*)(cU + 4096 + ((et * 4 + tm) * 64 + lane) * 4) = pack4(o[0], o[1], o[2], o[3]);
        }
    }
    LDS_WAIT(); asm volatile("" ::: "memory"); __builtin_amdgcn_sched_barrier(0);
}
#undef MFMA16
#undef MFMA32
#undef GDN_RAW

#define GDN_BAR() do { asm volatile("" ::: "memory"); __builtin_amdgcn_s_barrier(); asm volatile("" ::: "memory"); } while (0)
__device__ __forceinline__ void gdn_scan(Frame& F, int bh) {
    const int lane = F.lane, wave = F.wave, b = bh >> 3, hh = bh & 7, fr = lane & 15, fq = lane >> 4;
    LAS unsigned char* const ring = F.lds + RING_OFF;
    constexpr int SLOT = 32768, OB0 = 131072, OB1 = 139264;
    const unsigned char* gA = (const unsigned char*)(F.CHKA + (size_t)bh * 64 * 8192);
    const unsigned char* gU = (const unsigned char*)(F.CHKU + (size_t)bh * 64 * 8192);
    if (wave >= 4) {
        const int hw = wave - 4, nt = hw * 64 + lane;
        bf16* mp = F.ORAW + ((size_t)b * T + (nt >> 3)) * 512 + hh * 64 + (nt & 7) * 8;
#define GDN_ISSUE(nn) do { const int n_ = (nn); const int sl_ = n_ & 3; _Pragma("unroll") for (int i_ = 0; i_ < 8; ++i_) { const int p_ = hw * 8 + i_; \
            const unsigned char* s_ = (p_ < 16) ? gA + (size_t)n_ * 16384 + p_ * 1024 : gU + (size_t)n_ * 16384 + (p_ - 16) * 1024; \
            __builtin_amdgcn_global_load_lds((const unsigned*)(s_ + lane * 16), (LAS unsigned*)(ring + sl_ * SLOT + p_ * 1024), 16, 0, 0); } } while (0)
#define GDN_COPY(nn) do { const LAS unsigned char* ob_ = ring + (((nn) & 1) ? OB1 : OB0); _Pragma("unroll") for (int k_ = 0; k_ < 2; ++k_) \
            *(GAS v4u*)(mp + (size_t)(64 * (nn) + 32 * k_) * 512) = *(const LAS v4u*)(ob_ + (nt + 256 * k_) * 16); } while (0)
        GDN_ISSUE(0); GDN_ISSUE(1); GDN_ISSUE(2);
        asm volatile("s_waitcnt vmcnt(16)" ::: "memory"); GDN_BAR();
        for (int n = 0; n < 64; ++n) {
            if (n + 3 < 64) { GDN_ISSUE(n + 3); asm volatile("s_waitcnt vmcnt(16)" ::: "memory"); } else asm volatile("s_waitcnt vmcnt(0)" ::: "memory");
            if (n > 0) GDN_COPY(n - 1);
            LDS_WAIT(); GDN_BAR();
        }
        GDN_COPY(63);
#undef GDN_ISSUE
#undef GDN_COPY
    } else {
        const int ew = wave;
        f32x4 Sacc[4];
#pragma unroll
        for (int t = 0; t < 4; ++t) Sacc[t] = (f32x4){0.f, 0.f, 0.f, 0.f};
        const float decs = ld_f32_coh(F.dec + bh * 64 + lane);
        GDN_BAR();
        for (int n = 0; n < 64; ++n) {
            const LAS unsigned char* sl = ring + (n & 3) * SLOT;
            LAS bf16* ob = (LAS bf16*)(ring + ((n & 1) ? OB1 : OB0)) + (4 * fq) * 64 + 16 * ew + fr;
            const float dec = __int_as_float(__builtin_amdgcn_readlane(__float_as_int(decs), n));
            unsigned long long rf[4], of[4]; bf16x8 pf[8], qf[8];
#pragma unroll
            for (int t = 0; t < 4; ++t) { rf[t] = *(const LAS unsigned long long*)(sl + 16384 + ((ew * 4 + t) * 64 + lane) * 8); of[t] = *(const LAS unsigned long long*)(sl + 24576 + ((ew * 4 + t) * 64 + lane) * 8); }
#pragma unroll
            for (int f = 0; f < 8; ++f) { pf[f] = *(const LAS bf16x8*)(sl + (f * 64 + lane) * 16); qf[f] = *(const LAS bf16x8*)(sl + 8192 + (f * 64 + lane) * 16); }
            __builtin_amdgcn_sched_barrier(0);
            bf16x8 Sb[2]; Sb[0] = pack8(Sacc[0], Sacc[1]); Sb[1] = pack8(Sacc[2], Sacc[3]);
            f32x4 O[4];
#pragma unroll
            for (int t = 0; t < 4; ++t) { const unsigned rl = (unsigned)rf[t], rh = (unsigned)(rf[t] >> 32), ol = (unsigned)of[t], oh = (unsigned)(of[t] >> 32);
                Sacc[t] = Sacc[t] * dec + (f32x4){__uint_as_float(rl << 16), __uint_as_float(rl & 0xffff0000u), __uint_as_float(rh << 16), __uint_as_float(rh & 0xffff0000u)};
                O[t] = (f32x4){__uint_as_float(ol << 16), __uint_as_float(ol & 0xffff0000u), __uint_as_float(oh << 16), __uint_as_float(oh & 0xffff0000u)}; }
#pragma unroll
            for (int t = 0; t < 4; ++t)
#pragma unroll
                for (int ks = 0; ks < 2; ++ks) { const int f = t * 2 + ks;
                    Sacc[t] = __builtin_amdgcn_mfma_f32_16x16x32_bf16(pf[f], Sb[ks], Sacc[t], 0, 0, 0); O[t] = __builtin_amdgcn_mfma_f32_16x16x32_bf16(qf[f], Sb[ks], O[t], 0, 0, 0); }
#pragma unroll
            for (int t = 0; t < 4; ++t)
#pragma unroll
                for (int i = 0; i < 4; ++i) ob[(16 * t + i) * 64] = (bf16)(cvtpk(O[t][i], O[t][i]) & 0xffffu);
            LDS_WAIT(); GDN_BAR();
        }
    }
}
__device__ __forceinline__ void gdn_norm_rows(Frame& F, int r0) {
    const int oc = F.tid & 7, hd = (F.tid >> 3) & 7;
    float nw[8];
#pragma unroll
    for (int j = 0; j < 8; ++j) nw[j] = F.gdn_norm_w[oc * 8 + j];
#pragma unroll 1
    for (int it = 0; it < 4; ++it) {
        v4u ov[8], zv[8];
#pragma unroll
        for (int k = 0; k < 8; ++k) { const size_t row = (size_t)r0 + (it * 8 + k) * 8 + (F.tid >> 6); ov[k] = *(const GAS v4u*)(F.ORAW + row * 512 + hd * 64 + oc * 8); zv[k] = *(const GAS v4u*)(F.PQ + row * NP + C_GZ + hd * 64 + oc * 8); }
#pragma unroll
        for (int k = 0; k < 8; ++k) { const size_t row = (size_t)r0 + (it * 8 + k) * 8 + (F.tid >> 6);
            const unsigned ow[4] = {ov[k].x, ov[k].y, ov[k].z, ov[k].w}, zw[4] = {zv[k].x, zv[k].y, zv[k].z, zv[k].w};
            float o[8], z[8]; float ss = 0.f;
#pragma unroll
            for (int w = 0; w < 4; ++w) { o[2 * w] = __uint_as_float(ow[w] << 16); o[2 * w + 1] = __uint_as_float(ow[w] & 0xffff0000u); z[2 * w] = __uint_as_float(zw[w] << 16); z[2 * w + 1] = __uint_as_float(zw[w] & 0xffff0000u);
                ss += o[2 * w] * o[2 * w] + o[2 * w + 1] * o[2 * w + 1]; }
            ss = sum8(ss);
            const float rs = rsq(ss * (1.0f / 64.0f) + EPS);
            v4u w4; w4.x = cvtpk(o[0] * rs * nw[0] * z[0], o[1] * rs * nw[1] * z[1]); w4.y = cvtpk(o[2] * rs * nw[2] * z[2], o[3] * rs * nw[3] * z[3]);
            w4.z = cvtpk(o[4] * rs * nw[4] * z[4], o[5] * rs * nw[5] * z[5]); w4.w = cvtpk(o[6] * rs * nw[6] * z[6], o[7] * rs * nw[7] * z[7]);
            *(GAS v4u*)(F.MIX + row * D + hd * 64 + oc * 8) = w4; }
    }
    asm volatile("s_waitcnt vmcnt(0)" ::: "memory"); __syncthreads();
}
__device__ __forceinline__ void swa_unit(Frame& F, int unit, LAS unsigned char* L) {
    const int tid = F.tid, lane = F.lane, wave = F.wave, fr = lane & 15, fq = lane >> 4;
    const int blk = unit & 63, kvh = (unit >> 6) & 1, b = unit >> 7, t0 = blk * 64;
    const size_t row0 = (size_t)b * T;
    LAS bf16* const Ks = (LAS bf16*)L; LAS bf16* const Vt = (LAS bf16*)(L + 27648);
    for (int p = tid; p < 1536; p += NWAVES * 64) {
        const int key = p >> 3, oc = p & 7, s = t0 - 128 + key;
        v4u kv = (v4u){0u, 0u, 0u, 0u}, vv = (v4u){0u, 0u, 0u, 0u};
        if (s >= 0) { kv = *(const GAS v4u*)(F.PQ + (row0 + s) * NP + C_SK + kvh * 64 + oc * 8); vv = *(const GAS v4u*)(F.PQ + (row0 + s) * NP + C_SV + kvh * 64 + oc * 8); }
        const unsigned kw[4] = {kv.x, kv.y, kv.z, kv.w}, vw[4] = {vv.x, vv.y, vv.z, vv.w};
        float k[8]; float ss = 0.f;
#pragma unroll
        for (int w = 0; w < 4; ++w) { k[2 * w] = __uint_as_float(kw[w] << 16); k[2 * w + 1] = __uint_as_float(kw[w] & 0xffff0000u); ss += k[2 * w] * k[2 * w] + k[2 * w + 1] * k[2 * w + 1]; }
        ss = sum8(ss);
        const float rstd = rsq(ss * (1.0f / 64.0f) + EPS);
#pragma unroll
        for (int j = 0; j < 8; ++j) k[j] = k[j] * rstd * F.k_norm_w[oc * 8 + j];
        v4u o; o.x = cvtpk(k[0], k[1]); o.y = cvtpk(k[2], k[3]); o.z = cvtpk(k[4], k[5]); o.w = cvtpk(k[6], k[7]);
        *(LAS v4u*)(Ks + key * 72 + oc * 8) = o;
#pragma unroll
        for (int w = 0; w < 4; ++w) { Vt[(oc * 8 + 2 * w) * 196 + key] = (bf16)(vw[w] & 0xffffu); Vt[(oc * 8 + 2 * w + 1) * 196 + key] = (bf16)(vw[w] >> 16); }
    }
    __syncthreads();
    const int hq = kvh * 4 + (wave >> 1);
    const float slope = exp2f(-(float)(hq + 1)), sink = F.sinks[hq];
#pragma unroll 1
    for (int qt = 0; qt < 2; ++qt) {
        const int tq0 = t0 + 32 * (wave & 1) + 16 * qt;
        bf16x8 qf[2];
        {
            const bf16* qp = F.PQ + (row0 + tq0 + fr) * NP + C_SQ + hq * 64 + 8 * fq;
            const v4u r0 = *(const GAS v4u*)qp, r1 = *(const GAS v4u*)(qp + 32);
            const unsigned qw[8] = {r0.x, r0.y, r0.z, r0.w, r1.x, r1.y, r1.z, r1.w};
            float q[16]; float ss = 0.f;
#pragma unroll
            for (int w = 0; w < 8; ++w) { q[2 * w] = __uint_as_float(qw[w] << 16); q[2 * w + 1] = __uint_as_float(qw[w] & 0xffff0000u); ss += q[2 * w] * q[2 * w] + q[2 * w + 1] * q[2 * w + 1]; }
            ss = fq_sum(ss);
            const float rstd = 0.125f * rsq(ss * (1.0f / 64.0f) + EPS);
#pragma unroll
            for (int kk = 0; kk < 2; ++kk) { float z[8];
#pragma unroll
                for (int j = 0; j < 8; ++j) z[j] = q[8 * kk + j] * rstd * F.q_norm_w[32 * kk + 8 * fq + j];
                v4u o; o.x = cvtpk(z[0], z[1]); o.y = cvtpk(z[2], z[3]); o.z = cvtpk(z[4], z[5]); o.w = cvtpk(z[6], z[7]); qf[kk] = __builtin_bit_cast(bf16x8, o); }
        }
        f32x4 sc[12]; float mx = -INFINITY;
#pragma unroll
        for (int nt = 0; nt < 12; ++nt) { f32x4 acc = (f32x4){0.f, 0.f, 0.f, 0.f};
#pragma unroll
            for (int kk = 0; kk < 2; ++kk) { const bf16x8 kf = *(const LAS bf16x8*)(Ks + (16 * nt + fr) * 72 + 32 * kk + 8 * fq); acc = __builtin_amdgcn_mfma_f32_16x16x32_bf16(kf, qf[kk], acc, 0, 0, 0); }
#pragma unroll
            for (int i = 0; i < 4; ++i) { const int s = t0 - 128 + 16 * nt + 4 * fq + i, dist = tq0 + fr - s; const bool ok = (s >= 0) && (dist >= 0) && (dist < 128);
                const float v = ok ? acc[i] - slope * (float)dist : -INFINITY; acc[i] = v; mx = fmaxf(mx, v); }
            sc[nt] = acc; if (nt & 1) __builtin_amdgcn_sched_barrier(0); }
        mx = fmaxf(fq_max(mx), sink);
        float sum = 0.f;
#pragma unroll
        for (int nt = 0; nt < 12; ++nt)
#pragma unroll
            for (int i = 0; i < 4; ++i) { const float p = __expf(sc[nt][i] - mx); sc[nt][i] = p; sum += p; }
        sum = fq_sum(sum);
        const float den = sum + __expf(sink - mx);
        bf16x8 pf[6];
#pragma unroll
        for (int ks = 0; ks < 6; ++ks) pf[ks] = pack8(sc[2 * ks], sc[2 * ks + 1]);
        float rden[4];
#pragma unroll
        for (int i = 0; i < 4; ++i) rden[i] = __builtin_amdgcn_rcpf(__shfl(den, 4 * fq + i));
        bf16* op = F.MIX + (row0 + tq0 + 4 * fq) * D + 512 + hq * 64 + fr;
#pragma unroll 1
        for (int dt = 0; dt < 4; ++dt) { f32x4 oacc = (f32x4){0.f, 0.f, 0.f, 0.f};
#pragma unroll
            for (int ks = 0; ks < 6; ++ks) { const LAS bf16* vp = Vt + (16 * dt + fr) * 196 + 32 * ks + 4 * fq;
                const unsigned long long lo = *(const LAS unsigned long long*)vp, hi = *(const LAS unsigned long long*)(vp + 16);
                v4u vv; vv.x = (unsigned)lo; vv.y = (unsigned)(lo >> 32); vv.z = (unsigned)hi; vv.w = (unsigned)(hi >> 32);
                oacc = __builtin_amdgcn_mfma_f32_16x16x32_bf16(pf[ks], __builtin_bit_cast(bf16x8, vv), oacc, 0, 0, 0); }
#pragma unroll
            for (int i = 0; i < 4; ++i) op[(size_t)i * D + 16 * dt] = (bf16)f2bf(oacc[i] * rden[i]); }
    }
    __syncthreads();
}
__device__ __forceinline__ void p3a_prep(Frame& F) {
    LAS unsigned char* wl = F.lds + RING_OFF + F.wave * 19456;
    const int gw = F.vcu * NWAVES + F.wave, NGW = F.G * NWAVES;
    for (int ci = gw; ci < BATCH * 8 * (T / 64); ci += NGW) gdn_prep_chunk(F, ci, wl);
}
__device__ __forceinline__ void p3b_mixers(Frame& F) {
    const int bx = blockIdx.x;
    if (bx < 32) gdn_scan(F, bx);
    else for (int u = bx - 32; u < BATCH * 2 * (T / 64); u += F.G - 32) swa_unit(F, u, F.lds + RING_OFF);
}

struct Args { const float* in[18]; float* out; unsigned char* ws; };
__global__ void __launch_bounds__(NWAVES * 64, 2) hymba_fwd(Args args) {
    extern __shared__ __attribute__((aligned(16))) unsigned char lds[];
    Frame F;
    F.lds = (LAS unsigned char*)lds;
    F.MISC = (volatile LAS unsigned*)(F.lds + MISC_OFF);
    F.tid = threadIdx.x; F.lane = F.tid & 63; F.wave = __builtin_amdgcn_readfirstlane(F.tid >> 6);
    F.G = gridDim.x; { const int bx = blockIdx.x; F.vcu = (F.G % 8 == 0) ? (bx % 8) * (F.G / 8) + bx / 8 : bx; }
    unsigned char* ws = args.ws;
    F.ctl = (gu32*)(ws + WS_CTL);
    F.x = args.in[0]; F.c = args.in[1]; F.w_ada = args.in[2]; F.b_ada = args.in[3]; F.norm1_w = args.in[4]; F.w_in = args.in[5]; F.conv_w = args.in[6];
    F.a_log = args.in[7]; F.dt_bias = args.in[8]; F.gdn_norm_w = args.in[9]; F.q_norm_w = args.in[10]; F.k_norm_w = args.in[11]; F.sinks = args.in[12];
    F.w_out = args.in[13]; F.norm2_w = args.in[14]; F.w_gate = args.in[15]; F.w_up = args.in[16]; F.w_down = args.in[17]; F.out = args.out;
    F.modacc = (float*)(ws + WS_CTL) + CW_MODACC; F.modf = (float*)(ws + WS_MODF);
    F.Win_t = (bf16*)(ws + WS_WIN); F.Wout_t = (bf16*)(ws + WS_WOUT); F.Wgu_t = (bf16*)(ws + WS_WGU); F.Wdn_t = (bf16*)(ws + WS_WDN);
    F.H = (bf16*)(ws + WS_H); F.PQ = (bf16*)(ws + WS_PQ); F.MIX = (bf16*)(ws + WS_MIX); F.CHKA = (bf16*)(ws + WS_CHKA); F.CHKU = (bf16*)(ws + WS_H); F.X1B = (bf16*)(ws + WS_CHKA); F.CHKT = (bf16*)(ws + WS_CHKA + 32 * MiB); F.ORAW = (bf16*)(ws + WS_CHKA + 32 * MiB); F.dec = (float*)(ws + WS_DEC);
    for (int u = F.tid; u < (LDS_BYTES - LDSCTL_OFF) / 4; u += NWAVES * 64) ((LAS unsigned*)(F.lds + LDSCTL_OFF))[u] = 0u;
    __syncthreads();
    XcdBarrier bar = xcd_barrier_post((unsigned*)(F.ctl + CW_BAR), F.MISC + 8);
#define GRID_BAR() do { xcd_barrier(bar); int t_ = F.tid; asm volatile("" : "+v"(t_)); F.tid = t_; F.lane = t_ & 63; } while (0)

    p0_prologue(F);
    norm_phase<1>(F); GRID_BAR();
    { pg8::Gemm g{F.H, F.Win_t, M, NP, D}; pg8::StaticOrder S; S.init(M, NP, F.G, (int)blockIdx.x);
      pg8::EpiBf16Plain E{F.PQ, NP, C_GZ / 256, C_SQ / 256};
      pg8::gemm_phase<pg8::EpiBf16Plain, pg8::StaticOrder, true, true>(F.lds + RING_OFF, g, S, E); }
    GRID_BAR();
    p3a_prep(F); GRID_BAR();
    p3b_mixers(F); GRID_BAR();
    { pg8::Gemm g{F.MIX, F.Wout_t, M, D, D}; pg8::StaticOrder S; S.init(M, D, F.G, (int)blockIdx.x);
      { pg8::Unit u0; for (int i = 0; S.next(i, u0); ++i) gdn_norm_rows(F, u0.pm * 256); }
      pg8::EpiGateResToBf16 E{F.x, F.X1B, D, F.modf + 2 * D, 6 * D, T};
      pg8::gemm_phase<pg8::EpiGateResToBf16, pg8::StaticOrder, true, true>(F.lds + RING_OFF, g, S, E); }
    GRID_BAR();
    norm_phase<2>(F); GRID_BAR();
    { pg8::Gemm g{F.H, F.Wgu_t, M, NGU, D}; pg8::StaticOrder S; S.init(M, NGU, F.G, (int)blockIdx.x);
      pg8::EpiSwiGLU E{F.PQ, FF};
      pg8::gemm_phase<pg8::EpiSwiGLU, pg8::StaticOrder, true, true>(F.lds + RING_OFF, g, S, E); }
    GRID_BAR();
    { pg8::Gemm g{F.PQ, F.Wdn_t, M, D, FF}; pg8::StaticOrder S; S.init(M, D, F.G, (int)blockIdx.x);
      pg8::EpiGateResFromBf16 E{F.X1B, F.out, D, F.modf + 5 * D, 6 * D, T};
      pg8::gemm_phase<pg8::EpiGateResFromBf16, pg8::StaticOrder, true, true>(F.lds + RING_OFF, g, S, E); }
#undef GRID_BAR
}

extern "C" void kernel_launch(void* const* d_in, const int* in_sizes, int n_in, void* d_out, int out_size, void* d_ws, size_t ws_size, hipStream_t stream) {
    static int grid = 0;
    if (grid == 0) {
        if (n_in != 18 || in_sizes[0] != M * D || out_size != M * D || ws_size < WS_END) { fprintf(stderr, "kernel_launch: unexpected shapes (n_in %d, in0 %d, out %d, ws %zu); nothing launched\n", n_in, n_in > 0 ? in_sizes[0] : -1, out_size, ws_size); grid = -1; return; }
        int dev = 0, cus = 0;
        if (hipGetDevice(&dev) != hipSuccess || hipDeviceGetAttribute(&cus, hipDeviceAttributeMultiprocessorCount, dev) != hipSuccess) { grid = -1; return; }
        if (hipFuncSetAttribute((const void*)hymba_fwd, hipFuncAttributeMaxDynamicSharedMemorySize, LDS_BYTES) != hipSuccess) { fprintf(stderr, "kernel_launch: hipFuncSetAttribute failed\n"); grid = -1; return; }
        (void)hipGetLastError();
        grid = cus;
    }
    if (grid < 0) return;
    if (hipMemsetAsync((char*)d_ws + WS_CTL, 0, CTL_ZERO_BYTES, stream) != hipSuccess) { fprintf(stderr, "kernel_launch: hipMemsetAsync failed\n"); return; }
    Args a{};
    for (int i = 0; i < 18; ++i) a.in[i] = (const float*)d_in[i];
    a.out = (float*)d_out; a.ws = (unsigned char*)d_ws;
    hipLaunchKernelGGL(hymba_fwd, dim3(grid), dim3(NWAVES * 64), LDS_BYTES, stream, a);
    const hipError_t le = hipPeekAtLastError();
    if (le != hipSuccess) fprintf(stderr, "kernel_launch: launch failed: %s\n", hipGetErrorName(le));
}
```

```cpp
#include <hip/hip_runtime.h>
#include <cstdio>
#include <cstdint>
#include <cmath>
namespace pg8 {
#define PG8_LAS __attribute__((address_space(3)))
typedef unsigned short bf16_t;
typedef short bf16x8 __attribute__((ext_vector_type(8)));
typedef float f32x4 __attribute__((ext_vector_type(4)));
typedef unsigned u32x4 __attribute__((ext_vector_type(4)));
constexpr int BM = 256, BK = 64, HALF = 128, HTB = HALF * BK * 2  , STAGE_BYTES = 8 * HTB, NXCD = 8, WGM = 8;

__host__ __device__ __forceinline__ int lds_byte(int r, int c) { const int st = (r >> 4) * 2 + (c >> 5), rr = r & 15, cc = c & 31, ob = rr * 64 + cc * 2; return st * 1024 + (ob ^ (((ob >> 9) & 1) << 5)); }
__host__ __device__ __forceinline__ void stage_rc(int b, int& R, int& C) { const int st = b / 1024, sb = b % 1024, swz = sb ^ (((sb >> 9) & 1) << 5); R = (st >> 1) * 16 + swz / 64; C = (st & 1) * 32 + (swz % 64) / 2; }
__host__ __device__ __forceinline__ int perm32(int rho) { const int n = rho >> 4, i = rho & 15; return 8 * (i >> 2) + 4 * n + (i & 3); }

struct Unit { int pm, pn; };
struct Gemm { const bf16_t* A; const bf16_t* Bt; int M, N, K; };

struct StaticOrder {
    int nM, nN, nwg, G, c;
    __host__ __device__ void init(int M, int N, int G_, int c_) { nM = M / BM; nN = N / BM; nwg = nM * nN; G = G_; c = c_; }
    __host__ __device__ bool next(int i, Unit& u) const {
        const long L = (long)i * G + c; if (L >= nwg) return false;
        int wgid = (int)L; { const int q = nwg / NXCD, r = nwg % NXCD, xcd = wgid % NXCD, off = wgid / NXCD; wgid = (xcd < r ? xcd * (q + 1) : r * (q + 1) + (xcd - r) * q) + off; }
        const int nig = WGM * nN, gid = wgid / nig, fm = gid * WGM, gsz = (nM - fm) < WGM ? (nM - fm) : WGM;
        u.pm = fm + ((wgid % nig) % gsz); u.pn = (wgid % nig) / gsz; return true;
    }
    __device__ __forceinline__ void a_ready(const Unit&) const {}
    __device__ __forceinline__ void done(const Unit&) const {}
};

__device__ __forceinline__ unsigned cvt_pk_bf16(float lo, float hi) { unsigned r; asm volatile("v_cvt_pk_bf16_f32 %0, %1, %2" : "=v"(r) : "v"(lo), "v"(hi)); return r; }
__device__ __forceinline__ float silu_f(float x) { return x * __builtin_amdgcn_rcpf(1.0f + __expf(-x)); }

struct EpiBf16Plain {
    static constexpr bool PERM = true, AFTER_DRAIN = false;
    bf16_t* O; int ldc; int silu_lo, silu_hi;
    __device__ __forceinline__ void operator()(const f32x4 (&acc)[2][2][4][2], const Unit& u, int wr, int wc, int fr, int fq) const {
        const int row0 = u.pm * BM + wr * 64 + fr, col0 = u.pn * BM + wc * 32 + 8 * fq;
        const bool act = (u.pn >= silu_lo) && (u.pn < silu_hi);
#pragma unroll
        for (int ai = 0; ai < 2; ++ai)
#pragma unroll
            for (int m = 0; m < 4; ++m) { bf16_t* rowp = O + (size_t)(row0 + ai * HALF + m * 16) * ldc + col0;
#pragma unroll
                for (int bj = 0; bj < 2; ++bj) { f32x4 v0 = acc[ai][bj][m][0], v1 = acc[ai][bj][m][1];
                    if (act) {
#pragma unroll
                        for (int i = 0; i < 4; ++i) { v0[i] = silu_f(v0[i]); v1[i] = silu_f(v1[i]); } }
                    u32x4 w; w.x = cvt_pk_bf16(v0[0], v0[1]); w.y = cvt_pk_bf16(v0[2], v0[3]); w.z = cvt_pk_bf16(v1[0], v1[1]); w.w = cvt_pk_bf16(v1[2], v1[3]);
                    *(u32x4*)(rowp + bj * HALF) = w; } }
    }
};
struct EpiSwiGLU {
    static constexpr bool PERM = true, AFTER_DRAIN = false;
    bf16_t* O; int ldc;
    __device__ __forceinline__ void operator()(const f32x4 (&acc)[2][2][4][2], const Unit& u, int wr, int wc, int fr, int fq) const {
        const int row0 = u.pm * BM + wr * 64 + fr, col0 = u.pn * HALF + wc * 32 + 8 * fq;
#pragma unroll
        for (int ai = 0; ai < 2; ++ai)
#pragma unroll
            for (int m = 0; m < 4; ++m) { bf16_t* rowp = O + (size_t)(row0 + ai * HALF + m * 16) * ldc + col0;
                const f32x4 g0 = acc[ai][0][m][0], g1 = acc[ai][0][m][1], u0 = acc[ai][1][m][0], u1 = acc[ai][1][m][1];
                float a[8];
#pragma unroll
                for (int i = 0; i < 4; ++i) { a[i] = silu_f(g0[i]) * u0[i]; a[4 + i] = silu_f(g1[i]) * u1[i]; }
                u32x4 w; w.x = cvt_pk_bf16(a[0], a[1]); w.y = cvt_pk_bf16(a[2], a[3]); w.z = cvt_pk_bf16(a[4], a[5]); w.w = cvt_pk_bf16(a[6], a[7]);
                *(u32x4*)rowp = w; }
    }
};
struct EpiGateResToBf16 {
    static constexpr bool PERM = false, AFTER_DRAIN = false;
    const float* base; bf16_t* out; int ldc; const float* gate; int gstride; int rows_per_batch;
    __device__ __forceinline__ void operator()(const f32x4 (&acc)[2][2][4][2], const Unit& u, int wr, int wc, int fr, int fq) const {
        const int row0 = u.pm * BM + wr * 64 + fr, col0 = u.pn * BM + wc * 32 + 4 * fq;
        const float* gp = gate + (size_t)((u.pm * BM) / rows_per_batch) * gstride + col0;
        f32x4 gv[2][2];
#pragma unroll
        for (int bj = 0; bj < 2; ++bj)
#pragma unroll
            for (int n = 0; n < 2; ++n) gv[bj][n] = *(const f32x4*)(gp + bj * HALF + n * 16);
#pragma unroll
        for (int ai = 0; ai < 2; ++ai)
#pragma unroll
            for (int m = 0; m < 4; ++m) { const size_t off = (size_t)(row0 + ai * HALF + m * 16) * ldc + col0;
#pragma unroll
                for (int bj = 0; bj < 2; ++bj)
#pragma unroll
                    for (int n = 0; n < 2; ++n) { const f32x4 o = *(const f32x4*)(base + off + bj * HALF + n * 16) + gv[bj][n] * acc[ai][bj][m][n];
                        *(unsigned long long*)(out + off + bj * HALF + n * 16) = (unsigned long long)cvt_pk_bf16(o[0], o[1]) | ((unsigned long long)cvt_pk_bf16(o[2], o[3]) << 32); } }
    }
};
struct EpiGateResFromBf16 {
    static constexpr bool PERM = false, AFTER_DRAIN = false;
    const bf16_t* base; float* out; int ldc; const float* gate; int gstride; int rows_per_batch;
    __device__ __forceinline__ void operator()(const f32x4 (&acc)[2][2][4][2], const Unit& u, int wr, int wc, int fr, int fq) const {
        const int row0 = u.pm * BM + wr * 64 + fr, col0 = u.pn * BM + wc * 32 + 4 * fq;
        const float* gp = gate + (size_t)((u.pm * BM) / rows_per_batch) * gstride + col0;
        f32x4 gv[2][2];
#pragma unroll
        for (int bj = 0; bj < 2; ++bj)
#pragma unroll
            for (int n = 0; n < 2; ++n) gv[bj][n] = *(const f32x4*)(gp + bj * HALF + n * 16);
#pragma unroll
        for (int ai = 0; ai < 2; ++ai)
#pragma unroll
            for (int m = 0; m < 4; ++m) { const size_t off = (size_t)(row0 + ai * HALF + m * 16) * ldc + col0;
#pragma unroll
                for (int bj = 0; bj < 2; ++bj)
#pragma unroll
                    for (int n = 0; n < 2; ++n) { const unsigned long long bb = *(const unsigned long long*)(base + off + bj * HALF + n * 16); const unsigned lo = (unsigned)bb, hi = (unsigned)(bb >> 32);
                        const f32x4 bs = (f32x4){__uint_as_float(lo << 16), __uint_as_float(lo & 0xffff0000u), __uint_as_float(hi << 16), __uint_as_float(hi & 0xffff0000u)};
                        *(f32x4*)(out + off + bj * HALF + n * 16) = bs + gv[bj][n] * acc[ai][bj][m][n]; } }
    }
};

template <class Epi, class Sched, bool ALIGN_EPI = false, bool SP2 = false>
__device__ __forceinline__ void gemm_phase(PG8_LAS unsigned char* lds, const Gemm g, const Sched& S, const Epi& E, int tid_in) {
    int tid_ = tid_in; asm volatile("" : "+v"(tid_));
    const int tid = tid_, wid = __builtin_amdgcn_readfirstlane(tid >> 6), lane = tid & 63, wr = wid >> 2, wc = wid & 3, fr = lane & 15, fq = lane >> 4;
    const int K = g.K, nt = K / BK;
    unsigned voffA[2], voffB[2];
#pragma unroll
    for (int i = 0; i < 2; ++i) { int R, C; stage_rc(tid * 16 + i * 8192, R, C); const int Rb = Epi::PERM ? ((R & ~31) + perm32(R & 31)) : R;
        voffA[i] = (unsigned)(R * K + C) * 2u; voffB[i] = (unsigned)(Rb * K + C) * 2u; }
    const size_t kstep = (size_t)(BK * 2);
    const size_t hstep = (size_t)HALF * K * 2;
    const size_t tstep = 2 * hstep;
    const unsigned ldsw = (unsigned)wid * 1024u;
    const int aoff = lds_byte(wr * 64 + fr, fq * 8), boff = lds_byte(wc * 32 + fr, fq * 8);
#define PG8_SA(b, h) (((b) * 2 + (h)) * HTB)
#define PG8_SB(b, h) ((4 + (b) * 2 + (h)) * HTB)
#define PG8_STAGE(bufoff, gbase, voff) do { _Pragma("unroll") for (int _i = 0; _i < 2; ++_i) \
        __builtin_amdgcn_global_load_lds((const unsigned*)((const char*)(gbase) + (voff)[_i]), (PG8_LAS unsigned*)(lds + (bufoff) + ldsw + _i * 8192), 16, 0, 0); } while (0)
#define PG8_LDA(dst, b, h) do { _Pragma("unroll") for (int m = 0; m < 4; ++m) _Pragma("unroll") for (int k = 0; k < 2; ++k) dst[m][k] = *(const PG8_LAS bf16x8*)(lds + PG8_SA(b, h) + aoff + m * 2048 + k * 1024); } while (0)
#define PG8_LDB(dst, b, h) do { _Pragma("unroll") for (int n = 0; n < 2; ++n) _Pragma("unroll") for (int k = 0; k < 2; ++k) dst[n][k] = *(const PG8_LAS bf16x8*)(lds + PG8_SB(b, h) + boff + n * 2048 + k * 1024); } while (0)
#define PG8_MMA(ai, bj, At, Bt) do { __builtin_amdgcn_s_setprio(1); _Pragma("unroll") for (int m = 0; m < 4; ++m) _Pragma("unroll") for (int n = 0; n < 2; ++n) _Pragma("unroll") for (int k = 0; k < 2; ++k) \
        acc[ai][bj][m][n] = __builtin_amdgcn_mfma_f32_16x16x32_bf16(Bt[n][k], At[m][k], acc[ai][bj][m][n], 0, 0, 0); __builtin_amdgcn_s_setprio(0); } while (0)
#define PG8_WAIT_V(n) asm volatile("s_waitcnt vmcnt(" #n ")" ::: "memory")
#define PG8_WAIT_L(n) asm volatile("s_waitcnt lgkmcnt(" #n ")" ::: "memory")
#define PG8_BAR __builtin_amdgcn_s_barrier()
#define PG8_SCHED __builtin_amdgcn_sched_barrier(0)
    Unit cur, nxt; int ui = 0;
    if (!S.next(0, cur)) return;
    f32x4 acc[2][2][4][2];
#pragma unroll
    for (int a = 0; a < 2; ++a)
#pragma unroll
        for (int b = 0; b < 2; ++b)
#pragma unroll
            for (int m = 0; m < 4; ++m)
#pragma unroll
                for (int n = 0; n < 2; ++n) acc[a][b][m][n] = (f32x4){0.f, 0.f, 0.f, 0.f};
    bf16x8 At[4][2], B0[2][2], B1[2][2];
    const char* cA = (const char*)g.A + (size_t)cur.pm * tstep; const char* cB = (const char*)g.Bt + (size_t)cur.pn * tstep;
    S.a_ready(cur);
    if constexpr (SP2) {
        PG8_STAGE(PG8_SB(0, 0), cB, voffB); PG8_STAGE(PG8_SB(0, 1), cB + hstep, voffB); PG8_STAGE(PG8_SA(0, 0), cA, voffA); PG8_STAGE(PG8_SA(0, 1), cA + hstep, voffA);
        if (wr == 1) PG8_BAR;
        PG8_WAIT_V(2); PG8_BAR;
        PG8_STAGE(PG8_SB(1, 0), cB + kstep, voffB); PG8_STAGE(PG8_SA(1, 0), cA + kstep, voffA); PG8_STAGE(PG8_SB(1, 1), cB + hstep + kstep, voffB);
        PG8_WAIT_V(6); PG8_BAR;
    } else {
        PG8_STAGE(PG8_SB(0, 0), cB, voffB); PG8_STAGE(PG8_SA(0, 0), cA, voffA); PG8_STAGE(PG8_SB(0, 1), cB + hstep, voffB); PG8_STAGE(PG8_SA(0, 1), cA + hstep, voffA);
        if (wr == 1) PG8_BAR;
        PG8_WAIT_V(4); PG8_BAR;
        PG8_STAGE(PG8_SB(1, 0), cB + kstep, voffB); PG8_STAGE(PG8_SA(1, 0), cA + kstep, voffA); PG8_STAGE(PG8_SB(1, 1), cB + hstep + kstep, voffB);
        PG8_WAIT_V(6); PG8_BAR;
    }
    for (;;) {
        const bool has_next = S.next(ui + 1, nxt);
        const char* nA = has_next ? (const char*)g.A + (size_t)nxt.pm * tstep : cA; const char* nB = has_next ? (const char*)g.Bt + (size_t)nxt.pn * tstep : cB;
        for (int t = 0; t < nt; t += 2) {
            const bool last = (t == nt - 2);
            const char* a1 = cA + (size_t)(t + 1) * kstep;
            const char* a2 = last ? nA : cA + (size_t)(t + 2) * kstep; const char* b2 = last ? nB : cB + (size_t)(t + 2) * kstep;
            const char* a3 = a2 + kstep; const char* b3 = b2 + kstep;
            if (last && has_next) S.a_ready(nxt);
            if constexpr (SP2) {
            PG8_LDB(B0, 0, 0); PG8_LDB(B1, 0, 1); PG8_SCHED; PG8_LDA(At, 0, 0); PG8_STAGE(PG8_SA(1, 1), a1 + hstep, voffA);
            PG8_WAIT_V(8); PG8_WAIT_L(0); PG8_BAR; PG8_MMA(0, 0, At, B0); PG8_MMA(0, 1, At, B1); PG8_BAR; PG8_SCHED;
            PG8_LDA(At, 0, 1); PG8_STAGE(PG8_SB(0, 0), b2, voffB); PG8_STAGE(PG8_SB(0, 1), b2 + hstep, voffB); PG8_STAGE(PG8_SA(0, 0), a2, voffA);
            PG8_WAIT_V(8); PG8_WAIT_L(0); PG8_BAR; PG8_MMA(1, 0, At, B0); PG8_MMA(1, 1, At, B1); PG8_BAR; PG8_SCHED;
            PG8_LDB(B0, 1, 0); PG8_LDB(B1, 1, 1); PG8_SCHED; PG8_LDA(At, 1, 0); PG8_STAGE(PG8_SA(0, 1), a2 + hstep, voffA);
            PG8_WAIT_V(8); PG8_WAIT_L(0); PG8_BAR; PG8_MMA(0, 0, At, B0); PG8_MMA(0, 1, At, B1); PG8_BAR; PG8_SCHED;
            PG8_LDA(At, 1, 1); PG8_STAGE(PG8_SB(1, 0), b3, voffB); PG8_STAGE(PG8_SB(1, 1), b3 + hstep, voffB); PG8_STAGE(PG8_SA(1, 0), a3, voffA);
            PG8_WAIT_V(8); PG8_WAIT_L(0); PG8_BAR; PG8_MMA(1, 0, At, B0); PG8_MMA(1, 1, At, B1); PG8_BAR; PG8_SCHED;
            } else {
            PG8_LDB(B0, 0, 0); PG8_SCHED; PG8_LDA(At, 0, 0); PG8_STAGE(PG8_SA(1, 1), a1 + hstep, voffA);
            PG8_WAIT_L(8); PG8_BAR; PG8_WAIT_L(0); PG8_MMA(0, 0, At, B0); PG8_BAR; PG8_SCHED;
            PG8_LDB(B1, 0, 1); PG8_STAGE(PG8_SB(0, 0), b2, voffB);
            PG8_BAR; PG8_WAIT_L(0); PG8_MMA(0, 1, At, B1); PG8_BAR;
            PG8_LDA(At, 0, 1); PG8_STAGE(PG8_SA(0, 0), a2, voffA);
            PG8_BAR; PG8_WAIT_L(0); PG8_MMA(1, 0, At, B0); PG8_BAR; PG8_SCHED;
            PG8_STAGE(PG8_SB(0, 1), b2 + hstep, voffB);
            PG8_WAIT_V(6); PG8_BAR; PG8_MMA(1, 1, At, B1); PG8_BAR;
            PG8_LDB(B0, 1, 0); PG8_SCHED; PG8_LDA(At, 1, 0); PG8_STAGE(PG8_SA(0, 1), a2 + hstep, voffA);
            PG8_WAIT_L(8); PG8_BAR; PG8_WAIT_L(0); PG8_MMA(0, 0, At, B0); PG8_BAR; PG8_SCHED;
            PG8_LDB(B1, 1, 1); PG8_STAGE(PG8_SB(1, 0), b3, voffB);
            PG8_BAR; PG8_WAIT_L(0); PG8_MMA(0, 1, At, B1); PG8_BAR;
            PG8_LDA(At, 1, 1); PG8_STAGE(PG8_SA(1, 0), a3, voffA);
            PG8_BAR; PG8_WAIT_L(0); PG8_MMA(1, 0, At, B0); PG8_BAR; PG8_SCHED;
            PG8_STAGE(PG8_SB(1, 1), b3 + hstep, voffB);
            PG8_WAIT_V(6); PG8_BAR; PG8_MMA(1, 1, At, B1); PG8_BAR;
            }
        }
        if constexpr (ALIGN_EPI) { if (wr == 0) PG8_BAR; }
        if constexpr (!Epi::AFTER_DRAIN) { E(acc, cur, wr, wc, fr, fq); S.done(cur); }
        if (!has_next) break;
#pragma unroll
        for (int a = 0; a < 2; ++a)
#pragma unroll
            for (int b = 0; b < 2; ++b)
#pragma unroll
                for (int m = 0; m < 4; ++m)
#pragma unroll
                    for (int n = 0; n < 2; ++n) acc[a][b][m][n] = (f32x4){0.f, 0.f, 0.f, 0.f};
        cur = nxt; cA = nA; cB = nB; ++ui;
        if constexpr (ALIGN_EPI) { if (wr == 1) PG8_BAR; }
    }
    PG8_WAIT_V(0);
    if constexpr (!ALIGN_EPI) { if (wr == 0) PG8_BAR; }
    PG8_BAR;
    if constexpr (Epi::AFTER_DRAIN) { E.fused(acc, cur, wr, wc, fr, fq, lds, wid, lane); S.done(cur); }
#undef PG8_SA
#undef PG8_SB
#undef PG8_STAGE
#undef PG8_LDA
#undef PG8_LDB
#undef PG8_MMA
#undef PG8_WAIT_V
#undef PG8_WAIT_L
#undef PG8_BAR
#undef PG8_SCHED
}
}
constexpr int NWAVES = 8;
constexpr int BATCH = 4, T = 4096, D = 1024, M = BATCH * T;
constexpr int PROJ_W = 2832, NP = 3072, FF = 2816, NGU = 2 * FF, HD = 64;
constexpr int C_GQ = 0, C_GK = 512, C_GV = 1024, C_GZ = 1536, C_SQ = 2048, C_SK = 2560, C_SV = 2688, C_GA = 2816, C_GB = 2824;
constexpr float EPS = 1e-6f;
constexpr size_t MiB = 1u << 20;
constexpr size_t WS_CTL = 0, CTL_ZERO_BYTES = 256 * 1024;
constexpr size_t WS_MODF = 1 * MiB;
constexpr size_t WS_DEC = 1 * MiB + 384 * 1024;
constexpr size_t WS_WIN = 4 * MiB, WS_WOUT = 10 * MiB, WS_WGU = 12 * MiB, WS_WDN = 24 * MiB;
constexpr size_t WS_H = 32 * MiB;
constexpr size_t WS_PQ = 64 * MiB;
constexpr size_t WS_MIX = 160 * MiB;
constexpr size_t WS_CHKA = 192 * MiB;
constexpr size_t WS_END = 256 * MiB;
constexpr int CW_ADA = 1024;
constexpr int CW_BAR = 4096;
constexpr int CW_MODACC = 16384;
constexpr int RING_OFF = 0, RING_BYTES = 131072;
constexpr int LDS_BYTES = 163840;
constexpr int LDSCTL_OFF = LDS_BYTES - 1024, MISC_OFF = LDSCTL_OFF + 320;
#define GAS __attribute__((address_space(1)))
#define LAS __attribute__((address_space(3)))
typedef unsigned short bf16;
typedef unsigned v4u __attribute__((ext_vector_type(4)));
typedef float f32x4 __attribute__((ext_vector_type(4)));
typedef short bf16x8 __attribute__((ext_vector_type(8)));
typedef GAS unsigned gu32;
typedef GAS unsigned long long gu64;
#define RLX_AGENT __ATOMIC_RELAXED, __HIP_MEMORY_SCOPE_AGENT
#define LDS_WAIT() asm volatile("s_waitcnt lgkmcnt(0)" ::: "memory")
#define VM_WAIT() asm volatile("s_waitcnt vmcnt(0)" ::: "memory")
__device__ __forceinline__ unsigned long long rt() { return __builtin_amdgcn_s_memrealtime(); }
__device__ __forceinline__ unsigned f2bf(float f) { unsigned u = __builtin_bit_cast(unsigned, f); return (u + 0x7fffu + ((u >> 16) & 1u)) >> 16; }
__device__ __forceinline__ unsigned pk2(float lo, float hi) { return f2bf(lo) | (f2bf(hi) << 16); }

#define XB_TMO      128
#define XB_XCNT(j)  (256  + 64 * (j))
#define XB_XSUB(j)  (1280 + 64 * (j))
#define XB_XGEN(j)  (2304 + 64 * (j))
#define XB_TOP      3328
#define XB_TOPGEN   3392
#define XCD_BAR_WORDS 3456
#define XB_SPIN_CAP (1u << 22)

__device__ __forceinline__ unsigned xb_ld(unsigned* p)              { return __hip_atomic_load(p, __ATOMIC_RELAXED, __HIP_MEMORY_SCOPE_AGENT); }
__device__ __forceinline__ unsigned xb_add(unsigned* p, unsigned v) { return __hip_atomic_fetch_add(p, v, __ATOMIC_RELAXED, __HIP_MEMORY_SCOPE_AGENT); }
__device__ __forceinline__ unsigned xb_xcc_id() { return (unsigned)__builtin_amdgcn_s_getreg((3 << 11) | 20) & 0xFu; }
#define XB_SPIN(cond, bar) do { unsigned _sp = 0; while (cond) { __builtin_amdgcn_s_sleep(1); \
    if ((++_sp & 255u) == 0u) { if (xb_ld(&(bar)[XB_TMO])) break; if (_sp > XB_SPIN_CAP) { atomicAdd(&(bar)[XB_TMO], 1u); break; } } } } while (0)

struct XcdBarrier {
    unsigned* bar; unsigned x;
    volatile LAS unsigned* st;
};

__device__ __forceinline__ XcdBarrier xcd_barrier_post(unsigned* bar, volatile LAS unsigned* st) {
    XcdBarrier b; b.bar = bar; b.x = xb_xcc_id(); b.st = st;
    if (threadIdx.x == 0) (void)xb_add(&bar[XB_XCNT(b.x)], 1u);
    return b;
}
__device__ __forceinline__ void xcd_barrier_complete(unsigned* bar, unsigned x, unsigned& nloc, unsigned& nx) {
    const unsigned G = gridDim.x * gridDim.y * gridDim.z;
    unsigned sum, cnt, mine, sp = 0u;
    for (;;) {
        sum = 0u; cnt = 0u; mine = 0u;
#pragma unroll
        for (unsigned j = 0; j < 16; ++j) { const unsigned c = xb_ld(&bar[XB_XCNT(j)]); sum += c; cnt += (c > 0u) ? 1u : 0u; mine = (j == x) ? c : mine; }
        if (sum == G) break;
        __builtin_amdgcn_s_sleep(1);
        if ((++sp & 255u) == 0u) { if (xb_ld(&bar[XB_TMO])) break; if (sp > XB_SPIN_CAP) { atomicAdd(&bar[XB_TMO], 1u); break; } }
    }
    nloc = mine > 0u ? mine : 1u; nx = cnt > 0u ? cnt : 1u;
}

__device__ __forceinline__ void xcd_barrier(const XcdBarrier& b, int tid  ) {
    asm volatile("s_waitcnt vmcnt(0)" ::: "memory");
    __syncthreads();
    if (tid == 0) {
        unsigned* bar = b.bar;
        __builtin_amdgcn_s_waitcnt(0);
        unsigned nloc = b.st[0], nx = b.st[1];
        if (nloc == 0u) { xcd_barrier_complete(bar, b.x, nloc, nx); b.st[0] = nloc; b.st[1] = nx; }
        const unsigned old = xb_add(&bar[XB_XSUB(b.x)], 1u);
        const unsigned gen = old / nloc;
        if (old + 1u == (gen + 1u) * nloc) {
            __builtin_amdgcn_fence(__ATOMIC_RELEASE, "agent");
            asm volatile("s_waitcnt vmcnt(0)" ::: "memory");
            const unsigned og = xb_add(&bar[XB_TOP], 1u);
            const unsigned tg = og / nx;
            if (og + 1u == (tg + 1u) * nx) xb_add(&bar[XB_TOPGEN], 1u);
            else XB_SPIN(xb_ld(&bar[XB_TOPGEN]) == tg, bar);
            __builtin_amdgcn_fence(__ATOMIC_ACQUIRE, "agent");
            xb_add(&bar[XB_XGEN(b.x)], 1u);
            asm volatile("s_waitcnt vmcnt(0)" ::: "memory");
        } else {
            XB_SPIN(xb_ld(&bar[XB_XGEN(b.x)]) == gen, bar);
            __builtin_amdgcn_fence(__ATOMIC_ACQUIRE, "agent");
            asm volatile("s_waitcnt vmcnt(0)" ::: "memory");
        }
    }
    __syncthreads();
}
struct Frame {
    LAS unsigned char* lds;
    volatile LAS unsigned* MISC;
    gu32* ctl;
    int tid, lane, wave;
    int vcu, G;
    const float *x, *c, *w_ada, *b_ada, *norm1_w, *w_in, *conv_w, *a_log, *dt_bias, *gdn_norm_w, *q_norm_w, *k_norm_w, *sinks, *w_out, *norm2_w, *w_gate, *w_up, *w_down;
    float* out;
    float *modacc, *modf, *dec;
    bf16 *Win_t, *Wout_t, *Wgu_t, *Wdn_t, *H, *PQ, *MIX, *X1B, *CHKA, *CHKU, *CHKT, *ORAW;
};
template <int CTRL, int ROWMASK, bool BC>
__device__ __forceinline__ float dpp_mov(float v) { return __int_as_float(__builtin_amdgcn_update_dpp(0, __float_as_int(v), CTRL, ROWMASK, 0xF, BC)); }
__device__ __forceinline__ float sum8(float v) { v += dpp_mov<0xB1, 0xF, true>(v); v += dpp_mov<0x4E, 0xF, true>(v); v += dpp_mov<0x141, 0xF, true>(v); return v; }
__device__ __forceinline__ float wave_sum(float v) {
    v = sum8(v); v += dpp_mov<0x140, 0xF, true>(v);
    v += dpp_mov<0x142, 0xA, false>(v); v += dpp_mov<0x143, 0xC, false>(v);
    return __int_as_float(__builtin_amdgcn_readlane(__float_as_int(v), 63));
}
__device__ __forceinline__ float fq_sum(float v) {
    auto r = __builtin_amdgcn_permlane16_swap(__float_as_uint(v), __float_as_uint(v), false, false); v = __uint_as_float(r[0]) + __uint_as_float(r[1]);
    auto s = __builtin_amdgcn_permlane32_swap(__float_as_uint(v), __float_as_uint(v), false, false); return __uint_as_float(s[0]) + __uint_as_float(s[1]);
}
__device__ __forceinline__ float fq_max(float v) {
    auto r = __builtin_amdgcn_permlane16_swap(__float_as_uint(v), __float_as_uint(v), false, false); v = fmaxf(__uint_as_float(r[0]), __uint_as_float(r[1]));
    auto s = __builtin_amdgcn_permlane32_swap(__float_as_uint(v), __float_as_uint(v), false, false); return fmaxf(__uint_as_float(s[0]), __uint_as_float(s[1]));
}
typedef float f32x2_t __attribute__((ext_vector_type(2))); typedef __bf16 bf16x2_t __attribute__((ext_vector_type(2)));
__device__ __forceinline__ unsigned cvtpk(float lo, float hi) { f32x2_t v = {lo, hi}; bf16x2_t b = __builtin_convertvector(v, bf16x2_t); return __builtin_bit_cast(unsigned, b); }
__device__ __forceinline__ float bf2f(bf16 h) { return __uint_as_float((unsigned)h << 16); }
__device__ __forceinline__ float ld_f32_coh(const float* p) { return __uint_as_float(__hip_atomic_load((const unsigned*)p, RLX_AGENT)); }
__device__ __forceinline__ float silu(float x) { return x * __builtin_amdgcn_rcpf(1.0f + __expf(-x)); }
__device__ __forceinline__ float rsq(float x) { return __builtin_amdgcn_rsqf(x); }

__device__ __forceinline__ void tr_item64(const float* W, int ldw, int src_col, bf16* WT, int K, int dst_row, int k0, LAS bf16* tl, int lane) {
    const int cg = lane & 15, rr = lane >> 4;
    f32x4 v[16];
#pragma unroll
    for (int i = 0; i < 16; ++i) v[i] = *(const GAS f32x4*)(W + (size_t)(k0 + 4 * i + rr) * ldw + src_col + 4 * cg);
#pragma unroll
    for (int i = 0; i < 16; ++i) *(LAS unsigned long long*)(tl + (4 * i + rr) * 68 + 4 * cg) = (unsigned long long)cvtpk(v[i].x, v[i].y) | ((unsigned long long)cvtpk(v[i].z, v[i].w) << 32);
    LDS_WAIT(); asm volatile("" ::: "memory");
#pragma unroll
    for (int ii = 0; ii < 8; ++ii) { const int p = lane + 64 * ii, n = p >> 3, kc = p & 7; const LAS bf16* s = tl + (8 * kc) * 68 + n;
        v4u o; o.x = (unsigned)s[0] | ((unsigned)s[68] << 16); o.y = (unsigned)s[2 * 68] | ((unsigned)s[3 * 68] << 16); o.z = (unsigned)s[4 * 68] | ((unsigned)s[5 * 68] << 16); o.w = (unsigned)s[6 * 68] | ((unsigned)s[7 * 68] << 16);
        *(GAS v4u*)(WT + (size_t)(dst_row + n) * K + k0 + 8 * kc) = o; }
    LDS_WAIT(); asm volatile("" ::: "memory");
}

__device__ __forceinline__ void p0_prologue(Frame& F) {
    LAS bf16* tl = (LAS bf16*)(F.lds + RING_OFF + F.wave * 16384);
    const int gw = F.vcu * NWAVES + F.wave, NGW = F.G * NWAVES, lane = F.lane;
    if ((int)blockIdx.x < 24 * 8) {
        const int ct = blockIdx.x % 24, kg = blockIdx.x / 24, col = ct * 256 + 4 * lane, k0 = kg * 128 + F.wave * 16;
        f32x4 w[16];
#pragma unroll
        for (int kk = 0; kk < 16; ++kk) w[kk] = *(const GAS f32x4*)(F.w_ada + (size_t)(k0 + kk) * (6 * D) + col);
        f32x4 acc[4];
#pragma unroll
        for (int b = 0; b < 4; ++b) acc[b] = (f32x4){0.f, 0.f, 0.f, 0.f};
#pragma unroll
        for (int kk = 0; kk < 16; ++kk)
#pragma unroll
            for (int b = 0; b < 4; ++b) acc[b] += silu(F.c[b * D + k0 + kk]) * w[kk];
        LAS f32x4* rd = (LAS f32x4*)(F.lds + RING_OFF + F.wave * 16384 + 12288);
#pragma unroll
        for (int b = 0; b < 4; ++b) rd[b * 64 + lane] = acc[b];
        __syncthreads();
#pragma unroll
        for (int j = 0; j < 2; ++j) { const int e = F.tid * 2 + j, bb = e >> 8, c = e & 255; float s = 0.f;
#pragma unroll
            for (int wv = 0; wv < 8; ++wv) s += ((const LAS float*)(F.lds + RING_OFF + wv * 16384 + 12288))[(bb * 64 + (c >> 2)) * 4 + (c & 3)];
            const float prev = atomicAdd(F.modacc + bb * (6 * D) + ct * 256 + c, s); asm volatile("" :: "v"(prev)); }
        __syncthreads();
        if (F.tid == 0) (void)xb_add((unsigned*)(F.ctl + CW_ADA), 1u);
    }
    constexpr int I_IN = 16 * (NP / 64), I_OUT = 16 * 16, I_GU = 16 * (NGU / 64), I_DN = (FF / 64) * 16;
    constexpr int NITEMS = I_IN + I_OUT + I_GU + I_DN;
    for (int it = gw; it < NITEMS; it += NGW) {
        int r = it;
        if (r < I_IN) { const int nb = r % (NP / 64), kb = r / (NP / 64), n0 = 64 * nb;
            tr_item64(F.w_in, PROJ_W, n0 < 2048 ? n0 : (n0 < 2816 ? n0 + 16 : (n0 == 2816 ? 2048 : 0)), F.Win_t, D, n0, 64 * kb, tl, lane); continue; }
        r -= I_IN;
        if (r < I_OUT) { const int nb = r % 16, kb = r / 16; tr_item64(F.w_out, D, 64 * nb, F.Wout_t, D, 64 * nb, 64 * kb, tl, lane); continue; }
        r -= I_OUT;
        if (r < I_GU) { const int nb = r % (NGU / 64), kb = r / (NGU / 64), n0 = 64 * nb, p = n0 >> 8, j = n0 & 255;
            if (j < 128) tr_item64(F.w_gate, FF, 128 * p + j, F.Wgu_t, D, n0, 64 * kb, tl, lane);
            else         tr_item64(F.w_up,   FF, 128 * p + j - 128, F.Wgu_t, D, n0, 64 * kb, tl, lane);
            continue; }
        r -= I_GU;
        { const int nb = r % 16, kb = r / 16; tr_item64(F.w_down, D, 64 * nb, F.Wdn_t, FF, 64 * nb, 64 * kb, tl, lane); }
    }
}

template <int WHICH> __device__ __forceinline__ void norm_phase(Frame& F) {
    const int gw = F.vcu * NWAVES + F.wave, NGW = F.G * NWAVES, lane = F.lane;
    if (WHICH == 1) {
        if (F.tid == 0) { unsigned* bw = (unsigned*)(F.ctl + CW_BAR); XB_SPIN(xb_ld((unsigned*)(F.ctl + CW_ADA)) < 192u, bw); __builtin_amdgcn_fence(__ATOMIC_ACQUIRE, "agent"); asm volatile("s_waitcnt vmcnt(0)" ::: "memory"); }
        __syncthreads();
        for (int idx = gw * 64 + lane; idx < 4 * 6 * D; idx += NGW * 64) F.modf[idx] = F.modacc[idx] + F.b_ada[idx % (6 * D)];
    }
    const float* nw = (WHICH == 1) ? F.norm1_w : F.norm2_w;
    constexpr int R = (WHICH == 1) ? 4 : 8;
    for (int m0 = gw * R; m0 < M; m0 += NGW * R) {
        const int b = m0 / T;
        f32x4 v[R][4];
#pragma unroll
        for (int r = 0; r < R; ++r) {
            if (WHICH == 1) { const GAS f32x4* xr = (const GAS f32x4*)(F.x + (size_t)(m0 + r) * D) + lane;
#pragma unroll
                for (int i = 0; i < 4; ++i) v[r][i] = xr[64 * i]; }
            else { const GAS unsigned long long* xr = (const GAS unsigned long long*)(F.X1B + (size_t)(m0 + r) * D) + lane;
#pragma unroll
                for (int i = 0; i < 4; ++i) { const unsigned long long bb = xr[64 * i]; const unsigned lo = (unsigned)bb, hi = (unsigned)(bb >> 32);
                    v[r][i] = (f32x4){__uint_as_float(lo << 16), __uint_as_float(lo & 0xffff0000u), __uint_as_float(hi << 16), __uint_as_float(hi & 0xffff0000u)}; } } }
        f32x4 gm[4], sh[4];
#pragma unroll
        for (int i = 0; i < 4; ++i) { const int c = 256 * i + 4 * lane; f32x4 sc, sf;
            if (WHICH == 1) { sf = *(const GAS f32x4*)(F.modacc + b * 6 * D + c) + *(const GAS f32x4*)(F.b_ada + c); sc = *(const GAS f32x4*)(F.modacc + b * 6 * D + D + c) + *(const GAS f32x4*)(F.b_ada + D + c); }
            else { sf = *(const GAS f32x4*)(F.modf + b * 6 * D + 3 * D + c); sc = *(const GAS f32x4*)(F.modf + b * 6 * D + 4 * D + c); }
            gm[i] = *(const GAS f32x4*)(nw + c) * (sc + 1.0f); sh[i] = sf; }
#pragma unroll
        for (int r = 0; r < R; ++r) {
            float ss = 0.f;
#pragma unroll
            for (int i = 0; i < 4; ++i) ss += (v[r][i].x * v[r][i].x + v[r][i].y * v[r][i].y) + (v[r][i].z * v[r][i].z + v[r][i].w * v[r][i].w);
            const float rstd = rsq(wave_sum(ss) * (1.0f / D) + EPS);
            GAS unsigned long long* o8 = (GAS unsigned long long*)(F.H + (size_t)(m0 + r) * D) + lane;
#pragma unroll
            for (int i = 0; i < 4; ++i) { const f32x4 a = v[r][i] * rstd * gm[i] + sh[i];
                o8[64 * i] = (unsigned long long)cvtpk(a[0], a[1]) | ((unsigned long long)cvtpk(a[2], a[3]) << 32); }
        }
    }
}

__device__ __forceinline__ float rdlane(float v, int l) { return __int_as_float(__builtin_amdgcn_readlane(__float_as_int(v), l)); }
__device__ __forceinline__ bf16x8 pack8(const f32x4 a, const f32x4 b) {
    v4u w; w.x = cvtpk(a[0], a[1]); w.y = cvtpk(a[2], a[3]); w.z = cvtpk(b[0], b[1]); w.w = cvtpk(b[2], b[3]); return __builtin_bit_cast(bf16x8, w); }
__device__ __forceinline__ bf16x8 tile_frag(const LAS bf16* tile, int t, int ks, int fr, int fq) {
    const LAS bf16* p = tile + (16 * t + fr) * 64 + 32 * ks + 4 * fq;
    const unsigned long long lo = *(const LAS unsigned long long*)p, hi = *(const LAS unsigned long long*)(p + 16);
    v4u v; v.x = (unsigned)lo; v.y = (unsigned)(lo >> 32); v.z = (unsigned)hi; v.w = (unsigned)(hi >> 32); return __builtin_bit_cast(bf16x8, v);
}
__device__ __forceinline__ unsigned long long pack4(float a, float b, float c, float d) { return (unsigned long long)cvtpk(a, b) | ((unsigned long long)cvtpk(c, d) << 32); }

typedef short s16x4 __attribute__((ext_vector_type(4)));
__device__ __forceinline__ s16x4 cvt4(const f32x4 v) { const unsigned lo = cvtpk(v[0], v[1]), hi = cvtpk(v[2], v[3]); typedef unsigned u32x2 __attribute__((ext_vector_type(2))); return __builtin_bit_cast(s16x4, (u32x2){lo, hi}); }
#define MFMA16(a, b, c) __builtin_amdgcn_mfma_f32_16x16x16bf16_1k((a), (b), (c), 0, 0, 0)
#define MFMA32(a, b, c) __builtin_amdgcn_mfma_f32_16x16x32_bf16((a), (b), (c), 0, 0, 0)

__device__ __forceinline__ void gdn_prep_chunk(Frame& F, int ci, LAS unsigned char* wl  ) {
    const int lane = F.lane, bh = ci >> 6, n = ci & 63, b = bh >> 3, hh = bh & 7, fr = lane & 15, fq = lane >> 4;
    const size_t m0 = (size_t)b * T + 64 * n;
    bf16* const cA = F.CHKA + (size_t)ci * 8192;
    bf16* const cT = F.CHKT + (size_t)ci * 8192;
    bf16* const cU = F.CHKU + (size_t)ci * 8192;
    LAS bf16* const R0 = (LAS bf16*)wl;
    LAS bf16* const R1 = (LAS bf16*)(wl + 9728);
#define GDN_RAW(dst, col0) do { _Pragma("unroll") for (int i_ = 0; i_ < 9; ++i_) { long row_ = (long)m0 - 3 + 8 * i_ + (lane >> 3); row_ = row_ < 0 ? 0 : (row_ > M - 1 ? M - 1 : row_); \
        __builtin_amdgcn_global_load_lds((const unsigned*)(F.PQ + (size_t)row_ * NP + (col0) + hh * 64 + (lane & 7) * 8), (LAS unsigned*)((dst) + i_ * 512), 16, 0, 0); } } while (0)
    GDN_RAW(R0, C_GQ); GDN_RAW(R1, C_GK);
    const f32x4 z4 = (f32x4){0.f, 0.f, 0.f, 0.f};
    float g, beta;
    {
        const float ga = bf2f(F.PQ[(m0 + lane) * NP + C_GA + hh]), gbv = bf2f(F.PQ[(m0 + lane) * NP + C_GB + hh]);
        const float xx = ga + F.dt_bias[hh]; g = -__expf(F.a_log[hh]) * (fmaxf(xx, 0.f) + log1pf(__expf(-fabsf(xx)))); beta = __builtin_amdgcn_rcpf(1.0f + __expf(-gbv));
    }
    float G = g;
#pragma unroll
    for (int o = 1; o < 64; o <<= 1) { const float t = __shfl_up(G, o); if (lane >= o) G += t; }
    const float eG = __expf(G), Glast = __shfl(G, 63), kdsc = __expf(Glast - G), beG = beta * eG;
    if (lane == 0) F.dec[ci] = __expf(Glast);
    asm volatile("s_waitcnt vmcnt(0)" ::: "memory");
    {
        const f32x2_t w0 = {F.conv_w[hh * 64 + lane], F.conv_w[512 + hh * 64 + lane]}, w1 = {F.conv_w[1536 + hh * 64 + lane], F.conv_w[1536 + 512 + hh * 64 + lane]};
        const f32x2_t w2 = {F.conv_w[2 * 1536 + hh * 64 + lane], F.conv_w[2 * 1536 + 512 + hh * 64 + lane]}, w3 = {F.conv_w[3 * 1536 + hh * 64 + lane], F.conv_w[3 * 1536 + 512 + hh * 64 + lane]};
        f32x2_t x0 = {0.f, 0.f}, x1 = {0.f, 0.f}, x2 = {0.f, 0.f};
        if (n > 0) { x0 = (f32x2_t){bf2f(R0[lane]), bf2f(R1[lane])}; x1 = (f32x2_t){bf2f(R0[64 + lane]), bf2f(R1[64 + lane])}; x2 = (f32x2_t){bf2f(R0[128 + lane]), bf2f(R1[128 + lane])}; }
#pragma unroll
        for (int c0 = 0; c0 < 64; c0 += 4) {
            unsigned rq[4], rk[4];
#pragma unroll
            for (int j = 0; j < 4; ++j) { rq[j] = R0[(c0 + j + 3) * 64 + lane]; rk[j] = R1[(c0 + j + 3) * 64 + lane]; }
            __builtin_amdgcn_sched_barrier(0);
#pragma unroll
            for (int j = 0; j < 4; ++j) {
                const f32x2_t r = {__uint_as_float(rq[j] << 16), __uint_as_float(rk[j] << 16)};
                const f32x2_t t = w0 * x0 + w1 * x1 + w2 * x2 + w3 * r; x0 = x1; x1 = x2; x2 = r;
                const f32x2_t e = t * -1.44269504f;
                const f32x2_t d = (f32x2_t){__builtin_amdgcn_exp2f(e.x), __builtin_amdgcn_exp2f(e.y)} + 1.0f;
                const f32x2_t sv = t * (f32x2_t){__builtin_amdgcn_rcpf(d.x), __builtin_amdgcn_rcpf(d.y)};
                const unsigned pk = cvtpk(sv.x, sv.y);
                R0[(c0 + j) * 64 + lane] = (bf16)(pk & 0xffffu); R1[(c0 + j) * 64 + lane] = (bf16)(pk >> 16);
            }
            __builtin_amdgcn_sched_barrier(0);
        }
    }
    LDS_WAIT(); asm volatile("" ::: "memory"); __builtin_amdgcn_sched_barrier(0);
    bf16x8 kf[4][2], qf[4][2];
#pragma unroll
    for (int blk = 0; blk < 4; ++blk)
#pragma unroll
        for (int kk = 0; kk < 2; ++kk) { kf[blk][kk] = *(const LAS bf16x8*)(R1 + (16 * blk + fr) * 64 + 32 * kk + 8 * fq); qf[blk][kk] = *(const LAS bf16x8*)(R0 + (16 * blk + fr) * 64 + 32 * kk + 8 * fq); }
    float rqc[4], rkc[4];
#pragma unroll
    for (int t = 0; t < 4; ++t) { f32x4 dq = MFMA32(qf[t][0], qf[t][0], z4); dq = MFMA32(qf[t][1], qf[t][1], dq); f32x4 dk = MFMA32(kf[t][0], kf[t][0], z4); dk = MFMA32(kf[t][1], kf[t][1], dk);
        const int di = fr & 3; const bool on = (fq == (fr >> 2));
        const float vq = di == 0 ? dq[0] : di == 1 ? dq[1] : di == 2 ? dq[2] : dq[3], vk = di == 0 ? dk[0] : di == 1 ? dk[1] : di == 2 ? dk[2] : dk[3];
        rqc[t] = rsq(fq_sum(on ? vq : 0.f) + EPS); rkc[t] = rsq(fq_sum(on ? vk : 0.f) + EPS); }
    const float rk_tok = fq == 0 ? rkc[0] : fq == 1 ? rkc[1] : fq == 2 ? rkc[2] : rkc[3];
    const float beGn = beG * rk_tok, kdscn = kdsc * rk_tok;
    float Gcol[4], Bcol[4];
#pragma unroll
    for (int t = 0; t < 4; ++t) { Gcol[t] = __shfl(G, 16 * t + fr); Bcol[t] = __shfl(beta, 16 * t + fr) * rkc[t]; }
#pragma unroll
    for (int mt = 0; mt < 4; ++mt) { const float esc = __expf(Gcol[mt]) * 0.125f * rqc[mt];
#pragma unroll
        for (int ks = 0; ks < 2; ++ks) { const v4u q8 = __builtin_bit_cast(v4u, tile_frag(R0, mt, ks, fr, fq)); const unsigned w_[4] = {q8.x, q8.y, q8.z, q8.w}; v4u o_;
            o_.x = cvtpk(__uint_as_float(w_[0] << 16) * esc, __uint_as_float(w_[0] & 0xffff0000u) * esc); o_.y = cvtpk(__uint_as_float(w_[1] << 16) * esc, __uint_as_float(w_[1] & 0xffff0000u) * esc);
            o_.z = cvtpk(__uint_as_float(w_[2] << 16) * esc, __uint_as_float(w_[2] & 0xffff0000u) * esc); o_.w = cvtpk(__uint_as_float(w_[3] << 16) * esc, __uint_as_float(w_[3] & 0xffff0000u) * esc);
            *(GAS v4u*)(cT + ((mt * 2 + ks) * 64 + lane) * 8) = o_; } }
    LDS_WAIT(); asm volatile("" ::: "memory"); __builtin_amdgcn_sched_barrier(0);
#pragma unroll
    for (int ks = 0; ks < 2; ++ks) { float Grow[2][4], Krow[2][4];
#pragma unroll
        for (int h2 = 0; h2 < 2; ++h2)
#pragma unroll
            for (int i = 0; i < 4; ++i) { Grow[h2][i] = __shfl(G, 16 * (2 * ks + h2) + 4 * fq + i); Krow[h2][i] = __shfl(rk_tok, 16 * (2 * ks + h2) + 4 * fq + i); }
#pragma unroll
        for (int tc = 0; tc < 4; ++tc) {
            f32x4 v[2];
#pragma unroll
            for (int h2 = 0; h2 < 2; ++h2) { const int ts = 2 * ks + h2;
                if (ts <= tc) { f32x4 acc = MFMA32(kf[ts][0], qf[tc][0], z4); acc = MFMA32(kf[ts][1], qf[tc][1], acc);
#pragma unroll
                    for (int i = 0; i < 4; ++i) { const int cidx = 16 * tc + fr, sidx = 16 * ts + 4 * fq + i; v[h2][i] = (cidx >= sidx) ? acc[i] * __expf(Gcol[tc] - Grow[h2][i]) * (0.125f * rqc[tc]) * Krow[h2][i] : 0.f; }
                } else v[h2] = z4; }
            *(bf16x8*)(cT + 4096 + ((tc * 2 + ks) * 64 + lane) * 8) = pack8(v[0], v[1]);
        } }
#pragma unroll
    for (int ts = 0; ts < 4; ++ts) { float Grow[4], Krow[4];
#pragma unroll
        for (int i = 0; i < 4; ++i) { Grow[i] = __shfl(G, 16 * ts + 4 * fq + i); Krow[i] = __shfl(rk_tok, 16 * ts + 4 * fq + i); }
#pragma unroll
        for (int tc = 0; tc < 4; ++tc) { f32x4 a = z4;
            if (ts <= tc) { f32x4 acc = MFMA32(kf[ts][0], kf[tc][0], z4); acc = MFMA32(kf[ts][1], kf[tc][1], acc);
#pragma unroll
                for (int i = 0; i < 4; ++i) { const int cidx = 16 * tc + fr, sidx = 16 * ts + 4 * fq + i; a[i] = (cidx > sidx) ? Bcol[tc] * Krow[i] * acc[i] * __expf(Gcol[tc] - Grow[i]) : 0.f; } }
            *(LAS unsigned long long*)(R0 + (16 * tc + fr) * 64 + 16 * ts + 4 * fq) = pack4(a[0], a[1], a[2], a[3]); } }
    bf16x8 RkB[4][2], KDf[4][2];
#pragma unroll
    for (int ks = 0; ks < 2; ++ks) { float sB[8], sD[8];
#pragma unroll
        for (int j = 0; j < 8; ++j) { const int tok = 32 * ks + 16 * (j >> 2) + 4 * fq + (j & 3); sB[j] = __shfl(beGn, tok); sD[j] = __shfl(kdscn, tok); }
#pragma unroll
        for (int t = 0; t < 4; ++t) { float kv[8];
#pragma unroll
            for (int j = 0; j < 8; ++j) kv[j] = bf2f(R1[(32 * ks + 16 * (j >> 2) + 4 * fq + (j & 3)) * 64 + 16 * t + fr]);
            v4u a_, d_;
            a_.x = cvtpk(kv[0] * sB[0], kv[1] * sB[1]); a_.y = cvtpk(kv[2] * sB[2], kv[3] * sB[3]); a_.z = cvtpk(kv[4] * sB[4], kv[5] * sB[5]); a_.w = cvtpk(kv[6] * sB[6], kv[7] * sB[7]);
            d_.x = cvtpk(kv[0] * sD[0], kv[1] * sD[1]); d_.y = cvtpk(kv[2] * sD[2], kv[3] * sD[3]); d_.z = cvtpk(kv[4] * sD[4], kv[5] * sD[5]); d_.w = cvtpk(kv[6] * sD[6], kv[7] * sD[7]);
            RkB[t][ks] = __builtin_bit_cast(bf16x8, a_); KDf[t][ks] = __builtin_bit_cast(bf16x8, d_); } }
    LDS_WAIT(); asm volatile("" ::: "memory"); __builtin_amdgcn_sched_barrier(0);
    {
        float X[16];
#pragma unroll
        for (int r = 0; r < 16; ++r) X[r] = (r == fr) ? 1.f : 0.f;
        const LAS bf16* ab = R0 + (16 * fq) * 64 + 16 * fq;
#pragma unroll
        for (int s = 0; s < 15; ++s) {
#pragma unroll
            for (int r = s + 1; r < 16; ++r) X[r] -= bf2f(ab[r * 64 + s]) * X[s];
            if ((s & 3) == 3) __builtin_amdgcn_sched_barrier(0);
        }
        LDS_WAIT(); asm volatile("" ::: "memory"); __builtin_amdgcn_sched_barrier(0);
#pragma unroll
        for (int r = 0; r < 16; ++r) R0[(16 * fq + r) * 64 + 16 * fq + fr] = (bf16)(cvtpk(X[r], X[r]) & 0xffffu);
    }
    LDS_WAIT(); asm volatile("" ::: "memory"); __builtin_amdgcn_sched_barrier(0);
    {
#define A16(i, k) (*(const LAS s16x4*)(R0 + (16 * (i) + fr) * 64 + 16 * (k) + 4 * fq))
        s16x4 Td[4];
#pragma unroll
        for (int j = 0; j < 3; ++j) { const LAS bf16* p = R0 + (16 * j + 4 * fq) * 64 + 16 * j + fr; typedef unsigned u32x2 __attribute__((ext_vector_type(2)));
            Td[j] = __builtin_bit_cast(s16x4, (u32x2){(unsigned)p[0] | ((unsigned)p[64] << 16), (unsigned)p[128] | ((unsigned)p[192] << 16)}); }
        f32x4 m10 = MFMA16(A16(1, 0), Td[0], z4);
        const f32x4 t10 = -MFMA16(A16(1, 1), cvt4(m10), z4);
        f32x4 m21 = MFMA16(A16(2, 1), Td[1], z4);
        f32x4 m20 = MFMA16(A16(2, 0), Td[0], z4); m20 = MFMA16(A16(2, 1), cvt4(t10), m20);
        const s16x4 a22 = A16(2, 2);
        const f32x4 t21 = -MFMA16(a22, cvt4(m21), z4), t20 = -MFMA16(a22, cvt4(m20), z4);
        f32x4 m32 = MFMA16(A16(3, 2), Td[2], z4);
        f32x4 m31 = MFMA16(A16(3, 1), Td[1], z4); m31 = MFMA16(A16(3, 2), cvt4(t21), m31);
        f32x4 m30 = MFMA16(A16(3, 0), Td[0], z4); m30 = MFMA16(A16(3, 1), cvt4(t10), m30); m30 = MFMA16(A16(3, 2), cvt4(t20), m30);
        const s16x4 a33 = A16(3, 3);
        const f32x4 t32 = -MFMA16(a33, cvt4(m32), z4), t31 = -MFMA16(a33, cvt4(m31), z4), t30 = -MFMA16(a33, cvt4(m30), z4);
        LDS_WAIT(); asm volatile("" ::: "memory"); __builtin_amdgcn_sched_barrier(0);
#define TST(i, j, t) do { _Pragma("unroll") for (int r_ = 0; r_ < 4; ++r_) R0[(16 * (i) + 4 * fq + r_) * 64 + 16 * (j) + fr] = (bf16)(cvtpk((t)[r_], (t)[r_]) & 0xffffu); } while (0)
        TST(1, 0, t10); TST(2, 0, t20); TST(2, 1, t21); TST(3, 0, t30); TST(3, 1, t31); TST(3, 2, t32);
#undef TST
#undef A16
    }
    LDS_WAIT(); asm volatile("" ::: "memory"); __builtin_amdgcn_sched_barrier(0);
#pragma unroll
    for (int ct = 0; ct < 4; ++ct) { const bf16x8 ta0 = tile_frag(R0, ct, 0, fr, fq), ta1 = tile_frag(R0, ct, 1, fr, fq);
#pragma unroll
        for (int dt = 0; dt < 4; ++dt) { f32x4 acc = MFMA32(ta0, RkB[dt][0], z4); if (ct >= 2) acc = MFMA32(ta1, RkB[dt][1], acc);
            *(LAS unsigned long long*)(R1 + (16 * dt + fr) * 64 + 16 * ct + 4 * fq) = pack4(acc[0], acc[1], acc[2], acc[3]); } }
    LDS_WAIT(); asm volatile("" ::: "memory");
    asm volatile("s_waitcnt vmcnt(0)" ::: "memory");
    v4u qdf[8]; bf16x8 qkf[8];
#pragma unroll
    for (int f = 0; f < 8; ++f) { qdf[f] = *(const GAS v4u*)(cT + (f * 64 + lane) * 8); qkf[f] = *(const GAS bf16x8*)(cT + 4096 + (f * 64 + lane) * 8); }
    bf16x8 waf[4][2];
#pragma unroll
    for (int tm = 0; tm < 4; ++tm) { waf[tm][0] = tile_frag(R1, tm, 0, fr, fq); waf[tm][1] = tile_frag(R1, tm, 1, fr, fq); }
    LDS_WAIT(); asm volatile("" ::: "memory");
    GDN_RAW(R1, C_GV);
#pragma unroll
    for (int tn = 0; tn < 4; ++tn) {
#pragma unroll
        for (int ks2 = 0; ks2 < 2; ++ks2) {
            const v4u qd8 = qdf[tn * 2 + ks2]; const unsigned qw_[4] = {qd8.x, qd8.y, qd8.z, qd8.w};
            f32x4 pp[2], q2[2];
#pragma unroll
            for (int h2 = 0; h2 < 2; ++h2) { const int tm = 2 * ks2 + h2;
                f32x4 a1 = MFMA32(waf[tm][0], KDf[tn][0], z4); a1 = MFMA32(waf[tm][1], KDf[tn][1], a1);
                f32x4 a2 = MFMA32(waf[tm][0], qkf[tn * 2], z4); a2 = MFMA32(waf[tm][1], qkf[tn * 2 + 1], a2);
                pp[h2] = -a1;
                q2[h2] = (f32x4){__uint_as_float(qw_[2 * h2] << 16), __uint_as_float(qw_[2 * h2] & 0xffff0000u), __uint_as_float(qw_[2 * h2 + 1] << 16), __uint_as_float(qw_[2 * h2 + 1] & 0xffff0000u)} - a2; }
            *(GAS bf16x8*)(cA + ((tn * 2 + ks2) * 64 + lane) * 8) = pack8(pp[0], pp[1]);
            *(GAS bf16x8*)(cA + 4096 + ((tn * 2 + ks2) * 64 + lane) * 8) = pack8(q2[0], q2[1]);
        }
    }
    asm volatile("s_waitcnt vmcnt(0)" ::: "memory");
    {
        const float ws0 = F.conv_w[1024 + hh * 64 + lane], ws1 = F.conv_w[1536 + 1024 + hh * 64 + lane], ws2 = F.conv_w[2 * 1536 + 1024 + hh * 64 + lane], ws3 = F.conv_w[3 * 1536 + 1024 + hh * 64 + lane];
        const f32x2_t w0 = {ws0, ws0}, w1 = {ws1, ws1}, w2 = {ws2, ws2}, w3 = {ws3, ws3};
        const unsigned s0 = R1[32 * 64 + lane], s1 = R1[33 * 64 + lane], s2 = R1[34 * 64 + lane];
        f32x2_t x0 = {0.f, __uint_as_float(s0 << 16)}, x1 = {0.f, __uint_as_float(s1 << 16)}, x2 = {0.f, __uint_as_float(s2 << 16)};
        if (n > 0) { x0.x = bf2f(R1[lane]); x1.x = bf2f(R1[64 + lane]); x2.x = bf2f(R1[128 + lane]); }
#pragma unroll
        for (int c0 = 0; c0 < 32; c0 += 4) {
            unsigned ra[4], rb[4];
#pragma unroll
            for (int j = 0; j < 4; ++j) { const int c = c0 + j; ra[j] = (c + 3 < 32) ? (unsigned)R1[(c + 3) * 64 + lane] : (c + 3 == 32 ? s0 : (c + 3 == 33 ? s1 : s2)); rb[j] = R1[(c + 35) * 64 + lane]; }
            __builtin_amdgcn_sched_barrier(0);
#pragma unroll
            for (int j = 0; j < 4; ++j) { const int c = c0 + j;
                const f32x2_t r = {__uint_as_float(ra[j] << 16), __uint_as_float(rb[j] << 16)};
                const f32x2_t t = w0 * x0 + w1 * x1 + w2 * x2 + w3 * r; x0 = x1; x1 = x2; x2 = r;
                const f32x2_t e = t * -1.44269504f;
                const f32x2_t d = (f32x2_t){__builtin_amdgcn_exp2f(e.x), __builtin_amdgcn_exp2f(e.y)} + 1.0f;
                const f32x2_t sv = t * (f32x2_t){__builtin_amdgcn_rcpf(d.x), __builtin_amdgcn_rcpf(d.y)};
                const unsigned pk = cvtpk(sv.x, sv.y);
                R1[c * 64 + lane] = (bf16)(pk & 0xffffu); R1[(c + 32) * 64 + lane] = (bf16)(pk >> 16);
            }
            __builtin_amdgcn_sched_barrier(0);
        }
    }
    LDS_WAIT(); asm volatile("" ::: "memory"); __builtin_amdgcn_sched_barrier(0);
    bf16x8 RvB[4][2];
#pragma unroll
    for (int ks = 0; ks < 2; ++ks) { float sB[8];
#pragma unroll
        for (int j = 0; j < 8; ++j) sB[j] = __shfl(beta, 32 * ks + 16 * (j >> 2) + 4 * fq + (j & 3));
#pragma unroll
        for (int t = 0; t < 4; ++t) { float vv[8];
#pragma unroll
            for (int j = 0; j < 8; ++j) vv[j] = bf2f(R1[(32 * ks + 16 * (j >> 2) + 4 * fq + (j & 3)) * 64 + 16 * t + fr]) * sB[j];
            v4u a_; a_.x = cvtpk(vv[0], vv[1]); a_.y = cvtpk(vv[2], vv[3]); a_.z = cvtpk(vv[4], vv[5]); a_.w = cvtpk(vv[6], vv[7]);
            RvB[t][ks] = __builtin_bit_cast(bf16x8, a_); } }
    LDS_WAIT(); asm volatile("" ::: "memory"); __builtin_amdgcn_sched_barrier(0);
#pragma unroll
    for (int ct = 0; ct < 4; ++ct) { const bf16x8 ta0 = tile_frag(R0, ct, 0, fr, fq), ta1 = tile_frag(R0, ct, 1, fr, fq);
#pragma unroll
        for (int et = 0; et < 4; ++et) { f32x4 acc = MFMA32(ta0, RvB[et][0], z4); if (ct >= 2) acc = MFMA32(ta1, RvB[et][1], acc);
            *(LAS unsigned long long*)(R1 + (16 * et + fr) * 64 + 16 * ct + 4 * fq) = pack4(acc[0], acc[1], acc[2], acc[3]); } }
    LDS_WAIT(); asm volatile("" ::: "memory"); __builtin_amdgcn_sched_barrier(0);
#pragma unroll
    for (int et = 0; et < 4; ++et) {
        const bf16x8 ub0 = tile_frag(R1, et, 0, fr, fq), ub1 = tile_frag(R1, et, 1, fr, fq);
#pragma unroll
        for (int tm = 0; tm < 4; ++tm) {
            const bf16x8 qa0 = qkf[tm * 2], qa1 = qkf[tm * 2 + 1];
            f32x4 r = MFMA32(KDf[tm][0], ub0, z4); r = MFMA32(KDf[tm][1], ub1, r);
            f32x4 o = MFMA32(qa0, ub0, z4); o = MFMA32(qa1, ub1, o);
            *(GAS unsigned long long*)(cU + ((et * 4 + tm) * 64 + lane) * 4) = pack4(r[0], r[1], r[2], r[3]);
            *(GAS unsigned long long*)(cU + 4096 + ((et * 4 + tm) * 64 + lane) * 4) = pack4(o[0], o[1], o[2], o[3]);
        }
    }
    LDS_WAIT(); asm volatile("" ::: "memory"); __builtin_amdgcn_sched_barrier(0);
}
#undef MFMA16
#undef MFMA32
#undef GDN_RAW

#define GDN_BAR() do { asm volatile("" ::: "memory"); __builtin_amdgcn_s_barrier(); asm volatile("" ::: "memory"); } while (0)
__device__ __forceinline__ void gdn_scan(Frame& F, int bh) {
    const int lane = F.lane, wave = F.wave, b = bh >> 3, hh = bh & 7, fr = lane & 15, fq = lane >> 4;
    LAS unsigned char* const ring = F.lds + RING_OFF;
    constexpr int SLOT = 32768, OB0 = 131072, OB1 = 139264;
    const unsigned char* gA = (const unsigned char*)(F.CHKA + (size_t)bh * 64 * 8192);
    const unsigned char* gU = (const unsigned char*)(F.CHKU + (size_t)bh * 64 * 8192);
    if (wave >= 4) {
        const int hw = wave - 4, nt = hw * 64 + lane;
        bf16* mp = F.ORAW + ((size_t)b * T + (nt >> 3)) * 512 + hh * 64 + (nt & 7) * 8;
#define GDN_ISSUE(nn) do { const int n_ = (nn); const int sl_ = n_ & 3; _Pragma("unroll") for (int i_ = 0; i_ < 8; ++i_) { const int p_ = hw * 8 + i_; \
            const unsigned char* s_ = (p_ < 16) ? gA + (size_t)n_ * 16384 + p_ * 1024 : gU + (size_t)n_ * 16384 + (p_ - 16) * 1024; \
            __builtin_amdgcn_global_load_lds((const unsigned*)(s_ + lane * 16), (LAS unsigned*)(ring + sl_ * SLOT + p_ * 1024), 16, 0, 0); } } while (0)
#define GDN_COPY(nn) do { const LAS unsigned char* ob_ = ring + (((nn) & 1) ? OB1 : OB0); _Pragma("unroll") for (int k_ = 0; k_ < 2; ++k_) \
            *(GAS v4u*)(mp + (size_t)(64 * (nn) + 32 * k_) * 512) = *(const LAS v4u*)(ob_ + (nt + 256 * k_) * 16); } while (0)
        GDN_ISSUE(0); GDN_ISSUE(1); GDN_ISSUE(2);
        asm volatile("s_waitcnt vmcnt(16)" ::: "memory"); GDN_BAR();
        for (int n = 0; n < 64; ++n) {
            if (n + 3 < 64) { GDN_ISSUE(n + 3); asm volatile("s_waitcnt vmcnt(16)" ::: "memory"); } else asm volatile("s_waitcnt vmcnt(0)" ::: "memory");
            if (n > 0) GDN_COPY(n - 1);
            LDS_WAIT(); GDN_BAR();
        }
        GDN_COPY(63);
#undef GDN_ISSUE
#undef GDN_COPY
    } else {
        const int ew = wave;
        f32x4 Sacc[4];
#pragma unroll
        for (int t = 0; t < 4; ++t) Sacc[t] = (f32x4){0.f, 0.f, 0.f, 0.f};
        const float decs = ld_f32_coh(F.dec + bh * 64 + lane);
        GDN_BAR();
        for (int n = 0; n < 64; ++n) {
            const LAS unsigned char* sl = ring + (n & 3) * SLOT;
            LAS bf16* ob = (LAS bf16*)(ring + ((n & 1) ? OB1 : OB0)) + (4 * fq) * 64 + 16 * ew + fr;
            const float dec = __int_as_float(__builtin_amdgcn_readlane(__float_as_int(decs), n));
            unsigned long long rf[4], of[4]; bf16x8 pf[8], qf[8];
#pragma unroll
            for (int t = 0; t < 4; ++t) { rf[t] = *(const LAS unsigned long long*)(sl + 16384 + ((ew * 4 + t) * 64 + lane) * 8); of[t] = *(const LAS unsigned long long*)(sl + 24576 + ((ew * 4 + t) * 64 + lane) * 8); }
#pragma unroll
            for (int f = 0; f < 8; ++f) { pf[f] = *(const LAS bf16x8*)(sl + (f * 64 + lane) * 16); qf[f] = *(const LAS bf16x8*)(sl + 8192 + (f * 64 + lane) * 16); }
            __builtin_amdgcn_sched_barrier(0);
            bf16x8 Sb[2]; Sb[0] = pack8(Sacc[0], Sacc[1]); Sb[1] = pack8(Sacc[2], Sacc[3]);
            f32x4 O[4];
#pragma unroll
            for (int t = 0; t < 4; ++t) { const unsigned rl = (unsigned)rf[t], rh = (unsigned)(rf[t] >> 32), ol = (unsigned)of[t], oh = (unsigned)(of[t] >> 32);
                Sacc[t] = Sacc[t] * dec + (f32x4){__uint_as_float(rl << 16), __uint_as_float(rl & 0xffff0000u), __uint_as_float(rh << 16), __uint_as_float(rh & 0xffff0000u)};
                O[t] = (f32x4){__uint_as_float(ol << 16), __uint_as_float(ol & 0xffff0000u), __uint_as_float(oh << 16), __uint_as_float(oh & 0xffff0000u)}; }
#pragma unroll
            for (int t = 0; t < 4; ++t)
#pragma unroll
                for (int ks = 0; ks < 2; ++ks) { const int f = t * 2 + ks;
                    Sacc[t] = __builtin_amdgcn_mfma_f32_16x16x32_bf16(pf[f], Sb[ks], Sacc[t], 0, 0, 0); O[t] = __builtin_amdgcn_mfma_f32_16x16x32_bf16(qf[f], Sb[ks], O[t], 0, 0, 0); }
#pragma unroll
            for (int t = 0; t < 4; ++t)
#pragma unroll
                for (int i = 0; i < 4; ++i) ob[(16 * t + i) * 64] = (bf16)(cvtpk(O[t][i], O[t][i]) & 0xffffu);
            LDS_WAIT(); GDN_BAR();
        }
    }
}
__device__ __forceinline__ void gdn_norm_rows(Frame& F, int r0) {
    const int oc = F.tid & 7, hd = (F.tid >> 3) & 7;
    float nw[8];
#pragma unroll
    for (int j = 0; j < 8; ++j) nw[j] = F.gdn_norm_w[oc * 8 + j];
#pragma unroll 1
    for (int it = 0; it < 4; ++it) {
        v4u ov[8], zv[8];
#pragma unroll
        for (int k = 0; k < 8; ++k) { const size_t row = (size_t)r0 + (it * 8 + k) * 8 + (F.tid >> 6); ov[k] = *(const GAS v4u*)(F.ORAW + row * 512 + hd * 64 + oc * 8); zv[k] = *(const GAS v4u*)(F.PQ + row * NP + C_GZ + hd * 64 + oc * 8); }
#pragma unroll
        for (int k = 0; k < 8; ++k) { const size_t row = (size_t)r0 + (it * 8 + k) * 8 + (F.tid >> 6);
            const unsigned ow[4] = {ov[k].x, ov[k].y, ov[k].z, ov[k].w}, zw[4] = {zv[k].x, zv[k].y, zv[k].z, zv[k].w};
            float o[8], z[8]; float ss = 0.f;
#pragma unroll
            for (int w = 0; w < 4; ++w) { o[2 * w] = __uint_as_float(ow[w] << 16); o[2 * w + 1] = __uint_as_float(ow[w] & 0xffff0000u); z[2 * w] = __uint_as_float(zw[w] << 16); z[2 * w + 1] = __uint_as_float(zw[w] & 0xffff0000u);
                ss += o[2 * w] * o[2 * w] + o[2 * w + 1] * o[2 * w + 1]; }
            ss = sum8(ss);
            const float rs = rsq(ss * (1.0f / 64.0f) + EPS);
            v4u w4; w4.x = cvtpk(o[0] * rs * nw[0] * z[0], o[1] * rs * nw[1] * z[1]); w4.y = cvtpk(o[2] * rs * nw[2] * z[2], o[3] * rs * nw[3] * z[3]);
            w4.z = cvtpk(o[4] * rs * nw[4] * z[4], o[5] * rs * nw[5] * z[5]); w4.w = cvtpk(o[6] * rs * nw[6] * z[6], o[7] * rs * nw[7] * z[7]);
            *(GAS v4u*)(F.MIX + row * D + hd * 64 + oc * 8) = w4; }
    }
    asm volatile("s_waitcnt vmcnt(0)" ::: "memory"); __syncthreads();
}
__device__ __forceinline__ void swa_unit(Frame& F, int unit, LAS unsigned char* L) {
    const int tid = F.tid, lane = F.lane, wave = F.wave, fr = lane & 15, fq = lane >> 4;
    const int blk = unit & 63, kvh = (unit >> 6) & 1, b = unit >> 7, t0 = blk * 64;
    const size_t row0 = (size_t)b * T;
    LAS bf16* const Ks = (LAS bf16*)L; LAS bf16* const Vt = (LAS bf16*)(L + 27648);
    for (int p = tid; p < 1536; p += NWAVES * 64) {
        const int key = p >> 3, oc = p & 7, s = t0 - 128 + key;
        v4u kv = (v4u){0u, 0u, 0u, 0u}, vv = (v4u){0u, 0u, 0u, 0u};
        if (s >= 0) { kv = *(const GAS v4u*)(F.PQ + (row0 + s) * NP + C_SK + kvh * 64 + oc * 8); vv = *(const GAS v4u*)(F.PQ + (row0 + s) * NP + C_SV + kvh * 64 + oc * 8); }
        const unsigned kw[4] = {kv.x, kv.y, kv.z, kv.w}, vw[4] = {vv.x, vv.y, vv.z, vv.w};
        float k[8]; float ss = 0.f;
#pragma unroll
        for (int w = 0; w < 4; ++w) { k[2 * w] = __uint_as_float(kw[w] << 16); k[2 * w + 1] = __uint_as_float(kw[w] & 0xffff0000u); ss += k[2 * w] * k[2 * w] + k[2 * w + 1] * k[2 * w + 1]; }
        ss = sum8(ss);
        const float rstd = rsq(ss * (1.0f / 64.0f) + EPS);
#pragma unroll
        for (int j = 0; j < 8; ++j) k[j] = k[j] * rstd * F.k_norm_w[oc * 8 + j];
        v4u o; o.x = cvtpk(k[0], k[1]); o.y = cvtpk(k[2], k[3]); o.z = cvtpk(k[4], k[5]); o.w = cvtpk(k[6], k[7]);
        *(LAS v4u*)(Ks + key * 72 + oc * 8) = o;
#pragma unroll
        for (int w = 0; w < 4; ++w) { Vt[(oc * 8 + 2 * w) * 196 + key] = (bf16)(vw[w] & 0xffffu); Vt[(oc * 8 + 2 * w + 1) * 196 + key] = (bf16)(vw[w] >> 16); }
    }
    __syncthreads();
    const int hq = kvh * 4 + (wave >> 1);
    const float slope = exp2f(-(float)(hq + 1)), sink = F.sinks[hq];
#pragma unroll 1
    for (int qt = 0; qt < 2; ++qt) {
        const int tq0 = t0 + 32 * (wave & 1) + 16 * qt;
        bf16x8 qf[2];
        {
            const bf16* qp = F.PQ + (row0 + tq0 + fr) * NP + C_SQ + hq * 64 + 8 * fq;
            const v4u r0 = *(const GAS v4u*)qp, r1 = *(const GAS v4u*)(qp + 32);
            const unsigned qw[8] = {r0.x, r0.y, r0.z, r0.w, r1.x, r1.y, r1.z, r1.w};
            float q[16]; float ss = 0.f;
#pragma unroll
            for (int w = 0; w < 8; ++w) { q[2 * w] = __uint_as_float(qw[w] << 16); q[2 * w + 1] = __uint_as_float(qw[w] & 0xffff0000u); ss += q[2 * w] * q[2 * w] + q[2 * w + 1] * q[2 * w + 1]; }
            ss = fq_sum(ss);
            const float rstd = 0.125f * rsq(ss * (1.0f / 64.0f) + EPS);
#pragma unroll
            for (int kk = 0; kk < 2; ++kk) { float z[8];
#pragma unroll
                for (int j = 0; j < 8; ++j) z[j] = q[8 * kk + j] * rstd * F.q_norm_w[32 * kk + 8 * fq + j];
                v4u o; o.x = cvtpk(z[0], z[1]); o.y = cvtpk(z[2], z[3]); o.z = cvtpk(z[4], z[5]); o.w = cvtpk(z[6], z[7]); qf[kk] = __builtin_bit_cast(bf16x8, o); }
        }
        f32x4 sc[12]; float mx = -INFINITY;
#pragma unroll
        for (int nt = 0; nt < 12; ++nt) { f32x4 acc = (f32x4){0.f, 0.f, 0.f, 0.f};
#pragma unroll
            for (int kk = 0; kk < 2; ++kk) { const bf16x8 kf = *(const LAS bf16x8*)(Ks + (16 * nt + fr) * 72 + 32 * kk + 8 * fq); acc = __builtin_amdgcn_mfma_f32_16x16x32_bf16(kf, qf[kk], acc, 0, 0, 0); }
#pragma unroll
            for (int i = 0; i < 4; ++i) { const int s = t0 - 128 + 16 * nt + 4 * fq + i, dist = tq0 + fr - s; const bool ok = (s >= 0) && (dist >= 0) && (dist < 128);
                const float v = ok ? acc[i] - slope * (float)dist : -INFINITY; acc[i] = v; mx = fmaxf(mx, v); }
            sc[nt] = acc; if (nt & 1) __builtin_amdgcn_sched_barrier(0); }
        mx = fmaxf(fq_max(mx), sink);
        float sum = 0.f;
#pragma unroll
        for (int nt = 0; nt < 12; ++nt)
#pragma unroll
            for (int i = 0; i < 4; ++i) { const float p = __expf(sc[nt][i] - mx); sc[nt][i] = p; sum += p; }
        sum = fq_sum(sum);
        const float den = sum + __expf(sink - mx);
        bf16x8 pf[6];
#pragma unroll
        for (int ks = 0; ks < 6; ++ks) pf[ks] = pack8(sc[2 * ks], sc[2 * ks + 1]);
        float rden[4];
#pragma unroll
        for (int i = 0; i < 4; ++i) rden[i] = __builtin_amdgcn_rcpf(__shfl(den, 4 * fq + i));
        bf16* op = F.MIX + (row0 + tq0 + 4 * fq) * D + 512 + hq * 64 + fr;
#pragma unroll 1
        for (int dt = 0; dt < 4; ++dt) { f32x4 oacc = (f32x4){0.f, 0.f, 0.f, 0.f};
#pragma unroll
            for (int ks = 0; ks < 6; ++ks) { const LAS bf16* vp = Vt + (16 * dt + fr) * 196 + 32 * ks + 4 * fq;
                const unsigned long long lo = *(const LAS unsigned long long*)vp, hi = *(const LAS unsigned long long*)(vp + 16);
                v4u vv; vv.x = (unsigned)lo; vv.y = (unsigned)(lo >> 32); vv.z = (unsigned)hi; vv.w = (unsigned)(hi >> 32);
                oacc = __builtin_amdgcn_mfma_f32_16x16x32_bf16(pf[ks], __builtin_bit_cast(bf16x8, vv), oacc, 0, 0, 0); }
#pragma unroll
            for (int i = 0; i < 4; ++i) op[(size_t)i * D + 16 * dt] = (bf16)f2bf(oacc[i] * rden[i]); }
    }
    __syncthreads();
}
__device__ __forceinline__ void p3a_prep(Frame& F) {
    LAS unsigned char* wl = F.lds + RING_OFF + F.wave * 19456;
    const int gw = F.vcu * NWAVES + F.wave, NGW = F.G * NWAVES;
    for (int ci = gw; ci < BATCH * 8 * (T / 64); ci += NGW) gdn_prep_chunk(F, ci, wl);
}
__device__ __forceinline__ void p3b_mixers(Frame& F) {
    const int bx = blockIdx.x;
    if (bx < 32) gdn_scan(F, bx);
    else for (int u = bx - 32; u < BATCH * 2 * (T / 64); u += F.G - 32) swa_unit(F, u, F.lds + RING_OFF);
}

struct Args { const float* in[18]; float* out; unsigned char* ws; };
__global__ void __launch_bounds__(NWAVES * 64, 2) hymba_fwd(Args args) {
    extern __shared__ __attribute__((aligned(16))) unsigned char lds[];
    Frame F;
    F.lds = (LAS unsigned char*)lds;
    F.MISC = (volatile LAS unsigned*)(F.lds + MISC_OFF);
    F.tid = threadIdx.x; F.lane = F.tid & 63; F.wave = __builtin_amdgcn_readfirstlane(F.tid >> 6);
    F.G = gridDim.x; { const int bx = blockIdx.x; F.vcu = (F.G % 8 == 0) ? (bx % 8) * (F.G / 8) + bx / 8 : bx; }
    unsigned char* ws = args.ws;
    F.ctl = (gu32*)(ws + WS_CTL);
    F.x = args.in[0]; F.c = args.in[1]; F.w_ada = args.in[2]; F.b_ada = args.in[3]; F.norm1_w = args.in[4]; F.w_in = args.in[5]; F.conv_w = args.in[6];
    F.a_log = args.in[7]; F.dt_bias = args.in[8]; F.gdn_norm_w = args.in[9]; F.q_norm_w = args.in[10]; F.k_norm_w = args.in[11]; F.sinks = args.in[12];
    F.w_out = args.in[13]; F.norm2_w = args.in[14]; F.w_gate = args.in[15]; F.w_up = args.in[16]; F.w_down = args.in[17]; F.out = args.out;
    F.modacc = (float*)(ws + WS_CTL) + CW_MODACC; F.modf = (float*)(ws + WS_MODF);
    F.Win_t = (bf16*)(ws + WS_WIN); F.Wout_t = (bf16*)(ws + WS_WOUT); F.Wgu_t = (bf16*)(ws + WS_WGU); F.Wdn_t = (bf16*)(ws + WS_WDN);
    F.H = (bf16*)(ws + WS_H); F.PQ = (bf16*)(ws + WS_PQ); F.MIX = (bf16*)(ws + WS_MIX); F.CHKA = (bf16*)(ws + WS_CHKA); F.CHKU = (bf16*)(ws + WS_H); F.X1B = (bf16*)(ws + WS_CHKA); F.CHKT = (bf16*)(ws + WS_CHKA + 32 * MiB); F.ORAW = (bf16*)(ws + WS_CHKA + 32 * MiB); F.dec = (float*)(ws + WS_DEC);
    for (int u = F.tid; u < (LDS_BYTES - LDSCTL_OFF) / 4; u += NWAVES * 64) ((LAS unsigned*)(F.lds + LDSCTL_OFF))[u] = 0u;
    __syncthreads();
    XcdBarrier bar = xcd_barrier_post((unsigned*)(F.ctl + CW_BAR), F.MISC + 8);
#define GRID_BAR() do { xcd_barrier(bar, F.tid); int t_ = F.tid; asm volatile("" : "+v"(t_)); F.tid = t_; F.lane = t_ & 63; } while (0)

    p0_prologue(F);
    norm_phase<1>(F); GRID_BAR();
    { pg8::Gemm g{F.H, F.Win_t, M, NP, D}; pg8::StaticOrder S; S.init(M, NP, F.G, (int)blockIdx.x);
      pg8::EpiBf16Plain E{F.PQ, NP, C_GZ / 256, C_SQ / 256};
      pg8::gemm_phase<pg8::EpiBf16Plain, pg8::StaticOrder, true, true>(F.lds + RING_OFF, g, S, E, F.tid); }
    GRID_BAR();
    p3a_prep(F); GRID_BAR();
    p3b_mixers(F); GRID_BAR();
    { pg8::Gemm g{F.MIX, F.Wout_t, M, D, D}; pg8::StaticOrder S; S.init(M, D, F.G, (int)blockIdx.x);
      { pg8::Unit u0; for (int i = 0; S.next(i, u0); ++i) gdn_norm_rows(F, u0.pm * 256); }
      pg8::EpiGateResToBf16 E{F.x, F.X1B, D, F.modf + 2 * D, 6 * D, T};
      pg8::gemm_phase<pg8::EpiGateResToBf16, pg8::StaticOrder, true, true>(F.lds + RING_OFF, g, S, E, F.tid); }
    GRID_BAR();
    norm_phase<2>(F); GRID_BAR();
    { pg8::Gemm g{F.H, F.Wgu_t, M, NGU, D}; pg8::StaticOrder S; S.init(M, NGU, F.G, (int)blockIdx.x);
      pg8::EpiSwiGLU E{F.PQ, FF};
      pg8::gemm_phase<pg8::EpiSwiGLU, pg8::StaticOrder, true, true>(F.lds + RING_OFF, g, S, E, F.tid); }
    GRID_BAR();
    { pg8::Gemm g{F.PQ, F.Wdn_t, M, D, FF}; pg8::StaticOrder S; S.init(M, D, F.G, (int)blockIdx.x);
      pg8::EpiGateResFromBf16 E{F.X1B, F.out, D, F.modf + 5 * D, 6 * D, T};
      pg8::gemm_phase<pg8::EpiGateResFromBf16, pg8::StaticOrder, true, true>(F.lds + RING_OFF, g, S, E, F.tid); }
#undef GRID_BAR
}

extern "C" void kernel_launch(void* const* d_in, const int* in_sizes, int n_in, void* d_out, int out_size, void* d_ws, size_t ws_size, hipStream_t stream) {
    static int grid = 0;
    if (grid == 0) {
        if (n_in != 18 || in_sizes[0] != M * D || out_size != M * D || ws_size < WS_END) { fprintf(stderr, "kernel_launch: unexpected shapes (n_in %d, in0 %d, out %d, ws %zu); nothing launched\n", n_in, n_in > 0 ? in_sizes[0] : -1, out_size, ws_size); grid = -1; return; }
        int dev = 0, cus = 0;
        if (hipGetDevice(&dev) != hipSuccess || hipDeviceGetAttribute(&cus, hipDeviceAttributeMultiprocessorCount, dev) != hipSuccess) { grid = -1; return; }
        if (hipFuncSetAttribute((const void*)hymba_fwd, hipFuncAttributeMaxDynamicSharedMemorySize, LDS_BYTES) != hipSuccess) { fprintf(stderr, "kernel_launch: hipFuncSetAttribute failed\n"); grid = -1; return; }
        (void)hipGetLastError();
        grid = cus;
    }
    if (grid < 0) return;
    if (hipMemsetAsync((char*)d_ws + WS_CTL, 0, CTL_ZERO_BYTES, stream) != hipSuccess) { fprintf(stderr, "kernel_launch: hipMemsetAsync failed\n"); return; }
    Args a{};
    for (int i = 0; i < 18; ++i) a.in[i] = (const float*)d_in[i];
    a.out = (float*)d_out; a.ws = (unsigned char*)d_ws;
    hipLaunchKernelGGL(hymba_fwd, dim3(grid), dim3(NWAVES * 64), LDS_BYTES, stream, a);
    const hipError_t le = hipPeekAtLastError();
    if (le != hipSuccess) fprintf(stderr, "kernel_launch: launch failed: %s\n", hipGetErrorName(le));
}
```

```cpp
#include <hip/hip_runtime.h>
#include <cstdio>
#include <cstdint>
#include <cmath>
namespace pg8 {
#define PG8_LAS __attribute__((address_space(3)))
typedef unsigned short bf16_t;
typedef short bf16x8 __attribute__((ext_vector_type(8)));
typedef float f32x4 __attribute__((ext_vector_type(4)));
typedef unsigned u32x4 __attribute__((ext_vector_type(4)));
constexpr int BM = 256, BK = 64, HALF = 128, HTB = HALF * BK * 2  , STAGE_BYTES = 8 * HTB, NXCD = 8, WGM = 8;

__host__ __device__ __forceinline__ int lds_byte(int r, int c) { const int st = (r >> 4) * 2 + (c >> 5), rr = r & 15, cc = c & 31, ob = rr * 64 + cc * 2; return st * 1024 + (ob ^ (((ob >> 9) & 1) << 5)); }
__host__ __device__ __forceinline__ void stage_rc(int b, int& R, int& C) { const int st = b / 1024, sb = b % 1024, swz = sb ^ (((sb >> 9) & 1) << 5); R = (st >> 1) * 16 + swz / 64; C = (st & 1) * 32 + (swz % 64) / 2; }
__host__ __device__ __forceinline__ int perm32(int rho) { const int n = rho >> 4, i = rho & 15; return 8 * (i >> 2) + 4 * n + (i & 3); }

struct Unit { int pm, pn; };
struct Gemm { const bf16_t* A; const bf16_t* Bt; int M, N, K; };

struct StaticOrder {
    int nM, nN, nwg, G, c;
    __host__ __device__ void init(int M, int N, int G_, int c_) { nM = M / BM; nN = N / BM; nwg = nM * nN; G = G_; c = c_; }
    __host__ __device__ bool next(int i, Unit& u) const {
        const long L = (long)i * G + c; if (L >= nwg) return false;
        int wgid = (int)L; { const int q = nwg / NXCD, r = nwg % NXCD, xcd = wgid % NXCD, off = wgid / NXCD; wgid = (xcd < r ? xcd * (q + 1) : r * (q + 1) + (xcd - r) * q) + off; }
        const int nig = WGM * nN, gid = wgid / nig, fm = gid * WGM, gsz = (nM - fm) < WGM ? (nM - fm) : WGM;
        u.pm = fm + ((wgid % nig) % gsz); u.pn = (wgid % nig) / gsz; return true;
    }
    __device__ __forceinline__ void a_ready(const Unit&) const {}
    __device__ __forceinline__ void done(const Unit&) const {}
};

__device__ __forceinline__ unsigned cvt_pk_bf16(float lo, float hi) { unsigned r; asm volatile("v_cvt_pk_bf16_f32 %0, %1, %2" : "=v"(r) : "v"(lo), "v"(hi)); return r; }
__device__ __forceinline__ float silu_f(float x) { return x * __builtin_amdgcn_rcpf(1.0f + __expf(-x)); }

struct EpiBf16Plain {
    static constexpr bool PERM = true, AFTER_DRAIN = false;
    bf16_t* O; int ldc; int silu_lo, silu_hi;
    __device__ __forceinline__ void operator()(const f32x4 (&acc)[2][2][4][2], const Unit& u, int wr, int wc, int fr, int fq) const {
        const int row0 = u.pm * BM + wr * 64 + fr, col0 = u.pn * BM + wc * 32 + 8 * fq;
        const bool act = (u.pn >= silu_lo) && (u.pn < silu_hi);
#pragma unroll
        for (int ai = 0; ai < 2; ++ai)
#pragma unroll
            for (int m = 0; m < 4; ++m) { bf16_t* rowp = O + (size_t)(row0 + ai * HALF + m * 16) * ldc + col0;
#pragma unroll
                for (int bj = 0; bj < 2; ++bj) { f32x4 v0 = acc[ai][bj][m][0], v1 = acc[ai][bj][m][1];
                    if (act) {
#pragma unroll
                        for (int i = 0; i < 4; ++i) { v0[i] = silu_f(v0[i]); v1[i] = silu_f(v1[i]); } }
                    u32x4 w; w.x = cvt_pk_bf16(v0[0], v0[1]); w.y = cvt_pk_bf16(v0[2], v0[3]); w.z = cvt_pk_bf16(v1[0], v1[1]); w.w = cvt_pk_bf16(v1[2], v1[3]);
                    *(u32x4*)(rowp + bj * HALF) = w; } }
    }
};
struct EpiSwiGLU {
    static constexpr bool PERM = true, AFTER_DRAIN = false;
    bf16_t* O; int ldc;
    __device__ __forceinline__ void operator()(const f32x4 (&acc)[2][2][4][2], const Unit& u, int wr, int wc, int fr, int fq) const {
        const int row0 = u.pm * BM + wr * 64 + fr, col0 = u.pn * HALF + wc * 32 + 8 * fq;
#pragma unroll
        for (int ai = 0; ai < 2; ++ai)
#pragma unroll
            for (int m = 0; m < 4; ++m) { bf16_t* rowp = O + (size_t)(row0 + ai * HALF + m * 16) * ldc + col0;
                const f32x4 g0 = acc[ai][0][m][0], g1 = acc[ai][0][m][1], u0 = acc[ai][1][m][0], u1 = acc[ai][1][m][1];
                float a[8];
#pragma unroll
                for (int i = 0; i < 4; ++i) { a[i] = silu_f(g0[i]) * u0[i]; a[4 + i] = silu_f(g1[i]) * u1[i]; }
                u32x4 w; w.x = cvt_pk_bf16(a[0], a[1]); w.y = cvt_pk_bf16(a[2], a[3]); w.z = cvt_pk_bf16(a[4], a[5]); w.w = cvt_pk_bf16(a[6], a[7]);
                *(u32x4*)rowp = w; }
    }
};
struct EpiGateResToBf16 {
    static constexpr bool PERM = false, AFTER_DRAIN = false;
    const float* base; bf16_t* out; int ldc; const float* gate; int gstride; int rows_per_batch;
    __device__ __forceinline__ void operator()(const f32x4 (&acc)[2][2][4][2], const Unit& u, int wr, int wc, int fr, int fq) const {
        const int row0 = u.pm * BM + wr * 64 + fr, col0 = u.pn * BM + wc * 32 + 4 * fq;
        const float* gp = gate + (size_t)((u.pm * BM) / rows_per_batch) * gstride + col0;
        f32x4 gv[2][2];
#pragma unroll
        for (int bj = 0; bj < 2; ++bj)
#pragma unroll
            for (int n = 0; n < 2; ++n) gv[bj][n] = *(const f32x4*)(gp + bj * HALF + n * 16);
#pragma unroll
        for (int ai = 0; ai < 2; ++ai)
#pragma unroll
            for (int m = 0; m < 4; ++m) { const size_t off = (size_t)(row0 + ai * HALF + m * 16) * ldc + col0;
#pragma unroll
                for (int bj = 0; bj < 2; ++bj)
#pragma unroll
                    for (int n = 0; n < 2; ++n) { const f32x4 o = *(const f32x4*)(base + off + bj * HALF + n * 16) + gv[bj][n] * acc[ai][bj][m][n];
                        *(unsigned long long*)(out + off + bj * HALF + n * 16) = (unsigned long long)cvt_pk_bf16(o[0], o[1]) | ((unsigned long long)cvt_pk_bf16(o[2], o[3]) << 32); } }
    }
};
struct EpiGateResFromBf16 {
    static constexpr bool PERM = false, AFTER_DRAIN = false;
    const bf16_t* base; float* out; int ldc; const float* gate; int gstride; int rows_per_batch;
    __device__ __forceinline__ void operator()(const f32x4 (&acc)[2][2][4][2], const Unit& u, int wr, int wc, int fr, int fq) const {
        const int row0 = u.pm * BM + wr * 64 + fr, col0 = u.pn * BM + wc * 32 + 4 * fq;
        const float* gp = gate + (size_t)((u.pm * BM) / rows_per_batch) * gstride + col0;
        f32x4 gv[2][2];
#pragma unroll
        for (int bj = 0; bj < 2; ++bj)
#pragma unroll
            for (int n = 0; n < 2; ++n) gv[bj][n] = *(const f32x4*)(gp + bj * HALF + n * 16);
#pragma unroll
        for (int ai = 0; ai < 2; ++ai)
#pragma unroll
            for (int m = 0; m < 4; ++m) { const size_t off = (size_t)(row0 + ai * HALF + m * 16) * ldc + col0;
#pragma unroll
                for (int bj = 0; bj < 2; ++bj)
#pragma unroll
                    for (int n = 0; n < 2; ++n) { const unsigned long long bb = *(const unsigned long long*)(base + off + bj * HALF + n * 16); const unsigned lo = (unsigned)bb, hi = (unsigned)(bb >> 32);
                        const f32x4 bs = (f32x4){__uint_as_float(lo << 16), __uint_as_float(lo & 0xffff0000u), __uint_as_float(hi << 16), __uint_as_float(hi & 0xffff0000u)};
                        *(f32x4*)(out + off + bj * HALF + n * 16) = bs + gv[bj][n] * acc[ai][bj][m][n]; } }
    }
};

template <class Epi, class Sched, bool ALIGN_EPI = false, bool SP2 = false>
__device__ __forceinline__ void gemm_phase(PG8_LAS unsigned char* lds, const Gemm g, const Sched& S, const Epi& E, int tid_in) {
    int tid_ = tid_in; asm volatile("" : "+v"(tid_));
    const int tid = tid_, wid = __builtin_amdgcn_readfirstlane(tid >> 6), lane = tid & 63, wr = wid >> 2, wc = wid & 3, fr = lane & 15, fq = lane >> 4;
    const int K = g.K, nt = K / BK;
    unsigned voffA[2], voffB[2];
#pragma unroll
    for (int i = 0; i < 2; ++i) { int R, C; stage_rc(tid * 16 + i * 8192, R, C); const int Rb = Epi::PERM ? ((R & ~31) + perm32(R & 31)) : R;
        voffA[i] = (unsigned)(R * K + C) * 2u; voffB[i] = (unsigned)(Rb * K + C) * 2u; }
    const size_t kstep = (size_t)(BK * 2);
    const size_t hstep = (size_t)HALF * K * 2;
    const size_t tstep = 2 * hstep;
    const unsigned ldsw = (unsigned)wid * 1024u;
    const int aoff = lds_byte(wr * 64 + fr, fq * 8), boff = lds_byte(wc * 32 + fr, fq * 8);
#define PG8_SA(b, h) (((b) * 2 + (h)) * HTB)
#define PG8_SB(b, h) ((4 + (b) * 2 + (h)) * HTB)
#define PG8_STAGE(bufoff, gbase, voff) do { _Pragma("unroll") for (int _i = 0; _i < 2; ++_i) \
        __builtin_amdgcn_global_load_lds((const unsigned*)((const char*)(gbase) + (voff)[_i]), (PG8_LAS unsigned*)(lds + (bufoff) + ldsw + _i * 8192), 16, 0, 0); } while (0)
#define PG8_LDA(dst, b, h) do { _Pragma("unroll") for (int m = 0; m < 4; ++m) _Pragma("unroll") for (int k = 0; k < 2; ++k) dst[m][k] = *(const PG8_LAS bf16x8*)(lds + PG8_SA(b, h) + aoff + m * 2048 + k * 1024); } while (0)
#define PG8_LDB(dst, b, h) do { _Pragma("unroll") for (int n = 0; n < 2; ++n) _Pragma("unroll") for (int k = 0; k < 2; ++k) dst[n][k] = *(const PG8_LAS bf16x8*)(lds + PG8_SB(b, h) + boff + n * 2048 + k * 1024); } while (0)
#define PG8_MMA(ai, bj, At, Bt) do { __builtin_amdgcn_s_setprio(1); _Pragma("unroll") for (int m = 0; m < 4; ++m) _Pragma("unroll") for (int n = 0; n < 2; ++n) _Pragma("unroll") for (int k = 0; k < 2; ++k) \
        acc[ai][bj][m][n] = __builtin_amdgcn_mfma_f32_16x16x32_bf16(Bt[n][k], At[m][k], acc[ai][bj][m][n], 0, 0, 0); __builtin_amdgcn_s_setprio(0); } while (0)
#define PG8_WAIT_V(n) asm volatile("s_waitcnt vmcnt(" #n ")" ::: "memory")
#define PG8_WAIT_L(n) asm volatile("s_waitcnt lgkmcnt(" #n ")" ::: "memory")
#define PG8_BAR __builtin_amdgcn_s_barrier()
#define PG8_SCHED __builtin_amdgcn_sched_barrier(0)
    Unit cur, nxt; int ui = 0;
    if (!S.next(0, cur)) return;
    f32x4 acc[2][2][4][2];
#pragma unroll
    for (int a = 0; a < 2; ++a)
#pragma unroll
        for (int b = 0; b < 2; ++b)
#pragma unroll
            for (int m = 0; m < 4; ++m)
#pragma unroll
                for (int n = 0; n < 2; ++n) acc[a][b][m][n] = (f32x4){0.f, 0.f, 0.f, 0.f};
    bf16x8 At[4][2], B0[2][2], B1[2][2];
    const char* cA = (const char*)g.A + (size_t)cur.pm * tstep; const char* cB = (const char*)g.Bt + (size_t)cur.pn * tstep;
    S.a_ready(cur);
    if constexpr (SP2) {
        PG8_STAGE(PG8_SB(0, 0), cB, voffB); PG8_STAGE(PG8_SB(0, 1), cB + hstep, voffB); PG8_STAGE(PG8_SA(0, 0), cA, voffA); PG8_STAGE(PG8_SA(0, 1), cA + hstep, voffA);
        if (wr == 1) PG8_BAR;
        PG8_WAIT_V(2); PG8_BAR;
        PG8_STAGE(PG8_SB(1, 0), cB + kstep, voffB); PG8_STAGE(PG8_SA(1, 0), cA + kstep, voffA); PG8_STAGE(PG8_SB(1, 1), cB + hstep + kstep, voffB);
        PG8_WAIT_V(6); PG8_BAR;
    } else {
        PG8_STAGE(PG8_SB(0, 0), cB, voffB); PG8_STAGE(PG8_SA(0, 0), cA, voffA); PG8_STAGE(PG8_SB(0, 1), cB + hstep, voffB); PG8_STAGE(PG8_SA(0, 1), cA + hstep, voffA);
        if (wr == 1) PG8_BAR;
        PG8_WAIT_V(4); PG8_BAR;
        PG8_STAGE(PG8_SB(1, 0), cB + kstep, voffB); PG8_STAGE(PG8_SA(1, 0), cA + kstep, voffA); PG8_STAGE(PG8_SB(1, 1), cB + hstep + kstep, voffB);
        PG8_WAIT_V(6); PG8_BAR;
    }
    for (;;) {
        const bool has_next = S.next(ui + 1, nxt);
        const char* nA = has_next ? (const char*)g.A + (size_t)nxt.pm * tstep : cA; const char* nB = has_next ? (const char*)g.Bt + (size_t)nxt.pn * tstep : cB;
        for (int t = 0; t < nt; t += 2) {
            const bool last = (t == nt - 2);
            const char* a1 = cA + (size_t)(t + 1) * kstep;
            const char* a2 = last ? nA : cA + (size_t)(t + 2) * kstep; const char* b2 = last ? nB : cB + (size_t)(t + 2) * kstep;
            const char* a3 = a2 + kstep; const char* b3 = b2 + kstep;
            if (last && has_next) S.a_ready(nxt);
            if constexpr (SP2) {
            PG8_LDB(B0, 0, 0); PG8_LDB(B1, 0, 1); PG8_SCHED; PG8_LDA(At, 0, 0); PG8_STAGE(PG8_SA(1, 1), a1 + hstep, voffA);
            PG8_WAIT_V(8); PG8_WAIT_L(0); PG8_BAR; PG8_MMA(0, 0, At, B0); PG8_MMA(0, 1, At, B1); PG8_BAR; PG8_SCHED;
            PG8_LDA(At, 0, 1); PG8_STAGE(PG8_SB(0, 0), b2, voffB); PG8_STAGE(PG8_SB(0, 1), b2 + hstep, voffB); PG8_STAGE(PG8_SA(0, 0), a2, voffA);
            PG8_WAIT_V(8); PG8_WAIT_L(0); PG8_BAR; PG8_MMA(1, 0, At, B0); PG8_MMA(1, 1, At, B1); PG8_BAR; PG8_SCHED;
            PG8_LDB(B0, 1, 0); PG8_LDB(B1, 1, 1); PG8_SCHED; PG8_LDA(At, 1, 0); PG8_STAGE(PG8_SA(0, 1), a2 + hstep, voffA);
            PG8_WAIT_V(8); PG8_WAIT_L(0); PG8_BAR; PG8_MMA(0, 0, At, B0); PG8_MMA(0, 1, At, B1); PG8_BAR; PG8_SCHED;
            PG8_LDA(At, 1, 1); PG8_STAGE(PG8_SB(1, 0), b3, voffB); PG8_STAGE(PG8_SB(1, 1), b3 + hstep, voffB); PG8_STAGE(PG8_SA(1, 0), a3, voffA);
            PG8_WAIT_V(8); PG8_WAIT_L(0); PG8_BAR; PG8_MMA(1, 0, At, B0); PG8_MMA(1, 1, At, B1); PG8_BAR; PG8_SCHED;
            } else {
            PG8_LDB(B0, 0, 0); PG8_SCHED; PG8_LDA(At, 0, 0); PG8_STAGE(PG8_SA(1, 1), a1 + hstep, voffA);
            PG8_WAIT_L(8); PG8_BAR; PG8_WAIT_L(0); PG8_MMA(0, 0, At, B0); PG8_BAR; PG8_SCHED;
            PG8_LDB(B1, 0, 1); PG8_STAGE(PG8_SB(0, 0), b2, voffB);
            PG8_BAR; PG8_WAIT_L(0); PG8_MMA(0, 1, At, B1); PG8_BAR;
            PG8_LDA(At, 0, 1); PG8_STAGE(PG8_SA(0, 0), a2, voffA);
            PG8_BAR; PG8_WAIT_L(0); PG8_MMA(1, 0, At, B0); PG8_BAR; PG8_SCHED;
            PG8_STAGE(PG8_SB(0, 1), b2 + hstep, voffB);
            PG8_WAIT_V(6); PG8_BAR; PG8_MMA(1, 1, At, B1); PG8_BAR;
            PG8_LDB(B0, 1, 0); PG8_SCHED; PG8_LDA(At, 1, 0); PG8_STAGE(PG8_SA(0, 1), a2 + hstep, voffA);
            PG8_WAIT_L(8); PG8_BAR; PG8_WAIT_L(0); PG8_MMA(0, 0, At, B0); PG8_BAR; PG8_SCHED;
            PG8_LDB(B1, 1, 1); PG8_STAGE(PG8_SB(1, 0), b3, voffB);
            PG8_BAR; PG8_WAIT_L(0); PG8_MMA(0, 1, At, B1); PG8_BAR;
            PG8_LDA(At, 1, 1); PG8_STAGE(PG8_SA(1, 0), a3, voffA);
            PG8_BAR; PG8_WAIT_L(0); PG8_MMA(1, 0, At, B0); PG8_BAR; PG8_SCHED;
            PG8_STAGE(PG8_SB(1, 1), b3 + hstep, voffB);
            PG8_WAIT_V(6); PG8_BAR; PG8_MMA(1, 1, At, B1); PG8_BAR;
            }
        }
        if constexpr (ALIGN_EPI) { if (wr == 0) PG8_BAR; }
        if constexpr (!Epi::AFTER_DRAIN) { E(acc, cur, wr, wc, fr, fq); S.done(cur); }
        if (!has_next) break;
#pragma unroll
        for (int a = 0; a < 2; ++a)
#pragma unroll
            for (int b = 0; b < 2; ++b)
#pragma unroll
                for (int m = 0; m < 4; ++m)
#pragma unroll
                    for (int n = 0; n < 2; ++n) acc[a][b][m][n] = (f32x4){0.f, 0.f, 0.f, 0.f};
        cur = nxt; cA = nA; cB = nB; ++ui;
        if constexpr (ALIGN_EPI) { if (wr == 1) PG8_BAR; }
    }
    PG8_WAIT_V(0);
    if constexpr (!ALIGN_EPI) { if (wr == 0) PG8_BAR; }
    PG8_BAR;
    if constexpr (Epi::AFTER_DRAIN) { E.fused(acc, cur, wr, wc, fr, fq, lds, wid, lane); S.done(cur); }
#undef PG8_SA
#undef PG8_SB
#undef PG8_STAGE
#undef PG8_LDA
#undef PG8_LDB
#undef PG8_MMA
#undef PG8_WAIT_V
#undef PG8_WAIT_L
#undef PG8_BAR
#undef PG8_SCHED
}
}
constexpr int NWAVES = 8;
constexpr int BATCH = 4, T = 4096, D = 1024, M = BATCH * T;
constexpr int PROJ_W = 2832, NP = 3072, FF = 2816, NGU = 2 * FF, HD = 64;
constexpr int C_GQ = 0, C_GK = 512, C_GV = 1024, C_GZ = 1536, C_SQ = 2048, C_SK = 2560, C_SV = 2688, C_GA = 2816, C_GB = 2824;
constexpr float EPS = 1e-6f;
constexpr size_t MiB = 1u << 20;
constexpr size_t WS_CTL = 0, CTL_ZERO_BYTES = 256 * 1024;
constexpr size_t WS_MODF = 1 * MiB;
constexpr size_t WS_DEC = 1 * MiB + 384 * 1024;
constexpr size_t WS_WIN = 4 * MiB, WS_WOUT = 10 * MiB, WS_WGU = 12 * MiB, WS_WDN = 24 * MiB;
constexpr size_t WS_H = 32 * MiB;
constexpr size_t WS_PQ = 64 * MiB;
constexpr size_t WS_MIX = 160 * MiB;
constexpr size_t WS_CHKA = 192 * MiB;
constexpr size_t WS_END = 256 * MiB;
constexpr int CW_ADA = 1024;
constexpr int CW_BAR = 4096;
constexpr int CW_MODACC = 16384;
constexpr int RING_OFF = 0, RING_BYTES = 131072;
constexpr int LDS_BYTES = 163840;
constexpr int LDSCTL_OFF = LDS_BYTES - 1024, MISC_OFF = LDSCTL_OFF + 320;
#define GAS __attribute__((address_space(1)))
#define LAS __attribute__((address_space(3)))
typedef unsigned short bf16;
typedef unsigned v4u __attribute__((ext_vector_type(4)));
typedef float f32x4 __attribute__((ext_vector_type(4)));
typedef short bf16x8 __attribute__((ext_vector_type(8)));
typedef GAS unsigned gu32;
typedef GAS unsigned long long gu64;
#define RLX_AGENT __ATOMIC_RELAXED, __HIP_MEMORY_SCOPE_AGENT
#define LDS_WAIT() asm volatile("s_waitcnt lgkmcnt(0)" ::: "memory")
#define VM_WAIT() asm volatile("s_waitcnt vmcnt(0)" ::: "memory")
__device__ __forceinline__ unsigned long long rt() { return __builtin_amdgcn_s_memrealtime(); }
__device__ __forceinline__ unsigned f2bf(float f) { unsigned u = __builtin_bit_cast(unsigned, f); return (u + 0x7fffu + ((u >> 16) & 1u)) >> 16; }
__device__ __forceinline__ unsigned pk2(float lo, float hi) { return f2bf(lo) | (f2bf(hi) << 16); }

#define XB_TMO      128
#define XB_XCNT(j)  (256  + 64 * (j))
#define XB_XSUB(j)  (1280 + 64 * (j))
#define XB_XGEN(j)  (2304 + 64 * (j))
#define XB_TOP      3328
#define XB_TOPGEN   3392
#define XCD_BAR_WORDS 3456
#define XB_SPIN_CAP (1u << 22)

__device__ __forceinline__ unsigned xb_ld(unsigned* p)              { return __hip_atomic_load(p, __ATOMIC_RELAXED, __HIP_MEMORY_SCOPE_AGENT); }
__device__ __forceinline__ unsigned xb_add(unsigned* p, unsigned v) { return __hip_atomic_fetch_add(p, v, __ATOMIC_RELAXED, __HIP_MEMORY_SCOPE_AGENT); }
__device__ __forceinline__ unsigned xb_xcc_id() { return (unsigned)__builtin_amdgcn_s_getreg((3 << 11) | 20) & 0xFu; }
#define XB_SPIN(cond, bar) do { unsigned _sp = 0; while (cond) { __builtin_amdgcn_s_sleep(1); \
    if ((++_sp & 255u) == 0u) { if (xb_ld(&(bar)[XB_TMO])) break; if (_sp > XB_SPIN_CAP) { atomicAdd(&(bar)[XB_TMO], 1u); break; } } } } while (0)

struct XcdBarrier {
    unsigned* bar; unsigned x;
    volatile LAS unsigned* st;
};

__device__ __forceinline__ XcdBarrier xcd_barrier_post(unsigned* bar, volatile LAS unsigned* st) {
    XcdBarrier b; b.bar = bar; b.x = xb_xcc_id(); b.st = st;
    if (threadIdx.x == 0) (void)xb_add(&bar[XB_XCNT(b.x)], 1u);
    return b;
}
__device__ __forceinline__ void xcd_barrier_complete(unsigned* bar, unsigned x, unsigned& nloc, unsigned& nx) {
    const unsigned G = gridDim.x * gridDim.y * gridDim.z;
    unsigned sum, cnt, mine, sp = 0u;
    for (;;) {
        sum = 0u; cnt = 0u; mine = 0u;
#pragma unroll
        for (unsigned j = 0; j < 16; ++j) { const unsigned c = xb_ld(&bar[XB_XCNT(j)]); sum += c; cnt += (c > 0u) ? 1u : 0u; mine = (j == x) ? c : mine; }
        if (sum == G) break;
        __builtin_amdgcn_s_sleep(1);
        if ((++sp & 255u) == 0u) { if (xb_ld(&bar[XB_TMO])) break; if (sp > XB_SPIN_CAP) { atomicAdd(&bar[XB_TMO], 1u); break; } }
    }
    nloc = mine > 0u ? mine : 1u; nx = cnt > 0u ? cnt : 1u;
}

__device__ __forceinline__ void xcd_barrier(const XcdBarrier& b, int tid  ) {
    asm volatile("s_waitcnt vmcnt(0)" ::: "memory");
    __syncthreads();
    if (tid == 0) {
        unsigned* bar = b.bar;
        __builtin_amdgcn_s_waitcnt(0);
        unsigned nloc = b.st[0], nx = b.st[1];
        if (nloc == 0u) { xcd_barrier_complete(bar, b.x, nloc, nx); b.st[0] = nloc; b.st[1] = nx; }
        const unsigned old = xb_add(&bar[XB_XSUB(b.x)], 1u);
        const unsigned gen = old / nloc;
        if (old + 1u == (gen + 1u) * nloc) {
            __builtin_amdgcn_fence(__ATOMIC_RELEASE, "agent");
            asm volatile("s_waitcnt vmcnt(0)" ::: "memory");
            const unsigned og = xb_add(&bar[XB_TOP], 1u);
            const unsigned tg = og / nx;
            if (og + 1u == (tg + 1u) * nx) xb_add(&bar[XB_TOPGEN], 1u);
            else XB_SPIN(xb_ld(&bar[XB_TOPGEN]) == tg, bar);
            __builtin_amdgcn_fence(__ATOMIC_ACQUIRE, "agent");
            xb_add(&bar[XB_XGEN(b.x)], 1u);
            asm volatile("s_waitcnt vmcnt(0)" ::: "memory");
        } else {
            XB_SPIN(xb_ld(&bar[XB_XGEN(b.x)]) == gen, bar);
            __builtin_amdgcn_fence(__ATOMIC_ACQUIRE, "agent");
            asm volatile("s_waitcnt vmcnt(0)" ::: "memory");
        }
    }
    __syncthreads();
}
struct Frame {
    LAS unsigned char* lds;
    volatile LAS unsigned* MISC;
    gu32* ctl;
    int tid, lane, wave;
    int vcu, G;
    const float *x, *c, *w_ada, *b_ada, *norm1_w, *w_in, *conv_w, *a_log, *dt_bias, *gdn_norm_w, *q_norm_w, *k_norm_w, *sinks, *w_out, *norm2_w, *w_gate, *w_up, *w_down;
    float* out;
    float *modacc, *modf, *dec;
    bf16 *Win_t, *Wout_t, *Wgu_t, *Wdn_t, *H, *PQ, *MIX, *X1B, *CHKA, *CHKU, *CHKT, *ORAW;
};
template <int CTRL, int ROWMASK, bool BC>
__device__ __forceinline__ float dpp_mov(float v) { return __int_as_float(__builtin_amdgcn_update_dpp(0, __float_as_int(v), CTRL, ROWMASK, 0xF, BC)); }
__device__ __forceinline__ float sum8(float v) { v += dpp_mov<0xB1, 0xF, true>(v); v += dpp_mov<0x4E, 0xF, true>(v); v += dpp_mov<0x141, 0xF, true>(v); return v; }
__device__ __forceinline__ float wave_sum(float v) {
    v = sum8(v); v += dpp_mov<0x140, 0xF, true>(v);
    v += dpp_mov<0x142, 0xA, false>(v); v += dpp_mov<0x143, 0xC, false>(v);
    return __int_as_float(__builtin_amdgcn_readlane(__float_as_int(v), 63));
}
__device__ __forceinline__ float fq_sum(float v) {
    auto r = __builtin_amdgcn_permlane16_swap(__float_as_uint(v), __float_as_uint(v), false, false); v = __uint_as_float(r[0]) + __uint_as_float(r[1]);
    auto s = __builtin_amdgcn_permlane32_swap(__float_as_uint(v), __float_as_uint(v), false, false); return __uint_as_float(s[0]) + __uint_as_float(s[1]);
}
__device__ __forceinline__ float fq_max(float v) {
    auto r = __builtin_amdgcn_permlane16_swap(__float_as_uint(v), __float_as_uint(v), false, false); v = fmaxf(__uint_as_float(r[0]), __uint_as_float(r[1]));
    auto s = __builtin_amdgcn_permlane32_swap(__float_as_uint(v), __float_as_uint(v), false, false); return fmaxf(__uint_as_float(s[0]), __uint_as_float(s[1]));
}
typedef float f32x2_t __attribute__((ext_vector_type(2))); typedef __bf16 bf16x2_t __attribute__((ext_vector_type(2)));
__device__ __forceinline__ unsigned cvtpk(float lo, float hi) { f32x2_t v = {lo, hi}; bf16x2_t b = __builtin_convertvector(v, bf16x2_t); return __builtin_bit_cast(unsigned, b); }
__device__ __forceinline__ float bf2f(bf16 h) { return __uint_as_float((unsigned)h << 16); }
__device__ __forceinline__ float ld_f32_coh(const float* p) { return __uint_as_float(__hip_atomic_load((const unsigned*)p, RLX_AGENT)); }
__device__ __forceinline__ float silu(float x) { return x * __builtin_amdgcn_rcpf(1.0f + __expf(-x)); }
__device__ __forceinline__ float rsq(float x) { return __builtin_amdgcn_rsqf(x); }

__device__ __forceinline__ void tr_item64(const float* W, int ldw, int src_col, bf16* WT, int K, int dst_row, int k0, LAS bf16* tl, int lane) {
    const int cg = lane & 15, rr = lane >> 4;
    f32x4 v[16];
#pragma unroll
    for (int i = 0; i < 16; ++i) v[i] = *(const GAS f32x4*)(W + (size_t)(k0 + 4 * i + rr) * ldw + src_col + 4 * cg);
#pragma unroll
    for (int i = 0; i < 16; ++i) *(LAS unsigned long long*)(tl + (4 * i + rr) * 68 + 4 * cg) = (unsigned long long)cvtpk(v[i].x, v[i].y) | ((unsigned long long)cvtpk(v[i].z, v[i].w) << 32);
    LDS_WAIT(); asm volatile("" ::: "memory");
#pragma unroll
    for (int ii = 0; ii < 8; ++ii) { const int p = lane + 64 * ii, n = p >> 3, kc = p & 7; const LAS bf16* s = tl + (8 * kc) * 68 + n;
        v4u o; o.x = (unsigned)s[0] | ((unsigned)s[68] << 16); o.y = (unsigned)s[2 * 68] | ((unsigned)s[3 * 68] << 16); o.z = (unsigned)s[4 * 68] | ((unsigned)s[5 * 68] << 16); o.w = (unsigned)s[6 * 68] | ((unsigned)s[7 * 68] << 16);
        *(GAS v4u*)(WT + (size_t)(dst_row + n) * K + k0 + 8 * kc) = o; }
    LDS_WAIT(); asm volatile("" ::: "memory");
}

__device__ __forceinline__ void p0_prologue(Frame& F) {
    LAS bf16* tl = (LAS bf16*)(F.lds + RING_OFF + F.wave * 16384);
    const int gw = F.vcu * NWAVES + F.wave, NGW = F.G * NWAVES, lane = F.lane;
    if ((int)blockIdx.x < 24 * 8) {
        const int ct = blockIdx.x % 24, kg = blockIdx.x / 24, col = ct * 256 + 4 * lane, k0 = kg * 128 + F.wave * 16;
        f32x4 w[16];
#pragma unroll
        for (int kk = 0; kk < 16; ++kk) w[kk] = *(const GAS f32x4*)(F.w_ada + (size_t)(k0 + kk) * (6 * D) + col);
        f32x4 acc[4];
#pragma unroll
        for (int b = 0; b < 4; ++b) acc[b] = (f32x4){0.f, 0.f, 0.f, 0.f};
#pragma unroll
        for (int kk = 0; kk < 16; ++kk)
#pragma unroll
            for (int b = 0; b < 4; ++b) acc[b] += silu(F.c[b * D + k0 + kk]) * w[kk];
        LAS f32x4* rd = (LAS f32x4*)(F.lds + RING_OFF + F.wave * 16384 + 12288);
#pragma unroll
        for (int b = 0; b < 4; ++b) rd[b * 64 + lane] = acc[b];
        __syncthreads();
#pragma unroll
        for (int j = 0; j < 2; ++j) { const int e = F.tid * 2 + j, bb = e >> 8, c = e & 255; float s = 0.f;
#pragma unroll
            for (int wv = 0; wv < 8; ++wv) s += ((const LAS float*)(F.lds + RING_OFF + wv * 16384 + 12288))[(bb * 64 + (c >> 2)) * 4 + (c & 3)];
            const float prev = atomicAdd(F.modacc + bb * (6 * D) + ct * 256 + c, s); asm volatile("" :: "v"(prev)); }
        __syncthreads();
        if (F.tid == 0) (void)xb_add((unsigned*)(F.ctl + CW_ADA), 1u);
    }
    constexpr int I_IN = 16 * (NP / 64), I_OUT = 16 * 16, I_GU = 16 * (NGU / 64), I_DN = (FF / 64) * 16;
    constexpr int NITEMS = I_IN + I_OUT + I_GU + I_DN;
    for (int it = gw; it < NITEMS; it += NGW) {
        int r = it;
        if (r < I_IN) { const int nb = r % (NP / 64), kb = r / (NP / 64), n0 = 64 * nb;
            tr_item64(F.w_in, PROJ_W, n0 < 2048 ? n0 : (n0 < 2816 ? n0 + 16 : (n0 == 2816 ? 2048 : 0)), F.Win_t, D, n0, 64 * kb, tl, lane); continue; }
        r -= I_IN;
        if (r < I_OUT) { const int nb = r % 16, kb = r / 16; tr_item64(F.w_out, D, 64 * nb, F.Wout_t, D, 64 * nb, 64 * kb, tl, lane); continue; }
        r -= I_OUT;
        if (r < I_GU) { const int nb = r % (NGU / 64), kb = r / (NGU / 64), n0 = 64 * nb, p = n0 >> 8, j = n0 & 255;
            if (j < 128) tr_item64(F.w_gate, FF, 128 * p + j, F.Wgu_t, D, n0, 64 * kb, tl, lane);
            else         tr_item64(F.w_up,   FF, 128 * p + j - 128, F.Wgu_t, D, n0, 64 * kb, tl, lane);
            continue; }
        r -= I_GU;
        { const int nb = r % 16, kb = r / 16; tr_item64(F.w_down, D, 64 * nb, F.Wdn_t, FF, 64 * nb, 64 * kb, tl, lane); }
    }
}

template <int WHICH> __device__ __forceinline__ void norm_phase(Frame& F) {
    const int gw = F.vcu * NWAVES + F.wave, NGW = F.G * NWAVES, lane = F.lane;
    if (WHICH == 1) {
        if (F.tid == 0) { unsigned* bw = (unsigned*)(F.ctl + CW_BAR); XB_SPIN(xb_ld((unsigned*)(F.ctl + CW_ADA)) < 192u, bw); __builtin_amdgcn_fence(__ATOMIC_ACQUIRE, "agent"); asm volatile("s_waitcnt vmcnt(0)" ::: "memory"); }
        __syncthreads();
        for (int idx = gw * 64 + lane; idx < 4 * 6 * D; idx += NGW * 64) F.modf[idx] = F.modacc[idx] + F.b_ada[idx % (6 * D)];
    }
    const float* nw = (WHICH == 1) ? F.norm1_w : F.norm2_w;
    constexpr int R = (WHICH == 1) ? 4 : 8;
    for (int m0 = gw * R; m0 < M; m0 += NGW * R) {
        const int b = m0 / T;
        f32x4 v[R][4];
#pragma unroll
        for (int r = 0; r < R; ++r) {
            if (WHICH == 1) { const GAS f32x4* xr = (const GAS f32x4*)(F.x + (size_t)(m0 + r) * D) + lane;
#pragma unroll
                for (int i = 0; i < 4; ++i) v[r][i] = xr[64 * i]; }
            else { const GAS unsigned long long* xr = (const GAS unsigned long long*)(F.X1B + (size_t)(m0 + r) * D) + lane;
#pragma unroll
                for (int i = 0; i < 4; ++i) { const unsigned long long bb = xr[64 * i]; const unsigned lo = (unsigned)bb, hi = (unsigned)(bb >> 32);
                    v[r][i] = (f32x4){__uint_as_float(lo << 16), __uint_as_float(lo & 0xffff0000u), __uint_as_float(hi << 16), __uint_as_float(hi & 0xffff0000u)}; } } }
        f32x4 gm[4], sh[4];
#pragma unroll
        for (int i = 0; i < 4; ++i) { const int c = 256 * i + 4 * lane; f32x4 sc, sf;
            if (WHICH == 1) { sf = *(const GAS f32x4*)(F.modacc + b * 6 * D + c) + *(const GAS f32x4*)(F.b_ada + c); sc = *(const GAS f32x4*)(F.modacc + b * 6 * D + D + c) + *(const GAS f32x4*)(F.b_ada + D + c); }
            else { sf = *(const GAS f32x4*)(F.modf + b * 6 * D + 3 * D + c); sc = *(const GAS f32x4*)(F.modf + b * 6 * D + 4 * D + c); }
            gm[i] = *(const GAS f32x4*)(nw + c) * (sc + 1.0f); sh[i] = sf; }
#pragma unroll
        for (int r = 0; r < R; ++r) {
            float ss = 0.f;
#pragma unroll
            for (int i = 0; i < 4; ++i) ss += (v[r][i].x * v[r][i].x + v[r][i].y * v[r][i].y) + (v[r][i].z * v[r][i].z + v[r][i].w * v[r][i].w);
            const float rstd = rsq(wave_sum(ss) * (1.0f / D) + EPS);
            GAS unsigned long long* o8 = (GAS unsigned long long*)(F.H + (size_t)(m0 + r) * D) + lane;
#pragma unroll
            for (int i = 0; i < 4; ++i) { const f32x4 a = v[r][i] * rstd * gm[i] + sh[i];
                o8[64 * i] = (unsigned long long)cvtpk(a[0], a[1]) | ((unsigned long long)cvtpk(a[2], a[3]) << 32); }
        }
    }
}

__device__ __forceinline__ float rdlane(float v, int l) { return __int_as_float(__builtin_amdgcn_readlane(__float_as_int(v), l)); }
__device__ __forceinline__ bf16x8 pack8(const f32x4 a, const f32x4 b) {
    v4u w; w.x = cvtpk(a[0], a[1]); w.y = cvtpk(a[2], a[3]); w.z = cvtpk(b[0], b[1]); w.w = cvtpk(b[2], b[3]); return __builtin_bit_cast(bf16x8, w); }
__device__ __forceinline__ bf16x8 tile_frag(const LAS bf16* tile, int t, int ks, int fr, int fq) {
    const LAS bf16* p = tile + (16 * t + fr) * 64 + 32 * ks + 4 * fq;
    const unsigned long long lo = *(const LAS unsigned long long*)p, hi = *(const LAS unsigned long long*)(p + 16);
    v4u v; v.x = (unsigned)lo; v.y = (unsigned)(lo >> 32); v.z = (unsigned)hi; v.w = (unsigned)(hi >> 32); return __builtin_bit_cast(bf16x8, v);
}
__device__ __forceinline__ unsigned long long pack4(float a, float b, float c, float d) { return (unsigned long long)cvtpk(a, b) | ((unsigned long long)cvtpk(c, d) << 32); }

typedef short s16x4 __attribute__((ext_vector_type(4)));
__device__ __forceinline__ s16x4 cvt4(const f32x4 v) { const unsigned lo = cvtpk(v[0], v[1]), hi = cvtpk(v[2], v[3]); typedef unsigned u32x2 __attribute__((ext_vector_type(2))); return __builtin_bit_cast(s16x4, (u32x2){lo, hi}); }
#define MFMA16(a, b, c) __builtin_amdgcn_mfma_f32_16x16x16bf16_1k((a), (b), (c), 0, 0, 0)
#define MFMA32(a, b, c) __builtin_amdgcn_mfma_f32_16x16x32_bf16((a), (b), (c), 0, 0, 0)

__device__ __forceinline__ void gdn_prep_chunk(Frame& F, int ci, LAS unsigned char* wl  ) {
    const int lane = F.lane, bh = ci >> 6, n = ci & 63, b = bh >> 3, hh = bh & 7, fr = lane & 15, fq = lane >> 4;
    const size_t m0 = (size_t)b * T + 64 * n;
    bf16* const cA = F.CHKA + (size_t)ci * 8192;
    bf16* const cT = F.CHKT + (size_t)ci * 8192;
    bf16* const cU = F.CHKU + (size_t)ci * 8192;
    LAS bf16* const R0 = (LAS bf16*)wl;
    LAS bf16* const R1 = (LAS bf16*)(wl + 9728);
#define GDN_RAW(dst, col0) do { _Pragma("unroll") for (int i_ = 0; i_ < 9; ++i_) { long row_ = (long)m0 - 3 + 8 * i_ + (lane >> 3); row_ = row_ < 0 ? 0 : (row_ > M - 1 ? M - 1 : row_); \
        __builtin_amdgcn_global_load_lds((const unsigned*)(F.PQ + (size_t)row_ * NP + (col0) + hh * 64 + (lane & 7) * 8), (LAS unsigned*)((dst) + i_ * 512), 16, 0, 0); } } while (0)
    GDN_RAW(R0, C_GQ); GDN_RAW(R1, C_GK);
    const f32x4 z4 = (f32x4){0.f, 0.f, 0.f, 0.f};
    float g, beta;
    {
        const float ga = bf2f(F.PQ[(m0 + lane) * NP + C_GA + hh]), gbv = bf2f(F.PQ[(m0 + lane) * NP + C_GB + hh]);
        const float xx = ga + F.dt_bias[hh]; g = -__expf(F.a_log[hh]) * (fmaxf(xx, 0.f) + log1pf(__expf(-fabsf(xx)))); beta = __builtin_amdgcn_rcpf(1.0f + __expf(-gbv));
    }
    float G = g;
#pragma unroll
    for (int o = 1; o < 64; o <<= 1) { const float t = __shfl_up(G, o); if (lane >= o) G += t; }
    const float eG = __expf(G), Glast = __shfl(G, 63), kdsc = __expf(Glast - G), beG = beta * eG;
    if (lane == 0) F.dec[ci] = __expf(Glast);
    asm volatile("s_waitcnt vmcnt(0)" ::: "memory");
    {
        const f32x2_t w0 = {F.conv_w[hh * 64 + lane], F.conv_w[512 + hh * 64 + lane]}, w1 = {F.conv_w[1536 + hh * 64 + lane], F.conv_w[1536 + 512 + hh * 64 + lane]};
        const f32x2_t w2 = {F.conv_w[2 * 1536 + hh * 64 + lane], F.conv_w[2 * 1536 + 512 + hh * 64 + lane]}, w3 = {F.conv_w[3 * 1536 + hh * 64 + lane], F.conv_w[3 * 1536 + 512 + hh * 64 + lane]};
        f32x2_t x0 = {0.f, 0.f}, x1 = {0.f, 0.f}, x2 = {0.f, 0.f};
        if (n > 0) { x0 = (f32x2_t){bf2f(R0[lane]), bf2f(R1[lane])}; x1 = (f32x2_t){bf2f(R0[64 + lane]), bf2f(R1[64 + lane])}; x2 = (f32x2_t){bf2f(R0[128 + lane]), bf2f(R1[128 + lane])}; }
#pragma unroll
        for (int c0 = 0; c0 < 64; c0 += 8) {
            unsigned rq[8], rk[8];
#pragma unroll
            for (int j = 0; j < 8; ++j) { rq[j] = R0[(c0 + j + 3) * 64 + lane]; rk[j] = R1[(c0 + j + 3) * 64 + lane]; }
            __builtin_amdgcn_sched_barrier(0);
#pragma unroll
            for (int j = 0; j < 8; ++j) {
                const f32x2_t r = {__uint_as_float(rq[j] << 16), __uint_as_float(rk[j] << 16)};
                const f32x2_t t = w0 * x0 + w1 * x1 + w2 * x2 + w3 * r; x0 = x1; x1 = x2; x2 = r;
                const f32x2_t e = t * -1.44269504f;
                const f32x2_t d = (f32x2_t){__builtin_amdgcn_exp2f(e.x), __builtin_amdgcn_exp2f(e.y)} + 1.0f;
                const f32x2_t sv = t * (f32x2_t){__builtin_amdgcn_rcpf(d.x), __builtin_amdgcn_rcpf(d.y)};
                const unsigned pk = cvtpk(sv.x, sv.y);
                R0[(c0 + j) * 64 + lane] = (bf16)(pk & 0xffffu); R1[(c0 + j) * 64 + lane] = (bf16)(pk >> 16);
            }
            __builtin_amdgcn_sched_barrier(0);
        }
    }
    LDS_WAIT(); asm volatile("" ::: "memory"); __builtin_amdgcn_sched_barrier(0);
    bf16x8 kf[4][2], qf[4][2];
#pragma unroll
    for (int blk = 0; blk < 4; ++blk)
#pragma unroll
        for (int kk = 0; kk < 2; ++kk) { kf[blk][kk] = *(const LAS bf16x8*)(R1 + (16 * blk + fr) * 64 + 32 * kk + 8 * fq); qf[blk][kk] = *(const LAS bf16x8*)(R0 + (16 * blk + fr) * 64 + 32 * kk + 8 * fq); }
    float rqc[4], rkc[4];
#pragma unroll
    for (int t = 0; t < 4; ++t) { f32x4 dq = MFMA32(qf[t][0], qf[t][0], z4); dq = MFMA32(qf[t][1], qf[t][1], dq); f32x4 dk = MFMA32(kf[t][0], kf[t][0], z4); dk = MFMA32(kf[t][1], kf[t][1], dk);
        const int di = fr & 3; const bool on = (fq == (fr >> 2));
        const float vq = di == 0 ? dq[0] : di == 1 ? dq[1] : di == 2 ? dq[2] : dq[3], vk = di == 0 ? dk[0] : di == 1 ? dk[1] : di == 2 ? dk[2] : dk[3];
        rqc[t] = rsq(fq_sum(on ? vq : 0.f) + EPS); rkc[t] = rsq(fq_sum(on ? vk : 0.f) + EPS); }
    const float rk_tok = fq == 0 ? rkc[0] : fq == 1 ? rkc[1] : fq == 2 ? rkc[2] : rkc[3];
    const float beGn = beG * rk_tok, kdscn = kdsc * rk_tok;
    float Gcol[4], Bcol[4];
#pragma unroll
    for (int t = 0; t < 4; ++t) { Gcol[t] = __shfl(G, 16 * t + fr); Bcol[t] = __shfl(beta, 16 * t + fr) * rkc[t]; }
#pragma unroll
    for (int mt = 0; mt < 4; ++mt) { const float esc = __expf(Gcol[mt]) * 0.125f * rqc[mt];
#pragma unroll
        for (int ks = 0; ks < 2; ++ks) { const v4u q8 = __builtin_bit_cast(v4u, tile_frag(R0, mt, ks, fr, fq)); const unsigned w_[4] = {q8.x, q8.y, q8.z, q8.w}; v4u o_;
            o_.x = cvtpk(__uint_as_float(w_[0] << 16) * esc, __uint_as_float(w_[0] & 0xffff0000u) * esc); o_.y = cvtpk(__uint_as_float(w_[1] << 16) * esc, __uint_as_float(w_[1] & 0xffff0000u) * esc);
            o_.z = cvtpk(__uint_as_float(w_[2] << 16) * esc, __uint_as_float(w_[2] & 0xffff0000u) * esc); o_.w = cvtpk(__uint_as_float(w_[3] << 16) * esc, __uint_as_float(w_[3] & 0xffff0000u) * esc);
            *(GAS v4u*)(cT + ((mt * 2 + ks) * 64 + lane) * 8) = o_; } }
    LDS_WAIT(); asm volatile("" ::: "memory"); __builtin_amdgcn_sched_barrier(0);
#pragma unroll
    for (int ks = 0; ks < 2; ++ks) { float Grow[2][4], Krow[2][4];
#pragma unroll
        for (int h2 = 0; h2 < 2; ++h2)
#pragma unroll
            for (int i = 0; i < 4; ++i) { Grow[h2][i] = __shfl(G, 16 * (2 * ks + h2) + 4 * fq + i); Krow[h2][i] = __shfl(rk_tok, 16 * (2 * ks + h2) + 4 * fq + i); }
#pragma unroll
        for (int tc = 0; tc < 4; ++tc) {
            f32x4 v[2];
#pragma unroll
            for (int h2 = 0; h2 < 2; ++h2) { const int ts = 2 * ks + h2;
                if (ts <= tc) { f32x4 acc = MFMA32(kf[ts][0], qf[tc][0], z4); acc = MFMA32(kf[ts][1], qf[tc][1], acc);
#pragma unroll
                    for (int i = 0; i < 4; ++i) { const int cidx = 16 * tc + fr, sidx = 16 * ts + 4 * fq + i; v[h2][i] = (cidx >= sidx) ? acc[i] * __expf(Gcol[tc] - Grow[h2][i]) * (0.125f * rqc[tc]) * Krow[h2][i] : 0.f; }
                } else v[h2] = z4; }
            *(bf16x8*)(cT + 4096 + ((tc * 2 + ks) * 64 + lane) * 8) = pack8(v[0], v[1]);
        } }
#pragma unroll
    for (int ts = 0; ts < 4; ++ts) { float Grow[4], Krow[4];
#pragma unroll
        for (int i = 0; i < 4; ++i) { Grow[i] = __shfl(G, 16 * ts + 4 * fq + i); Krow[i] = __shfl(rk_tok, 16 * ts + 4 * fq + i); }
#pragma unroll
        for (int tc = 0; tc < 4; ++tc) { f32x4 a = z4;
            if (ts <= tc) { f32x4 acc = MFMA32(kf[ts][0], kf[tc][0], z4); acc = MFMA32(kf[ts][1], kf[tc][1], acc);
#pragma unroll
                for (int i = 0; i < 4; ++i) { const int cidx = 16 * tc + fr, sidx = 16 * ts + 4 * fq + i; a[i] = (cidx > sidx) ? Bcol[tc] * Krow[i] * acc[i] * __expf(Gcol[tc] - Grow[i]) : 0.f; } }
            *(LAS unsigned long long*)(R0 + (16 * tc + fr) * 64 + 16 * ts + 4 * fq) = pack4(a[0], a[1], a[2], a[3]); } }
    bf16x8 RkB[4][2], KDf[4][2];
#pragma unroll
    for (int ks = 0; ks < 2; ++ks) { float sB[8], sD[8];
#pragma unroll
        for (int j = 0; j < 8; ++j) { const int tok = 32 * ks + 16 * (j >> 2) + 4 * fq + (j & 3); sB[j] = __shfl(beGn, tok); sD[j] = __shfl(kdscn, tok); }
#pragma unroll
        for (int t = 0; t < 4; ++t) { float kv[8];
#pragma unroll
            for (int j = 0; j < 8; ++j) kv[j] = bf2f(R1[(32 * ks + 16 * (j >> 2) + 4 * fq + (j & 3)) * 64 + 16 * t + fr]);
            v4u a_, d_;
            a_.x = cvtpk(kv[0] * sB[0], kv[1] * sB[1]); a_.y = cvtpk(kv[2] * sB[2], kv[3] * sB[3]); a_.z = cvtpk(kv[4] * sB[4], kv[5] * sB[5]); a_.w = cvtpk(kv[6] * sB[6], kv[7] * sB[7]);
            d_.x = cvtpk(kv[0] * sD[0], kv[1] * sD[1]); d_.y = cvtpk(kv[2] * sD[2], kv[3] * sD[3]); d_.z = cvtpk(kv[4] * sD[4], kv[5] * sD[5]); d_.w = cvtpk(kv[6] * sD[6], kv[7] * sD[7]);
            RkB[t][ks] = __builtin_bit_cast(bf16x8, a_); KDf[t][ks] = __builtin_bit_cast(bf16x8, d_); } }
    LDS_WAIT(); asm volatile("" ::: "memory"); __builtin_amdgcn_sched_barrier(0);
    {
        float X[16];
#pragma unroll
        for (int r = 0; r < 16; ++r) X[r] = (r == fr) ? 1.f : 0.f;
        const LAS bf16* ab = R0 + (16 * fq) * 64 + 16 * fq;
#pragma unroll
        for (int s = 0; s < 15; ++s) {
#pragma unroll
            for (int r = s + 1; r < 16; ++r) X[r] -= bf2f(ab[r * 64 + s]) * X[s];
            if ((s & 3) == 3) __builtin_amdgcn_sched_barrier(0);
        }
        LDS_WAIT(); asm volatile("" ::: "memory"); __builtin_amdgcn_sched_barrier(0);
#pragma unroll
        for (int r = 0; r < 16; ++r) R0[(16 * fq + r) * 64 + 16 * fq + fr] = (bf16)(cvtpk(X[r], X[r]) & 0xffffu);
    }
    LDS_WAIT(); asm volatile("" ::: "memory"); __builtin_amdgcn_sched_barrier(0);
    {
#define A16(i, k) (*(const LAS s16x4*)(R0 + (16 * (i) + fr) * 64 + 16 * (k) + 4 * fq))
        s16x4 Td[4];
#pragma unroll
        for (int j = 0; j < 3; ++j) { const LAS bf16* p = R0 + (16 * j + 4 * fq) * 64 + 16 * j + fr; typedef unsigned u32x2 __attribute__((ext_vector_type(2)));
            Td[j] = __builtin_bit_cast(s16x4, (u32x2){(unsigned)p[0] | ((unsigned)p[64] << 16), (unsigned)p[128] | ((unsigned)p[192] << 16)}); }
        f32x4 m10 = MFMA16(A16(1, 0), Td[0], z4);
        const f32x4 t10 = -MFMA16(A16(1, 1), cvt4(m10), z4);
        f32x4 m21 = MFMA16(A16(2, 1), Td[1], z4);
        f32x4 m20 = MFMA16(A16(2, 0), Td[0], z4); m20 = MFMA16(A16(2, 1), cvt4(t10), m20);
        const s16x4 a22 = A16(2, 2);
        const f32x4 t21 = -MFMA16(a22, cvt4(m21), z4), t20 = -MFMA16(a22, cvt4(m20), z4);
        f32x4 m32 = MFMA16(A16(3, 2), Td[2], z4);
        f32x4 m31 = MFMA16(A16(3, 1), Td[1], z4); m31 = MFMA16(A16(3, 2), cvt4(t21), m31);
        f32x4 m30 = MFMA16(A16(3, 0), Td[0], z4); m30 = MFMA16(A16(3, 1), cvt4(t10), m30); m30 = MFMA16(A16(3, 2), cvt4(t20), m30);
        const s16x4 a33 = A16(3, 3);
        const f32x4 t32 = -MFMA16(a33, cvt4(m32), z4), t31 = -MFMA16(a33, cvt4(m31), z4), t30 = -MFMA16(a33, cvt4(m30), z4);
        LDS_WAIT(); asm volatile("" ::: "memory"); __builtin_amdgcn_sched_barrier(0);
#define TST(i, j, t) do { _Pragma("unroll") for (int r_ = 0; r_ < 4; ++r_) R0[(16 * (i) + 4 * fq + r_) * 64 + 16 * (j) + fr] = (bf16)(cvtpk((t)[r_], (t)[r_]) & 0xffffu); } while (0)
        TST(1, 0, t10); TST(2, 0, t20); TST(2, 1, t21); TST(3, 0, t30); TST(3, 1, t31); TST(3, 2, t32);
#undef TST
#undef A16
    }
    LDS_WAIT(); asm volatile("" ::: "memory"); __builtin_amdgcn_sched_barrier(0);
#pragma unroll
    for (int ct = 0; ct < 4; ++ct) { const bf16x8 ta0 = tile_frag(R0, ct, 0, fr, fq), ta1 = tile_frag(R0, ct, 1, fr, fq);
#pragma unroll
        for (int dt = 0; dt < 4; ++dt) { f32x4 acc = MFMA32(ta0, RkB[dt][0], z4); if (ct >= 2) acc = MFMA32(ta1, RkB[dt][1], acc);
            *(LAS unsigned long long*)(R1 + (16 * dt + fr) * 64 + 16 * ct + 4 * fq) = pack4(acc[0], acc[1], acc[2], acc[3]); } }
    LDS_WAIT(); asm volatile("" ::: "memory");
    asm volatile("s_waitcnt vmcnt(0)" ::: "memory");
    v4u qdf[8]; bf16x8 qkf[8];
#pragma unroll
    for (int f = 0; f < 8; ++f) { qdf[f] = *(const GAS v4u*)(cT + (f * 64 + lane) * 8); qkf[f] = *(const GAS bf16x8*)(cT + 4096 + (f * 64 + lane) * 8); }
    bf16x8 waf[4][2];
#pragma unroll
    for (int tm = 0; tm < 4; ++tm) { waf[tm][0] = tile_frag(R1, tm, 0, fr, fq); waf[tm][1] = tile_frag(R1, tm, 1, fr, fq); }
    LDS_WAIT(); asm volatile("" ::: "memory");
    GDN_RAW(R1, C_GV);
#pragma unroll
    for (int tn = 0; tn < 4; ++tn) {
#pragma unroll
        for (int ks2 = 0; ks2 < 2; ++ks2) {
            const v4u qd8 = qdf[tn * 2 + ks2]; const unsigned qw_[4] = {qd8.x, qd8.y, qd8.z, qd8.w};
            f32x4 pp[2], q2[2];
#pragma unroll
            for (int h2 = 0; h2 < 2; ++h2) { const int tm = 2 * ks2 + h2;
                f32x4 a1 = MFMA32(waf[tm][0], KDf[tn][0], z4); a1 = MFMA32(waf[tm][1], KDf[tn][1], a1);
                f32x4 a2 = MFMA32(waf[tm][0], qkf[tn * 2], z4); a2 = MFMA32(waf[tm][1], qkf[tn * 2 + 1], a2);
                pp[h2] = -a1;
                q2[h2] = (f32x4){__uint_as_float(qw_[2 * h2] << 16), __uint_as_float(qw_[2 * h2] & 0xffff0000u), __uint_as_float(qw_[2 * h2 + 1] << 16), __uint_as_float(qw_[2 * h2 + 1] & 0xffff0000u)} - a2; }
            *(GAS bf16x8*)(cA + ((tn * 2 + ks2) * 64 + lane) * 8) = pack8(pp[0], pp[1]);
            *(GAS bf16x8*)(cA + 4096 + ((tn * 2 + ks2) * 64 + lane) * 8) = pack8(q2[0], q2[1]);
        }
    }
    asm volatile("s_waitcnt vmcnt(0)" ::: "memory");
    {
        const float ws0 = F.conv_w[1024 + hh * 64 + lane], ws1 = F.conv_w[1536 + 1024 + hh * 64 + lane], ws2 = F.conv_w[2 * 1536 + 1024 + hh * 64 + lane], ws3 = F.conv_w[3 * 1536 + 1024 + hh * 64 + lane];
        const f32x2_t w0 = {ws0, ws0}, w1 = {ws1, ws1}, w2 = {ws2, ws2}, w3 = {ws3, ws3};
        const unsigned s0 = R1[32 * 64 + lane], s1 = R1[33 * 64 + lane], s2 = R1[34 * 64 + lane];
        f32x2_t x0 = {0.f, __uint_as_float(s0 << 16)}, x1 = {0.f, __uint_as_float(s1 << 16)}, x2 = {0.f, __uint_as_float(s2 << 16)};
        if (n > 0) { x0.x = bf2f(R1[lane]); x1.x = bf2f(R1[64 + lane]); x2.x = bf2f(R1[128 + lane]); }
#pragma unroll
        for (int c0 = 0; c0 < 32; c0 += 8) {
            unsigned ra[8], rb[8];
#pragma unroll
            for (int j = 0; j < 8; ++j) { const int c = c0 + j; ra[j] = (c + 3 < 32) ? (unsigned)R1[(c + 3) * 64 + lane] : (c + 3 == 32 ? s0 : (c + 3 == 33 ? s1 : s2)); rb[j] = R1[(c + 35) * 64 + lane]; }
            __builtin_amdgcn_sched_barrier(0);
#pragma unroll
            for (int j = 0; j < 8; ++j) { const int c = c0 + j;
                const f32x2_t r = {__uint_as_float(ra[j] << 16), __uint_as_float(rb[j] << 16)};
                const f32x2_t t = w0 * x0 + w1 * x1 + w2 * x2 + w3 * r; x0 = x1; x1 = x2; x2 = r;
                const f32x2_t e = t * -1.44269504f;
                const f32x2_t d = (f32x2_t){__builtin_amdgcn_exp2f(e.x), __builtin_amdgcn_exp2f(e.y)} + 1.0f;
                const f32x2_t sv = t * (f32x2_t){__builtin_amdgcn_rcpf(d.x), __builtin_amdgcn_rcpf(d.y)};
                const unsigned pk = cvtpk(sv.x, sv.y);
                R1[c * 64 + lane] = (bf16)(pk & 0xffffu); R1[(c + 32) * 64 + lane] = (bf16)(pk >> 16);
            }
            __builtin_amdgcn_sched_barrier(0);
        }
    }
    LDS_WAIT(); asm volatile("" ::: "memory"); __builtin_amdgcn_sched_barrier(0);
    bf16x8 RvB[4][2];
#pragma unroll
    for (int ks = 0; ks < 2; ++ks) { float sB[8];
#pragma unroll
        for (int j = 0; j < 8; ++j) sB[j] = __shfl(beta, 32 * ks + 16 * (j >> 2) + 4 * fq + (j & 3));
#pragma unroll
        for (int t = 0; t < 4; ++t) { float vv[8];
#pragma unroll
            for (int j = 0; j < 8; ++j) vv[j] = bf2f(R1[(32 * ks + 16 * (j >> 2) + 4 * fq + (j & 3)) * 64 + 16 * t + fr]) * sB[j];
            v4u a_; a_.x = cvtpk(vv[0], vv[1]); a_.y = cvtpk(vv[2], vv[3]); a_.z = cvtpk(vv[4], vv[5]); a_.w = cvtpk(vv[6], vv[7]);
            RvB[t][ks] = __builtin_bit_cast(bf16x8, a_); } }
    LDS_WAIT(); asm volatile("" ::: "memory"); __builtin_amdgcn_sched_barrier(0);
#pragma unroll
    for (int ct = 0; ct < 4; ++ct) { const bf16x8 ta0 = tile_frag(R0, ct, 0, fr, fq), ta1 = tile_frag(R0, ct, 1, fr, fq);
#pragma unroll
        for (int et = 0; et < 4; ++et) { f32x4 acc = MFMA32(ta0, RvB[et][0], z4); if (ct >= 2) acc = MFMA32(ta1, RvB[et][1], acc);
            *(LAS unsigned long long*)(R1 + (16 * et + fr) * 64 + 16 * ct + 4 * fq) = pack4(acc[0], acc[1], acc[2], acc[3]); } }
    LDS_WAIT(); asm volatile("" ::: "memory"); __builtin_amdgcn_sched_barrier(0);
#pragma unroll
    for (int et = 0; et < 4; ++et) {
        const bf16x8 ub0 = tile_frag(R1, et, 0, fr, fq), ub1 = tile_frag(R1, et, 1, fr, fq);
#pragma unroll
        for (int tm = 0; tm < 4; ++tm) {
            const bf16x8 qa0 = qkf[tm * 2], qa1 = qkf[tm * 2 + 1];
            f32x4 r = MFMA32(KDf[tm][0], ub0, z4); r = MFMA32(KDf[tm][1], ub1, r);
            f32x4 o = MFMA32(qa0, ub0, z4); o = MFMA32(qa1, ub1, o);
            *(GAS unsigned long long*)(cU + ((et * 4 + tm) * 64 + lane) * 4) = pack4(r[0], r[1], r[2], r[3]);
            *(GAS unsigned long long*)(cU + 4096 + ((et * 4 + tm) * 64 + lane) * 4) = pack4(o[0], o[1], o[2], o[3]);
        }
    }
    LDS_WAIT(); asm volatile("" ::: "memory"); __builtin_amdgcn_sched_barrier(0);
}
#undef MFMA16
#undef MFMA32
#undef GDN_RAW

#define GDN_BAR() do { asm volatile("" ::: "memory"); __builtin_amdgcn_s_barrier(); asm volatile("" ::: "memory"); } while (0)
__device__ __forceinline__ void gdn_scan(Frame& F, int bh) {
    const int lane = F.lane, wave = F.wave, b = bh >> 3, hh = bh & 7, fr = lane & 15, fq = lane >> 4;
    LAS unsigned char* const ring = F.lds + RING_OFF;
    constexpr int SLOT = 32768, OB0 = 131072, OB1 = 139264;
    const unsigned char* gA = (const unsigned char*)(F.CHKA + (size_t)bh * 64 * 8192);
    const unsigned char* gU = (const unsigned char*)(F.CHKU + (size_t)bh * 64 * 8192);
    if (wave >= 4) {
        const int hw = wave - 4, nt = hw * 64 + lane;
        bf16* mp = F.ORAW + ((size_t)b * T + (nt >> 3)) * 512 + hh * 64 + (nt & 7) * 8;
#define GDN_ISSUE(nn) do { const int n_ = (nn); const int sl_ = n_ & 3; _Pragma("unroll") for (int i_ = 0; i_ < 8; ++i_) { const int p_ = hw * 8 + i_; \
            const unsigned char* s_ = (p_ < 16) ? gA + (size_t)n_ * 16384 + p_ * 1024 : gU + (size_t)n_ * 16384 + (p_ - 16) * 1024; \
            __builtin_amdgcn_global_load_lds((const unsigned*)(s_ + lane * 16), (LAS unsigned*)(ring + sl_ * SLOT + p_ * 1024), 16, 0, 0); } } while (0)
#define GDN_COPY(nn) do { const LAS unsigned char* ob_ = ring + (((nn) & 1) ? OB1 : OB0); _Pragma("unroll") for (int k_ = 0; k_ < 2; ++k_) \
            *(GAS v4u*)(mp + (size_t)(64 * (nn) + 32 * k_) * 512) = *(const LAS v4u*)(ob_ + (nt + 256 * k_) * 16); } while (0)
        GDN_ISSUE(0); GDN_ISSUE(1); GDN_ISSUE(2);
        asm volatile("s_waitcnt vmcnt(16)" ::: "memory"); GDN_BAR();
        for (int n = 0; n < 64; ++n) {
            if (n + 3 < 64) { GDN_ISSUE(n + 3); asm volatile("s_waitcnt vmcnt(16)" ::: "memory"); } else asm volatile("s_waitcnt vmcnt(0)" ::: "memory");
            if (n > 0) GDN_COPY(n - 1);
            LDS_WAIT(); GDN_BAR();
        }
        GDN_COPY(63);
#undef GDN_ISSUE
#undef GDN_COPY
    } else {
        const int ew = wave;
        f32x4 Sacc[4];
#pragma unroll
        for (int t = 0; t < 4; ++t) Sacc[t] = (f32x4){0.f, 0.f, 0.f, 0.f};
        const float decs = ld_f32_coh(F.dec + bh * 64 + lane);
        GDN_BAR();
        for (int n = 0; n < 64; ++n) {
            const LAS unsigned char* sl = ring + (n & 3) * SLOT;
            LAS bf16* ob = (LAS bf16*)(ring + ((n & 1) ? OB1 : OB0)) + (4 * fq) * 64 + 16 * ew + fr;
            const float dec = __int_as_float(__builtin_amdgcn_readlane(__float_as_int(decs), n));
            unsigned long long rf[4], of[4]; bf16x8 pf[8], qf[8];
#pragma unroll
            for (int t = 0; t < 4; ++t) { rf[t] = *(const LAS unsigned long long*)(sl + 16384 + ((ew * 4 + t) * 64 + lane) * 8); of[t] = *(const LAS unsigned long long*)(sl + 24576 + ((ew * 4 + t) * 64 + lane) * 8); }
#pragma unroll
            for (int f = 0; f < 8; ++f) { pf[f] = *(const LAS bf16x8*)(sl + (f * 64 + lane) * 16); qf[f] = *(const LAS bf16x8*)(sl + 8192 + (f * 64 + lane) * 16); }
            __builtin_amdgcn_sched_barrier(0);
            bf16x8 Sb[2]; Sb[0] = pack8(Sacc[0], Sacc[1]); Sb[1] = pack8(Sacc[2], Sacc[3]);
            f32x4 O[4];
#pragma unroll
            for (int t = 0; t < 4; ++t) { const unsigned rl = (unsigned)rf[t], rh = (unsigned)(rf[t] >> 32), ol = (unsigned)of[t], oh = (unsigned)(of[t] >> 32);
                Sacc[t] = Sacc[t] * dec + (f32x4){__uint_as_float(rl << 16), __uint_as_float(rl & 0xffff0000u), __uint_as_float(rh << 16), __uint_as_float(rh & 0xffff0000u)};
                O[t] = (f32x4){__uint_as_float(ol << 16), __uint_as_float(ol & 0xffff0000u), __uint_as_float(oh << 16), __uint_as_float(oh & 0xffff0000u)}; }
#pragma unroll
            for (int t = 0; t < 4; ++t)
#pragma unroll
                for (int ks = 0; ks < 2; ++ks) { const int f = t * 2 + ks;
                    Sacc[t] = __builtin_amdgcn_mfma_f32_16x16x32_bf16(pf[f], Sb[ks], Sacc[t], 0, 0, 0); O[t] = __builtin_amdgcn_mfma_f32_16x16x32_bf16(qf[f], Sb[ks], O[t], 0, 0, 0); }
#pragma unroll
            for (int t = 0; t < 4; ++t)
#pragma unroll
                for (int i = 0; i < 4; ++i) ob[(16 * t + i) * 64] = (bf16)(cvtpk(O[t][i], O[t][i]) & 0xffffu);
            LDS_WAIT(); GDN_BAR();
        }
    }
}
__device__ __forceinline__ void gdn_norm_rows(Frame& F, int r0) {
    const int oc = F.tid & 7, hd = (F.tid >> 3) & 7;
    float nw[8];
#pragma unroll
    for (int j = 0; j < 8; ++j) nw[j] = F.gdn_norm_w[oc * 8 + j];
#pragma unroll 1
    for (int it = 0; it < 4; ++it) {
        v4u ov[8], zv[8];
#pragma unroll
        for (int k = 0; k < 8; ++k) { const size_t row = (size_t)r0 + (it * 8 + k) * 8 + (F.tid >> 6); ov[k] = *(const GAS v4u*)(F.ORAW + row * 512 + hd * 64 + oc * 8); zv[k] = *(const GAS v4u*)(F.PQ + row * NP + C_GZ + hd * 64 + oc * 8); }
#pragma unroll
        for (int k = 0; k < 8; ++k) { const size_t row = (size_t)r0 + (it * 8 + k) * 8 + (F.tid >> 6);
            const unsigned ow[4] = {ov[k].x, ov[k].y, ov[k].z, ov[k].w}, zw[4] = {zv[k].x, zv[k].y, zv[k].z, zv[k].w};
            float o[8], z[8]; float ss = 0.f;
#pragma unroll
            for (int w = 0; w < 4; ++w) { o[2 * w] = __uint_as_float(ow[w] << 16); o[2 * w + 1] = __uint_as_float(ow[w] & 0xffff0000u); z[2 * w] = __uint_as_float(zw[w] << 16); z[2 * w + 1] = __uint_as_float(zw[w] & 0xffff0000u);
                ss += o[2 * w] * o[2 * w] + o[2 * w + 1] * o[2 * w + 1]; }
            ss = sum8(ss);
            const float rs = rsq(ss * (1.0f / 64.0f) + EPS);
            v4u w4; w4.x = cvtpk(o[0] * rs * nw[0] * z[0], o[1] * rs * nw[1] * z[1]); w4.y = cvtpk(o[2] * rs * nw[2] * z[2], o[3] * rs * nw[3] * z[3]);
            w4.z = cvtpk(o[4] * rs * nw[4] * z[4], o[5] * rs * nw[5] * z[5]); w4.w = cvtpk(o[6] * rs * nw[6] * z[6], o[7] * rs * nw[7] * z[7]);
            *(GAS v4u*)(F.MIX + row * D + hd * 64 + oc * 8) = w4; }
    }
    asm volatile("s_waitcnt vmcnt(0)" ::: "memory"); __syncthreads();
}
__device__ __forceinline__ void swa_unit(Frame& F, int unit, LAS unsigned char* L) {
    const int tid = F.tid, lane = F.lane, wave = F.wave, fr = lane & 15, fq = lane >> 4;
    const int blk = unit & 63, kvh = (unit >> 6) & 1, b = unit >> 7, t0 = blk * 64;
    const size_t row0 = (size_t)b * T;
    LAS bf16* const Ks = (LAS bf16*)L; LAS bf16* const Vt = (LAS bf16*)(L + 27648);
    for (int p = tid; p < 1536; p += NWAVES * 64) {
        const int key = p >> 3, oc = p & 7, s = t0 - 128 + key;
        v4u kv = (v4u){0u, 0u, 0u, 0u}, vv = (v4u){0u, 0u, 0u, 0u};
        if (s >= 0) { kv = *(const GAS v4u*)(F.PQ + (row0 + s) * NP + C_SK + kvh * 64 + oc * 8); vv = *(const GAS v4u*)(F.PQ + (row0 + s) * NP + C_SV + kvh * 64 + oc * 8); }
        const unsigned kw[4] = {kv.x, kv.y, kv.z, kv.w}, vw[4] = {vv.x, vv.y, vv.z, vv.w};
        float k[8]; float ss = 0.f;
#pragma unroll
        for (int w = 0; w < 4; ++w) { k[2 * w] = __uint_as_float(kw[w] << 16); k[2 * w + 1] = __uint_as_float(kw[w] & 0xffff0000u); ss += k[2 * w] * k[2 * w] + k[2 * w + 1] * k[2 * w + 1]; }
        ss = sum8(ss);
        const float rstd = rsq(ss * (1.0f / 64.0f) + EPS);
#pragma unroll
        for (int j = 0; j < 8; ++j) k[j] = k[j] * rstd * F.k_norm_w[oc * 8 + j];
        v4u o; o.x = cvtpk(k[0], k[1]); o.y = cvtpk(k[2], k[3]); o.z = cvtpk(k[4], k[5]); o.w = cvtpk(k[6], k[7]);
        *(LAS v4u*)(Ks + key * 72 + oc * 8) = o;
#pragma unroll
        for (int w = 0; w < 4; ++w) { Vt[(oc * 8 + 2 * w) * 196 + key] = (bf16)(vw[w] & 0xffffu); Vt[(oc * 8 + 2 * w + 1) * 196 + key] = (bf16)(vw[w] >> 16); }
    }
    __syncthreads();
    const int hq = kvh * 4 + (wave >> 1);
    const float slope = exp2f(-(float)(hq + 1)), sink = F.sinks[hq];
#pragma unroll 1
    for (int qt = 0; qt < 2; ++qt) {
        const int tq0 = t0 + 32 * (wave & 1) + 16 * qt;
        bf16x8 qf[2];
        {
            const bf16* qp = F.PQ + (row0 + tq0 + fr) * NP + C_SQ + hq * 64 + 8 * fq;
            const v4u r0 = *(const GAS v4u*)qp, r1 = *(const GAS v4u*)(qp + 32);
            const unsigned qw[8] = {r0.x, r0.y, r0.z, r0.w, r1.x, r1.y, r1.z, r1.w};
            float q[16]; float ss = 0.f;
#pragma unroll
            for (int w = 0; w < 8; ++w) { q[2 * w] = __uint_as_float(qw[w] << 16); q[2 * w + 1] = __uint_as_float(qw[w] & 0xffff0000u); ss += q[2 * w] * q[2 * w] + q[2 * w + 1] * q[2 * w + 1]; }
            ss = fq_sum(ss);
            const float rstd = 0.125f * rsq(ss * (1.0f / 64.0f) + EPS);
#pragma unroll
            for (int kk = 0; kk < 2; ++kk) { float z[8];
#pragma unroll
                for (int j = 0; j < 8; ++j) z[j] = q[8 * kk + j] * rstd * F.q_norm_w[32 * kk + 8 * fq + j];
                v4u o; o.x = cvtpk(z[0], z[1]); o.y = cvtpk(z[2], z[3]); o.z = cvtpk(z[4], z[5]); o.w = cvtpk(z[6], z[7]); qf[kk] = __builtin_bit_cast(bf16x8, o); }
        }
        f32x4 sc[12]; float mx = -INFINITY;
#pragma unroll
        for (int nt = 0; nt < 12; ++nt) { f32x4 acc = (f32x4){0.f, 0.f, 0.f, 0.f};
#pragma unroll
            for (int kk = 0; kk < 2; ++kk) { const bf16x8 kf = *(const LAS bf16x8*)(Ks + (16 * nt + fr) * 72 + 32 * kk + 8 * fq); acc = __builtin_amdgcn_mfma_f32_16x16x32_bf16(kf, qf[kk], acc, 0, 0, 0); }
#pragma unroll
            for (int i = 0; i < 4; ++i) { const int s = t0 - 128 + 16 * nt + 4 * fq + i, dist = tq0 + fr - s; const bool ok = (s >= 0) && (dist >= 0) && (dist < 128);
                const float v = ok ? acc[i] - slope * (float)dist : -INFINITY; acc[i] = v; mx = fmaxf(mx, v); }
            sc[nt] = acc; if (nt & 1) __builtin_amdgcn_sched_barrier(0); }
        mx = fmaxf(fq_max(mx), sink);
        float sum = 0.f;
#pragma unroll
        for (int nt = 0; nt < 12; ++nt)
#pragma unroll
            for (int i = 0; i < 4; ++i) { const float p = __expf(sc[nt][i] - mx); sc[nt][i] = p; sum += p; }
        sum = fq_sum(sum);
        const float den = sum + __expf(sink - mx);
        bf16x8 pf[6];
#pragma unroll
        for (int ks = 0; ks < 6; ++ks) pf[ks] = pack8(sc[2 * ks], sc[2 * ks + 1]);
        float rden[4];
#pragma unroll
        for (int i = 0; i < 4; ++i) rden[i] = __builtin_amdgcn_rcpf(__shfl(den, 4 * fq + i));
        bf16* op = F.MIX + (row0 + tq0 + 4 * fq) * D + 512 + hq * 64 + fr;
#pragma unroll 1
        for (int dt = 0; dt < 4; ++dt) { f32x4 oacc = (f32x4){0.f, 0.f, 0.f, 0.f};
#pragma unroll
            for (int ks = 0; ks < 6; ++ks) { const LAS bf16* vp = Vt + (16 * dt + fr) * 196 + 32 * ks + 4 * fq;
                const unsigned long long lo = *(const LAS unsigned long long*)vp, hi = *(const LAS unsigned long long*)(vp + 16);
                v4u vv; vv.x = (unsigned)lo; vv.y = (unsigned)(lo >> 32); vv.z = (unsigned)hi; vv.w = (unsigned)(hi >> 32);
                oacc = __builtin_amdgcn_mfma_f32_16x16x32_bf16(pf[ks], __builtin_bit_cast(bf16x8, vv), oacc, 0, 0, 0); }
#pragma unroll
            for (int i = 0; i < 4; ++i) op[(size_t)i * D + 16 * dt] = (bf16)f2bf(oacc[i] * rden[i]); }
    }
    __syncthreads();
}
__device__ __forceinline__ void p3a_prep(Frame& F) {
    LAS unsigned char* wl = F.lds + RING_OFF + F.wave * 19456;
    const int gw = F.vcu * NWAVES + F.wave, NGW = F.G * NWAVES;
    for (int ci = gw; ci < BATCH * 8 * (T / 64); ci += NGW) gdn_prep_chunk(F, ci, wl);
}
__device__ __forceinline__ void p3b_mixers(Frame& F) {
    const int bx = blockIdx.x;
    if (bx < 32) gdn_scan(F, bx);
    else for (int u = bx - 32; u < BATCH * 2 * (T / 64); u += F.G - 32) swa_unit(F, u, F.lds + RING_OFF);
}

struct Args { const float* in[18]; float* out; unsigned char* ws; };
__global__ void __launch_bounds__(NWAVES * 64, 2) hymba_fwd(Args args) {
    extern __shared__ __attribute__((aligned(16))) unsigned char lds[];
    Frame F;
    F.lds = (LAS unsigned char*)lds;
    F.MISC = (volatile LAS unsigned*)(F.lds + MISC_OFF);
    F.tid = threadIdx.x; F.lane = F.tid & 63; F.wave = __builtin_amdgcn_readfirstlane(F.tid >> 6);
    F.G = gridDim.x; { const int bx = blockIdx.x; F.vcu = (F.G % 8 == 0) ? (bx % 8) * (F.G / 8) + bx / 8 : bx; }
    unsigned char* ws = args.ws;
    F.ctl = (gu32*)(ws + WS_CTL);
    F.x = args.in[0]; F.c = args.in[1]; F.w_ada = args.in[2]; F.b_ada = args.in[3]; F.norm1_w = args.in[4]; F.w_in = args.in[5]; F.conv_w = args.in[6];
    F.a_log = args.in[7]; F.dt_bias = args.in[8]; F.gdn_norm_w = args.in[9]; F.q_norm_w = args.in[10]; F.k_norm_w = args.in[11]; F.sinks = args.in[12];
    F.w_out = args.in[13]; F.norm2_w = args.in[14]; F.w_gate = args.in[15]; F.w_up = args.in[16]; F.w_down = args.in[17]; F.out = args.out;
    F.modacc = (float*)(ws + WS_CTL) + CW_MODACC; F.modf = (float*)(ws + WS_MODF);
    F.Win_t = (bf16*)(ws + WS_WIN); F.Wout_t = (bf16*)(ws + WS_WOUT); F.Wgu_t = (bf16*)(ws + WS_WGU); F.Wdn_t = (bf16*)(ws + WS_WDN);
    F.H = (bf16*)(ws + WS_H); F.PQ = (bf16*)(ws + WS_PQ); F.MIX = (bf16*)(ws + WS_MIX); F.CHKA = (bf16*)(ws + WS_CHKA); F.CHKU = (bf16*)(ws + WS_H); F.X1B = (bf16*)(ws + WS_CHKA); F.CHKT = (bf16*)(ws + WS_CHKA + 32 * MiB); F.ORAW = (bf16*)(ws + WS_CHKA + 32 * MiB); F.dec = (float*)(ws + WS_DEC);
    for (int u = F.tid; u < (LDS_BYTES - LDSCTL_OFF) / 4; u += NWAVES * 64) ((LAS unsigned*)(F.lds + LDSCTL_OFF))[u] = 0u;
    __syncthreads();
    XcdBarrier bar = xcd_barrier_post((unsigned*)(F.ctl + CW_BAR), F.MISC + 8);
#define GRID_BAR() do { xcd_barrier(bar, F.tid); int t_ = F.tid; asm volatile("" : "+v"(t_)); F.tid = t_; F.lane = t_ & 63; } while (0)

    p0_prologue(F);
    norm_phase<1>(F); GRID_BAR();
    { pg8::Gemm g{F.H, F.Win_t, M, NP, D}; pg8::StaticOrder S; S.init(M, NP, F.G, (int)blockIdx.x);
      pg8::EpiBf16Plain E{F.PQ, NP, C_GZ / 256, C_SQ / 256};
      pg8::gemm_phase<pg8::EpiBf16Plain, pg8::StaticOrder, true, true>(F.lds + RING_OFF, g, S, E, F.tid); }
    GRID_BAR();
    p3a_prep(F); GRID_BAR();
    p3b_mixers(F); GRID_BAR();
    { pg8::Gemm g{F.MIX, F.Wout_t, M, D, D}; pg8::StaticOrder S; S.init(M, D, F.G, (int)blockIdx.x);
      { pg8::Unit u0; for (int i = 0; S.next(i, u0); ++i) gdn_norm_rows(F, u0.pm * 256); }
      pg8::EpiGateResToBf16 E{F.x, F.X1B, D, F.modf + 2 * D, 6 * D, T};
      pg8::gemm_phase<pg8::EpiGateResToBf16, pg8::StaticOrder, true, true>(F.lds + RING_OFF, g, S, E, F.tid); }
    GRID_BAR();
    norm_phase<2>(F); GRID_BAR();
    { pg8::Gemm g{F.H, F.Wgu_t, M, NGU, D}; pg8::StaticOrder S; S.init(M, NGU, F.G, (int)blockIdx.x);
      pg8::EpiSwiGLU E{F.PQ, FF};
      pg8::gemm_phase<pg8::EpiSwiGLU, pg8::StaticOrder, true, true>(F.lds + RING_OFF, g, S, E, F.tid); }
    GRID_BAR();
    { pg8::Gemm g{F.PQ, F.Wdn_t, M, D, FF}; pg8::StaticOrder S; S.init(M, D, F.G, (int)blockIdx.x);
      pg8::EpiGateResFromBf16 E{F.X1B, F.out, D, F.modf + 5 * D, 6 * D, T};
      pg8::gemm_phase<pg8::EpiGateResFromBf16, pg8::StaticOrder, true, true>(F.lds + RING_OFF, g, S, E, F.tid); }
#undef GRID_BAR
}

extern "C" void kernel_launch(void* const* d_in, const int* in_sizes, int n_in, void* d_out, int out_size, void* d_ws, size_t ws_size, hipStream_t stream) {
    static int grid = 0;
    if (grid == 0) {
        if (n_in != 18 || in_sizes[0] != M * D || out_size != M * D || ws_size < WS_END) { fprintf(stderr, "kernel_launch: unexpected shapes (n_in %d, in0 %d, out %d, ws %zu); nothing launched\n", n_in, n_in > 0 ? in_sizes[0] : -1, out_size, ws_size); grid = -1; return; }
        int dev = 0, cus = 0;
        if (hipGetDevice(&dev) != hipSuccess || hipDeviceGetAttribute(&cus, hipDeviceAttributeMultiprocessorCount, dev) != hipSuccess) { grid = -1; return; }
        if (hipFuncSetAttribute((const void*)hymba_fwd, hipFuncAttributeMaxDynamicSharedMemorySize, LDS_BYTES) != hipSuccess) { fprintf(stderr, "kernel_launch: hipFuncSetAttribute failed\n"); grid = -1; return; }
        (void)hipGetLastError();
        grid = cus;
    }
    if (grid < 0) return;
    if (hipMemsetAsync((char*)d_ws + WS_CTL, 0, CTL_ZERO_BYTES, stream) != hipSuccess) { fprintf(stderr, "kernel_launch: hipMemsetAsync failed\n"); return; }
    Args a{};
    for (int i = 0; i < 18; ++i) a.in[i] = (const float*)d_in[i];
    a.out = (float*)d_out; a.ws = (unsigned char*)d_ws;
    hipLaunchKernelGGL(hymba_fwd, dim3(grid), dim3(NWAVES * 64), LDS_BYTES, stream, a);
    const hipError_t le = hipPeekAtLastError();
    if (le != hipSuccess) fprintf(stderr, "kernel_launch: launch failed: %s\n", hipGetErrorName(le));
}
```

```cpp
#include <hip/hip_runtime.h>
#include <cstdio>
#include <cstdint>
#include <cmath>
namespace pg8 {
#define PG8_LAS __attribute__((address_space(3)))
typedef unsigned short bf16_t;
typedef short bf16x8 __attribute__((ext_vector_type(8)));
typedef float f32x4 __attribute__((ext_vector_type(4)));
typedef unsigned u32x4 __attribute__((ext_vector_type(4)));
constexpr int BM = 256, BK = 64, HALF = 128, HTB = HALF * BK * 2  , STAGE_BYTES = 8 * HTB, NXCD = 8, WGM = 8;

__host__ __device__ __forceinline__ int lds_byte(int r, int c) { const int st = (r >> 4) * 2 + (c >> 5), rr = r & 15, cc = c & 31, ob = rr * 64 + cc * 2; return st * 1024 + (ob ^ (((ob >> 9) & 1) << 5)); }
__host__ __device__ __forceinline__ void stage_rc(int b, int& R, int& C) { const int st = b / 1024, sb = b % 1024, swz = sb ^ (((sb >> 9) & 1) << 5); R = (st >> 1) * 16 + swz / 64; C = (st & 1) * 32 + (swz % 64) / 2; }
__host__ __device__ __forceinline__ int perm32(int rho) { const int n = rho >> 4, i = rho & 15; return 8 * (i >> 2) + 4 * n + (i & 3); }

struct Unit { int pm, pn; };
struct Gemm { const bf16_t* A; const bf16_t* Bt; int M, N, K; };

struct StaticOrder {
    int nM, nN, nwg, G, c, wgm;
    __host__ __device__ void init(int M, int N, int G_, int c_, int wgm_ = WGM) { nM = M / BM; nN = N / BM; nwg = nM * nN; G = G_; c = c_; wgm = wgm_; }
    __host__ __device__ bool next(int i, Unit& u) const {
        const long L = (long)i * G + c; if (L >= nwg) return false;
        int wgid = (int)L; { const int q = nwg / NXCD, r = nwg % NXCD, xcd = wgid % NXCD, off = wgid / NXCD; wgid = (xcd < r ? xcd * (q + 1) : r * (q + 1) + (xcd - r) * q) + off; }
        const int nig = wgm * nN, gid = wgid / nig, fm = gid * wgm, gsz = (nM - fm) < wgm ? (nM - fm) : wgm;
        u.pm = fm + ((wgid % nig) % gsz); u.pn = (wgid % nig) / gsz; return true;
    }
    __device__ __forceinline__ void a_ready(const Unit&) const {}
    __device__ __forceinline__ void done(const Unit&) const {}
};

__device__ __forceinline__ unsigned cvt_pk_bf16(float lo, float hi) { unsigned r; asm volatile("v_cvt_pk_bf16_f32 %0, %1, %2" : "=v"(r) : "v"(lo), "v"(hi)); return r; }
__device__ __forceinline__ float silu_f(float x) { return x * __builtin_amdgcn_rcpf(1.0f + __expf(-x)); }

struct EpiBf16Plain {
    static constexpr bool PERM = true, AFTER_DRAIN = false;
    bf16_t* O; int ldc; int silu_lo, silu_hi;
    __device__ __forceinline__ void operator()(const f32x4 (&acc)[2][2][4][2], const Unit& u, int wr, int wc, int fr, int fq) const {
        const int row0 = u.pm * BM + wr * 64 + fr, col0 = u.pn * BM + wc * 32 + 8 * fq;
        const bool act = (u.pn >= silu_lo) && (u.pn < silu_hi);
#pragma unroll
        for (int ai = 0; ai < 2; ++ai)
#pragma unroll
            for (int m = 0; m < 4; ++m) { bf16_t* rowp = O + (size_t)(row0 + ai * HALF + m * 16) * ldc + col0;
#pragma unroll
                for (int bj = 0; bj < 2; ++bj) { f32x4 v0 = acc[ai][bj][m][0], v1 = acc[ai][bj][m][1];
                    if (act) {
#pragma unroll
                        for (int i = 0; i < 4; ++i) { v0[i] = silu_f(v0[i]); v1[i] = silu_f(v1[i]); } }
                    u32x4 w; w.x = cvt_pk_bf16(v0[0], v0[1]); w.y = cvt_pk_bf16(v0[2], v0[3]); w.z = cvt_pk_bf16(v1[0], v1[1]); w.w = cvt_pk_bf16(v1[2], v1[3]);
                    *(u32x4*)(rowp + bj * HALF) = w; } }
    }
};
struct EpiSwiGLU {
    static constexpr bool PERM = true, AFTER_DRAIN = false;
    bf16_t* O; int ldc;
    __device__ __forceinline__ void operator()(const f32x4 (&acc)[2][2][4][2], const Unit& u, int wr, int wc, int fr, int fq) const {
        const int row0 = u.pm * BM + wr * 64 + fr, col0 = u.pn * HALF + wc * 32 + 8 * fq;
#pragma unroll
        for (int ai = 0; ai < 2; ++ai)
#pragma unroll
            for (int m = 0; m < 4; ++m) { bf16_t* rowp = O + (size_t)(row0 + ai * HALF + m * 16) * ldc + col0;
                const f32x4 g0 = acc[ai][0][m][0], g1 = acc[ai][0][m][1], u0 = acc[ai][1][m][0], u1 = acc[ai][1][m][1];
                float a[8];
#pragma unroll
                for (int i = 0; i < 4; ++i) { a[i] = silu_f(g0[i]) * u0[i]; a[4 + i] = silu_f(g1[i]) * u1[i]; }
                u32x4 w; w.x = cvt_pk_bf16(a[0], a[1]); w.y = cvt_pk_bf16(a[2], a[3]); w.z = cvt_pk_bf16(a[4], a[5]); w.w = cvt_pk_bf16(a[6], a[7]);
                *(u32x4*)rowp = w; }
    }
};
struct EpiGateResToBf16 {
    static constexpr bool PERM = true, AFTER_DRAIN = false;
    const float* base; bf16_t* out; int ldc; const float* gate; int gstride; int rows_per_batch;
    __device__ __forceinline__ void operator()(const f32x4 (&acc)[2][2][4][2], const Unit& u, int wr, int wc, int fr, int fq) const {
        const int row0 = u.pm * BM + wr * 64 + fr, col0 = u.pn * BM + wc * 32 + 8 * fq;
        const float* gp = gate + (size_t)((u.pm * BM) / rows_per_batch) * gstride + col0;
        f32x4 gv[2][2];
#pragma unroll
        for (int bj = 0; bj < 2; ++bj)
#pragma unroll
            for (int n = 0; n < 2; ++n) gv[bj][n] = *(const f32x4*)(gp + bj * HALF + n * 4);
#pragma unroll
        for (int ai = 0; ai < 2; ++ai)
#pragma unroll
            for (int m = 0; m < 4; ++m) { const size_t off = (size_t)(row0 + ai * HALF + m * 16) * ldc + col0;
#pragma unroll
                for (int bj = 0; bj < 2; ++bj) { const f32x4 o0 = *(const f32x4*)(base + off + bj * HALF) + gv[bj][0] * acc[ai][bj][m][0], o1 = *(const f32x4*)(base + off + bj * HALF + 4) + gv[bj][1] * acc[ai][bj][m][1];
                    u32x4 w; w.x = cvt_pk_bf16(o0[0], o0[1]); w.y = cvt_pk_bf16(o0[2], o0[3]); w.z = cvt_pk_bf16(o1[0], o1[1]); w.w = cvt_pk_bf16(o1[2], o1[3]);
                    *(u32x4*)(out + off + bj * HALF) = w; } }
    }
};
struct EpiGateResFromBf16 {
    static constexpr bool PERM = true, AFTER_DRAIN = false;
    const bf16_t* base; float* out; int ldc; const float* gate; int gstride; int rows_per_batch;
    __device__ __forceinline__ void operator()(const f32x4 (&acc)[2][2][4][2], const Unit& u, int wr, int wc, int fr, int fq) const {
        const int row0 = u.pm * BM + wr * 64 + fr, col0 = u.pn * BM + wc * 32 + 8 * fq;
        const float* gp = gate + (size_t)((u.pm * BM) / rows_per_batch) * gstride + col0;
        f32x4 gv[2][2];
#pragma unroll
        for (int bj = 0; bj < 2; ++bj)
#pragma unroll
            for (int n = 0; n < 2; ++n) gv[bj][n] = *(const f32x4*)(gp + bj * HALF + n * 4);
#pragma unroll
        for (int ai = 0; ai < 2; ++ai)
#pragma unroll
            for (int m = 0; m < 4; ++m) { const size_t off = (size_t)(row0 + ai * HALF + m * 16) * ldc + col0;
#pragma unroll
                for (int bj = 0; bj < 2; ++bj) { const u32x4 bb = *(const u32x4*)(base + off + bj * HALF);
                    const f32x4 b0 = (f32x4){__uint_as_float(bb.x << 16), __uint_as_float(bb.x & 0xffff0000u), __uint_as_float(bb.y << 16), __uint_as_float(bb.y & 0xffff0000u)};
                    const f32x4 b1 = (f32x4){__uint_as_float(bb.z << 16), __uint_as_float(bb.z & 0xffff0000u), __uint_as_float(bb.w << 16), __uint_as_float(bb.w & 0xffff0000u)};
                    *(f32x4*)(out + off + bj * HALF) = b0 + gv[bj][0] * acc[ai][bj][m][0]; *(f32x4*)(out + off + bj * HALF + 4) = b1 + gv[bj][1] * acc[ai][bj][m][1]; } }
    }
};

template <class Epi, class Sched, bool ALIGN_EPI = false, bool SP2 = false>
__device__ __forceinline__ void gemm_phase(PG8_LAS unsigned char* lds, const Gemm g, const Sched& S, const Epi& E, int tid_in) {
    int tid_ = tid_in; asm volatile("" : "+v"(tid_));
    const int tid = tid_, wid = __builtin_amdgcn_readfirstlane(tid >> 6), lane = tid & 63, wr = wid >> 2, wc = wid & 3, fr = lane & 15, fq = lane >> 4;
    const int K = g.K, nt = K / BK;
    unsigned voffA[2], voffB[2];
#pragma unroll
    for (int i = 0; i < 2; ++i) { int R, C; stage_rc(tid * 16 + i * 8192, R, C); const int Rb = Epi::PERM ? ((R & ~31) + perm32(R & 31)) : R;
        voffA[i] = (unsigned)(R * K + C) * 2u; voffB[i] = (unsigned)(Rb * K + C) * 2u; }
    const size_t kstep = (size_t)(BK * 2);
    const size_t hstep = (size_t)HALF * K * 2;
    const size_t tstep = 2 * hstep;
    const unsigned ldsw = (unsigned)wid * 1024u;
    const int aoff = lds_byte(wr * 64 + fr, fq * 8), boff = lds_byte(wc * 32 + fr, fq * 8);
#define PG8_SA(b, h) (((b) * 2 + (h)) * HTB)
#define PG8_SB(b, h) ((4 + (b) * 2 + (h)) * HTB)
#define PG8_STAGE(bufoff, gbase, voff) do { _Pragma("unroll") for (int _i = 0; _i < 2; ++_i) \
        __builtin_amdgcn_global_load_lds((const unsigned*)((const char*)(gbase) + (voff)[_i]), (PG8_LAS unsigned*)(lds + (bufoff) + ldsw + _i * 8192), 16, 0, 0); } while (0)
#define PG8_LDA(dst, b, h) do { _Pragma("unroll") for (int m = 0; m < 4; ++m) _Pragma("unroll") for (int k = 0; k < 2; ++k) dst[m][k] = *(const PG8_LAS bf16x8*)(lds + PG8_SA(b, h) + aoff + m * 2048 + k * 1024); } while (0)
#define PG8_LDB(dst, b, h) do { _Pragma("unroll") for (int n = 0; n < 2; ++n) _Pragma("unroll") for (int k = 0; k < 2; ++k) dst[n][k] = *(const PG8_LAS bf16x8*)(lds + PG8_SB(b, h) + boff + n * 2048 + k * 1024); } while (0)
#define PG8_MMA(ai, bj, At, Bt) do { __builtin_amdgcn_s_setprio(1); _Pragma("unroll") for (int m = 0; m < 4; ++m) _Pragma("unroll") for (int n = 0; n < 2; ++n) _Pragma("unroll") for (int k = 0; k < 2; ++k) \
        acc[ai][bj][m][n] = __builtin_amdgcn_mfma_f32_16x16x32_bf16(Bt[n][k], At[m][k], acc[ai][bj][m][n], 0, 0, 0); __builtin_amdgcn_s_setprio(0); } while (0)
#define PG8_WAIT_V(n) asm volatile("s_waitcnt vmcnt(" #n ")" ::: "memory")
#define PG8_WAIT_L(n) asm volatile("s_waitcnt lgkmcnt(" #n ")" ::: "memory")
#define PG8_BAR __builtin_amdgcn_s_barrier()
#define PG8_SCHED __builtin_amdgcn_sched_barrier(0)
    Unit cur, nxt; int ui = 0;
    if (!S.next(0, cur)) return;
    f32x4 acc[2][2][4][2];
#pragma unroll
    for (int a = 0; a < 2; ++a)
#pragma unroll
        for (int b = 0; b < 2; ++b)
#pragma unroll
            for (int m = 0; m < 4; ++m)
#pragma unroll
                for (int n = 0; n < 2; ++n) acc[a][b][m][n] = (f32x4){0.f, 0.f, 0.f, 0.f};
    bf16x8 At[4][2], B0[2][2], B1[2][2];
    const char* cA = (const char*)g.A + (size_t)cur.pm * tstep; const char* cB = (const char*)g.Bt + (size_t)cur.pn * tstep;
    S.a_ready(cur);
    if constexpr (SP2) {
        PG8_STAGE(PG8_SB(0, 0), cB, voffB); PG8_STAGE(PG8_SB(0, 1), cB + hstep, voffB); PG8_STAGE(PG8_SA(0, 0), cA, voffA); PG8_STAGE(PG8_SA(0, 1), cA + hstep, voffA);
        if (wr == 1) PG8_BAR;
        PG8_WAIT_V(2); PG8_BAR;
        PG8_STAGE(PG8_SB(1, 0), cB + kstep, voffB); PG8_STAGE(PG8_SA(1, 0), cA + kstep, voffA); PG8_STAGE(PG8_SB(1, 1), cB + hstep + kstep, voffB);
        PG8_WAIT_V(6); PG8_BAR;
    } else {
        PG8_STAGE(PG8_SB(0, 0), cB, voffB); PG8_STAGE(PG8_SA(0, 0), cA, voffA); PG8_STAGE(PG8_SB(0, 1), cB + hstep, voffB); PG8_STAGE(PG8_SA(0, 1), cA + hstep, voffA);
        if (wr == 1) PG8_BAR;
        PG8_WAIT_V(4); PG8_BAR;
        PG8_STAGE(PG8_SB(1, 0), cB + kstep, voffB); PG8_STAGE(PG8_SA(1, 0), cA + kstep, voffA); PG8_STAGE(PG8_SB(1, 1), cB + hstep + kstep, voffB);
        PG8_WAIT_V(6); PG8_BAR;
    }
    for (;;) {
        const bool has_next = S.next(ui + 1, nxt);
        const char* nA = has_next ? (const char*)g.A + (size_t)nxt.pm * tstep : cA; const char* nB = has_next ? (const char*)g.Bt + (size_t)nxt.pn * tstep : cB;
        for (int t = 0; t < nt; t += 2) {
            const bool last = (t == nt - 2);
            const char* a1 = cA + (size_t)(t + 1) * kstep;
            const char* a2 = last ? nA : cA + (size_t)(t + 2) * kstep; const char* b2 = last ? nB : cB + (size_t)(t + 2) * kstep;
            const char* a3 = a2 + kstep; const char* b3 = b2 + kstep;
            if (last && has_next) S.a_ready(nxt);
            if constexpr (SP2) {
            PG8_LDB(B0, 0, 0); PG8_LDB(B1, 0, 1); PG8_SCHED; PG8_LDA(At, 0, 0); PG8_STAGE(PG8_SA(1, 1), a1 + hstep, voffA);
            PG8_WAIT_V(8); PG8_WAIT_L(0); PG8_BAR; PG8_MMA(0, 0, At, B0); PG8_MMA(0, 1, At, B1); PG8_BAR; PG8_SCHED;
            PG8_LDA(At, 0, 1); PG8_STAGE(PG8_SB(0, 0), b2, voffB); PG8_STAGE(PG8_SB(0, 1), b2 + hstep, voffB); PG8_STAGE(PG8_SA(0, 0), a2, voffA);
            PG8_WAIT_V(8); PG8_WAIT_L(0); PG8_BAR; PG8_MMA(1, 0, At, B0); PG8_MMA(1, 1, At, B1); PG8_BAR; PG8_SCHED;
            PG8_LDB(B0, 1, 0); PG8_LDB(B1, 1, 1); PG8_SCHED; PG8_LDA(At, 1, 0); PG8_STAGE(PG8_SA(0, 1), a2 + hstep, voffA);
            PG8_WAIT_V(8); PG8_WAIT_L(0); PG8_BAR; PG8_MMA(0, 0, At, B0); PG8_MMA(0, 1, At, B1); PG8_BAR; PG8_SCHED;
            PG8_LDA(At, 1, 1); PG8_STAGE(PG8_SB(1, 0), b3, voffB); PG8_STAGE(PG8_SB(1, 1), b3 + hstep, voffB); PG8_STAGE(PG8_SA(1, 0), a3, voffA);
            PG8_WAIT_V(8); PG8_WAIT_L(0); PG8_BAR; PG8_MMA(1, 0, At, B0); PG8_MMA(1, 1, At, B1); PG8_BAR; PG8_SCHED;
            } else {
            PG8_LDB(B0, 0, 0); PG8_SCHED; PG8_LDA(At, 0, 0); PG8_STAGE(PG8_SA(1, 1), a1 + hstep, voffA);
            PG8_WAIT_L(8); PG8_BAR; PG8_WAIT_L(0); PG8_MMA(0, 0, At, B0); PG8_BAR; PG8_SCHED;
            PG8_LDB(B1, 0, 1); PG8_STAGE(PG8_SB(0, 0), b2, voffB);
            PG8_BAR; PG8_WAIT_L(0); PG8_MMA(0, 1, At, B1); PG8_BAR;
            PG8_LDA(At, 0, 1); PG8_STAGE(PG8_SA(0, 0), a2, voffA);
            PG8_BAR; PG8_WAIT_L(0); PG8_MMA(1, 0, At, B0); PG8_BAR; PG8_SCHED;
            PG8_STAGE(PG8_SB(0, 1), b2 + hstep, voffB);
            PG8_WAIT_V(6); PG8_BAR; PG8_MMA(1, 1, At, B1); PG8_BAR;
            PG8_LDB(B0, 1, 0); PG8_SCHED; PG8_LDA(At, 1, 0); PG8_STAGE(PG8_SA(0, 1), a2 + hstep, voffA);
            PG8_WAIT_L(8); PG8_BAR; PG8_WAIT_L(0); PG8_MMA(0, 0, At, B0); PG8_BAR; PG8_SCHED;
            PG8_LDB(B1, 1, 1); PG8_STAGE(PG8_SB(1, 0), b3, voffB);
            PG8_BAR; PG8_WAIT_L(0); PG8_MMA(0, 1, At, B1); PG8_BAR;
            PG8_LDA(At, 1, 1); PG8_STAGE(PG8_SA(1, 0), a3, voffA);
            PG8_BAR; PG8_WAIT_L(0); PG8_MMA(1, 0, At, B0); PG8_BAR; PG8_SCHED;
            PG8_STAGE(PG8_SB(1, 1), b3 + hstep, voffB);
            PG8_WAIT_V(6); PG8_BAR; PG8_MMA(1, 1, At, B1); PG8_BAR;
            }
        }
        if constexpr (ALIGN_EPI) { if (wr == 0) PG8_BAR; }
        if constexpr (!Epi::AFTER_DRAIN) { E(acc, cur, wr, wc, fr, fq); S.done(cur); }
        if (!has_next) break;
#pragma unroll
        for (int a = 0; a < 2; ++a)
#pragma unroll
            for (int b = 0; b < 2; ++b)
#pragma unroll
                for (int m = 0; m < 4; ++m)
#pragma unroll
                    for (int n = 0; n < 2; ++n) acc[a][b][m][n] = (f32x4){0.f, 0.f, 0.f, 0.f};
        cur = nxt; cA = nA; cB = nB; ++ui;
        if constexpr (ALIGN_EPI) { if (wr == 1) PG8_BAR; }
    }
    PG8_WAIT_V(0);
    if constexpr (!ALIGN_EPI) { if (wr == 0) PG8_BAR; }
    PG8_BAR;
    if constexpr (Epi::AFTER_DRAIN) { E.fused(acc, cur, wr, wc, fr, fq, lds, wid, lane); S.done(cur); }
#undef PG8_SA
#undef PG8_SB
#undef PG8_STAGE
#undef PG8_LDA
#undef PG8_LDB
#undef PG8_MMA
#undef PG8_WAIT_V
#undef PG8_WAIT_L
#undef PG8_BAR
#undef PG8_SCHED
}
}
constexpr int NWAVES = 8;
constexpr int BATCH = 4, T = 4096, D = 1024, M = BATCH * T;
constexpr int PROJ_W = 2832, NP = 3072, FF = 2816, NGU = 2 * FF, HD = 64;
constexpr int C_GQ = 0, C_GK = 512, C_GV = 1024, C_GZ = 1536, C_SQ = 2048, C_SK = 2560, C_SV = 2688, C_GA = 2816, C_GB = 2824;
constexpr float EPS = 1e-6f;
constexpr size_t MiB = 1u << 20;
constexpr size_t WS_CTL = 0, CTL_ZERO_BYTES = 256 * 1024;
constexpr size_t WS_MODF = 1 * MiB;
constexpr size_t WS_DEC = 1 * MiB + 384 * 1024;
constexpr size_t WS_WIN = 4 * MiB, WS_WOUT = 10 * MiB, WS_WGU = 12 * MiB, WS_WDN = 24 * MiB;
constexpr size_t WS_H = 32 * MiB;
constexpr size_t WS_PQ = 64 * MiB;
constexpr size_t WS_MIX = 160 * MiB;
constexpr size_t WS_CHKA = 192 * MiB;
constexpr size_t WS_END = 256 * MiB;
constexpr int WGM_G1 = 4, WGM_G2 = 4, WGM_G3 = 4, WGM_G4 = 4;
constexpr int CW_ADA = 1024;
constexpr int CW_BAR = 4096;
constexpr int CW_MODACC = 16384;
constexpr int RING_OFF = 0, RING_BYTES = 131072;
constexpr int LDS_BYTES = 163840;
constexpr int LDSCTL_OFF = LDS_BYTES - 1024, MISC_OFF = LDSCTL_OFF + 320;
#define GAS __attribute__((address_space(1)))
#define LAS __attribute__((address_space(3)))
typedef unsigned short bf16;
typedef unsigned v4u __attribute__((ext_vector_type(4)));
typedef float f32x4 __attribute__((ext_vector_type(4)));
typedef short bf16x8 __attribute__((ext_vector_type(8)));
typedef GAS unsigned gu32;
typedef GAS unsigned long long gu64;
#define RLX_AGENT __ATOMIC_RELAXED, __HIP_MEMORY_SCOPE_AGENT
#define LDS_WAIT() asm volatile("s_waitcnt lgkmcnt(0)" ::: "memory")
#define VM_WAIT() asm volatile("s_waitcnt vmcnt(0)" ::: "memory")
__device__ __forceinline__ unsigned long long rt() { return __builtin_amdgcn_s_memrealtime(); }
__device__ __forceinline__ unsigned f2bf(float f) { unsigned u = __builtin_bit_cast(unsigned, f); return (u + 0x7fffu + ((u >> 16) & 1u)) >> 16; }
__device__ __forceinline__ unsigned pk2(float lo, float hi) { return f2bf(lo) | (f2bf(hi) << 16); }

#define XB_TMO      128
#define XB_XCNT(j)  (256  + 64 * (j))
#define XB_XSUB(j)  (1280 + 64 * (j))
#define XB_XGEN(j)  (2304 + 64 * (j))
#define XB_TOP      3328
#define XB_TOPGEN   3392
#define XCD_BAR_WORDS 3456
#define XB_SPIN_CAP (1u << 22)

__device__ __forceinline__ unsigned xb_ld(unsigned* p)              { return __hip_atomic_load(p, __ATOMIC_RELAXED, __HIP_MEMORY_SCOPE_AGENT); }
__device__ __forceinline__ unsigned xb_add(unsigned* p, unsigned v) { return __hip_atomic_fetch_add(p, v, __ATOMIC_RELAXED, __HIP_MEMORY_SCOPE_AGENT); }
__device__ __forceinline__ unsigned xb_xcc_id() { return (unsigned)__builtin_amdgcn_s_getreg((3 << 11) | 20) & 0xFu; }
#define XB_SPIN(cond, bar) do { unsigned _sp = 0; while (cond) { __builtin_amdgcn_s_sleep(1); \
    if ((++_sp & 255u) == 0u) { if (xb_ld(&(bar)[XB_TMO])) break; if (_sp > XB_SPIN_CAP) { atomicAdd(&(bar)[XB_TMO], 1u); break; } } } } while (0)

struct XcdBarrier {
    unsigned* bar; unsigned x;
    volatile LAS unsigned* st;
};

__device__ __forceinline__ XcdBarrier xcd_barrier_post(unsigned* bar, volatile LAS unsigned* st) {
    XcdBarrier b; b.bar = bar; b.x = xb_xcc_id(); b.st = st;
    if (threadIdx.x == 0) (void)xb_add(&bar[XB_XCNT(b.x)], 1u);
    return b;
}
__device__ __forceinline__ void xcd_barrier_complete(unsigned* bar, unsigned x, unsigned& nloc, unsigned& nx) {
    const unsigned G = gridDim.x * gridDim.y * gridDim.z;
    unsigned sum, cnt, mine, sp = 0u;
    for (;;) {
        sum = 0u; cnt = 0u; mine = 0u;
#pragma unroll
        for (unsigned j = 0; j < 16; ++j) { const unsigned c = xb_ld(&bar[XB_XCNT(j)]); sum += c; cnt += (c > 0u) ? 1u : 0u; mine = (j == x) ? c : mine; }
        if (sum == G) break;
        __builtin_amdgcn_s_sleep(1);
        if ((++sp & 255u) == 0u) { if (xb_ld(&bar[XB_TMO])) break; if (sp > XB_SPIN_CAP) { atomicAdd(&bar[XB_TMO], 1u); break; } }
    }
    nloc = mine > 0u ? mine : 1u; nx = cnt > 0u ? cnt : 1u;
}

__device__ __forceinline__ void xcd_barrier(const XcdBarrier& b, int tid  ) {
    asm volatile("s_waitcnt vmcnt(0)" ::: "memory");
    __syncthreads();
    if (tid == 0) {
        unsigned* bar = b.bar;
        __builtin_amdgcn_s_waitcnt(0);
        unsigned nloc = b.st[0], nx = b.st[1];
        if (nloc == 0u) { xcd_barrier_complete(bar, b.x, nloc, nx); b.st[0] = nloc; b.st[1] = nx; }
        const unsigned old = xb_add(&bar[XB_XSUB(b.x)], 1u);
        const unsigned gen = old / nloc;
        if (old + 1u == (gen + 1u) * nloc) {
            __builtin_amdgcn_fence(__ATOMIC_RELEASE, "agent");
            asm volatile("s_waitcnt vmcnt(0)" ::: "memory");
            const unsigned og = xb_add(&bar[XB_TOP], 1u);
            const unsigned tg = og / nx;
            if (og + 1u == (tg + 1u) * nx) xb_add(&bar[XB_TOPGEN], 1u);
            else XB_SPIN(xb_ld(&bar[XB_TOPGEN]) == tg, bar);
            __builtin_amdgcn_fence(__ATOMIC_ACQUIRE, "agent");
            xb_add(&bar[XB_XGEN(b.x)], 1u);
            asm volatile("s_waitcnt vmcnt(0)" ::: "memory");
        } else {
            XB_SPIN(xb_ld(&bar[XB_XGEN(b.x)]) == gen, bar);
            __builtin_amdgcn_fence(__ATOMIC_ACQUIRE, "agent");
            asm volatile("s_waitcnt vmcnt(0)" ::: "memory");
        }
    }
    __syncthreads();
}
struct Frame {
    LAS unsigned char* lds;
    volatile LAS unsigned* MISC;
    gu32* ctl;
    int tid, lane, wave;
    int vcu, G;
    const float *x, *c, *w_ada, *b_ada, *norm1_w, *w_in, *conv_w, *a_log, *dt_bias, *gdn_norm_w, *q_norm_w, *k_norm_w, *sinks, *w_out, *norm2_w, *w_gate, *w_up, *w_down;
    float* out;
    float *modacc, *modf, *dec;
    bf16 *Win_t, *Wout_t, *Wgu_t, *Wdn_t, *H, *PQ, *MIX, *X1B, *CHKA, *CHKU, *CHKT, *ORAW;
};
template <int CTRL, int ROWMASK, bool BC>
__device__ __forceinline__ float dpp_mov(float v) { return __int_as_float(__builtin_amdgcn_update_dpp(0, __float_as_int(v), CTRL, ROWMASK, 0xF, BC)); }
__device__ __forceinline__ float sum8(float v) { v += dpp_mov<0xB1, 0xF, true>(v); v += dpp_mov<0x4E, 0xF, true>(v); v += dpp_mov<0x141, 0xF, true>(v); return v; }
__device__ __forceinline__ float wave_sum(float v) {
    v = sum8(v); v += dpp_mov<0x140, 0xF, true>(v);
    v += dpp_mov<0x142, 0xA, false>(v); v += dpp_mov<0x143, 0xC, false>(v);
    return __int_as_float(__builtin_amdgcn_readlane(__float_as_int(v), 63));
}
__device__ __forceinline__ float fq_sum(float v) {
    auto r = __builtin_amdgcn_permlane16_swap(__float_as_uint(v), __float_as_uint(v), false, false); v = __uint_as_float(r[0]) + __uint_as_float(r[1]);
    auto s = __builtin_amdgcn_permlane32_swap(__float_as_uint(v), __float_as_uint(v), false, false); return __uint_as_float(s[0]) + __uint_as_float(s[1]);
}
__device__ __forceinline__ float fq_max(float v) {
    auto r = __builtin_amdgcn_permlane16_swap(__float_as_uint(v), __float_as_uint(v), false, false); v = fmaxf(__uint_as_float(r[0]), __uint_as_float(r[1]));
    auto s = __builtin_amdgcn_permlane32_swap(__float_as_uint(v), __float_as_uint(v), false, false); return fmaxf(__uint_as_float(s[0]), __uint_as_float(s[1]));
}
typedef float f32x2_t __attribute__((ext_vector_type(2))); typedef __bf16 bf16x2_t __attribute__((ext_vector_type(2)));
__device__ __forceinline__ unsigned cvtpk(float lo, float hi) { f32x2_t v = {lo, hi}; bf16x2_t b = __builtin_convertvector(v, bf16x2_t); return __builtin_bit_cast(unsigned, b); }
__device__ __forceinline__ float bf2f(bf16 h) { return __uint_as_float((unsigned)h << 16); }
__device__ __forceinline__ float ld_f32_coh(const float* p) { return __uint_as_float(__hip_atomic_load((const unsigned*)p, RLX_AGENT)); }
__device__ __forceinline__ float silu(float x) { return x * __builtin_amdgcn_rcpf(1.0f + __expf(-x)); }
__device__ __forceinline__ float rsq(float x) { return __builtin_amdgcn_rsqf(x); }

__device__ __forceinline__ void tr_item64(const float* W, int ldw, int src_col, bf16* WT, int K, int dst_row, int k0, LAS bf16* tl, int lane) {
    const int cg = lane & 15, rr = lane >> 4;
    f32x4 v[16];
#pragma unroll
    for (int i = 0; i < 16; ++i) v[i] = *(const GAS f32x4*)(W + (size_t)(k0 + 4 * i + rr) * ldw + src_col + 4 * cg);
#pragma unroll
    for (int i = 0; i < 16; ++i) *(LAS unsigned long long*)(tl + (4 * i + rr) * 68 + 4 * cg) = (unsigned long long)cvtpk(v[i].x, v[i].y) | ((unsigned long long)cvtpk(v[i].z, v[i].w) << 32);
    LDS_WAIT(); asm volatile("" ::: "memory");
#pragma unroll
    for (int ii = 0; ii < 8; ++ii) { const int p = lane + 64 * ii, n = p >> 3, kc = p & 7; const LAS bf16* s = tl + (8 * kc) * 68 + n;
        v4u o; o.x = (unsigned)s[0] | ((unsigned)s[68] << 16); o.y = (unsigned)s[2 * 68] | ((unsigned)s[3 * 68] << 16); o.z = (unsigned)s[4 * 68] | ((unsigned)s[5 * 68] << 16); o.w = (unsigned)s[6 * 68] | ((unsigned)s[7 * 68] << 16);
        *(GAS v4u*)(WT + (size_t)(dst_row + n) * K + k0 + 8 * kc) = o; }
    LDS_WAIT(); asm volatile("" ::: "memory");
}

__device__ __forceinline__ void p0_prologue(Frame& F) {
    LAS bf16* tl = (LAS bf16*)(F.lds + RING_OFF + F.wave * 16384);
    const int gw = F.vcu * NWAVES + F.wave, NGW = F.G * NWAVES, lane = F.lane;
    if ((int)blockIdx.x < 24 * 8) {
        const int ct = blockIdx.x % 24, kg = blockIdx.x / 24, col = ct * 256 + 4 * lane, k0 = kg * 128 + F.wave * 16;
        f32x4 w[16];
#pragma unroll
        for (int kk = 0; kk < 16; ++kk) w[kk] = *(const GAS f32x4*)(F.w_ada + (size_t)(k0 + kk) * (6 * D) + col);
        f32x4 acc[4];
#pragma unroll
        for (int b = 0; b < 4; ++b) acc[b] = (f32x4){0.f, 0.f, 0.f, 0.f};
#pragma unroll
        for (int kk = 0; kk < 16; ++kk)
#pragma unroll
            for (int b = 0; b < 4; ++b) acc[b] += silu(F.c[b * D + k0 + kk]) * w[kk];
        LAS f32x4* rd = (LAS f32x4*)(F.lds + RING_OFF + F.wave * 16384 + 12288);
#pragma unroll
        for (int b = 0; b < 4; ++b) rd[b * 64 + lane] = acc[b];
        __syncthreads();
#pragma unroll
        for (int j = 0; j < 2; ++j) { const int e = F.tid * 2 + j, bb = e >> 8, c = e & 255; float s = 0.f;
#pragma unroll
            for (int wv = 0; wv < 8; ++wv) s += ((const LAS float*)(F.lds + RING_OFF + wv * 16384 + 12288))[(bb * 64 + (c >> 2)) * 4 + (c & 3)];
            const float prev = atomicAdd(F.modacc + bb * (6 * D) + ct * 256 + c, s); asm volatile("" :: "v"(prev)); }
        __syncthreads();
        if (F.tid == 0) (void)xb_add((unsigned*)(F.ctl + CW_ADA), 1u);
    }
    constexpr int I_IN = 16 * (NP / 64), I_OUT = 16 * 16, I_GU = 16 * (NGU / 64), I_DN = (FF / 64) * 16;
    constexpr int NITEMS = I_IN + I_OUT + I_GU + I_DN;
    for (int it = gw; it < NITEMS; it += NGW) {
        int r = it;
        if (r < I_IN) { const int nb = r % (NP / 64), kb = r / (NP / 64), n0 = 64 * nb;
            tr_item64(F.w_in, PROJ_W, n0 < 2048 ? n0 : (n0 < 2816 ? n0 + 16 : (n0 == 2816 ? 2048 : 0)), F.Win_t, D, n0, 64 * kb, tl, lane); continue; }
        r -= I_IN;
        if (r < I_OUT) { const int nb = r % 16, kb = r / 16; tr_item64(F.w_out, D, 64 * nb, F.Wout_t, D, 64 * nb, 64 * kb, tl, lane); continue; }
        r -= I_OUT;
        if (r < I_GU) { const int nb = r % (NGU / 64), kb = r / (NGU / 64), n0 = 64 * nb, p = n0 >> 8, j = n0 & 255;
            if (j < 128) tr_item64(F.w_gate, FF, 128 * p + j, F.Wgu_t, D, n0, 64 * kb, tl, lane);
            else         tr_item64(F.w_up,   FF, 128 * p + j - 128, F.Wgu_t, D, n0, 64 * kb, tl, lane);
            continue; }
        r -= I_GU;
        { const int nb = r % 16, kb = r / 16; tr_item64(F.w_down, D, 64 * nb, F.Wdn_t, FF, 64 * nb, 64 * kb, tl, lane); }
    }
}

template <int WHICH> __device__ __forceinline__ void norm_phase(Frame& F) {
    const int gw = F.vcu * NWAVES + F.wave, NGW = F.G * NWAVES, lane = F.lane;
    if (WHICH == 1) {
        if (F.tid == 0) { unsigned* bw = (unsigned*)(F.ctl + CW_BAR); XB_SPIN(xb_ld((unsigned*)(F.ctl + CW_ADA)) < 192u, bw); __builtin_amdgcn_fence(__ATOMIC_ACQUIRE, "agent"); asm volatile("s_waitcnt vmcnt(0)" ::: "memory"); }
        __syncthreads();
        for (int idx = gw * 64 + lane; idx < 4 * 6 * D; idx += NGW * 64) F.modf[idx] = F.modacc[idx] + F.b_ada[idx % (6 * D)];
    }
    const float* nw = (WHICH == 1) ? F.norm1_w : F.norm2_w;
    constexpr int R = (WHICH == 1) ? 4 : 8;
    for (int m0 = gw * R; m0 < M; m0 += NGW * R) {
        const int b = m0 / T;
        f32x4 v[R][4];
#pragma unroll
        for (int r = 0; r < R; ++r) {
            if (WHICH == 1) { const GAS f32x4* xr = (const GAS f32x4*)(F.x + (size_t)(m0 + r) * D) + lane;
#pragma unroll
                for (int i = 0; i < 4; ++i) v[r][i] = xr[64 * i]; }
            else { const GAS unsigned long long* xr = (const GAS unsigned long long*)(F.X1B + (size_t)(m0 + r) * D) + lane;
#pragma unroll
                for (int i = 0; i < 4; ++i) { const unsigned long long bb = xr[64 * i]; const unsigned lo = (unsigned)bb, hi = (unsigned)(bb >> 32);
                    v[r][i] = (f32x4){__uint_as_float(lo << 16), __uint_as_float(lo & 0xffff0000u), __uint_as_float(hi << 16), __uint_as_float(hi & 0xffff0000u)}; } } }
        f32x4 gm[4], sh[4];
#pragma unroll
        for (int i = 0; i < 4; ++i) { const int c = 256 * i + 4 * lane; f32x4 sc, sf;
            if (WHICH == 1) { sf = *(const GAS f32x4*)(F.modacc + b * 6 * D + c) + *(const GAS f32x4*)(F.b_ada + c); sc = *(const GAS f32x4*)(F.modacc + b * 6 * D + D + c) + *(const GAS f32x4*)(F.b_ada + D + c); }
            else { sf = *(const GAS f32x4*)(F.modf + b * 6 * D + 3 * D + c); sc = *(const GAS f32x4*)(F.modf + b * 6 * D + 4 * D + c); }
            gm[i] = *(const GAS f32x4*)(nw + c) * (sc + 1.0f); sh[i] = sf; }
#pragma unroll
        for (int r = 0; r < R; ++r) {
            float ss = 0.f;
#pragma unroll
            for (int i = 0; i < 4; ++i) ss += (v[r][i].x * v[r][i].x + v[r][i].y * v[r][i].y) + (v[r][i].z * v[r][i].z + v[r][i].w * v[r][i].w);
            const float rstd = rsq(wave_sum(ss) * (1.0f / D) + EPS);
            GAS unsigned long long* o8 = (GAS unsigned long long*)(F.H + (size_t)(m0 + r) * D) + lane;
#pragma unroll
            for (int i = 0; i < 4; ++i) { const f32x4 a = v[r][i] * rstd * gm[i] + sh[i];
                o8[64 * i] = (unsigned long long)cvtpk(a[0], a[1]) | ((unsigned long long)cvtpk(a[2], a[3]) << 32); }
        }
    }
}

__device__ __forceinline__ float rdlane(float v, int l) { return __int_as_float(__builtin_amdgcn_readlane(__float_as_int(v), l)); }
__device__ __forceinline__ bf16x8 pack8(const f32x4 a, const f32x4 b) {
    v4u w; w.x = cvtpk(a[0], a[1]); w.y = cvtpk(a[2], a[3]); w.z = cvtpk(b[0], b[1]); w.w = cvtpk(b[2], b[3]); return __builtin_bit_cast(bf16x8, w); }
__device__ __forceinline__ bf16x8 tile_frag(const LAS bf16* tile, int t, int ks, int fr, int fq) {
    const LAS bf16* p = tile + (16 * t + fr) * 64 + 32 * ks + 4 * fq;
    const unsigned long long lo = *(const LAS unsigned long long*)p, hi = *(const LAS unsigned long long*)(p + 16);
    v4u v; v.x = (unsigned)lo; v.y = (unsigned)(lo >> 32); v.z = (unsigned)hi; v.w = (unsigned)(hi >> 32); return __builtin_bit_cast(bf16x8, v);
}
__device__ __forceinline__ unsigned long long pack4(float a, float b, float c, float d) { return (unsigned long long)cvtpk(a, b) | ((unsigned long long)cvtpk(c, d) << 32); }

typedef short s16x4 __attribute__((ext_vector_type(4)));
__device__ __forceinline__ s16x4 cvt4(const f32x4 v) { const unsigned lo = cvtpk(v[0], v[1]), hi = cvtpk(v[2], v[3]); typedef unsigned u32x2 __attribute__((ext_vector_type(2))); return __builtin_bit_cast(s16x4, (u32x2){lo, hi}); }
#define MFMA16(a, b, c) __builtin_amdgcn_mfma_f32_16x16x16bf16_1k((a), (b), (c), 0, 0, 0)
#define MFMA32(a, b, c) __builtin_amdgcn_mfma_f32_16x16x32_bf16((a), (b), (c), 0, 0, 0)

template <int NT> __device__ __forceinline__ void gdn_conv_silu(LAS bf16* const (&R)[NT], const float* const (&wp)[NT], bool has_prev, int lane) {
    const int cp = lane & 31; const bool up = lane >= 32;
    f32x2_t w[NT][4], x0[NT], x1[NT], x2[NT]; unsigned sv[NT][3]; LAS unsigned* Ru[NT];
#pragma unroll
    for (int k = 0; k < NT; ++k) {
#pragma unroll
        for (int i = 0; i < 4; ++i) w[k][i] = *(const GAS f32x2_t*)(wp[k] + i * 1536 + 2 * cp);
        Ru[k] = (LAS unsigned*)R[k] + cp + (up ? 32 * 32 : 0);
        const LAS unsigned* R0u = (const LAS unsigned*)R[k] + cp;
#pragma unroll
        for (int i = 0; i < 3; ++i) sv[k][i] = R0u[(32 + i) * 32];
        unsigned p0 = 0u, p1 = 0u, p2 = 0u;
        if (has_prev) { p0 = R0u[0]; p1 = R0u[32]; p2 = R0u[64]; }
        const unsigned i0 = up ? sv[k][0] : p0, i1 = up ? sv[k][1] : p1, i2 = up ? sv[k][2] : p2;
        x0[k] = (f32x2_t){__uint_as_float(i0 << 16), __uint_as_float(i0 & 0xffff0000u)}; x1[k] = (f32x2_t){__uint_as_float(i1 << 16), __uint_as_float(i1 & 0xffff0000u)};
        x2[k] = (f32x2_t){__uint_as_float(i2 << 16), __uint_as_float(i2 & 0xffff0000u)};
    }
#pragma unroll
    for (int c0 = 0; c0 < 32; c0 += 8) {
        unsigned rr[NT][8];
#pragma unroll
        for (int j = 0; j < 8; ++j)
#pragma unroll
            for (int k = 0; k < NT; ++k) { const int c = c0 + j; const unsigned ld = Ru[k][(c + 3) * 32];
                rr[k][j] = (c + 3 < 32) ? ld : (up ? ld : sv[k][c + 3 - 32]); }
        __builtin_amdgcn_sched_barrier(0);
#pragma unroll
        for (int j = 0; j < 8; ++j)
#pragma unroll
            for (int k = 0; k < NT; ++k) { const int c = c0 + j;
                const f32x2_t r = {__uint_as_float(rr[k][j] << 16), __uint_as_float(rr[k][j] & 0xffff0000u)};
                const f32x2_t t = w[k][0] * x0[k] + w[k][1] * x1[k] + w[k][2] * x2[k] + w[k][3] * r; x0[k] = x1[k]; x1[k] = x2[k]; x2[k] = r;
                const f32x2_t e = t * -1.44269504f;
                const f32x2_t d = (f32x2_t){__builtin_amdgcn_exp2f(e.x), __builtin_amdgcn_exp2f(e.y)} + 1.0f;
                const f32x2_t o = t * (f32x2_t){__builtin_amdgcn_rcpf(d.x), __builtin_amdgcn_rcpf(d.y)};
                Ru[k][c * 32] = cvtpk(o.x, o.y); }
        __builtin_amdgcn_sched_barrier(0);
    }
}

__device__ __forceinline__ void gdn_prep_chunk(Frame& F, int ci, LAS unsigned char* wl  ) {
    const int lane = F.lane, bh = ci >> 6, n = ci & 63, b = bh >> 3, hh = bh & 7, fr = lane & 15, fq = lane >> 4;
    const size_t m0 = (size_t)b * T + 64 * n;
    bf16* const cA = F.CHKA + (size_t)ci * 8192;
    bf16* const cT = F.CHKT + (size_t)ci * 8192;
    bf16* const cU = F.CHKU + (size_t)ci * 8192;
    LAS bf16* const R0 = (LAS bf16*)wl;
    LAS bf16* const R1 = (LAS bf16*)(wl + 9728);
#define GDN_RAW(dst, col0) do { _Pragma("unroll") for (int i_ = 0; i_ < 9; ++i_) { long row_ = (long)m0 - 3 + 8 * i_ + (lane >> 3); row_ = row_ < 0 ? 0 : (row_ > M - 1 ? M - 1 : row_); \
        __builtin_amdgcn_global_load_lds((const unsigned*)(F.PQ + (size_t)row_ * NP + (col0) + hh * 64 + (lane & 7) * 8), (LAS unsigned*)((dst) + i_ * 512), 16, 0, 0); } } while (0)
    GDN_RAW(R0, C_GQ); GDN_RAW(R1, C_GK);
    const f32x4 z4 = (f32x4){0.f, 0.f, 0.f, 0.f};
    float g, beta;
    {
        const float ga = bf2f(F.PQ[(m0 + lane) * NP + C_GA + hh]), gbv = bf2f(F.PQ[(m0 + lane) * NP + C_GB + hh]);
        const float xx = ga + F.dt_bias[hh]; g = -__expf(F.a_log[hh]) * (fmaxf(xx, 0.f) + log1pf(__expf(-fabsf(xx)))); beta = __builtin_amdgcn_rcpf(1.0f + __expf(-gbv));
    }
    float G = g;
#pragma unroll
    for (int o = 1; o < 64; o <<= 1) { const float t = __shfl_up(G, o); if (lane >= o) G += t; }
    const float eG = __expf(G), Glast = __shfl(G, 63), kdsc = __expf(Glast - G), beG = beta * eG;
    if (lane == 0) F.dec[ci] = __expf(Glast);
    asm volatile("s_waitcnt vmcnt(0)" ::: "memory");
    { LAS bf16* const Rs[2] = {R0, R1}; const float* const wps[2] = {F.conv_w + hh * 64, F.conv_w + 512 + hh * 64}; gdn_conv_silu<2>(Rs, wps, n > 0, lane); }
    LDS_WAIT(); asm volatile("" ::: "memory"); __builtin_amdgcn_sched_barrier(0);
    bf16x8 kf[4][2], qf[4][2];
#pragma unroll
    for (int blk = 0; blk < 4; ++blk)
#pragma unroll
        for (int kk = 0; kk < 2; ++kk) { kf[blk][kk] = *(const LAS bf16x8*)(R1 + (16 * blk + fr) * 64 + 32 * kk + 8 * fq); qf[blk][kk] = *(const LAS bf16x8*)(R0 + (16 * blk + fr) * 64 + 32 * kk + 8 * fq); }
    float rqc[4], rkc[4];
#pragma unroll
    for (int t = 0; t < 4; ++t) { f32x4 dq = MFMA32(qf[t][0], qf[t][0], z4); dq = MFMA32(qf[t][1], qf[t][1], dq); f32x4 dk = MFMA32(kf[t][0], kf[t][0], z4); dk = MFMA32(kf[t][1], kf[t][1], dk);
        const int di = fr & 3; const bool on = (fq == (fr >> 2));
        const float vq = di == 0 ? dq[0] : di == 1 ? dq[1] : di == 2 ? dq[2] : dq[3], vk = di == 0 ? dk[0] : di == 1 ? dk[1] : di == 2 ? dk[2] : dk[3];
        rqc[t] = rsq(fq_sum(on ? vq : 0.f) + EPS); rkc[t] = rsq(fq_sum(on ? vk : 0.f) + EPS); }
    const float rk_tok = fq == 0 ? rkc[0] : fq == 1 ? rkc[1] : fq == 2 ? rkc[2] : rkc[3];
    const float beGn = beG * rk_tok, kdscn = kdsc * rk_tok;
    float Gcol[4], Bcol[4];
#pragma unroll
    for (int t = 0; t < 4; ++t) { Gcol[t] = __shfl(G, 16 * t + fr); Bcol[t] = __shfl(beta, 16 * t + fr) * rkc[t]; }
#pragma unroll
    for (int mt = 0; mt < 4; ++mt) { const float esc = __expf(Gcol[mt]) * 0.125f * rqc[mt];
#pragma unroll
        for (int ks = 0; ks < 2; ++ks) { const v4u q8 = __builtin_bit_cast(v4u, tile_frag(R0, mt, ks, fr, fq)); const unsigned w_[4] = {q8.x, q8.y, q8.z, q8.w}; v4u o_;
            o_.x = cvtpk(__uint_as_float(w_[0] << 16) * esc, __uint_as_float(w_[0] & 0xffff0000u) * esc); o_.y = cvtpk(__uint_as_float(w_[1] << 16) * esc, __uint_as_float(w_[1] & 0xffff0000u) * esc);
            o_.z = cvtpk(__uint_as_float(w_[2] << 16) * esc, __uint_as_float(w_[2] & 0xffff0000u) * esc); o_.w = cvtpk(__uint_as_float(w_[3] << 16) * esc, __uint_as_float(w_[3] & 0xffff0000u) * esc);
            *(GAS v4u*)(cT + ((mt * 2 + ks) * 64 + lane) * 8) = o_; } }
    LDS_WAIT(); asm volatile("" ::: "memory"); __builtin_amdgcn_sched_barrier(0);
#pragma unroll
    for (int ks = 0; ks < 2; ++ks) { float Grow[2][4], Krow[2][4];
#pragma unroll
        for (int h2 = 0; h2 < 2; ++h2)
#pragma unroll
            for (int i = 0; i < 4; ++i) { Grow[h2][i] = __shfl(G, 16 * (2 * ks + h2) + 4 * fq + i); Krow[h2][i] = __shfl(rk_tok, 16 * (2 * ks + h2) + 4 * fq + i); }
#pragma unroll
        for (int tc = 0; tc < 4; ++tc) {
            f32x4 v[2];
#pragma unroll
            for (int h2 = 0; h2 < 2; ++h2) { const int ts = 2 * ks + h2;
                if (ts <= tc) { f32x4 acc = MFMA32(kf[ts][0], qf[tc][0], z4); acc = MFMA32(kf[ts][1], qf[tc][1], acc);
#pragma unroll
                    for (int i = 0; i < 4; ++i) { const int cidx = 16 * tc + fr, sidx = 16 * ts + 4 * fq + i; v[h2][i] = (cidx >= sidx) ? acc[i] * __expf(Gcol[tc] - Grow[h2][i]) * (0.125f * rqc[tc]) * Krow[h2][i] : 0.f; }
                } else v[h2] = z4; }
            *(bf16x8*)(cT + 4096 + ((tc * 2 + ks) * 64 + lane) * 8) = pack8(v[0], v[1]);
        } }
#pragma unroll
    for (int ts = 0; ts < 4; ++ts) { float Grow[4], Krow[4];
#pragma unroll
        for (int i = 0; i < 4; ++i) { Grow[i] = __shfl(G, 16 * ts + 4 * fq + i); Krow[i] = __shfl(rk_tok, 16 * ts + 4 * fq + i); }
#pragma unroll
        for (int tc = 0; tc < 4; ++tc) { f32x4 a = z4;
            if (ts <= tc) { f32x4 acc = MFMA32(kf[ts][0], kf[tc][0], z4); acc = MFMA32(kf[ts][1], kf[tc][1], acc);
#pragma unroll
                for (int i = 0; i < 4; ++i) { const int cidx = 16 * tc + fr, sidx = 16 * ts + 4 * fq + i; a[i] = (cidx > sidx) ? Bcol[tc] * Krow[i] * acc[i] * __expf(Gcol[tc] - Grow[i]) : 0.f; } }
            *(LAS unsigned long long*)(R0 + (16 * tc + fr) * 64 + 16 * ts + 4 * fq) = pack4(a[0], a[1], a[2], a[3]); } }
    bf16x8 RkB[4][2], KDf[4][2];
    LAS float* const sp0 = (LAS float*)(wl + 9216); LAS float* const sp1 = (LAS float*)(wl + 9728 + 9216);
    sp0[lane] = beGn; sp0[64 + lane] = kdscn; sp1[lane] = beta;
#pragma unroll
    for (int ks = 0; ks < 2; ++ks) { float sB[8], sD[8];
#pragma unroll
        for (int h = 0; h < 2; ++h) { const f32x4 b_ = *(const LAS f32x4*)(sp0 + 32 * ks + 16 * h + 4 * fq), d_ = *(const LAS f32x4*)(sp0 + 64 + 32 * ks + 16 * h + 4 * fq);
#pragma unroll
            for (int q = 0; q < 4; ++q) { sB[4 * h + q] = b_[q]; sD[4 * h + q] = d_[q]; } }
#pragma unroll
        for (int t = 0; t < 4; ++t) { float kv[8];
#pragma unroll
            for (int h = 0; h < 2; ++h) { const s16x4 r_ = __builtin_amdgcn_ds_read_tr16_b64_v4i16((LAS s16x4*)(R1 + (32 * ks + 16 * h + 4 * fq + (fr >> 2)) * 64 + 16 * t + 4 * (fr & 3)));
#pragma unroll
                for (int q = 0; q < 4; ++q) kv[4 * h + q] = bf2f((bf16)r_[q]); }
            v4u a_, d_;
            a_.x = cvtpk(kv[0] * sB[0], kv[1] * sB[1]); a_.y = cvtpk(kv[2] * sB[2], kv[3] * sB[3]); a_.z = cvtpk(kv[4] * sB[4], kv[5] * sB[5]); a_.w = cvtpk(kv[6] * sB[6], kv[7] * sB[7]);
            d_.x = cvtpk(kv[0] * sD[0], kv[1] * sD[1]); d_.y = cvtpk(kv[2] * sD[2], kv[3] * sD[3]); d_.z = cvtpk(kv[4] * sD[4], kv[5] * sD[5]); d_.w = cvtpk(kv[6] * sD[6], kv[7] * sD[7]);
            RkB[t][ks] = __builtin_bit_cast(bf16x8, a_); KDf[t][ks] = __builtin_bit_cast(bf16x8, d_); } }
    LDS_WAIT(); asm volatile("" ::: "memory"); __builtin_amdgcn_sched_barrier(0);
    GDN_RAW(R1, C_GV);
    {
        float X[16];
#pragma unroll
        for (int r = 0; r < 16; ++r) X[r] = (r == fr) ? 1.f : 0.f;
        const LAS bf16* ab = R0 + (16 * fq) * 64 + 16 * fq;
#pragma unroll
        for (int p = 0; p < 8; ++p) {
            unsigned a2[16];
#pragma unroll
            for (int r = 2 * p + 1; r < 16; ++r) a2[r] = *(const LAS unsigned*)(ab + r * 64 + 2 * p);
#pragma unroll
            for (int r = 2 * p + 1; r < 16; ++r) X[r] -= __uint_as_float(a2[r] << 16) * X[2 * p];
#pragma unroll
            for (int r = 2 * p + 2; r < 16; ++r) X[r] -= __uint_as_float(a2[r] & 0xffff0000u) * X[2 * p + 1];
            if ((p & 1) == 1) __builtin_amdgcn_sched_barrier(0);
        }
        LDS_WAIT(); asm volatile("" ::: "memory"); __builtin_amdgcn_sched_barrier(0);
        {
            const bool odd = (fr & 1) != 0;
            LAS bf16* dp = R0 + (16 * fq + (odd ? 1 : 0)) * 64 + 16 * fq + (fr & ~1);
#pragma unroll
            for (int r = 0; r < 16; r += 2) { const float snd = odd ? X[r] : X[r + 1], rcv = dpp_mov<0xB1, 0xF, true>(snd);
                *(LAS unsigned*)(dp + r * 64) = odd ? cvtpk(rcv, X[r + 1]) : cvtpk(X[r], rcv); }
        }
    }
    LDS_WAIT(); asm volatile("" ::: "memory"); __builtin_amdgcn_sched_barrier(0);
    {
#define A16(i, k) (*(const LAS s16x4*)(R0 + (16 * (i) + fr) * 64 + 16 * (k) + 4 * fq))
        s16x4 Td[4];
#pragma unroll
        for (int j = 0; j < 3; ++j) { const LAS bf16* p = R0 + (16 * j + 4 * fq) * 64 + 16 * j + fr; typedef unsigned u32x2 __attribute__((ext_vector_type(2)));
            Td[j] = __builtin_bit_cast(s16x4, (u32x2){(unsigned)p[0] | ((unsigned)p[64] << 16), (unsigned)p[128] | ((unsigned)p[192] << 16)}); }
        f32x4 m10 = MFMA16(A16(1, 0), Td[0], z4);
        const f32x4 t10 = -MFMA16(A16(1, 1), cvt4(m10), z4);
        f32x4 m21 = MFMA16(A16(2, 1), Td[1], z4);
        f32x4 m20 = MFMA16(A16(2, 0), Td[0], z4); m20 = MFMA16(A16(2, 1), cvt4(t10), m20);
        const s16x4 a22 = A16(2, 2);
        const f32x4 t21 = -MFMA16(a22, cvt4(m21), z4), t20 = -MFMA16(a22, cvt4(m20), z4);
        f32x4 m32 = MFMA16(A16(3, 2), Td[2], z4);
        f32x4 m31 = MFMA16(A16(3, 1), Td[1], z4); m31 = MFMA16(A16(3, 2), cvt4(t21), m31);
        f32x4 m30 = MFMA16(A16(3, 0), Td[0], z4); m30 = MFMA16(A16(3, 1), cvt4(t10), m30); m30 = MFMA16(A16(3, 2), cvt4(t20), m30);
        const s16x4 a33 = A16(3, 3);
        const f32x4 t32 = -MFMA16(a33, cvt4(m32), z4), t31 = -MFMA16(a33, cvt4(m31), z4), t30 = -MFMA16(a33, cvt4(m30), z4);
        LDS_WAIT(); asm volatile("" ::: "memory"); __builtin_amdgcn_sched_barrier(0);
#define TST(i, j, t) do { const bool od_ = (fr & 1) != 0; _Pragma("unroll") for (int r_ = 0; r_ < 4; r_ += 2) { const float sn_ = od_ ? (t)[r_] : (t)[r_ + 1], rc_ = dpp_mov<0xB1, 0xF, true>(sn_); \
            *(LAS unsigned*)(R0 + (16 * (i) + 4 * fq + r_ + (od_ ? 1 : 0)) * 64 + 16 * (j) + (fr & ~1)) = od_ ? cvtpk(rc_, (t)[r_ + 1]) : cvtpk((t)[r_], rc_); } } while (0)
        TST(1, 0, t10); TST(2, 0, t20); TST(2, 1, t21); TST(3, 0, t30); TST(3, 1, t31); TST(3, 2, t32);
#undef TST
#undef A16
    }
    LDS_WAIT(); asm volatile("" ::: "memory"); __builtin_amdgcn_sched_barrier(0);
    asm volatile("s_waitcnt vmcnt(0)" ::: "memory");
    v4u qdf[8]; bf16x8 qkf[8];
#pragma unroll
    for (int f = 0; f < 8; ++f) { qdf[f] = *(const GAS v4u*)(cT + (f * 64 + lane) * 8); qkf[f] = *(const GAS bf16x8*)(cT + 4096 + (f * 64 + lane) * 8); }
    bf16x8 waf[4][2];
    {
        bf16x8 ta[4][2];
#pragma unroll
        for (int ct = 0; ct < 4; ++ct) { ta[ct][0] = tile_frag(R0, ct, 0, fr, fq); if (ct >= 2) ta[ct][1] = tile_frag(R0, ct, 1, fr, fq); }
        LDS_WAIT(); asm volatile("" ::: "memory");
#pragma unroll
        for (int dt = 0; dt < 4; ++dt) { f32x4 wa[4];
#pragma unroll
            for (int ct = 0; ct < 4; ++ct) { f32x4 acc = MFMA32(ta[ct][0], RkB[dt][0], z4); if (ct >= 2) acc = MFMA32(ta[ct][1], RkB[dt][1], acc); wa[ct] = acc; }
            waf[dt][0] = pack8(wa[0], wa[1]); waf[dt][1] = pack8(wa[2], wa[3]); }
    }
#pragma unroll
    for (int tn = 0; tn < 4; ++tn) {
#pragma unroll
        for (int ks2 = 0; ks2 < 2; ++ks2) {
            const v4u qd8 = qdf[tn * 2 + ks2]; const unsigned qw_[4] = {qd8.x, qd8.y, qd8.z, qd8.w};
            f32x4 pp[2], q2[2];
#pragma unroll
            for (int h2 = 0; h2 < 2; ++h2) { const int tm = 2 * ks2 + h2;
                f32x4 a1 = MFMA32(waf[tm][0], KDf[tn][0], z4); a1 = MFMA32(waf[tm][1], KDf[tn][1], a1);
                f32x4 a2 = MFMA32(waf[tm][0], qkf[tn * 2], z4); a2 = MFMA32(waf[tm][1], qkf[tn * 2 + 1], a2);
                pp[h2] = -a1;
                q2[h2] = (f32x4){__uint_as_float(qw_[2 * h2] << 16), __uint_as_float(qw_[2 * h2] & 0xffff0000u), __uint_as_float(qw_[2 * h2 + 1] << 16), __uint_as_float(qw_[2 * h2 + 1] & 0xffff0000u)} - a2; }
            *(GAS bf16x8*)(cA + ((tn * 2 + ks2) * 64 + lane) * 8) = pack8(pp[0], pp[1]);
            *(GAS bf16x8*)(cA + 4096 + ((tn * 2 + ks2) * 64 + lane) * 8) = pack8(q2[0], q2[1]);
        }
    }
    asm volatile("s_waitcnt vmcnt(0)" ::: "memory");
    { LAS bf16* const Rs[1] = {R1}; const float* const wps[1] = {F.conv_w + 1024 + hh * 64}; gdn_conv_silu<1>(Rs, wps, n > 0, lane); }
    LDS_WAIT(); asm volatile("" ::: "memory"); __builtin_amdgcn_sched_barrier(0);
    bf16x8 RvB[4][2];
#pragma unroll
    for (int ks = 0; ks < 2; ++ks) { float sB[8];
#pragma unroll
        for (int h = 0; h < 2; ++h) { const f32x4 b_ = *(const LAS f32x4*)(sp1 + 32 * ks + 16 * h + 4 * fq);
#pragma unroll
            for (int q = 0; q < 4; ++q) sB[4 * h + q] = b_[q]; }
#pragma unroll
        for (int t = 0; t < 4; ++t) { float vv[8];
#pragma unroll
            for (int h = 0; h < 2; ++h) { const s16x4 r_ = __builtin_amdgcn_ds_read_tr16_b64_v4i16((LAS s16x4*)(R1 + (32 * ks + 16 * h + 4 * fq + (fr >> 2)) * 64 + 16 * t + 4 * (fr & 3)));
#pragma unroll
                for (int q = 0; q < 4; ++q) vv[4 * h + q] = bf2f((bf16)r_[q]) * sB[4 * h + q]; }
            v4u a_; a_.x = cvtpk(vv[0], vv[1]); a_.y = cvtpk(vv[2], vv[3]); a_.z = cvtpk(vv[4], vv[5]); a_.w = cvtpk(vv[6], vv[7]);
            RvB[t][ks] = __builtin_bit_cast(bf16x8, a_); } }
    LDS_WAIT(); asm volatile("" ::: "memory"); __builtin_amdgcn_sched_barrier(0);
    bf16x8 tu[4][2];
#pragma unroll
    for (int ct = 0; ct < 4; ++ct) { tu[ct][0] = tile_frag(R0, ct, 0, fr, fq); if (ct >= 2) tu[ct][1] = tile_frag(R0, ct, 1, fr, fq); }
    LDS_WAIT(); asm volatile("" ::: "memory");
#pragma unroll
    for (int et = 0; et < 4; ++et) {
        f32x4 ua[4];
#pragma unroll
        for (int ct = 0; ct < 4; ++ct) { f32x4 acc = MFMA32(tu[ct][0], RvB[et][0], z4); if (ct >= 2) acc = MFMA32(tu[ct][1], RvB[et][1], acc); ua[ct] = acc; }
        const bf16x8 ub0 = pack8(ua[0], ua[1]), ub1 = pack8(ua[2], ua[3]);
#pragma unroll
        for (int tp = 0; tp < 2; ++tp) {
            unsigned long long rr[2], oo[2];
#pragma unroll
            for (int h2 = 0; h2 < 2; ++h2) { const int tm = 2 * tp + h2;
                const bf16x8 qa0 = qkf[tm * 2], qa1 = qkf[tm * 2 + 1];
                f32x4 r = MFMA32(KDf[tm][0], ub0, z4); r = MFMA32(KDf[tm][1], ub1, r);
                f32x4 o = MFMA32(qa0, ub0, z4); o = MFMA32(qa1, ub1, o);
                rr[h2] = pack4(r[0], r[1], r[2], r[3]); oo[h2] = pack4(o[0], o[1], o[2], o[3]); }
            *(GAS v4u*)(cU + ((et * 2 + tp) * 64 + lane) * 8) = (v4u){(unsigned)rr[0], (unsigned)(rr[0] >> 32), (unsigned)rr[1], (unsigned)(rr[1] >> 32)};
            *(GAS v4u*)(cU + 4096 + ((et * 2 + tp) * 64 + lane) * 8) = (v4u){(unsigned)oo[0], (unsigned)(oo[0] >> 32), (unsigned)oo[1], (unsigned)(oo[1] >> 32)};
        }
    }
    LDS_WAIT(); asm volatile("" ::: "memory"); __builtin_amdgcn_sched_barrier(0);
}
#undef MFMA16
#undef MFMA32
#undef GDN_RAW

#define GDN_BAR() do { asm volatile("" ::: "memory"); __builtin_amdgcn_s_barrier(); asm volatile("" ::: "memory"); } while (0)
template <int J> struct GdnIC { static constexpr int value = J; };
__device__ __forceinline__ void gdn_scan(Frame& F, int bh, int half) {
    const int lane = F.lane, wave = F.wave, b = bh >> 3, hh = bh & 7, fr = lane & 15, fq = lane >> 4;
    LAS unsigned char* const ring = F.lds + RING_OFF;
    constexpr int SLOT = 16384, OBS = 36  , OB0 = 131072, OB1 = OB0 + 64 * OBS * 2;
    const unsigned char* gA = (const unsigned char*)(F.CHKA + (size_t)bh * 64 * 8192);
    const unsigned char* gU = (const unsigned char*)(F.CHKU + (size_t)bh * 64 * 8192);
    if (wave >= 4) {
        const int hw = wave - 4, nt = hw * 64 + lane;
        bf16* mp = F.ORAW + ((size_t)b * T + (nt >> 2)) * 512 + hh * 64 + 32 * half + (nt & 3) * 8;
#define GDN_ISSUE(nn) do { const int n_ = (nn); const int sl_ = n_ & 7; _Pragma("unroll") for (int i_ = 0; i_ < 4; ++i_) { const int p_ = hw * 4 + i_; \
            __builtin_amdgcn_global_load_lds((const unsigned*)(gA + (size_t)n_ * 16384 + p_ * 1024 + lane * 16), (LAS unsigned*)(ring + sl_ * SLOT + p_ * 1024), 16, 0, 0); } } while (0)
#define GDN_COPY(nn) do { const LAS unsigned char* ob_ = ring + (((nn) & 1) ? OB1 : OB0); \
            const LAS unsigned long long* p_ = (const LAS unsigned long long*)(ob_ + (nt >> 2) * (OBS * 2) + (nt & 3) * 16); const unsigned long long lo_ = p_[0], hi_ = p_[1]; \
            *(GAS v4u*)(mp + (size_t)(64 * (nn)) * 512) = (v4u){(unsigned)lo_, (unsigned)(lo_ >> 32), (unsigned)hi_, (unsigned)(hi_ >> 32)}; } while (0)
#pragma unroll
        for (int i = 0; i < 7; ++i) GDN_ISSUE(i);
        asm volatile("s_waitcnt vmcnt(20)" ::: "memory"); GDN_BAR();
        for (int n = 0; n < 64; ++n) {
            if (n + 7 < 64) { GDN_ISSUE(n + 7); asm volatile("s_waitcnt vmcnt(20)" ::: "memory"); } else asm volatile("s_waitcnt vmcnt(0)" ::: "memory");
            if (n > 0) GDN_COPY(n - 1);
            LDS_WAIT(); GDN_BAR();
        }
        GDN_COPY(63);
#undef GDN_ISSUE
#undef GDN_COPY
    } else if (wave >= 2) {
        GDN_BAR();
        for (int n = 0; n < 64; ++n) GDN_BAR();
    } else {
        const int ew = 2 * half + wave;
        f32x4 Sacc[4];
#pragma unroll
        for (int t = 0; t < 4; ++t) Sacc[t] = (f32x4){0.f, 0.f, 0.f, 0.f};
        const float decs = ld_f32_coh(F.dec + bh * 64 + lane);
        const unsigned char* gUw = gU + ((ew * 2) * 64 + lane) * 16;
        v4u ro4[6][4];
#define GDN_LDRO(nn, j_) do { _Pragma("unroll") for (int p_ = 0; p_ < 2; ++p_) { ro4[j_][p_] = *(const GAS v4u*)(gUw + (size_t)(nn) * 16384 + p_ * 1024); \
            ro4[j_][2 + p_] = *(const GAS v4u*)(gUw + (size_t)(nn) * 16384 + 8192 + p_ * 1024); } } while (0)
        GDN_LDRO(0, 0); GDN_LDRO(1, 1); GDN_LDRO(2, 2); GDN_LDRO(3, 3); GDN_LDRO(4, 4); GDN_LDRO(5, 5);
        GDN_BAR();
        bf16x8 pf[8], qf[8];
#pragma unroll
        for (int f = 0; f < 8; ++f) { pf[f] = *(const LAS bf16x8*)(ring + (f * 64 + lane) * 16); qf[f] = *(const LAS bf16x8*)(ring + 8192 + (f * 64 + lane) * 16); }
        auto step = [&](const int n, auto jc) __attribute__((always_inline)) { constexpr int j = decltype(jc)::value; {
                const LAS unsigned char* sl = ring + ((n + 1) & 7) * SLOT;
                const bool odd = (fr & 1) != 0;
                LAS bf16* ob2 = (LAS bf16*)(ring + ((n & 1) ? OB1 : OB0)) + (4 * fq + (odd ? 1 : 0)) * OBS + 16 * wave + (fr & ~1);
                const float dec = __int_as_float(__builtin_amdgcn_readlane(__float_as_int(decs), n));
                bf16x8 Sb[2]; Sb[0] = pack8(Sacc[0], Sacc[1]); Sb[1] = pack8(Sacc[2], Sacc[3]);
#pragma unroll
                for (int t = 0; t < 4; ++t) { const unsigned rl = (t & 1) ? ro4[j][t >> 1].z : ro4[j][t >> 1].x, rh = (t & 1) ? ro4[j][t >> 1].w : ro4[j][t >> 1].y;
                    Sacc[t] = Sacc[t] * dec + (f32x4){__uint_as_float(rl << 16), __uint_as_float(rl & 0xffff0000u), __uint_as_float(rh << 16), __uint_as_float(rh & 0xffff0000u)}; }
#pragma unroll
                for (int ks = 0; ks < 2; ++ks)
#pragma unroll
                    for (int t = 0; t < 4; ++t) Sacc[t] = __builtin_amdgcn_mfma_f32_16x16x32_bf16(pf[t * 2 + ks], Sb[ks], Sacc[t], 0, 0, 0);
                if (n < 63) {
#pragma unroll
                    for (int f = 0; f < 8; ++f) pf[f] = *(const LAS bf16x8*)(sl + (f * 64 + lane) * 16);
                }
                f32x4 O[4];
#pragma unroll
                for (int t = 0; t < 4; ++t) { const unsigned ol = (t & 1) ? ro4[j][2 + (t >> 1)].z : ro4[j][2 + (t >> 1)].x, oh = (t & 1) ? ro4[j][2 + (t >> 1)].w : ro4[j][2 + (t >> 1)].y;
                    O[t] = (f32x4){__uint_as_float(ol << 16), __uint_as_float(ol & 0xffff0000u), __uint_as_float(oh << 16), __uint_as_float(oh & 0xffff0000u)}; }
#pragma unroll
                for (int ks = 0; ks < 2; ++ks)
#pragma unroll
                    for (int t = 0; t < 4; ++t) O[t] = __builtin_amdgcn_mfma_f32_16x16x32_bf16(qf[t * 2 + ks], Sb[ks], O[t], 0, 0, 0);
                if (n < 63) {
#pragma unroll
                    for (int f = 0; f < 8; ++f) qf[f] = *(const LAS bf16x8*)(sl + 8192 + (f * 64 + lane) * 16);
                }
                if (n + 6 < 64) GDN_LDRO(n + 6, j);
#pragma unroll
                for (int t = 0; t < 4; ++t)
#pragma unroll
                    for (int ip = 0; ip < 2; ++ip) { const float v0 = O[t][2 * ip], v1 = O[t][2 * ip + 1];
                        const float snd = odd ? v0 : v1, rcv = dpp_mov<0xB1, 0xF, true>(snd);
                        *(LAS unsigned*)(ob2 + (16 * t + 2 * ip) * OBS) = odd ? cvtpk(rcv, v1) : cvtpk(v0, rcv); }
                LDS_WAIT(); GDN_BAR();
            }
        };
        for (int n0 = 0; n0 < 60; n0 += 6) { step(n0, GdnIC<0>{}); step(n0 + 1, GdnIC<1>{}); step(n0 + 2, GdnIC<2>{}); step(n0 + 3, GdnIC<3>{}); step(n0 + 4, GdnIC<4>{}); step(n0 + 5, GdnIC<5>{}); }
        step(60, GdnIC<0>{}); step(61, GdnIC<1>{}); step(62, GdnIC<2>{}); step(63, GdnIC<3>{});
#undef GDN_LDRO
    }
}
__device__ __forceinline__ void gdn_norm_rows(Frame& F, int r0) {
    const int oc = F.tid & 7, hd = (F.tid >> 3) & 7;
    float nw[8];
#pragma unroll
    for (int j = 0; j < 8; ++j) nw[j] = F.gdn_norm_w[oc * 8 + j];
#pragma unroll 1
    for (int it = 0; it < 4; ++it) {
        v4u ov[8], zv[8];
#pragma unroll
        for (int k = 0; k < 8; ++k) { const size_t row = (size_t)r0 + (it * 8 + k) * 8 + (F.tid >> 6); ov[k] = *(const GAS v4u*)(F.ORAW + row * 512 + hd * 64 + oc * 8); zv[k] = *(const GAS v4u*)(F.PQ + row * NP + C_GZ + hd * 64 + oc * 8); }
#pragma unroll
        for (int k = 0; k < 8; ++k) { const size_t row = (size_t)r0 + (it * 8 + k) * 8 + (F.tid >> 6);
            const unsigned ow[4] = {ov[k].x, ov[k].y, ov[k].z, ov[k].w}, zw[4] = {zv[k].x, zv[k].y, zv[k].z, zv[k].w};
            float o[8], z[8]; float ss = 0.f;
#pragma unroll
            for (int w = 0; w < 4; ++w) { o[2 * w] = __uint_as_float(ow[w] << 16); o[2 * w + 1] = __uint_as_float(ow[w] & 0xffff0000u); z[2 * w] = __uint_as_float(zw[w] << 16); z[2 * w + 1] = __uint_as_float(zw[w] & 0xffff0000u);
                ss += o[2 * w] * o[2 * w] + o[2 * w + 1] * o[2 * w + 1]; }
            ss = sum8(ss);
            const float rs = rsq(ss * (1.0f / 64.0f) + EPS);
            v4u w4; w4.x = cvtpk(o[0] * rs * nw[0] * z[0], o[1] * rs * nw[1] * z[1]); w4.y = cvtpk(o[2] * rs * nw[2] * z[2], o[3] * rs * nw[3] * z[3]);
            w4.z = cvtpk(o[4] * rs * nw[4] * z[4], o[5] * rs * nw[5] * z[5]); w4.w = cvtpk(o[6] * rs * nw[6] * z[6], o[7] * rs * nw[7] * z[7]);
            *(GAS v4u*)(F.MIX + row * D + hd * 64 + oc * 8) = w4; }
    }
    asm volatile("s_waitcnt vmcnt(0)" ::: "memory"); __syncthreads();
}
__device__ __forceinline__ void swa_unit(Frame& F, int unit, LAS unsigned char* L) {
    const int tid = F.tid, lane = F.lane, wave = F.wave, fr = lane & 15, fq = lane >> 4;
    const int blk = unit & 63, kvh = (unit >> 6) & 1, b = unit >> 7, t0 = blk * 64;
    const size_t row0 = (size_t)b * T;
    LAS bf16* const Ks = (LAS bf16*)L; LAS bf16* const Vt = (LAS bf16*)(L + 27648);
    const int hq = kvh * 4 + (wave >> 1);
    v4u kvr[3], vvr[3], qr[2][2];
#pragma unroll
    for (int it = 0; it < 3; ++it) { const int p = tid + it * (NWAVES * 64), key = p >> 3, oc = p & 7, s = t0 - 128 + key, sc_ = s < 0 ? 0 : s;
        kvr[it] = *(const GAS v4u*)(F.PQ + (row0 + sc_) * NP + C_SK + kvh * 64 + oc * 8); vvr[it] = *(const GAS v4u*)(F.PQ + (row0 + sc_) * NP + C_SV + kvh * 64 + oc * 8); }
#pragma unroll
    for (int qt = 0; qt < 2; ++qt) { const bf16* qp = F.PQ + (row0 + t0 + 32 * (wave & 1) + 16 * qt + fr) * NP + C_SQ + hq * 64 + 8 * fq;
        qr[qt][0] = *(const GAS v4u*)qp; qr[qt][1] = *(const GAS v4u*)(qp + 32); }
    float knw[8];
#pragma unroll
    for (int j = 0; j < 8; ++j) knw[j] = F.k_norm_w[(tid & 7) * 8 + j];
#pragma unroll
    for (int it = 0; it < 3; ++it) {
        const int p = tid + it * (NWAVES * 64), key = p >> 3, oc = p & 7, s = t0 - 128 + key;
        v4u kv = kvr[it], vv = vvr[it];
        if (s < 0) { kv = (v4u){0u, 0u, 0u, 0u}; vv = (v4u){0u, 0u, 0u, 0u}; }
        const unsigned kw[4] = {kv.x, kv.y, kv.z, kv.w}, vw[4] = {vv.x, vv.y, vv.z, vv.w};
        float k[8]; float ss = 0.f;
#pragma unroll
        for (int w = 0; w < 4; ++w) { k[2 * w] = __uint_as_float(kw[w] << 16); k[2 * w + 1] = __uint_as_float(kw[w] & 0xffff0000u); ss += k[2 * w] * k[2 * w] + k[2 * w + 1] * k[2 * w + 1]; }
        ss = sum8(ss);
        const float rstd = rsq(ss * (1.0f / 64.0f) + EPS);
#pragma unroll
        for (int j = 0; j < 8; ++j) k[j] = k[j] * rstd * knw[j];
        v4u o; o.x = cvtpk(k[0], k[1]); o.y = cvtpk(k[2], k[3]); o.z = cvtpk(k[4], k[5]); o.w = cvtpk(k[6], k[7]);
        *(LAS v4u*)(Ks + key * 72 + oc * 8) = o;
#pragma unroll
        for (int w = 0; w < 4; ++w) { Vt[(oc * 8 + 2 * w) * 196 + key] = (bf16)(vw[w] & 0xffffu); Vt[(oc * 8 + 2 * w + 1) * 196 + key] = (bf16)(vw[w] >> 16); }
    }
    __syncthreads();
    const float slope = exp2f(-(float)(hq + 1)), sink = F.sinks[hq];
#pragma unroll
    for (int qt = 0; qt < 2; ++qt) {
        const int tq0 = t0 + 32 * (wave & 1) + 16 * qt;
        bf16x8 qf[2];
        {
            const v4u r0 = qr[qt][0], r1 = qr[qt][1];
            const unsigned qw[8] = {r0.x, r0.y, r0.z, r0.w, r1.x, r1.y, r1.z, r1.w};
            float q[16]; float ss = 0.f;
#pragma unroll
            for (int w = 0; w < 8; ++w) { q[2 * w] = __uint_as_float(qw[w] << 16); q[2 * w + 1] = __uint_as_float(qw[w] & 0xffff0000u); ss += q[2 * w] * q[2 * w] + q[2 * w + 1] * q[2 * w + 1]; }
            ss = fq_sum(ss);
            const float rstd = 0.125f * rsq(ss * (1.0f / 64.0f) + EPS);
#pragma unroll
            for (int kk = 0; kk < 2; ++kk) { float z[8];
#pragma unroll
                for (int j = 0; j < 8; ++j) z[j] = q[8 * kk + j] * rstd * F.q_norm_w[32 * kk + 8 * fq + j];
                v4u o; o.x = cvtpk(z[0], z[1]); o.y = cvtpk(z[2], z[3]); o.z = cvtpk(z[4], z[5]); o.w = cvtpk(z[6], z[7]); qf[kk] = __builtin_bit_cast(bf16x8, o); }
        }
        f32x4 sc[12]; float mx = -INFINITY;
#pragma unroll
        for (int nt = 0; nt < 12; ++nt) { f32x4 acc = (f32x4){0.f, 0.f, 0.f, 0.f};
#pragma unroll
            for (int kk = 0; kk < 2; ++kk) { const bf16x8 kf = *(const LAS bf16x8*)(Ks + (16 * nt + fr) * 72 + 32 * kk + 8 * fq); acc = __builtin_amdgcn_mfma_f32_16x16x32_bf16(kf, qf[kk], acc, 0, 0, 0); }
#pragma unroll
            for (int i = 0; i < 4; ++i) { const int s = t0 - 128 + 16 * nt + 4 * fq + i, dist = tq0 + fr - s; const bool ok = (s >= 0) && (dist >= 0) && (dist < 128);
                const float v = ok ? acc[i] - slope * (float)dist : -INFINITY; acc[i] = v; mx = fmaxf(mx, v); }
            sc[nt] = acc; if (nt & 1) __builtin_amdgcn_sched_barrier(0); }
        mx = fmaxf(fq_max(mx), sink);
        float sum = 0.f;
#pragma unroll
        for (int nt = 0; nt < 12; ++nt)
#pragma unroll
            for (int i = 0; i < 4; ++i) { const float p = __expf(sc[nt][i] - mx); sc[nt][i] = p; sum += p; }
        sum = fq_sum(sum);
        const float den = sum + __expf(sink - mx);
        bf16x8 pf[6];
#pragma unroll
        for (int ks = 0; ks < 6; ++ks) pf[ks] = pack8(sc[2 * ks], sc[2 * ks + 1]);
        float rden[4];
#pragma unroll
        for (int i = 0; i < 4; ++i) rden[i] = __builtin_amdgcn_rcpf(__shfl(den, 4 * fq + i));
        bf16* op = F.MIX + (row0 + tq0 + 4 * fq) * D + 512 + hq * 64 + fr;
#pragma unroll 1
        for (int dt = 0; dt < 4; ++dt) { f32x4 oacc = (f32x4){0.f, 0.f, 0.f, 0.f};
#pragma unroll
            for (int ks = 0; ks < 6; ++ks) { const LAS bf16* vp = Vt + (16 * dt + fr) * 196 + 32 * ks + 4 * fq;
                const unsigned long long lo = *(const LAS unsigned long long*)vp, hi = *(const LAS unsigned long long*)(vp + 16);
                v4u vv; vv.x = (unsigned)lo; vv.y = (unsigned)(lo >> 32); vv.z = (unsigned)hi; vv.w = (unsigned)(hi >> 32);
                oacc = __builtin_amdgcn_mfma_f32_16x16x32_bf16(pf[ks], __builtin_bit_cast(bf16x8, vv), oacc, 0, 0, 0); }
#pragma unroll
            for (int i = 0; i < 4; ++i) op[(size_t)i * D + 16 * dt] = (bf16)f2bf(oacc[i] * rden[i]); }
    }
    __syncthreads();
}
__device__ __forceinline__ void p3a_prep(Frame& F) {
    LAS unsigned char* wl = F.lds + RING_OFF + F.wave * 19456;
    const int gw = F.vcu * NWAVES + F.wave, NGW = F.G * NWAVES;
    for (int ci = gw; ci < BATCH * 8 * (T / 64); ci += NGW) gdn_prep_chunk(F, ci, wl);
}
__device__ __forceinline__ void p3b_mixers(Frame& F) {
    const int bx = blockIdx.x;
    if (bx < 64) gdn_scan(F, 4 * (bx & 7) + (bx >> 4), (bx >> 3) & 1);
    else {
        const int w = bx - 64, x = w & 7, j = w >> 3, nj = (F.G - 64 - x + 7) >> 3;
        for (int i = j; i < T / 64; i += nj) swa_unit(F, x * (T / 64) + i, F.lds + RING_OFF); }
}

struct Args { const float* in[18]; float* out; unsigned char* ws; };
__global__ void __launch_bounds__(NWAVES * 64, 2) hymba_fwd(Args args) {
    extern __shared__ __attribute__((aligned(16))) unsigned char lds[];
    Frame F;
    F.lds = (LAS unsigned char*)lds;
    F.MISC = (volatile LAS unsigned*)(F.lds + MISC_OFF);
    F.tid = threadIdx.x; F.lane = F.tid & 63; F.wave = __builtin_amdgcn_readfirstlane(F.tid >> 6);
    F.G = gridDim.x; { const int bx = blockIdx.x; F.vcu = (F.G % 8 == 0) ? (bx % 8) * (F.G / 8) + bx / 8 : bx; }
    unsigned char* ws = args.ws;
    F.ctl = (gu32*)(ws + WS_CTL);
    F.x = args.in[0]; F.c = args.in[1]; F.w_ada = args.in[2]; F.b_ada = args.in[3]; F.norm1_w = args.in[4]; F.w_in = args.in[5]; F.conv_w = args.in[6];
    F.a_log = args.in[7]; F.dt_bias = args.in[8]; F.gdn_norm_w = args.in[9]; F.q_norm_w = args.in[10]; F.k_norm_w = args.in[11]; F.sinks = args.in[12];
    F.w_out = args.in[13]; F.norm2_w = args.in[14]; F.w_gate = args.in[15]; F.w_up = args.in[16]; F.w_down = args.in[17]; F.out = args.out;
    F.modacc = (float*)(ws + WS_CTL) + CW_MODACC; F.modf = (float*)(ws + WS_MODF);
    F.Win_t = (bf16*)(ws + WS_WIN); F.Wout_t = (bf16*)(ws + WS_WOUT); F.Wgu_t = (bf16*)(ws + WS_WGU); F.Wdn_t = (bf16*)(ws + WS_WDN);
    F.H = (bf16*)(ws + WS_H); F.PQ = (bf16*)(ws + WS_PQ); F.MIX = (bf16*)(ws + WS_MIX); F.CHKA = (bf16*)(ws + WS_CHKA); F.CHKU = (bf16*)(ws + WS_H); F.X1B = (bf16*)(ws + WS_CHKA); F.CHKT = (bf16*)(ws + WS_CHKA + 32 * MiB); F.ORAW = (bf16*)(ws + WS_CHKA + 32 * MiB); F.dec = (float*)(ws + WS_DEC);
    for (int u = F.tid; u < (LDS_BYTES - LDSCTL_OFF) / 4; u += NWAVES * 64) ((LAS unsigned*)(F.lds + LDSCTL_OFF))[u] = 0u;
    __syncthreads();
    XcdBarrier bar = xcd_barrier_post((unsigned*)(F.ctl + CW_BAR), F.MISC + 8);
#define GRID_BAR() do { xcd_barrier(bar, F.tid); int t_ = F.tid; asm volatile("" : "+v"(t_)); F.tid = t_; F.lane = t_ & 63; } while (0)

    p0_prologue(F);
    norm_phase<1>(F); GRID_BAR();
    { pg8::Gemm g{F.H, F.Win_t, M, NP, D}; pg8::StaticOrder S; S.init(M, NP, F.G, (int)blockIdx.x, WGM_G1);
      pg8::EpiBf16Plain E{F.PQ, NP, C_GZ / 256, C_SQ / 256};
      pg8::gemm_phase<pg8::EpiBf16Plain, pg8::StaticOrder, true, true>(F.lds + RING_OFF, g, S, E, F.tid); }
    GRID_BAR();
    p3a_prep(F); GRID_BAR();
    p3b_mixers(F); GRID_BAR();
    { pg8::Gemm g{F.MIX, F.Wout_t, M, D, D}; pg8::StaticOrder S; S.init(M, D, F.G, (int)blockIdx.x, WGM_G2);
      { pg8::Unit u0; for (int i = 0; S.next(i, u0); ++i) gdn_norm_rows(F, u0.pm * 256); }
      pg8::EpiGateResToBf16 E{F.x, F.X1B, D, F.modf + 2 * D, 6 * D, T};
      pg8::gemm_phase<pg8::EpiGateResToBf16, pg8::StaticOrder, true, true>(F.lds + RING_OFF, g, S, E, F.tid); }
    GRID_BAR();
    norm_phase<2>(F); GRID_BAR();
    { pg8::Gemm g{F.H, F.Wgu_t, M, NGU, D}; pg8::StaticOrder S; S.init(M, NGU, F.G, (int)blockIdx.x, WGM_G3);
      pg8::EpiSwiGLU E{F.PQ, FF};
      pg8::gemm_phase<pg8::EpiSwiGLU, pg8::StaticOrder, true, true>(F.lds + RING_OFF, g, S, E, F.tid); }
    GRID_BAR();
    { pg8::Gemm g{F.PQ, F.Wdn_t, M, D, FF}; pg8::StaticOrder S; S.init(M, D, F.G, (int)blockIdx.x, WGM_G4);
      pg8::EpiGateResFromBf16 E{F.X1B, F.out, D, F.modf + 5 * D, 6 * D, T};
      pg8::gemm_phase<pg8::EpiGateResFromBf16, pg8::StaticOrder, true, true>(F.lds + RING_OFF, g, S, E, F.tid); }
#undef GRID_BAR
}

extern "C" void kernel_launch(void* const* d_in, const int* in_sizes, int n_in, void* d_out, int out_size, void* d_ws, size_t ws_size, hipStream_t stream) {
    static int grid = 0;
    if (grid == 0) {
        if (n_in != 18 || in_sizes[0] != M * D || out_size != M * D || ws_size < WS_END) { fprintf(stderr, "kernel_launch: unexpected shapes (n_in %d, in0 %d, out %d, ws %zu); nothing launched\n", n_in, n_in > 0 ? in_sizes[0] : -1, out_size, ws_size); grid = -1; return; }
        int dev = 0, cus = 0;
        if (hipGetDevice(&dev) != hipSuccess || hipDeviceGetAttribute(&cus, hipDeviceAttributeMultiprocessorCount, dev) != hipSuccess) { grid = -1; return; }
        if (hipFuncSetAttribute((const void*)hymba_fwd, hipFuncAttributeMaxDynamicSharedMemorySize, LDS_BYTES) != hipSuccess) { fprintf(stderr, "kernel_launch: hipFuncSetAttribute failed\n"); grid = -1; return; }
        (void)hipGetLastError();
        grid = cus;
    }
    if (grid < 0) return;
    if (hipMemsetAsync((char*)d_ws + WS_CTL, 0, CTL_ZERO_BYTES, stream) != hipSuccess) { fprintf(stderr, "kernel_launch: hipMemsetAsync failed\n"); return; }
    Args a{};
    for (int i = 0; i < 18; ++i) a.in[i] = (const float*)d_in[i];
    a.out = (float*)d_out; a.ws = (unsigned char*)d_ws;
    hipLaunchKernelGGL(hymba_fwd, dim3(grid), dim3(NWAVES * 64), LDS_BYTES, stream, a);
    const hipError_t le = hipPeekAtLastError();
    if (le != hipSuccess) fprintf(stderr, "kernel_launch: launch failed: %s\n", hipGetErrorName(le));
}
```
